# Optimizing an MI355X kernel written in HIP

```python
import math
import jax
import jax.numpy as jnp
from jax import lax
import numpy as np

D_MODEL = 1024
BATCH = 8
SEQ = 4096
DEPTH = 2

GRID_W = 64
CTX_LEN = 256
EPS = 1e-6
CHUNK = 64

GLA_HEADS = 4
GLA_DK = 64
GLA_DV = 128
GLA_RANK = 16
GLA_GATE_NORM = 16.0
GLA_QK = GLA_HEADS * GLA_DK
GLA_V = GLA_HEADS * GLA_DV
S5_WIDTH = D_MODEL - GLA_V
S5_GROUP = 16
S5_GROUPS = S5_WIDTH // S5_GROUP
S5_STATE = 64
S5_DT_MIN = 1e-3
S5_DT_MAX = 1e-1
AB_SPLITS = (GLA_QK, 2 * GLA_QK, 2 * GLA_QK + GLA_V, 2 * GLA_QK + 2 * GLA_V,
             2 * GLA_QK + 2 * GLA_V + GLA_RANK, 2 * GLA_QK + 2 * GLA_V + 2 * GLA_RANK)
AB_IN = AB_SPLITS[-1] + S5_WIDTH
HG_EXPAND = 128
HG_HEADS = D_MODEL // HG_EXPAND
HG_DV = D_MODEL // HG_HEADS
N_EXPERTS = 32
N_GROUPS = 8
EXPERTS_PER_GROUP = N_EXPERTS // N_GROUPS
TOP_K = 2
D_EXPERT = 256

N_EVEN = (DEPTH + 1) // 2
N_ODD = DEPTH // 2

kernel_name = 'hybrid_gla_s5_hgrn2_groupmoe_diffusion'

F32 = jnp.float32


def rmsnorm(x, g):
    xf = x.astype(F32)
    y = xf * lax.rsqrt(jnp.mean(xf * xf, axis=-1, keepdims=True) + EPS)
    return y.astype(x.dtype) * g


def to_heads(t, n_heads):
    b, n, w = t.shape
    return t.reshape(b, n, n_heads, w // n_heads).transpose(0, 2, 1, 3)


def from_heads(t):
    b, h, n, d = t.shape
    return t.transpose(0, 2, 1, 3).reshape(b, n, h * d)


def grid_sincos(n_tokens, dim):
    rows = n_tokens // GRID_W
    r, col = jnp.meshgrid(jnp.arange(rows, dtype=F32), jnp.arange(GRID_W, dtype=F32), indexing='ij')
    quarter = dim // 4
    omega = 1.0 / (10000.0 ** (jnp.arange(quarter, dtype=F32) / quarter))
    def emb(pos):
        ang = pos.reshape(-1, 1) * omega
        return jnp.concatenate([jnp.sin(ang), jnp.cos(ang)], axis=-1)
    return jnp.concatenate([emb(r), emb(col)], axis=-1)


def chunked_gated_recurrence(q, k, v, log_a, h0):
    out_dtype = v.dtype
    q, k, v, log_a = (t.astype(F32) for t in (q, k, v, log_a))
    bsz, nh, n, dk = q.shape
    dv = v.shape[-1]
    nc = n // CHUNK
    rs = lambda t: t.reshape(bsz, nh, nc, CHUNK, t.shape[-1])
    q, k, v, log_a = rs(q), rs(k), rs(v), rs(log_a)
    b = jnp.cumsum(log_a, axis=3)
    b_mid = b[:, :, :, CHUNK // 2 - 1:CHUNK // 2, :]
    b_end = b[:, :, :, -1:, :]
    attn = jnp.einsum('bhclk,bhcsk->bhcls', q * jnp.exp(b - b_mid), k * jnp.exp(b_mid - b))
    attn = jnp.where(jnp.tril(jnp.ones((CHUNK, CHUNK), dtype=bool)), attn, 0.0)
    o_intra = jnp.einsum('bhcls,bhcsv->bhclv', attn, v)
    q_in = jnp.moveaxis(q * jnp.exp(b), 2, 0)
    d_state = jnp.moveaxis(jnp.einsum('bhcsk,bhcsv->bhckv', k * jnp.exp(b_end - b), v), 2, 0)
    decay = jnp.moveaxis(jnp.exp(b_end[:, :, :, 0, :]), 2, 0)
    s0 = jnp.zeros((bsz, nh, dk, dv), F32) if h0 is None else h0.astype(F32)

    def step(s, xs):
        qc, dsc, dc = xs
        oc = jnp.einsum('bhlk,bhkv->bhlv', qc, s)
        return dc[..., None] * s + dsc, oc

    s_fin, o_inter = lax.scan(step, s0, (q_in, d_state, decay))
    o = o_intra + jnp.moveaxis(o_inter, 0, 2)
    return o.reshape(bsz, nh, n, dv).astype(out_dtype), s_fin


def gated_final_state(k, v, log_a):
    b = jnp.cumsum(log_a.astype(F32), axis=2)
    w = jnp.exp(b[:, :, -1:, :] - b)
    return jnp.einsum('bhnk,bhnv->bhkv', k.astype(F32) * w, v.astype(F32))


def bidir_gated_recurrence(lat, ctx, need_ctx):
    q, k_f, k_b, v, la_f, la_b = lat
    cq, ck_f, ck_b, cv, cla_f, cla_b = ctx
    fl = lambda t: jnp.flip(t, axis=2)
    if need_ctx:
        co_f, s_f = chunked_gated_recurrence(cq, ck_f, cv, cla_f, None)
        co_b, s_b = chunked_gated_recurrence(fl(cq), fl(ck_b), fl(cv), fl(cla_b), None)
        co = co_f + fl(co_b)
    else:
        s_f = gated_final_state(ck_f, cv, cla_f)
        s_b = gated_final_state(fl(ck_b), fl(cv), fl(cla_b))
        co = None
    o_f, _ = chunked_gated_recurrence(q, k_f, v, la_f, s_f)
    o_b, _ = chunked_gated_recurrence(fl(q), fl(k_b), fl(v), fl(la_b), s_b)
    return o_f + fl(o_b), co


def s5_discretize(lam_re, lam_im, log_dt, b_re, b_im):
    dt = jnp.exp(log_dt)[:, None]
    mag = jnp.exp(lam_re * dt)
    a_re, a_im = mag * jnp.cos(lam_im * dt), mag * jnp.sin(lam_im * dt)
    den = lam_re * lam_re + lam_im * lam_im
    f_re = ((a_re - 1.0) * lam_re + a_im * lam_im) / den
    f_im = (a_im * lam_re - (a_re - 1.0) * lam_im) / den
    bb_re = f_re[..., None] * b_re - f_im[..., None] * b_im
    bb_im = f_re[..., None] * b_im + f_im[..., None] * b_re
    return a_re, a_im, bb_re, bb_im


def s5_scan(u, a_re, a_im, bb_re, bb_im, h0, reverse):
    x_re = jnp.einsum('nbgh,gph->nbgp', u, bb_re)
    x_im = jnp.einsum('nbgh,gph->nbgp', u, bb_im)
    if h0 is not None:
        h_re, h_im = h0
        edge = -1 if reverse else 0
        x_re = x_re.at[edge].add(a_re * h_re - a_im * h_im)
        x_im = x_im.at[edge].add(a_re * h_im + a_im * h_re)
    n = u.shape[0]
    ar = jnp.broadcast_to(a_re[None, None], (n, 1) + a_re.shape)
    ai = jnp.broadcast_to(a_im[None, None], (n, 1) + a_im.shape)

    def combine(e1, e2):
        a1r, a1i, b1r, b1i = e1
        a2r, a2i, b2r, b2i = e2
        return (a2r * a1r - a2i * a1i, a2r * a1i + a2i * a1r,
                a2r * b1r - a2i * b1i + b2r, a2r * b1i + a2i * b1r + b2i)

    _, _, s_re, s_im = lax.associative_scan(combine, (ar, ai, x_re, x_im), reverse=reverse, axis=0)
    return s_re, s_im


def s5_bidir(u, uc, lam_re, lam_im, log_dt, b_re, b_im, c_re, c_im, d, need_ctx):
    def to_scan(t):
        bsz, n, _ = t.shape
        return t.astype(F32).reshape(bsz, n, S5_GROUPS, S5_GROUP).transpose(1, 0, 2, 3)

    def readout(s_re, s_im, cr, ci):
        y = jnp.einsum('nbgp,ghp->bngh', s_re, cr) - jnp.einsum('nbgp,ghp->bngh', s_im, ci)
        return y.reshape(y.shape[0], y.shape[1], S5_WIDTH)

    us, ucs = to_scan(u), to_scan(uc)
    y = d.astype(F32) * u.astype(F32)
    yc = d.astype(F32) * uc.astype(F32) if need_ctx else None
    for di, rev in enumerate((False, True)):
        a_re, a_im, bb_re, bb_im = s5_discretize(lam_re[di].astype(F32), lam_im[di].astype(F32),
                                                 log_dt[di].astype(F32), b_re[di].astype(F32),
                                                 b_im[di].astype(F32))
        sc_re, sc_im = s5_scan(ucs, a_re, a_im, bb_re, bb_im, None, rev)
        edge = 0 if rev else -1
        s_re, s_im = s5_scan(us, a_re, a_im, bb_re, bb_im, (sc_re[edge], sc_im[edge]), rev)
        cr, ci = c_re[di].astype(F32), c_im[di].astype(F32)
        y = y + readout(s_re, s_im, cr, ci)
        if need_ctx:
            yc = yc + readout(sc_re, sc_im, cr, ci)
    return y.astype(u.dtype), (yc.astype(uc.dtype) if need_ctx else None)


def mixer_gla_s5(h, hc, w_in, w_out, gla_a2, gla_ab, gla_norm, lam_re, lam_im, log_dt,
                 b_re, b_im, c_re, c_im, s5_d, glu_w, glu_b, need_ctx):
    def project(t):
        q, k, v, g, a_f, a_b, u = jnp.split(t @ w_in, AB_SPLITS, axis=-1)
        la_f = jax.nn.log_sigmoid((a_f @ gla_a2[0] + gla_ab[0]).astype(F32)) / GLA_GATE_NORM
        la_b = jax.nn.log_sigmoid((a_b @ gla_a2[1] + gla_ab[1]).astype(F32)) / GLA_GATE_NORM
        kh = to_heads(k, GLA_HEADS)
        heads = (to_heads(q * GLA_DK ** -0.5, GLA_HEADS), kh, kh, to_heads(v, GLA_HEADS),
                 to_heads(la_f, GLA_HEADS), to_heads(la_b, GLA_HEADS))
        return heads, g, u

    lat, g, u = project(h)
    ctx_heads, gc, uc = project(hc)
    o, oc = bidir_gated_recurrence(lat, ctx_heads, need_ctx)
    s, sc = s5_bidir(u, uc, lam_re, lam_im, log_dt, b_re, b_im, c_re, c_im, s5_d, need_ctx)
    gla_out = lambda o_, g_: from_heads(rmsnorm(o_, gla_norm)) * jax.nn.silu(g_)

    def glu(s_):
        a = jax.nn.gelu(s_)
        return a * jax.nn.sigmoid(a @ glu_w + glu_b)

    y = jnp.concatenate([gla_out(o, g), glu(s)], axis=-1) @ w_out
    yc = jnp.concatenate([gla_out(oc, gc), glu(sc)], axis=-1) @ w_out if need_ctx else None
    return y, yc


def mixer_hgrn2(h, hc, w_in, w_out, lb, hg_norm, need_ctx):
    def project(t):
        q, f_f, f_b, i, g = jnp.split(t @ w_in, 5, axis=-1)

        def gate(f_pre):
            f = lb + (1.0 - lb) * jax.nn.sigmoid(f_pre.astype(F32))
            return to_heads(1.0 - f, HG_HEADS), to_heads(jnp.log(f), HG_HEADS)

        k_f, la_f = gate(f_f)
        k_b, la_b = gate(f_b)
        heads = (to_heads(jax.nn.silu(q), HG_HEADS), k_f, k_b, to_heads(i, HG_HEADS), la_f, la_b)
        return heads, g

    lat, g = project(h)
    ctx_heads, gc = project(hc)
    o, oc = bidir_gated_recurrence(lat, ctx_heads, need_ctx)
    out = lambda o_, g_: (from_heads(rmsnorm(o_, hg_norm)) * jax.nn.silu(g_)) @ w_out
    return out(o, g), (out(oc, gc) if need_ctx else None)


def grouped_moe(t, router_w, router_bias, w_gate, w_up, w_down):
    aff = jax.nn.sigmoid((t @ router_w).astype(F32))
    sel = aff + router_bias.astype(F32)
    sel_g = sel.reshape(-1, N_GROUPS, EXPERTS_PER_GROUP)
    group_score = jnp.sum(lax.top_k(sel_g, TOP_K)[0], axis=-1)
    grp = jnp.argmax(group_score, axis=-1)
    in_grp = jnp.take_along_axis(sel_g, grp[:, None, None], axis=1)[:, 0]
    _, local = lax.top_k(in_grp, TOP_K)
    idx = grp[:, None] * EXPERTS_PER_GROUP + local
    w = jnp.take_along_axis(aff, idx, axis=1)
    w = w / jnp.sum(w, axis=-1, keepdims=True)
    gates = jnp.sum(jax.nn.one_hot(idx, N_EXPERTS, dtype=F32) * w[..., None], axis=1).astype(t.dtype)

    def expert(acc, p):
        wg, wu, wd, ge = p
        y = (jax.nn.silu(t @ wg) * (t @ wu)) @ wd
        return acc + ge[:, None] * y, None

    out, _ = lax.scan(expert, jnp.zeros_like(t), (w_gate, w_up, w_down, gates.T))
    return out


def setup_inputs(seed: int = 0) -> dict:
    key = jax.random.key(seed)
    ks = iter(jax.random.split(key, 40))
    D = D_MODEL
    nrm = lambda shape, scale: scale * jax.random.normal(next(ks), shape, F32)
    gain = lambda shape: 1.0 + nrm(shape, 0.02)
    s5_shape = (N_EVEN, 2, S5_GROUPS, S5_STATE)
    n_idx = jnp.arange(S5_STATE, dtype=F32)
    return {
        'x': nrm((BATCH, SEQ, D), 1.0),
        'c': nrm((BATCH, D), 1.0),
        'ctx': nrm((BATCH, CTX_LEN, D), 1.0),
        'c_ctx': nrm((D,), 1.0),
        'ada_w': nrm((DEPTH, D, 6 * D), 0.5 * D ** -0.5),
        'ada_b': nrm((DEPTH, 6 * D), 0.02),
        'norm_mix': gain((DEPTH, D)),
        'norm_ffn': gain((DEPTH, D)),
        'ab_w_in': nrm((N_EVEN, D, AB_IN), D ** -0.5),
        'ab_w_out': nrm((N_EVEN, GLA_V + S5_WIDTH, D), (GLA_V + S5_WIDTH) ** -0.5),
        'gla_a2': nrm((N_EVEN, 2, GLA_RANK, GLA_QK), GLA_RANK ** -0.5),
        'gla_ab': nrm((N_EVEN, 2, GLA_QK), 0.1),
        'gla_norm': gain((N_EVEN, GLA_DV)),
        's5_lam_re': -0.5 + nrm(s5_shape, 0.01),
        's5_lam_im': math.pi * n_idx + nrm(s5_shape, 0.01),
        's5_log_dt': jax.random.uniform(next(ks), (N_EVEN, 2, S5_GROUPS), F32,
                                        math.log(S5_DT_MIN), math.log(S5_DT_MAX)),
        's5_b_re': nrm((N_EVEN, 2, S5_GROUPS, S5_STATE, S5_GROUP), (2 * S5_GROUP) ** -0.5),
        's5_b_im': nrm((N_EVEN, 2, S5_GROUPS, S5_STATE, S5_GROUP), (2 * S5_GROUP) ** -0.5),
        's5_c_re': nrm((N_EVEN, 2, S5_GROUPS, S5_GROUP, S5_STATE), 0.5),
        's5_c_im': nrm((N_EVEN, 2, S5_GROUPS, S5_GROUP, S5_STATE), 0.5),
        's5_d': nrm((N_EVEN, S5_WIDTH), 0.5),
        's5_glu_w': nrm((N_EVEN, S5_WIDTH, S5_WIDTH), S5_WIDTH ** -0.5),
        's5_glu_b': nrm((N_EVEN, S5_WIDTH), 0.01),
        'hg_w_in': nrm((N_ODD, D, 5 * D), D ** -0.5),
        'hg_w_out': nrm((N_ODD, D, D), D ** -0.5),
        'hg_lb_logits': nrm((DEPTH, D), 0.1),
        'hg_norm': gain((N_ODD, HG_DV)),
        'router_w': nrm((D, N_EXPERTS), D ** -0.5),
        'router_bias': nrm((N_EXPERTS,), 0.01),
        'moe_w_gate': nrm((DEPTH, N_EXPERTS, D, D_EXPERT), D ** -0.5),
        'moe_w_up': nrm((DEPTH, N_EXPERTS, D, D_EXPERT), D ** -0.5),
        'moe_w_down': nrm((DEPTH, N_EXPERTS, D_EXPERT, D), D_EXPERT ** -0.5),
        'final_norm': gain((D,)),
    }


def reference(x, c, ctx, c_ctx, ada_w, ada_b, norm_mix, norm_ffn, ab_w_in, ab_w_out,
              gla_a2, gla_ab, gla_norm, s5_lam_re, s5_lam_im, s5_log_dt, s5_b_re, s5_b_im,
              s5_c_re, s5_c_im, s5_d, s5_glu_w, s5_glu_b, hg_w_in, hg_w_out, hg_lb_logits,
              hg_norm, router_w, router_bias, moe_w_gate, moe_w_up, moe_w_down, final_norm):
    n_lat_seq, d = x.shape[1], x.shape[2]
    x = x + grid_sincos(n_lat_seq, d).astype(x.dtype)[None]
    cx = ctx
    lb_all = jax.nn.softmax(hg_lb_logits.astype(F32), axis=0)
    lb_all = jnp.cumsum(lb_all, axis=0) - lb_all[0]
    silu_c = jax.nn.silu(c)
    silu_cc = jax.nn.silu(c_ctx)
    for l in range(DEPTH):
        last = l == DEPTH - 1
        j = l // 2
        mod = silu_c @ ada_w[l] + ada_b[l]
        mod_c = silu_cc @ ada_w[l] + ada_b[l]
        sh1, sc1, g1, sh2, sc2, g2 = jnp.split(mod[:, None, :], 6, axis=-1)
        csh1, csc1, cg1, csh2, csc2, cg2 = jnp.split(mod_c, 6)
        h = rmsnorm(x, norm_mix[l]) * (1.0 + sc1) + sh1
        hc = rmsnorm(cx, norm_mix[l]) * (1.0 + csc1) + csh1
        if l % 2 == 0:
            y, yc = mixer_gla_s5(h, hc, ab_w_in[j], ab_w_out[j], gla_a2[j], gla_ab[j], gla_norm[j],
                                 s5_lam_re[j], s5_lam_im[j], s5_log_dt[j], s5_b_re[j], s5_b_im[j],
                                 s5_c_re[j], s5_c_im[j], s5_d[j], s5_glu_w[j], s5_glu_b[j],
                                 need_ctx=not last)
        else:
            y, yc = mixer_hgrn2(h, hc, hg_w_in[j], hg_w_out[j], lb_all[l], hg_norm[j],
                                need_ctx=not last)
        x = x + g1 * y
        h = rmsnorm(x, norm_ffn[l]) * (1.0 + sc2) + sh2
        if last:
            ffn = grouped_moe(h.reshape(-1, d), router_w, router_bias,
                              moe_w_gate[l], moe_w_up[l], moe_w_down[l])
            x = x + g2 * ffn.reshape(x.shape)
        else:
            cx = cx + cg1 * yc
            hc = rmsnorm(cx, norm_ffn[l]) * (1.0 + csc2) + csh2
            tokens = jnp.concatenate([h.reshape(-1, d), hc.reshape(-1, d)], axis=0)
            ffn = grouped_moe(tokens, router_w, router_bias,
                              moe_w_gate[l], moe_w_up[l], moe_w_down[l])
            n_lat = x.shape[0] * x.shape[1]
            x = x + g2 * ffn[:n_lat].reshape(x.shape)
            cx = cx + cg2 * ffn[n_lat:].reshape(cx.shape)
    return rmsnorm(x, final_norm)
```

```cpp
#include <hip/hip_runtime.h>
#include <stdint.h>
#include <string.h>
#include <stdio.h>

#ifndef ONE_LAUNCH
#define ONE_LAUNCH 1
#endif

typedef unsigned short bf16_t;
typedef short bf16x8 __attribute__((ext_vector_type(8)));
typedef float f32x4 __attribute__((ext_vector_type(4)));
typedef unsigned u32x4 __attribute__((ext_vector_type(4)));
typedef unsigned u32x2 __attribute__((ext_vector_type(2)));
#define DEVINL __device__ __forceinline__

constexpr int D = 1024, NBATCH = 8, SEQ = 4096, CTXL = 256;
constexpr int RPB = SEQ + CTXL;
constexpr int R = NBATCH * RPB;
constexpr int NLAT = NBATCH * SEQ;
constexpr int NCH = RPB / 64;
constexpr float EPS = 1e-6f;
constexpr int NTHR = 512;
constexpr int LDS_BYTES = 136 * 1024;
constexpr int ACT_ROWS = 41088;

#define XB_TMO      128
#define XB_XCNT(j)  (256  + 64 * (j))
#define XB_XSUB(j)  (1280 + 64 * (j))
#define XB_XGEN(j)  (2304 + 64 * (j))
#define XB_TOP      3328
#define XB_TOPGEN   3392
#define XCD_BAR_WORDS 3456
#define XB_SPIN_CAP (1u << 18)
#define LAS __attribute__((address_space(3)))

__device__ __forceinline__ unsigned xb_ld(unsigned* p)              { return __hip_atomic_load(p, __ATOMIC_RELAXED, __HIP_MEMORY_SCOPE_AGENT); }
__device__ __forceinline__ unsigned xb_add(unsigned* p, unsigned v) { return __hip_atomic_fetch_add(p, v, __ATOMIC_RELAXED, __HIP_MEMORY_SCOPE_AGENT); }
__device__ __forceinline__ unsigned xb_xcc_id() { return (unsigned)__builtin_amdgcn_s_getreg((3 << 11) | 20) & 0xFu; }
#define XB_SPIN(cond, bar) do { unsigned _sp = 0; while (cond) { __builtin_amdgcn_s_sleep(1); \
    if ((++_sp & 255u) == 0u) { if (xb_ld(&(bar)[XB_TMO])) break; if (_sp > XB_SPIN_CAP) { atomicAdd(&(bar)[XB_TMO], 1u); break; } } } } while (0)

struct XcdBarrier {
    unsigned* bar; unsigned x;
    volatile LAS unsigned* st;
};
__device__ __forceinline__ XcdBarrier xcd_barrier_post(unsigned* bar, volatile LAS unsigned* st) {
    XcdBarrier b; b.bar = bar; b.x = xb_xcc_id(); b.st = st;
    if (threadIdx.x == 0) (void)xb_add(&bar[XB_XCNT(b.x)], 1u);
    return b;
}
__device__ __forceinline__ void xcd_barrier_complete(unsigned* bar, unsigned x, unsigned& nloc, unsigned& nx) {
    const unsigned G = gridDim.x * gridDim.y * gridDim.z;
    unsigned sum, cnt, mine, sp = 0u;
    for (;;) {
        sum = 0u; cnt = 0u; mine = 0u;
#pragma unroll
        for (unsigned j = 0; j < 16; ++j) { const unsigned c = xb_ld(&bar[XB_XCNT(j)]); sum += c; cnt += (c > 0u) ? 1u : 0u; mine = (j == x) ? c : mine; }
        if (sum == G) break;
        __builtin_amdgcn_s_sleep(1);
        if ((++sp & 255u) == 0u) { if (xb_ld(&bar[XB_TMO])) break; if (sp > XB_SPIN_CAP) { atomicAdd(&bar[XB_TMO], 1u); break; } }
    }
    nloc = mine > 0u ? mine : 1u; nx = cnt > 0u ? cnt : 1u;
}
__device__ __forceinline__ void xcd_barrier(const XcdBarrier& b) {
    asm volatile("s_waitcnt vmcnt(0)" ::: "memory");
    __syncthreads();
    if (threadIdx.x == 0) {
        unsigned* bar = b.bar;
        __builtin_amdgcn_s_waitcnt(0);
        unsigned nloc = b.st[0], nx = b.st[1];
        if (nloc == 0u) { xcd_barrier_complete(bar, b.x, nloc, nx); b.st[0] = nloc; b.st[1] = nx; }
        const unsigned old = xb_add(&bar[XB_XSUB(b.x)], 1u);
        const unsigned gen = old / nloc;
        if (old + 1u == (gen + 1u) * nloc) {
            __builtin_amdgcn_fence(__ATOMIC_RELEASE, "agent");
            asm volatile("s_waitcnt vmcnt(0)" ::: "memory");
            const unsigned og = xb_add(&bar[XB_TOP], 1u);
            const unsigned tg = og / nx;
            if (og + 1u == (tg + 1u) * nx) xb_add(&bar[XB_TOPGEN], 1u);
            else XB_SPIN(xb_ld(&bar[XB_TOPGEN]) == tg, bar);
            __builtin_amdgcn_fence(__ATOMIC_ACQUIRE, "agent");
            xb_add(&bar[XB_XGEN(b.x)], 1u);
            asm volatile("s_waitcnt vmcnt(0)" ::: "memory");
        } else {
            XB_SPIN(xb_ld(&bar[XB_XGEN(b.x)]) == gen, bar);
            __builtin_amdgcn_fence(__ATOMIC_ACQUIRE, "agent");
            asm volatile("s_waitcnt vmcnt(0)" ::: "memory");
        }
    }
    __syncthreads();
}

struct Params {
    const float *x, *c, *ctx, *c_ctx, *ada_w, *ada_b, *norm_mix, *norm_ffn, *ab_w_in, *ab_w_out, *gla_a2, *gla_ab, *gla_norm;
    const float *s5_lam_re, *s5_lam_im, *s5_log_dt, *s5_b_re, *s5_b_im, *s5_c_re, *s5_c_im, *s5_d, *glu_w, *glu_b;
    const float *hg_w_in, *hg_w_out, *hg_lb, *hg_norm, *router_w, *router_bias, *moe_wg, *moe_wu, *moe_wd, *final_norm;
    float* out;
    unsigned* bar;
    int* cnt;
    float *mod, *pos, *lb, *atab, *a64tab, *bbtab;
    bf16_t* cmt;
    float4* RT;
    int* list; float *wl, *wh;
    float* cx;
    bf16_t *wt_in0, *wt_out0, *glu_t, *wt_in1, *wt_out1;
    bf16_t* H;
    bf16_t* P;
    float *gslots, *gdecs;
    float *s5xend, *s5carry;
    bf16_t* s5a;
    bf16_t *wgu_t, *wd_t, *act;
    float* AF;
    float *hslots, *hdecs;
};

DEVINL float bf2f(bf16_t v) { return __uint_as_float(((unsigned)v) << 16); }
DEVINL bf16_t f2bf(float f) { unsigned u = __float_as_uint(f); u += 0x7fffu + ((u >> 16) & 1u); return (bf16_t)(u >> 16); }
DEVINL unsigned pk2(float lo, float hi) { return (unsigned)f2bf(lo) | ((unsigned)f2bf(hi) << 16); }
DEVINL u32x2 pk4(f32x4 v) { u32x2 r; r.x = pk2(v[0], v[1]); r.y = pk2(v[2], v[3]); return r; }
DEVINL float h2f(unsigned short v) { return (float)__builtin_bit_cast(_Float16, v); }
DEVINL unsigned short f2h(float f) { return __builtin_bit_cast(unsigned short, (_Float16)f); }
DEVINL float sigmoidf_(float x) { return 1.0f / (1.0f + __expf(-x)); }
DEVINL float siluf_(float x) { return x * sigmoidf_(x); }
DEVINL float logsigmoidf_(float x) { return fminf(x, 0.0f) - log1pf(__expf(-fabsf(x))); }
DEVINL float gelu_tanh(float y) { float z = 0.7978845608028654f * (y + 0.044715f * y * y * y); float th = 1.0f - 2.0f / (__expf(2.0f * z) + 1.0f); return 0.5f * y * (1.0f + th); }
DEVINL float* resid_row(const Params& p, int r) {
    const int b = r / RPB, j = r - b * RPB;
    return (j < CTXL) ? (p.cx + (size_t)(b * CTXL + j) * D) : (p.out + (size_t)(b * SEQ + (j - CTXL)) * D);
}
DEVINL int row_batch_mod(int r) { const int b = r / RPB, j = r - b * RPB; return (j < CTXL) ? 8 : b; }

template <int K>
DEVINL f32x4 mma_lds(f32x4 c, const bf16_t* A, int lda, const bf16_t* Bt, int ldb, int fr, int fq) {
#pragma unroll
    for (int k0 = 0; k0 < K; k0 += 32) {
        const bf16x8 a = *(const bf16x8*)(A + fr * lda + k0 + fq * 8);
        const bf16x8 b = *(const bf16x8*)(Bt + fr * ldb + k0 + fq * 8);
        c = __builtin_amdgcn_mfma_f32_16x16x32_bf16(b, a, c, 0, 0, 0);
    }
    return c;
}

DEVINL void cvt_tile64(const float* colp, int ld, int k0, int n0, bf16_t* dst, int ldd, char* smem) {
    float (*T)[65] = (float (*)[65])smem;
    const int t = threadIdx.x, nl = t & 63, ks = t >> 6;
    const float* sp = colp + (size_t)(k0 + ks * 8) * ld;
#pragma unroll
    for (int i = 0; i < 8; ++i) T[nl][ks * 8 + i] = sp[(size_t)i * ld];
    __syncthreads();
    const int n2 = t >> 3, kc = t & 7;
    u32x4 v;
    v.x = pk2(T[n2][kc * 8 + 0], T[n2][kc * 8 + 1]); v.y = pk2(T[n2][kc * 8 + 2], T[n2][kc * 8 + 3]);
    v.z = pk2(T[n2][kc * 8 + 4], T[n2][kc * 8 + 5]); v.w = pk2(T[n2][kc * 8 + 6], T[n2][kc * 8 + 7]);
    *(u32x4*)(dst + (size_t)(n0 + n2) * ldd + k0 + kc * 8) = v;
    __syncthreads();
}

constexpr int NT_GU = 4096, NT_WD = 2048;
DEVINL void moe_cvt_task(const Params& p, int layer, int tid, char* smem) {
    if (tid < NT_GU) {
        const int e = tid >> 7, rem = tid & 127, nb = rem >> 4, kb = rem & 15;
        const float* wg = p.moe_wg + (size_t)(layer * 32 + e) * 1024 * 256;
        const float* wu = p.moe_wu + (size_t)(layer * 32 + e) * 1024 * 256;
        const int n = nb * 64 + (threadIdx.x & 63), blk = n >> 5, wi = n & 31;
        const float* cp = (wi < 16 ? wg : wu) + blk * 16 + (wi & 15);
        cvt_tile64(cp, 256, kb * 64, nb * 64, p.wgu_t + (size_t)e * 512 * 1024, 1024, smem);
    } else {
        const int t2 = tid - NT_GU, e = t2 >> 6, rem = t2 & 63, nb = rem >> 2, kb = rem & 3;
        const float* wd = p.moe_wd + (size_t)(layer * 32 + e) * 256 * 1024;
        cvt_tile64(wd + nb * 64 + (threadIdx.x & 63), 1024, kb * 64, nb * 64, p.wd_t + (size_t)e * 1024 * 256, 256, smem);
    }
}

constexpr int NT_MOD = 192, NT_IN0 = 512, NT_OUT0 = 256, NT_GLU = 64, NT_IN1 = 1280, NT_OUT1 = 256, NT_POS = 64, NT_S5 = 64, NT_MISC = 1;
constexpr int T0_IN0 = NT_MOD, T0_OUT0 = T0_IN0 + NT_IN0, T0_GLU = T0_OUT0 + NT_OUT0, T0_IN1 = T0_GLU + NT_GLU, T0_OUT1 = T0_IN1 + NT_IN1,
              T0_MOE = T0_OUT1 + NT_OUT1, T0_POS = T0_MOE + NT_GU + NT_WD, T0_S5 = T0_POS + NT_POS, T0_MISC = T0_S5 + NT_S5, T0_END = T0_MISC + NT_MISC;

DEVINL void phase_prologue(const Params& p, char* smem, int bid, int nb) {
    const int t = threadIdx.x;
    bool have_sc = false;
    for (int task = bid; task < T0_END; task += nb) {
        if (task < NT_MOD) {
            float* sc = (float*)smem;
            float* red = sc + 9 * 1024;
            if (!have_sc) {
                for (int i = t; i < 9 * 1024; i += NTHR) { const int rr = i >> 10, k = i & 1023; const float v = rr < 8 ? p.c[rr * 1024 + k] : p.c_ctx[k]; sc[i] = siluf_(v); }
                have_sc = true;
                __syncthreads();
            }
            const int l = task / 96, c0 = (task % 96) * 64, col = t & 63, kp = t >> 6;
            const float* wp = p.ada_w + ((size_t)l * 1024 + kp * 128) * 6144 + c0 + col;
            float acc[9];
#pragma unroll
            for (int rr = 0; rr < 9; ++rr) acc[rr] = 0.f;
            for (int k = 0; k < 128; ++k) {
                const float w = wp[(size_t)k * 6144];
#pragma unroll
                for (int rr = 0; rr < 9; ++rr) acc[rr] += sc[rr * 1024 + kp * 128 + k] * w;
            }
#pragma unroll
            for (int rr = 0; rr < 9; ++rr) red[(kp * 9 + rr) * 64 + col] = acc[rr];
            __syncthreads();
            for (int o = t; o < 576; o += NTHR) {
                const int rr = o >> 6, cc = o & 63;
                float s = p.ada_b[l * 6144 + c0 + cc];
#pragma unroll
                for (int q = 0; q < 8; ++q) s += red[(q * 9 + rr) * 64 + cc];
                p.mod[((size_t)l * 9 + rr) * 6144 + c0 + cc] = s;
            }
            __syncthreads();
        } else if (task < T0_OUT0) {
            const int tt = task - T0_IN0, nbk = tt >> 4, kb = tt & 15;
            const int n = nbk * 64 + (t & 63);
            const float* cp = p.ab_w_in + (n < 1536 ? n : n + 32);
            cvt_tile64(cp, 2080, kb * 64, nbk * 64, p.wt_in0, 1024, smem);
        } else if (task < T0_GLU) {
            const int tt = task - T0_OUT0, nbk = tt >> 4, kb = tt & 15;
            const float* cp = p.ab_w_out + nbk * 64 + (t & 63);
            cvt_tile64(cp, 1024, kb * 64, nbk * 64, p.wt_out0, 1024, smem);
        } else if (task < T0_IN1) {
            const int tt = task - T0_GLU, nbk = tt >> 3, kb = tt & 7;
            const float* cp = p.glu_w + nbk * 64 + (t & 63);
            cvt_tile64(cp, 512, kb * 64, nbk * 64, p.glu_t, 512, smem);
        } else if (task < T0_OUT1) {
            const int tt = task - T0_IN1, nbk = tt >> 4, kb = tt & 15;
            const float* cp = p.hg_w_in + nbk * 64 + (t & 63);
            cvt_tile64(cp, 5120, kb * 64, nbk * 64, p.wt_in1, 1024, smem);
        } else if (task < T0_MOE) {
            const int tt = task - T0_OUT1, nbk = tt >> 4, kb = tt & 15;
            const float* cp = p.hg_w_out + nbk * 64 + (t & 63);
            cvt_tile64(cp, 1024, kb * 64, nbk * 64, p.wt_out1, 1024, smem);
        } else if (task < T0_POS) {
            moe_cvt_task(p, 0, task - T0_MOE, smem);
        } else if (task < T0_S5) {
            const int pi = task - T0_POS;
            const int j = t, jj = j & 255;
            const float omega = __expf(-9.210340371976184f * (float)jj * (1.0f / 256.0f));
            const float ang = (float)pi * omega;
            p.pos[pi * 512 + j] = (j < 256) ? sinf(ang) : cosf(ang);
        } else if (task < T0_MISC) {
            const int tt = task - T0_S5, di = tt >> 5, g = tt & 31;
            const int pp = t & 63, hs = t >> 6;
            const float dt = __expf(p.s5_log_dt[di * 32 + g]);
            const float lr = p.s5_lam_re[(di * 32 + g) * 64 + pp], li = p.s5_lam_im[(di * 32 + g) * 64 + pp];
            const float mag = __expf(lr * dt);
            const float are = mag * cosf(li * dt), aim = mag * sinf(li * dt);
            const float den = lr * lr + li * li;
            const float fre = ((are - 1.0f) * lr + aim * li) / den;
            const float fim = (aim * lr - (are - 1.0f) * li) / den;
            if (hs == 0) {
                p.atab[((di * 32 + g) * 64 + pp) * 2 + 0] = are; p.atab[((di * 32 + g) * 64 + pp) * 2 + 1] = aim;
                float xr = are, xi = aim;
#pragma unroll
                for (int q = 0; q < 6; ++q) { const float nr = xr * xr - xi * xi, ni = 2.0f * xr * xi; xr = nr; xi = ni; }
                p.a64tab[((di * 32 + g) * 64 + pp) * 2 + 0] = xr; p.a64tab[((di * 32 + g) * 64 + pp) * 2 + 1] = xi;
            }
#pragma unroll
            for (int q = 0; q < 2; ++q) {
                const int h = hs * 2 + q;
                const float bre = p.s5_b_re[((size_t)((di * 32 + g) * 64 + pp)) * 16 + h], bim = p.s5_b_im[((size_t)((di * 32 + g) * 64 + pp)) * 16 + h];
                float* bt = p.bbtab + ((size_t)((di * 32 + g) * 64 + pp)) * 32;
                bt[h * 2 + 0] = fre * bre - fim * bim;
                bt[h * 2 + 1] = fre * bim + fim * bre;
                const float cre = p.s5_c_re[((size_t)((di * 32 + g) * 16 + h)) * 64 + pp], cim = p.s5_c_im[((size_t)((di * 32 + g) * 16 + h)) * 64 + pp];
                bf16_t* cm = p.cmt + ((size_t)(g * 16 + h)) * 256 + di * 128;
                cm[pp] = f2bf(cre); cm[64 + pp] = f2bf(-cim);
            }
        } else {
            for (int i = t; i < 1024; i += NTHR) p.lb[i] = sigmoidf_(p.hg_lb[1024 + i] - p.hg_lb[i]);
            if (t < 256) p.cnt[t] = 0;
        }
    }
}

template <int MODE>
DEVINL void phase_pre(const Params& p, char* smem, int bid, int nb) {
    constexpr bool GEMV = (MODE == 0 || MODE == 1 || MODE == 3);
    constexpr int L = (MODE >= 2) ? 1 : 0;
    constexpr bool FFN = (MODE == 1 || MODE == 3);
    float* hrow = (float*)smem;
    float* part = hrow + 8 * 1024;
    float* logit = part + 8 * 16 * 32;
    int* lcnt = (int*)(logit + 256);
    const int t = threadIdx.x, w = t >> 6, lane = t & 63;
    float wreg[64];
    if (GEMV) {
        const int e = t & 31, kg = t >> 5;
        const float* W = (MODE == 0) ? (p.ab_w_in + 1536) : p.router_w;
        const int ld = (MODE == 0) ? 2080 : 32;
#pragma unroll
        for (int i = 0; i < 64; ++i) wreg[i] = W[(size_t)(kg * 64 + i) * ld + e];
    }
    if (FFN) { if (t < 64) lcnt[t] = 0; }
    __syncthreads();
    const float* gain = (FFN ? p.norm_ffn : p.norm_mix) + L * 1024;
    const int ngroups = (MODE == 3) ? (NLAT / 8) : (R / 8);
    for (int rg = bid; rg < ngroups; rg += nb) {
        int r;
        if (MODE == 3) { const int i = rg * 8 + w; r = (i >> 12) * RPB + CTXL + (i & 4095); } else r = rg * 8 + w;
        const int b = r / RPB, j = r - b * RPB;
        const bool isctx = j < CTXL;
        const float* modv = p.mod + ((size_t)(L * 9 + (isctx ? 8 : b))) * 6144 + (FFN ? 3072 : 0);
        float* res = isctx ? (p.cx + (size_t)(b * CTXL + j) * D) : (p.out + (size_t)(b * SEQ + (j - CTXL)) * D);
        f32x4 v[4];
        if (MODE == 0) {
            const float* src = isctx ? (p.ctx + (size_t)(b * CTXL + j) * D) : (p.x + (size_t)(b * SEQ + (j - CTXL)) * D);
#pragma unroll
            for (int i = 0; i < 4; ++i) v[i] = *(const f32x4*)(src + lane * 4 + i * 256);
            if (!isctx) {
                const int n = j - CTXL, prow = n >> 6, pcol = n & 63;
#pragma unroll
                for (int i = 0; i < 4; ++i) {
                    const int c = lane * 4 + i * 256;
                    const f32x4 pe = (c < 512) ? *(const f32x4*)(p.pos + prow * 512 + c) : *(const f32x4*)(p.pos + pcol * 512 + (c - 512));
                    v[i] += pe;
                }
            }
#pragma unroll
            for (int i = 0; i < 4; ++i) *(f32x4*)(res + lane * 4 + i * 256) = v[i];
        } else {
#pragma unroll
            for (int i = 0; i < 4; ++i) v[i] = *(const f32x4*)(res + lane * 4 + i * 256);
        }
        float ss = 0.f;
#pragma unroll
        for (int i = 0; i < 4; ++i) ss += v[i][0] * v[i][0] + v[i][1] * v[i][1] + v[i][2] * v[i][2] + v[i][3] * v[i][3];
#pragma unroll
        for (int o = 32; o >= 1; o >>= 1) ss += __shfl_xor(ss, o);
        const float rstd = rsqrtf(ss * (1.0f / 1024.0f) + EPS);
#pragma unroll
        for (int i = 0; i < 4; ++i) {
            const int c = lane * 4 + i * 256;
            const f32x4 g4 = *(const f32x4*)(gain + c), sh4 = *(const f32x4*)(modv + c), sc4 = *(const f32x4*)(modv + 1024 + c);
            f32x4 hv;
#pragma unroll
            for (int q = 0; q < 4; ++q) hv[q] = v[i][q] * rstd * g4[q] * (1.0f + sc4[q]) + sh4[q];
            *(u32x2*)(p.H + (size_t)r * D + c) = pk4(hv);
            if (GEMV) *(f32x4*)(hrow + w * 1024 + c) = hv;
        }
        if (GEMV) {
            __syncthreads();
            const int e = t & 31, kg = t >> 5;
#pragma unroll 1
            for (int row = 0; row < 8; ++row) {
                float s = 0.f;
#pragma unroll
                for (int i = 0; i < 64; i += 4) {
                    const f32x4 hv = *(const f32x4*)(hrow + row * 1024 + kg * 64 + i);
                    s += wreg[i] * hv[0] + wreg[i + 1] * hv[1] + wreg[i + 2] * hv[2] + wreg[i + 3] * hv[3];
                }
                part[(row * 16 + kg) * 32 + e] = s;
            }
            __syncthreads();
            if (t < 256) {
                const int row = t >> 5, e2 = t & 31;
                float s = 0.f;
#pragma unroll
                for (int q = 0; q < 16; ++q) s += part[(row * 16 + q) * 32 + e2];
                if (MODE == 0) p.AF[(size_t)(rg * 8 + row) * 32 + e2] = s;
                else logit[row * 32 + e2] = s;
            }
            if (FFN) {
                __syncthreads();
                if (t < 8) {
                    int rr;
                    if (MODE == 3) { const int i = rg * 8 + t; rr = (i >> 12) * RPB + CTXL + (i & 4095); } else rr = rg * 8 + t;
                    float best = -3.0e38f; int bg = 0, bi1 = 0, bi2 = 1; float ba1 = 0.f, ba2 = 0.f;
#pragma unroll 1
                    for (int g = 0; g < 8; ++g) {
                        float m1 = -3.0e38f, m2 = -3.0e38f, a1 = 0.f, a2 = 0.f; int i1 = 0, i2 = 0;
#pragma unroll
                        for (int e = 0; e < 4; ++e) {
                            const float a = sigmoidf_(logit[t * 32 + g * 4 + e]);
                            const float s = a + p.router_bias[g * 4 + e];
                            if (s > m1) { m2 = m1; i2 = i1; a2 = a1; m1 = s; i1 = e; a1 = a; }
                            else if (s > m2) { m2 = s; i2 = e; a2 = a; }
                        }
                        const float gs = m1 + m2;
                        if (gs > best) { best = gs; bg = g; bi1 = i1; bi2 = i2; ba1 = a1; ba2 = a2; }
                    }
                    const float inv = 1.0f / (ba1 + ba2);
                    const float w1 = ba1 * inv, w2 = ba2 * inv;
                    const int lo = bi1 < bi2 ? bi1 : bi2, hi = bi1 < bi2 ? bi2 : bi1;
                    const float wlo = bi1 < bi2 ? w1 : w2, whi = bi1 < bi2 ? w2 : w1;
                    const int pair = (lo == 0) ? (hi - 1) : (lo == 1 ? (hi + 1) : 5);
                    const int bucket = bg * 6 + pair;
                    float4 rec; rec.x = __int_as_float(bucket); rec.y = wlo; rec.z = whi; rec.w = 0.f;
                    p.RT[rr] = rec;
                    atomicAdd(&lcnt[bucket], 1);
                }
            }
            __syncthreads();
        }
    }
    if (FFN) {
        __syncthreads();
        if (t < 48 && lcnt[t] != 0) atomicAdd(&p.cnt[L * 64 + t], lcnt[t]);
    }
    if (MODE == 3) {
        for (int task = bid; task < NT_GU + NT_WD; task += nb) moe_cvt_task(p, 1, task, smem);
    }
}

struct GemmSmem { bf16_t A[2][128][72]; bf16_t B[2][256][72]; };
static_assert(sizeof(GemmSmem) <= LDS_BYTES, "gemm lds");

template <class Epi>
DEVINL void gemm_tile(const bf16_t* __restrict__ A, int lda, const int* __restrict__ rowlist, int m0, int mvalid,
                      const bf16_t* __restrict__ Bt0, const bf16_t* __restrict__ Bt1, int ldb, int kseg, int K, Epi& epi, char* smem) {
    GemmSmem& S = *(GemmSmem*)smem;
    const int t = threadIdx.x, w = t >> 6, lane = t & 63, fr = lane & 15, fq = lane >> 4, wr = w >> 2, wc = w & 3;
    const int ch = t & 7, rr = t >> 3;
    const bf16_t* ap[2];
#pragma unroll
    for (int i = 0; i < 2; ++i) {
        const int ri = rr + i * 64, gi = ri < mvalid ? ri : 0;
        const int grow = rowlist ? rowlist[m0 + gi] : (m0 + gi);
        ap[i] = A + (size_t)grow * lda + ch * 8;
    }
    u32x4 ra[2], rb[4];
    f32x4 acc[4][4];
#pragma unroll
    for (int m = 0; m < 4; ++m)
#pragma unroll
        for (int n = 0; n < 4; ++n) acc[m][n] = (f32x4){0.f, 0.f, 0.f, 0.f};
    const int nk = K >> 6;
#define GT_GLOAD(kt) do { const int _k0 = (kt) * 64; \
        _Pragma("unroll") for (int i = 0; i < 2; ++i) ra[i] = *(const u32x4*)(ap[i] + _k0); \
        const bf16_t* _bb = (_k0 < kseg) ? (Bt0 + _k0) : (Bt1 + (_k0 - kseg)); \
        _Pragma("unroll") for (int i = 0; i < 4; ++i) rb[i] = *(const u32x4*)(_bb + (size_t)(rr + i * 64) * ldb + ch * 8); } while (0)
#define GT_SSTORE(buf) do { \
        _Pragma("unroll") for (int i = 0; i < 2; ++i) *(u32x4*)&S.A[buf][rr + i * 64][ch * 8] = ra[i]; \
        _Pragma("unroll") for (int i = 0; i < 4; ++i) *(u32x4*)&S.B[buf][rr + i * 64][ch * 8] = rb[i]; } while (0)
    GT_GLOAD(0);
    GT_SSTORE(0);
    __syncthreads();
    for (int kt = 0; kt < nk; ++kt) {
        const int cur = kt & 1;
        if (kt + 1 < nk) GT_GLOAD(kt + 1);
#pragma unroll
        for (int kk = 0; kk < 2; ++kk) {
            bf16x8 a[4], b[4];
#pragma unroll
            for (int m = 0; m < 4; ++m) a[m] = *(const bf16x8*)&S.A[cur][wr * 64 + m * 16 + fr][kk * 32 + fq * 8];
#pragma unroll
            for (int n = 0; n < 4; ++n) b[n] = *(const bf16x8*)&S.B[cur][wc * 64 + n * 16 + fr][kk * 32 + fq * 8];
#pragma unroll
            for (int m = 0; m < 4; ++m)
#pragma unroll
                for (int n = 0; n < 4; ++n) acc[m][n] = __builtin_amdgcn_mfma_f32_16x16x32_bf16(b[n], a[m], acc[m][n], 0, 0, 0);
        }
        if (kt + 1 < nk) GT_SSTORE(cur ^ 1);
        __syncthreads();
    }
#undef GT_GLOAD
#undef GT_SSTORE
    epi(acc, wr * 64, wc * 64, fr, fq);
}

struct EpiP0 {
    bf16_t* P; int m0, n0;
    DEVINL void operator()(const f32x4 (&acc)[4][4], int mb, int nbs, int fr, int fq) const {
        const float sc = (n0 < 256) ? 0.125f : 1.0f;
#pragma unroll
        for (int m = 0; m < 4; ++m) {
            bf16_t* rp = P + (size_t)(m0 + mb + m * 16 + fr) * 2048 + n0 + nbs + fq * 4;
#pragma unroll
            for (int n = 0; n < 4; ++n) *(u32x2*)(rp + n * 16) = pk4(acc[m][n] * sc);
        }
    }
};
struct EpiP1 {
    bf16_t* P; const float* lb; int m0, n0;
    DEVINL void operator()(const f32x4 (&acc)[4][4], int mb, int nbs, int fr, int fq) const {
        const int cb = n0 >> 10;
#pragma unroll
        for (int m = 0; m < 4; ++m) {
            bf16_t* rp = P + (size_t)(m0 + mb + m * 16 + fr) * 5120 + n0 + nbs + fq * 4;
#pragma unroll
            for (int n = 0; n < 4; ++n) {
                const f32x4 a = acc[m][n];
                u32x2 o;
                if (cb == 1 || cb == 2) {
                    const int cc = ((n0 + nbs + n * 16 + fq * 4) & 1023);
                    const f32x4 l4 = *(const f32x4*)(lb + cc);
                    unsigned short hv[4];
#pragma unroll
                    for (int j = 0; j < 4; ++j) { const float f = l4[j] + (1.0f - l4[j]) * sigmoidf_(a[j]); hv[j] = f2h(__logf(f)); }
                    o.x = (unsigned)hv[0] | ((unsigned)hv[1] << 16); o.y = (unsigned)hv[2] | ((unsigned)hv[3] << 16);
                } else if (cb == 0 || cb == 4) {
                    f32x4 s;
#pragma unroll
                    for (int j = 0; j < 4; ++j) s[j] = siluf_(a[j]);
                    o = pk4(s);
                } else o = pk4(a);
                *(u32x2*)(rp + n * 16) = o;
            }
        }
    }
};
struct EpiGlu {
    bf16_t* CAT; const bf16_t* s5a; const float* gb; int m0, n0;
    DEVINL void operator()(const f32x4 (&acc)[4][4], int mb, int nbs, int fr, int fq) const {
#pragma unroll
        for (int m = 0; m < 4; ++m) {
            const size_t row = (size_t)(m0 + mb + m * 16 + fr);
#pragma unroll
            for (int n = 0; n < 4; ++n) {
                const int col = n0 + nbs + n * 16 + fq * 4;
                const u32x2 av = *(const u32x2*)(s5a + row * 512 + col);
                const f32x4 b4 = *(const f32x4*)(gb + col);
                f32x4 o;
                o[0] = bf2f((bf16_t)(av.x & 0xffff)) * sigmoidf_(acc[m][n][0] + b4[0]);
                o[1] = bf2f((bf16_t)(av.x >> 16)) * sigmoidf_(acc[m][n][1] + b4[1]);
                o[2] = bf2f((bf16_t)(av.y & 0xffff)) * sigmoidf_(acc[m][n][2] + b4[2]);
                o[3] = bf2f((bf16_t)(av.y >> 16)) * sigmoidf_(acc[m][n][3] + b4[3]);
                *(u32x2*)(CAT + row * 1024 + 512 + col) = pk4(o);
            }
        }
    }
};
struct EpiOut {
    const Params* p; const float* gate; int m0, n0;
    DEVINL void operator()(const f32x4 (&acc)[4][4], int mb, int nbs, int fr, int fq) const {
#pragma unroll
        for (int m = 0; m < 4; ++m) {
            const int r = m0 + mb + m * 16 + fr;
            float* rp = resid_row(*p, r);
            const float* gp = gate + (size_t)row_batch_mod(r) * 6144;
#pragma unroll
            for (int n = 0; n < 4; ++n) {
                const int col = n0 + nbs + n * 16 + fq * 4;
                const f32x4 g4 = *(const f32x4*)(gp + col);
                f32x4 x4 = *(f32x4*)(rp + col);
                x4 += g4 * acc[m][n];
                *(f32x4*)(rp + col) = x4;
            }
        }
    }
};
struct EpiMoe1 {
    bf16_t* act; const float* wsel; int m0, mvalid, colbase;
    DEVINL void operator()(const f32x4 (&acc)[4][4], int mb, int nbs, int fr, int fq) const {
#pragma unroll
        for (int m = 0; m < 4; ++m) {
            const int lr = mb + m * 16 + fr;
            if (lr < mvalid) {
                const int slot = m0 + lr;
                const float wv = wsel[slot];
#pragma unroll
                for (int nn = 0; nn < 2; ++nn) {
                    f32x4 o;
#pragma unroll
                    for (int j = 0; j < 4; ++j) o[j] = wv * siluf_(acc[m][2 * nn][j]) * acc[m][2 * nn + 1][j];
                    *(u32x2*)(act + (size_t)slot * 512 + colbase + (nbs >> 1) + nn * 16 + fq * 4) = pk4(o);
                }
            }
        }
    }
};
struct EpiMoe2 {
    const Params* p; const float* gate; const int* list; int m0, mvalid, n0;
    DEVINL void operator()(const f32x4 (&acc)[4][4], int mb, int nbs, int fr, int fq) const {
#pragma unroll
        for (int m = 0; m < 4; ++m) {
            const int lr = mb + m * 16 + fr;
            if (lr < mvalid) {
                const int r = list[m0 + lr];
                float* rp = resid_row(*p, r);
                const float* gp = gate + (size_t)row_batch_mod(r) * 6144;
#pragma unroll
                for (int n = 0; n < 4; ++n) {
                    const int col = n0 + nbs + n * 16 + fq * 4;
                    const f32x4 g4 = *(const f32x4*)(gp + col);
                    f32x4 x4 = *(f32x4*)(rp + col);
                    x4 += g4 * acc[m][n];
                    *(f32x4*)(rp + col) = x4;
                }
            }
        }
    }
};

template <int WHICH>
DEVINL void phase_gemm(const Params& p, char* smem, int bid, int nb) {
    constexpr int N = (WHICH == 0) ? 2048 : (WHICH == 1) ? 512 : (WHICH == 3) ? 5120 : 1024;
    constexpr int K = (WHICH == 1) ? 512 : 1024;
    constexpr int NT = N / 256, MT = R / 128;
    for (int u = bid; u < MT * NT; u += nb) {
        const int mt = u / NT, nt = u - mt * NT;
        const int m0 = mt * 128, n0 = nt * 256;
        if (WHICH == 4) { const int j = m0 % RPB; if (j < CTXL) continue; }
        if (WHICH == 0) { EpiP0 e{p.P, m0, n0}; gemm_tile(p.H, 1024, nullptr, m0, 128, p.wt_in0 + (size_t)n0 * 1024, nullptr, 1024, K, K, e, smem); }
        if (WHICH == 1) { EpiGlu e{p.H, p.s5a, p.glu_b, m0, n0}; gemm_tile(p.s5a, 512, nullptr, m0, 128, p.glu_t + (size_t)n0 * 512, nullptr, 512, K, K, e, smem); }
        if (WHICH == 2) { EpiOut e{&p, p.mod + 2048, m0, n0}; gemm_tile(p.H, 1024, nullptr, m0, 128, p.wt_out0 + (size_t)n0 * 1024, nullptr, 1024, K, K, e, smem); }
        if (WHICH == 3) { EpiP1 e{p.P, p.lb, m0, n0}; gemm_tile(p.H, 1024, nullptr, m0, 128, p.wt_in1 + (size_t)n0 * 1024, nullptr, 1024, K, K, e, smem); }
        if (WHICH == 4) { EpiOut e{&p, p.mod + 9 * 6144 + 2048, m0, n0}; gemm_tile(p.H, 1024, nullptr, m0, 128, p.wt_out1 + (size_t)n0 * 1024, nullptr, 1024, K, K, e, smem); }
    }
}

DEVINL void moe_setup(const Params& p, int L, int* off, int* tstart) {
    if (threadIdx.x == 0) {
        int o = 0, ts = 0;
        for (int b = 0; b < 48; ++b) { const int c = p.cnt[L * 64 + b]; off[b] = o; tstart[b] = ts; const int nt = (c + 127) >> 7; o += nt * 128; ts += nt; }
        off[48] = o; tstart[48] = ts;
    }
    __syncthreads();
}
template <int L>
DEVINL void phase_list(const Params& p, char* smem, int bid, int nb) {
    int* off = (int*)smem; int* tstart = off + 64;
    moe_setup(p, L, off, tstart);
    const int nrows = L ? NLAT : R;
    for (int i = bid * NTHR + threadIdx.x; i < nrows; i += nb * NTHR) {
        const int r = L ? ((i >> 12) * RPB + CTXL + (i & 4095)) : i;
        const float4 rec = p.RT[r];
        const int bucket = __float_as_int(rec.x);
        const int pos = atomicAdd(&p.cnt[128 + L * 64 + bucket], 1);
        const int slot = off[bucket] + pos;
        p.list[slot] = r; p.wl[slot] = rec.y; p.wh[slot] = rec.z;
    }
}
template <int L, int STAGE>
DEVINL void phase_moe(const Params& p, char* smem, int bid, int nb) {
    int* off = (int*)(smem + sizeof(GemmSmem)); int* tstart = off + 64;
    static_assert(sizeof(GemmSmem) + 1024 <= LDS_BYTES, "moe lds");
    moe_setup(p, L, off, tstart);
    const int ntiles = tstart[48];
    for (int u = bid; u < ntiles * 4; u += nb) {
        const int tile = u >> 2, nt = u & 3;
        int bucket = 0;
        for (int b = 0; b < 48; ++b) if (tile >= tstart[b] && tile < tstart[b + 1]) bucket = b;
        const int ti = tile - tstart[bucket];
        const int cntb = p.cnt[L * 64 + bucket];
        const int m0 = off[bucket] + ti * 128;
        const int mvalid = min(128, cntb - ti * 128);
        const int grp = bucket / 6, pair = bucket - grp * 6;
        const int lo = (pair < 3) ? 0 : (pair < 5 ? 1 : 2);
        const int hi = (pair < 3) ? (pair + 1) : (pair < 5 ? (pair - 1) : 3);
        const int ea = grp * 4 + lo, eb = grp * 4 + hi;
        if (STAGE == 1) {
            const int half = nt >> 1, e = half ? eb : ea;
            EpiMoe1 ep{p.act, half ? p.wh : p.wl, m0, mvalid, half * 256 + (nt & 1) * 128};
            gemm_tile(p.H, 1024, p.list, m0, mvalid, p.wgu_t + ((size_t)e * 512 + (nt & 1) * 256) * 1024, nullptr, 1024, 1024, 1024, ep, smem);
        } else {
            EpiMoe2 ep{&p, p.mod + (size_t)L * 9 * 6144 + 5120, p.list, m0, mvalid, nt * 256};
            gemm_tile(p.act, 512, nullptr, m0, mvalid, p.wd_t + ((size_t)ea * 1024 + nt * 256) * 256, p.wd_t + ((size_t)eb * 1024 + nt * 256) * 256, 256, 256, 512, ep, smem);
        }
    }
}

template <int DK> struct RecL {
    static constexpr int QS = DK + 8;
    static constexpr int oQs = 0;
    static constexpr int oKs = oQs + 64 * QS * 2;
    static constexpr int oKt = oKs + 64 * QS * 2;
    static constexpr int oVt = oKt + DK * 72 * 2;
    static constexpr int oAt = oVt + 128 * 72 * 2;
    static constexpr int oSt = oAt + 64 * 72 * 2;
    static constexpr int oPart = oSt + 128 * QS * 2;
    static constexpr int oEmid = oPart + 8 * 128 * 4;
    static constexpr int oEend = oEmid + 128 * 4;
    static constexpr int oAF = oEend + 128 * 4;
    static constexpr int oRed = oAF + 64 * 32 * 4;
    static constexpr int total = oRed + 64 * 2 * 4;
};
static_assert(RecL<128>::total <= LDS_BYTES, "rec lds");

template <bool GLA> struct RecCols {
    static constexpr int LDP = GLA ? 2048 : 5120;
    static constexpr int QOFF = 0;
    static constexpr int KOFF = 256;
    static constexpr int LAF = 1024, LAB = 2048;
    static constexpr int VOFF = GLA ? 512 : 3072;
    static constexpr int GOFF = GLA ? 1024 : 4096;
};

template <int DK, bool GLA, int DIR>
DEVINL void rec_prep(const Params& p, char* smem, const bf16_t* __restrict__ P, int row0, int h, bool ref_end, bool need_q,
                     const float (&a2col)[16], float abv, float& bsum_acc) {
    using L = RecL<DK>; using C = RecCols<GLA>;
    constexpr int NSEG = NTHR / DK, RS = 64 / NSEG, QS = L::QS, LDP = C::LDP;
    bf16_t* Qs = (bf16_t*)(smem + L::oQs); bf16_t* Ks = (bf16_t*)(smem + L::oKs); bf16_t* Kt = (bf16_t*)(smem + L::oKt); bf16_t* Vt = (bf16_t*)(smem + L::oVt);
    float* part = (float*)(smem + L::oPart); float* emid = (float*)(smem + L::oEmid); float* eend = (float*)(smem + L::oEend); float* AFs = (float*)(smem + L::oAF);
    const int t = threadIdx.x, k = t % DK, seg = t / DK, l0 = seg * RS;
    float la[RS];
    if (GLA) {
        { const int rr = t >> 3, c4 = (t & 7) * 4; *(f32x4*)&AFs[rr * 32 + c4] = *(const f32x4*)&p.AF[(size_t)(row0 + rr) * 32 + c4]; }
        __syncthreads();
#pragma unroll
        for (int i = 0; i < RS; ++i) {
            const float* ar = &AFs[(l0 + i) * 32 + DIR * 16];
            float s = abv;
#pragma unroll
            for (int r = 0; r < 16; ++r) s += ar[r] * a2col[r];
            la[i] = logsigmoidf_(s) * 0.0625f;
        }
    } else {
        const bf16_t* lp = P + (size_t)(row0 + l0) * LDP + (DIR ? C::LAB : C::LAF) + h * DK + k;
#pragma unroll
        for (int i = 0; i < RS; ++i) la[i] = h2f(lp[(size_t)i * LDP]);
    }
    float s = 0.f;
#pragma unroll
    for (int i = 0; i < RS; ++i) s += la[i];
    part[seg * 128 + k] = s;
    __syncthreads();
    float tot = 0.f, base = 0.f, bmid = 0.f;
#pragma unroll
    for (int sg = 0; sg < NSEG; ++sg) {
        const float pv = part[sg * 128 + k];
        tot += pv;
        if (DIR == 0 ? (sg < seg) : (sg > seg)) base += pv;
        if (DIR == 0 ? (sg < NSEG / 2) : (sg >= NSEG / 2)) bmid += pv;
    }
    const float bref = ref_end ? tot : bmid;
    if (seg == 0) { emid[k] = __expf(bref); eend[k] = __expf(tot - bref); bsum_acc += tot; }
    unsigned short ktv[RS];
    float b = base;
#pragma unroll
    for (int ii = 0; ii < RS; ++ii) {
        const int i = (DIR == 0) ? ii : (RS - 1 - ii);
        b += la[i];
        const int l = l0 + i;
        const size_t ro = (size_t)(row0 + l) * LDP;
        const float kval = GLA ? bf2f(P[ro + C::KOFF + h * DK + k]) : (1.0f - __expf(la[i]));
        const bf16_t kb = f2bf(kval * __expf(bref - b));
        ktv[i] = kb;
        if (need_q) {
            Ks[l * QS + k] = kb;
            const float qv = bf2f(P[ro + C::QOFF + h * DK + k]);
            Qs[l * QS + k] = f2bf(qv * __expf(b - bref));
        }
    }
#pragma unroll
    for (int c = 0; c < RS / 8; ++c) {
        u32x4 v;
        v.x = (unsigned)ktv[c * 8 + 0] | ((unsigned)ktv[c * 8 + 1] << 16); v.y = (unsigned)ktv[c * 8 + 2] | ((unsigned)ktv[c * 8 + 3] << 16);
        v.z = (unsigned)ktv[c * 8 + 4] | ((unsigned)ktv[c * 8 + 5] << 16); v.w = (unsigned)ktv[c * 8 + 6] | ((unsigned)ktv[c * 8 + 7] << 16);
        *(u32x4*)&Kt[k * 72 + l0 + c * 8] = v;
    }
    {
        const int v = t & 127, vq = t >> 7;
        const bf16_t* vp = P + (size_t)(row0 + vq * 16) * LDP + C::VOFF + h * 128 + v;
        unsigned short vv[16];
#pragma unroll
        for (int i = 0; i < 16; ++i) vv[i] = vp[(size_t)i * LDP];
#pragma unroll
        for (int c = 0; c < 2; ++c) {
            u32x4 o;
            o.x = (unsigned)vv[c * 8 + 0] | ((unsigned)vv[c * 8 + 1] << 16); o.y = (unsigned)vv[c * 8 + 2] | ((unsigned)vv[c * 8 + 3] << 16);
            o.z = (unsigned)vv[c * 8 + 4] | ((unsigned)vv[c * 8 + 5] << 16); o.w = (unsigned)vv[c * 8 + 6] | ((unsigned)vv[c * 8 + 7] << 16);
            *(u32x4*)&Vt[v * 72 + vq * 16 + c * 8] = o;
        }
    }
    __syncthreads();
}

template <int DK, bool GLA> struct RecGeo {
    static constexpr int GC = GLA ? 4 : 8;
    static constexpr int NS = GLA ? 16 : 8;
    static constexpr int H = GLA ? 4 : 8;
    static constexpr int KT = DK / 16;
};

template <int DK, bool GLA, int DIR>
DEVINL void rec_pass1_unit(const Params& p, char* smem, const bf16_t* P, int b, int h, int cg, float* slots, float* decs) {
    using L = RecL<DK>; using G = RecGeo<DK, GLA>;
    constexpr int KT = G::KT;
    bf16_t* Kt = (bf16_t*)(smem + L::oKt); bf16_t* Vt = (bf16_t*)(smem + L::oVt); float* emid = (float*)(smem + L::oEmid);
    const int t = threadIdx.x, w = t >> 6, lane = t & 63, fr = lane & 15, fq = lane >> 4;
    float a2col[16]; float abv = 0.f;
#pragma unroll
    for (int r = 0; r < 16; ++r) a2col[r] = 0.f;
    if (GLA) {
        const int k = t % DK;
#pragma unroll
        for (int r = 0; r < 16; ++r) a2col[r] = p.gla_a2[(DIR * 16 + r) * 256 + h * 64 + k];
        abv = p.gla_ab[DIR * 256 + h * 64 + k];
    }
    f32x4 accS[KT];
#pragma unroll
    for (int kt = 0; kt < KT; ++kt) accS[kt] = (f32x4){0.f, 0.f, 0.f, 0.f};
    float bsum = 0.f;
    const int nch = (cg == 0) ? 4 : G::GC;
    for (int ci = 0; ci < nch; ++ci) {
        const int pc = (cg == 0) ? (DIR == 0 ? ci : 3 - ci) : (DIR == 0 ? (4 + (cg - 1) * G::GC + ci) : (67 - (cg - 1) * G::GC - ci));
        const int row0 = b * RPB + pc * 64;
        rec_prep<DK, GLA, DIR>(p, smem, P, row0, h, true, false, a2col, abv, bsum);
#pragma unroll
        for (int kt = 0; kt < KT; ++kt) {
            const f32x4 e4 = *(const f32x4*)&emid[kt * 16 + fq * 4];
            f32x4 c = accS[kt] * e4;
            c = mma_lds<64>(c, Vt + (w * 16) * 72, 72, Kt + (kt * 16) * 72, 72, fr, fq);
            accS[kt] = c;
        }
        __syncthreads();
    }
    const size_t chain = ((size_t)(b * G::H + h) * 2 + DIR);
    float* sl = slots + (chain * G::NS + cg) * (size_t)(128 * DK);
#pragma unroll
    for (int kt = 0; kt < KT; ++kt) *(f32x4*)&sl[(w * 16 + fr) * DK + kt * 16 + fq * 4] = accS[kt];
    if (t < DK) decs[(chain * G::NS + cg) * DK + t] = bsum;
}

template <int DK, bool GLA, int DIR>
DEVINL void rec_pass3_chunk(const Params& p, char* smem, const bf16_t* P, bf16_t* CAT, int row0, int h, f32x4 (&accS)[DK / 16],
                            const float (&a2col)[16], float abv, const float* gnorm) {
    using L = RecL<DK>; using C = RecCols<GLA>;
    constexpr int KT = DK / 16, QS = L::QS;
    bf16_t* Qs = (bf16_t*)(smem + L::oQs); bf16_t* Ks = (bf16_t*)(smem + L::oKs); bf16_t* Kt = (bf16_t*)(smem + L::oKt); bf16_t* Vt = (bf16_t*)(smem + L::oVt);
    bf16_t* At = (bf16_t*)(smem + L::oAt); bf16_t* St = (bf16_t*)(smem + L::oSt);
    float* emid = (float*)(smem + L::oEmid); float* eend = (float*)(smem + L::oEend); float* red = (float*)(smem + L::oRed);
    const int t = threadIdx.x, w = t >> 6, lane = t & 63, fr = lane & 15, fq = lane >> 4;
    float dummy = 0.f;
    rec_prep<DK, GLA, DIR>(p, smem, P, row0, h, false, true, a2col, abv, dummy);
#pragma unroll
    for (int kt = 0; kt < KT; ++kt) {
        const f32x4 e4 = *(const f32x4*)&emid[kt * 16 + fq * 4];
        accS[kt] = accS[kt] * e4;
        *(u32x2*)&St[(w * 16 + fr) * QS + kt * 16 + fq * 4] = pk4(accS[kt]);
    }
    {
        const int lt = w >> 1, st0 = (w & 1) * 2;
#pragma unroll
        for (int s2 = 0; s2 < 2; ++s2) {
            const int st = st0 + s2;
            f32x4 c = (f32x4){0.f, 0.f, 0.f, 0.f};
            c = mma_lds<DK>(c, Qs + (lt * 16) * QS, QS, Ks + (st * 16) * QS, QS, fr, fq);
            const int l = lt * 16 + fr;
#pragma unroll
            for (int j = 0; j < 4; ++j) { const int sidx = st * 16 + fq * 4 + j; const bool keep = (DIR == 0) ? (sidx <= l) : (sidx >= l); c[j] = keep ? c[j] : 0.f; }
            *(u32x2*)&At[l * 72 + st * 16 + fq * 4] = pk4(c);
        }
    }
    __syncthreads();
    const int lt = w & 3, vt0 = (w >> 2) * 4;
    f32x4 o[4];
#pragma unroll
    for (int n = 0; n < 4; ++n) {
        const int vt = vt0 + n;
        f32x4 c = (f32x4){0.f, 0.f, 0.f, 0.f};
        c = mma_lds<64>(c, At + (lt * 16) * 72, 72, Vt + (vt * 16) * 72, 72, fr, fq);
        c = mma_lds<DK>(c, Qs + (lt * 16) * QS, QS, St + (vt * 16) * QS, QS, fr, fq);
        o[n] = c;
    }
#pragma unroll
    for (int kt = 0; kt < KT; ++kt) {
        f32x4 c = accS[kt];
        c = mma_lds<64>(c, Vt + (w * 16) * 72, 72, Kt + (kt * 16) * 72, 72, fr, fq);
        const f32x4 e4 = *(const f32x4*)&eend[kt * 16 + fq * 4];
        accS[kt] = c * e4;
    }
    const int l = lt * 16 + fr;
    const size_t row = (size_t)(row0 + l);
    bf16_t* cp = CAT + row * 1024 + h * 128 + vt0 * 16 + fq * 4;
    if (DIR == 1) {
#pragma unroll
        for (int n = 0; n < 4; ++n) *(u32x2*)(cp + n * 16) = pk4(o[n]);
    } else {
        float ss = 0.f;
#pragma unroll
        for (int n = 0; n < 4; ++n) {
            const u32x2 ob = *(const u32x2*)(cp + n * 16);
            o[n][0] += bf2f((bf16_t)(ob.x & 0xffff)); o[n][1] += bf2f((bf16_t)(ob.x >> 16));
            o[n][2] += bf2f((bf16_t)(ob.y & 0xffff)); o[n][3] += bf2f((bf16_t)(ob.y >> 16));
            ss += o[n][0] * o[n][0] + o[n][1] * o[n][1] + o[n][2] * o[n][2] + o[n][3] * o[n][3];
        }
        ss += __shfl_xor(ss, 16);
        ss += __shfl_xor(ss, 32);
        if (fq == 0) red[l * 2 + (w >> 2)] = ss;
        __syncthreads();
        const float tot = red[l * 2] + red[l * 2 + 1];
        const float rstd = rsqrtf(tot * (1.0f / 128.0f) + EPS);
        const bf16_t* gp = P + row * C::LDP + C::GOFF + h * 128 + vt0 * 16 + fq * 4;
#pragma unroll
        for (int n = 0; n < 4; ++n) {
            const u32x2 gb = *(const u32x2*)(gp + n * 16);
            const f32x4 gn = *(const f32x4*)(gnorm + vt0 * 16 + n * 16 + fq * 4);
            f32x4 gv;
            gv[0] = bf2f((bf16_t)(gb.x & 0xffff)); gv[1] = bf2f((bf16_t)(gb.x >> 16)); gv[2] = bf2f((bf16_t)(gb.y & 0xffff)); gv[3] = bf2f((bf16_t)(gb.y >> 16));
            f32x4 r4;
#pragma unroll
            for (int j = 0; j < 4; ++j) { const float g = GLA ? siluf_(gv[j]) : gv[j]; r4[j] = o[n][j] * rstd * gn[j] * g; }
            *(u32x2*)(cp + n * 16) = pk4(r4);
        }
    }
    __syncthreads();
}

template <int DK, bool GLA, int DIR>
DEVINL void rec_pass3_sweep(const Params& p, char* smem, const bf16_t* P, bf16_t* CAT, int b, int h, int c_lo, int nch, int slot, const float* slots, const float* gnorm) {
    using G = RecGeo<DK, GLA>;
    constexpr int KT = G::KT;
    const int t = threadIdx.x, w = t >> 6, lane = t & 63, fr = lane & 15, fq = lane >> 4;
    float a2col[16]; float abv = 0.f;
#pragma unroll
    for (int r = 0; r < 16; ++r) a2col[r] = 0.f;
    if (GLA) {
        const int k = t % DK;
#pragma unroll
        for (int r = 0; r < 16; ++r) a2col[r] = p.gla_a2[(DIR * 16 + r) * 256 + h * 64 + k];
        abv = p.gla_ab[DIR * 256 + h * 64 + k];
    }
    f32x4 accS[KT];
    if (slot >= 0) {
        const size_t chain = ((size_t)(b * G::H + h) * 2 + DIR);
        const float* sl = slots + (chain * G::NS + slot) * (size_t)(128 * DK);
#pragma unroll
        for (int kt = 0; kt < KT; ++kt) accS[kt] = *(const f32x4*)&sl[(w * 16 + fr) * DK + kt * 16 + fq * 4];
    } else {
#pragma unroll
        for (int kt = 0; kt < KT; ++kt) accS[kt] = (f32x4){0.f, 0.f, 0.f, 0.f};
    }
    for (int ci = 0; ci < nch; ++ci) {
        const int pc = (DIR == 0) ? (c_lo + ci) : (c_lo + nch - 1 - ci);
        rec_pass3_chunk<DK, GLA, DIR>(p, smem, P, CAT, b * RPB + pc * 64, h, accS, a2col, abv, gnorm);
    }
}

template <int DK, bool GLA>
DEVINL void rec_pass3_unit(const Params& p, char* smem, const bf16_t* P, bf16_t* CAT, int b, int h, int gi, const float* slots, const float* gnorm) {
    using G = RecGeo<DK, GLA>;
    int c_lo, nch, slot_f, slot_b;
    if (GLA) {
        if (gi == 0) { c_lo = 0; nch = 4; slot_f = -1; slot_b = -1; }
        else { const int pg = gi - 1; c_lo = 4 + pg * G::GC; nch = G::GC; slot_f = pg; slot_b = G::NS - 1 - pg; }
    } else { const int pg = gi; c_lo = 4 + pg * G::GC; nch = G::GC; slot_f = pg; slot_b = G::NS - 1 - pg; }
    rec_pass3_sweep<DK, GLA, 1>(p, smem, P, CAT, b, h, c_lo, nch, slot_b, slots, gnorm);
    rec_pass3_sweep<DK, GLA, 0>(p, smem, P, CAT, b, h, c_lo, nch, slot_f, slots, gnorm);
}

template <int DK, bool GLA>
DEVINL void rec_scan(float* slots, const float* decs, int bid, int nb) {
    using G = RecGeo<DK, GLA>;
    constexpr int NCHAIN = NBATCH * G::H * 2, PER = 128 * DK / 4;
    const int total = NCHAIN * PER;
    for (int i = bid * NTHR + threadIdx.x; i < total; i += nb * NTHR) {
        const int chain = i / PER, e = i - chain * PER;
        const int k4 = (e * 4) % DK;
        f32x4 run = (f32x4){0.f, 0.f, 0.f, 0.f};
        for (int s = 0; s < G::NS; ++s) {
            const f32x4 d4 = *(const f32x4*)&decs[((size_t)chain * G::NS + s) * DK + k4];
            float* sp = slots + ((size_t)chain * G::NS + s) * (size_t)(128 * DK) + (size_t)e * 4;
            const f32x4 a = *(const f32x4*)sp;
#pragma unroll
            for (int j = 0; j < 4; ++j) run[j] = __expf(d4[j]) * run[j] + a[j];
            *(f32x4*)sp = run;
        }
    }
}

DEVINL size_t s5_idx(int b, int di, int pc, int g, int pp) { return ((((size_t)(b * 2 + di) * NCH + pc) * 32 + g) * 64 + pp) * 2; }

DEVINL void s5_load_u_tile(const Params& p, bf16_t* Us, int row0) {
    const int t = threadIdx.x;
#pragma unroll
    for (int i = 0; i < 8; ++i) {
        const int idx = t + i * NTHR, l = idx >> 6, c8 = (idx & 63) * 8;
        *(u32x4*)&Us[l * 512 + c8] = *(const u32x4*)(p.P + (size_t)(row0 + l) * 2048 + 1536 + c8);
    }
}
DEVINL void s5_step(float& xr, float& xi, float are, float aim, const float (&bb)[32], const bf16_t* urow) {
    const u32x4 u0 = *(const u32x4*)urow, u1 = *(const u32x4*)(urow + 8);
    float uf[16];
    uf[0] = __uint_as_float(u0.x << 16); uf[1] = __uint_as_float(u0.x & 0xffff0000u); uf[2] = __uint_as_float(u0.y << 16); uf[3] = __uint_as_float(u0.y & 0xffff0000u);
    uf[4] = __uint_as_float(u0.z << 16); uf[5] = __uint_as_float(u0.z & 0xffff0000u); uf[6] = __uint_as_float(u0.w << 16); uf[7] = __uint_as_float(u0.w & 0xffff0000u);
    uf[8] = __uint_as_float(u1.x << 16); uf[9] = __uint_as_float(u1.x & 0xffff0000u); uf[10] = __uint_as_float(u1.y << 16); uf[11] = __uint_as_float(u1.y & 0xffff0000u);
    uf[12] = __uint_as_float(u1.z << 16); uf[13] = __uint_as_float(u1.z & 0xffff0000u); uf[14] = __uint_as_float(u1.w << 16); uf[15] = __uint_as_float(u1.w & 0xffff0000u);
    float br = 0.f, bi = 0.f;
#pragma unroll
    for (int h = 0; h < 16; ++h) { br += bb[2 * h] * uf[h]; bi += bb[2 * h + 1] * uf[h]; }
    const float nr = are * xr - aim * xi + br, ni = are * xi + aim * xr + bi;
    xr = nr; xi = ni;
}
DEVINL void s5_pass1_unit(const Params& p, char* smem, int b, int pc) {
    bf16_t* Us = (bf16_t*)smem;
    const int row0 = b * RPB + pc * 64;
    s5_load_u_tile(p, Us, row0);
    __syncthreads();
    const int t = threadIdx.x, w = t >> 6, lane = t & 63;
#pragma unroll 1
    for (int q = 0; q < 8; ++q) {
        const int task = w * 8 + q, g = task >> 1, di = task & 1;
        float bb[32];
        const float* bt = p.bbtab + ((size_t)((di * 32 + g) * 64 + lane)) * 32;
#pragma unroll
        for (int i = 0; i < 8; ++i) { const f32x4 v = *(const f32x4*)(bt + i * 4); bb[i * 4] = v[0]; bb[i * 4 + 1] = v[1]; bb[i * 4 + 2] = v[2]; bb[i * 4 + 3] = v[3]; }
        const float are = p.atab[((di * 32 + g) * 64 + lane) * 2], aim = p.atab[((di * 32 + g) * 64 + lane) * 2 + 1];
        float xr = 0.f, xi = 0.f;
#pragma unroll 4
        for (int tt = 0; tt < 64; ++tt) { const int tok = di ? (63 - tt) : tt; s5_step(xr, xi, are, aim, bb, Us + tok * 512 + g * 16); }
        float* o = p.s5xend + s5_idx(b, di, pc, g, lane);
        o[0] = xr; o[1] = xi;
    }
    __syncthreads();
}
DEVINL void s5_scan(const Params& p, int bid, int nb) {
    for (int i = bid * NTHR + threadIdx.x; i < NBATCH * 2 * 32 * 64; i += nb * NTHR) {
        const int pp = i & 63, g = (i >> 6) & 31, di = (i >> 11) & 1, b = i >> 12;
        const float ar = p.a64tab[((di * 32 + g) * 64 + pp) * 2], ai = p.a64tab[((di * 32 + g) * 64 + pp) * 2 + 1];
        float cr = 0.f, ci = 0.f;
        for (int ch = 0; ch < NCH; ++ch) {
            const int pc = di ? (ch < 4 ? 3 - ch : 71 - ch) : ch;
            const size_t ix = s5_idx(b, di, pc, g, pp);
            p.s5carry[ix] = cr; p.s5carry[ix + 1] = ci;
            const float er = p.s5xend[ix], ei = p.s5xend[ix + 1];
            const float nr = ar * cr - ai * ci + er, ni = ar * ci + ai * cr + ei;
            cr = nr; ci = ni;
        }
    }
}
DEVINL void s5_pass3_unit(const Params& p, char* smem, int b, int pc) {
    bf16_t* Us = (bf16_t*)smem;
    const int t = threadIdx.x, w = t >> 6, lane = t & 63, fr = lane & 15, fq = lane >> 4;
    bf16_t* Xs = (bf16_t*)(smem + 65536) + w * (16 * 136);
    const int row0 = b * RPB + pc * 64;
    s5_load_u_tile(p, Us, row0);
    __syncthreads();
#pragma unroll 1
    for (int q = 0; q < 4; ++q) {
        const int g = w * 4 + q;
        f32x4 acc[4];
#pragma unroll
        for (int sb = 0; sb < 4; ++sb) acc[sb] = (f32x4){0.f, 0.f, 0.f, 0.f};
#pragma unroll 1
        for (int dd = 0; dd < 2; ++dd) {
            const int di = 1 - dd;
            float bb[32];
            const float* bt = p.bbtab + ((size_t)((di * 32 + g) * 64 + lane)) * 32;
#pragma unroll
            for (int i = 0; i < 8; ++i) { const f32x4 v = *(const f32x4*)(bt + i * 4); bb[i * 4] = v[0]; bb[i * 4 + 1] = v[1]; bb[i * 4 + 2] = v[2]; bb[i * 4 + 3] = v[3]; }
            const float are = p.atab[((di * 32 + g) * 64 + lane) * 2], aim = p.atab[((di * 32 + g) * 64 + lane) * 2 + 1];
            const size_t cix = s5_idx(b, di, pc, g, lane);
            float xr = p.s5carry[cix], xi = p.s5carry[cix + 1];
            bf16x8 cb[4];
#pragma unroll
            for (int ks = 0; ks < 4; ++ks) cb[ks] = *(const bf16x8*)(p.cmt + ((size_t)(g * 16 + fr)) * 256 + di * 128 + ks * 32 + fq * 8);
#pragma unroll 1
            for (int sbi = 0; sbi < 4; ++sbi) {
                const int sb = di ? (3 - sbi) : sbi;
#pragma unroll 4
                for (int tt = 0; tt < 16; ++tt) {
                    const int tl = di ? (15 - tt) : tt;
                    s5_step(xr, xi, are, aim, bb, Us + (sb * 16 + tl) * 512 + g * 16);
                    Xs[tl * 136 + lane] = f2bf(xr); Xs[tl * 136 + 64 + lane] = f2bf(xi);
                }
                asm volatile("s_waitcnt lgkmcnt(0)" ::: "memory");
                f32x4 c = (f32x4){0.f, 0.f, 0.f, 0.f};
#pragma unroll
                for (int ks = 0; ks < 4; ++ks) {
                    const bf16x8 a = *(const bf16x8*)(Xs + fr * 136 + ks * 32 + fq * 8);
                    c = __builtin_amdgcn_mfma_f32_16x16x32_bf16(cb[ks], a, c, 0, 0, 0);
                }
                asm volatile("s_waitcnt lgkmcnt(0)" ::: "memory");
                if (sb == 0) acc[0] += c; else if (sb == 1) acc[1] += c; else if (sb == 2) acc[2] += c; else acc[3] += c;
            }
        }
        const f32x4 d4 = *(const f32x4*)(p.s5_d + g * 16 + fq * 4);
#pragma unroll
        for (int sb = 0; sb < 4; ++sb) {
            const int tok = sb * 16 + fr;
            const u32x2 ub = *(const u32x2*)(Us + tok * 512 + g * 16 + fq * 4);
            f32x4 uv; uv[0] = bf2f((bf16_t)(ub.x & 0xffff)); uv[1] = bf2f((bf16_t)(ub.x >> 16)); uv[2] = bf2f((bf16_t)(ub.y & 0xffff)); uv[3] = bf2f((bf16_t)(ub.y >> 16));
            f32x4 r4;
#pragma unroll
            for (int j = 0; j < 4; ++j) r4[j] = gelu_tanh(acc[sb][j] + d4[j] * uv[j]);
            *(u32x2*)(p.s5a + (size_t)(row0 + tok) * 512 + g * 16 + fq * 4) = pk4(r4);
        }
    }
    __syncthreads();
}
static_assert(65536 + 8 * 16 * 136 * 2 <= LDS_BYTES, "s5 lds");

template <int LAYER>
DEVINL void phase_rec1(const Params& p, char* smem, int bid, int nb) {
    if (LAYER == 0) {
        constexpr int NG = 8 * 4 * 2 * 16;
        constexpr int NS5 = NBATCH * NCH;
        for (int u = bid; u < NG + NS5; u += nb) {
            if (u < NG) {
                const int cg = u & 15, dir = (u >> 4) & 1, h = (u >> 5) & 3, b = u >> 7;
                if (dir == 0) rec_pass1_unit<64, true, 0>(p, smem, p.P, b, h, cg, p.gslots, p.gdecs);
                else rec_pass1_unit<64, true, 1>(p, smem, p.P, b, h, cg, p.gslots, p.gdecs);
            } else { const int v = u - NG; s5_pass1_unit(p, smem, v / NCH, v % NCH); }
        }
    } else {
        constexpr int NG = 8 * 8 * 2 * 8;
        for (int u = bid; u < NG; u += nb) {
            const int cg = u & 7, dir = (u >> 3) & 1, h = (u >> 4) & 7, b = u >> 7;
            if (dir == 0) rec_pass1_unit<128, false, 0>(p, smem, p.P, b, h, cg, p.hslots, p.hdecs);
            else rec_pass1_unit<128, false, 1>(p, smem, p.P, b, h, cg, p.hslots, p.hdecs);
        }
    }
}
template <int LAYER>
DEVINL void phase_scan(const Params& p, char* smem, int bid, int nb) {
    if (LAYER == 0) { rec_scan<64, true>(p.gslots, p.gdecs, bid, nb); s5_scan(p, bid, nb); }
    else rec_scan<128, false>(p.hslots, p.hdecs, bid, nb);
}
template <int LAYER>
DEVINL void phase_rec3(const Params& p, char* smem, int bid, int nb) {
    if (LAYER == 0) {
        constexpr int NG = 8 * 4 * 17;
        constexpr int NS5 = NBATCH * NCH;
        for (int u = bid; u < NG + NS5; u += nb) {
            if (u < NG) { const int gi = u % 17, h = (u / 17) & 3, b = u / 68; rec_pass3_unit<64, true>(p, smem, p.P, p.H, b, h, gi, p.gslots, p.gla_norm); }
            else { const int v = u - NG; s5_pass3_unit(p, smem, v / NCH, v % NCH); }
        }
    } else {
        constexpr int NG = 8 * 8 * 8;
        for (int u = bid; u < NG; u += nb) { const int gi = u & 7, h = (u >> 3) & 7, b = u >> 6; rec_pass3_unit<128, false>(p, smem, p.P, p.H, b, h, gi, p.hslots, p.hg_norm); }
    }
}

DEVINL void phase_final(const Params& p, int bid, int nb) {
    const int t = threadIdx.x, w = t >> 6, lane = t & 63;
    for (int rg = bid; rg < NLAT / 8; rg += nb) {
        float* res = p.out + (size_t)(rg * 8 + w) * D;
        f32x4 v[4];
        float ss = 0.f;
#pragma unroll
        for (int i = 0; i < 4; ++i) { v[i] = *(const f32x4*)(res + lane * 4 + i * 256); ss += v[i][0] * v[i][0] + v[i][1] * v[i][1] + v[i][2] * v[i][2] + v[i][3] * v[i][3]; }
#pragma unroll
        for (int o = 32; o >= 1; o >>= 1) ss += __shfl_xor(ss, o);
        const float rstd = rsqrtf(ss * (1.0f / 1024.0f) + EPS);
#pragma unroll
        for (int i = 0; i < 4; ++i) { const f32x4 g4 = *(const f32x4*)(p.final_norm + lane * 4 + i * 256); *(f32x4*)(res + lane * 4 + i * 256) = v[i] * rstd * g4; }
    }
}

constexpr int NPHASE = 23;
constexpr int MEGA_LDS = LDS_BYTES + 16 + 1024;
static_assert(sizeof(Params) <= 1024 && sizeof(Params) % 8 == 0, "params block");
template <int PH>
DEVINL void run_phase(const Params& p, char* smem, int bid, int nb) {
    if (PH == 0) phase_prologue(p, smem, bid, nb);
    if (PH == 1) phase_pre<0>(p, smem, bid, nb);
    if (PH == 2) phase_gemm<0>(p, smem, bid, nb);
    if (PH == 3) phase_rec1<0>(p, smem, bid, nb);
    if (PH == 4) phase_scan<0>(p, smem, bid, nb);
    if (PH == 5) phase_rec3<0>(p, smem, bid, nb);
    if (PH == 6) phase_gemm<1>(p, smem, bid, nb);
    if (PH == 7) phase_gemm<2>(p, smem, bid, nb);
    if (PH == 8) phase_pre<1>(p, smem, bid, nb);
    if (PH == 9) phase_list<0>(p, smem, bid, nb);
    if (PH == 10) phase_moe<0, 1>(p, smem, bid, nb);
    if (PH == 11) phase_moe<0, 2>(p, smem, bid, nb);
    if (PH == 12) phase_pre<2>(p, smem, bid, nb);
    if (PH == 13) phase_gemm<3>(p, smem, bid, nb);
    if (PH == 14) phase_rec1<1>(p, smem, bid, nb);
    if (PH == 15) phase_scan<1>(p, smem, bid, nb);
    if (PH == 16) phase_rec3<1>(p, smem, bid, nb);
    if (PH == 17) phase_gemm<4>(p, smem, bid, nb);
    if (PH == 18) phase_pre<3>(p, smem, bid, nb);
    if (PH == 19) phase_list<1>(p, smem, bid, nb);
    if (PH == 20) phase_moe<1, 1>(p, smem, bid, nb);
    if (PH == 21) phase_moe<1, 2>(p, smem, bid, nb);
    if (PH == 22) phase_final(p, bid, nb);
}

extern __shared__ __attribute__((aligned(16))) char dyn_smem[];

#if ONE_LAUNCH
template <int PH> struct PhaseSeq {
    static DEVINL void run(const Params& p, char* smem, const XcdBarrier& bar) {
        PhaseSeq<PH - 1>::run(p, smem, bar);
        xcd_barrier(bar);
        run_phase<PH>(p, smem, (int)blockIdx.x, (int)gridDim.x);
    }
};
template <> struct PhaseSeq<0> {
    static DEVINL void run(const Params& p, char* smem, const XcdBarrier& bar) { run_phase<0>(p, smem, (int)blockIdx.x, (int)gridDim.x); }
};
__global__ void __launch_bounds__(NTHR, 2) mega_kernel(Params pk) {
    volatile LAS unsigned* st = (volatile LAS unsigned*)(dyn_smem + LDS_BYTES);
    unsigned long long* lp = (unsigned long long*)(dyn_smem + LDS_BYTES + 16);
    const unsigned long long* ka = (const unsigned long long*)__builtin_amdgcn_kernarg_segment_ptr();
    if (threadIdx.x < sizeof(Params) / 8) lp[threadIdx.x] = ka[threadIdx.x];
    if (threadIdx.x == 0) { st[0] = 0u; st[1] = 0u; st[2] = 0u; st[3] = 0u; }
    __syncthreads();
    const Params& p = *(const Params*)lp;
    XcdBarrier bar = xcd_barrier_post(p.bar, st);
    PhaseSeq<NPHASE - 1>::run(p, dyn_smem, bar);
}
#else
template <int PH>
__global__ void __launch_bounds__(NTHR, 2) phase_kernel(Params p) {
    run_phase<PH>(p, dyn_smem, (int)blockIdx.x, (int)gridDim.x);
}
template <int PH> struct Launcher {
    static void go(const Params& p, int grid, hipStream_t s) {
        Launcher<PH - 1>::go(p, grid, s);
        static bool attr = false;
        if (!attr) { hipFuncSetAttribute((const void*)phase_kernel<PH>, hipFuncAttributeMaxDynamicSharedMemorySize, LDS_BYTES + 16); attr = true; }
        phase_kernel<PH><<<grid, NTHR, LDS_BYTES + 16, s>>>(p);
    }
};
template <> struct Launcher<-1> { static void go(const Params&, int, hipStream_t) {} };
#endif

static size_t align_up(size_t v, size_t a) { return (v + a - 1) / a * a; }

extern "C" void kernel_launch(void* const* d_in, const int* in_sizes, int n_in, void* d_out, int out_size, void* d_ws, size_t ws_size, hipStream_t stream) {
    (void)in_sizes; (void)n_in; (void)out_size;
    Params p;
    memset(&p, 0, sizeof(p));
    const float* const* in = (const float* const*)d_in;
    p.x = in[0]; p.c = in[1]; p.ctx = in[2]; p.c_ctx = in[3]; p.ada_w = in[4]; p.ada_b = in[5]; p.norm_mix = in[6]; p.norm_ffn = in[7];
    p.ab_w_in = in[8]; p.ab_w_out = in[9]; p.gla_a2 = in[10]; p.gla_ab = in[11]; p.gla_norm = in[12];
    p.s5_lam_re = in[13]; p.s5_lam_im = in[14]; p.s5_log_dt = in[15]; p.s5_b_re = in[16]; p.s5_b_im = in[17]; p.s5_c_re = in[18]; p.s5_c_im = in[19];
    p.s5_d = in[20]; p.glu_w = in[21]; p.glu_b = in[22]; p.hg_w_in = in[23]; p.hg_w_out = in[24]; p.hg_lb = in[25]; p.hg_norm = in[26];
    p.router_w = in[27]; p.router_bias = in[28]; p.moe_wg = in[29]; p.moe_wu = in[30]; p.moe_wd = in[31]; p.final_norm = in[32];
    p.out = (float*)d_out;

    char* ws = (char*)d_ws;
    size_t o = 0;
    auto take = [&](size_t bytes) { char* r = ws + o; o = align_up(o + bytes, 256); return r; };
    p.bar = (unsigned*)take(XCD_BAR_WORDS * 4);
    p.cnt = (int*)take(256 * 4);
    p.mod = (float*)take((size_t)2 * 9 * 6144 * 4);
    p.pos = (float*)take(64 * 512 * 4);
    p.lb = (float*)take(1024 * 4);
    p.atab = (float*)take(2 * 32 * 64 * 2 * 4);
    p.a64tab = (float*)take(2 * 32 * 64 * 2 * 4);
    p.bbtab = (float*)take((size_t)2 * 32 * 64 * 32 * 4);
    p.cmt = (bf16_t*)take((size_t)32 * 16 * 256 * 2);
    p.RT = (float4*)take((size_t)R * 16);
    p.list = (int*)take((size_t)ACT_ROWS * 4);
    p.wl = (float*)take((size_t)ACT_ROWS * 4);
    p.wh = (float*)take((size_t)ACT_ROWS * 4);
    p.cx = (float*)take((size_t)NBATCH * CTXL * D * 4);
    p.wt_in0 = (bf16_t*)take((size_t)2048 * 1024 * 2);
    p.wt_out0 = (bf16_t*)take((size_t)1024 * 1024 * 2);
    p.glu_t = (bf16_t*)take((size_t)512 * 512 * 2);
    p.wt_in1 = (bf16_t*)take((size_t)5120 * 1024 * 2);
    p.wt_out1 = (bf16_t*)take((size_t)1024 * 1024 * 2);
    p.H = (bf16_t*)take((size_t)R * 1024 * 2);
    const size_t big = o;
    p.P = (bf16_t*)(ws + big);
    size_t o0 = big + (size_t)R * 2048 * 2;
    auto take0 = [&](size_t bytes) { char* r = ws + o0; o0 = align_up(o0 + bytes, 256); return r; };
    p.gslots = (float*)take0((size_t)64 * 16 * 128 * 64 * 4);
    p.gdecs = (float*)take0((size_t)64 * 16 * 64 * 4);
    p.s5xend = (float*)take0((size_t)NBATCH * 2 * NCH * 32 * 64 * 2 * 4);
    p.s5carry = (float*)take0((size_t)NBATCH * 2 * NCH * 32 * 64 * 2 * 4);
    p.s5a = (bf16_t*)take0((size_t)R * 512 * 2);
    p.AF = (float*)take0((size_t)R * 32 * 4);
    p.wgu_t = (bf16_t*)take0((size_t)32 * 512 * 1024 * 2);
    p.wd_t = (bf16_t*)take0((size_t)32 * 1024 * 256 * 2);
    p.act = (bf16_t*)take0((size_t)ACT_ROWS * 512 * 2);
    size_t o1 = big + (size_t)R * 5120 * 2;
    auto take1 = [&](size_t bytes) { char* r = ws + o1; o1 = align_up(o1 + bytes, 256); return r; };
    p.hslots = (float*)take1((size_t)128 * 8 * 128 * 128 * 4);
    p.hdecs = (float*)take1((size_t)128 * 8 * 128 * 4);
    const size_t need = o0 > o1 ? o0 : o1;
    if (need > ws_size) fprintf(stderr, "workspace too small: need %zu have %zu\n", need, ws_size);

    const int grid = 256;
#if ONE_LAUNCH
    static bool attr = false;
    if (!attr) { hipFuncSetAttribute((const void*)mega_kernel, hipFuncAttributeMaxDynamicSharedMemorySize, MEGA_LDS); attr = true; }
    hipMemsetAsync(p.bar, 0, XCD_BAR_WORDS * 4, stream);
    mega_kernel<<<grid, NTHR, MEGA_LDS, stream>>>(p);
#else
    Launcher<NPHASE - 1>::go(p, grid, stream);
#endif
}
```

```cpp
#include <hip/hip_runtime.h>
#include <stdint.h>
#include <string.h>
#include <stdio.h>

#ifndef ONE_LAUNCH
#define ONE_LAUNCH 1
#endif

typedef unsigned short bf16_t;
typedef short bf16x8 __attribute__((ext_vector_type(8)));
typedef float f32x4 __attribute__((ext_vector_type(4)));
typedef unsigned u32x4 __attribute__((ext_vector_type(4)));
typedef unsigned u32x2 __attribute__((ext_vector_type(2)));
#define DEVINL __device__ __forceinline__

constexpr int D = 1024, NBATCH = 8, SEQ = 4096, CTXL = 256;
constexpr int RPB = SEQ + CTXL;
constexpr int R = NBATCH * RPB;
constexpr int NLAT = NBATCH * SEQ;
constexpr int NCH = RPB / 64;
constexpr float EPS = 1e-6f;
constexpr int NTHR = 512;
constexpr int LDS_BYTES = 136 * 1024;
constexpr int ACT_ROWS = 47104;

#define XB_TMO      128
#define XB_XCNT(j)  (256  + 64 * (j))
#define XB_XSUB(j)  (1280 + 64 * (j))
#define XB_XGEN(j)  (2304 + 64 * (j))
#define XB_TOP      3328
#define XB_TOPGEN   3392
#define XCD_BAR_WORDS 3456
#define XB_SPIN_CAP (1u << 18)
#define LAS __attribute__((address_space(3)))

__device__ __forceinline__ unsigned xb_ld(unsigned* p)              { return __hip_atomic_load(p, __ATOMIC_RELAXED, __HIP_MEMORY_SCOPE_AGENT); }
__device__ __forceinline__ unsigned xb_add(unsigned* p, unsigned v) { return __hip_atomic_fetch_add(p, v, __ATOMIC_RELAXED, __HIP_MEMORY_SCOPE_AGENT); }
__device__ __forceinline__ unsigned xb_xcc_id() { return (unsigned)__builtin_amdgcn_s_getreg((3 << 11) | 20) & 0xFu; }
#define XB_SPIN(cond, bar) do { unsigned _sp = 0; while (cond) { __builtin_amdgcn_s_sleep(1); \
    if ((++_sp & 255u) == 0u) { if (xb_ld(&(bar)[XB_TMO])) break; if (_sp > XB_SPIN_CAP) { atomicAdd(&(bar)[XB_TMO], 1u); break; } } } } while (0)

struct XcdBarrier {
    unsigned* bar; unsigned x;
    volatile LAS unsigned* st;
};
__device__ __forceinline__ XcdBarrier xcd_barrier_post(unsigned* bar, volatile LAS unsigned* st) {
    XcdBarrier b; b.bar = bar; b.x = xb_xcc_id(); b.st = st;
    if (threadIdx.x == 0) (void)xb_add(&bar[XB_XCNT(b.x)], 1u);
    return b;
}
__device__ __forceinline__ void xcd_barrier_complete(unsigned* bar, unsigned x, unsigned& nloc, unsigned& nx) {
    const unsigned G = gridDim.x * gridDim.y * gridDim.z;
    unsigned sum, cnt, mine, sp = 0u;
    for (;;) {
        sum = 0u; cnt = 0u; mine = 0u;
#pragma unroll
        for (unsigned j = 0; j < 16; ++j) { const unsigned c = xb_ld(&bar[XB_XCNT(j)]); sum += c; cnt += (c > 0u) ? 1u : 0u; mine = (j == x) ? c : mine; }
        if (sum == G) break;
        __builtin_amdgcn_s_sleep(1);
        if ((++sp & 255u) == 0u) { if (xb_ld(&bar[XB_TMO])) break; if (sp > XB_SPIN_CAP) { atomicAdd(&bar[XB_TMO], 1u); break; } }
    }
    nloc = mine > 0u ? mine : 1u; nx = cnt > 0u ? cnt : 1u;
}
__device__ __forceinline__ void xcd_barrier(const XcdBarrier& b) {
    asm volatile("s_waitcnt vmcnt(0)" ::: "memory");
    __syncthreads();
    if (threadIdx.x == 0) {
        unsigned* bar = b.bar;
        __builtin_amdgcn_s_waitcnt(0);
        unsigned nloc = b.st[0], nx = b.st[1];
        if (nloc == 0u) { xcd_barrier_complete(bar, b.x, nloc, nx); b.st[0] = nloc; b.st[1] = nx; }
        const unsigned old = xb_add(&bar[XB_XSUB(b.x)], 1u);
        const unsigned gen = old / nloc;
        if (old + 1u == (gen + 1u) * nloc) {
            __builtin_amdgcn_fence(__ATOMIC_RELEASE, "agent");
            asm volatile("s_waitcnt vmcnt(0)" ::: "memory");
            const unsigned og = xb_add(&bar[XB_TOP], 1u);
            const unsigned tg = og / nx;
            if (og + 1u == (tg + 1u) * nx) xb_add(&bar[XB_TOPGEN], 1u);
            else XB_SPIN(xb_ld(&bar[XB_TOPGEN]) == tg, bar);
            __builtin_amdgcn_fence(__ATOMIC_ACQUIRE, "agent");
            xb_add(&bar[XB_XGEN(b.x)], 1u);
            asm volatile("s_waitcnt vmcnt(0)" ::: "memory");
        } else {
            XB_SPIN(xb_ld(&bar[XB_XGEN(b.x)]) == gen, bar);
            __builtin_amdgcn_fence(__ATOMIC_ACQUIRE, "agent");
            asm volatile("s_waitcnt vmcnt(0)" ::: "memory");
        }
    }
    __syncthreads();
}

struct Params {
    const float *x, *c, *ctx, *c_ctx, *ada_w, *ada_b, *norm_mix, *norm_ffn, *ab_w_in, *ab_w_out, *gla_a2, *gla_ab, *gla_norm;
    const float *s5_lam_re, *s5_lam_im, *s5_log_dt, *s5_b_re, *s5_b_im, *s5_c_re, *s5_c_im, *s5_d, *glu_w, *glu_b;
    const float *hg_w_in, *hg_w_out, *hg_lb, *hg_norm, *router_w, *router_bias, *moe_wg, *moe_wu, *moe_wd, *final_norm;
    float* out;
    unsigned* bar;
    int* cnt;
    float *mod, *pos, *lb, *atab, *a64tab, *bbtab;
    bf16_t* cmt; bf16_t* bbm;
    float4* RT;
    int* list; float *wl, *wh;
    float* cx;
    bf16_t *wt_in0, *wt_out0, *glu_t, *wt_in1, *wt_out1;
    bf16_t* H;
    bf16_t* P;
    float *gslots, *gdecs;
    float *s5xend, *s5carry;
    bf16_t* s5a;
    bf16_t *wgu_t, *wd_t, *act, *hs;
    float* AF;
    float *hslots, *hdecs;
};

DEVINL int tid_opaque() { int t = threadIdx.x; asm volatile("" : "+v"(t)); return t; }
DEVINL int sgpr(int v) { return __builtin_amdgcn_readfirstlane(v); }
template <class T> DEVINL T* sgpr_ptr(T* ptr) {
    const unsigned long long v = (unsigned long long)ptr;
    const unsigned lo = (unsigned)__builtin_amdgcn_readfirstlane((int)(unsigned)v), hi = (unsigned)__builtin_amdgcn_readfirstlane((int)(unsigned)(v >> 32));
    return (T*)(((unsigned long long)hi << 32) | lo);
}
DEVINL unsigned cvt_pk_bf16(float lo, float hi) { unsigned r; asm volatile("v_cvt_pk_bf16_f32 %0, %1, %2" : "=v"(r) : "v"(lo), "v"(hi)); return r; }
DEVINL float bf2f(bf16_t v) { return __uint_as_float(((unsigned)v) << 16); }
DEVINL bf16_t f2bf(float f) { unsigned u = __float_as_uint(f); u += 0x7fffu + ((u >> 16) & 1u); return (bf16_t)(u >> 16); }
DEVINL unsigned pk2(float lo, float hi) { return cvt_pk_bf16(lo, hi); }
DEVINL u32x2 pk4(f32x4 v) { u32x2 r; r.x = pk2(v[0], v[1]); r.y = pk2(v[2], v[3]); return r; }
DEVINL float h2f(unsigned short v) { return (float)__builtin_bit_cast(_Float16, v); }
DEVINL unsigned short f2h(float f) { return __builtin_bit_cast(unsigned short, (_Float16)f); }
DEVINL float sigmoidf_(float x) { return 1.0f / (1.0f + __expf(-x)); }
DEVINL float siluf_(float x) { return x * sigmoidf_(x); }
DEVINL float logsigmoidf_(float x) { return fminf(x, 0.0f) - log1pf(__expf(-fabsf(x))); }
DEVINL float gelu_tanh(float y) { float z = 0.7978845608028654f * (y + 0.044715f * y * y * y); float th = 1.0f - 2.0f / (__expf(2.0f * z) + 1.0f); return 0.5f * y * (1.0f + th); }
DEVINL float* resid_row(const Params& p, int r) {
    const int b = r / RPB, j = r - b * RPB;
    return (j < CTXL) ? (p.cx + (size_t)(b * CTXL + j) * D) : (p.out + (size_t)(b * SEQ + (j - CTXL)) * D);
}
DEVINL int row_batch_mod(int r) { const int b = r / RPB, j = r - b * RPB; return (j < CTXL) ? 8 : b; }

template <int K>
DEVINL f32x4 mma_lds(f32x4 c, const bf16_t* A, int lda, const bf16_t* Bt, int ldb, int fr, int fq) {
#pragma unroll
    for (int k0 = 0; k0 < K; k0 += 32) {
        const bf16x8 a = *(const bf16x8*)(A + fr * lda + k0 + fq * 8);
        const bf16x8 b = *(const bf16x8*)(Bt + fr * ldb + k0 + fq * 8);
        c = __builtin_amdgcn_mfma_f32_16x16x32_bf16(b, a, c, 0, 0, 0);
    }
    return c;
}

DEVINL void cvt_tile64(const float* colp, int ld, int k0, int n0, bf16_t* dst, int ldd, char* smem, int lrow = -1) {
    float (*T)[65] = (float (*)[65])smem;
    const int t = tid_opaque(), nl = lrow >= 0 ? lrow : (t & 63), ks = t >> 6;
    const float* sp = colp + (size_t)(k0 + ks * 8) * ld;
#pragma unroll
    for (int i = 0; i < 8; ++i) T[nl][ks * 8 + i] = sp[(size_t)i * ld];
    __syncthreads();
    const int n2 = t >> 3, kc = t & 7;
    u32x4 v;
    v.x = pk2(T[n2][kc * 8 + 0], T[n2][kc * 8 + 1]); v.y = pk2(T[n2][kc * 8 + 2], T[n2][kc * 8 + 3]);
    v.z = pk2(T[n2][kc * 8 + 4], T[n2][kc * 8 + 5]); v.w = pk2(T[n2][kc * 8 + 6], T[n2][kc * 8 + 7]);
    *(u32x4*)(dst + (size_t)(n0 + n2) * ldd + k0 + kc * 8) = v;
    __syncthreads();
}

constexpr int NT_GU = 4096, NT_WD = 2048;
DEVINL void moe_cvt_task(const Params& p, int layer, int tid, char* smem) {
    if (tid < NT_GU) {
        const int e = tid >> 7, rem = tid & 127, nb = rem >> 4, kb = rem & 15;
        const float* wg = p.moe_wg + (size_t)(layer * 32 + e) * 1024 * 256;
        const float* wu = p.moe_wu + (size_t)(layer * 32 + e) * 1024 * 256;
        const int nl = tid_opaque() & 63, isup = nl >> 5, ul = nl & 31;
        const int ub = (nb >> 2) * 128 + (nb & 3) * 32;
        const float* cp = (isup ? wu : wg) + ub + ul;
        const int lrow = (ul >> 2) * 8 + isup * 4 + (ul & 3);
        cvt_tile64(cp, 256, kb * 64, nb * 64, p.wgu_t + (size_t)e * 512 * 1024, 1024, smem, lrow);
    } else {
        const int t2 = tid - NT_GU, e = t2 >> 6, rem = t2 & 63, nb = rem >> 2, kb = rem & 3;
        const float* wd = p.moe_wd + (size_t)(layer * 32 + e) * 256 * 1024;
        cvt_tile64(wd + nb * 64 + (tid_opaque() & 63), 1024, kb * 64, nb * 64, p.wd_t + (size_t)e * 1024 * 256, 256, smem);
    }
}

constexpr int NT_MOD = 192, NT_IN0 = 512, NT_OUT0 = 256, NT_GLU = 64, NT_IN1 = 1280, NT_OUT1 = 256, NT_POS = 64, NT_S5 = 64, NT_MISC = 1;
constexpr int T0_IN0 = NT_MOD, T0_OUT0 = T0_IN0 + NT_IN0, T0_GLU = T0_OUT0 + NT_OUT0, T0_IN1 = T0_GLU + NT_GLU, T0_OUT1 = T0_IN1 + NT_IN1,
              T0_MOE = T0_OUT1 + NT_OUT1, T0_POS = T0_MOE + NT_GU + NT_WD, T0_S5 = T0_POS + NT_POS, T0_MISC = T0_S5 + NT_S5, T0_END = T0_MISC + NT_MISC;

DEVINL void phase_prologue(const Params& p, char* smem, int bid, int nb) {
    const int t = tid_opaque();
    bool have_sc = false;
    for (int task = bid; task < T0_END; task += nb) {
        if (task < NT_MOD) {
            float* sc = (float*)smem;
            float* red = sc + 9 * 1024;
            if (!have_sc) {
                for (int i = t; i < 9 * 1024; i += NTHR) { const int rr = i >> 10, k = i & 1023; const float v = rr < 8 ? p.c[rr * 1024 + k] : p.c_ctx[k]; sc[i] = siluf_(v); }
                have_sc = true;
                __syncthreads();
            }
            const int l = task / 96, c0 = (task % 96) * 64, col = t & 63, kp = t >> 6;
            const float* wp = p.ada_w + ((size_t)l * 1024 + kp * 128) * 6144 + c0 + col;
            float acc[9];
#pragma unroll
            for (int rr = 0; rr < 9; ++rr) acc[rr] = 0.f;
            for (int k = 0; k < 128; ++k) {
                const float w = wp[(size_t)k * 6144];
#pragma unroll
                for (int rr = 0; rr < 9; ++rr) acc[rr] += sc[rr * 1024 + kp * 128 + k] * w;
            }
#pragma unroll
            for (int rr = 0; rr < 9; ++rr) red[(kp * 9 + rr) * 64 + col] = acc[rr];
            __syncthreads();
            for (int o = t; o < 576; o += NTHR) {
                const int rr = o >> 6, cc = o & 63;
                float s = p.ada_b[l * 6144 + c0 + cc];
#pragma unroll
                for (int q = 0; q < 8; ++q) s += red[(q * 9 + rr) * 64 + cc];
                p.mod[((size_t)l * 9 + rr) * 6144 + c0 + cc] = s;
            }
            __syncthreads();
        } else if (task < T0_OUT0) {
            const int tt = task - T0_IN0, nbk = tt >> 4, kb = tt & 15;
            const int n = nbk * 64 + (t & 63);
            const float* cp = p.ab_w_in + (n < 1536 ? n : n + 32);
            cvt_tile64(cp, 2080, kb * 64, nbk * 64, p.wt_in0, 1024, smem);
        } else if (task < T0_GLU) {
            const int tt = task - T0_OUT0, nbk = tt >> 4, kb = tt & 15;
            const float* cp = p.ab_w_out + nbk * 64 + (t & 63);
            cvt_tile64(cp, 1024, kb * 64, nbk * 64, p.wt_out0, 1024, smem);
        } else if (task < T0_IN1) {
            const int tt = task - T0_GLU, nbk = tt >> 3, kb = tt & 7;
            const float* cp = p.glu_w + nbk * 64 + (t & 63);
            cvt_tile64(cp, 512, kb * 64, nbk * 64, p.glu_t, 512, smem);
        } else if (task < T0_OUT1) {
            const int tt = task - T0_IN1, nbk = tt >> 4, kb = tt & 15;
            const float* cp = p.hg_w_in + nbk * 64 + (t & 63);
            cvt_tile64(cp, 5120, kb * 64, nbk * 64, p.wt_in1, 1024, smem);
        } else if (task < T0_MOE) {
            const int tt = task - T0_OUT1, nbk = tt >> 4, kb = tt & 15;
            const float* cp = p.hg_w_out + nbk * 64 + (t & 63);
            cvt_tile64(cp, 1024, kb * 64, nbk * 64, p.wt_out1, 1024, smem);
        } else if (task < T0_POS) {
            moe_cvt_task(p, 0, task - T0_MOE, smem);
        } else if (task < T0_S5) {
            const int pi = task - T0_POS;
            const int j = t, jj = j & 255;
            const float omega = __expf(-9.210340371976184f * (float)jj * (1.0f / 256.0f));
            const float ang = (float)pi * omega;
            p.pos[pi * 512 + j] = (j < 256) ? sinf(ang) : cosf(ang);
        } else if (task < T0_MISC) {
            const int tt = task - T0_S5, di = tt >> 5, g = tt & 31;
            const int pp = t & 63, hs = t >> 6;
            const float dt = __expf(p.s5_log_dt[di * 32 + g]);
            const float lr = p.s5_lam_re[(di * 32 + g) * 64 + pp], li = p.s5_lam_im[(di * 32 + g) * 64 + pp];
            const float mag = __expf(lr * dt);
            const float are = mag * cosf(li * dt), aim = mag * sinf(li * dt);
            const float den = lr * lr + li * li;
            const float fre = ((are - 1.0f) * lr + aim * li) / den;
            const float fim = (aim * lr - (are - 1.0f) * li) / den;
            if (hs == 0) {
                p.atab[((di * 32 + g) * 64 + pp) * 2 + 0] = are; p.atab[((di * 32 + g) * 64 + pp) * 2 + 1] = aim;
                float xr = are, xi = aim;
#pragma unroll
                for (int q = 0; q < 6; ++q) { const float nr = xr * xr - xi * xi, ni = 2.0f * xr * xi; xr = nr; xi = ni; }
                p.a64tab[((di * 32 + g) * 64 + pp) * 2 + 0] = xr; p.a64tab[((di * 32 + g) * 64 + pp) * 2 + 1] = xi;
            }
#pragma unroll
            for (int q = 0; q < 2; ++q) {
                const int h = hs * 2 + q;
                const float bre = p.s5_b_re[((size_t)((di * 32 + g) * 64 + pp)) * 16 + h], bim = p.s5_b_im[((size_t)((di * 32 + g) * 64 + pp)) * 16 + h];
                float* bt = p.bbtab + ((size_t)((di * 32 + g) * 64 + pp)) * 32;
                bt[h * 2 + 0] = fre * bre - fim * bim;
                bt[h * 2 + 1] = fre * bim + fim * bre;
                p.bbm[((size_t)((di * 32 + g) * 128 + pp)) * 16 + h] = f2bf(fre * bre - fim * bim);
                p.bbm[((size_t)((di * 32 + g) * 128 + 64 + pp)) * 16 + h] = f2bf(fre * bim + fim * bre);
                const float cre = p.s5_c_re[((size_t)((di * 32 + g) * 16 + h)) * 64 + pp], cim = p.s5_c_im[((size_t)((di * 32 + g) * 16 + h)) * 64 + pp];
                bf16_t* cm = p.cmt + ((size_t)(g * 16 + h)) * 256 + di * 128;
                cm[pp] = f2bf(cre); cm[64 + pp] = f2bf(-cim);
            }
        } else {
            for (int i = t; i < 1024; i += NTHR) p.lb[i] = sigmoidf_(p.hg_lb[1024 + i] - p.hg_lb[i]);
            if (t < 256) p.cnt[t] = 0;
        }
    }
}

template <int MODE>
DEVINL void phase_pre(const Params& p, char* smem, int bid, int nb) {
    constexpr bool GEMV = (MODE == 0 || MODE == 1 || MODE == 3);
    constexpr int L = (MODE >= 2) ? 1 : 0;
    constexpr bool FFN = (MODE == 1 || MODE == 3);
    float* hrow = (float*)smem;
    float* part = hrow + 8 * 1024;
    float* logit = part + 8 * 16 * 32;
    int* lcnt = (int*)(logit + 256);
    const int t = tid_opaque(), w = t >> 6, lane = t & 63;
    float wreg[64];
    if (GEMV) {
        const int e = t & 31, kg = t >> 5;
        const float* W = (MODE == 0) ? (p.ab_w_in + 1536) : p.router_w;
        const int ld = (MODE == 0) ? 2080 : 32;
#pragma unroll
        for (int i = 0; i < 64; ++i) wreg[i] = W[(size_t)(kg * 64 + i) * ld + e];
    }
    if (FFN) { if (t < 64) lcnt[t] = 0; }
    __syncthreads();
    const float* gain = (FFN ? p.norm_ffn : p.norm_mix) + L * 1024;
    const int ngroups = (MODE == 3) ? (NLAT / 8) : (R / 8);
    for (int rg = bid; rg < ngroups; rg += nb) {
        int r;
        if (MODE == 3) { const int i = rg * 8 + w; r = (i >> 12) * RPB + CTXL + (i & 4095); } else r = rg * 8 + w;
        const int b = r / RPB, j = r - b * RPB;
        const bool isctx = j < CTXL;
        const float* modv = p.mod + ((size_t)(L * 9 + (isctx ? 8 : b))) * 6144 + (FFN ? 3072 : 0);
        float* res = isctx ? (p.cx + (size_t)(b * CTXL + j) * D) : (p.out + (size_t)(b * SEQ + (j - CTXL)) * D);
        f32x4 v[4];
        if (MODE == 0) {
            const float* src = isctx ? (p.ctx + (size_t)(b * CTXL + j) * D) : (p.x + (size_t)(b * SEQ + (j - CTXL)) * D);
#pragma unroll
            for (int i = 0; i < 4; ++i) v[i] = *(const f32x4*)(src + lane * 4 + i * 256);
            if (!isctx) {
                const int n = j - CTXL, prow = n >> 6, pcol = n & 63;
#pragma unroll
                for (int i = 0; i < 4; ++i) {
                    const int c = lane * 4 + i * 256;
                    const f32x4 pe = (c < 512) ? *(const f32x4*)(p.pos + prow * 512 + c) : *(const f32x4*)(p.pos + pcol * 512 + (c - 512));
                    v[i] += pe;
                }
            }
#pragma unroll
            for (int i = 0; i < 4; ++i) *(f32x4*)(res + lane * 4 + i * 256) = v[i];
        } else {
#pragma unroll
            for (int i = 0; i < 4; ++i) v[i] = *(const f32x4*)(res + lane * 4 + i * 256);
        }
        float ss = 0.f;
#pragma unroll
        for (int i = 0; i < 4; ++i) ss += v[i][0] * v[i][0] + v[i][1] * v[i][1] + v[i][2] * v[i][2] + v[i][3] * v[i][3];
#pragma unroll
        for (int o = 32; o >= 1; o >>= 1) ss += __shfl_xor(ss, o);
        const float rstd = rsqrtf(ss * (1.0f / 1024.0f) + EPS);
#pragma unroll
        for (int i = 0; i < 4; ++i) {
            const int c = lane * 4 + i * 256;
            const f32x4 g4 = *(const f32x4*)(gain + c), sh4 = *(const f32x4*)(modv + c), sc4 = *(const f32x4*)(modv + 1024 + c);
            f32x4 hv;
#pragma unroll
            for (int q = 0; q < 4; ++q) hv[q] = v[i][q] * rstd * g4[q] * (1.0f + sc4[q]) + sh4[q];
            *(u32x2*)(p.H + (size_t)r * D + c) = pk4(hv);
            if (GEMV) *(f32x4*)(hrow + w * 1024 + c) = hv;
        }
        if (GEMV) {
            __syncthreads();
            const int e = t & 31, kg = t >> 5;
#pragma unroll 1
            for (int row = 0; row < 8; ++row) {
                float s = 0.f;
#pragma unroll
                for (int i = 0; i < 64; i += 4) {
                    const f32x4 hv = *(const f32x4*)(hrow + row * 1024 + kg * 64 + i);
                    s += wreg[i] * hv[0] + wreg[i + 1] * hv[1] + wreg[i + 2] * hv[2] + wreg[i + 3] * hv[3];
                }
                part[(row * 16 + kg) * 32 + e] = s;
            }
            __syncthreads();
            if (t < 256) {
                const int row = t >> 5, e2 = t & 31;
                float s = 0.f;
#pragma unroll
                for (int q = 0; q < 16; ++q) s += part[(row * 16 + q) * 32 + e2];
                if (MODE == 0) p.AF[(size_t)(rg * 8 + row) * 32 + e2] = s;
                else logit[row * 32 + e2] = s;
            }
            if (FFN) {
                __syncthreads();
                if (t < 8) {
                    int rr;
                    if (MODE == 3) { const int i = rg * 8 + t; rr = (i >> 12) * RPB + CTXL + (i & 4095); } else rr = rg * 8 + t;
                    float best = -3.0e38f; int bg = 0, bi1 = 0, bi2 = 1; float ba1 = 0.f, ba2 = 0.f;
#pragma unroll 1
                    for (int g = 0; g < 8; ++g) {
                        float m1 = -3.0e38f, m2 = -3.0e38f, a1 = 0.f, a2 = 0.f; int i1 = 0, i2 = 0;
#pragma unroll
                        for (int e = 0; e < 4; ++e) {
                            const float a = sigmoidf_(logit[t * 32 + g * 4 + e]);
                            const float s = a + p.router_bias[g * 4 + e];
                            if (s > m1) { m2 = m1; i2 = i1; a2 = a1; m1 = s; i1 = e; a1 = a; }
                            else if (s > m2) { m2 = s; i2 = e; a2 = a; }
                        }
                        const float gs = m1 + m2;
                        if (gs > best) { best = gs; bg = g; bi1 = i1; bi2 = i2; ba1 = a1; ba2 = a2; }
                    }
                    const float inv = 1.0f / (ba1 + ba2);
                    const float w1 = ba1 * inv, w2 = ba2 * inv;
                    const int lo = bi1 < bi2 ? bi1 : bi2, hi = bi1 < bi2 ? bi2 : bi1;
                    const float wlo = bi1 < bi2 ? w1 : w2, whi = bi1 < bi2 ? w2 : w1;
                    const int pair = (lo == 0) ? (hi - 1) : (lo == 1 ? (hi + 1) : 5);
                    const int bucket = bg * 6 + pair;
                    float4 rec; rec.x = __int_as_float(bucket); rec.y = wlo; rec.z = whi; rec.w = 0.f;
                    p.RT[rr] = rec;
                    atomicAdd(&lcnt[bucket], 1);
                }
            }
            __syncthreads();
        }
    }
    if (FFN) {
        __syncthreads();
        if (t < 48 && lcnt[t] != 0) atomicAdd(&p.cnt[L * 64 + t], lcnt[t]);
    }
    if (MODE == 3) {
        for (int task = bid; task < NT_GU + NT_WD; task += nb) moe_cvt_task(p, 1, task, smem);
    }
}

struct GemmSmem { bf16_t A[2][128][72]; bf16_t B[2][256][72]; };
static_assert(sizeof(GemmSmem) <= LDS_BYTES, "gemm lds");

template <class Epi>
DEVINL void gemm_tile(const bf16_t* __restrict__ A, int lda, const int* __restrict__ rowlist, int m0, int mvalid,
                      const bf16_t* __restrict__ Bt0, const bf16_t* __restrict__ Bt1, int ldb, int kseg, int K, Epi& epi, char* smem) {
    GemmSmem& S = *(GemmSmem*)smem;
    const int t = tid_opaque(), w = t >> 6, lane = t & 63, fr = lane & 15, fq = lane >> 4, wr = w >> 2, wc = w & 3;
    const int ch = t & 7, rr = t >> 3;
    const bf16_t* ap[2];
#pragma unroll
    for (int i = 0; i < 2; ++i) {
        const int ri = rr + i * 64, gi = ri < mvalid ? ri : 0;
        const int grow = rowlist ? rowlist[m0 + gi] : (m0 + gi);
        ap[i] = A + (size_t)grow * lda + ch * 8;
    }
    u32x4 ra[2], rb[4];
    f32x4 acc[4][4];
#pragma unroll
    for (int m = 0; m < 4; ++m)
#pragma unroll
        for (int n = 0; n < 4; ++n) acc[m][n] = (f32x4){0.f, 0.f, 0.f, 0.f};
    const int nk = K >> 6;
#define GT_GLOAD(kt) do { const int _k0 = (kt) * 64; \
        _Pragma("unroll") for (int i = 0; i < 2; ++i) ra[i] = *(const u32x4*)(ap[i] + _k0); \
        const bf16_t* _bb = (_k0 < kseg) ? (Bt0 + _k0) : (Bt1 + (_k0 - kseg)); \
        _Pragma("unroll") for (int i = 0; i < 4; ++i) rb[i] = *(const u32x4*)(_bb + (size_t)(rr + i * 64) * ldb + ch * 8); } while (0)
#define GT_SSTORE(buf) do { \
        _Pragma("unroll") for (int i = 0; i < 2; ++i) *(u32x4*)&S.A[buf][rr + i * 64][ch * 8] = ra[i]; \
        _Pragma("unroll") for (int i = 0; i < 4; ++i) *(u32x4*)&S.B[buf][rr + i * 64][ch * 8] = rb[i]; } while (0)
    GT_GLOAD(0);
    GT_SSTORE(0);
    __syncthreads();
    for (int kt = 0; kt < nk; ++kt) {
        const int cur = kt & 1;
        if (kt + 1 < nk) GT_GLOAD(kt + 1);
#pragma unroll
        for (int kk = 0; kk < 2; ++kk) {
            bf16x8 a[4], b[4];
#pragma unroll
            for (int m = 0; m < 4; ++m) a[m] = *(const bf16x8*)&S.A[cur][wr * 64 + m * 16 + fr][kk * 32 + fq * 8];
#pragma unroll
            for (int n = 0; n < 4; ++n) b[n] = *(const bf16x8*)&S.B[cur][wc * 64 + n * 16 + fr][kk * 32 + fq * 8];
#pragma unroll
            for (int m = 0; m < 4; ++m)
#pragma unroll
                for (int n = 0; n < 4; ++n) acc[m][n] = __builtin_amdgcn_mfma_f32_16x16x32_bf16(b[n], a[m], acc[m][n], 0, 0, 0);
        }
        if (kt + 1 < nk) GT_SSTORE(cur ^ 1);
        __syncthreads();
    }
#undef GT_GLOAD
#undef GT_SSTORE
    epi(acc, wr * 64, wc * 64, fr, fq);
}

struct EpiP0 {
    bf16_t* P; int m0, n0;
    DEVINL void operator()(const f32x4 (&acc)[4][4], int mb, int nbs, int fr, int fq) const {
        const float sc = (n0 < 256) ? 0.125f : 1.0f;
#pragma unroll
        for (int m = 0; m < 4; ++m) {
            bf16_t* rp = P + (size_t)(m0 + mb + m * 16 + fr) * 2048 + n0 + nbs + fq * 4;
#pragma unroll
            for (int n = 0; n < 4; ++n) *(u32x2*)(rp + n * 16) = pk4(acc[m][n] * sc);
        }
    }
};
struct EpiP1 {
    bf16_t* P; const float* lb; int m0, n0;
    DEVINL void operator()(const f32x4 (&acc)[4][4], int mb, int nbs, int fr, int fq) const {
        const int cb = n0 >> 10;
#pragma unroll
        for (int m = 0; m < 4; ++m) {
            bf16_t* rp = P + (size_t)(m0 + mb + m * 16 + fr) * 5120 + n0 + nbs + fq * 4;
#pragma unroll
            for (int n = 0; n < 4; ++n) {
                const f32x4 a = acc[m][n];
                u32x2 o;
                if (cb == 1 || cb == 2) {
                    const int cc = ((n0 + nbs + n * 16 + fq * 4) & 1023);
                    const f32x4 l4 = *(const f32x4*)(lb + cc);
                    unsigned short hv[4];
#pragma unroll
                    for (int j = 0; j < 4; ++j) hv[j] = f2h((1.0f - l4[j]) * sigmoidf_(-a[j]));
                    o.x = (unsigned)hv[0] | ((unsigned)hv[1] << 16); o.y = (unsigned)hv[2] | ((unsigned)hv[3] << 16);
                } else if (cb == 0 || cb == 4) {
                    f32x4 s;
#pragma unroll
                    for (int j = 0; j < 4; ++j) s[j] = siluf_(a[j]);
                    o = pk4(s);
                } else o = pk4(a);
                *(u32x2*)(rp + n * 16) = o;
            }
        }
    }
};
struct EpiGlu {
    bf16_t* CAT; const bf16_t* s5a; const float* gb; int m0, n0;
    DEVINL void operator()(const f32x4 (&acc)[4][4], int mb, int nbs, int fr, int fq) const {
#pragma unroll
        for (int m = 0; m < 4; ++m) {
            const size_t row = (size_t)(m0 + mb + m * 16 + fr);
#pragma unroll
            for (int n = 0; n < 4; ++n) {
                const int col = n0 + nbs + n * 16 + fq * 4;
                const u32x2 av = *(const u32x2*)(s5a + row * 512 + col);
                const f32x4 b4 = *(const f32x4*)(gb + col);
                f32x4 o;
                o[0] = bf2f((bf16_t)(av.x & 0xffff)) * sigmoidf_(acc[m][n][0] + b4[0]);
                o[1] = bf2f((bf16_t)(av.x >> 16)) * sigmoidf_(acc[m][n][1] + b4[1]);
                o[2] = bf2f((bf16_t)(av.y & 0xffff)) * sigmoidf_(acc[m][n][2] + b4[2]);
                o[3] = bf2f((bf16_t)(av.y >> 16)) * sigmoidf_(acc[m][n][3] + b4[3]);
                *(u32x2*)(CAT + row * 1024 + 512 + col) = pk4(o);
            }
        }
    }
};
struct EpiOut {
    const Params* p; const float* gate; int m0, n0;
    DEVINL void operator()(const f32x4 (&acc)[4][4], int mb, int nbs, int fr, int fq) const {
#pragma unroll
        for (int m = 0; m < 4; ++m) {
            const int r = m0 + mb + m * 16 + fr;
            float* rp = resid_row(*p, r);
            const float* gp = gate + (size_t)row_batch_mod(r) * 6144;
#pragma unroll
            for (int n = 0; n < 4; ++n) {
                const int col = n0 + nbs + n * 16 + fq * 4;
                const f32x4 g4 = *(const f32x4*)(gp + col);
                f32x4 x4 = *(f32x4*)(rp + col);
                x4 += g4 * acc[m][n];
                *(f32x4*)(rp + col) = x4;
            }
        }
    }
};
struct EpiMoe1 {
    bf16_t* act; const float* wsel; int m0, mvalid, colbase;
    DEVINL void operator()(const f32x4 (&acc)[4][4], int mb, int nbs, int fr, int fq) const {
#pragma unroll
        for (int m = 0; m < 4; ++m) {
            const int lr = mb + m * 16 + fr;
            if (lr < mvalid) {
                const int slot = m0 + lr;
                const float wv = wsel[slot];
#pragma unroll
                for (int nn = 0; nn < 2; ++nn) {
                    f32x4 o;
#pragma unroll
                    for (int j = 0; j < 4; ++j) o[j] = wv * siluf_(acc[m][2 * nn][j]) * acc[m][2 * nn + 1][j];
                    *(u32x2*)(act + (size_t)slot * 512 + colbase + (nbs >> 1) + nn * 16 + fq * 4) = pk4(o);
                }
            }
        }
    }
};
struct EpiMoe2 {
    const Params* p; const float* gate; const int* list; int m0, mvalid, n0;
    DEVINL void operator()(const f32x4 (&acc)[4][4], int mb, int nbs, int fr, int fq) const {
#pragma unroll
        for (int m = 0; m < 4; ++m) {
            const int lr = mb + m * 16 + fr;
            if (lr < mvalid) {
                const int r = list[m0 + lr];
                float* rp = resid_row(*p, r);
                const float* gp = gate + (size_t)row_batch_mod(r) * 6144;
#pragma unroll
                for (int n = 0; n < 4; ++n) {
                    const int col = n0 + nbs + n * 16 + fq * 4;
                    const f32x4 g4 = *(const f32x4*)(gp + col);
                    f32x4 x4 = *(f32x4*)(rp + col);
                    x4 += g4 * acc[m][n];
                    *(f32x4*)(rp + col) = x4;
                }
            }
        }
    }
};

namespace pg8 {
#define PG8_LAS __attribute__((address_space(3)))
constexpr int BM = 256, BK = 64, HALF = 128, HTB = HALF * BK * 2, STAGE_BYTES = 8 * HTB, NXCD = 8, WGM = 8;
DEVINL int lds_byte(int r, int c) { const int st = (r >> 4) * 2 + (c >> 5), rr = r & 15, cc = c & 31, ob = rr * 64 + cc * 2; return st * 1024 + (ob ^ (((ob >> 9) & 1) << 5)); }
DEVINL void stage_rc(int b, int& R_, int& C_) { const int st = b / 1024, sb = b % 1024, swz = sb ^ (((sb >> 9) & 1) << 5); R_ = (st >> 1) * 16 + swz / 64; C_ = (st & 1) * 32 + (swz % 64) / 2; }
DEVINL int perm32(int rho) { const int n = rho >> 4, i = rho & 15; return 8 * (i >> 2) + 4 * n + (i & 3); }
struct Unit { int pm, pn; const char* A; const char* B0; const char* B1; int mvalid, aux; };

template <class Epi, class Sched>
DEVINL void gemm_phase(PG8_LAS unsigned char* lds, const Sched& S, const Epi& E) {
    const int tid = tid_opaque(), wid = __builtin_amdgcn_readfirstlane(tid >> 6), lane = tid & 63, wr = wid >> 2, wc = wid & 3, fr = lane & 15, fq = lane >> 4;
    const int K = S.K, nt = K / BK, ldb = S.ldb, ksplit = S.ksplit;
    unsigned voffA[2], voffB[2];
#pragma unroll
    for (int i = 0; i < 2; ++i) { int R_, C_; stage_rc(tid * 16 + i * 8192, R_, C_); const int Rb = Epi::PERM ? ((R_ & ~31) + perm32(R_ & 31)) : R_;
        voffA[i] = (unsigned)(R_ * K + C_) * 2u; voffB[i] = (unsigned)(Rb * ldb + C_) * 2u; }
    const size_t kstep = (size_t)(BK * 2);
    const size_t hstepA = (size_t)HALF * K * 2, hstepB = (size_t)HALF * ldb * 2;
    const unsigned ldsw = (unsigned)wid * 1024u;
    const int aoff = lds_byte(wr * 64 + fr, fq * 8), boff = lds_byte(wc * 32 + fr, fq * 8);
#define PG8_SA(b, h) (((b) * 2 + (h)) * HTB)
#define PG8_SB(b, h) ((4 + (b) * 2 + (h)) * HTB)
#define PG8_STAGE(bufoff, gbase, voff) do { _Pragma("unroll") for (int _i = 0; _i < 2; ++_i) \
        __builtin_amdgcn_global_load_lds((const unsigned*)((const char*)(gbase) + (voff)[_i]), (PG8_LAS unsigned*)(lds + (bufoff) + ldsw + _i * 8192), 16, 0, 0); } while (0)
#define PG8_LDA(dst, b, h) do { _Pragma("unroll") for (int m = 0; m < 4; ++m) _Pragma("unroll") for (int k = 0; k < 2; ++k) dst[m][k] = *(const PG8_LAS bf16x8*)(lds + PG8_SA(b, h) + aoff + m * 2048 + k * 1024); } while (0)
#define PG8_LDB(dst, b, h) do { _Pragma("unroll") for (int n = 0; n < 2; ++n) _Pragma("unroll") for (int k = 0; k < 2; ++k) dst[n][k] = *(const PG8_LAS bf16x8*)(lds + PG8_SB(b, h) + boff + n * 2048 + k * 1024); } while (0)
#define PG8_MMA(ai, bj, At, Bt) do { __builtin_amdgcn_s_setprio(1); _Pragma("unroll") for (int m = 0; m < 4; ++m) _Pragma("unroll") for (int n = 0; n < 2; ++n) _Pragma("unroll") for (int k = 0; k < 2; ++k) \
        acc[ai][bj][m][n] = __builtin_amdgcn_mfma_f32_16x16x32_bf16(Bt[n][k], At[m][k], acc[ai][bj][m][n], 0, 0, 0); __builtin_amdgcn_s_setprio(0); } while (0)
#define PG8_WAIT_V(n) asm volatile("s_waitcnt vmcnt(" #n ")" ::: "memory")
#define PG8_WAIT_L(n) asm volatile("s_waitcnt lgkmcnt(" #n ")" ::: "memory")
#define PG8_BAR __builtin_amdgcn_s_barrier()
#define PG8_SCHED __builtin_amdgcn_sched_barrier(0)
#define PG8_BPTR(u, kt) (((kt) < ksplit ? (u).B0 : (u).B1) + (size_t)(kt) * kstep)
    Unit cur, nxt; int ui = 0;
    if (!S.next(0, cur)) return;
    f32x4 acc[2][2][4][2];
#pragma unroll
    for (int a = 0; a < 2; ++a)
#pragma unroll
        for (int b = 0; b < 2; ++b)
#pragma unroll
            for (int m = 0; m < 4; ++m)
#pragma unroll
                for (int n = 0; n < 2; ++n) acc[a][b][m][n] = (f32x4){0.f, 0.f, 0.f, 0.f};
    bf16x8 At[4][2], B0[2][2], B1[2][2];
    const char* cA = cur.A;
    { const char* cB0 = PG8_BPTR(cur, 0); const char* cB1 = PG8_BPTR(cur, 1);
      PG8_STAGE(PG8_SB(0, 0), cB0, voffB); PG8_STAGE(PG8_SA(0, 0), cA, voffA); PG8_STAGE(PG8_SB(0, 1), cB0 + hstepB, voffB); PG8_STAGE(PG8_SA(0, 1), cA + hstepA, voffA);
      if (wr == 1) PG8_BAR;
      PG8_WAIT_V(4); PG8_BAR;
      PG8_STAGE(PG8_SB(1, 0), cB1, voffB); PG8_STAGE(PG8_SA(1, 0), cA + kstep, voffA); PG8_STAGE(PG8_SB(1, 1), cB1 + hstepB, voffB);
      PG8_WAIT_V(6); PG8_BAR; }
    for (;;) {
        const bool has_next = S.next(ui + 1, nxt);
        if (!has_next) nxt = cur;
        const char* nA = nxt.A;
        for (int t = 0; t < nt; t += 2) {
            const bool last = (t == nt - 2);
            const char* a1 = cA + (size_t)(t + 1) * kstep;
            const char* a2 = last ? nA : cA + (size_t)(t + 2) * kstep;
            const char* b2 = last ? PG8_BPTR(nxt, 0) : PG8_BPTR(cur, t + 2);
            const char* a3 = a2 + kstep;
            const char* b3 = last ? PG8_BPTR(nxt, 1) : PG8_BPTR(cur, t + 3);
            PG8_LDB(B0, 0, 0); PG8_SCHED; PG8_LDA(At, 0, 0); PG8_STAGE(PG8_SA(1, 1), a1 + hstepA, voffA);
            PG8_WAIT_L(8); PG8_BAR; PG8_WAIT_L(0); PG8_MMA(0, 0, At, B0); PG8_BAR; PG8_SCHED;
            PG8_LDB(B1, 0, 1); PG8_STAGE(PG8_SB(0, 0), b2, voffB);
            PG8_BAR; PG8_WAIT_L(0); PG8_MMA(0, 1, At, B1); PG8_BAR;
            PG8_LDA(At, 0, 1); PG8_STAGE(PG8_SA(0, 0), a2, voffA);
            PG8_BAR; PG8_WAIT_L(0); PG8_MMA(1, 0, At, B0); PG8_BAR; PG8_SCHED;
            PG8_STAGE(PG8_SB(0, 1), b2 + hstepB, voffB);
            PG8_WAIT_V(6); PG8_BAR; PG8_MMA(1, 1, At, B1); PG8_BAR;
            PG8_LDB(B0, 1, 0); PG8_SCHED; PG8_LDA(At, 1, 0); PG8_STAGE(PG8_SA(0, 1), a2 + hstepA, voffA);
            PG8_WAIT_L(8); PG8_BAR; PG8_WAIT_L(0); PG8_MMA(0, 0, At, B0); PG8_BAR; PG8_SCHED;
            PG8_LDB(B1, 1, 1); PG8_STAGE(PG8_SB(1, 0), b3, voffB);
            PG8_BAR; PG8_WAIT_L(0); PG8_MMA(0, 1, At, B1); PG8_BAR;
            PG8_LDA(At, 1, 1); PG8_STAGE(PG8_SA(1, 0), a3, voffA);
            PG8_BAR; PG8_WAIT_L(0); PG8_MMA(1, 0, At, B0); PG8_BAR; PG8_SCHED;
            PG8_STAGE(PG8_SB(1, 1), b3 + hstepB, voffB);
            PG8_WAIT_V(6); PG8_BAR; PG8_MMA(1, 1, At, B1); PG8_BAR;
        }
        E(acc, cur, wr, wc, fr, fq);
        if (!has_next) break;
#pragma unroll
        for (int a = 0; a < 2; ++a)
#pragma unroll
            for (int b = 0; b < 2; ++b)
#pragma unroll
                for (int m = 0; m < 4; ++m)
#pragma unroll
                    for (int n = 0; n < 2; ++n) acc[a][b][m][n] = (f32x4){0.f, 0.f, 0.f, 0.f};
        cur = nxt; cA = nA; ++ui;
    }
    PG8_WAIT_V(0);
    if (wr == 0) PG8_BAR;
    PG8_BAR;
#undef PG8_SA
#undef PG8_SB
#undef PG8_STAGE
#undef PG8_LDA
#undef PG8_LDB
#undef PG8_MMA
#undef PG8_WAIT_V
#undef PG8_WAIT_L
#undef PG8_BAR
#undef PG8_SCHED
#undef PG8_BPTR
}

struct DenseSched {
    const char* A; const char* Bt; int K, ldb, ksplit, nM, nN, G, c, lat;
    DEVINL void init(const bf16_t* A_, const bf16_t* Bt_, int N, int K_, int G_, int c_, int lat_) {
        A = (const char*)A_; Bt = (const char*)Bt_; K = K_; ldb = K_; ksplit = K_ / BK; nM = lat_ ? 128 : 136; nN = N / BM; G = G_; c = c_; lat = lat_; }
    DEVINL bool next(int i, Unit& u) const {
        const int nwg = nM * nN;
        const long Lq = (long)i * G + c; if (Lq >= nwg) return false;
        int wgid = (int)Lq; { const int q = nwg / NXCD, r = nwg % NXCD, xcd = wgid % NXCD, off = wgid / NXCD; wgid = (xcd < r ? xcd * (q + 1) : r * (q + 1) + (xcd - r) * q) + off; }
        const int nig = WGM * nN, gid = wgid / nig, fm = gid * WGM, gsz = (nM - fm) < WGM ? (nM - fm) : WGM;
        int pm = fm + ((wgid % nig) % gsz); const int pn = (wgid % nig) / gsz;
        if (lat) pm = (pm >> 4) * 17 + 1 + (pm & 15);
        u.pm = pm; u.pn = pn; u.A = A + (size_t)pm * BM * K * 2; u.B0 = Bt + (size_t)pn * BM * K * 2; u.B1 = u.B0; u.mvalid = 256; u.aux = 0;
        return true;
    }
};
}

struct GEpiP0 {
    static constexpr bool PERM = true;
    bf16_t* P;
    DEVINL void operator()(const f32x4 (&acc)[2][2][4][2], const pg8::Unit& u, int wr, int wc, int fr, int fq) const {
        const float sc = (u.pn == 0) ? 0.125f : 1.0f;
        const int row0 = u.pm * 256 + wr * 64 + fr, col0 = u.pn * 256 + wc * 32 + 8 * fq;
#pragma unroll
        for (int ai = 0; ai < 2; ++ai)
#pragma unroll
            for (int m = 0; m < 4; ++m) {
                bf16_t* rp = P + (size_t)(row0 + ai * 128 + m * 16) * 2048 + col0;
#pragma unroll
                for (int bj = 0; bj < 2; ++bj) {
                    const u32x2 a = pk4(acc[ai][bj][m][0] * sc), b = pk4(acc[ai][bj][m][1] * sc);
                    u32x4 w; w.x = a.x; w.y = a.y; w.z = b.x; w.w = b.y;
                    *(u32x4*)(rp + bj * 128) = w;
                }
            }
    }
};
struct GEpiP1 {
    static constexpr bool PERM = true;
    bf16_t* P; const float* lb;
    DEVINL void operator()(const f32x4 (&acc)[2][2][4][2], const pg8::Unit& u, int wr, int wc, int fr, int fq) const {
        const int cb = u.pn >> 2;
        const int row0 = u.pm * 256 + wr * 64 + fr, col0 = u.pn * 256 + wc * 32 + 8 * fq;
#pragma unroll
        for (int ai = 0; ai < 2; ++ai)
#pragma unroll
            for (int m = 0; m < 4; ++m) {
                bf16_t* rp = P + (size_t)(row0 + ai * 128 + m * 16) * 5120 + col0;
#pragma unroll
                for (int bj = 0; bj < 2; ++bj) {
                    u32x4 w;
                    if (cb == 1 || cb == 2) {
                        const int cc = (col0 + bj * 128) & 1023;
                        unsigned short hv[8];
#pragma unroll
                        for (int n = 0; n < 2; ++n) {
                            const f32x4 l4 = *(const f32x4*)(lb + cc + 4 * n);
#pragma unroll
                            for (int j = 0; j < 4; ++j) hv[n * 4 + j] = f2h((1.0f - l4[j]) * sigmoidf_(-acc[ai][bj][m][n][j]));
                        }
                        w.x = (unsigned)hv[0] | ((unsigned)hv[1] << 16); w.y = (unsigned)hv[2] | ((unsigned)hv[3] << 16);
                        w.z = (unsigned)hv[4] | ((unsigned)hv[5] << 16); w.w = (unsigned)hv[6] | ((unsigned)hv[7] << 16);
                    } else {
                        f32x4 v0 = acc[ai][bj][m][0], v1 = acc[ai][bj][m][1];
                        if (cb == 0 || cb == 4) {
#pragma unroll
                            for (int j = 0; j < 4; ++j) { v0[j] = siluf_(v0[j]); v1[j] = siluf_(v1[j]); }
                        }
                        const u32x2 a = pk4(v0), b = pk4(v1);
                        w.x = a.x; w.y = a.y; w.z = b.x; w.w = b.y;
                    }
                    *(u32x4*)(rp + bj * 128) = w;
                }
            }
    }
};
struct GEpiGlu {
    static constexpr bool PERM = true;
    bf16_t* CAT; const bf16_t* s5a; const float* gb;
    DEVINL void operator()(const f32x4 (&acc)[2][2][4][2], const pg8::Unit& u, int wr, int wc, int fr, int fq) const {
        const int row0 = u.pm * 256 + wr * 64 + fr, col0 = u.pn * 256 + wc * 32 + 8 * fq;
#pragma unroll
        for (int ai = 0; ai < 2; ++ai)
#pragma unroll
            for (int m = 0; m < 4; ++m) {
                const size_t row = (size_t)(row0 + ai * 128 + m * 16);
#pragma unroll
                for (int bj = 0; bj < 2; ++bj) {
                    const int col = col0 + bj * 128;
                    const u32x4 av = *(const u32x4*)(s5a + row * 512 + col);
                    const f32x4 b0 = *(const f32x4*)(gb + col), b1 = *(const f32x4*)(gb + col + 4);
                    f32x4 o0, o1;
                    o0[0] = bf2f((bf16_t)(av.x & 0xffff)) * sigmoidf_(acc[ai][bj][m][0][0] + b0[0]);
                    o0[1] = bf2f((bf16_t)(av.x >> 16)) * sigmoidf_(acc[ai][bj][m][0][1] + b0[1]);
                    o0[2] = bf2f((bf16_t)(av.y & 0xffff)) * sigmoidf_(acc[ai][bj][m][0][2] + b0[2]);
                    o0[3] = bf2f((bf16_t)(av.y >> 16)) * sigmoidf_(acc[ai][bj][m][0][3] + b0[3]);
                    o1[0] = bf2f((bf16_t)(av.z & 0xffff)) * sigmoidf_(acc[ai][bj][m][1][0] + b1[0]);
                    o1[1] = bf2f((bf16_t)(av.z >> 16)) * sigmoidf_(acc[ai][bj][m][1][1] + b1[1]);
                    o1[2] = bf2f((bf16_t)(av.w & 0xffff)) * sigmoidf_(acc[ai][bj][m][1][2] + b1[2]);
                    o1[3] = bf2f((bf16_t)(av.w >> 16)) * sigmoidf_(acc[ai][bj][m][1][3] + b1[3]);
                    const u32x2 a = pk4(o0), b = pk4(o1);
                    u32x4 w; w.x = a.x; w.y = a.y; w.z = b.x; w.w = b.y;
                    *(u32x4*)(CAT + row * 1024 + 512 + col) = w;
                }
            }
    }
};
struct GEpiOut {
    static constexpr bool PERM = false;
    float* out; const float* gate;
    DEVINL void operator()(const f32x4 (&acc)[2][2][4][2], const pg8::Unit& u, int wr, int wc, int fr, int fq) const {
        const int b = u.pm / 17, lt = u.pm - b * 17 - 1;
        const float* gp = gate + (size_t)b * 6144;
        const int col0 = u.pn * 256 + wc * 32 + 4 * fq;
        float* base = out + ((size_t)b * SEQ + lt * 256 + wr * 64 + fr) * D;
#pragma unroll
        for (int ai = 0; ai < 2; ++ai)
#pragma unroll
            for (int m = 0; m < 4; ++m) {
                float* rp = base + (size_t)(ai * 128 + m * 16) * D;
#pragma unroll
                for (int bj = 0; bj < 2; ++bj)
#pragma unroll
                    for (int n = 0; n < 2; ++n) {
                        const int col = col0 + bj * 128 + n * 16;
                        const f32x4 g4 = *(const f32x4*)(gp + col);
                        f32x4 x4 = *(f32x4*)(rp + col);
                        x4 += g4 * acc[ai][bj][m][n];
                        *(f32x4*)(rp + col) = x4;
                    }
            }
    }
};
struct GEpiMoe1 {
    static constexpr bool PERM = true;
    bf16_t* act; const float* wl; const float* wh;
    DEVINL void operator()(const f32x4 (&acc)[2][2][4][2], const pg8::Unit& u, int wr, int wc, int fr, int fq) const {
        const int half = u.pn >> 1;
        const float* wsel = half ? wh : wl;
        const int cbase = half * 256 + (u.pn & 1) * 128 + 16 * wc + 4 * fq;
#pragma unroll
        for (int ai = 0; ai < 2; ++ai)
#pragma unroll
            for (int m = 0; m < 4; ++m) {
                const int lr = ai * 128 + wr * 64 + m * 16 + fr;
                if (lr < u.mvalid) {
                    const int slot = u.pm * 256 + lr;
                    const float wv = wsel[slot];
#pragma unroll
                    for (int bj = 0; bj < 2; ++bj) {
                        f32x4 o;
#pragma unroll
                        for (int j = 0; j < 4; ++j) o[j] = wv * siluf_(acc[ai][bj][m][0][j]) * acc[ai][bj][m][1][j];
                        *(u32x2*)(act + (size_t)slot * 512 + cbase + 64 * bj) = pk4(o);
                    }
                }
            }
    }
};
struct GEpiMoe2 {
    static constexpr bool PERM = false;
    float* out; float* cx; const float* gate; const int* list;
    DEVINL void operator()(const f32x4 (&acc)[2][2][4][2], const pg8::Unit& u, int wr, int wc, int fr, int fq) const {
        const int col0 = u.pn * 256 + wc * 32 + 4 * fq;
#pragma unroll
        for (int ai = 0; ai < 2; ++ai)
#pragma unroll
            for (int m = 0; m < 4; ++m) {
                const int lr = ai * 128 + wr * 64 + m * 16 + fr;
                if (lr < u.mvalid) {
                    const int r = list[u.pm * 256 + lr];
                    const int rb = r / RPB, rj = r - rb * RPB;
                    float* rp = (rj < CTXL) ? (cx + (size_t)(rb * CTXL + rj) * D) : (out + (size_t)(rb * SEQ + (rj - CTXL)) * D);
                    const float* gp = gate + (size_t)((rj < CTXL) ? 8 : rb) * 6144;
#pragma unroll
                    for (int bj = 0; bj < 2; ++bj)
#pragma unroll
                        for (int n = 0; n < 2; ++n) {
                            const int col = col0 + bj * 128 + n * 16;
                            const f32x4 g4 = *(const f32x4*)(gp + col);
                            f32x4 x4 = *(f32x4*)(rp + col);
                            x4 += g4 * acc[ai][bj][m][n];
                            *(f32x4*)(rp + col) = x4;
                        }
                }
            }
    }
};

template <int WHICH>
DEVINL void phase_gemm(const Params& p, char* smem, int bid, int nb) {
    constexpr int N = (WHICH == 0) ? 2048 : (WHICH == 1) ? 512 : (WHICH == 3) ? 5120 : 1024;
    constexpr int K = (WHICH == 1) ? 512 : 1024;
    PG8_LAS unsigned char* lds = (PG8_LAS unsigned char*)smem;
    pg8::DenseSched S;
    bid = sgpr(bid); nb = sgpr(nb);
    if (WHICH == 0) { S.init(sgpr_ptr(p.H), sgpr_ptr(p.wt_in0), N, K, nb, bid, 1); GEpiP0 e{sgpr_ptr(p.P)}; pg8::gemm_phase(lds, S, e); }
    if (WHICH == 1) { S.init(sgpr_ptr(p.s5a), sgpr_ptr(p.glu_t), N, K, nb, bid, 1); GEpiGlu e{sgpr_ptr(p.H), sgpr_ptr(p.s5a), sgpr_ptr(p.glu_b)}; pg8::gemm_phase(lds, S, e); }
    if (WHICH == 2) { S.init(sgpr_ptr(p.H), sgpr_ptr(p.wt_out0), N, K, nb, bid, 1); GEpiOut e{sgpr_ptr(p.out), sgpr_ptr(p.mod) + 2048}; pg8::gemm_phase(lds, S, e); }
    if (WHICH == 3) { S.init(sgpr_ptr(p.H), sgpr_ptr(p.wt_in1), N, K, nb, bid, 1); GEpiP1 e{sgpr_ptr(p.P), sgpr_ptr(p.lb)}; pg8::gemm_phase(lds, S, e); }
    if (WHICH == 4) { S.init(sgpr_ptr(p.H), sgpr_ptr(p.wt_out1), N, K, nb, bid, 1); GEpiOut e{sgpr_ptr(p.out), sgpr_ptr(p.mod) + 9 * 6144 + 2048}; pg8::gemm_phase(lds, S, e); }
    if (WHICH != 4) {
        constexpr int NT0 = (WHICH == 3) ? 4 : 0, NT1 = (WHICH == 3) ? 16 : N / 256, NTC = NT1 - NT0;
        for (int u = bid; u < 16 * NTC; u += nb) {
            const int mt = u / NTC, nt = NT0 + (u - mt * NTC);
            const int m0 = (mt >> 1) * RPB + (mt & 1) * 128, n0 = nt * 256;
            if (WHICH == 0) { EpiP0 e{p.P, m0, n0}; gemm_tile(p.H, 1024, nullptr, m0, 128, p.wt_in0 + (size_t)n0 * 1024, nullptr, 1024, K, K, e, smem); }
            if (WHICH == 1) { EpiGlu e{p.H, p.s5a, p.glu_b, m0, n0}; gemm_tile(p.s5a, 512, nullptr, m0, 128, p.glu_t + (size_t)n0 * 512, nullptr, 512, K, K, e, smem); }
            if (WHICH == 2) { EpiOut e{&p, p.mod + 2048, m0, n0}; gemm_tile(p.H, 1024, nullptr, m0, 128, p.wt_out0 + (size_t)n0 * 1024, nullptr, 1024, K, K, e, smem); }
            if (WHICH == 3) { EpiP1 e{p.P, p.lb, m0, n0}; gemm_tile(p.H, 1024, nullptr, m0, 128, p.wt_in1 + (size_t)n0 * 1024, nullptr, 1024, K, K, e, smem); }
        }
    }
}

constexpr int MOE_TAB = pg8::STAGE_BYTES;
static_assert(MOE_TAB + 1024 <= LDS_BYTES, "moe tables");
DEVINL void moe_setup(const Params& p, int L, int* tab) {
    if (tid_opaque() == 0) {
        int o = 0, ts = 0;
        for (int b = 0; b < 48; ++b) { const int c = p.cnt[L * 64 + b]; tab[b] = o; tab[64 + b] = ts; tab[128 + b] = c; const int nt = (c + 255) >> 8; o += nt * 256; ts += nt; }
        tab[48] = o; tab[64 + 48] = ts;
    }
    __syncthreads();
}
template <int L>
DEVINL void phase_list(const Params& p, char* smem, int bid, int nb) {
    int* tab = (int*)(smem + MOE_TAB);
    moe_setup(p, L, tab);
    const int nrows = L ? NLAT : R;
    const int w = tid_opaque() >> 6, lane = tid_opaque() & 63;
    for (int i = bid * 8 + w; i < nrows; i += nb * 8) {
        const int r = L ? ((i >> 12) * RPB + CTXL + (i & 4095)) : i;
        const float4 rec = p.RT[r];
        const int bucket = __float_as_int(rec.x);
        int slot = 0;
        if (lane == 0) { const int pos = atomicAdd(&p.cnt[128 + L * 64 + bucket], 1); slot = tab[bucket] + pos; p.list[slot] = r; p.wl[slot] = rec.y; p.wh[slot] = rec.z; }
        slot = __shfl(slot, 0);
        const u32x4* src = (const u32x4*)(p.H + (size_t)r * D);
        u32x4* dst = (u32x4*)(p.hs + (size_t)slot * D);
        dst[lane] = src[lane]; dst[lane + 64] = src[lane + 64];
    }
}
struct MoeSched {
    const bf16_t* hs; const bf16_t* wgu_t; const bf16_t* act; const bf16_t* wd_t; const int* tab; int K, ldb, ksplit, G, c, stage, ntiles;
    DEVINL bool next(int i, pg8::Unit& u) const {
        const int Lq = i * G + c; if (Lq >= ntiles * 4) return false;
        const int tile = Lq >> 2, pn = Lq & 3;
        int bucket = 0;
        for (int b = 0; b < 48; ++b) if (tile >= tab[64 + b] && tile < tab[64 + b + 1]) bucket = b;
        bucket = sgpr(bucket);
        const int ti = tile - sgpr(tab[64 + bucket]);
        const int m0 = sgpr(tab[bucket]) + ti * 256;
        const int rem = sgpr(tab[128 + bucket]) - ti * 256;
        const int grp = bucket / 6, pair = bucket - grp * 6;
        const int lo = (pair < 3) ? 0 : (pair < 5 ? 1 : 2);
        const int hi = (pair < 3) ? (pair + 1) : (pair < 5 ? (pair - 1) : 3);
        const int ea = grp * 4 + lo, eb = grp * 4 + hi;
        u.pm = m0 >> 8; u.pn = pn; u.mvalid = rem < 256 ? rem : 256; u.aux = 0;
        if (stage == 1) {
            const int e = (pn >> 1) ? eb : ea;
            u.A = (const char*)(hs + (size_t)m0 * 1024);
            u.B0 = (const char*)(wgu_t + ((size_t)e * 512 + (pn & 1) * 256) * 1024); u.B1 = u.B0;
        } else {
            u.A = (const char*)(act + (size_t)m0 * 512);
            u.B0 = (const char*)(wd_t + ((size_t)ea * 1024 + pn * 256) * 256);
            u.B1 = (const char*)(wd_t + ((size_t)eb * 1024 + pn * 256) * 256) - (size_t)4 * 128;
        }
        return true;
    }
};
template <int L, int STAGE>
DEVINL void phase_moe(const Params& p, char* smem, int bid, int nb) {
    int* tab = (int*)(smem + MOE_TAB);
    moe_setup(p, L, tab);
    PG8_LAS unsigned char* lds = (PG8_LAS unsigned char*)smem;
    MoeSched S; S.hs = sgpr_ptr(p.hs); S.wgu_t = sgpr_ptr(p.wgu_t); S.act = sgpr_ptr(p.act); S.wd_t = sgpr_ptr(p.wd_t);
    S.tab = tab; S.G = sgpr(nb); S.c = sgpr(bid); S.stage = STAGE; S.ntiles = sgpr(tab[64 + 48]);
    if (STAGE == 1) { S.K = 1024; S.ldb = 1024; S.ksplit = 16; GEpiMoe1 e{sgpr_ptr(p.act), sgpr_ptr(p.wl), sgpr_ptr(p.wh)}; pg8::gemm_phase(lds, S, e); }
    else { S.K = 512; S.ldb = 256; S.ksplit = 4; GEpiMoe2 e{sgpr_ptr(p.out), sgpr_ptr(p.cx), sgpr_ptr(p.mod) + (size_t)L * 9 * 6144 + 5120, sgpr_ptr(p.list)}; pg8::gemm_phase(lds, S, e); }
    __syncthreads();
}

template <int DK> struct RecL {
    static constexpr int QS = DK + 8;
    static constexpr int oQs = 0;
    static constexpr int oKs = oQs + 64 * QS * 2;
    static constexpr int oKt = oKs + 64 * QS * 2;
    static constexpr int oVt = oKt + DK * 72 * 2;
    static constexpr int oAt = oVt + 128 * 72 * 2;
    static constexpr int oSt = oAt + 64 * 72 * 2;
    static constexpr int oPart = oSt + 128 * 136 * 2;
    static constexpr int oEmid = oPart + 8 * 128 * 4;
    static constexpr int oEend = oEmid + 128 * 4;
    static constexpr int oAF = oEend + 128 * 4;
    static constexpr int oRed = oAF + 64 * 32 * 4;
    static constexpr int total = oRed + 64 * 2 * 4 + 128 * 4;
};
static_assert(RecL<128>::total <= LDS_BYTES, "rec lds");

template <bool GLA> struct RecCols {
    static constexpr int LDP = GLA ? 2048 : 5120;
    static constexpr int QOFF = 0;
    static constexpr int KOFF = 256;
    static constexpr int KF = 1024, KB = 2048;
    static constexpr int VOFF = GLA ? 512 : 3072;
    static constexpr int GOFF = GLA ? 1024 : 4096;
};
template <int DK, bool GLA> struct RecGeo {
    static constexpr int GC = GLA ? 4 : 8;
    static constexpr int NS = GLA ? 16 : 8;
    static constexpr int H = GLA ? 4 : 8;
    static constexpr int KT = DK / 16;
};

DEVINL void lds_sync() { asm volatile("s_waitcnt lgkmcnt(0)" ::: "memory"); __builtin_amdgcn_s_barrier(); asm volatile("" ::: "memory"); }

struct RawRegs { u32x4 q[2], k[2], v[2], af; };

template <int DK, bool GLA, int DIR, bool PASS3>
DEVINL void rec_load_raw(const Params& p, const bf16_t* __restrict__ P, int row0, int h, RawRegs& r) {
    using C = RecCols<GLA>; constexpr int LDP = C::LDP;
    const int t = tid_opaque();
    if (GLA) {
        const int row = t >> 3, c8 = (t & 7) * 8;
        const bf16_t* rp = P + (size_t)(row0 + row) * LDP + h * 64 + c8;
        if (PASS3) r.q[0] = *(const u32x4*)(rp + C::QOFF);
        r.k[0] = *(const u32x4*)(rp + C::KOFF);
        r.af = *(const u32x4*)(p.AF + (size_t)(row0 + row) * 32 + (t & 7) * 4);
    } else {
#pragma unroll
        for (int i = 0; i < 2; ++i) {
            const int row = (t >> 4) + i * 32, c8 = (t & 15) * 8;
            const bf16_t* rp = P + (size_t)(row0 + row) * LDP + h * 128 + c8;
            if (PASS3) r.q[i] = *(const u32x4*)(rp + C::QOFF);
            r.k[i] = *(const u32x4*)(rp + (DIR ? C::KB : C::KF));
        }
    }
#pragma unroll
    for (int i = 0; i < 2; ++i) {
        const int row = (t >> 4) + i * 32, c8 = (t & 15) * 8;
        r.v[i] = *(const u32x4*)(P + (size_t)(row0 + row) * LDP + C::VOFF + h * 128 + c8);
    }
}

template <int DK, bool GLA, int DIR, bool PASS3>
DEVINL void rec_prep(const Params& p, char* smem, const bf16_t* __restrict__ P, RawRegs& raw, bool has_next, int next_row0, int h,
                     const float (&a2c)[2][16], const float (&abv)[2], float (&bsum)[2]) {
    using L = RecL<DK>;
    constexpr int NCP = DK / 2, NSEG = NTHR / NCP, RS = 64 / NSEG, QS = L::QS;
    constexpr bool ref_end = !PASS3;
    bf16_t* Qs = (bf16_t*)(smem + L::oQs); bf16_t* Ks = (bf16_t*)(smem + L::oKs); bf16_t* Kt = (bf16_t*)(smem + L::oKt); bf16_t* Vt = (bf16_t*)(smem + L::oVt);
    bf16_t* Vraw = (bf16_t*)(smem + L::oSt);
    float* part = (float*)(smem + L::oPart); float* emid = (float*)(smem + L::oEmid); float* eend = (float*)(smem + L::oEend); float* AFs = (float*)(smem + L::oAF);
    const int t = tid_opaque();
    if (GLA) {
        const int row = t >> 3, c8 = (t & 7) * 8;
        if (PASS3) *(u32x4*)&Qs[row * QS + c8] = raw.q[0];
        *(u32x4*)&Ks[row * QS + c8] = raw.k[0];
        *(u32x4*)&AFs[row * 32 + (t & 7) * 4] = raw.af;
    } else {
#pragma unroll
        for (int i = 0; i < 2; ++i) {
            const int row = (t >> 4) + i * 32, c8 = (t & 15) * 8;
            if (PASS3) *(u32x4*)&Qs[row * QS + c8] = raw.q[i];
            *(u32x4*)&Ks[row * QS + c8] = raw.k[i];
        }
    }
#pragma unroll
    for (int i = 0; i < 2; ++i) { const int row = (t >> 4) + i * 32, c8 = (t & 15) * 8; *(u32x4*)&Vraw[row * 136 + c8] = raw.v[i]; }
    lds_sync();
    if (has_next) rec_load_raw<DK, GLA, DIR, PASS3>(p, P, next_row0, h, raw);
    const int cp = t % NCP, seg = t / NCP, c0 = cp * 2, l0 = seg * RS;
    float dv[RS][2];
    float kv[RS][2];
#pragma unroll
    for (int i = 0; i < RS; ++i) {
        const unsigned kr = *(const unsigned*)&Ks[(l0 + i) * QS + c0];
        if (GLA) {
            kv[i][0] = bf2f((bf16_t)(kr & 0xffffu)); kv[i][1] = bf2f((bf16_t)(kr >> 16));
            const float* ar = &AFs[(l0 + i) * 32 + DIR * 16];
            float s0 = abv[0], s1 = abv[1];
#pragma unroll
            for (int r = 0; r < 16; ++r) { const float av = ar[r]; s0 += av * a2c[0][r]; s1 += av * a2c[1][r]; }
            dv[i][0] = logsigmoidf_(s0) * 0.0625f; dv[i][1] = logsigmoidf_(s1) * 0.0625f;
        } else {
            kv[i][0] = h2f((unsigned short)(kr & 0xffffu)); kv[i][1] = h2f((unsigned short)(kr >> 16));
            dv[i][0] = 1.0f - kv[i][0]; dv[i][1] = 1.0f - kv[i][1];
        }
    }
    {
        float s0 = GLA ? 0.f : 1.f, s1 = GLA ? 0.f : 1.f;
#pragma unroll
        for (int i = 0; i < RS; ++i) { if (GLA) { s0 += dv[i][0]; s1 += dv[i][1]; } else { s0 *= dv[i][0]; s1 *= dv[i][1]; } }
        float2 pv; pv.x = s0; pv.y = s1;
        *(float2*)&part[seg * DK + c0] = pv;
    }
    lds_sync();
    float tot[2], base[2], mid[2];
#pragma unroll
    for (int c = 0; c < 2; ++c) { tot[c] = GLA ? 0.f : 1.f; base[c] = tot[c]; mid[c] = tot[c]; }
#pragma unroll
    for (int sg = 0; sg < NSEG; ++sg) {
        const float2 pv = *(const float2*)&part[sg * DK + c0];
        const bool before = (DIR == 0) ? (sg < seg) : (sg > seg);
        const bool firsthalf = (DIR == 0) ? (sg < NSEG / 2) : (sg >= NSEG / 2);
        if (GLA) { tot[0] += pv.x; tot[1] += pv.y; if (before) { base[0] += pv.x; base[1] += pv.y; } if (firsthalf) { mid[0] += pv.x; mid[1] += pv.y; } }
        else { tot[0] *= pv.x; tot[1] *= pv.y; if (before) { base[0] *= pv.x; base[1] *= pv.y; } if (firsthalf) { mid[0] *= pv.x; mid[1] *= pv.y; } }
    }
    float ref[2], iref[2];
#pragma unroll
    for (int c = 0; c < 2; ++c) { ref[c] = ref_end ? tot[c] : mid[c]; iref[c] = GLA ? 0.f : __builtin_amdgcn_rcpf(ref[c]); }
    if (seg == 0) {
#pragma unroll
        for (int c = 0; c < 2; ++c) {
            if (GLA) { emid[c0 + c] = __expf(ref[c]); eend[c0 + c] = __expf(tot[c] - ref[c]); bsum[c] += tot[c]; }
            else { emid[c0 + c] = ref[c]; eend[c0 + c] = tot[c] * iref[c]; bsum[c] += __logf(tot[c]); }
        }
    }
    unsigned short ktv[2][RS];
    float run[2] = {base[0], base[1]};
#pragma unroll
    for (int ii = 0; ii < RS; ++ii) {
        const int i = (DIR == 0) ? ii : (RS - 1 - ii);
        float ek[2], eq[2];
#pragma unroll
        for (int c = 0; c < 2; ++c) {
            if (GLA) { run[c] += dv[i][c]; ek[c] = __expf(ref[c] - run[c]); eq[c] = PASS3 ? __expf(run[c] - ref[c]) : 0.f; }
            else { run[c] *= dv[i][c]; ek[c] = ref[c] * __builtin_amdgcn_rcpf(run[c]); eq[c] = run[c] * iref[c]; }
        }
        const unsigned kp = cvt_pk_bf16(kv[i][0] * ek[0], kv[i][1] * ek[1]);
        ktv[0][i] = (unsigned short)(kp & 0xffffu); ktv[1][i] = (unsigned short)(kp >> 16);
        if (PASS3) {
            const int l = l0 + i;
            *(unsigned*)&Ks[l * QS + c0] = kp;
            const unsigned qr = *(const unsigned*)&Qs[l * QS + c0];
            *(unsigned*)&Qs[l * QS + c0] = cvt_pk_bf16(bf2f((bf16_t)(qr & 0xffffu)) * eq[0], bf2f((bf16_t)(qr >> 16)) * eq[1]);
        }
    }
#pragma unroll
    for (int c = 0; c < 2; ++c) {
        if (RS == 8) {
            u32x4 v;
            v.x = (unsigned)ktv[c][0] | ((unsigned)ktv[c][1] << 16); v.y = (unsigned)ktv[c][2] | ((unsigned)ktv[c][3] << 16);
            v.z = (unsigned)ktv[c][RS > 4 ? 4 : 0] | ((unsigned)ktv[c][RS > 4 ? 5 : 0] << 16); v.w = (unsigned)ktv[c][RS > 4 ? 6 : 0] | ((unsigned)ktv[c][RS > 4 ? 7 : 0] << 16);
            *(u32x4*)&Kt[(c0 + c) * 72 + l0] = v;
        } else {
            u32x2 v;
            v.x = (unsigned)ktv[c][0] | ((unsigned)ktv[c][1] << 16); v.y = (unsigned)ktv[c][2] | ((unsigned)ktv[c][3] << 16);
            *(u32x2*)&Kt[(c0 + c) * 72 + l0] = v;
        }
    }
    {
        const int vp = t & 63, vq = t >> 6;
        unsigned vr[8];
#pragma unroll
        for (int i = 0; i < 8; ++i) vr[i] = *(const unsigned*)&Vraw[(vq * 8 + i) * 136 + 2 * vp];
        u32x4 lo, hi;
        lo.x = (vr[0] & 0xffffu) | (vr[1] << 16); lo.y = (vr[2] & 0xffffu) | (vr[3] << 16); lo.z = (vr[4] & 0xffffu) | (vr[5] << 16); lo.w = (vr[6] & 0xffffu) | (vr[7] << 16);
        hi.x = (vr[0] >> 16) | (vr[1] & 0xffff0000u); hi.y = (vr[2] >> 16) | (vr[3] & 0xffff0000u); hi.z = (vr[4] >> 16) | (vr[5] & 0xffff0000u); hi.w = (vr[6] >> 16) | (vr[7] & 0xffff0000u);
        *(u32x4*)&Vt[(2 * vp) * 72 + vq * 8] = lo;
        *(u32x4*)&Vt[(2 * vp + 1) * 72 + vq * 8] = hi;
    }
    lds_sync();
}

DEVINL bf16x8 ldfrag(const bf16_t* base, int ld, int fr, int fq, int k0) { return *(const bf16x8*)(base + fr * ld + k0 + fq * 8); }

template <int DK, bool GLA, int DIR>
DEVINL void rec_load_a2(const Params& p, int h, float (&a2c)[2][16], float (&abv)[2]) {
#pragma unroll
    for (int c = 0; c < 2; ++c) { abv[c] = 0.f;
#pragma unroll
        for (int r = 0; r < 16; ++r) a2c[c][r] = 0.f; }
    if (GLA) {
        const int c0 = (tid_opaque() % (DK / 2)) * 2;
#pragma unroll
        for (int c = 0; c < 2; ++c) {
#pragma unroll
            for (int r = 0; r < 16; ++r) a2c[c][r] = p.gla_a2[(DIR * 16 + r) * 256 + h * 64 + c0 + c];
            abv[c] = p.gla_ab[DIR * 256 + h * 64 + c0 + c];
        }
    }
}

template <int DK, bool GLA, int DIR>
DEVINL void rec_pass1_unit(const Params& p, char* smem, const bf16_t* P, int b, int h, int cg, float* slots, float* decs) {
    using L = RecL<DK>; using G = RecGeo<DK, GLA>;
    constexpr int KT = G::KT;
    bf16_t* Kt = (bf16_t*)(smem + L::oKt); bf16_t* Vt = (bf16_t*)(smem + L::oVt); float* emid = (float*)(smem + L::oEmid);
    const int t = tid_opaque(), w = t >> 6, lane = t & 63, fr = lane & 15, fq = lane >> 4;
    float a2c[2][16], abv[2];
    rec_load_a2<DK, GLA, DIR>(p, h, a2c, abv);
    f32x4 accS[KT];
#pragma unroll
    for (int kt = 0; kt < KT; ++kt) accS[kt] = (f32x4){0.f, 0.f, 0.f, 0.f};
    float bsum[2] = {0.f, 0.f};
    const int nch = (cg == 0) ? 4 : G::GC;
    auto chunk_row0 = [&](int ci) { const int pc = (cg == 0) ? (DIR == 0 ? ci : 3 - ci) : (DIR == 0 ? (4 + (cg - 1) * G::GC + ci) : (67 - (cg - 1) * G::GC - ci)); return b * RPB + pc * 64; };
    RawRegs raw;
    rec_load_raw<DK, GLA, DIR, false>(p, P, chunk_row0(0), h, raw);
    for (int ci = 0; ci < nch; ++ci) {
        const bool has_next = ci + 1 < nch;
        rec_prep<DK, GLA, DIR, false>(p, smem, P, raw, has_next, has_next ? chunk_row0(ci + 1) : 0, h, a2c, abv, bsum);
        bf16x8 av[2];
#pragma unroll
        for (int ks = 0; ks < 2; ++ks) av[ks] = ldfrag(Vt + (w * 16) * 72, 72, fr, fq, ks * 32);
#pragma unroll
        for (int kt = 0; kt < KT; ++kt) {
            const f32x4 e4 = *(const f32x4*)&emid[kt * 16 + fq * 4];
            f32x4 c = accS[kt] * e4;
#pragma unroll
            for (int ks = 0; ks < 2; ++ks) c = __builtin_amdgcn_mfma_f32_16x16x32_bf16(ldfrag(Kt + (kt * 16) * 72, 72, fr, fq, ks * 32), av[ks], c, 0, 0, 0);
            accS[kt] = c;
        }
        lds_sync();
    }
    const size_t chain = ((size_t)(b * G::H + h) * 2 + DIR);
    float* sl = slots + (chain * G::NS + cg) * (size_t)(128 * DK);
#pragma unroll
    for (int kt = 0; kt < KT; ++kt) *(f32x4*)&sl[(w * 16 + fr) * DK + kt * 16 + fq * 4] = accS[kt];
    if (t < DK / 2) { decs[(chain * G::NS + cg) * DK + 2 * t] = bsum[0]; decs[(chain * G::NS + cg) * DK + 2 * t + 1] = bsum[1]; }
}

template <int DK, bool GLA, int DIR>
DEVINL void rec_pass3_chunk(const Params& p, char* smem, const bf16_t* P, bf16_t* CAT, int row0, int h, f32x4 (&accS)[DK / 16], const float* gnorm) {
    using L = RecL<DK>; using C = RecCols<GLA>;
    constexpr int KT = DK / 16, QS = L::QS, KS = DK / 32;
    bf16_t* Qs = (bf16_t*)(smem + L::oQs); bf16_t* Ks = (bf16_t*)(smem + L::oKs); bf16_t* Kt = (bf16_t*)(smem + L::oKt); bf16_t* Vt = (bf16_t*)(smem + L::oVt);
    bf16_t* At = (bf16_t*)(smem + L::oAt); bf16_t* St = (bf16_t*)(smem + L::oSt);
    float* emid = (float*)(smem + L::oEmid); float* eend = (float*)(smem + L::oEend); float* red = (float*)(smem + L::oRed);
    const int t = tid_opaque(), w = t >> 6, lane = t & 63, fr = lane & 15, fq = lane >> 4;
    u32x2 obv[4], gbv[4];
    if (DIR == 0) {
        const size_t prow = (size_t)(row0 + (w & 3) * 16 + fr);
        const bf16_t* cp0 = CAT + prow * 1024 + h * 128 + (w >> 2) * 64 + fq * 4;
        const bf16_t* gp0 = P + prow * C::LDP + C::GOFF + h * 128 + (w >> 2) * 64 + fq * 4;
#pragma unroll
        for (int n = 0; n < 4; ++n) { obv[n] = *(const u32x2*)(cp0 + n * 16); gbv[n] = *(const u32x2*)(gp0 + n * 16); }
    }
#pragma unroll
    for (int kt = 0; kt < KT; ++kt) {
        const f32x4 e4 = *(const f32x4*)&emid[kt * 16 + fq * 4];
        accS[kt] = accS[kt] * e4;
        *(u32x2*)&St[(w * 16 + fr) * QS + kt * 16 + fq * 4] = pk4(accS[kt]);
    }
    {
        const int lt = w >> 1, st0 = (w & 1) * 2;
        bf16x8 aq[KS];
#pragma unroll
        for (int ks = 0; ks < KS; ++ks) aq[ks] = ldfrag(Qs + (lt * 16) * QS, QS, fr, fq, ks * 32);
#pragma unroll
        for (int s2 = 0; s2 < 2; ++s2) {
            const int st = st0 + s2;
            f32x4 c = (f32x4){0.f, 0.f, 0.f, 0.f};
#pragma unroll
            for (int ks = 0; ks < KS; ++ks) c = __builtin_amdgcn_mfma_f32_16x16x32_bf16(ldfrag(Ks + (st * 16) * QS, QS, fr, fq, ks * 32), aq[ks], c, 0, 0, 0);
            const int l = lt * 16 + fr;
#pragma unroll
            for (int j = 0; j < 4; ++j) { const int sidx = st * 16 + fq * 4 + j; const bool keep = (DIR == 0) ? (sidx <= l) : (sidx >= l); c[j] = keep ? c[j] : 0.f; }
            *(u32x2*)&At[l * 72 + st * 16 + fq * 4] = pk4(c);
        }
    }
    lds_sync();
    const int lt = w & 3, vt0 = (w >> 2) * 4;
    f32x4 o[4];
    {
        bf16x8 aa[2], aq[KS];
#pragma unroll
        for (int ks = 0; ks < 2; ++ks) aa[ks] = ldfrag(At + (lt * 16) * 72, 72, fr, fq, ks * 32);
#pragma unroll
        for (int ks = 0; ks < KS; ++ks) aq[ks] = ldfrag(Qs + (lt * 16) * QS, QS, fr, fq, ks * 32);
#pragma unroll
        for (int n = 0; n < 4; ++n) {
            const int vt = vt0 + n;
            f32x4 c = (f32x4){0.f, 0.f, 0.f, 0.f};
#pragma unroll
            for (int ks = 0; ks < 2; ++ks) c = __builtin_amdgcn_mfma_f32_16x16x32_bf16(ldfrag(Vt + (vt * 16) * 72, 72, fr, fq, ks * 32), aa[ks], c, 0, 0, 0);
#pragma unroll
            for (int ks = 0; ks < KS; ++ks) c = __builtin_amdgcn_mfma_f32_16x16x32_bf16(ldfrag(St + (vt * 16) * QS, QS, fr, fq, ks * 32), aq[ks], c, 0, 0, 0);
            o[n] = c;
        }
    }
    {
        bf16x8 av[2];
#pragma unroll
        for (int ks = 0; ks < 2; ++ks) av[ks] = ldfrag(Vt + (w * 16) * 72, 72, fr, fq, ks * 32);
#pragma unroll
        for (int kt = 0; kt < KT; ++kt) {
            f32x4 c = accS[kt];
#pragma unroll
            for (int ks = 0; ks < 2; ++ks) c = __builtin_amdgcn_mfma_f32_16x16x32_bf16(ldfrag(Kt + (kt * 16) * 72, 72, fr, fq, ks * 32), av[ks], c, 0, 0, 0);
            const f32x4 e4 = *(const f32x4*)&eend[kt * 16 + fq * 4];
            accS[kt] = c * e4;
        }
    }
    const int l = lt * 16 + fr;
    const size_t row = (size_t)(row0 + l);
    bf16_t* cp = CAT + row * 1024 + h * 128 + vt0 * 16 + fq * 4;
    if (DIR == 1) {
#pragma unroll
        for (int n = 0; n < 4; ++n) *(u32x2*)(cp + n * 16) = pk4(o[n]);
    } else {
        float ss = 0.f;
#pragma unroll
        for (int n = 0; n < 4; ++n) {
            const u32x2 ob = obv[n];
            o[n][0] += bf2f((bf16_t)(ob.x & 0xffff)); o[n][1] += bf2f((bf16_t)(ob.x >> 16));
            o[n][2] += bf2f((bf16_t)(ob.y & 0xffff)); o[n][3] += bf2f((bf16_t)(ob.y >> 16));
            ss += o[n][0] * o[n][0] + o[n][1] * o[n][1] + o[n][2] * o[n][2] + o[n][3] * o[n][3];
        }
        ss += __shfl_xor(ss, 16);
        ss += __shfl_xor(ss, 32);
        if (fq == 0) red[l * 2 + (w >> 2)] = ss;
        lds_sync();
        const float tot = red[l * 2] + red[l * 2 + 1];
        const float rstd = rsqrtf(tot * (1.0f / 128.0f) + EPS);
#pragma unroll
        for (int n = 0; n < 4; ++n) {
            const u32x2 gb = gbv[n];
            const f32x4 gn = *(const f32x4*)(gnorm + vt0 * 16 + n * 16 + fq * 4);
            f32x4 gv;
            gv[0] = bf2f((bf16_t)(gb.x & 0xffff)); gv[1] = bf2f((bf16_t)(gb.x >> 16)); gv[2] = bf2f((bf16_t)(gb.y & 0xffff)); gv[3] = bf2f((bf16_t)(gb.y >> 16));
            f32x4 r4;
#pragma unroll
            for (int j = 0; j < 4; ++j) { const float g = GLA ? siluf_(gv[j]) : gv[j]; r4[j] = o[n][j] * rstd * gn[j] * g; }
            *(u32x2*)(cp + n * 16) = pk4(r4);
        }
    }
    lds_sync();
}

template <int DK, bool GLA, int DIR>
DEVINL void rec_pass3_sweep(const Params& p, char* smem, const bf16_t* P, bf16_t* CAT, int b, int h, int c_lo, int nch, int slot, const float* slots, const float* gnorm) {
    using G = RecGeo<DK, GLA>;
    constexpr int KT = G::KT;
    const int t = tid_opaque(), w = t >> 6, lane = t & 63, fr = lane & 15, fq = lane >> 4;
    float a2c[2][16], abv[2];
    rec_load_a2<DK, GLA, DIR>(p, h, a2c, abv);
    f32x4 accS[KT];
    if (slot >= 0) {
        const size_t chain = ((size_t)(b * G::H + h) * 2 + DIR);
        const float* sl = slots + (chain * G::NS + slot) * (size_t)(128 * DK);
#pragma unroll
        for (int kt = 0; kt < KT; ++kt) accS[kt] = *(const f32x4*)&sl[(w * 16 + fr) * DK + kt * 16 + fq * 4];
    } else {
#pragma unroll
        for (int kt = 0; kt < KT; ++kt) accS[kt] = (f32x4){0.f, 0.f, 0.f, 0.f};
    }
    float bsum[2] = {0.f, 0.f};
    float* gn_lds = (float*)(smem + RecL<DK>::oRed + 64 * 2 * 4);
    if (DIR == 0) { if (t < 128) gn_lds[t] = gnorm[t]; }
    auto chunk_row0 = [&](int ci) { const int pc = (DIR == 0) ? (c_lo + ci) : (c_lo + nch - 1 - ci); return b * RPB + pc * 64; };
    RawRegs raw;
    rec_load_raw<DK, GLA, DIR, true>(p, P, chunk_row0(0), h, raw);
    for (int ci = 0; ci < nch; ++ci) {
        const bool has_next = ci + 1 < nch;
        rec_prep<DK, GLA, DIR, true>(p, smem, P, raw, has_next, has_next ? chunk_row0(ci + 1) : 0, h, a2c, abv, bsum);
        rec_pass3_chunk<DK, GLA, DIR>(p, smem, P, CAT, chunk_row0(ci), h, accS, gn_lds);
    }
}

template <int DK, bool GLA>
DEVINL void rec_pass3_unit(const Params& p, char* smem, const bf16_t* P, bf16_t* CAT, int b, int h, int gi, const float* slots, const float* gnorm) {
    using G = RecGeo<DK, GLA>;
    int c_lo, nch, slot_f, slot_b;
    if (GLA) {
        if (gi == 0) { c_lo = 0; nch = 4; slot_f = -1; slot_b = -1; }
        else { const int pg = gi - 1; c_lo = 4 + pg * G::GC; nch = G::GC; slot_f = pg; slot_b = G::NS - 1 - pg; }
    } else { const int pg = gi; c_lo = 4 + pg * G::GC; nch = G::GC; slot_f = pg; slot_b = G::NS - 1 - pg; }
    rec_pass3_sweep<DK, GLA, 1>(p, smem, P, CAT, b, h, c_lo, nch, slot_b, slots, gnorm);
    asm volatile("s_waitcnt vmcnt(0)" ::: "memory");
    rec_pass3_sweep<DK, GLA, 0>(p, smem, P, CAT, b, h, c_lo, nch, slot_f, slots, gnorm);
}

template <int DK, bool GLA>
DEVINL void rec_scan(float* slots, const float* decs, int bid, int nb) {
    using G = RecGeo<DK, GLA>;
    constexpr int NCHAIN = NBATCH * G::H * 2, PER = 128 * DK / 4;
    const int total = NCHAIN * PER;
    for (int i = bid * NTHR + tid_opaque(); i < total; i += nb * NTHR) {
        const int chain = i / PER, e = i - chain * PER;
        const int k4 = (e * 4) % DK;
        f32x4 run = (f32x4){0.f, 0.f, 0.f, 0.f};
        for (int s = 0; s < G::NS; ++s) {
            const f32x4 d4 = *(const f32x4*)&decs[((size_t)chain * G::NS + s) * DK + k4];
            float* sp = slots + ((size_t)chain * G::NS + s) * (size_t)(128 * DK) + (size_t)e * 4;
            const f32x4 a = *(const f32x4*)sp;
#pragma unroll
            for (int j = 0; j < 4; ++j) run[j] = __expf(d4[j]) * run[j] + a[j];
            *(f32x4*)sp = run;
        }
    }
}

DEVINL size_t s5_idx(int b, int di, int pc, int g, int pp) { return ((((size_t)(b * 2 + di) * NCH + pc) * 32 + g) * 64 + pp) * 2; }

constexpr int S5_BU_LD = 20;
constexpr int S5_WAVE_LDS = 128 * S5_BU_LD * 4 + 16 * 136 * 2;
static_assert(8 * S5_WAVE_LDS <= LDS_BYTES, "s5 lds");

DEVINL void s5_load_afr(const Params& p, int row0, int g, int fr, int fq, bf16x8 (&afr)[4]) {
    const bf16x8 z = (bf16x8){0, 0, 0, 0, 0, 0, 0, 0};
#pragma unroll
    for (int sb = 0; sb < 4; ++sb) afr[sb] = (fq < 2) ? *(const bf16x8*)(p.P + (size_t)(row0 + sb * 16 + fr) * 2048 + 1536 + g * 16 + fq * 8) : z;
}
DEVINL void s5_load_bfr(const Params& p, int di, int g, int fr, int fq, bf16x8 (&bfr)[8]) {
    const bf16x8 z = (bf16x8){0, 0, 0, 0, 0, 0, 0, 0};
#pragma unroll
    for (int nt = 0; nt < 8; ++nt) bfr[nt] = (fq < 2) ? *(const bf16x8*)(p.bbm + ((size_t)((di * 32 + g) * 128 + nt * 16 + fr)) * 16 + fq * 8) : z;
}
DEVINL void s5_bu_subblock(float* BuT, const bf16x8& a, const bf16x8 (&bfr)[8], int fr, int fq) {
#pragma unroll
    for (int nt = 0; nt < 8; ++nt) {
        f32x4 c = (f32x4){0.f, 0.f, 0.f, 0.f};
        c = __builtin_amdgcn_mfma_f32_16x16x32_bf16(bfr[nt], a, c, 0, 0, 0);
#pragma unroll
        for (int r = 0; r < 4; ++r) BuT[(nt * 16 + fq * 4 + r) * S5_BU_LD + fr] = c[r];
    }
}
template <int DIR, bool XS>
DEVINL void s5_scan16(const float* BuT, bf16_t* Xs, int lane, float are, float aim, float& xr, float& xi) {
    f32x4 br[4], bi[4];
#pragma unroll
    for (int q = 0; q < 4; ++q) { br[q] = *(const f32x4*)&BuT[lane * S5_BU_LD + q * 4]; bi[q] = *(const f32x4*)&BuT[(64 + lane) * S5_BU_LD + q * 4]; }
#pragma unroll
    for (int tt = 0; tt < 16; ++tt) {
        const int tl = DIR ? (15 - tt) : tt;
        const float nr = are * xr - aim * xi + br[tl >> 2][tl & 3], ni = are * xi + aim * xr + bi[tl >> 2][tl & 3];
        xr = nr; xi = ni;
        if (XS) { const unsigned pkd = cvt_pk_bf16(xr, xi); Xs[tl * 136 + lane] = (bf16_t)(pkd & 0xffffu); Xs[tl * 136 + 64 + lane] = (bf16_t)(pkd >> 16); }
    }
}
template <int DIR>
DEVINL void s5_pass1_task(const Params& p, float* BuT, int b, int pc, int g, const bf16x8 (&afr)[4], int lane, int fr, int fq) {
    bf16x8 bfr[8];
    s5_load_bfr(p, DIR, g, fr, fq, bfr);
    const float are = p.atab[((DIR * 32 + g) * 64 + lane) * 2], aim = p.atab[((DIR * 32 + g) * 64 + lane) * 2 + 1];
    float xr = 0.f, xi = 0.f;
#pragma unroll
    for (int sbi = 0; sbi < 4; ++sbi) {
        const int sb = DIR ? (3 - sbi) : sbi;
        s5_bu_subblock(BuT, afr[sb], bfr, fr, fq);
        asm volatile("s_waitcnt lgkmcnt(0)" ::: "memory");
        s5_scan16<DIR, false>(BuT, nullptr, lane, are, aim, xr, xi);
        asm volatile("s_waitcnt lgkmcnt(0)" ::: "memory");
    }
    float* o = p.s5xend + s5_idx(b, DIR, pc, g, lane);
    o[0] = xr; o[1] = xi;
}
DEVINL void s5_pass1_unit(const Params& p, char* smem, int b, int pc) {
    const int t = tid_opaque(), w = t >> 6, lane = t & 63, fr = lane & 15, fq = lane >> 4;
    float* BuT = (float*)(smem + w * S5_WAVE_LDS);
    const int row0 = b * RPB + pc * 64;
#pragma unroll 1
    for (int q = 0; q < 4; ++q) {
        const int g = w * 4 + q;
        bf16x8 afr[4];
        s5_load_afr(p, row0, g, fr, fq, afr);
        s5_pass1_task<0>(p, BuT, b, pc, g, afr, lane, fr, fq);
        s5_pass1_task<1>(p, BuT, b, pc, g, afr, lane, fr, fq);
    }
}
DEVINL void s5_scan(const Params& p, int bid, int nb) {
    for (int i = bid * NTHR + tid_opaque(); i < NBATCH * 2 * 32 * 64; i += nb * NTHR) {
        const int pp = i & 63, g = (i >> 6) & 31, di = (i >> 11) & 1, b = i >> 12;
        const float ar = p.a64tab[((di * 32 + g) * 64 + pp) * 2], ai = p.a64tab[((di * 32 + g) * 64 + pp) * 2 + 1];
        float cr = 0.f, ci = 0.f;
#pragma unroll 1
        for (int c0 = 0; c0 < NCH; c0 += 17) {
            float er[17], ei[17];
#pragma unroll
            for (int j = 0; j < 17; ++j) {
                const int ch = c0 + j, pc = di ? (ch < 4 ? 3 - ch : 71 - ch) : ch;
                const size_t ix = s5_idx(b, di, pc, g, pp);
                er[j] = p.s5xend[ix]; ei[j] = p.s5xend[ix + 1];
            }
#pragma unroll
            for (int j = 0; j < 17; ++j) {
                const int ch = c0 + j, pc = di ? (ch < 4 ? 3 - ch : 71 - ch) : ch;
                const size_t ix = s5_idx(b, di, pc, g, pp);
                p.s5carry[ix] = cr; p.s5carry[ix + 1] = ci;
                const float nr = ar * cr - ai * ci + er[j], ni = ar * ci + ai * cr + ei[j];
                cr = nr; ci = ni;
            }
        }
    }
}
template <int DIR>
DEVINL void s5_pass3_task(const Params& p, float* BuT, bf16_t* Xs, int b, int pc, int g, const bf16x8 (&afr)[4], f32x4 (&acc)[4], int lane, int fr, int fq) {
    bf16x8 bfr[8];
    s5_load_bfr(p, DIR, g, fr, fq, bfr);
    bf16x8 cb[4];
#pragma unroll
    for (int ks = 0; ks < 4; ++ks) cb[ks] = *(const bf16x8*)(p.cmt + ((size_t)(g * 16 + fr)) * 256 + DIR * 128 + ks * 32 + fq * 8);
    const float are = p.atab[((DIR * 32 + g) * 64 + lane) * 2], aim = p.atab[((DIR * 32 + g) * 64 + lane) * 2 + 1];
    const size_t cix = s5_idx(b, DIR, pc, g, lane);
    float xr = p.s5carry[cix], xi = p.s5carry[cix + 1];
#pragma unroll
    for (int sbi = 0; sbi < 4; ++sbi) {
        const int sb = DIR ? (3 - sbi) : sbi;
        s5_bu_subblock(BuT, afr[sb], bfr, fr, fq);
        asm volatile("s_waitcnt lgkmcnt(0)" ::: "memory");
        s5_scan16<DIR, true>(BuT, Xs, lane, are, aim, xr, xi);
        asm volatile("s_waitcnt lgkmcnt(0)" ::: "memory");
        f32x4 c = acc[sb];
#pragma unroll
        for (int ks = 0; ks < 4; ++ks) {
            const bf16x8 a = *(const bf16x8*)(Xs + fr * 136 + ks * 32 + fq * 8);
            c = __builtin_amdgcn_mfma_f32_16x16x32_bf16(cb[ks], a, c, 0, 0, 0);
        }
        acc[sb] = c;
        asm volatile("s_waitcnt lgkmcnt(0)" ::: "memory");
    }
}
DEVINL void s5_pass3_unit(const Params& p, char* smem, int b, int pc) {
    const int t = tid_opaque(), w = t >> 6, lane = t & 63, fr = lane & 15, fq = lane >> 4;
    float* BuT = (float*)(smem + w * S5_WAVE_LDS);
    bf16_t* Xs = (bf16_t*)(smem + w * S5_WAVE_LDS + 128 * S5_BU_LD * 4);
    const int row0 = b * RPB + pc * 64;
#pragma unroll 1
    for (int q = 0; q < 4; ++q) {
        const int g = w * 4 + q;
        bf16x8 afr[4];
        s5_load_afr(p, row0, g, fr, fq, afr);
        f32x4 acc[4];
#pragma unroll
        for (int sb = 0; sb < 4; ++sb) acc[sb] = (f32x4){0.f, 0.f, 0.f, 0.f};
        s5_pass3_task<1>(p, BuT, Xs, b, pc, g, afr, acc, lane, fr, fq);
        s5_pass3_task<0>(p, BuT, Xs, b, pc, g, afr, acc, lane, fr, fq);
        const f32x4 d4 = *(const f32x4*)(p.s5_d + g * 16 + fq * 4);
#pragma unroll
        for (int sb = 0; sb < 4; ++sb) {
            const int tok = sb * 16 + fr;
            const u32x2 ub = *(const u32x2*)(p.P + (size_t)(row0 + tok) * 2048 + 1536 + g * 16 + fq * 4);
            f32x4 uv; uv[0] = bf2f((bf16_t)(ub.x & 0xffff)); uv[1] = bf2f((bf16_t)(ub.x >> 16)); uv[2] = bf2f((bf16_t)(ub.y & 0xffff)); uv[3] = bf2f((bf16_t)(ub.y >> 16));
            f32x4 r4;
#pragma unroll
            for (int j = 0; j < 4; ++j) r4[j] = gelu_tanh(acc[sb][j] + d4[j] * uv[j]);
            *(u32x2*)(p.s5a + (size_t)(row0 + tok) * 512 + g * 16 + fq * 4) = pk4(r4);
        }
    }
}

template <int LAYER>
DEVINL void phase_rec1(const Params& p, char* smem, int bid, int nb) {
    if (LAYER == 0) {
        constexpr int NG = 8 * 4 * 2 * 16;
        constexpr int NS5 = NBATCH * NCH;
        for (int u = bid; u < NG + NS5; u += nb) {
            if (u < NG) {
                const int cg = u & 15, dir = (u >> 4) & 1, h = (u >> 5) & 3, b = u >> 7;
                if (dir == 0) rec_pass1_unit<64, true, 0>(p, smem, p.P, b, h, cg, p.gslots, p.gdecs);
                else rec_pass1_unit<64, true, 1>(p, smem, p.P, b, h, cg, p.gslots, p.gdecs);
            } else { const int v = u - NG; s5_pass1_unit(p, smem, v / NCH, v % NCH); }
        }
    } else {
        constexpr int NG = 8 * 8 * 2 * 8;
        for (int u = bid; u < NG; u += nb) {
            const int cg = u & 7, dir = (u >> 3) & 1, h = (u >> 4) & 7, b = u >> 7;
            if (dir == 0) rec_pass1_unit<128, false, 0>(p, smem, p.P, b, h, cg, p.hslots, p.hdecs);
            else rec_pass1_unit<128, false, 1>(p, smem, p.P, b, h, cg, p.hslots, p.hdecs);
        }
    }
}
template <int LAYER>
DEVINL void phase_scan(const Params& p, char* smem, int bid, int nb) {
    if (LAYER == 0) { rec_scan<64, true>(p.gslots, p.gdecs, bid, nb); s5_scan(p, bid, nb); }
    else rec_scan<128, false>(p.hslots, p.hdecs, bid, nb);
}
template <int LAYER>
DEVINL void phase_rec3(const Params& p, char* smem, int bid, int nb) {
    if (LAYER == 0) {
        constexpr int NG = 8 * 4 * 17;
        constexpr int NS5 = NBATCH * NCH;
        for (int u = bid; u < NG + NS5; u += nb) {
            if (u < NG) { const int gi = u % 17, h = (u / 17) & 3, b = u / 68; rec_pass3_unit<64, true>(p, smem, p.P, p.H, b, h, gi, p.gslots, p.gla_norm); }
            else { const int v = u - NG; s5_pass3_unit(p, smem, v / NCH, v % NCH); }
        }
    } else {
        constexpr int NG = 8 * 8 * 8;
        for (int u = bid; u < NG; u += nb) { const int gi = u & 7, h = (u >> 3) & 7, b = u >> 6; rec_pass3_unit<128, false>(p, smem, p.P, p.H, b, h, gi, p.hslots, p.hg_norm); }
    }
}

DEVINL void phase_final(const Params& p, int bid, int nb) {
    const int t = tid_opaque(), w = t >> 6, lane = t & 63;
    for (int rg = bid; rg < NLAT / 8; rg += nb) {
        float* res = p.out + (size_t)(rg * 8 + w) * D;
        f32x4 v[4];
        float ss = 0.f;
#pragma unroll
        for (int i = 0; i < 4; ++i) { v[i] = *(const f32x4*)(res + lane * 4 + i * 256); ss += v[i][0] * v[i][0] + v[i][1] * v[i][1] + v[i][2] * v[i][2] + v[i][3] * v[i][3]; }
#pragma unroll
        for (int o = 32; o >= 1; o >>= 1) ss += __shfl_xor(ss, o);
        const float rstd = rsqrtf(ss * (1.0f / 1024.0f) + EPS);
#pragma unroll
        for (int i = 0; i < 4; ++i) { const f32x4 g4 = *(const f32x4*)(p.final_norm + lane * 4 + i * 256); *(f32x4*)(res + lane * 4 + i * 256) = v[i] * rstd * g4; }
    }
}

constexpr int NPHASE = 23;
constexpr int MEGA_LDS = LDS_BYTES + 16 + 1024;
static_assert(sizeof(Params) <= 1024 && sizeof(Params) % 8 == 0, "params block");
template <int PH>
DEVINL void run_phase(const Params& p, char* smem, int bid, int nb) {
    if (PH == 0) phase_prologue(p, smem, bid, nb);
    if (PH == 1) phase_pre<0>(p, smem, bid, nb);
    if (PH == 2) phase_gemm<0>(p, smem, bid, nb);
    if (PH == 3) phase_rec1<0>(p, smem, bid, nb);
    if (PH == 4) phase_scan<0>(p, smem, bid, nb);
    if (PH == 5) phase_rec3<0>(p, smem, bid, nb);
    if (PH == 6) phase_gemm<1>(p, smem, bid, nb);
    if (PH == 7) phase_gemm<2>(p, smem, bid, nb);
    if (PH == 8) phase_pre<1>(p, smem, bid, nb);
    if (PH == 9) phase_list<0>(p, smem, bid, nb);
    if (PH == 10) phase_moe<0, 1>(p, smem, bid, nb);
    if (PH == 11) phase_moe<0, 2>(p, smem, bid, nb);
    if (PH == 12) phase_pre<2>(p, smem, bid, nb);
    if (PH == 13) phase_gemm<3>(p, smem, bid, nb);
    if (PH == 14) phase_rec1<1>(p, smem, bid, nb);
    if (PH == 15) phase_scan<1>(p, smem, bid, nb);
    if (PH == 16) phase_rec3<1>(p, smem, bid, nb);
    if (PH == 17) phase_gemm<4>(p, smem, bid, nb);
    if (PH == 18) phase_pre<3>(p, smem, bid, nb);
    if (PH == 19) phase_list<1>(p, smem, bid, nb);
    if (PH == 20) phase_moe<1, 1>(p, smem, bid, nb);
    if (PH == 21) phase_moe<1, 2>(p, smem, bid, nb);
    if (PH == 22) phase_final(p, bid, nb);
}

extern __shared__ __attribute__((aligned(16))) char dyn_smem[];

#if ONE_LAUNCH
template <int PH> struct PhaseSeq {
    static DEVINL void run(const Params& p, char* smem, const XcdBarrier& bar) {
        PhaseSeq<PH - 1>::run(p, smem, bar);
        xcd_barrier(bar);
        run_phase<PH>(p, smem, (int)blockIdx.x, (int)gridDim.x);
#ifdef DUP_MASK
        if ((DUP_MASK >> PH) & 1) { xcd_barrier(bar); run_phase<PH>(p, smem, (int)blockIdx.x, (int)gridDim.x); }
#endif
    }
};
template <> struct PhaseSeq<0> {
    static DEVINL void run(const Params& p, char* smem, const XcdBarrier& bar) {
        run_phase<0>(p, smem, (int)blockIdx.x, (int)gridDim.x);
#ifdef DUP_MASK
        if (DUP_MASK & 1) { xcd_barrier(bar); run_phase<0>(p, smem, (int)blockIdx.x, (int)gridDim.x); }
#endif
    }
};
__global__ void __launch_bounds__(NTHR, 2) mega_kernel(Params pk) {
    volatile LAS unsigned* st = (volatile LAS unsigned*)(dyn_smem + LDS_BYTES);
    unsigned long long* lp = (unsigned long long*)(dyn_smem + LDS_BYTES + 16);
    const unsigned long long* ka = (const unsigned long long*)__builtin_amdgcn_kernarg_segment_ptr();
    if (threadIdx.x < sizeof(Params) / 8) lp[threadIdx.x] = ka[threadIdx.x];
    if (threadIdx.x == 0) { st[0] = 0u; st[1] = 0u; st[2] = 0u; st[3] = 0u; }
    __syncthreads();
    const Params& p = *(const Params*)lp;
    XcdBarrier bar = xcd_barrier_post(p.bar, st);
    PhaseSeq<NPHASE - 1>::run(p, dyn_smem, bar);
}
#else
template <int PH>
__global__ void __launch_bounds__(NTHR, 2) phase_kernel(Params p) {
    run_phase<PH>(p, dyn_smem, (int)blockIdx.x, (int)gridDim.x);
}
template <int PH> struct Launcher {
    static void go(const Params& p, int grid, hipStream_t s) {
        Launcher<PH - 1>::go(p, grid, s);
        static bool attr = false;
        if (!attr) { hipFuncSetAttribute((const void*)phase_kernel<PH>, hipFuncAttributeMaxDynamicSharedMemorySize, LDS_BYTES + 16); attr = true; }
        phase_kernel<PH><<<grid, NTHR, LDS_BYTES + 16, s>>>(p);
    }
};
template <> struct Launcher<-1> { static void go(const Params&, int, hipStream_t) {} };
#endif

static size_t align_up(size_t v, size_t a) { return (v + a - 1) / a * a; }

extern "C" void kernel_launch(void* const* d_in, const int* in_sizes, int n_in, void* d_out, int out_size, void* d_ws, size_t ws_size, hipStream_t stream) {
    (void)in_sizes; (void)n_in; (void)out_size;
    Params p;
    memset(&p, 0, sizeof(p));
    const float* const* in = (const float* const*)d_in;
    p.x = in[0]; p.c = in[1]; p.ctx = in[2]; p.c_ctx = in[3]; p.ada_w = in[4]; p.ada_b = in[5]; p.norm_mix = in[6]; p.norm_ffn = in[7];
    p.ab_w_in = in[8]; p.ab_w_out = in[9]; p.gla_a2 = in[10]; p.gla_ab = in[11]; p.gla_norm = in[12];
    p.s5_lam_re = in[13]; p.s5_lam_im = in[14]; p.s5_log_dt = in[15]; p.s5_b_re = in[16]; p.s5_b_im = in[17]; p.s5_c_re = in[18]; p.s5_c_im = in[19];
    p.s5_d = in[20]; p.glu_w = in[21]; p.glu_b = in[22]; p.hg_w_in = in[23]; p.hg_w_out = in[24]; p.hg_lb = in[25]; p.hg_norm = in[26];
    p.router_w = in[27]; p.router_bias = in[28]; p.moe_wg = in[29]; p.moe_wu = in[30]; p.moe_wd = in[31]; p.final_norm = in[32];
    p.out = (float*)d_out;

    char* ws = (char*)d_ws;
    size_t o = 0;
    auto take = [&](size_t bytes) { char* r = ws + o; o = align_up(o + bytes, 256); return r; };
    p.bar = (unsigned*)take(XCD_BAR_WORDS * 4);
    p.cnt = (int*)take(256 * 4);
    p.mod = (float*)take((size_t)2 * 9 * 6144 * 4);
    p.pos = (float*)take(64 * 512 * 4);
    p.lb = (float*)take(1024 * 4);
    p.atab = (float*)take(2 * 32 * 64 * 2 * 4);
    p.a64tab = (float*)take(2 * 32 * 64 * 2 * 4);
    p.bbtab = (float*)take((size_t)2 * 32 * 64 * 32 * 4);
    p.cmt = (bf16_t*)take((size_t)32 * 16 * 256 * 2);
    p.bbm = (bf16_t*)take((size_t)2 * 32 * 128 * 16 * 2);
    p.RT = (float4*)take((size_t)R * 16);
    p.list = (int*)take((size_t)ACT_ROWS * 4);
    p.wl = (float*)take((size_t)ACT_ROWS * 4);
    p.wh = (float*)take((size_t)ACT_ROWS * 4);
    p.cx = (float*)take((size_t)NBATCH * CTXL * D * 4);
    p.wt_in0 = (bf16_t*)take((size_t)2048 * 1024 * 2);
    p.wt_out0 = (bf16_t*)take((size_t)1024 * 1024 * 2);
    p.glu_t = (bf16_t*)take((size_t)512 * 512 * 2);
    p.wt_in1 = (bf16_t*)take((size_t)5120 * 1024 * 2);
    p.wt_out1 = (bf16_t*)take((size_t)1024 * 1024 * 2);
    p.H = (bf16_t*)take((size_t)R * 1024 * 2);
    const size_t big = o;
    p.P = (bf16_t*)(ws + big);
    size_t o0 = big + (size_t)R * 2048 * 2;
    auto take0 = [&](size_t bytes) { char* r = ws + o0; o0 = align_up(o0 + bytes, 256); return r; };
    p.gslots = (float*)take0((size_t)64 * 16 * 128 * 64 * 4);
    p.gdecs = (float*)take0((size_t)64 * 16 * 64 * 4);
    p.s5xend = (float*)take0((size_t)NBATCH * 2 * NCH * 32 * 64 * 2 * 4);
    p.s5carry = (float*)take0((size_t)NBATCH * 2 * NCH * 32 * 64 * 2 * 4);
    p.s5a = (bf16_t*)take0((size_t)R * 512 * 2);
    p.AF = (float*)take0((size_t)R * 32 * 4);
    p.wgu_t = (bf16_t*)take0((size_t)32 * 512 * 1024 * 2);
    p.wd_t = (bf16_t*)take0((size_t)32 * 1024 * 256 * 2);
    p.hs = (bf16_t*)(ws + big);
    p.act = (bf16_t*)(ws + big + (size_t)ACT_ROWS * 1024 * 2);
    if (big + (size_t)ACT_ROWS * 1024 * 2 + (size_t)ACT_ROWS * 512 * 2 > (size_t)((char*)p.s5a - ws)) fprintf(stderr, "moe overlay overlaps live buffers\n");
    size_t o1 = big + (size_t)R * 5120 * 2;
    auto take1 = [&](size_t bytes) { char* r = ws + o1; o1 = align_up(o1 + bytes, 256); return r; };
    p.hslots = (float*)take1((size_t)128 * 8 * 128 * 128 * 4);
    p.hdecs = (float*)take1((size_t)128 * 8 * 128 * 4);
    const size_t need = o0 > o1 ? o0 : o1;
    if (need > ws_size) fprintf(stderr, "workspace too small: need %zu have %zu\n", need, ws_size);

    const int grid = 256;
#if ONE_LAUNCH
    static bool attr = false;
    if (!attr) { hipFuncSetAttribute((const void*)mega_kernel, hipFuncAttributeMaxDynamicSharedMemorySize, MEGA_LDS); attr = true; }
    hipMemsetAsync(p.bar, 0, XCD_BAR_WORDS * 4, stream);
    mega_kernel<<<grid, NTHR, MEGA_LDS, stream>>>(p);
#else
    Launcher<NPHASE - 1>::go(p, grid, stream);
#endif
}
```

```cpp
#include <hip/hip_runtime.h>
#include <stdint.h>
#include <string.h>
#include <stdio.h>

#ifndef ONE_LAUNCH
#define ONE_LAUNCH 1
#endif

typedef unsigned short bf16_t;
typedef short bf16x8 __attribute__((ext_vector_type(8)));
typedef float f32x4 __attribute__((ext_vector_type(4)));
typedef unsigned u32x4 __attribute__((ext_vector_type(4)));
typedef unsigned u32x2 __attribute__((ext_vector_type(2)));
#define DEVINL __device__ __forceinline__

constexpr int D = 1024, NBATCH = 8, SEQ = 4096, CTXL = 256;
constexpr int RPB = SEQ + CTXL;
constexpr int R = NBATCH * RPB;
constexpr int NLAT = NBATCH * SEQ;
constexpr int NCH = RPB / 64;
constexpr float EPS = 1e-6f;
constexpr int NTHR = 512;
constexpr int LDS_BYTES = 136 * 1024;
constexpr int ACT_ROWS = 47104;

#define XB_TMO      128
#define XB_XCNT(j)  (256  + 64 * (j))
#define XB_XSUB(j)  (1280 + 64 * (j))
#define XB_XGEN(j)  (2304 + 64 * (j))
#define XB_TOP      3328
#define XB_TOPGEN   3392
#define XCD_BAR_WORDS 3456
#define XB_SPIN_CAP (1u << 18)
#define LAS __attribute__((address_space(3)))

__device__ __forceinline__ unsigned xb_ld(unsigned* p)              { return __hip_atomic_load(p, __ATOMIC_RELAXED, __HIP_MEMORY_SCOPE_AGENT); }
__device__ __forceinline__ unsigned xb_add(unsigned* p, unsigned v) { return __hip_atomic_fetch_add(p, v, __ATOMIC_RELAXED, __HIP_MEMORY_SCOPE_AGENT); }
__device__ __forceinline__ unsigned xb_xcc_id() { return (unsigned)__builtin_amdgcn_s_getreg((3 << 11) | 20) & 0xFu; }
#define XB_SPIN(cond, bar) do { unsigned _sp = 0; while (cond) { __builtin_amdgcn_s_sleep(1); \
    if ((++_sp & 255u) == 0u) { if (xb_ld(&(bar)[XB_TMO])) break; if (_sp > XB_SPIN_CAP) { atomicAdd(&(bar)[XB_TMO], 1u); break; } } } } while (0)

struct XcdBarrier {
    unsigned* bar; unsigned x;
    volatile LAS unsigned* st;
};
__device__ __forceinline__ XcdBarrier xcd_barrier_post(unsigned* bar, volatile LAS unsigned* st) {
    XcdBarrier b; b.bar = bar; b.x = xb_xcc_id(); b.st = st;
    if (threadIdx.x == 0) (void)xb_add(&bar[XB_XCNT(b.x)], 1u);
    return b;
}
__device__ __forceinline__ void xcd_barrier_complete(unsigned* bar, unsigned x, unsigned& nloc, unsigned& nx) {
    const unsigned G = gridDim.x * gridDim.y * gridDim.z;
    unsigned sum, cnt, mine, sp = 0u;
    for (;;) {
        sum = 0u; cnt = 0u; mine = 0u;
#pragma unroll
        for (unsigned j = 0; j < 16; ++j) { const unsigned c = xb_ld(&bar[XB_XCNT(j)]); sum += c; cnt += (c > 0u) ? 1u : 0u; mine = (j == x) ? c : mine; }
        if (sum == G) break;
        __builtin_amdgcn_s_sleep(1);
        if ((++sp & 255u) == 0u) { if (xb_ld(&bar[XB_TMO])) break; if (sp > XB_SPIN_CAP) { atomicAdd(&bar[XB_TMO], 1u); break; } }
    }
    nloc = mine > 0u ? mine : 1u; nx = cnt > 0u ? cnt : 1u;
}
__device__ __forceinline__ void xcd_barrier(const XcdBarrier& b) {
    asm volatile("s_waitcnt vmcnt(0)" ::: "memory");
    __syncthreads();
    if (threadIdx.x == 0) {
        unsigned* bar = b.bar;
        __builtin_amdgcn_s_waitcnt(0);
        unsigned nloc = b.st[0], nx = b.st[1];
        if (nloc == 0u) { xcd_barrier_complete(bar, b.x, nloc, nx); b.st[0] = nloc; b.st[1] = nx; }
        const unsigned old = xb_add(&bar[XB_XSUB(b.x)], 1u);
        const unsigned gen = old / nloc;
        if (old + 1u == (gen + 1u) * nloc) {
            __builtin_amdgcn_fence(__ATOMIC_RELEASE, "agent");
            asm volatile("s_waitcnt vmcnt(0)" ::: "memory");
            const unsigned og = xb_add(&bar[XB_TOP], 1u);
            const unsigned tg = og / nx;
            if (og + 1u == (tg + 1u) * nx) xb_add(&bar[XB_TOPGEN], 1u);
            else XB_SPIN(xb_ld(&bar[XB_TOPGEN]) == tg, bar);
            __builtin_amdgcn_fence(__ATOMIC_ACQUIRE, "agent");
            xb_add(&bar[XB_XGEN(b.x)], 1u);
            asm volatile("s_waitcnt vmcnt(0)" ::: "memory");
        } else {
            XB_SPIN(xb_ld(&bar[XB_XGEN(b.x)]) == gen, bar);
            __builtin_amdgcn_fence(__ATOMIC_ACQUIRE, "agent");
            asm volatile("s_waitcnt vmcnt(0)" ::: "memory");
        }
    }
    __syncthreads();
}

struct Params {
    const float *x, *c, *ctx, *c_ctx, *ada_w, *ada_b, *norm_mix, *norm_ffn, *ab_w_in, *ab_w_out, *gla_a2, *gla_ab, *gla_norm;
    const float *s5_lam_re, *s5_lam_im, *s5_log_dt, *s5_b_re, *s5_b_im, *s5_c_re, *s5_c_im, *s5_d, *glu_w, *glu_b;
    const float *hg_w_in, *hg_w_out, *hg_lb, *hg_norm, *router_w, *router_bias, *moe_wg, *moe_wu, *moe_wd, *final_norm;
    float* out;
    unsigned* bar;
    int* cnt;
    float *mod, *pos, *lb, *atab, *a64tab, *bbtab;
    bf16_t* cmt; bf16_t* bbm; bf16_t* wrt;
    float4* RT;
    int* list; float *wl, *wh;
    float* cx;
    bf16_t *wt_in0, *wt_out0, *glu_t, *wt_in1, *wt_out1;
    bf16_t* H;
    bf16_t* P;
    float *gslots, *gdecs;
    float *s5xend, *s5carry;
    bf16_t* s5a;
    bf16_t *wgu_t, *wd_t, *act, *hs;
    float* AF;
    float *hslots, *hdecs;
};

DEVINL int tid_opaque() { int t = threadIdx.x; asm volatile("" : "+v"(t)); return t; }
DEVINL int sgpr(int v) { return __builtin_amdgcn_readfirstlane(v); }
template <class T> DEVINL T* sgpr_ptr(T* ptr) {
    const unsigned long long v = (unsigned long long)ptr;
    const unsigned lo = (unsigned)__builtin_amdgcn_readfirstlane((int)(unsigned)v), hi = (unsigned)__builtin_amdgcn_readfirstlane((int)(unsigned)(v >> 32));
    return (T*)(((unsigned long long)hi << 32) | lo);
}
DEVINL unsigned cvt_pk_bf16(float lo, float hi) { unsigned r; asm volatile("v_cvt_pk_bf16_f32 %0, %1, %2" : "=v"(r) : "v"(lo), "v"(hi)); return r; }
DEVINL float bf2f(bf16_t v) { return __uint_as_float(((unsigned)v) << 16); }
DEVINL bf16_t f2bf(float f) { unsigned u = __float_as_uint(f); u += 0x7fffu + ((u >> 16) & 1u); return (bf16_t)(u >> 16); }
DEVINL unsigned pk2(float lo, float hi) { return cvt_pk_bf16(lo, hi); }
DEVINL u32x2 pk4(f32x4 v) { u32x2 r; r.x = pk2(v[0], v[1]); r.y = pk2(v[2], v[3]); return r; }
DEVINL float h2f(unsigned short v) { return (float)__builtin_bit_cast(_Float16, v); }
DEVINL unsigned short f2h(float f) { return __builtin_bit_cast(unsigned short, (_Float16)f); }
DEVINL float sigmoidf_(float x) { return 1.0f / (1.0f + __expf(-x)); }
DEVINL float siluf_(float x) { return x * sigmoidf_(x); }
DEVINL float logsigmoidf_(float x) { return fminf(x, 0.0f) - log1pf(__expf(-fabsf(x))); }
DEVINL float gelu_tanh(float y) { float z = 0.7978845608028654f * (y + 0.044715f * y * y * y); float th = 1.0f - 2.0f / (__expf(2.0f * z) + 1.0f); return 0.5f * y * (1.0f + th); }
DEVINL float* resid_row(const Params& p, int r) {
    const int b = r / RPB, j = r - b * RPB;
    return (j < CTXL) ? (p.cx + (size_t)(b * CTXL + j) * D) : (p.out + (size_t)(b * SEQ + (j - CTXL)) * D);
}
DEVINL int row_batch_mod(int r) { const int b = r / RPB, j = r - b * RPB; return (j < CTXL) ? 8 : b; }

template <int K>
DEVINL f32x4 mma_lds(f32x4 c, const bf16_t* A, int lda, const bf16_t* Bt, int ldb, int fr, int fq) {
#pragma unroll
    for (int k0 = 0; k0 < K; k0 += 32) {
        const bf16x8 a = *(const bf16x8*)(A + fr * lda + k0 + fq * 8);
        const bf16x8 b = *(const bf16x8*)(Bt + fr * ldb + k0 + fq * 8);
        c = __builtin_amdgcn_mfma_f32_16x16x32_bf16(b, a, c, 0, 0, 0);
    }
    return c;
}

DEVINL void cvt_tile64(const float* colp, int ld, int k0, int n0, bf16_t* dst, int ldd, char* smem, int lrow = -1) {
    float (*T)[65] = (float (*)[65])smem;
    const int t = tid_opaque(), nl = lrow >= 0 ? lrow : (t & 63), ks = t >> 6;
    const float* sp = colp + (size_t)(k0 + ks * 8) * ld;
#pragma unroll
    for (int i = 0; i < 8; ++i) T[nl][ks * 8 + i] = sp[(size_t)i * ld];
    __syncthreads();
    const int n2 = t >> 3, kc = t & 7;
    u32x4 v;
    v.x = pk2(T[n2][kc * 8 + 0], T[n2][kc * 8 + 1]); v.y = pk2(T[n2][kc * 8 + 2], T[n2][kc * 8 + 3]);
    v.z = pk2(T[n2][kc * 8 + 4], T[n2][kc * 8 + 5]); v.w = pk2(T[n2][kc * 8 + 6], T[n2][kc * 8 + 7]);
    *(u32x4*)(dst + (size_t)(n0 + n2) * ldd + k0 + kc * 8) = v;
    __syncthreads();
}

constexpr int NT_GU = 4096, NT_WD = 2048;
DEVINL void moe_cvt_task(const Params& p, int layer, int tid, char* smem) {
    if (tid < NT_GU) {
        const int e = tid >> 7, rem = tid & 127, nb = rem >> 4, kb = rem & 15;
        const float* wg = p.moe_wg + (size_t)(layer * 32 + e) * 1024 * 256;
        const float* wu = p.moe_wu + (size_t)(layer * 32 + e) * 1024 * 256;
        const int nl = tid_opaque() & 63, isup = nl >> 5, ul = nl & 31;
        const int ub = (nb >> 2) * 128 + (nb & 3) * 32;
        const float* cp = (isup ? wu : wg) + ub + ul;
        const int lrow = (ul >> 2) * 8 + isup * 4 + (ul & 3);
        cvt_tile64(cp, 256, kb * 64, nb * 64, p.wgu_t + (size_t)e * 512 * 1024, 1024, smem, lrow);
    } else {
        const int t2 = tid - NT_GU, e = t2 >> 6, rem = t2 & 63, nb = rem >> 2, kb = rem & 3;
        const float* wd = p.moe_wd + (size_t)(layer * 32 + e) * 256 * 1024;
        cvt_tile64(wd + nb * 64 + (tid_opaque() & 63), 1024, kb * 64, nb * 64, p.wd_t + (size_t)e * 1024 * 256, 256, smem);
    }
}

constexpr int NT_MOD = 192, NT_IN0 = 512, NT_OUT0 = 256, NT_GLU = 64, NT_IN1 = 1280, NT_OUT1 = 256, NT_POS = 64, NT_S5 = 64, NT_MISC = 1;
constexpr int T0_IN0 = NT_MOD, T0_OUT0 = T0_IN0 + NT_IN0, T0_GLU = T0_OUT0 + NT_OUT0, T0_IN1 = T0_GLU + NT_GLU, T0_OUT1 = T0_IN1 + NT_IN1,
              T0_MOE = T0_OUT1 + NT_OUT1, T0_POS = T0_MOE + NT_GU + NT_WD, T0_S5 = T0_POS + NT_POS, T0_MISC = T0_S5 + NT_S5, T0_END = T0_MISC + NT_MISC;

DEVINL void phase_prologue(const Params& p, char* smem, int bid, int nb) {
    const int t = tid_opaque();
    bool have_sc = false;
    for (int task = bid; task < T0_END; task += nb) {
        if (task < NT_MOD) {
            float* sc = (float*)smem;
            float* red = sc + 9 * 1024;
            if (!have_sc) {
                for (int i = t; i < 9 * 1024; i += NTHR) { const int rr = i >> 10, k = i & 1023; const float v = rr < 8 ? p.c[rr * 1024 + k] : p.c_ctx[k]; sc[i] = siluf_(v); }
                have_sc = true;
                __syncthreads();
            }
            const int l = task / 96, c0 = (task % 96) * 64, col = t & 63, kp = t >> 6;
            const float* wp = p.ada_w + ((size_t)l * 1024 + kp * 128) * 6144 + c0 + col;
            float acc[9];
#pragma unroll
            for (int rr = 0; rr < 9; ++rr) acc[rr] = 0.f;
            for (int k = 0; k < 128; ++k) {
                const float w = wp[(size_t)k * 6144];
#pragma unroll
                for (int rr = 0; rr < 9; ++rr) acc[rr] += sc[rr * 1024 + kp * 128 + k] * w;
            }
#pragma unroll
            for (int rr = 0; rr < 9; ++rr) red[(kp * 9 + rr) * 64 + col] = acc[rr];
            __syncthreads();
            for (int o = t; o < 576; o += NTHR) {
                const int rr = o >> 6, cc = o & 63;
                float s = p.ada_b[l * 6144 + c0 + cc];
#pragma unroll
                for (int q = 0; q < 8; ++q) s += red[(q * 9 + rr) * 64 + cc];
                p.mod[((size_t)l * 9 + rr) * 6144 + c0 + cc] = s;
            }
            __syncthreads();
        } else if (task < T0_OUT0) {
            const int tt = task - T0_IN0, nbk = tt >> 4, kb = tt & 15;
            const int n = nbk * 64 + (t & 63);
            const float* cp = p.ab_w_in + (n < 1536 ? n : n + 32);
            cvt_tile64(cp, 2080, kb * 64, nbk * 64, p.wt_in0, 1024, smem);
        } else if (task < T0_GLU) {
            const int tt = task - T0_OUT0, nbk = tt >> 4, kb = tt & 15;
            const float* cp = p.ab_w_out + nbk * 64 + (t & 63);
            cvt_tile64(cp, 1024, kb * 64, nbk * 64, p.wt_out0, 1024, smem);
        } else if (task < T0_IN1) {
            const int tt = task - T0_GLU, nbk = tt >> 3, kb = tt & 7;
            const float* cp = p.glu_w + nbk * 64 + (t & 63);
            cvt_tile64(cp, 512, kb * 64, nbk * 64, p.glu_t, 512, smem);
        } else if (task < T0_OUT1) {
            const int tt = task - T0_IN1, nbk = tt >> 4, kb = tt & 15;
            const float* cp = p.hg_w_in + nbk * 64 + (t & 63);
            cvt_tile64(cp, 5120, kb * 64, nbk * 64, p.wt_in1, 1024, smem);
        } else if (task < T0_MOE) {
            const int tt = task - T0_OUT1, nbk = tt >> 4, kb = tt & 15;
            const float* cp = p.hg_w_out + nbk * 64 + (t & 63);
            cvt_tile64(cp, 1024, kb * 64, nbk * 64, p.wt_out1, 1024, smem);
        } else if (task < T0_POS) {
            moe_cvt_task(p, 0, task - T0_MOE, smem);
        } else if (task < T0_S5) {
            const int pi = task - T0_POS;
            const int j = t, jj = j & 255;
            const float omega = __expf(-9.210340371976184f * (float)jj * (1.0f / 256.0f));
            const float ang = (float)pi * omega;
            p.pos[pi * 512 + j] = (j < 256) ? sinf(ang) : cosf(ang);
        } else if (task < T0_MISC) {
            const int tt = task - T0_S5, di = tt >> 5, g = tt & 31;
            const int pp = t & 63, hs = t >> 6;
            const float dt = __expf(p.s5_log_dt[di * 32 + g]);
            const float lr = p.s5_lam_re[(di * 32 + g) * 64 + pp], li = p.s5_lam_im[(di * 32 + g) * 64 + pp];
            const float mag = __expf(lr * dt);
            const float are = mag * cosf(li * dt), aim = mag * sinf(li * dt);
            const float den = lr * lr + li * li;
            const float fre = ((are - 1.0f) * lr + aim * li) / den;
            const float fim = (aim * lr - (are - 1.0f) * li) / den;
            if (hs == 0) {
                p.atab[((di * 32 + g) * 64 + pp) * 2 + 0] = are; p.atab[((di * 32 + g) * 64 + pp) * 2 + 1] = aim;
                float xr = are, xi = aim;
#pragma unroll
                for (int q = 0; q < 6; ++q) { const float nr = xr * xr - xi * xi, ni = 2.0f * xr * xi; xr = nr; xi = ni; }
                p.a64tab[((di * 32 + g) * 64 + pp) * 2 + 0] = xr; p.a64tab[((di * 32 + g) * 64 + pp) * 2 + 1] = xi;
            }
#pragma unroll
            for (int q = 0; q < 2; ++q) {
                const int h = hs * 2 + q;
                const float bre = p.s5_b_re[((size_t)((di * 32 + g) * 64 + pp)) * 16 + h], bim = p.s5_b_im[((size_t)((di * 32 + g) * 64 + pp)) * 16 + h];
                float* bt = p.bbtab + ((size_t)((di * 32 + g) * 64 + pp)) * 32;
                bt[h * 2 + 0] = fre * bre - fim * bim;
                bt[h * 2 + 1] = fre * bim + fim * bre;
                p.bbm[((size_t)((di * 32 + g) * 128 + pp)) * 16 + h] = f2bf(fre * bre - fim * bim);
                p.bbm[((size_t)((di * 32 + g) * 128 + 64 + pp)) * 16 + h] = f2bf(fre * bim + fim * bre);
                const float cre = p.s5_c_re[((size_t)((di * 32 + g) * 16 + h)) * 64 + pp], cim = p.s5_c_im[((size_t)((di * 32 + g) * 16 + h)) * 64 + pp];
                bf16_t* cm = p.cmt + ((size_t)(g * 16 + h)) * 256 + di * 128;
                cm[pp] = f2bf(cre); cm[64 + pp] = f2bf(-cim);
            }
        } else {
            for (int i = t; i < 1024; i += NTHR) p.lb[i] = sigmoidf_(p.hg_lb[1024 + i] - p.hg_lb[i]);
            if (t < 256) p.cnt[t] = 0;
            for (int i = t; i < 2 * 32 * 1024; i += NTHR) {
                const int which = i >> 15, e = (i >> 10) & 31, k = i & 1023;
                const float v = which ? p.ab_w_in[(size_t)k * 2080 + 1536 + e] : p.router_w[k * 32 + e];
                const bf16_t hi = f2bf(v); const bf16_t lo = f2bf(v - bf2f(hi));
                p.wrt[((size_t)(which * 2 + 0) * 32 + e) * 1024 + k] = hi;
                p.wrt[((size_t)(which * 2 + 1) * 32 + e) * 1024 + k] = lo;
            }
        }
    }
}

constexpr int PRE_LD = 1028;
template <int MODE>
DEVINL void phase_pre(const Params& p, char* smem, int bid, int nb) {
    constexpr bool GEMV = (MODE == 0 || MODE == 1 || MODE == 3);
    constexpr int L = (MODE >= 2) ? 1 : 0;
    constexpr bool FFN = (MODE == 1 || MODE == 3);
    float* hrow = (float*)smem;
    float* part = hrow + 16 * PRE_LD;
    float* logit = part + 8 * 16 * 32;
    int* lcnt = (int*)(logit + 512);
    static_assert((16 * PRE_LD + 8 * 16 * 32 + 512 + 64) * 4 <= LDS_BYTES, "pre lds");
    const int t = tid_opaque(), w = t >> 6, lane = t & 63, fr = lane & 15, fq = lane >> 4;
    bf16x8 bh[4][2], bl[4][2];
    if (GEMV) {
        const bf16_t* wt = p.wrt + (size_t)(MODE == 0 ? 1 : 0) * 2 * 32 * 1024;
#pragma unroll
        for (int ks = 0; ks < 4; ++ks)
#pragma unroll
            for (int nt = 0; nt < 2; ++nt) {
                const size_t off = (size_t)(nt * 16 + fr) * 1024 + w * 128 + ks * 32 + fq * 8;
                bh[ks][nt] = *(const bf16x8*)(wt + off);
                bl[ks][nt] = *(const bf16x8*)(wt + 32 * 1024 + off);
            }
    }
    if (FFN) { if (t < 64) lcnt[t] = 0; }
    __syncthreads();
    const float* gain = (FFN ? p.norm_ffn : p.norm_mix) + L * 1024;
    const int ngroups = (MODE == 3) ? (NLAT / 16) : (R / 16);
    for (int rg = bid; rg < ngroups; rg += nb) {
#pragma unroll
        for (int rw = 0; rw < 2; ++rw) {
            const int lrow = w * 2 + rw;
            int r;
            if (MODE == 3) { const int i = rg * 16 + lrow; r = (i >> 12) * RPB + CTXL + (i & 4095); } else r = rg * 16 + lrow;
            const int b = r / RPB, j = r - b * RPB;
            const bool isctx = j < CTXL;
            const float* modv = p.mod + ((size_t)(L * 9 + (isctx ? 8 : b))) * 6144 + (FFN ? 3072 : 0);
            float* res = isctx ? (p.cx + (size_t)(b * CTXL + j) * D) : (p.out + (size_t)(b * SEQ + (j - CTXL)) * D);
            f32x4 v[4];
            if (MODE == 0) {
                const float* src = isctx ? (p.ctx + (size_t)(b * CTXL + j) * D) : (p.x + (size_t)(b * SEQ + (j - CTXL)) * D);
#pragma unroll
                for (int i = 0; i < 4; ++i) v[i] = *(const f32x4*)(src + lane * 4 + i * 256);
                if (!isctx) {
                    const int n = j - CTXL, prow = n >> 6, pcol = n & 63;
#pragma unroll
                    for (int i = 0; i < 4; ++i) {
                        const int c = lane * 4 + i * 256;
                        const f32x4 pe = (c < 512) ? *(const f32x4*)(p.pos + prow * 512 + c) : *(const f32x4*)(p.pos + pcol * 512 + (c - 512));
                        v[i] += pe;
                    }
                }
#pragma unroll
                for (int i = 0; i < 4; ++i) *(f32x4*)(res + lane * 4 + i * 256) = v[i];
            } else {
#pragma unroll
                for (int i = 0; i < 4; ++i) v[i] = *(const f32x4*)(res + lane * 4 + i * 256);
            }
            float ss = 0.f;
#pragma unroll
            for (int i = 0; i < 4; ++i) ss += v[i][0] * v[i][0] + v[i][1] * v[i][1] + v[i][2] * v[i][2] + v[i][3] * v[i][3];
#pragma unroll
            for (int o = 32; o >= 1; o >>= 1) ss += __shfl_xor(ss, o);
            const float rstd = rsqrtf(ss * (1.0f / 1024.0f) + EPS);
#pragma unroll
            for (int i = 0; i < 4; ++i) {
                const int c = lane * 4 + i * 256;
                const f32x4 g4 = *(const f32x4*)(gain + c), sh4 = *(const f32x4*)(modv + c), sc4 = *(const f32x4*)(modv + 1024 + c);
                f32x4 hv;
#pragma unroll
                for (int q = 0; q < 4; ++q) hv[q] = v[i][q] * rstd * g4[q] * (1.0f + sc4[q]) + sh4[q];
                *(u32x2*)(p.H + (size_t)r * D + c) = pk4(hv);
                if (GEMV) *(f32x4*)(hrow + lrow * PRE_LD + c) = hv;
            }
        }
        if (GEMV) {
            __syncthreads();
            f32x4 c0 = (f32x4){0.f, 0.f, 0.f, 0.f}, c1 = c0;
#pragma unroll
            for (int ks = 0; ks < 4; ++ks) {
                const float* hp = hrow + fr * PRE_LD + w * 128 + ks * 32 + fq * 8;
                const f32x4 x0 = *(const f32x4*)hp, x1 = *(const f32x4*)(hp + 4);
                u32x4 hi, lo;
                hi.x = cvt_pk_bf16(x0[0], x0[1]); hi.y = cvt_pk_bf16(x0[2], x0[3]); hi.z = cvt_pk_bf16(x1[0], x1[1]); hi.w = cvt_pk_bf16(x1[2], x1[3]);
                lo.x = cvt_pk_bf16(x0[0] - __uint_as_float(hi.x << 16), x0[1] - __uint_as_float(hi.x & 0xffff0000u));
                lo.y = cvt_pk_bf16(x0[2] - __uint_as_float(hi.y << 16), x0[3] - __uint_as_float(hi.y & 0xffff0000u));
                lo.z = cvt_pk_bf16(x1[0] - __uint_as_float(hi.z << 16), x1[1] - __uint_as_float(hi.z & 0xffff0000u));
                lo.w = cvt_pk_bf16(x1[2] - __uint_as_float(hi.w << 16), x1[3] - __uint_as_float(hi.w & 0xffff0000u));
                const bf16x8 ah = __builtin_bit_cast(bf16x8, hi), al = __builtin_bit_cast(bf16x8, lo);
                c0 = __builtin_amdgcn_mfma_f32_16x16x32_bf16(bh[ks][0], ah, c0, 0, 0, 0);
                c0 = __builtin_amdgcn_mfma_f32_16x16x32_bf16(bl[ks][0], ah, c0, 0, 0, 0);
                c0 = __builtin_amdgcn_mfma_f32_16x16x32_bf16(bh[ks][0], al, c0, 0, 0, 0);
                c1 = __builtin_amdgcn_mfma_f32_16x16x32_bf16(bh[ks][1], ah, c1, 0, 0, 0);
                c1 = __builtin_amdgcn_mfma_f32_16x16x32_bf16(bl[ks][1], ah, c1, 0, 0, 0);
                c1 = __builtin_amdgcn_mfma_f32_16x16x32_bf16(bh[ks][1], al, c1, 0, 0, 0);
            }
            *(f32x4*)&part[(w * 16 + fr) * 32 + fq * 4] = c0;
            *(f32x4*)&part[(w * 16 + fr) * 32 + 16 + fq * 4] = c1;
            __syncthreads();
            {
                const int row = t >> 5, e2 = t & 31;
                float s = 0.f;
#pragma unroll
                for (int q = 0; q < 8; ++q) s += part[(q * 16 + row) * 32 + e2];
                if (MODE == 0) p.AF[(size_t)(rg * 16 + row) * 32 + e2] = s;
                else logit[row * 32 + e2] = s;
            }
            if (FFN) {
                __syncthreads();
                if (t < 16) {
                    int rr;
                    if (MODE == 3) { const int i = rg * 16 + t; rr = (i >> 12) * RPB + CTXL + (i & 4095); } else rr = rg * 16 + t;
                    float best = -3.0e38f; int bg = 0, bi1 = 0, bi2 = 1; float ba1 = 0.f, ba2 = 0.f;
#pragma unroll 1
                    for (int g = 0; g < 8; ++g) {
                        float m1 = -3.0e38f, m2 = -3.0e38f, a1 = 0.f, a2 = 0.f; int i1 = 0, i2 = 0;
#pragma unroll
                        for (int e = 0; e < 4; ++e) {
                            const float a = sigmoidf_(logit[t * 32 + g * 4 + e]);
                            const float sv = a + p.router_bias[g * 4 + e];
                            if (sv > m1) { m2 = m1; i2 = i1; a2 = a1; m1 = sv; i1 = e; a1 = a; }
                            else if (sv > m2) { m2 = sv; i2 = e; a2 = a; }
                        }
                        const float gs = m1 + m2;
                        if (gs > best) { best = gs; bg = g; bi1 = i1; bi2 = i2; ba1 = a1; ba2 = a2; }
                    }
                    const float inv = 1.0f / (ba1 + ba2);
                    const float w1 = ba1 * inv, w2 = ba2 * inv;
                    const int lo = bi1 < bi2 ? bi1 : bi2, hi = bi1 < bi2 ? bi2 : bi1;
                    const float wlo = bi1 < bi2 ? w1 : w2, whi = bi1 < bi2 ? w2 : w1;
                    const int pair = (lo == 0) ? (hi - 1) : (lo == 1 ? (hi + 1) : 5);
                    const int bucket = bg * 6 + pair;
                    float4 rec; rec.x = __int_as_float(bucket); rec.y = wlo; rec.z = whi; rec.w = 0.f;
                    p.RT[rr] = rec;
                    atomicAdd(&lcnt[bucket], 1);
                }
            }
            __syncthreads();
        }
    }
    if (FFN) {
        __syncthreads();
        if (t < 48 && lcnt[t] != 0) atomicAdd(&p.cnt[L * 64 + t], lcnt[t]);
    }
    if (MODE == 3) {
        __syncthreads();
        for (int task = bid; task < NT_GU + NT_WD; task += nb) moe_cvt_task(p, 1, task, smem);
    }
}

struct GemmSmem { bf16_t A[2][128][72]; bf16_t B[2][256][72]; };
static_assert(sizeof(GemmSmem) <= LDS_BYTES, "gemm lds");

template <class Epi>
DEVINL void gemm_tile(const bf16_t* __restrict__ A, int lda, const int* __restrict__ rowlist, int m0, int mvalid,
                      const bf16_t* __restrict__ Bt0, const bf16_t* __restrict__ Bt1, int ldb, int kseg, int K, Epi& epi, char* smem) {
    GemmSmem& S = *(GemmSmem*)smem;
    const int t = tid_opaque(), w = t >> 6, lane = t & 63, fr = lane & 15, fq = lane >> 4, wr = w >> 2, wc = w & 3;
    const int ch = t & 7, rr = t >> 3;
    const bf16_t* ap[2];
#pragma unroll
    for (int i = 0; i < 2; ++i) {
        const int ri = rr + i * 64, gi = ri < mvalid ? ri : 0;
        const int grow = rowlist ? rowlist[m0 + gi] : (m0 + gi);
        ap[i] = A + (size_t)grow * lda + ch * 8;
    }
    u32x4 ra[2], rb[4];
    f32x4 acc[4][4];
#pragma unroll
    for (int m = 0; m < 4; ++m)
#pragma unroll
        for (int n = 0; n < 4; ++n) acc[m][n] = (f32x4){0.f, 0.f, 0.f, 0.f};
    const int nk = K >> 6;
#define GT_GLOAD(kt) do { const int _k0 = (kt) * 64; \
        _Pragma("unroll") for (int i = 0; i < 2; ++i) ra[i] = *(const u32x4*)(ap[i] + _k0); \
        const bf16_t* _bb = (_k0 < kseg) ? (Bt0 + _k0) : (Bt1 + (_k0 - kseg)); \
        _Pragma("unroll") for (int i = 0; i < 4; ++i) rb[i] = *(const u32x4*)(_bb + (size_t)(rr + i * 64) * ldb + ch * 8); } while (0)
#define GT_SSTORE(buf) do { \
        _Pragma("unroll") for (int i = 0; i < 2; ++i) *(u32x4*)&S.A[buf][rr + i * 64][ch * 8] = ra[i]; \
        _Pragma("unroll") for (int i = 0; i < 4; ++i) *(u32x4*)&S.B[buf][rr + i * 64][ch * 8] = rb[i]; } while (0)
    GT_GLOAD(0);
    GT_SSTORE(0);
    __syncthreads();
    for (int kt = 0; kt < nk; ++kt) {
        const int cur = kt & 1;
        if (kt + 1 < nk) GT_GLOAD(kt + 1);
#pragma unroll
        for (int kk = 0; kk < 2; ++kk) {
            bf16x8 a[4], b[4];
#pragma unroll
            for (int m = 0; m < 4; ++m) a[m] = *(const bf16x8*)&S.A[cur][wr * 64 + m * 16 + fr][kk * 32 + fq * 8];
#pragma unroll
            for (int n = 0; n < 4; ++n) b[n] = *(const bf16x8*)&S.B[cur][wc * 64 + n * 16 + fr][kk * 32 + fq * 8];
#pragma unroll
            for (int m = 0; m < 4; ++m)
#pragma unroll
                for (int n = 0; n < 4; ++n) acc[m][n] = __builtin_amdgcn_mfma_f32_16x16x32_bf16(b[n], a[m], acc[m][n], 0, 0, 0);
        }
        if (kt + 1 < nk) GT_SSTORE(cur ^ 1);
        __syncthreads();
    }
#undef GT_GLOAD
#undef GT_SSTORE
    epi(acc, wr * 64, wc * 64, fr, fq);
}

struct EpiP0 {
    bf16_t* P; int m0, n0;
    DEVINL void operator()(const f32x4 (&acc)[4][4], int mb, int nbs, int fr, int fq) const {
        const float sc = (n0 < 256) ? 0.125f : 1.0f;
#pragma unroll
        for (int m = 0; m < 4; ++m) {
            bf16_t* rp = P + (size_t)(m0 + mb + m * 16 + fr) * 2048 + n0 + nbs + fq * 4;
#pragma unroll
            for (int n = 0; n < 4; ++n) *(u32x2*)(rp + n * 16) = pk4(acc[m][n] * sc);
        }
    }
};
struct EpiP1 {
    bf16_t* P; const float* lb; int m0, n0;
    DEVINL void operator()(const f32x4 (&acc)[4][4], int mb, int nbs, int fr, int fq) const {
        const int cb = n0 >> 10;
#pragma unroll
        for (int m = 0; m < 4; ++m) {
            bf16_t* rp = P + (size_t)(m0 + mb + m * 16 + fr) * 5120 + n0 + nbs + fq * 4;
#pragma unroll
            for (int n = 0; n < 4; ++n) {
                const f32x4 a = acc[m][n];
                u32x2 o;
                if (cb == 1 || cb == 2) {
                    const int cc = ((n0 + nbs + n * 16 + fq * 4) & 1023);
                    const f32x4 l4 = *(const f32x4*)(lb + cc);
                    unsigned short hv[4];
#pragma unroll
                    for (int j = 0; j < 4; ++j) hv[j] = f2h((1.0f - l4[j]) * sigmoidf_(-a[j]));
                    o.x = (unsigned)hv[0] | ((unsigned)hv[1] << 16); o.y = (unsigned)hv[2] | ((unsigned)hv[3] << 16);
                } else if (cb == 0 || cb == 4) {
                    f32x4 s;
#pragma unroll
                    for (int j = 0; j < 4; ++j) s[j] = siluf_(a[j]);
                    o = pk4(s);
                } else o = pk4(a);
                *(u32x2*)(rp + n * 16) = o;
            }
        }
    }
};
struct EpiGlu {
    bf16_t* CAT; const bf16_t* s5a; const float* gb; int m0, n0;
    DEVINL void operator()(const f32x4 (&acc)[4][4], int mb, int nbs, int fr, int fq) const {
#pragma unroll
        for (int m = 0; m < 4; ++m) {
            const size_t row = (size_t)(m0 + mb + m * 16 + fr);
#pragma unroll
            for (int n = 0; n < 4; ++n) {
                const int col = n0 + nbs + n * 16 + fq * 4;
                const u32x2 av = *(const u32x2*)(s5a + row * 512 + col);
                const f32x4 b4 = *(const f32x4*)(gb + col);
                f32x4 o;
                o[0] = bf2f((bf16_t)(av.x & 0xffff)) * sigmoidf_(acc[m][n][0] + b4[0]);
                o[1] = bf2f((bf16_t)(av.x >> 16)) * sigmoidf_(acc[m][n][1] + b4[1]);
                o[2] = bf2f((bf16_t)(av.y & 0xffff)) * sigmoidf_(acc[m][n][2] + b4[2]);
                o[3] = bf2f((bf16_t)(av.y >> 16)) * sigmoidf_(acc[m][n][3] + b4[3]);
                *(u32x2*)(CAT + row * 1024 + 512 + col) = pk4(o);
            }
        }
    }
};
struct EpiOut {
    const Params* p; const float* gate; int m0, n0;
    DEVINL void operator()(const f32x4 (&acc)[4][4], int mb, int nbs, int fr, int fq) const {
#pragma unroll
        for (int m = 0; m < 4; ++m) {
            const int r = m0 + mb + m * 16 + fr;
            float* rp = resid_row(*p, r);
            const float* gp = gate + (size_t)row_batch_mod(r) * 6144;
#pragma unroll
            for (int n = 0; n < 4; ++n) {
                const int col = n0 + nbs + n * 16 + fq * 4;
                const f32x4 g4 = *(const f32x4*)(gp + col);
                f32x4 x4 = *(f32x4*)(rp + col);
                x4 += g4 * acc[m][n];
                *(f32x4*)(rp + col) = x4;
            }
        }
    }
};
struct EpiMoe1 {
    bf16_t* act; const float* wsel; int m0, mvalid, colbase;
    DEVINL void operator()(const f32x4 (&acc)[4][4], int mb, int nbs, int fr, int fq) const {
#pragma unroll
        for (int m = 0; m < 4; ++m) {
            const int lr = mb + m * 16 + fr;
            if (lr < mvalid) {
                const int slot = m0 + lr;
                const float wv = wsel[slot];
#pragma unroll
                for (int nn = 0; nn < 2; ++nn) {
                    f32x4 o;
#pragma unroll
                    for (int j = 0; j < 4; ++j) o[j] = wv * siluf_(acc[m][2 * nn][j]) * acc[m][2 * nn + 1][j];
                    *(u32x2*)(act + (size_t)slot * 512 + colbase + (nbs >> 1) + nn * 16 + fq * 4) = pk4(o);
                }
            }
        }
    }
};
struct EpiMoe2 {
    const Params* p; const float* gate; const int* list; int m0, mvalid, n0;
    DEVINL void operator()(const f32x4 (&acc)[4][4], int mb, int nbs, int fr, int fq) const {
#pragma unroll
        for (int m = 0; m < 4; ++m) {
            const int lr = mb + m * 16 + fr;
            if (lr < mvalid) {
                const int r = list[m0 + lr];
                float* rp = resid_row(*p, r);
                const float* gp = gate + (size_t)row_batch_mod(r) * 6144;
#pragma unroll
                for (int n = 0; n < 4; ++n) {
                    const int col = n0 + nbs + n * 16 + fq * 4;
                    const f32x4 g4 = *(const f32x4*)(gp + col);
                    f32x4 x4 = *(f32x4*)(rp + col);
                    x4 += g4 * acc[m][n];
                    *(f32x4*)(rp + col) = x4;
                }
            }
        }
    }
};

namespace pg8 {
#define PG8_LAS __attribute__((address_space(3)))
constexpr int BM = 256, BK = 64, HALF = 128, HTB = HALF * BK * 2, STAGE_BYTES = 8 * HTB, NXCD = 8, WGM = 8;
DEVINL int lds_byte(int r, int c) { const int st = (r >> 4) * 2 + (c >> 5), rr = r & 15, cc = c & 31, ob = rr * 64 + cc * 2; return st * 1024 + (ob ^ (((ob >> 9) & 1) << 5)); }
DEVINL void stage_rc(int b, int& R_, int& C_) { const int st = b / 1024, sb = b % 1024, swz = sb ^ (((sb >> 9) & 1) << 5); R_ = (st >> 1) * 16 + swz / 64; C_ = (st & 1) * 32 + (swz % 64) / 2; }
DEVINL int perm32(int rho) { const int n = rho >> 4, i = rho & 15; return 8 * (i >> 2) + 4 * n + (i & 3); }
struct Unit { int pm, pn; const char* A; const char* B0; const char* B1; int mvalid, aux; };

template <class Epi, class Sched>
DEVINL void gemm_phase(PG8_LAS unsigned char* lds, const Sched& S, const Epi& E) {
    const int tid = tid_opaque(), wid = __builtin_amdgcn_readfirstlane(tid >> 6), lane = tid & 63, wr = wid >> 2, wc = wid & 3, fr = lane & 15, fq = lane >> 4;
    const int K = S.K, nt = K / BK, ldb = S.ldb, ksplit = S.ksplit;
    unsigned voffA[2], voffB[2];
#pragma unroll
    for (int i = 0; i < 2; ++i) { int R_, C_; stage_rc(tid * 16 + i * 8192, R_, C_); const int Rb = Epi::PERM ? ((R_ & ~31) + perm32(R_ & 31)) : R_;
        voffA[i] = (unsigned)(R_ * K + C_) * 2u; voffB[i] = (unsigned)(Rb * ldb + C_) * 2u; }
    const size_t kstep = (size_t)(BK * 2);
    const size_t hstepA = (size_t)HALF * K * 2, hstepB = (size_t)HALF * ldb * 2;
    const unsigned ldsw = (unsigned)wid * 1024u;
    const int aoff = lds_byte(wr * 64 + fr, fq * 8), boff = lds_byte(wc * 32 + fr, fq * 8);
#define PG8_SA(b, h) (((b) * 2 + (h)) * HTB)
#define PG8_SB(b, h) ((4 + (b) * 2 + (h)) * HTB)
#define PG8_STAGE(bufoff, gbase, voff) do { _Pragma("unroll") for (int _i = 0; _i < 2; ++_i) \
        __builtin_amdgcn_global_load_lds((const unsigned*)((const char*)(gbase) + (voff)[_i]), (PG8_LAS unsigned*)(lds + (bufoff) + ldsw + _i * 8192), 16, 0, 0); } while (0)
#define PG8_LDA(dst, b, h) do { _Pragma("unroll") for (int m = 0; m < 4; ++m) _Pragma("unroll") for (int k = 0; k < 2; ++k) dst[m][k] = *(const PG8_LAS bf16x8*)(lds + PG8_SA(b, h) + aoff + m * 2048 + k * 1024); } while (0)
#define PG8_LDB(dst, b, h) do { _Pragma("unroll") for (int n = 0; n < 2; ++n) _Pragma("unroll") for (int k = 0; k < 2; ++k) dst[n][k] = *(const PG8_LAS bf16x8*)(lds + PG8_SB(b, h) + boff + n * 2048 + k * 1024); } while (0)
#define PG8_MMA(ai, bj, At, Bt) do { __builtin_amdgcn_s_setprio(1); _Pragma("unroll") for (int m = 0; m < 4; ++m) _Pragma("unroll") for (int n = 0; n < 2; ++n) _Pragma("unroll") for (int k = 0; k < 2; ++k) \
        acc[ai][bj][m][n] = __builtin_amdgcn_mfma_f32_16x16x32_bf16(Bt[n][k], At[m][k], acc[ai][bj][m][n], 0, 0, 0); __builtin_amdgcn_s_setprio(0); } while (0)
#define PG8_WAIT_V(n) asm volatile("s_waitcnt vmcnt(" #n ")" ::: "memory")
#define PG8_WAIT_L(n) asm volatile("s_waitcnt lgkmcnt(" #n ")" ::: "memory")
#define PG8_BAR __builtin_amdgcn_s_barrier()
#define PG8_SCHED __builtin_amdgcn_sched_barrier(0)
#define PG8_BPTR(u, kt) (((kt) < ksplit ? (u).B0 : (u).B1) + (size_t)(kt) * kstep)
    Unit cur, nxt; int ui = 0;
    if (!S.next(0, cur)) return;
    f32x4 acc[2][2][4][2];
#pragma unroll
    for (int a = 0; a < 2; ++a)
#pragma unroll
        for (int b = 0; b < 2; ++b)
#pragma unroll
            for (int m = 0; m < 4; ++m)
#pragma unroll
                for (int n = 0; n < 2; ++n) acc[a][b][m][n] = (f32x4){0.f, 0.f, 0.f, 0.f};
    bf16x8 At[4][2], B0[2][2], B1[2][2];
    const char* cA = cur.A;
    { const char* cB0 = PG8_BPTR(cur, 0); const char* cB1 = PG8_BPTR(cur, 1);
      PG8_STAGE(PG8_SB(0, 0), cB0, voffB); PG8_STAGE(PG8_SA(0, 0), cA, voffA); PG8_STAGE(PG8_SB(0, 1), cB0 + hstepB, voffB); PG8_STAGE(PG8_SA(0, 1), cA + hstepA, voffA);
      if (wr == 1) PG8_BAR;
      PG8_WAIT_V(4); PG8_BAR;
      PG8_STAGE(PG8_SB(1, 0), cB1, voffB); PG8_STAGE(PG8_SA(1, 0), cA + kstep, voffA); PG8_STAGE(PG8_SB(1, 1), cB1 + hstepB, voffB);
      PG8_WAIT_V(6); PG8_BAR; }
    for (;;) {
        const bool has_next = S.next(ui + 1, nxt);
        if (!has_next) nxt = cur;
        const char* nA = nxt.A;
        for (int t = 0; t < nt; t += 2) {
            const bool last = (t == nt - 2);
            const char* a1 = cA + (size_t)(t + 1) * kstep;
            const char* a2 = last ? nA : cA + (size_t)(t + 2) * kstep;
            const char* b2 = last ? PG8_BPTR(nxt, 0) : PG8_BPTR(cur, t + 2);
            const char* a3 = a2 + kstep;
            const char* b3 = last ? PG8_BPTR(nxt, 1) : PG8_BPTR(cur, t + 3);
            PG8_LDB(B0, 0, 0); PG8_SCHED; PG8_LDA(At, 0, 0); PG8_STAGE(PG8_SA(1, 1), a1 + hstepA, voffA);
            PG8_WAIT_L(8); PG8_BAR; PG8_WAIT_L(0); PG8_MMA(0, 0, At, B0); PG8_BAR; PG8_SCHED;
            PG8_LDB(B1, 0, 1); PG8_STAGE(PG8_SB(0, 0), b2, voffB);
            PG8_BAR; PG8_WAIT_L(0); PG8_MMA(0, 1, At, B1); PG8_BAR;
            PG8_LDA(At, 0, 1); PG8_STAGE(PG8_SA(0, 0), a2, voffA);
            PG8_BAR; PG8_WAIT_L(0); PG8_MMA(1, 0, At, B0); PG8_BAR; PG8_SCHED;
            PG8_STAGE(PG8_SB(0, 1), b2 + hstepB, voffB);
            PG8_WAIT_V(6); PG8_BAR; PG8_MMA(1, 1, At, B1); PG8_BAR;
            PG8_LDB(B0, 1, 0); PG8_SCHED; PG8_LDA(At, 1, 0); PG8_STAGE(PG8_SA(0, 1), a2 + hstepA, voffA);
            PG8_WAIT_L(8); PG8_BAR; PG8_WAIT_L(0); PG8_MMA(0, 0, At, B0); PG8_BAR; PG8_SCHED;
            PG8_LDB(B1, 1, 1); PG8_STAGE(PG8_SB(1, 0), b3, voffB);
            PG8_BAR; PG8_WAIT_L(0); PG8_MMA(0, 1, At, B1); PG8_BAR;
            PG8_LDA(At, 1, 1); PG8_STAGE(PG8_SA(1, 0), a3, voffA);
            PG8_BAR; PG8_WAIT_L(0); PG8_MMA(1, 0, At, B0); PG8_BAR; PG8_SCHED;
            PG8_STAGE(PG8_SB(1, 1), b3 + hstepB, voffB);
            PG8_WAIT_V(6); PG8_BAR; PG8_MMA(1, 1, At, B1); PG8_BAR;
        }
        E(acc, cur, wr, wc, fr, fq);
        if (!has_next) break;
#pragma unroll
        for (int a = 0; a < 2; ++a)
#pragma unroll
            for (int b = 0; b < 2; ++b)
#pragma unroll
                for (int m = 0; m < 4; ++m)
#pragma unroll
                    for (int n = 0; n < 2; ++n) acc[a][b][m][n] = (f32x4){0.f, 0.f, 0.f, 0.f};
        cur = nxt; cA = nA; ++ui;
    }
    PG8_WAIT_V(0);
    if (wr == 0) PG8_BAR;
    PG8_BAR;
#undef PG8_SA
#undef PG8_SB
#undef PG8_STAGE
#undef PG8_LDA
#undef PG8_LDB
#undef PG8_MMA
#undef PG8_WAIT_V
#undef PG8_WAIT_L
#undef PG8_BAR
#undef PG8_SCHED
#undef PG8_BPTR
}

struct DenseSched {
    const char* A; const char* Bt; int K, ldb, ksplit, nM, nN, G, c, lat;
    DEVINL void init(const bf16_t* A_, const bf16_t* Bt_, int N, int K_, int G_, int c_, int lat_) {
        A = (const char*)A_; Bt = (const char*)Bt_; K = K_; ldb = K_; ksplit = K_ / BK; nM = lat_ ? 128 : 136; nN = N / BM; G = G_; c = c_; lat = lat_; }
    DEVINL bool next(int i, Unit& u) const {
        const int nwg = nM * nN;
        const long Lq = (long)i * G + c; if (Lq >= nwg) return false;
        int wgid = (int)Lq; { const int q = nwg / NXCD, r = nwg % NXCD, xcd = wgid % NXCD, off = wgid / NXCD; wgid = (xcd < r ? xcd * (q + 1) : r * (q + 1) + (xcd - r) * q) + off; }
        const int nig = WGM * nN, gid = wgid / nig, fm = gid * WGM, gsz = (nM - fm) < WGM ? (nM - fm) : WGM;
        int pm = fm + ((wgid % nig) % gsz); const int pn = (wgid % nig) / gsz;
        if (lat) pm = (pm >> 4) * 17 + 1 + (pm & 15);
        u.pm = pm; u.pn = pn; u.A = A + (size_t)pm * BM * K * 2; u.B0 = Bt + (size_t)pn * BM * K * 2; u.B1 = u.B0; u.mvalid = 256; u.aux = 0;
        return true;
    }
};
}

struct GEpiP0 {
    static constexpr bool PERM = true;
    bf16_t* P;
    DEVINL void operator()(const f32x4 (&acc)[2][2][4][2], const pg8::Unit& u, int wr, int wc, int fr, int fq) const {
        const float sc = (u.pn == 0) ? 0.125f : 1.0f;
        const int row0 = u.pm * 256 + wr * 64 + fr, col0 = u.pn * 256 + wc * 32 + 8 * fq;
#pragma unroll
        for (int ai = 0; ai < 2; ++ai)
#pragma unroll
            for (int m = 0; m < 4; ++m) {
                bf16_t* rp = P + (size_t)(row0 + ai * 128 + m * 16) * 2048 + col0;
#pragma unroll
                for (int bj = 0; bj < 2; ++bj) {
                    const u32x2 a = pk4(acc[ai][bj][m][0] * sc), b = pk4(acc[ai][bj][m][1] * sc);
                    u32x4 w; w.x = a.x; w.y = a.y; w.z = b.x; w.w = b.y;
                    *(u32x4*)(rp + bj * 128) = w;
                }
            }
    }
};
struct GEpiP1 {
    static constexpr bool PERM = true;
    bf16_t* P; const float* lb;
    DEVINL void operator()(const f32x4 (&acc)[2][2][4][2], const pg8::Unit& u, int wr, int wc, int fr, int fq) const {
        const int cb = u.pn >> 2;
        const int row0 = u.pm * 256 + wr * 64 + fr, col0 = u.pn * 256 + wc * 32 + 8 * fq;
#pragma unroll
        for (int ai = 0; ai < 2; ++ai)
#pragma unroll
            for (int m = 0; m < 4; ++m) {
                bf16_t* rp = P + (size_t)(row0 + ai * 128 + m * 16) * 5120 + col0;
#pragma unroll
                for (int bj = 0; bj < 2; ++bj) {
                    u32x4 w;
                    if (cb == 1 || cb == 2) {
                        const int cc = (col0 + bj * 128) & 1023;
                        unsigned short hv[8];
#pragma unroll
                        for (int n = 0; n < 2; ++n) {
                            const f32x4 l4 = *(const f32x4*)(lb + cc + 4 * n);
#pragma unroll
                            for (int j = 0; j < 4; ++j) hv[n * 4 + j] = f2h((1.0f - l4[j]) * sigmoidf_(-acc[ai][bj][m][n][j]));
                        }
                        w.x = (unsigned)hv[0] | ((unsigned)hv[1] << 16); w.y = (unsigned)hv[2] | ((unsigned)hv[3] << 16);
                        w.z = (unsigned)hv[4] | ((unsigned)hv[5] << 16); w.w = (unsigned)hv[6] | ((unsigned)hv[7] << 16);
                    } else {
                        f32x4 v0 = acc[ai][bj][m][0], v1 = acc[ai][bj][m][1];
                        if (cb == 0 || cb == 4) {
#pragma unroll
                            for (int j = 0; j < 4; ++j) { v0[j] = siluf_(v0[j]); v1[j] = siluf_(v1[j]); }
                        }
                        const u32x2 a = pk4(v0), b = pk4(v1);
                        w.x = a.x; w.y = a.y; w.z = b.x; w.w = b.y;
                    }
                    *(u32x4*)(rp + bj * 128) = w;
                }
            }
    }
};
struct GEpiGlu {
    static constexpr bool PERM = true;
    bf16_t* CAT; const bf16_t* s5a; const float* gb;
    DEVINL void operator()(const f32x4 (&acc)[2][2][4][2], const pg8::Unit& u, int wr, int wc, int fr, int fq) const {
        const int row0 = u.pm * 256 + wr * 64 + fr, col0 = u.pn * 256 + wc * 32 + 8 * fq;
#pragma unroll
        for (int ai = 0; ai < 2; ++ai)
#pragma unroll
            for (int m = 0; m < 4; ++m) {
                const size_t row = (size_t)(row0 + ai * 128 + m * 16);
#pragma unroll
                for (int bj = 0; bj < 2; ++bj) {
                    const int col = col0 + bj * 128;
                    const u32x4 av = *(const u32x4*)(s5a + row * 512 + col);
                    const f32x4 b0 = *(const f32x4*)(gb + col), b1 = *(const f32x4*)(gb + col + 4);
                    f32x4 o0, o1;
                    o0[0] = bf2f((bf16_t)(av.x & 0xffff)) * sigmoidf_(acc[ai][bj][m][0][0] + b0[0]);
                    o0[1] = bf2f((bf16_t)(av.x >> 16)) * sigmoidf_(acc[ai][bj][m][0][1] + b0[1]);
                    o0[2] = bf2f((bf16_t)(av.y & 0xffff)) * sigmoidf_(acc[ai][bj][m][0][2] + b0[2]);
                    o0[3] = bf2f((bf16_t)(av.y >> 16)) * sigmoidf_(acc[ai][bj][m][0][3] + b0[3]);
                    o1[0] = bf2f((bf16_t)(av.z & 0xffff)) * sigmoidf_(acc[ai][bj][m][1][0] + b1[0]);
                    o1[1] = bf2f((bf16_t)(av.z >> 16)) * sigmoidf_(acc[ai][bj][m][1][1] + b1[1]);
                    o1[2] = bf2f((bf16_t)(av.w & 0xffff)) * sigmoidf_(acc[ai][bj][m][1][2] + b1[2]);
                    o1[3] = bf2f((bf16_t)(av.w >> 16)) * sigmoidf_(acc[ai][bj][m][1][3] + b1[3]);
                    const u32x2 a = pk4(o0), b = pk4(o1);
                    u32x4 w; w.x = a.x; w.y = a.y; w.z = b.x; w.w = b.y;
                    *(u32x4*)(CAT + row * 1024 + 512 + col) = w;
                }
            }
    }
};
struct GEpiOut {
    static constexpr bool PERM = false;
    float* out; const float* gate;
    DEVINL void operator()(const f32x4 (&acc)[2][2][4][2], const pg8::Unit& u, int wr, int wc, int fr, int fq) const {
        const int b = u.pm / 17, lt = u.pm - b * 17 - 1;
        const float* gp = gate + (size_t)b * 6144;
        const int col0 = u.pn * 256 + wc * 32 + 4 * fq;
        float* base = out + ((size_t)b * SEQ + lt * 256 + wr * 64 + fr) * D;
#pragma unroll
        for (int ai = 0; ai < 2; ++ai)
#pragma unroll
            for (int m = 0; m < 4; ++m) {
                float* rp = base + (size_t)(ai * 128 + m * 16) * D;
#pragma unroll
                for (int bj = 0; bj < 2; ++bj)
#pragma unroll
                    for (int n = 0; n < 2; ++n) {
                        const int col = col0 + bj * 128 + n * 16;
                        const f32x4 g4 = *(const f32x4*)(gp + col);
                        f32x4 x4 = *(f32x4*)(rp + col);
                        x4 += g4 * acc[ai][bj][m][n];
                        *(f32x4*)(rp + col) = x4;
                    }
            }
    }
};
struct GEpiMoe1 {
    static constexpr bool PERM = true;
    bf16_t* act; const float* wl; const float* wh;
    DEVINL void operator()(const f32x4 (&acc)[2][2][4][2], const pg8::Unit& u, int wr, int wc, int fr, int fq) const {
        const int half = u.pn >> 1;
        const float* wsel = half ? wh : wl;
        const int cbase = half * 256 + (u.pn & 1) * 128 + 16 * wc + 4 * fq;
#pragma unroll
        for (int ai = 0; ai < 2; ++ai)
#pragma unroll
            for (int m = 0; m < 4; ++m) {
                const int lr = ai * 128 + wr * 64 + m * 16 + fr;
                if (lr < u.mvalid) {
                    const int slot = u.pm * 256 + lr;
                    const float wv = wsel[slot];
#pragma unroll
                    for (int bj = 0; bj < 2; ++bj) {
                        f32x4 o;
#pragma unroll
                        for (int j = 0; j < 4; ++j) o[j] = wv * siluf_(acc[ai][bj][m][0][j]) * acc[ai][bj][m][1][j];
                        *(u32x2*)(act + (size_t)slot * 512 + cbase + 64 * bj) = pk4(o);
                    }
                }
            }
    }
};
struct GEpiMoe2 {
    static constexpr bool PERM = false;
    float* out; float* cx; const float* gate; const int* list;
    DEVINL void operator()(const f32x4 (&acc)[2][2][4][2], const pg8::Unit& u, int wr, int wc, int fr, int fq) const {
        const int col0 = u.pn * 256 + wc * 32 + 4 * fq;
#pragma unroll
        for (int ai = 0; ai < 2; ++ai)
#pragma unroll
            for (int m = 0; m < 4; ++m) {
                const int lr = ai * 128 + wr * 64 + m * 16 + fr;
                if (lr < u.mvalid) {
                    const int r = list[u.pm * 256 + lr];
                    const int rb = r / RPB, rj = r - rb * RPB;
                    float* rp = (rj < CTXL) ? (cx + (size_t)(rb * CTXL + rj) * D) : (out + (size_t)(rb * SEQ + (rj - CTXL)) * D);
                    const float* gp = gate + (size_t)((rj < CTXL) ? 8 : rb) * 6144;
#pragma unroll
                    for (int bj = 0; bj < 2; ++bj)
#pragma unroll
                        for (int n = 0; n < 2; ++n) {
                            const int col = col0 + bj * 128 + n * 16;
                            const f32x4 g4 = *(const f32x4*)(gp + col);
                            f32x4 x4 = *(f32x4*)(rp + col);
                            x4 += g4 * acc[ai][bj][m][n];
                            *(f32x4*)(rp + col) = x4;
                        }
                }
            }
    }
};

template <int WHICH>
DEVINL void phase_gemm(const Params& p, char* smem, int bid, int nb) {
    constexpr int N = (WHICH == 0) ? 2048 : (WHICH == 1) ? 512 : (WHICH == 3) ? 5120 : 1024;
    constexpr int K = (WHICH == 1) ? 512 : 1024;
    PG8_LAS unsigned char* lds = (PG8_LAS unsigned char*)smem;
    pg8::DenseSched S;
    bid = sgpr(bid); nb = sgpr(nb);
    if (WHICH == 0) { S.init(sgpr_ptr(p.H), sgpr_ptr(p.wt_in0), N, K, nb, bid, 1); GEpiP0 e{sgpr_ptr(p.P)}; pg8::gemm_phase(lds, S, e); }
    if (WHICH == 1) { S.init(sgpr_ptr(p.s5a), sgpr_ptr(p.glu_t), N, K, nb, bid, 1); GEpiGlu e{sgpr_ptr(p.H), sgpr_ptr(p.s5a), sgpr_ptr(p.glu_b)}; pg8::gemm_phase(lds, S, e); }
    if (WHICH == 2) { S.init(sgpr_ptr(p.H), sgpr_ptr(p.wt_out0), N, K, nb, bid, 1); GEpiOut e{sgpr_ptr(p.out), sgpr_ptr(p.mod) + 2048}; pg8::gemm_phase(lds, S, e); }
    if (WHICH == 3) { S.init(sgpr_ptr(p.H), sgpr_ptr(p.wt_in1), N, K, nb, bid, 1); GEpiP1 e{sgpr_ptr(p.P), sgpr_ptr(p.lb)}; pg8::gemm_phase(lds, S, e); }
    if (WHICH == 4) { S.init(sgpr_ptr(p.H), sgpr_ptr(p.wt_out1), N, K, nb, bid, 1); GEpiOut e{sgpr_ptr(p.out), sgpr_ptr(p.mod) + 9 * 6144 + 2048}; pg8::gemm_phase(lds, S, e); }
    if (WHICH != 4) {
        constexpr int NT0 = (WHICH == 3) ? 4 : 0, NT1 = (WHICH == 3) ? 16 : N / 256, NTC = NT1 - NT0;
        for (int u = bid; u < 16 * NTC; u += nb) {
            const int mt = u / NTC, nt = NT0 + (u - mt * NTC);
            const int m0 = (mt >> 1) * RPB + (mt & 1) * 128, n0 = nt * 256;
            if (WHICH == 0) { EpiP0 e{p.P, m0, n0}; gemm_tile(p.H, 1024, nullptr, m0, 128, p.wt_in0 + (size_t)n0 * 1024, nullptr, 1024, K, K, e, smem); }
            if (WHICH == 1) { EpiGlu e{p.H, p.s5a, p.glu_b, m0, n0}; gemm_tile(p.s5a, 512, nullptr, m0, 128, p.glu_t + (size_t)n0 * 512, nullptr, 512, K, K, e, smem); }
            if (WHICH == 2) { EpiOut e{&p, p.mod + 2048, m0, n0}; gemm_tile(p.H, 1024, nullptr, m0, 128, p.wt_out0 + (size_t)n0 * 1024, nullptr, 1024, K, K, e, smem); }
            if (WHICH == 3) { EpiP1 e{p.P, p.lb, m0, n0}; gemm_tile(p.H, 1024, nullptr, m0, 128, p.wt_in1 + (size_t)n0 * 1024, nullptr, 1024, K, K, e, smem); }
        }
    }
}

constexpr int MOE_TAB = pg8::STAGE_BYTES;
static_assert(MOE_TAB + 1024 <= LDS_BYTES, "moe tables");
DEVINL void moe_setup(const Params& p, int L, int* tab) {
    if (tid_opaque() == 0) {
        int o = 0, ts = 0;
        for (int b = 0; b < 48; ++b) { const int c = p.cnt[L * 64 + b]; tab[b] = o; tab[64 + b] = ts; tab[128 + b] = c; const int nt = (c + 255) >> 8; o += nt * 256; ts += nt; }
        tab[48] = o; tab[64 + 48] = ts;
    }
    __syncthreads();
}
template <int L>
DEVINL void phase_list(const Params& p, char* smem, int bid, int nb) {
    int* tab = (int*)(smem + MOE_TAB);
    moe_setup(p, L, tab);
    const int nrows = L ? NLAT : R;
    const int t = tid_opaque(), w = t >> 6, lane = t & 63;
    for (int base = (bid * 8 + w) * 32; base < nrows; base += nb * 8 * 32) {
        int r = 0, slot = 0;
        if (lane < 32) {
            const int i = base + lane;
            r = L ? ((i >> 12) * RPB + CTXL + (i & 4095)) : i;
            const float4 rec = p.RT[r];
            const int bucket = __float_as_int(rec.x);
            const int pos = atomicAdd(&p.cnt[128 + L * 64 + bucket], 1);
            slot = tab[bucket] + pos;
            p.list[slot] = r; p.wl[slot] = rec.y; p.wh[slot] = rec.z;
        }
#pragma unroll 1
        for (int j0 = 0; j0 < 32; j0 += 8) {
            u32x4 v0[8], v1[8];
#pragma unroll
            for (int j = 0; j < 8; ++j) {
                const int rj = __shfl(r, j0 + j);
                const u32x4* src = (const u32x4*)(p.H + (size_t)rj * D);
                v0[j] = src[lane]; v1[j] = src[lane + 64];
            }
#pragma unroll
            for (int j = 0; j < 8; ++j) {
                const int sj = __shfl(slot, j0 + j);
                u32x4* dst = (u32x4*)(p.hs + (size_t)sj * D);
                dst[lane] = v0[j]; dst[lane + 64] = v1[j];
            }
        }
    }
}
struct MoeSched {
    const bf16_t* hs; const bf16_t* wgu_t; const bf16_t* act; const bf16_t* wd_t; const int* tab; int K, ldb, ksplit, G, c, stage, ntiles;
    DEVINL bool next(int i, pg8::Unit& u) const {
        const int Lq = i * G + c; if (Lq >= ntiles * 4) return false;
        const int tile = Lq >> 2, pn = Lq & 3;
        int bucket = 0;
        for (int b = 0; b < 48; ++b) if (tile >= tab[64 + b] && tile < tab[64 + b + 1]) bucket = b;
        bucket = sgpr(bucket);
        const int ti = tile - sgpr(tab[64 + bucket]);
        const int m0 = sgpr(tab[bucket]) + ti * 256;
        const int rem = sgpr(tab[128 + bucket]) - ti * 256;
        const int grp = bucket / 6, pair = bucket - grp * 6;
        const int lo = (pair < 3) ? 0 : (pair < 5 ? 1 : 2);
        const int hi = (pair < 3) ? (pair + 1) : (pair < 5 ? (pair - 1) : 3);
        const int ea = grp * 4 + lo, eb = grp * 4 + hi;
        u.pm = m0 >> 8; u.pn = pn; u.mvalid = rem < 256 ? rem : 256; u.aux = 0;
        if (stage == 1) {
            const int e = (pn >> 1) ? eb : ea;
            u.A = (const char*)(hs + (size_t)m0 * 1024);
            u.B0 = (const char*)(wgu_t + ((size_t)e * 512 + (pn & 1) * 256) * 1024); u.B1 = u.B0;
        } else {
            u.A = (const char*)(act + (size_t)m0 * 512);
            u.B0 = (const char*)(wd_t + ((size_t)ea * 1024 + pn * 256) * 256);
            u.B1 = (const char*)(wd_t + ((size_t)eb * 1024 + pn * 256) * 256) - (size_t)4 * 128;
        }
        return true;
    }
};
template <int L, int STAGE>
DEVINL void phase_moe(const Params& p, char* smem, int bid, int nb) {
    int* tab = (int*)(smem + MOE_TAB);
    moe_setup(p, L, tab);
    PG8_LAS unsigned char* lds = (PG8_LAS unsigned char*)smem;
    MoeSched S; S.hs = sgpr_ptr(p.hs); S.wgu_t = sgpr_ptr(p.wgu_t); S.act = sgpr_ptr(p.act); S.wd_t = sgpr_ptr(p.wd_t);
    S.tab = tab; S.G = sgpr(nb); S.c = sgpr(bid); S.stage = STAGE; S.ntiles = sgpr(tab[64 + 48]);
    if (STAGE == 1) { S.K = 1024; S.ldb = 1024; S.ksplit = 16; GEpiMoe1 e{sgpr_ptr(p.act), sgpr_ptr(p.wl), sgpr_ptr(p.wh)}; pg8::gemm_phase(lds, S, e); }
    else { S.K = 512; S.ldb = 256; S.ksplit = 4; GEpiMoe2 e{sgpr_ptr(p.out), sgpr_ptr(p.cx), sgpr_ptr(p.mod) + (size_t)L * 9 * 6144 + 5120, sgpr_ptr(p.list)}; pg8::gemm_phase(lds, S, e); }
    __syncthreads();
}

template <int DK> struct RecL {
    static constexpr int QS = DK + 8;
    static constexpr int oQs = 0;
    static constexpr int oKs = oQs + 64 * QS * 2;
    static constexpr int oKt = oKs + 64 * QS * 2;
    static constexpr int oVt = oKt + DK * 72 * 2;
    static constexpr int oAt = oVt + 128 * 72 * 2;
    static constexpr int oSt = oAt + 64 * 72 * 2;
    static constexpr int oPart = oSt + 128 * 136 * 2;
    static constexpr int oEmid = oPart + 8 * 128 * 4;
    static constexpr int oEend = oEmid + 128 * 4;
    static constexpr int oAF = oEend + 128 * 4;
    static constexpr int oRed = oAF + 64 * 32 * 4;
    static constexpr int total = oRed + 64 * 2 * 4 + 128 * 4;
};
static_assert(RecL<128>::total <= LDS_BYTES, "rec lds");

template <bool GLA> struct RecCols {
    static constexpr int LDP = GLA ? 2048 : 5120;
    static constexpr int QOFF = 0;
    static constexpr int KOFF = 256;
    static constexpr int KF = 1024, KB = 2048;
    static constexpr int VOFF = GLA ? 512 : 3072;
    static constexpr int GOFF = GLA ? 1024 : 4096;
};
template <int DK, bool GLA> struct RecGeo {
    static constexpr int GC = GLA ? 4 : 8;
    static constexpr int NS = GLA ? 16 : 8;
    static constexpr int H = GLA ? 4 : 8;
    static constexpr int KT = DK / 16;
};

DEVINL void lds_sync() { asm volatile("s_waitcnt lgkmcnt(0)" ::: "memory"); __builtin_amdgcn_s_barrier(); asm volatile("" ::: "memory"); }

struct RawRegs { u32x4 q[2], k[2], v[2], af; };

template <int DK, bool GLA, int DIR, bool PASS3>
DEVINL void rec_load_raw(const Params& p, const bf16_t* __restrict__ P, int row0, int h, RawRegs& r) {
    using C = RecCols<GLA>; constexpr int LDP = C::LDP;
    const int t = tid_opaque();
    if (GLA) {
        const int row = t >> 3, c8 = (t & 7) * 8;
        const bf16_t* rp = P + (size_t)(row0 + row) * LDP + h * 64 + c8;
        if (PASS3) r.q[0] = *(const u32x4*)(rp + C::QOFF);
        r.k[0] = *(const u32x4*)(rp + C::KOFF);
        r.af = *(const u32x4*)(p.AF + (size_t)(row0 + row) * 32 + (t & 7) * 4);
    } else {
#pragma unroll
        for (int i = 0; i < 2; ++i) {
            const int row = (t >> 4) + i * 32, c8 = (t & 15) * 8;
            const bf16_t* rp = P + (size_t)(row0 + row) * LDP + h * 128 + c8;
            if (PASS3) r.q[i] = *(const u32x4*)(rp + C::QOFF);
            r.k[i] = *(const u32x4*)(rp + (DIR ? C::KB : C::KF));
        }
    }
#pragma unroll
    for (int i = 0; i < 2; ++i) {
        const int row = (t >> 4) + i * 32, c8 = (t & 15) * 8;
        r.v[i] = *(const u32x4*)(P + (size_t)(row0 + row) * LDP + C::VOFF + h * 128 + c8);
    }
}

template <int DK, bool GLA, int DIR, bool PASS3>
DEVINL void rec_prep(const Params& p, char* smem, const bf16_t* __restrict__ P, RawRegs& raw, bool has_next, int next_row0, int h,
                     const float (&a2c)[2][16], const float (&abv)[2], float (&bsum)[2]) {
    using L = RecL<DK>;
    constexpr int NCP = DK / 2, NSEG = NTHR / NCP, RS = 64 / NSEG, QS = L::QS;
    constexpr bool ref_end = !PASS3;
    bf16_t* Qs = (bf16_t*)(smem + L::oQs); bf16_t* Ks = (bf16_t*)(smem + L::oKs); bf16_t* Kt = (bf16_t*)(smem + L::oKt); bf16_t* Vt = (bf16_t*)(smem + L::oVt);
    bf16_t* Vraw = (bf16_t*)(smem + L::oSt);
    float* part = (float*)(smem + L::oPart); float* emid = (float*)(smem + L::oEmid); float* eend = (float*)(smem + L::oEend); float* AFs = (float*)(smem + L::oAF);
    const int t = tid_opaque();
    if (GLA) {
        const int row = t >> 3, c8 = (t & 7) * 8;
        if (PASS3) *(u32x4*)&Qs[row * QS + c8] = raw.q[0];
        *(u32x4*)&Ks[row * QS + c8] = raw.k[0];
        *(u32x4*)&AFs[row * 32 + (t & 7) * 4] = raw.af;
    } else {
#pragma unroll
        for (int i = 0; i < 2; ++i) {
            const int row = (t >> 4) + i * 32, c8 = (t & 15) * 8;
            if (PASS3) *(u32x4*)&Qs[row * QS + c8] = raw.q[i];
            *(u32x4*)&Ks[row * QS + c8] = raw.k[i];
        }
    }
#pragma unroll
    for (int i = 0; i < 2; ++i) { const int row = (t >> 4) + i * 32, c8 = (t & 15) * 8; *(u32x4*)&Vraw[row * 136 + c8] = raw.v[i]; }
    lds_sync();
    if (has_next) rec_load_raw<DK, GLA, DIR, PASS3>(p, P, next_row0, h, raw);
    const int cp = t % NCP, seg = t / NCP, c0 = cp * 2, l0 = seg * RS;
    float dv[RS][2];
    float kv[RS][2];
#pragma unroll
    for (int i = 0; i < RS; ++i) {
        const unsigned kr = *(const unsigned*)&Ks[(l0 + i) * QS + c0];
        if (GLA) {
            kv[i][0] = bf2f((bf16_t)(kr & 0xffffu)); kv[i][1] = bf2f((bf16_t)(kr >> 16));
            const float* ar = &AFs[(l0 + i) * 32 + DIR * 16];
            float s0 = abv[0], s1 = abv[1];
#pragma unroll
            for (int r = 0; r < 16; ++r) { const float av = ar[r]; s0 += av * a2c[0][r]; s1 += av * a2c[1][r]; }
            dv[i][0] = logsigmoidf_(s0) * 0.0625f; dv[i][1] = logsigmoidf_(s1) * 0.0625f;
        } else {
            kv[i][0] = h2f((unsigned short)(kr & 0xffffu)); kv[i][1] = h2f((unsigned short)(kr >> 16));
            dv[i][0] = 1.0f - kv[i][0]; dv[i][1] = 1.0f - kv[i][1];
        }
    }
    {
        float s0 = GLA ? 0.f : 1.f, s1 = GLA ? 0.f : 1.f;
#pragma unroll
        for (int i = 0; i < RS; ++i) { if (GLA) { s0 += dv[i][0]; s1 += dv[i][1]; } else { s0 *= dv[i][0]; s1 *= dv[i][1]; } }
        float2 pv; pv.x = s0; pv.y = s1;
        *(float2*)&part[seg * DK + c0] = pv;
    }
    lds_sync();
    float tot[2], base[2], mid[2];
#pragma unroll
    for (int c = 0; c < 2; ++c) { tot[c] = GLA ? 0.f : 1.f; base[c] = tot[c]; mid[c] = tot[c]; }
#pragma unroll
    for (int sg = 0; sg < NSEG; ++sg) {
        const float2 pv = *(const float2*)&part[sg * DK + c0];
        const bool before = (DIR == 0) ? (sg < seg) : (sg > seg);
        const bool firsthalf = (DIR == 0) ? (sg < NSEG / 2) : (sg >= NSEG / 2);
        if (GLA) { tot[0] += pv.x; tot[1] += pv.y; if (before) { base[0] += pv.x; base[1] += pv.y; } if (firsthalf) { mid[0] += pv.x; mid[1] += pv.y; } }
        else { tot[0] *= pv.x; tot[1] *= pv.y; if (before) { base[0] *= pv.x; base[1] *= pv.y; } if (firsthalf) { mid[0] *= pv.x; mid[1] *= pv.y; } }
    }
    float ref[2], iref[2];
#pragma unroll
    for (int c = 0; c < 2; ++c) { ref[c] = ref_end ? tot[c] : mid[c]; iref[c] = GLA ? 0.f : __builtin_amdgcn_rcpf(ref[c]); }
    if (seg == 0) {
#pragma unroll
        for (int c = 0; c < 2; ++c) {
            if (GLA) { emid[c0 + c] = __expf(ref[c]); eend[c0 + c] = __expf(tot[c] - ref[c]); bsum[c] += tot[c]; }
            else { emid[c0 + c] = ref[c]; eend[c0 + c] = tot[c] * iref[c]; bsum[c] += __logf(tot[c]); }
        }
    }
    unsigned short ktv[2][RS];
    float run[2] = {base[0], base[1]};
#pragma unroll
    for (int ii = 0; ii < RS; ++ii) {
        const int i = (DIR == 0) ? ii : (RS - 1 - ii);
        float ek[2], eq[2];
#pragma unroll
        for (int c = 0; c < 2; ++c) {
            if (GLA) { run[c] += dv[i][c]; ek[c] = __expf(ref[c] - run[c]); eq[c] = PASS3 ? __expf(run[c] - ref[c]) : 0.f; }
            else { run[c] *= dv[i][c]; ek[c] = ref[c] * __builtin_amdgcn_rcpf(run[c]); eq[c] = run[c] * iref[c]; }
        }
        const unsigned kp = cvt_pk_bf16(kv[i][0] * ek[0], kv[i][1] * ek[1]);
        ktv[0][i] = (unsigned short)(kp & 0xffffu); ktv[1][i] = (unsigned short)(kp >> 16);
        if (PASS3) {
            const int l = l0 + i;
            *(unsigned*)&Ks[l * QS + c0] = kp;
            const unsigned qr = *(const unsigned*)&Qs[l * QS + c0];
            *(unsigned*)&Qs[l * QS + c0] = cvt_pk_bf16(bf2f((bf16_t)(qr & 0xffffu)) * eq[0], bf2f((bf16_t)(qr >> 16)) * eq[1]);
        }
    }
#pragma unroll
    for (int c = 0; c < 2; ++c) {
        if (RS == 8) {
            u32x4 v;
            v.x = (unsigned)ktv[c][0] | ((unsigned)ktv[c][1] << 16); v.y = (unsigned)ktv[c][2] | ((unsigned)ktv[c][3] << 16);
            v.z = (unsigned)ktv[c][RS > 4 ? 4 : 0] | ((unsigned)ktv[c][RS > 4 ? 5 : 0] << 16); v.w = (unsigned)ktv[c][RS > 4 ? 6 : 0] | ((unsigned)ktv[c][RS > 4 ? 7 : 0] << 16);
            *(u32x4*)&Kt[(c0 + c) * 72 + l0] = v;
        } else {
            u32x2 v;
            v.x = (unsigned)ktv[c][0] | ((unsigned)ktv[c][1] << 16); v.y = (unsigned)ktv[c][2] | ((unsigned)ktv[c][3] << 16);
            *(u32x2*)&Kt[(c0 + c) * 72 + l0] = v;
        }
    }
    {
        const int vp = t & 63, vq = t >> 6;
        unsigned vr[8];
#pragma unroll
        for (int i = 0; i < 8; ++i) vr[i] = *(const unsigned*)&Vraw[(vq * 8 + i) * 136 + 2 * vp];
        u32x4 lo, hi;
        lo.x = (vr[0] & 0xffffu) | (vr[1] << 16); lo.y = (vr[2] & 0xffffu) | (vr[3] << 16); lo.z = (vr[4] & 0xffffu) | (vr[5] << 16); lo.w = (vr[6] & 0xffffu) | (vr[7] << 16);
        hi.x = (vr[0] >> 16) | (vr[1] & 0xffff0000u); hi.y = (vr[2] >> 16) | (vr[3] & 0xffff0000u); hi.z = (vr[4] >> 16) | (vr[5] & 0xffff0000u); hi.w = (vr[6] >> 16) | (vr[7] & 0xffff0000u);
        *(u32x4*)&Vt[(2 * vp) * 72 + vq * 8] = lo;
        *(u32x4*)&Vt[(2 * vp + 1) * 72 + vq * 8] = hi;
    }
    lds_sync();
}

DEVINL bf16x8 ldfrag(const bf16_t* base, int ld, int fr, int fq, int k0) { return *(const bf16x8*)(base + fr * ld + k0 + fq * 8); }

template <int DK, bool GLA, int DIR>
DEVINL void rec_load_a2(const Params& p, int h, float (&a2c)[2][16], float (&abv)[2]) {
#pragma unroll
    for (int c = 0; c < 2; ++c) { abv[c] = 0.f;
#pragma unroll
        for (int r = 0; r < 16; ++r) a2c[c][r] = 0.f; }
    if (GLA) {
        const int c0 = (tid_opaque() % (DK / 2)) * 2;
#pragma unroll
        for (int c = 0; c < 2; ++c) {
#pragma unroll
            for (int r = 0; r < 16; ++r) a2c[c][r] = p.gla_a2[(DIR * 16 + r) * 256 + h * 64 + c0 + c];
            abv[c] = p.gla_ab[DIR * 256 + h * 64 + c0 + c];
        }
    }
}

template <int DK, bool GLA, int DIR>
DEVINL void rec_pass1_unit(const Params& p, char* smem, const bf16_t* P, int b, int h, int cg, float* slots, float* decs) {
    using L = RecL<DK>; using G = RecGeo<DK, GLA>;
    constexpr int KT = G::KT;
    bf16_t* Kt = (bf16_t*)(smem + L::oKt); bf16_t* Vt = (bf16_t*)(smem + L::oVt); float* emid = (float*)(smem + L::oEmid);
    const int t = tid_opaque(), w = t >> 6, lane = t & 63, fr = lane & 15, fq = lane >> 4;
    float a2c[2][16], abv[2];
    rec_load_a2<DK, GLA, DIR>(p, h, a2c, abv);
    f32x4 accS[KT];
#pragma unroll
    for (int kt = 0; kt < KT; ++kt) accS[kt] = (f32x4){0.f, 0.f, 0.f, 0.f};
    float bsum[2] = {0.f, 0.f};
    const int nch = (cg == 0) ? 4 : G::GC;
    auto chunk_row0 = [&](int ci) { const int pc = (cg == 0) ? (DIR == 0 ? ci : 3 - ci) : (DIR == 0 ? (4 + (cg - 1) * G::GC + ci) : (67 - (cg - 1) * G::GC - ci)); return b * RPB + pc * 64; };
    RawRegs raw;
    rec_load_raw<DK, GLA, DIR, false>(p, P, chunk_row0(0), h, raw);
    for (int ci = 0; ci < nch; ++ci) {
        const bool has_next = ci + 1 < nch;
        rec_prep<DK, GLA, DIR, false>(p, smem, P, raw, has_next, has_next ? chunk_row0(ci + 1) : 0, h, a2c, abv, bsum);
        bf16x8 av[2];
#pragma unroll
        for (int ks = 0; ks < 2; ++ks) av[ks] = ldfrag(Vt + (w * 16) * 72, 72, fr, fq, ks * 32);
#pragma unroll
        for (int kt = 0; kt < KT; ++kt) {
            const f32x4 e4 = *(const f32x4*)&emid[kt * 16 + fq * 4];
            f32x4 c = accS[kt] * e4;
#pragma unroll
            for (int ks = 0; ks < 2; ++ks) c = __builtin_amdgcn_mfma_f32_16x16x32_bf16(ldfrag(Kt + (kt * 16) * 72, 72, fr, fq, ks * 32), av[ks], c, 0, 0, 0);
            accS[kt] = c;
        }
        lds_sync();
    }
    const size_t chain = ((size_t)(b * G::H + h) * 2 + DIR);
    float* sl = slots + (chain * G::NS + cg) * (size_t)(128 * DK);
#pragma unroll
    for (int kt = 0; kt < KT; ++kt) *(f32x4*)&sl[(w * 16 + fr) * DK + kt * 16 + fq * 4] = accS[kt];
    if (t < DK / 2) { decs[(chain * G::NS + cg) * DK + 2 * t] = bsum[0]; decs[(chain * G::NS + cg) * DK + 2 * t + 1] = bsum[1]; }
}

template <int DK, bool GLA, int DIR>
DEVINL void rec_pass3_chunk(const Params& p, char* smem, const bf16_t* P, bf16_t* CAT, int row0, int h, f32x4 (&accS)[DK / 16], const float* gnorm) {
    using L = RecL<DK>; using C = RecCols<GLA>;
    constexpr int KT = DK / 16, QS = L::QS, KS = DK / 32;
    bf16_t* Qs = (bf16_t*)(smem + L::oQs); bf16_t* Ks = (bf16_t*)(smem + L::oKs); bf16_t* Kt = (bf16_t*)(smem + L::oKt); bf16_t* Vt = (bf16_t*)(smem + L::oVt);
    bf16_t* At = (bf16_t*)(smem + L::oAt); bf16_t* St = (bf16_t*)(smem + L::oSt);
    float* emid = (float*)(smem + L::oEmid); float* eend = (float*)(smem + L::oEend); float* red = (float*)(smem + L::oRed);
    const int t = tid_opaque(), w = t >> 6, lane = t & 63, fr = lane & 15, fq = lane >> 4;
    u32x2 obv[4], gbv[4];
    if (DIR == 0) {
        const size_t prow = (size_t)(row0 + (w & 3) * 16 + fr);
        const bf16_t* cp0 = CAT + prow * 1024 + h * 128 + (w >> 2) * 64 + fq * 4;
        const bf16_t* gp0 = P + prow * C::LDP + C::GOFF + h * 128 + (w >> 2) * 64 + fq * 4;
#pragma unroll
        for (int n = 0; n < 4; ++n) { obv[n] = *(const u32x2*)(cp0 + n * 16); gbv[n] = *(const u32x2*)(gp0 + n * 16); }
    }
#pragma unroll
    for (int kt = 0; kt < KT; ++kt) {
        const f32x4 e4 = *(const f32x4*)&emid[kt * 16 + fq * 4];
        accS[kt] = accS[kt] * e4;
        *(u32x2*)&St[(w * 16 + fr) * QS + kt * 16 + fq * 4] = pk4(accS[kt]);
    }
    {
        const int lt = w >> 1, st0 = (w & 1) * 2;
        bf16x8 aq[KS];
#pragma unroll
        for (int ks = 0; ks < KS; ++ks) aq[ks] = ldfrag(Qs + (lt * 16) * QS, QS, fr, fq, ks * 32);
#pragma unroll
        for (int s2 = 0; s2 < 2; ++s2) {
            const int st = st0 + s2;
            f32x4 c = (f32x4){0.f, 0.f, 0.f, 0.f};
#pragma unroll
            for (int ks = 0; ks < KS; ++ks) c = __builtin_amdgcn_mfma_f32_16x16x32_bf16(ldfrag(Ks + (st * 16) * QS, QS, fr, fq, ks * 32), aq[ks], c, 0, 0, 0);
            const int l = lt * 16 + fr;
#pragma unroll
            for (int j = 0; j < 4; ++j) { const int sidx = st * 16 + fq * 4 + j; const bool keep = (DIR == 0) ? (sidx <= l) : (sidx >= l); c[j] = keep ? c[j] : 0.f; }
            *(u32x2*)&At[l * 72 + st * 16 + fq * 4] = pk4(c);
        }
    }
    lds_sync();
    const int lt = w & 3, vt0 = (w >> 2) * 4;
    f32x4 o[4];
    {
        bf16x8 aa[2], aq[KS];
#pragma unroll
        for (int ks = 0; ks < 2; ++ks) aa[ks] = ldfrag(At + (lt * 16) * 72, 72, fr, fq, ks * 32);
#pragma unroll
        for (int ks = 0; ks < KS; ++ks) aq[ks] = ldfrag(Qs + (lt * 16) * QS, QS, fr, fq, ks * 32);
#pragma unroll
        for (int n = 0; n < 4; ++n) {
            const int vt = vt0 + n;
            f32x4 c = (f32x4){0.f, 0.f, 0.f, 0.f};
#pragma unroll
            for (int ks = 0; ks < 2; ++ks) c = __builtin_amdgcn_mfma_f32_16x16x32_bf16(ldfrag(Vt + (vt * 16) * 72, 72, fr, fq, ks * 32), aa[ks], c, 0, 0, 0);
#pragma unroll
            for (int ks = 0; ks < KS; ++ks) c = __builtin_amdgcn_mfma_f32_16x16x32_bf16(ldfrag(St + (vt * 16) * QS, QS, fr, fq, ks * 32), aq[ks], c, 0, 0, 0);
            o[n] = c;
        }
    }
    {
        bf16x8 av[2];
#pragma unroll
        for (int ks = 0; ks < 2; ++ks) av[ks] = ldfrag(Vt + (w * 16) * 72, 72, fr, fq, ks * 32);
#pragma unroll
        for (int kt = 0; kt < KT; ++kt) {
            f32x4 c = accS[kt];
#pragma unroll
            for (int ks = 0; ks < 2; ++ks) c = __builtin_amdgcn_mfma_f32_16x16x32_bf16(ldfrag(Kt + (kt * 16) * 72, 72, fr, fq, ks * 32), av[ks], c, 0, 0, 0);
            const f32x4 e4 = *(const f32x4*)&eend[kt * 16 + fq * 4];
            accS[kt] = c * e4;
        }
    }
    const int l = lt * 16 + fr;
    const size_t row = (size_t)(row0 + l);
    bf16_t* cp = CAT + row * 1024 + h * 128 + vt0 * 16 + fq * 4;
    if (DIR == 1) {
#pragma unroll
        for (int n = 0; n < 4; ++n) *(u32x2*)(cp + n * 16) = pk4(o[n]);
    } else {
        float ss = 0.f;
#pragma unroll
        for (int n = 0; n < 4; ++n) {
            const u32x2 ob = obv[n];
            o[n][0] += bf2f((bf16_t)(ob.x & 0xffff)); o[n][1] += bf2f((bf16_t)(ob.x >> 16));
            o[n][2] += bf2f((bf16_t)(ob.y & 0xffff)); o[n][3] += bf2f((bf16_t)(ob.y >> 16));
            ss += o[n][0] * o[n][0] + o[n][1] * o[n][1] + o[n][2] * o[n][2] + o[n][3] * o[n][3];
        }
        ss += __shfl_xor(ss, 16);
        ss += __shfl_xor(ss, 32);
        if (fq == 0) red[l * 2 + (w >> 2)] = ss;
        lds_sync();
        const float tot = red[l * 2] + red[l * 2 + 1];
        const float rstd = rsqrtf(tot * (1.0f / 128.0f) + EPS);
#pragma unroll
        for (int n = 0; n < 4; ++n) {
            const u32x2 gb = gbv[n];
            const f32x4 gn = *(const f32x4*)(gnorm + vt0 * 16 + n * 16 + fq * 4);
            f32x4 gv;
            gv[0] = bf2f((bf16_t)(gb.x & 0xffff)); gv[1] = bf2f((bf16_t)(gb.x >> 16)); gv[2] = bf2f((bf16_t)(gb.y & 0xffff)); gv[3] = bf2f((bf16_t)(gb.y >> 16));
            f32x4 r4;
#pragma unroll
            for (int j = 0; j < 4; ++j) { const float g = GLA ? siluf_(gv[j]) : gv[j]; r4[j] = o[n][j] * rstd * gn[j] * g; }
            *(u32x2*)(cp + n * 16) = pk4(r4);
        }
    }
    lds_sync();
}

template <int DK, bool GLA, int DIR>
DEVINL void rec_pass3_sweep(const Params& p, char* smem, const bf16_t* P, bf16_t* CAT, int b, int h, int c_lo, int nch, int slot, const float* slots, const float* gnorm) {
    using G = RecGeo<DK, GLA>;
    constexpr int KT = G::KT;
    const int t = tid_opaque(), w = t >> 6, lane = t & 63, fr = lane & 15, fq = lane >> 4;
    float a2c[2][16], abv[2];
    rec_load_a2<DK, GLA, DIR>(p, h, a2c, abv);
    f32x4 accS[KT];
    if (slot >= 0) {
        const size_t chain = ((size_t)(b * G::H + h) * 2 + DIR);
        const float* sl = slots + (chain * G::NS + slot) * (size_t)(128 * DK);
#pragma unroll
        for (int kt = 0; kt < KT; ++kt) accS[kt] = *(const f32x4*)&sl[(w * 16 + fr) * DK + kt * 16 + fq * 4];
    } else {
#pragma unroll
        for (int kt = 0; kt < KT; ++kt) accS[kt] = (f32x4){0.f, 0.f, 0.f, 0.f};
    }
    float bsum[2] = {0.f, 0.f};
    float* gn_lds = (float*)(smem + RecL<DK>::oRed + 64 * 2 * 4);
    if (DIR == 0) { if (t < 128) gn_lds[t] = gnorm[t]; }
    auto chunk_row0 = [&](int ci) { const int pc = (DIR == 0) ? (c_lo + ci) : (c_lo + nch - 1 - ci); return b * RPB + pc * 64; };
    RawRegs raw;
    rec_load_raw<DK, GLA, DIR, true>(p, P, chunk_row0(0), h, raw);
    for (int ci = 0; ci < nch; ++ci) {
        const bool has_next = ci + 1 < nch;
        rec_prep<DK, GLA, DIR, true>(p, smem, P, raw, has_next, has_next ? chunk_row0(ci + 1) : 0, h, a2c, abv, bsum);
        rec_pass3_chunk<DK, GLA, DIR>(p, smem, P, CAT, chunk_row0(ci), h, accS, gn_lds);
    }
}

template <int DK, bool GLA>
DEVINL void rec_pass3_unit(const Params& p, char* smem, const bf16_t* P, bf16_t* CAT, int b, int h, int gi, const float* slots, const float* gnorm) {
    using G = RecGeo<DK, GLA>;
    int c_lo, nch, slot_f, slot_b;
    if (GLA) {
        if (gi == 0) { c_lo = 0; nch = 4; slot_f = -1; slot_b = -1; }
        else { const int pg = gi - 1; c_lo = 4 + pg * G::GC; nch = G::GC; slot_f = pg; slot_b = G::NS - 1 - pg; }
    } else { const int pg = gi; c_lo = 4 + pg * G::GC; nch = G::GC; slot_f = pg; slot_b = G::NS - 1 - pg; }
    rec_pass3_sweep<DK, GLA, 1>(p, smem, P, CAT, b, h, c_lo, nch, slot_b, slots, gnorm);
    asm volatile("s_waitcnt vmcnt(0)" ::: "memory");
    rec_pass3_sweep<DK, GLA, 0>(p, smem, P, CAT, b, h, c_lo, nch, slot_f, slots, gnorm);
}

template <int DK, bool GLA>
DEVINL void rec_scan(float* slots, const float* decs, int bid, int nb) {
    using G = RecGeo<DK, GLA>;
    constexpr int NCHAIN = NBATCH * G::H * 2, PER = 128 * DK / 4;
    const int total = NCHAIN * PER;
    for (int i = bid * NTHR + tid_opaque(); i < total; i += nb * NTHR) {
        const int chain = i / PER, e = i - chain * PER;
        const int k4 = (e * 4) % DK;
        f32x4 run = (f32x4){0.f, 0.f, 0.f, 0.f};
#pragma unroll 1
        for (int s0 = 0; s0 < G::NS; s0 += 8) {
            f32x4 a[8], d4[8];
#pragma unroll
            for (int j = 0; j < 8; ++j) {
                d4[j] = *(const f32x4*)&decs[((size_t)chain * G::NS + s0 + j) * DK + k4];
                a[j] = *(const f32x4*)(slots + ((size_t)chain * G::NS + s0 + j) * (size_t)(128 * DK) + (size_t)e * 4);
            }
#pragma unroll
            for (int j = 0; j < 8; ++j) {
#pragma unroll
                for (int q = 0; q < 4; ++q) run[q] = __expf(d4[j][q]) * run[q] + a[j][q];
                *(f32x4*)(slots + ((size_t)chain * G::NS + s0 + j) * (size_t)(128 * DK) + (size_t)e * 4) = run;
            }
        }
    }
}

DEVINL size_t s5_idx(int b, int di, int pc, int g, int pp) { return ((((size_t)(b * 2 + di) * NCH + pc) * 32 + g) * 64 + pp) * 2; }

constexpr int S5_BU_LD = 20;
constexpr int S5_WAVE_LDS = 128 * S5_BU_LD * 4 + 16 * 136 * 2;
static_assert(8 * S5_WAVE_LDS <= LDS_BYTES, "s5 lds");

DEVINL void s5_load_afr(const Params& p, int row0, int g, int fr, int fq, bf16x8 (&afr)[4]) {
    const bf16x8 z = (bf16x8){0, 0, 0, 0, 0, 0, 0, 0};
#pragma unroll
    for (int sb = 0; sb < 4; ++sb) afr[sb] = (fq < 2) ? *(const bf16x8*)(p.P + (size_t)(row0 + sb * 16 + fr) * 2048 + 1536 + g * 16 + fq * 8) : z;
}
DEVINL void s5_load_bfr(const Params& p, int di, int g, int fr, int fq, bf16x8 (&bfr)[8]) {
    const bf16x8 z = (bf16x8){0, 0, 0, 0, 0, 0, 0, 0};
#pragma unroll
    for (int nt = 0; nt < 8; ++nt) bfr[nt] = (fq < 2) ? *(const bf16x8*)(p.bbm + ((size_t)((di * 32 + g) * 128 + nt * 16 + fr)) * 16 + fq * 8) : z;
}
DEVINL void s5_bu_subblock(float* BuT, const bf16x8& a, const bf16x8 (&bfr)[8], int fr, int fq) {
#pragma unroll
    for (int nt = 0; nt < 8; ++nt) {
        f32x4 c = (f32x4){0.f, 0.f, 0.f, 0.f};
        c = __builtin_amdgcn_mfma_f32_16x16x32_bf16(bfr[nt], a, c, 0, 0, 0);
#pragma unroll
        for (int r = 0; r < 4; ++r) BuT[(nt * 16 + fq * 4 + r) * S5_BU_LD + fr] = c[r];
    }
}
template <int DIR, bool XS>
DEVINL void s5_scan16(const float* BuT, bf16_t* Xs, int lane, float are, float aim, float& xr, float& xi) {
    f32x4 br[4], bi[4];
#pragma unroll
    for (int q = 0; q < 4; ++q) { br[q] = *(const f32x4*)&BuT[lane * S5_BU_LD + q * 4]; bi[q] = *(const f32x4*)&BuT[(64 + lane) * S5_BU_LD + q * 4]; }
#pragma unroll
    for (int tt = 0; tt < 16; ++tt) {
        const int tl = DIR ? (15 - tt) : tt;
        const float nr = are * xr - aim * xi + br[tl >> 2][tl & 3], ni = are * xi + aim * xr + bi[tl >> 2][tl & 3];
        xr = nr; xi = ni;
        if (XS) { const unsigned pkd = cvt_pk_bf16(xr, xi); Xs[tl * 136 + lane] = (bf16_t)(pkd & 0xffffu); Xs[tl * 136 + 64 + lane] = (bf16_t)(pkd >> 16); }
    }
}
template <int DIR>
DEVINL void s5_pass1_task(const Params& p, float* BuT, int b, int pc, int g, const bf16x8 (&afr)[4], int lane, int fr, int fq) {
    bf16x8 bfr[8];
    s5_load_bfr(p, DIR, g, fr, fq, bfr);
    const float are = p.atab[((DIR * 32 + g) * 64 + lane) * 2], aim = p.atab[((DIR * 32 + g) * 64 + lane) * 2 + 1];
    float xr = 0.f, xi = 0.f;
#pragma unroll
    for (int sbi = 0; sbi < 4; ++sbi) {
        const int sb = DIR ? (3 - sbi) : sbi;
        s5_bu_subblock(BuT, afr[sb], bfr, fr, fq);
        asm volatile("s_waitcnt lgkmcnt(0)" ::: "memory");
        s5_scan16<DIR, false>(BuT, nullptr, lane, are, aim, xr, xi);
        asm volatile("s_waitcnt lgkmcnt(0)" ::: "memory");
    }
    float* o = p.s5xend + s5_idx(b, DIR, pc, g, lane);
    o[0] = xr; o[1] = xi;
}
DEVINL void s5_pass1_unit(const Params& p, char* smem, int b, int pc) {
    const int t = tid_opaque(), w = t >> 6, lane = t & 63, fr = lane & 15, fq = lane >> 4;
    float* BuT = (float*)(smem + w * S5_WAVE_LDS);
    const int row0 = b * RPB + pc * 64;
#pragma unroll 1
    for (int q = 0; q < 4; ++q) {
        const int g = w * 4 + q;
        bf16x8 afr[4];
        s5_load_afr(p, row0, g, fr, fq, afr);
        s5_pass1_task<0>(p, BuT, b, pc, g, afr, lane, fr, fq);
        s5_pass1_task<1>(p, BuT, b, pc, g, afr, lane, fr, fq);
    }
}
DEVINL void s5_scan(const Params& p, int bid, int nb) {
    for (int i = bid * NTHR + tid_opaque(); i < NBATCH * 2 * 32 * 64; i += nb * NTHR) {
        const int pp = i & 63, g = (i >> 6) & 31, di = (i >> 11) & 1, b = i >> 12;
        const float ar = p.a64tab[((di * 32 + g) * 64 + pp) * 2], ai = p.a64tab[((di * 32 + g) * 64 + pp) * 2 + 1];
        float cr = 0.f, ci = 0.f;
#pragma unroll 1
        for (int c0 = 0; c0 < NCH; c0 += 17) {
            float er[17], ei[17];
#pragma unroll
            for (int j = 0; j < 17; ++j) {
                const int ch = c0 + j, pc = di ? (ch < 4 ? 3 - ch : 71 - ch) : ch;
                const size_t ix = s5_idx(b, di, pc, g, pp);
                er[j] = p.s5xend[ix]; ei[j] = p.s5xend[ix + 1];
            }
#pragma unroll
            for (int j = 0; j < 17; ++j) {
                const int ch = c0 + j, pc = di ? (ch < 4 ? 3 - ch : 71 - ch) : ch;
                const size_t ix = s5_idx(b, di, pc, g, pp);
                p.s5carry[ix] = cr; p.s5carry[ix + 1] = ci;
                const float nr = ar * cr - ai * ci + er[j], ni = ar * ci + ai * cr + ei[j];
                cr = nr; ci = ni;
            }
        }
    }
}
template <int DIR>
DEVINL void s5_pass3_task(const Params& p, float* BuT, bf16_t* Xs, int b, int pc, int g, const bf16x8 (&afr)[4], f32x4 (&acc)[4], int lane, int fr, int fq) {
    bf16x8 bfr[8];
    s5_load_bfr(p, DIR, g, fr, fq, bfr);
    bf16x8 cb[4];
#pragma unroll
    for (int ks = 0; ks < 4; ++ks) cb[ks] = *(const bf16x8*)(p.cmt + ((size_t)(g * 16 + fr)) * 256 + DIR * 128 + ks * 32 + fq * 8);
    const float are = p.atab[((DIR * 32 + g) * 64 + lane) * 2], aim = p.atab[((DIR * 32 + g) * 64 + lane) * 2 + 1];
    const size_t cix = s5_idx(b, DIR, pc, g, lane);
    float xr = p.s5carry[cix], xi = p.s5carry[cix + 1];
#pragma unroll
    for (int sbi = 0; sbi < 4; ++sbi) {
        const int sb = DIR ? (3 - sbi) : sbi;
        s5_bu_subblock(BuT, afr[sb], bfr, fr, fq);
        asm volatile("s_waitcnt lgkmcnt(0)" ::: "memory");
        s5_scan16<DIR, true>(BuT, Xs, lane, are, aim, xr, xi);
        asm volatile("s_waitcnt lgkmcnt(0)" ::: "memory");
        f32x4 c = acc[sb];
#pragma unroll
        for (int ks = 0; ks < 4; ++ks) {
            const bf16x8 a = *(const bf16x8*)(Xs + fr * 136 + ks * 32 + fq * 8);
            c = __builtin_amdgcn_mfma_f32_16x16x32_bf16(cb[ks], a, c, 0, 0, 0);
        }
        acc[sb] = c;
        asm volatile("s_waitcnt lgkmcnt(0)" ::: "memory");
    }
}
DEVINL void s5_pass3_unit(const Params& p, char* smem, int b, int pc) {
    const int t = tid_opaque(), w = t >> 6, lane = t & 63, fr = lane & 15, fq = lane >> 4;
    float* BuT = (float*)(smem + w * S5_WAVE_LDS);
    bf16_t* Xs = (bf16_t*)(smem + w * S5_WAVE_LDS + 128 * S5_BU_LD * 4);
    const int row0 = b * RPB + pc * 64;
#pragma unroll 1
    for (int q = 0; q < 4; ++q) {
        const int g = w * 4 + q;
        bf16x8 afr[4];
        s5_load_afr(p, row0, g, fr, fq, afr);
        f32x4 acc[4];
#pragma unroll
        for (int sb = 0; sb < 4; ++sb) acc[sb] = (f32x4){0.f, 0.f, 0.f, 0.f};
        s5_pass3_task<1>(p, BuT, Xs, b, pc, g, afr, acc, lane, fr, fq);
        s5_pass3_task<0>(p, BuT, Xs, b, pc, g, afr, acc, lane, fr, fq);
        const f32x4 d4 = *(const f32x4*)(p.s5_d + g * 16 + fq * 4);
#pragma unroll
        for (int sb = 0; sb < 4; ++sb) {
            const int tok = sb * 16 + fr;
            const u32x2 ub = *(const u32x2*)(p.P + (size_t)(row0 + tok) * 2048 + 1536 + g * 16 + fq * 4);
            f32x4 uv; uv[0] = bf2f((bf16_t)(ub.x & 0xffff)); uv[1] = bf2f((bf16_t)(ub.x >> 16)); uv[2] = bf2f((bf16_t)(ub.y & 0xffff)); uv[3] = bf2f((bf16_t)(ub.y >> 16));
            f32x4 r4;
#pragma unroll
            for (int j = 0; j < 4; ++j) r4[j] = gelu_tanh(acc[sb][j] + d4[j] * uv[j]);
            *(u32x2*)(p.s5a + (size_t)(row0 + tok) * 512 + g * 16 + fq * 4) = pk4(r4);
        }
    }
}

template <int LAYER>
DEVINL void phase_rec1(const Params& p, char* smem, int bid, int nb) {
    if (LAYER == 0) {
        constexpr int NG = 8 * 4 * 2 * 16;
        constexpr int NS5 = NBATCH * NCH;
        for (int u = bid; u < NG + NS5; u += nb) {
            if (u < NG) {
                const int cg = u & 15, dir = (u >> 4) & 1, h = (u >> 5) & 3, b = u >> 7;
                if (dir == 0) rec_pass1_unit<64, true, 0>(p, smem, p.P, b, h, cg, p.gslots, p.gdecs);
                else rec_pass1_unit<64, true, 1>(p, smem, p.P, b, h, cg, p.gslots, p.gdecs);
            } else { const int v = u - NG; s5_pass1_unit(p, smem, v / NCH, v % NCH); }
        }
    } else {
        constexpr int NG = 8 * 8 * 2 * 8;
        for (int u = bid; u < NG; u += nb) {
            const int cg = u & 7, dir = (u >> 3) & 1, h = (u >> 4) & 7, b = u >> 7;
            if (dir == 0) rec_pass1_unit<128, false, 0>(p, smem, p.P, b, h, cg, p.hslots, p.hdecs);
            else rec_pass1_unit<128, false, 1>(p, smem, p.P, b, h, cg, p.hslots, p.hdecs);
        }
    }
}
template <int LAYER>
DEVINL void phase_scan(const Params& p, char* smem, int bid, int nb) {
    if (LAYER == 0) { rec_scan<64, true>(p.gslots, p.gdecs, bid, nb); s5_scan(p, bid, nb); }
    else rec_scan<128, false>(p.hslots, p.hdecs, bid, nb);
}
template <int LAYER>
DEVINL void phase_rec3(const Params& p, char* smem, int bid, int nb) {
    if (LAYER == 0) {
        constexpr int NG = 8 * 4 * 17;
        constexpr int NS5 = NBATCH * NCH;
        for (int u = bid; u < NG + NS5; u += nb) {
            if (u < NG) { const int gi = u % 17, h = (u / 17) & 3, b = u / 68; rec_pass3_unit<64, true>(p, smem, p.P, p.H, b, h, gi, p.gslots, p.gla_norm); }
            else { const int v = u - NG; s5_pass3_unit(p, smem, v / NCH, v % NCH); }
        }
    } else {
        constexpr int NG = 8 * 8 * 8;
        for (int u = bid; u < NG; u += nb) { const int gi = u & 7, h = (u >> 3) & 7, b = u >> 6; rec_pass3_unit<128, false>(p, smem, p.P, p.H, b, h, gi, p.hslots, p.hg_norm); }
    }
}

DEVINL void phase_final(const Params& p, int bid, int nb) {
    const int t = tid_opaque(), w = t >> 6, lane = t & 63;
    for (int rg = bid; rg < NLAT / 8; rg += nb) {
        float* res = p.out + (size_t)(rg * 8 + w) * D;
        f32x4 v[4];
        float ss = 0.f;
#pragma unroll
        for (int i = 0; i < 4; ++i) { v[i] = *(const f32x4*)(res + lane * 4 + i * 256); ss += v[i][0] * v[i][0] + v[i][1] * v[i][1] + v[i][2] * v[i][2] + v[i][3] * v[i][3]; }
#pragma unroll
        for (int o = 32; o >= 1; o >>= 1) ss += __shfl_xor(ss, o);
        const float rstd = rsqrtf(ss * (1.0f / 1024.0f) + EPS);
#pragma unroll
        for (int i = 0; i < 4; ++i) { const f32x4 g4 = *(const f32x4*)(p.final_norm + lane * 4 + i * 256); *(f32x4*)(res + lane * 4 + i * 256) = v[i] * rstd * g4; }
    }
}

constexpr int NPHASE = 23;
constexpr int MEGA_LDS = LDS_BYTES + 16 + 1024;
static_assert(sizeof(Params) <= 1024 && sizeof(Params) % 8 == 0, "params block");
template <int PH>
DEVINL void run_phase(const Params& p, char* smem, int bid, int nb) {
    if (PH == 0) phase_prologue(p, smem, bid, nb);
    if (PH == 1) phase_pre<0>(p, smem, bid, nb);
    if (PH == 2) phase_gemm<0>(p, smem, bid, nb);
    if (PH == 3) phase_rec1<0>(p, smem, bid, nb);
    if (PH == 4) phase_scan<0>(p, smem, bid, nb);
    if (PH == 5) phase_rec3<0>(p, smem, bid, nb);
    if (PH == 6) phase_gemm<1>(p, smem, bid, nb);
    if (PH == 7) phase_gemm<2>(p, smem, bid, nb);
    if (PH == 8) phase_pre<1>(p, smem, bid, nb);
    if (PH == 9) phase_list<0>(p, smem, bid, nb);
    if (PH == 10) phase_moe<0, 1>(p, smem, bid, nb);
    if (PH == 11) phase_moe<0, 2>(p, smem, bid, nb);
    if (PH == 12) phase_pre<2>(p, smem, bid, nb);
    if (PH == 13) phase_gemm<3>(p, smem, bid, nb);
    if (PH == 14) phase_rec1<1>(p, smem, bid, nb);
    if (PH == 15) phase_scan<1>(p, smem, bid, nb);
    if (PH == 16) phase_rec3<1>(p, smem, bid, nb);
    if (PH == 17) phase_gemm<4>(p, smem, bid, nb);
    if (PH == 18) phase_pre<3>(p, smem, bid, nb);
    if (PH == 19) phase_list<1>(p, smem, bid, nb);
    if (PH == 20) phase_moe<1, 1>(p, smem, bid, nb);
    if (PH == 21) phase_moe<1, 2>(p, smem, bid, nb);
    if (PH == 22) phase_final(p, bid, nb);
}

extern __shared__ __attribute__((aligned(16))) char dyn_smem[];

#if ONE_LAUNCH
template <int PH> struct PhaseSeq {
    static DEVINL void run(const Params& p, char* smem, const XcdBarrier& bar) {
        PhaseSeq<PH - 1>::run(p, smem, bar);
        xcd_barrier(bar);
        run_phase<PH>(p, smem, (int)blockIdx.x, (int)gridDim.x);
#ifdef DUP_MASK
        if ((DUP_MASK >> PH) & 1) { xcd_barrier(bar); run_phase<PH>(p, smem, (int)blockIdx.x, (int)gridDim.x); }
#endif
    }
};
template <> struct PhaseSeq<0> {
    static DEVINL void run(const Params& p, char* smem, const XcdBarrier& bar) {
        run_phase<0>(p, smem, (int)blockIdx.x, (int)gridDim.x);
#ifdef DUP_MASK
        if (DUP_MASK & 1) { xcd_barrier(bar); run_phase<0>(p, smem, (int)blockIdx.x, (int)gridDim.x); }
#endif
    }
};
__global__ void __launch_bounds__(NTHR, 2) mega_kernel(Params pk) {
    volatile LAS unsigned* st = (volatile LAS unsigned*)(dyn_smem + LDS_BYTES);
    unsigned long long* lp = (unsigned long long*)(dyn_smem + LDS_BYTES + 16);
    const unsigned long long* ka = (const unsigned long long*)__builtin_amdgcn_kernarg_segment_ptr();
    if (threadIdx.x < sizeof(Params) / 8) lp[threadIdx.x] = ka[threadIdx.x];
    if (threadIdx.x == 0) { st[0] = 0u; st[1] = 0u; st[2] = 0u; st[3] = 0u; }
    __syncthreads();
    const Params& p = *(const Params*)lp;
    XcdBarrier bar = xcd_barrier_post(p.bar, st);
    PhaseSeq<NPHASE - 1>::run(p, dyn_smem, bar);
}
#else
template <int PH>
__global__ void __launch_bounds__(NTHR, 2) phase_kernel(Params p) {
    run_phase<PH>(p, dyn_smem, (int)blockIdx.x, (int)gridDim.x);
}
template <int PH> struct Launcher {
    static void go(const Params& p, int grid, hipStream_t s) {
        Launcher<PH - 1>::go(p, grid, s);
        static bool attr = false;
        if (!attr) { hipFuncSetAttribute((const void*)phase_kernel<PH>, hipFuncAttributeMaxDynamicSharedMemorySize, LDS_BYTES + 16); attr = true; }
        phase_kernel<PH><<<grid, NTHR, LDS_BYTES + 16, s>>>(p);
    }
};
template <> struct Launcher<-1> { static void go(const Params&, int, hipStream_t) {} };
#endif

static size_t align_up(size_t v, size_t a) { return (v + a - 1) / a * a; }

extern "C" void kernel_launch(void* const* d_in, const int* in_sizes, int n_in, void* d_out, int out_size, void* d_ws, size_t ws_size, hipStream_t stream) {
    (void)in_sizes; (void)n_in; (void)out_size;
    Params p;
    memset(&p, 0, sizeof(p));
    const float* const* in = (const float* const*)d_in;
    p.x = in[0]; p.c = in[1]; p.ctx = in[2]; p.c_ctx = in[3]; p.ada_w = in[4]; p.ada_b = in[5]; p.norm_mix = in[6]; p.norm_ffn = in[7];
    p.ab_w_in = in[8]; p.ab_w_out = in[9]; p.gla_a2 = in[10]; p.gla_ab = in[11]; p.gla_norm = in[12];
    p.s5_lam_re = in[13]; p.s5_lam_im = in[14]; p.s5_log_dt = in[15]; p.s5_b_re = in[16]; p.s5_b_im = in[17]; p.s5_c_re = in[18]; p.s5_c_im = in[19];
    p.s5_d = in[20]; p.glu_w = in[21]; p.glu_b = in[22]; p.hg_w_in = in[23]; p.hg_w_out = in[24]; p.hg_lb = in[25]; p.hg_norm = in[26];
    p.router_w = in[27]; p.router_bias = in[28]; p.moe_wg = in[29]; p.moe_wu = in[30]; p.moe_wd = in[31]; p.final_norm = in[32];
    p.out = (float*)d_out;

    char* ws = (char*)d_ws;
    size_t o = 0;
    auto take = [&](size_t bytes) { char* r = ws + o; o = align_up(o + bytes, 256); return r; };
    p.bar = (unsigned*)take(XCD_BAR_WORDS * 4);
    p.cnt = (int*)take(256 * 4);
    p.mod = (float*)take((size_t)2 * 9 * 6144 * 4);
    p.pos = (float*)take(64 * 512 * 4);
    p.lb = (float*)take(1024 * 4);
    p.atab = (float*)take(2 * 32 * 64 * 2 * 4);
    p.a64tab = (float*)take(2 * 32 * 64 * 2 * 4);
    p.bbtab = (float*)take((size_t)2 * 32 * 64 * 32 * 4);
    p.cmt = (bf16_t*)take((size_t)32 * 16 * 256 * 2);
    p.bbm = (bf16_t*)take((size_t)2 * 32 * 128 * 16 * 2);
    p.wrt = (bf16_t*)take((size_t)2 * 2 * 32 * 1024 * 2);
    p.RT = (float4*)take((size_t)R * 16);
    p.list = (int*)take((size_t)ACT_ROWS * 4);
    p.wl = (float*)take((size_t)ACT_ROWS * 4);
    p.wh = (float*)take((size_t)ACT_ROWS * 4);
    p.cx = (float*)take((size_t)NBATCH * CTXL * D * 4);
    p.wt_in0 = (bf16_t*)take((size_t)2048 * 1024 * 2);
    p.wt_out0 = (bf16_t*)take((size_t)1024 * 1024 * 2);
    p.glu_t = (bf16_t*)take((size_t)512 * 512 * 2);
    p.wt_in1 = (bf16_t*)take((size_t)5120 * 1024 * 2);
    p.wt_out1 = (bf16_t*)take((size_t)1024 * 1024 * 2);
    p.H = (bf16_t*)take((size_t)R * 1024 * 2);
    const size_t big = o;
    p.P = (bf16_t*)(ws + big);
    size_t o0 = big + (size_t)R * 2048 * 2;
    auto take0 = [&](size_t bytes) { char* r = ws + o0; o0 = align_up(o0 + bytes, 256); return r; };
    p.gslots = (float*)take0((size_t)64 * 16 * 128 * 64 * 4);
    p.gdecs = (float*)take0((size_t)64 * 16 * 64 * 4);
    p.s5xend = (float*)take0((size_t)NBATCH * 2 * NCH * 32 * 64 * 2 * 4);
    p.s5carry = (float*)take0((size_t)NBATCH * 2 * NCH * 32 * 64 * 2 * 4);
    p.s5a = (bf16_t*)take0((size_t)R * 512 * 2);
    p.AF = (float*)take0((size_t)R * 32 * 4);
    p.wgu_t = (bf16_t*)take0((size_t)32 * 512 * 1024 * 2);
    p.wd_t = (bf16_t*)take0((size_t)32 * 1024 * 256 * 2);
    p.hs = (bf16_t*)(ws + big);
    p.act = (bf16_t*)(ws + big + (size_t)ACT_ROWS * 1024 * 2);
    if (big + (size_t)ACT_ROWS * 1024 * 2 + (size_t)ACT_ROWS * 512 * 2 > (size_t)((char*)p.s5a - ws)) fprintf(stderr, "moe overlay overlaps live buffers\n");
    size_t o1 = big + (size_t)R * 5120 * 2;
    auto take1 = [&](size_t bytes) { char* r = ws + o1; o1 = align_up(o1 + bytes, 256); return r; };
    p.hslots = (float*)take1((size_t)128 * 8 * 128 * 128 * 4);
    p.hdecs = (float*)take1((size_t)128 * 8 * 128 * 4);
    const size_t need = o0 > o1 ? o0 : o1;
    if (need > ws_size) fprintf(stderr, "workspace too small: need %zu have %zu\n", need, ws_size);

    const int grid = 256;
#if ONE_LAUNCH
    static bool attr = false;
    if (!attr) { hipFuncSetAttribute((const void*)mega_kernel, hipFuncAttributeMaxDynamicSharedMemorySize, MEGA_LDS); attr = true; }
    hipMemsetAsync(p.bar, 0, XCD_BAR_WORDS * 4, stream);
    mega_kernel<<<grid, NTHR, MEGA_LDS, stream>>>(p);
#else
    Launcher<NPHASE - 1>::go(p, grid, stream);
#endif
}
```

```cpp
#include <hip/hip_runtime.h>
#include <stdint.h>
#include <string.h>
#include <stdio.h>

#ifndef ONE_LAUNCH
#define ONE_LAUNCH 1
#endif

typedef unsigned short bf16_t;
typedef short bf16x8 __attribute__((ext_vector_type(8)));
typedef float f32x4 __attribute__((ext_vector_type(4)));
typedef unsigned u32x4 __attribute__((ext_vector_type(4)));
typedef unsigned u32x2 __attribute__((ext_vector_type(2)));
#define DEVINL __device__ __forceinline__

constexpr int D = 1024, NBATCH = 8, SEQ = 4096, CTXL = 256;
constexpr int RPB = SEQ + CTXL;
constexpr int R = NBATCH * RPB;
constexpr int NLAT = NBATCH * SEQ;
constexpr int NCH = RPB / 64;
constexpr float EPS = 1e-6f;
constexpr int NTHR = 512;
constexpr int LDS_BYTES = 136 * 1024;
constexpr int ACT_ROWS = 47104;

#define XB_TMO      128
#define XB_XCNT(j)  (256  + 64 * (j))
#define XB_XSUB(j)  (1280 + 64 * (j))
#define XB_XGEN(j)  (2304 + 64 * (j))
#define XB_TOP      3328
#define XB_TOPGEN   3392
#define XCD_BAR_WORDS 3456
#define XB_SPIN_CAP (1u << 18)
#define LAS __attribute__((address_space(3)))

__device__ __forceinline__ unsigned xb_ld(unsigned* p)              { return __hip_atomic_load(p, __ATOMIC_RELAXED, __HIP_MEMORY_SCOPE_AGENT); }
__device__ __forceinline__ unsigned xb_add(unsigned* p, unsigned v) { return __hip_atomic_fetch_add(p, v, __ATOMIC_RELAXED, __HIP_MEMORY_SCOPE_AGENT); }
__device__ __forceinline__ unsigned xb_xcc_id() { return (unsigned)__builtin_amdgcn_s_getreg((3 << 11) | 20) & 0xFu; }
#define XB_SPIN(cond, bar) do { unsigned _sp = 0; while (cond) { __builtin_amdgcn_s_sleep(1); \
    if ((++_sp & 255u) == 0u) { if (xb_ld(&(bar)[XB_TMO])) break; if (_sp > XB_SPIN_CAP) { atomicAdd(&(bar)[XB_TMO], 1u); break; } } } } while (0)

struct XcdBarrier {
    unsigned* bar; unsigned x;
    volatile LAS unsigned* st;
};
__device__ __forceinline__ XcdBarrier xcd_barrier_post(unsigned* bar, volatile LAS unsigned* st) {
    XcdBarrier b; b.bar = bar; b.x = xb_xcc_id(); b.st = st;
    if (threadIdx.x == 0) (void)xb_add(&bar[XB_XCNT(b.x)], 1u);
    return b;
}
__device__ __forceinline__ void xcd_barrier_complete(unsigned* bar, unsigned x, unsigned& nloc, unsigned& nx) {
    const unsigned G = gridDim.x * gridDim.y * gridDim.z;
    unsigned sum, cnt, mine, sp = 0u;
    for (;;) {
        sum = 0u; cnt = 0u; mine = 0u;
#pragma unroll
        for (unsigned j = 0; j < 16; ++j) { const unsigned c = xb_ld(&bar[XB_XCNT(j)]); sum += c; cnt += (c > 0u) ? 1u : 0u; mine = (j == x) ? c : mine; }
        if (sum == G) break;
        __builtin_amdgcn_s_sleep(1);
        if ((++sp & 255u) == 0u) { if (xb_ld(&bar[XB_TMO])) break; if (sp > XB_SPIN_CAP) { atomicAdd(&bar[XB_TMO], 1u); break; } }
    }
    nloc = mine > 0u ? mine : 1u; nx = cnt > 0u ? cnt : 1u;
}
__device__ __forceinline__ void xcd_barrier(const XcdBarrier& b) {
    asm volatile("s_waitcnt vmcnt(0)" ::: "memory");
    __syncthreads();
    if (threadIdx.x == 0) {
        unsigned* bar = b.bar;
        __builtin_amdgcn_s_waitcnt(0);
        unsigned nloc = b.st[0], nx = b.st[1];
        if (nloc == 0u) { xcd_barrier_complete(bar, b.x, nloc, nx); b.st[0] = nloc; b.st[1] = nx; }
        const unsigned old = xb_add(&bar[XB_XSUB(b.x)], 1u);
        const unsigned gen = old / nloc;
        if (old + 1u == (gen + 1u) * nloc) {
            __builtin_amdgcn_fence(__ATOMIC_RELEASE, "agent");
            asm volatile("s_waitcnt vmcnt(0)" ::: "memory");
            const unsigned og = xb_add(&bar[XB_TOP], 1u);
            const unsigned tg = og / nx;
            if (og + 1u == (tg + 1u) * nx) xb_add(&bar[XB_TOPGEN], 1u);
            else XB_SPIN(xb_ld(&bar[XB_TOPGEN]) == tg, bar);
            __builtin_amdgcn_fence(__ATOMIC_ACQUIRE, "agent");
            xb_add(&bar[XB_XGEN(b.x)], 1u);
            asm volatile("s_waitcnt vmcnt(0)" ::: "memory");
        } else {
            XB_SPIN(xb_ld(&bar[XB_XGEN(b.x)]) == gen, bar);
            __builtin_amdgcn_fence(__ATOMIC_ACQUIRE, "agent");
            asm volatile("s_waitcnt vmcnt(0)" ::: "memory");
        }
    }
    __syncthreads();
}

struct Params {
    const float *x, *c, *ctx, *c_ctx, *ada_w, *ada_b, *norm_mix, *norm_ffn, *ab_w_in, *ab_w_out, *gla_a2, *gla_ab, *gla_norm;
    const float *s5_lam_re, *s5_lam_im, *s5_log_dt, *s5_b_re, *s5_b_im, *s5_c_re, *s5_c_im, *s5_d, *glu_w, *glu_b;
    const float *hg_w_in, *hg_w_out, *hg_lb, *hg_norm, *router_w, *router_bias, *moe_wg, *moe_wu, *moe_wd, *final_norm;
    float* out;
    unsigned* bar;
    int* cnt;
    float *mod, *pos, *lb, *atab, *a64tab;
    bf16_t* cmt; bf16_t* bbm; bf16_t* wrt;
    float4* RT;
    int* list; float *wl, *wh;
    float* cx;
    bf16_t *wt_in0, *wt_out0, *glu_t, *wt_in1, *wt_out1;
    bf16_t* H;
    bf16_t* P;
    float *gslots, *gdecs;
    float *s5xend, *s5carry;
    bf16_t* s5a;
    bf16_t *wgu_t, *wd_t, *act, *hs;
    float* AF;
    float *hslots, *hdecs;
};

DEVINL int tid_opaque() { int t = threadIdx.x; asm volatile("" : "+v"(t)); return t; }
DEVINL int sgpr(int v) { return __builtin_amdgcn_readfirstlane(v); }
template <class T> DEVINL T* sgpr_ptr(T* ptr) {
    const unsigned long long v = (unsigned long long)ptr;
    const unsigned lo = (unsigned)__builtin_amdgcn_readfirstlane((int)(unsigned)v), hi = (unsigned)__builtin_amdgcn_readfirstlane((int)(unsigned)(v >> 32));
    return (T*)(((unsigned long long)hi << 32) | lo);
}
DEVINL unsigned cvt_pk_bf16(float lo, float hi) { unsigned r; asm volatile("v_cvt_pk_bf16_f32 %0, %1, %2" : "=v"(r) : "v"(lo), "v"(hi)); return r; }
DEVINL float bf2f(bf16_t v) { return __uint_as_float(((unsigned)v) << 16); }
DEVINL bf16_t f2bf(float f) { unsigned u = __float_as_uint(f); u += 0x7fffu + ((u >> 16) & 1u); return (bf16_t)(u >> 16); }
DEVINL unsigned pk2(float lo, float hi) { return cvt_pk_bf16(lo, hi); }
DEVINL u32x2 pk4(f32x4 v) { u32x2 r; r.x = pk2(v[0], v[1]); r.y = pk2(v[2], v[3]); return r; }
DEVINL float h2f(unsigned short v) { return (float)__builtin_bit_cast(_Float16, v); }
DEVINL unsigned short f2h(float f) { return __builtin_bit_cast(unsigned short, (_Float16)f); }
DEVINL float sigmoidf_(float x) { return 1.0f / (1.0f + __expf(-x)); }
DEVINL float siluf_(float x) { return x * sigmoidf_(x); }
DEVINL float logsigmoidf_(float x) { return fminf(x, 0.0f) - __logf(1.0f + __expf(-fabsf(x))); }
DEVINL float gelu_tanh(float y) { float z = 0.7978845608028654f * (y + 0.044715f * y * y * y); float th = 1.0f - 2.0f / (__expf(2.0f * z) + 1.0f); return 0.5f * y * (1.0f + th); }
DEVINL float* resid_row(const Params& p, int r) {
    const int b = r / RPB, j = r - b * RPB;
    return (j < CTXL) ? (p.cx + (size_t)(b * CTXL + j) * D) : (p.out + (size_t)(b * SEQ + (j - CTXL)) * D);
}
DEVINL int row_batch_mod(int r) { const int b = r / RPB, j = r - b * RPB; return (j < CTXL) ? 8 : b; }

template <int K>
DEVINL f32x4 mma_lds(f32x4 c, const bf16_t* A, int lda, const bf16_t* Bt, int ldb, int fr, int fq) {
#pragma unroll
    for (int k0 = 0; k0 < K; k0 += 32) {
        const bf16x8 a = *(const bf16x8*)(A + fr * lda + k0 + fq * 8);
        const bf16x8 b = *(const bf16x8*)(Bt + fr * ldb + k0 + fq * 8);
        c = __builtin_amdgcn_mfma_f32_16x16x32_bf16(b, a, c, 0, 0, 0);
    }
    return c;
}

DEVINL void cvt_tile(const float* colp, int ld, int k0, int n0, bf16_t* dst, int ldd, char* smem, int lrow = -1) {
    float (*T)[257] = (float (*)[257])smem;
    const int t = tid_opaque(), nl = lrow >= 0 ? lrow : (t & 63), ks = t >> 6;
    const float* sp = colp + (size_t)(k0 + ks * 32) * ld;
#pragma unroll
    for (int i0 = 0; i0 < 32; i0 += 16) {
        float v[16];
#pragma unroll
        for (int i = 0; i < 16; ++i) v[i] = sp[(size_t)(i0 + i) * ld];
#pragma unroll
        for (int i = 0; i < 16; ++i) T[nl][ks * 32 + i0 + i] = v[i];
    }
    __syncthreads();
    const int n2 = t >> 3, kc = t & 7;
#pragma unroll
    for (int j = 0; j < 4; ++j) {
        const int k = j * 64 + kc * 8;
        u32x4 v;
        v.x = pk2(T[n2][k + 0], T[n2][k + 1]); v.y = pk2(T[n2][k + 2], T[n2][k + 3]);
        v.z = pk2(T[n2][k + 4], T[n2][k + 5]); v.w = pk2(T[n2][k + 6], T[n2][k + 7]);
        *(u32x4*)(dst + (size_t)(n0 + n2) * ldd + k0 + k) = v;
    }
    __syncthreads();
}

constexpr int NT_GU = 1024, NT_WD = 512;
DEVINL void moe_cvt_task(const Params& p, int layer, int tid, char* smem) {
    if (tid < NT_GU) {
        const int e = tid >> 5, rem = tid & 31, nb = rem >> 2, kb = rem & 3;
        const float* wg = p.moe_wg + (size_t)(layer * 32 + e) * 1024 * 256;
        const float* wu = p.moe_wu + (size_t)(layer * 32 + e) * 1024 * 256;
        const int nl = tid_opaque() & 63, isup = nl >> 5, ul = nl & 31;
        const int ub = (nb >> 2) * 128 + (nb & 3) * 32;
        const float* cp = (isup ? wu : wg) + ub + ul;
        const int lrow = (ul >> 2) * 8 + isup * 4 + (ul & 3);
        cvt_tile(cp, 256, kb * 256, nb * 64, p.wgu_t + (size_t)e * 512 * 1024, 1024, smem, lrow);
    } else {
        const int t2 = tid - NT_GU, e = t2 >> 4, nb = t2 & 15;
        const float* wd = p.moe_wd + (size_t)(layer * 32 + e) * 256 * 1024;
        cvt_tile(wd + nb * 64 + (tid_opaque() & 63), 1024, 0, nb * 64, p.wd_t + (size_t)e * 1024 * 256, 256, smem);
    }
}

constexpr int NT_MISC = 9, NT_MOD = 192, NT_IN0 = 128, NT_OUT0 = 64, NT_GLU = 16, NT_IN1 = 320, NT_OUT1 = 64, NT_POS = 64, NT_S5 = 64;
constexpr int T0_MOD = NT_MISC, T0_IN0 = T0_MOD + NT_MOD, T0_OUT0 = T0_IN0 + NT_IN0, T0_GLU = T0_OUT0 + NT_OUT0, T0_IN1 = T0_GLU + NT_GLU, T0_OUT1 = T0_IN1 + NT_IN1,
              T0_MOE = T0_OUT1 + NT_OUT1, T0_POS = T0_MOE + NT_GU + NT_WD, T0_S5 = T0_POS + NT_POS, T0_END = T0_S5 + NT_S5;

DEVINL void prologue_task(const Params& p, char* smem, int task) {
    const int t = tid_opaque();
    {
        if (task < T0_MOD) {
            if (task == 0) {
                for (int i = t; i < 1024; i += NTHR) p.lb[i] = sigmoidf_(p.hg_lb[1024 + i] - p.hg_lb[i]);
            } else {
                for (int i = (task - 1) * 8192 + t; i < task * 8192; i += NTHR) {
                    const int which = i >> 15, e = (i >> 10) & 31, k = i & 1023;
                    const float v = which ? p.ab_w_in[(size_t)k * 2080 + 1536 + e] : p.router_w[k * 32 + e];
                    const bf16_t hi = f2bf(v); const bf16_t lo = f2bf(v - bf2f(hi));
                    p.wrt[((size_t)(which * 2 + 0) * 32 + e) * 1024 + k] = hi;
                    p.wrt[((size_t)(which * 2 + 1) * 32 + e) * 1024 + k] = lo;
                }
            }
        } else if (task < T0_IN0) {
            float* sc = (float*)smem;
            float* red = sc + 9 * 1024;
            for (int i = t; i < 9 * 1024; i += NTHR) { const int rr = i >> 10, k = i & 1023; const float v = rr < 8 ? p.c[rr * 1024 + k] : p.c_ctx[k]; sc[i] = siluf_(v); }
            __syncthreads();
            const int tk = task - T0_MOD, l = tk / 96, c0 = (tk % 96) * 64, col = t & 63, kp = t >> 6;
            const float* wp = p.ada_w + ((size_t)l * 1024 + kp * 128) * 6144 + c0 + col;
            float acc[9];
#pragma unroll
            for (int rr = 0; rr < 9; ++rr) acc[rr] = 0.f;
#pragma unroll 1
            for (int k = 0; k < 128; k += 16) {
                float w16[16];
#pragma unroll
                for (int j = 0; j < 16; ++j) w16[j] = wp[(size_t)(k + j) * 6144];
#pragma unroll
                for (int rr = 0; rr < 9; ++rr) {
#pragma unroll
                    for (int j = 0; j < 16; j += 4) {
                        const f32x4 s4 = *(const f32x4*)&sc[rr * 1024 + kp * 128 + k + j];
                        acc[rr] += s4[0] * w16[j] + s4[1] * w16[j + 1] + s4[2] * w16[j + 2] + s4[3] * w16[j + 3];
                    }
                }
            }
#pragma unroll
            for (int rr = 0; rr < 9; ++rr) red[(kp * 9 + rr) * 64 + col] = acc[rr];
            __syncthreads();
            for (int o = t; o < 576; o += NTHR) {
                const int rr = o >> 6, cc = o & 63;
                float sv = p.ada_b[l * 6144 + c0 + cc];
#pragma unroll
                for (int q = 0; q < 8; ++q) sv += red[(q * 9 + rr) * 64 + cc];
                p.mod[((size_t)l * 9 + rr) * 6144 + c0 + cc] = sv;
            }
            __syncthreads();
        } else if (task < T0_OUT0) {
            const int tt = task - T0_IN0, nbk = tt >> 2, kb = tt & 3;
            const int n = nbk * 64 + (t & 63);
            const float* cp = p.ab_w_in + (n < 1536 ? n : n + 32);
            cvt_tile(cp, 2080, kb * 256, nbk * 64, p.wt_in0, 1024, smem);
        } else if (task < T0_GLU) {
            const int tt = task - T0_OUT0, nbk = tt >> 2, kb = tt & 3;
            cvt_tile(p.ab_w_out + nbk * 64 + (t & 63), 1024, kb * 256, nbk * 64, p.wt_out0, 1024, smem);
        } else if (task < T0_IN1) {
            const int tt = task - T0_GLU, nbk = tt >> 1, kb = tt & 1;
            cvt_tile(p.glu_w + nbk * 64 + (t & 63), 512, kb * 256, nbk * 64, p.glu_t, 512, smem);
        } else if (task < T0_OUT1) {
            const int tt = task - T0_IN1, nbk = tt >> 2, kb = tt & 3;
            cvt_tile(p.hg_w_in + nbk * 64 + (t & 63), 5120, kb * 256, nbk * 64, p.wt_in1, 1024, smem);
        } else if (task < T0_MOE) {
            const int tt = task - T0_OUT1, nbk = tt >> 2, kb = tt & 3;
            cvt_tile(p.hg_w_out + nbk * 64 + (t & 63), 1024, kb * 256, nbk * 64, p.wt_out1, 1024, smem);
        } else if (task < T0_POS) {
            moe_cvt_task(p, 0, task - T0_MOE, smem);
        } else if (task < T0_S5) {
            const int pi = task - T0_POS;
            const int j = t, jj = j & 255;
            const float omega = __expf(-9.210340371976184f * (float)jj * (1.0f / 256.0f));
            const float ang = (float)pi * omega;
            p.pos[pi * 512 + j] = (j < 256) ? sinf(ang) : cosf(ang);
        } else {
            const int tt = task - T0_S5, di = tt >> 5, g = tt & 31;
            const int pp = t & 63, hs = t >> 6;
            const float dt = __expf(p.s5_log_dt[di * 32 + g]);
            const float lr = p.s5_lam_re[(di * 32 + g) * 64 + pp], li = p.s5_lam_im[(di * 32 + g) * 64 + pp];
            const float mag = __expf(lr * dt);
            const float are = mag * cosf(li * dt), aim = mag * sinf(li * dt);
            const float den = lr * lr + li * li;
            const float fre = ((are - 1.0f) * lr + aim * li) / den;
            const float fim = (aim * lr - (are - 1.0f) * li) / den;
            if (hs == 0) {
                p.atab[((di * 32 + g) * 64 + pp) * 2 + 0] = are; p.atab[((di * 32 + g) * 64 + pp) * 2 + 1] = aim;
                float xr = are, xi = aim;
#pragma unroll
                for (int q = 0; q < 6; ++q) { const float nr = xr * xr - xi * xi, ni = 2.0f * xr * xi; xr = nr; xi = ni; }
                p.a64tab[((di * 32 + g) * 64 + pp) * 2 + 0] = xr; p.a64tab[((di * 32 + g) * 64 + pp) * 2 + 1] = xi;
            }
#pragma unroll
            for (int q = 0; q < 2; ++q) {
                const int h = hs * 2 + q;
                const float bre = p.s5_b_re[((size_t)((di * 32 + g) * 64 + pp)) * 16 + h], bim = p.s5_b_im[((size_t)((di * 32 + g) * 64 + pp)) * 16 + h];
                p.bbm[((size_t)((di * 32 + g) * 128 + pp)) * 16 + h] = f2bf(fre * bre - fim * bim);
                p.bbm[((size_t)((di * 32 + g) * 128 + 64 + pp)) * 16 + h] = f2bf(fre * bim + fim * bre);
                const float cre = p.s5_c_re[((size_t)((di * 32 + g) * 16 + h)) * 64 + pp], cim = p.s5_c_im[((size_t)((di * 32 + g) * 16 + h)) * 64 + pp];
                bf16_t* cm = p.cmt + ((size_t)(g * 16 + h)) * 256 + di * 128;
                cm[pp] = f2bf(cre); cm[64 + pp] = f2bf(-cim);
            }
        }
    }
}

constexpr int PRE_LD = 1028;
template <int MODE>
DEVINL void phase_pre(const Params& p, char* smem, int bid, int nb) {
    constexpr bool GEMV = (MODE == 0 || MODE == 1 || MODE == 3);
    constexpr int L = (MODE >= 2) ? 1 : 0;
    constexpr bool FFN = (MODE == 1 || MODE == 3);
    float* hrow = (float*)smem;
    float* part = hrow + 16 * PRE_LD;
    float* logit = part + 8 * 16 * 32;
    int* lcnt = (int*)(logit + 512);
    static_assert((16 * PRE_LD + 8 * 16 * 32 + 512 + 64) * 4 <= LDS_BYTES, "pre lds");
    const int t = tid_opaque(), w = t >> 6, lane = t & 63, fr = lane & 15, fq = lane >> 4;
    bf16x8 bh[4][2], bl[4][2];
    if (GEMV) {
        const bf16_t* wt = p.wrt + (size_t)(MODE == 0 ? 1 : 0) * 2 * 32 * 1024;
#pragma unroll
        for (int ks = 0; ks < 4; ++ks)
#pragma unroll
            for (int nt = 0; nt < 2; ++nt) {
                const size_t off = (size_t)(nt * 16 + fr) * 1024 + w * 128 + ks * 32 + fq * 8;
                bh[ks][nt] = *(const bf16x8*)(wt + off);
                bl[ks][nt] = *(const bf16x8*)(wt + 32 * 1024 + off);
            }
    }
    if (FFN) { if (t < 64) lcnt[t] = 0; }
    __syncthreads();
    const float* gain = (FFN ? p.norm_ffn : p.norm_mix) + L * 1024;
    const int ngroups = (MODE == 3) ? (NLAT / 16) : (R / 16);
    for (int rg = bid; rg < ngroups; rg += nb) {
#pragma unroll
        for (int rw = 0; rw < 2; ++rw) {
            const int lrow = w * 2 + rw;
            int r;
            if (MODE == 3) { const int i = rg * 16 + lrow; r = (i >> 12) * RPB + CTXL + (i & 4095); } else r = rg * 16 + lrow;
            const int b = r / RPB, j = r - b * RPB;
            const bool isctx = j < CTXL;
            const float* modv = p.mod + ((size_t)(L * 9 + (isctx ? 8 : b))) * 6144 + (FFN ? 3072 : 0);
            float* res = isctx ? (p.cx + (size_t)(b * CTXL + j) * D) : (p.out + (size_t)(b * SEQ + (j - CTXL)) * D);
            f32x4 v[4];
            if (MODE == 0) {
                const float* src = isctx ? (p.ctx + (size_t)(b * CTXL + j) * D) : (p.x + (size_t)(b * SEQ + (j - CTXL)) * D);
#pragma unroll
                for (int i = 0; i < 4; ++i) v[i] = *(const f32x4*)(src + lane * 4 + i * 256);
                if (!isctx) {
                    const int n = j - CTXL, prow = n >> 6, pcol = n & 63;
#pragma unroll
                    for (int i = 0; i < 4; ++i) {
                        const int c = lane * 4 + i * 256;
                        const f32x4 pe = (c < 512) ? *(const f32x4*)(p.pos + prow * 512 + c) : *(const f32x4*)(p.pos + pcol * 512 + (c - 512));
                        v[i] += pe;
                    }
                }
#pragma unroll
                for (int i = 0; i < 4; ++i) *(f32x4*)(res + lane * 4 + i * 256) = v[i];
            } else {
#pragma unroll
                for (int i = 0; i < 4; ++i) v[i] = *(const f32x4*)(res + lane * 4 + i * 256);
            }
            float ss = 0.f;
#pragma unroll
            for (int i = 0; i < 4; ++i) ss += v[i][0] * v[i][0] + v[i][1] * v[i][1] + v[i][2] * v[i][2] + v[i][3] * v[i][3];
#pragma unroll
            for (int o = 32; o >= 1; o >>= 1) ss += __shfl_xor(ss, o);
            const float rstd = rsqrtf(ss * (1.0f / 1024.0f) + EPS);
#pragma unroll
            for (int i = 0; i < 4; ++i) {
                const int c = lane * 4 + i * 256;
                const f32x4 g4 = *(const f32x4*)(gain + c), sh4 = *(const f32x4*)(modv + c), sc4 = *(const f32x4*)(modv + 1024 + c);
                f32x4 hv;
#pragma unroll
                for (int q = 0; q < 4; ++q) hv[q] = v[i][q] * rstd * g4[q] * (1.0f + sc4[q]) + sh4[q];
                *(u32x2*)(p.H + (size_t)r * D + c) = pk4(hv);
                if (GEMV) *(f32x4*)(hrow + lrow * PRE_LD + c) = hv;
            }
        }
        if (GEMV) {
            __syncthreads();
            f32x4 c0 = (f32x4){0.f, 0.f, 0.f, 0.f}, c1 = c0;
#pragma unroll
            for (int ks = 0; ks < 4; ++ks) {
                const float* hp = hrow + fr * PRE_LD + w * 128 + ks * 32 + fq * 8;
                const f32x4 x0 = *(const f32x4*)hp, x1 = *(const f32x4*)(hp + 4);
                u32x4 hi, lo;
                hi.x = cvt_pk_bf16(x0[0], x0[1]); hi.y = cvt_pk_bf16(x0[2], x0[3]); hi.z = cvt_pk_bf16(x1[0], x1[1]); hi.w = cvt_pk_bf16(x1[2], x1[3]);
                lo.x = cvt_pk_bf16(x0[0] - __uint_as_float(hi.x << 16), x0[1] - __uint_as_float(hi.x & 0xffff0000u));
                lo.y = cvt_pk_bf16(x0[2] - __uint_as_float(hi.y << 16), x0[3] - __uint_as_float(hi.y & 0xffff0000u));
                lo.z = cvt_pk_bf16(x1[0] - __uint_as_float(hi.z << 16), x1[1] - __uint_as_float(hi.z & 0xffff0000u));
                lo.w = cvt_pk_bf16(x1[2] - __uint_as_float(hi.w << 16), x1[3] - __uint_as_float(hi.w & 0xffff0000u));
                const bf16x8 ah = __builtin_bit_cast(bf16x8, hi), al = __builtin_bit_cast(bf16x8, lo);
                c0 = __builtin_amdgcn_mfma_f32_16x16x32_bf16(bh[ks][0], ah, c0, 0, 0, 0);
                c0 = __builtin_amdgcn_mfma_f32_16x16x32_bf16(bl[ks][0], ah, c0, 0, 0, 0);
                c0 = __builtin_amdgcn_mfma_f32_16x16x32_bf16(bh[ks][0], al, c0, 0, 0, 0);
                c1 = __builtin_amdgcn_mfma_f32_16x16x32_bf16(bh[ks][1], ah, c1, 0, 0, 0);
                c1 = __builtin_amdgcn_mfma_f32_16x16x32_bf16(bl[ks][1], ah, c1, 0, 0, 0);
                c1 = __builtin_amdgcn_mfma_f32_16x16x32_bf16(bh[ks][1], al, c1, 0, 0, 0);
            }
            *(f32x4*)&part[(w * 16 + fr) * 32 + fq * 4] = c0;
            *(f32x4*)&part[(w * 16 + fr) * 32 + 16 + fq * 4] = c1;
            __syncthreads();
            {
                const int row = t >> 5, e2 = t & 31;
                float s = 0.f;
#pragma unroll
                for (int q = 0; q < 8; ++q) s += part[(q * 16 + row) * 32 + e2];
                if (MODE == 0) p.AF[(size_t)(rg * 16 + row) * 32 + e2] = s;
                else logit[row * 32 + e2] = s;
            }
            if (FFN) {
                __syncthreads();
                if (t < 16) {
                    int rr;
                    if (MODE == 3) { const int i = rg * 16 + t; rr = (i >> 12) * RPB + CTXL + (i & 4095); } else rr = rg * 16 + t;
                    float best = -3.0e38f; int bg = 0, bi1 = 0, bi2 = 1; float ba1 = 0.f, ba2 = 0.f;
#pragma unroll 1
                    for (int g = 0; g < 8; ++g) {
                        float m1 = -3.0e38f, m2 = -3.0e38f, a1 = 0.f, a2 = 0.f; int i1 = 0, i2 = 0;
#pragma unroll
                        for (int e = 0; e < 4; ++e) {
                            const float a = sigmoidf_(logit[t * 32 + g * 4 + e]);
                            const float sv = a + p.router_bias[g * 4 + e];
                            if (sv > m1) { m2 = m1; i2 = i1; a2 = a1; m1 = sv; i1 = e; a1 = a; }
                            else if (sv > m2) { m2 = sv; i2 = e; a2 = a; }
                        }
                        const float gs = m1 + m2;
                        if (gs > best) { best = gs; bg = g; bi1 = i1; bi2 = i2; ba1 = a1; ba2 = a2; }
                    }
                    const float inv = 1.0f / (ba1 + ba2);
                    const float w1 = ba1 * inv, w2 = ba2 * inv;
                    const int lo = bi1 < bi2 ? bi1 : bi2, hi = bi1 < bi2 ? bi2 : bi1;
                    const float wlo = bi1 < bi2 ? w1 : w2, whi = bi1 < bi2 ? w2 : w1;
                    const int pair = (lo == 0) ? (hi - 1) : (lo == 1 ? (hi + 1) : 5);
                    const int bucket = bg * 6 + pair;
                    float4 rec; rec.x = __int_as_float(bucket); rec.y = wlo; rec.z = whi; rec.w = 0.f;
                    p.RT[rr] = rec;
                    atomicAdd(&lcnt[bucket], 1);
                }
            }
            __syncthreads();
        }
    }
    if (FFN) {
        __syncthreads();
        if (t < 48 && lcnt[t] != 0) atomicAdd(&p.cnt[L * 64 + t], lcnt[t]);
    }
    if (MODE == 3) {
        __syncthreads();
        for (int task = bid; task < NT_GU + NT_WD; task += nb) moe_cvt_task(p, 1, task, smem);
    }
}

struct GemmSmem { bf16_t A[2][128][72]; bf16_t B[2][256][72]; };
static_assert(sizeof(GemmSmem) <= LDS_BYTES, "gemm lds");

template <class Epi>
DEVINL void gemm_tile(const bf16_t* __restrict__ A, int lda, const int* __restrict__ rowlist, int m0, int mvalid,
                      const bf16_t* __restrict__ Bt0, const bf16_t* __restrict__ Bt1, int ldb, int kseg, int K, Epi& epi, char* smem) {
    GemmSmem& S = *(GemmSmem*)smem;
    const int t = tid_opaque(), w = t >> 6, lane = t & 63, fr = lane & 15, fq = lane >> 4, wr = w >> 2, wc = w & 3;
    const int ch = t & 7, rr = t >> 3;
    const bf16_t* ap[2];
#pragma unroll
    for (int i = 0; i < 2; ++i) {
        const int ri = rr + i * 64, gi = ri < mvalid ? ri : 0;
        const int grow = rowlist ? rowlist[m0 + gi] : (m0 + gi);
        ap[i] = A + (size_t)grow * lda + ch * 8;
    }
    u32x4 ra[2], rb[4];
    f32x4 acc[4][4];
#pragma unroll
    for (int m = 0; m < 4; ++m)
#pragma unroll
        for (int n = 0; n < 4; ++n) acc[m][n] = (f32x4){0.f, 0.f, 0.f, 0.f};
    const int nk = K >> 6;
#define GT_GLOAD(kt) do { const int _k0 = (kt) * 64; \
        _Pragma("unroll") for (int i = 0; i < 2; ++i) ra[i] = *(const u32x4*)(ap[i] + _k0); \
        const bf16_t* _bb = (_k0 < kseg) ? (Bt0 + _k0) : (Bt1 + (_k0 - kseg)); \
        _Pragma("unroll") for (int i = 0; i < 4; ++i) rb[i] = *(const u32x4*)(_bb + (size_t)(rr + i * 64) * ldb + ch * 8); } while (0)
#define GT_SSTORE(buf) do { \
        _Pragma("unroll") for (int i = 0; i < 2; ++i) *(u32x4*)&S.A[buf][rr + i * 64][ch * 8] = ra[i]; \
        _Pragma("unroll") for (int i = 0; i < 4; ++i) *(u32x4*)&S.B[buf][rr + i * 64][ch * 8] = rb[i]; } while (0)
    GT_GLOAD(0);
    GT_SSTORE(0);
    __syncthreads();
    for (int kt = 0; kt < nk; ++kt) {
        const int cur = kt & 1;
        if (kt + 1 < nk) GT_GLOAD(kt + 1);
#pragma unroll
        for (int kk = 0; kk < 2; ++kk) {
            bf16x8 a[4], b[4];
#pragma unroll
            for (int m = 0; m < 4; ++m) a[m] = *(const bf16x8*)&S.A[cur][wr * 64 + m * 16 + fr][kk * 32 + fq * 8];
#pragma unroll
            for (int n = 0; n < 4; ++n) b[n] = *(const bf16x8*)&S.B[cur][wc * 64 + n * 16 + fr][kk * 32 + fq * 8];
#pragma unroll
            for (int m = 0; m < 4; ++m)
#pragma unroll
                for (int n = 0; n < 4; ++n) acc[m][n] = __builtin_amdgcn_mfma_f32_16x16x32_bf16(b[n], a[m], acc[m][n], 0, 0, 0);
        }
        if (kt + 1 < nk) GT_SSTORE(cur ^ 1);
        __syncthreads();
    }
#undef GT_GLOAD
#undef GT_SSTORE
    epi(acc, wr * 64, wc * 64, fr, fq);
}

struct EpiP0 {
    bf16_t* P; int m0, n0;
    DEVINL void operator()(const f32x4 (&acc)[4][4], int mb, int nbs, int fr, int fq) const {
        const float sc = (n0 < 256) ? 0.125f : 1.0f;
#pragma unroll
        for (int m = 0; m < 4; ++m) {
            bf16_t* rp = P + (size_t)(m0 + mb + m * 16 + fr) * 2048 + n0 + nbs + fq * 4;
#pragma unroll
            for (int n = 0; n < 4; ++n) *(u32x2*)(rp + n * 16) = pk4(acc[m][n] * sc);
        }
    }
};
struct EpiP1 {
    bf16_t* P; const float* lb; int m0, n0;
    DEVINL void operator()(const f32x4 (&acc)[4][4], int mb, int nbs, int fr, int fq) const {
        const int cb = n0 >> 10;
#pragma unroll
        for (int m = 0; m < 4; ++m) {
            bf16_t* rp = P + (size_t)(m0 + mb + m * 16 + fr) * 5120 + n0 + nbs + fq * 4;
#pragma unroll
            for (int n = 0; n < 4; ++n) {
                const f32x4 a = acc[m][n];
                u32x2 o;
                if (cb == 1 || cb == 2) {
                    const int cc = ((n0 + nbs + n * 16 + fq * 4) & 1023);
                    const f32x4 l4 = *(const f32x4*)(lb + cc);
                    unsigned short hv[4];
#pragma unroll
                    for (int j = 0; j < 4; ++j) hv[j] = f2h((1.0f - l4[j]) * sigmoidf_(-a[j]));
                    o.x = (unsigned)hv[0] | ((unsigned)hv[1] << 16); o.y = (unsigned)hv[2] | ((unsigned)hv[3] << 16);
                } else if (cb == 0 || cb == 4) {
                    f32x4 s;
#pragma unroll
                    for (int j = 0; j < 4; ++j) s[j] = siluf_(a[j]);
                    o = pk4(s);
                } else o = pk4(a);
                *(u32x2*)(rp + n * 16) = o;
            }
        }
    }
};
struct EpiGlu {
    bf16_t* CAT; const bf16_t* s5a; const float* gb; int m0, n0;
    DEVINL void operator()(const f32x4 (&acc)[4][4], int mb, int nbs, int fr, int fq) const {
#pragma unroll
        for (int m = 0; m < 4; ++m) {
            const size_t row = (size_t)(m0 + mb + m * 16 + fr);
#pragma unroll
            for (int n = 0; n < 4; ++n) {
                const int col = n0 + nbs + n * 16 + fq * 4;
                const u32x2 av = *(const u32x2*)(s5a + row * 512 + col);
                const f32x4 b4 = *(const f32x4*)(gb + col);
                f32x4 o;
                o[0] = bf2f((bf16_t)(av.x & 0xffff)) * sigmoidf_(acc[m][n][0] + b4[0]);
                o[1] = bf2f((bf16_t)(av.x >> 16)) * sigmoidf_(acc[m][n][1] + b4[1]);
                o[2] = bf2f((bf16_t)(av.y & 0xffff)) * sigmoidf_(acc[m][n][2] + b4[2]);
                o[3] = bf2f((bf16_t)(av.y >> 16)) * sigmoidf_(acc[m][n][3] + b4[3]);
                *(u32x2*)(CAT + row * 1024 + 512 + col) = pk4(o);
            }
        }
    }
};
struct EpiOut {
    const Params* p; const float* gate; int m0, n0;
    DEVINL void operator()(const f32x4 (&acc)[4][4], int mb, int nbs, int fr, int fq) const {
#pragma unroll
        for (int m = 0; m < 4; ++m) {
            const int r = m0 + mb + m * 16 + fr;
            float* rp = resid_row(*p, r);
            const float* gp = gate + (size_t)row_batch_mod(r) * 6144;
#pragma unroll
            for (int n = 0; n < 4; ++n) {
                const int col = n0 + nbs + n * 16 + fq * 4;
                const f32x4 g4 = *(const f32x4*)(gp + col);
                f32x4 x4 = *(f32x4*)(rp + col);
                x4 += g4 * acc[m][n];
                *(f32x4*)(rp + col) = x4;
            }
        }
    }
};
struct EpiMoe1 {
    bf16_t* act; const float* wsel; int m0, mvalid, colbase;
    DEVINL void operator()(const f32x4 (&acc)[4][4], int mb, int nbs, int fr, int fq) const {
#pragma unroll
        for (int m = 0; m < 4; ++m) {
            const int lr = mb + m * 16 + fr;
            if (lr < mvalid) {
                const int slot = m0 + lr;
                const float wv = wsel[slot];
#pragma unroll
                for (int nn = 0; nn < 2; ++nn) {
                    f32x4 o;
#pragma unroll
                    for (int j = 0; j < 4; ++j) o[j] = wv * siluf_(acc[m][2 * nn][j]) * acc[m][2 * nn + 1][j];
                    *(u32x2*)(act + (size_t)slot * 512 + colbase + (nbs >> 1) + nn * 16 + fq * 4) = pk4(o);
                }
            }
        }
    }
};
struct EpiMoe2 {
    const Params* p; const float* gate; const int* list; int m0, mvalid, n0;
    DEVINL void operator()(const f32x4 (&acc)[4][4], int mb, int nbs, int fr, int fq) const {
#pragma unroll
        for (int m = 0; m < 4; ++m) {
            const int lr = mb + m * 16 + fr;
            if (lr < mvalid) {
                const int r = list[m0 + lr];
                float* rp = resid_row(*p, r);
                const float* gp = gate + (size_t)row_batch_mod(r) * 6144;
#pragma unroll
                for (int n = 0; n < 4; ++n) {
                    const int col = n0 + nbs + n * 16 + fq * 4;
                    const f32x4 g4 = *(const f32x4*)(gp + col);
                    f32x4 x4 = *(f32x4*)(rp + col);
                    x4 += g4 * acc[m][n];
                    *(f32x4*)(rp + col) = x4;
                }
            }
        }
    }
};

namespace pg8 {
#define PG8_LAS __attribute__((address_space(3)))
constexpr int BM = 256, BK = 64, HALF = 128, HTB = HALF * BK * 2, STAGE_BYTES = 8 * HTB, NXCD = 8, WGM = 8;
DEVINL int lds_byte(int r, int c) { const int st = (r >> 4) * 2 + (c >> 5), rr = r & 15, cc = c & 31, ob = rr * 64 + cc * 2; return st * 1024 + (ob ^ (((ob >> 9) & 1) << 5)); }
DEVINL void stage_rc(int b, int& R_, int& C_) { const int st = b / 1024, sb = b % 1024, swz = sb ^ (((sb >> 9) & 1) << 5); R_ = (st >> 1) * 16 + swz / 64; C_ = (st & 1) * 32 + (swz % 64) / 2; }
DEVINL int perm32(int rho) { const int n = rho >> 4, i = rho & 15; return 8 * (i >> 2) + 4 * n + (i & 3); }
struct Unit { int pm, pn; const char* A; const char* B0; const char* B1; int mvalid, aux; };

template <class Epi, class Sched>
DEVINL void gemm_phase(PG8_LAS unsigned char* lds, const Sched& S, const Epi& E) {
    const int tid = tid_opaque(), wid = __builtin_amdgcn_readfirstlane(tid >> 6), lane = tid & 63, wr = wid >> 2, wc = wid & 3, fr = lane & 15, fq = lane >> 4;
    const int K = S.K, nt = K / BK, ldb = S.ldb, ksplit = S.ksplit;
    unsigned voffA[2], voffB[2];
#pragma unroll
    for (int i = 0; i < 2; ++i) { int R_, C_; stage_rc(tid * 16 + i * 8192, R_, C_); const int Rb = Epi::PERM ? ((R_ & ~31) + perm32(R_ & 31)) : R_;
        voffA[i] = (unsigned)(R_ * K + C_) * 2u; voffB[i] = (unsigned)(Rb * ldb + C_) * 2u; }
    const size_t kstep = (size_t)(BK * 2);
    const size_t hstepA = (size_t)HALF * K * 2, hstepB = (size_t)HALF * ldb * 2;
    const unsigned ldsw = (unsigned)wid * 1024u;
    const int aoff = lds_byte(wr * 64 + fr, fq * 8), boff = lds_byte(wc * 32 + fr, fq * 8);
#define PG8_SA(b, h) (((b) * 2 + (h)) * HTB)
#define PG8_SB(b, h) ((4 + (b) * 2 + (h)) * HTB)
#define PG8_STAGE(bufoff, gbase, voff) do { _Pragma("unroll") for (int _i = 0; _i < 2; ++_i) \
        __builtin_amdgcn_global_load_lds((const unsigned*)((const char*)(gbase) + (voff)[_i]), (PG8_LAS unsigned*)(lds + (bufoff) + ldsw + _i * 8192), 16, 0, 0); } while (0)
#define PG8_LDA(dst, b, h) do { _Pragma("unroll") for (int m = 0; m < 4; ++m) _Pragma("unroll") for (int k = 0; k < 2; ++k) dst[m][k] = *(const PG8_LAS bf16x8*)(lds + PG8_SA(b, h) + aoff + m * 2048 + k * 1024); } while (0)
#define PG8_LDB(dst, b, h) do { _Pragma("unroll") for (int n = 0; n < 2; ++n) _Pragma("unroll") for (int k = 0; k < 2; ++k) dst[n][k] = *(const PG8_LAS bf16x8*)(lds + PG8_SB(b, h) + boff + n * 2048 + k * 1024); } while (0)
#define PG8_MMA(ai, bj, At, Bt) do { __builtin_amdgcn_s_setprio(1); _Pragma("unroll") for (int m = 0; m < 4; ++m) _Pragma("unroll") for (int n = 0; n < 2; ++n) _Pragma("unroll") for (int k = 0; k < 2; ++k) \
        acc[ai][bj][m][n] = __builtin_amdgcn_mfma_f32_16x16x32_bf16(Bt[n][k], At[m][k], acc[ai][bj][m][n], 0, 0, 0); __builtin_amdgcn_s_setprio(0); } while (0)
#define PG8_WAIT_V(n) asm volatile("s_waitcnt vmcnt(" #n ")" ::: "memory")
#define PG8_WAIT_L(n) asm volatile("s_waitcnt lgkmcnt(" #n ")" ::: "memory")
#define PG8_BAR __builtin_amdgcn_s_barrier()
#define PG8_SCHED __builtin_amdgcn_sched_barrier(0)
#define PG8_BPTR(u, kt) (((kt) < ksplit ? (u).B0 : (u).B1) + (size_t)(kt) * kstep)
    Unit cur, nxt; int ui = 0;
    if (!S.next(0, cur)) return;
    f32x4 acc[2][2][4][2];
#pragma unroll
    for (int a = 0; a < 2; ++a)
#pragma unroll
        for (int b = 0; b < 2; ++b)
#pragma unroll
            for (int m = 0; m < 4; ++m)
#pragma unroll
                for (int n = 0; n < 2; ++n) acc[a][b][m][n] = (f32x4){0.f, 0.f, 0.f, 0.f};
    bf16x8 At[4][2], B0[2][2], B1[2][2];
    const char* cA = cur.A;
    { const char* cB0 = PG8_BPTR(cur, 0); const char* cB1 = PG8_BPTR(cur, 1);
      PG8_STAGE(PG8_SB(0, 0), cB0, voffB); PG8_STAGE(PG8_SA(0, 0), cA, voffA); PG8_STAGE(PG8_SB(0, 1), cB0 + hstepB, voffB); PG8_STAGE(PG8_SA(0, 1), cA + hstepA, voffA);
      if (wr == 1) PG8_BAR;
      PG8_WAIT_V(4); PG8_BAR;
      PG8_STAGE(PG8_SB(1, 0), cB1, voffB); PG8_STAGE(PG8_SA(1, 0), cA + kstep, voffA); PG8_STAGE(PG8_SB(1, 1), cB1 + hstepB, voffB);
      PG8_WAIT_V(6); PG8_BAR; }
    for (;;) {
        const bool has_next = S.next(ui + 1, nxt);
        if (!has_next) nxt = cur;
        const char* nA = nxt.A;
        for (int t = 0; t < nt; t += 2) {
            const bool last = (t == nt - 2);
            const char* a1 = cA + (size_t)(t + 1) * kstep;
            const char* a2 = last ? nA : cA + (size_t)(t + 2) * kstep;
            const char* b2 = last ? PG8_BPTR(nxt, 0) : PG8_BPTR(cur, t + 2);
            const char* a3 = a2 + kstep;
            const char* b3 = last ? PG8_BPTR(nxt, 1) : PG8_BPTR(cur, t + 3);
            PG8_LDB(B0, 0, 0); PG8_SCHED; PG8_LDA(At, 0, 0); PG8_STAGE(PG8_SA(1, 1), a1 + hstepA, voffA);
            PG8_WAIT_L(8); PG8_BAR; PG8_WAIT_L(0); PG8_MMA(0, 0, At, B0); PG8_BAR; PG8_SCHED;
            PG8_LDB(B1, 0, 1); PG8_STAGE(PG8_SB(0, 0), b2, voffB);
            PG8_BAR; PG8_WAIT_L(0); PG8_MMA(0, 1, At, B1); PG8_BAR;
            PG8_LDA(At, 0, 1); PG8_STAGE(PG8_SA(0, 0), a2, voffA);
            PG8_BAR; PG8_WAIT_L(0); PG8_MMA(1, 0, At, B0); PG8_BAR; PG8_SCHED;
            PG8_STAGE(PG8_SB(0, 1), b2 + hstepB, voffB);
            PG8_WAIT_V(6); PG8_BAR; PG8_MMA(1, 1, At, B1); PG8_BAR;
            PG8_LDB(B0, 1, 0); PG8_SCHED; PG8_LDA(At, 1, 0); PG8_STAGE(PG8_SA(0, 1), a2 + hstepA, voffA);
            PG8_WAIT_L(8); PG8_BAR; PG8_WAIT_L(0); PG8_MMA(0, 0, At, B0); PG8_BAR; PG8_SCHED;
            PG8_LDB(B1, 1, 1); PG8_STAGE(PG8_SB(1, 0), b3, voffB);
            PG8_BAR; PG8_WAIT_L(0); PG8_MMA(0, 1, At, B1); PG8_BAR;
            PG8_LDA(At, 1, 1); PG8_STAGE(PG8_SA(1, 0), a3, voffA);
            PG8_BAR; PG8_WAIT_L(0); PG8_MMA(1, 0, At, B0); PG8_BAR; PG8_SCHED;
            PG8_STAGE(PG8_SB(1, 1), b3 + hstepB, voffB);
            PG8_WAIT_V(6); PG8_BAR; PG8_MMA(1, 1, At, B1); PG8_BAR;
        }
        E(acc, cur, wr, wc, fr, fq);
        if (!has_next) break;
#pragma unroll
        for (int a = 0; a < 2; ++a)
#pragma unroll
            for (int b = 0; b < 2; ++b)
#pragma unroll
                for (int m = 0; m < 4; ++m)
#pragma unroll
                    for (int n = 0; n < 2; ++n) acc[a][b][m][n] = (f32x4){0.f, 0.f, 0.f, 0.f};
        cur = nxt; cA = nA; ++ui;
    }
    PG8_WAIT_V(0);
    if (wr == 0) PG8_BAR;
    PG8_BAR;
#undef PG8_SA
#undef PG8_SB
#undef PG8_STAGE
#undef PG8_LDA
#undef PG8_LDB
#undef PG8_MMA
#undef PG8_WAIT_V
#undef PG8_WAIT_L
#undef PG8_BAR
#undef PG8_SCHED
#undef PG8_BPTR
}

struct DenseSched {
    const char* A; const char* Bt; int K, ldb, ksplit, nM, nN, G, c, lat;
    DEVINL void init(const bf16_t* A_, const bf16_t* Bt_, int N, int K_, int G_, int c_, int lat_) {
        A = (const char*)A_; Bt = (const char*)Bt_; K = K_; ldb = K_; ksplit = K_ / BK; nM = lat_ ? 128 : 136; nN = N / BM; G = G_; c = c_; lat = lat_; }
    DEVINL bool next(int i, Unit& u) const {
        const int nwg = nM * nN;
        const long Lq = (long)i * G + c; if (Lq >= nwg) return false;
        int wgid = (int)Lq; { const int q = nwg / NXCD, r = nwg % NXCD, xcd = wgid % NXCD, off = wgid / NXCD; wgid = (xcd < r ? xcd * (q + 1) : r * (q + 1) + (xcd - r) * q) + off; }
        const int nig = WGM * nN, gid = wgid / nig, fm = gid * WGM, gsz = (nM - fm) < WGM ? (nM - fm) : WGM;
        int pm = fm + ((wgid % nig) % gsz); const int pn = (wgid % nig) / gsz;
        if (lat) pm = (pm >> 4) * 17 + 1 + (pm & 15);
        u.pm = pm; u.pn = pn; u.A = A + (size_t)pm * BM * K * 2; u.B0 = Bt + (size_t)pn * BM * K * 2; u.B1 = u.B0; u.mvalid = 256; u.aux = 0;
        return true;
    }
};
}

struct GEpiP0 {
    static constexpr bool PERM = true;
    bf16_t* P;
    DEVINL void operator()(const f32x4 (&acc)[2][2][4][2], const pg8::Unit& u, int wr, int wc, int fr, int fq) const {
        const float sc = (u.pn == 0) ? 0.125f : 1.0f;
        const int row0 = u.pm * 256 + wr * 64 + fr, col0 = u.pn * 256 + wc * 32 + 8 * fq;
#pragma unroll
        for (int ai = 0; ai < 2; ++ai)
#pragma unroll
            for (int m = 0; m < 4; ++m) {
                bf16_t* rp = P + (size_t)(row0 + ai * 128 + m * 16) * 2048 + col0;
#pragma unroll
                for (int bj = 0; bj < 2; ++bj) {
                    const u32x2 a = pk4(acc[ai][bj][m][0] * sc), b = pk4(acc[ai][bj][m][1] * sc);
                    u32x4 w; w.x = a.x; w.y = a.y; w.z = b.x; w.w = b.y;
                    *(u32x4*)(rp + bj * 128) = w;
                }
            }
    }
};
struct GEpiP1 {
    static constexpr bool PERM = true;
    bf16_t* P; const float* lb;
    DEVINL void operator()(const f32x4 (&acc)[2][2][4][2], const pg8::Unit& u, int wr, int wc, int fr, int fq) const {
        const int cb = u.pn >> 2;
        const int row0 = u.pm * 256 + wr * 64 + fr, col0 = u.pn * 256 + wc * 32 + 8 * fq;
#pragma unroll
        for (int ai = 0; ai < 2; ++ai)
#pragma unroll
            for (int m = 0; m < 4; ++m) {
                bf16_t* rp = P + (size_t)(row0 + ai * 128 + m * 16) * 5120 + col0;
#pragma unroll
                for (int bj = 0; bj < 2; ++bj) {
                    u32x4 w;
                    if (cb == 1 || cb == 2) {
                        const int cc = (col0 + bj * 128) & 1023;
                        unsigned short hv[8];
#pragma unroll
                        for (int n = 0; n < 2; ++n) {
                            const f32x4 l4 = *(const f32x4*)(lb + cc + 4 * n);
#pragma unroll
                            for (int j = 0; j < 4; ++j) hv[n * 4 + j] = f2h((1.0f - l4[j]) * sigmoidf_(-acc[ai][bj][m][n][j]));
                        }
                        w.x = (unsigned)hv[0] | ((unsigned)hv[1] << 16); w.y = (unsigned)hv[2] | ((unsigned)hv[3] << 16);
                        w.z = (unsigned)hv[4] | ((unsigned)hv[5] << 16); w.w = (unsigned)hv[6] | ((unsigned)hv[7] << 16);
                    } else {
                        f32x4 v0 = acc[ai][bj][m][0], v1 = acc[ai][bj][m][1];
                        if (cb == 0 || cb == 4) {
#pragma unroll
                            for (int j = 0; j < 4; ++j) { v0[j] = siluf_(v0[j]); v1[j] = siluf_(v1[j]); }
                        }
                        const u32x2 a = pk4(v0), b = pk4(v1);
                        w.x = a.x; w.y = a.y; w.z = b.x; w.w = b.y;
                    }
                    *(u32x4*)(rp + bj * 128) = w;
                }
            }
    }
};
struct GEpiGlu {
    static constexpr bool PERM = true;
    bf16_t* CAT; const bf16_t* s5a; const float* gb;
    DEVINL void operator()(const f32x4 (&acc)[2][2][4][2], const pg8::Unit& u, int wr, int wc, int fr, int fq) const {
        const int row0 = u.pm * 256 + wr * 64 + fr, col0 = u.pn * 256 + wc * 32 + 8 * fq;
#pragma unroll
        for (int ai = 0; ai < 2; ++ai)
#pragma unroll
            for (int m = 0; m < 4; ++m) {
                const size_t row = (size_t)(row0 + ai * 128 + m * 16);
#pragma unroll
                for (int bj = 0; bj < 2; ++bj) {
                    const int col = col0 + bj * 128;
                    const u32x4 av = *(const u32x4*)(s5a + row * 512 + col);
                    const f32x4 b0 = *(const f32x4*)(gb + col), b1 = *(const f32x4*)(gb + col + 4);
                    f32x4 o0, o1;
                    o0[0] = bf2f((bf16_t)(av.x & 0xffff)) * sigmoidf_(acc[ai][bj][m][0][0] + b0[0]);
                    o0[1] = bf2f((bf16_t)(av.x >> 16)) * sigmoidf_(acc[ai][bj][m][0][1] + b0[1]);
                    o0[2] = bf2f((bf16_t)(av.y & 0xffff)) * sigmoidf_(acc[ai][bj][m][0][2] + b0[2]);
                    o0[3] = bf2f((bf16_t)(av.y >> 16)) * sigmoidf_(acc[ai][bj][m][0][3] + b0[3]);
                    o1[0] = bf2f((bf16_t)(av.z & 0xffff)) * sigmoidf_(acc[ai][bj][m][1][0] + b1[0]);
                    o1[1] = bf2f((bf16_t)(av.z >> 16)) * sigmoidf_(acc[ai][bj][m][1][1] + b1[1]);
                    o1[2] = bf2f((bf16_t)(av.w & 0xffff)) * sigmoidf_(acc[ai][bj][m][1][2] + b1[2]);
                    o1[3] = bf2f((bf16_t)(av.w >> 16)) * sigmoidf_(acc[ai][bj][m][1][3] + b1[3]);
                    const u32x2 a = pk4(o0), b = pk4(o1);
                    u32x4 w; w.x = a.x; w.y = a.y; w.z = b.x; w.w = b.y;
                    *(u32x4*)(CAT + row * 1024 + 512 + col) = w;
                }
            }
    }
};
struct GEpiOut {
    static constexpr bool PERM = false;
    float* out; const float* gate;
    DEVINL void operator()(const f32x4 (&acc)[2][2][4][2], const pg8::Unit& u, int wr, int wc, int fr, int fq) const {
        const int b = u.pm / 17, lt = u.pm - b * 17 - 1;
        const float* gp = gate + (size_t)b * 6144;
        const int col0 = u.pn * 256 + wc * 32 + 4 * fq;
        float* base = out + ((size_t)b * SEQ + lt * 256 + wr * 64 + fr) * D;
#pragma unroll
        for (int ai = 0; ai < 2; ++ai)
#pragma unroll
            for (int m = 0; m < 4; ++m) {
                float* rp = base + (size_t)(ai * 128 + m * 16) * D;
#pragma unroll
                for (int bj = 0; bj < 2; ++bj)
#pragma unroll
                    for (int n = 0; n < 2; ++n) {
                        const int col = col0 + bj * 128 + n * 16;
                        const f32x4 g4 = *(const f32x4*)(gp + col);
                        f32x4 x4 = *(f32x4*)(rp + col);
                        x4 += g4 * acc[ai][bj][m][n];
                        *(f32x4*)(rp + col) = x4;
                    }
            }
    }
};
struct GEpiMoe1 {
    static constexpr bool PERM = true;
    bf16_t* act; const float* wl; const float* wh;
    DEVINL void operator()(const f32x4 (&acc)[2][2][4][2], const pg8::Unit& u, int wr, int wc, int fr, int fq) const {
        const int half = u.pn >> 1;
        const float* wsel = half ? wh : wl;
        const int cbase = half * 256 + (u.pn & 1) * 128 + 16 * wc + 4 * fq;
#pragma unroll
        for (int ai = 0; ai < 2; ++ai)
#pragma unroll
            for (int m = 0; m < 4; ++m) {
                const int lr = ai * 128 + wr * 64 + m * 16 + fr;
                if (lr < u.mvalid) {
                    const int slot = u.pm * 256 + lr;
                    const float wv = wsel[slot];
#pragma unroll
                    for (int bj = 0; bj < 2; ++bj) {
                        f32x4 o;
#pragma unroll
                        for (int j = 0; j < 4; ++j) o[j] = wv * siluf_(acc[ai][bj][m][0][j]) * acc[ai][bj][m][1][j];
                        *(u32x2*)(act + (size_t)slot * 512 + cbase + 64 * bj) = pk4(o);
                    }
                }
            }
    }
};
struct GEpiMoe2 {
    static constexpr bool PERM = false;
    float* out; float* cx; const float* gate; const int* list;
    DEVINL void operator()(const f32x4 (&acc)[2][2][4][2], const pg8::Unit& u, int wr, int wc, int fr, int fq) const {
        const int col0 = u.pn * 256 + wc * 32 + 4 * fq;
#pragma unroll
        for (int ai = 0; ai < 2; ++ai)
#pragma unroll
            for (int m = 0; m < 4; ++m) {
                const int lr = ai * 128 + wr * 64 + m * 16 + fr;
                if (lr < u.mvalid) {
                    const int r = list[u.pm * 256 + lr];
                    const int rb = r / RPB, rj = r - rb * RPB;
                    float* rp = (rj < CTXL) ? (cx + (size_t)(rb * CTXL + rj) * D) : (out + (size_t)(rb * SEQ + (rj - CTXL)) * D);
                    const float* gp = gate + (size_t)((rj < CTXL) ? 8 : rb) * 6144;
#pragma unroll
                    for (int bj = 0; bj < 2; ++bj)
#pragma unroll
                        for (int n = 0; n < 2; ++n) {
                            const int col = col0 + bj * 128 + n * 16;
                            const f32x4 g4 = *(const f32x4*)(gp + col);
                            f32x4 x4 = *(f32x4*)(rp + col);
                            x4 += g4 * acc[ai][bj][m][n];
                            *(f32x4*)(rp + col) = x4;
                        }
                }
            }
    }
};

template <int WHICH>
DEVINL void phase_gemm(const Params& p, char* smem, int bid, int nb) {
    constexpr int N = (WHICH == 0) ? 2048 : (WHICH == 1) ? 512 : (WHICH == 3) ? 5120 : 1024;
    constexpr int K = (WHICH == 1) ? 512 : 1024;
    PG8_LAS unsigned char* lds = (PG8_LAS unsigned char*)smem;
    pg8::DenseSched S;
    bid = sgpr(bid); nb = sgpr(nb);
    if (WHICH == 0) { S.init(sgpr_ptr(p.H), sgpr_ptr(p.wt_in0), N, K, nb, bid, 1); GEpiP0 e{sgpr_ptr(p.P)}; pg8::gemm_phase(lds, S, e); }
    if (WHICH == 1) { S.init(sgpr_ptr(p.s5a), sgpr_ptr(p.glu_t), N, K, nb, bid, 1); GEpiGlu e{sgpr_ptr(p.H), sgpr_ptr(p.s5a), sgpr_ptr(p.glu_b)}; pg8::gemm_phase(lds, S, e); }
    if (WHICH == 2) { S.init(sgpr_ptr(p.H), sgpr_ptr(p.wt_out0), N, K, nb, bid, 1); GEpiOut e{sgpr_ptr(p.out), sgpr_ptr(p.mod) + 2048}; pg8::gemm_phase(lds, S, e); }
    if (WHICH == 3) { S.init(sgpr_ptr(p.H), sgpr_ptr(p.wt_in1), N, K, nb, bid, 1); GEpiP1 e{sgpr_ptr(p.P), sgpr_ptr(p.lb)}; pg8::gemm_phase(lds, S, e); }
    if (WHICH == 4) { S.init(sgpr_ptr(p.H), sgpr_ptr(p.wt_out1), N, K, nb, bid, 1); GEpiOut e{sgpr_ptr(p.out), sgpr_ptr(p.mod) + 9 * 6144 + 2048}; pg8::gemm_phase(lds, S, e); }
    if (WHICH != 4) {
        constexpr int NT0 = (WHICH == 3) ? 4 : 0, NT1 = (WHICH == 3) ? 16 : N / 256, NTC = NT1 - NT0;
        for (int u = bid; u < 16 * NTC; u += nb) {
            const int mt = u / NTC, nt = NT0 + (u - mt * NTC);
            const int m0 = (mt >> 1) * RPB + (mt & 1) * 128, n0 = nt * 256;
            if (WHICH == 0) { EpiP0 e{p.P, m0, n0}; gemm_tile(p.H, 1024, nullptr, m0, 128, p.wt_in0 + (size_t)n0 * 1024, nullptr, 1024, K, K, e, smem); }
            if (WHICH == 1) { EpiGlu e{p.H, p.s5a, p.glu_b, m0, n0}; gemm_tile(p.s5a, 512, nullptr, m0, 128, p.glu_t + (size_t)n0 * 512, nullptr, 512, K, K, e, smem); }
            if (WHICH == 2) { EpiOut e{&p, p.mod + 2048, m0, n0}; gemm_tile(p.H, 1024, nullptr, m0, 128, p.wt_out0 + (size_t)n0 * 1024, nullptr, 1024, K, K, e, smem); }
            if (WHICH == 3) { EpiP1 e{p.P, p.lb, m0, n0}; gemm_tile(p.H, 1024, nullptr, m0, 128, p.wt_in1 + (size_t)n0 * 1024, nullptr, 1024, K, K, e, smem); }
        }
    }
}

constexpr int MOE_TAB = pg8::STAGE_BYTES;
static_assert(MOE_TAB + 1024 <= LDS_BYTES, "moe tables");
DEVINL void moe_setup(const Params& p, int L, int* tab) {
    if (tid_opaque() == 0) {
        int o = 0, ts = 0;
        for (int b = 0; b < 48; ++b) { const int c = p.cnt[L * 64 + b]; tab[b] = o; tab[64 + b] = ts; tab[128 + b] = c; const int nt = (c + 255) >> 8; o += nt * 256; ts += nt; }
        tab[48] = o; tab[64 + 48] = ts;
    }
    __syncthreads();
}
template <int L>
DEVINL void phase_list(const Params& p, char* smem, int bid, int nb) {
    int* tab = (int*)(smem + MOE_TAB);
    moe_setup(p, L, tab);
    const int nrows = L ? NLAT : R;
    const int t = tid_opaque(), w = t >> 6, lane = t & 63;
    for (int base = (bid * 8 + w) * 32; base < nrows; base += nb * 8 * 32) {
        int r = 0, slot = 0;
        if (lane < 32) {
            const int i = base + lane;
            r = L ? ((i >> 12) * RPB + CTXL + (i & 4095)) : i;
            const float4 rec = p.RT[r];
            const int bucket = __float_as_int(rec.x);
            const int pos = atomicAdd(&p.cnt[128 + L * 64 + bucket], 1);
            slot = tab[bucket] + pos;
            p.list[slot] = r; p.wl[slot] = rec.y; p.wh[slot] = rec.z;
        }
#pragma unroll 1
        for (int j0 = 0; j0 < 32; j0 += 8) {
            u32x4 v0[8], v1[8];
#pragma unroll
            for (int j = 0; j < 8; ++j) {
                const int rj = __shfl(r, j0 + j);
                const u32x4* src = (const u32x4*)(p.H + (size_t)rj * D);
                v0[j] = src[lane]; v1[j] = src[lane + 64];
            }
#pragma unroll
            for (int j = 0; j < 8; ++j) {
                const int sj = __shfl(slot, j0 + j);
                u32x4* dst = (u32x4*)(p.hs + (size_t)sj * D);
                dst[lane] = v0[j]; dst[lane + 64] = v1[j];
            }
        }
    }
}
struct MoeSched {
    const bf16_t* hs; const bf16_t* wgu_t; const bf16_t* act; const bf16_t* wd_t; const int* tab; int K, ldb, ksplit, G, c, stage, ntiles;
    DEVINL bool next(int i, pg8::Unit& u) const {
        const int Lq = i * G + c; if (Lq >= ntiles * 4) return false;
        const int tile = Lq >> 2, pn = Lq & 3;
        int bucket = 0;
        for (int b = 0; b < 48; ++b) if (tile >= tab[64 + b] && tile < tab[64 + b + 1]) bucket = b;
        bucket = sgpr(bucket);
        const int ti = tile - sgpr(tab[64 + bucket]);
        const int m0 = sgpr(tab[bucket]) + ti * 256;
        const int rem = sgpr(tab[128 + bucket]) - ti * 256;
        const int grp = bucket / 6, pair = bucket - grp * 6;
        const int lo = (pair < 3) ? 0 : (pair < 5 ? 1 : 2);
        const int hi = (pair < 3) ? (pair + 1) : (pair < 5 ? (pair - 1) : 3);
        const int ea = grp * 4 + lo, eb = grp * 4 + hi;
        u.pm = m0 >> 8; u.pn = pn; u.mvalid = rem < 256 ? rem : 256; u.aux = 0;
        if (stage == 1) {
            const int e = (pn >> 1) ? eb : ea;
            u.A = (const char*)(hs + (size_t)m0 * 1024);
            u.B0 = (const char*)(wgu_t + ((size_t)e * 512 + (pn & 1) * 256) * 1024); u.B1 = u.B0;
        } else {
            u.A = (const char*)(act + (size_t)m0 * 512);
            u.B0 = (const char*)(wd_t + ((size_t)ea * 1024 + pn * 256) * 256);
            u.B1 = (const char*)(wd_t + ((size_t)eb * 1024 + pn * 256) * 256) - (size_t)4 * 128;
        }
        return true;
    }
};
template <int L, int STAGE>
DEVINL void phase_moe(const Params& p, char* smem, int bid, int nb) {
    int* tab = (int*)(smem + MOE_TAB);
    moe_setup(p, L, tab);
    PG8_LAS unsigned char* lds = (PG8_LAS unsigned char*)smem;
    MoeSched S; S.hs = sgpr_ptr(p.hs); S.wgu_t = sgpr_ptr(p.wgu_t); S.act = sgpr_ptr(p.act); S.wd_t = sgpr_ptr(p.wd_t);
    S.tab = tab; S.G = sgpr(nb); S.c = sgpr(bid); S.stage = STAGE; S.ntiles = sgpr(tab[64 + 48]);
    if (STAGE == 1) { S.K = 1024; S.ldb = 1024; S.ksplit = 16; GEpiMoe1 e{sgpr_ptr(p.act), sgpr_ptr(p.wl), sgpr_ptr(p.wh)}; pg8::gemm_phase(lds, S, e); }
    else { S.K = 512; S.ldb = 256; S.ksplit = 4; GEpiMoe2 e{sgpr_ptr(p.out), sgpr_ptr(p.cx), sgpr_ptr(p.mod) + (size_t)L * 9 * 6144 + 5120, sgpr_ptr(p.list)}; pg8::gemm_phase(lds, S, e); }
    __syncthreads();
}

template <int DK> struct RecL {
    static constexpr int QS = DK + 8;
    static constexpr int oQs = 0;
    static constexpr int oKs = oQs + 64 * QS * 2;
    static constexpr int oKt = oKs + 64 * QS * 2;
    static constexpr int oVt = oKt + DK * 72 * 2;
    static constexpr int oAt = oVt + 128 * 72 * 2;
    static constexpr int oSt = oAt + 64 * 72 * 2;
    static constexpr int oPart = oSt + 128 * 136 * 2;
    static constexpr int oEmid = oPart + 8 * 128 * 4;
    static constexpr int oEend = oEmid + 128 * 4;
    static constexpr int oAF = oEend + 128 * 4;
    static constexpr int oRed = oAF + 64 * 32 * 4;
    static constexpr int total = oRed + 64 * 2 * 4 + 128 * 4;
};
static_assert(RecL<128>::total <= LDS_BYTES, "rec lds");

template <bool GLA> struct RecCols {
    static constexpr int LDP = GLA ? 2048 : 5120;
    static constexpr int QOFF = 0;
    static constexpr int KOFF = 256;
    static constexpr int KF = 1024, KB = 2048;
    static constexpr int VOFF = GLA ? 512 : 3072;
    static constexpr int GOFF = GLA ? 1024 : 4096;
};
template <int DK, bool GLA> struct RecGeo {
    static constexpr int GC = GLA ? 4 : 8;
    static constexpr int NS = GLA ? 16 : 8;
    static constexpr int H = GLA ? 4 : 8;
    static constexpr int KT = DK / 16;
};

DEVINL void lds_sync() { asm volatile("s_waitcnt lgkmcnt(0)" ::: "memory"); __builtin_amdgcn_s_barrier(); asm volatile("" ::: "memory"); }

struct RawRegs { u32x4 q[2], k[2], v[2], af; };

template <int DK, bool GLA, int DIR, bool PASS3>
DEVINL void rec_load_raw(const Params& p, const bf16_t* __restrict__ P, int row0, int h, RawRegs& r) {
    using C = RecCols<GLA>; constexpr int LDP = C::LDP;
    const int t = tid_opaque();
    if (GLA) {
        const int row = t >> 3, c8 = (t & 7) * 8;
        const bf16_t* rp = P + (size_t)(row0 + row) * LDP + h * 64 + c8;
        if (PASS3) r.q[0] = *(const u32x4*)(rp + C::QOFF);
        r.k[0] = *(const u32x4*)(rp + C::KOFF);
        r.af = *(const u32x4*)(p.AF + (size_t)(row0 + row) * 32 + (t & 7) * 4);
    } else {
#pragma unroll
        for (int i = 0; i < 2; ++i) {
            const int row = (t >> 4) + i * 32, c8 = (t & 15) * 8;
            const bf16_t* rp = P + (size_t)(row0 + row) * LDP + h * 128 + c8;
            if (PASS3) r.q[i] = *(const u32x4*)(rp + C::QOFF);
            r.k[i] = *(const u32x4*)(rp + (DIR ? C::KB : C::KF));
        }
    }
#pragma unroll
    for (int i = 0; i < 2; ++i) {
        const int row = (t >> 4) + i * 32, c8 = (t & 15) * 8;
        r.v[i] = *(const u32x4*)(P + (size_t)(row0 + row) * LDP + C::VOFF + h * 128 + c8);
    }
}

template <int DK, bool GLA, int DIR, bool PASS3>
DEVINL void rec_prep(const Params& p, char* smem, const bf16_t* __restrict__ P, RawRegs& raw, bool has_next, int next_row0, int h,
                     const float (&a2c)[2][16], const float (&abv)[2], float (&bsum)[2]) {
    using L = RecL<DK>;
    constexpr int NCP = DK / 2, NSEG = NTHR / NCP, RS = 64 / NSEG, QS = L::QS;
    constexpr bool ref_end = !PASS3;
    bf16_t* Qs = (bf16_t*)(smem + L::oQs); bf16_t* Ks = (bf16_t*)(smem + L::oKs); bf16_t* Kt = (bf16_t*)(smem + L::oKt); bf16_t* Vt = (bf16_t*)(smem + L::oVt);
    bf16_t* Vraw = (bf16_t*)(smem + L::oSt);
    float* part = (float*)(smem + L::oPart); float* emid = (float*)(smem + L::oEmid); float* eend = (float*)(smem + L::oEend); float* AFs = (float*)(smem + L::oAF);
    const int t = tid_opaque();
    if (GLA) {
        const int row = t >> 3, c8 = (t & 7) * 8;
        if (PASS3) *(u32x4*)&Qs[row * QS + c8] = raw.q[0];
        *(u32x4*)&Ks[row * QS + c8] = raw.k[0];
        *(u32x4*)&AFs[row * 32 + (t & 7) * 4] = raw.af;
    } else {
#pragma unroll
        for (int i = 0; i < 2; ++i) {
            const int row = (t >> 4) + i * 32, c8 = (t & 15) * 8;
            if (PASS3) *(u32x4*)&Qs[row * QS + c8] = raw.q[i];
            *(u32x4*)&Ks[row * QS + c8] = raw.k[i];
        }
    }
#pragma unroll
    for (int i = 0; i < 2; ++i) { const int row = (t >> 4) + i * 32, c8 = (t & 15) * 8; *(u32x4*)&Vraw[row * 136 + c8] = raw.v[i]; }
    lds_sync();
    if (has_next) rec_load_raw<DK, GLA, DIR, PASS3>(p, P, next_row0, h, raw);
    const int cp = t % NCP, seg = t / NCP, c0 = cp * 2, l0 = seg * RS;
    float dv[RS][2];
    float kv[RS][2];
#pragma unroll
    for (int i = 0; i < RS; ++i) {
        const unsigned kr = *(const unsigned*)&Ks[(l0 + i) * QS + c0];
        if (GLA) {
            kv[i][0] = bf2f((bf16_t)(kr & 0xffffu)); kv[i][1] = bf2f((bf16_t)(kr >> 16));
            const float* ar = &AFs[(l0 + i) * 32 + DIR * 16];
            float s0 = abv[0], s1 = abv[1];
#pragma unroll
            for (int r = 0; r < 16; ++r) { const float av = ar[r]; s0 += av * a2c[0][r]; s1 += av * a2c[1][r]; }
            dv[i][0] = logsigmoidf_(s0) * 0.0625f; dv[i][1] = logsigmoidf_(s1) * 0.0625f;
        } else {
            kv[i][0] = h2f((unsigned short)(kr & 0xffffu)); kv[i][1] = h2f((unsigned short)(kr >> 16));
            dv[i][0] = 1.0f - kv[i][0]; dv[i][1] = 1.0f - kv[i][1];
        }
    }
    {
        float s0 = GLA ? 0.f : 1.f, s1 = GLA ? 0.f : 1.f;
#pragma unroll
        for (int i = 0; i < RS; ++i) { if (GLA) { s0 += dv[i][0]; s1 += dv[i][1]; } else { s0 *= dv[i][0]; s1 *= dv[i][1]; } }
        float2 pv; pv.x = s0; pv.y = s1;
        *(float2*)&part[seg * DK + c0] = pv;
    }
    lds_sync();
    float tot[2], base[2], mid[2];
#pragma unroll
    for (int c = 0; c < 2; ++c) { tot[c] = GLA ? 0.f : 1.f; base[c] = tot[c]; mid[c] = tot[c]; }
#pragma unroll
    for (int sg = 0; sg < NSEG; ++sg) {
        const float2 pv = *(const float2*)&part[sg * DK + c0];
        const bool before = (DIR == 0) ? (sg < seg) : (sg > seg);
        const bool firsthalf = (DIR == 0) ? (sg < NSEG / 2) : (sg >= NSEG / 2);
        if (GLA) { tot[0] += pv.x; tot[1] += pv.y; if (before) { base[0] += pv.x; base[1] += pv.y; } if (firsthalf) { mid[0] += pv.x; mid[1] += pv.y; } }
        else { tot[0] *= pv.x; tot[1] *= pv.y; if (before) { base[0] *= pv.x; base[1] *= pv.y; } if (firsthalf) { mid[0] *= pv.x; mid[1] *= pv.y; } }
    }
    float ref[2], iref[2];
#pragma unroll
    for (int c = 0; c < 2; ++c) { ref[c] = ref_end ? tot[c] : mid[c]; iref[c] = GLA ? 0.f : __builtin_amdgcn_rcpf(ref[c]); }
    if (seg == 0) {
#pragma unroll
        for (int c = 0; c < 2; ++c) {
            if (GLA) { emid[c0 + c] = __expf(ref[c]); eend[c0 + c] = __expf(tot[c] - ref[c]); bsum[c] += tot[c]; }
            else { emid[c0 + c] = ref[c]; eend[c0 + c] = tot[c] * iref[c]; bsum[c] += __logf(tot[c]); }
        }
    }
    unsigned short ktv[2][RS];
    float run[2] = {base[0], base[1]};
#pragma unroll
    for (int ii = 0; ii < RS; ++ii) {
        const int i = (DIR == 0) ? ii : (RS - 1 - ii);
        float ek[2], eq[2];
#pragma unroll
        for (int c = 0; c < 2; ++c) {
            if (GLA) { run[c] += dv[i][c]; ek[c] = __expf(ref[c] - run[c]); eq[c] = PASS3 ? __expf(run[c] - ref[c]) : 0.f; }
            else { run[c] *= dv[i][c]; ek[c] = ref[c] * __builtin_amdgcn_rcpf(run[c]); eq[c] = run[c] * iref[c]; }
        }
        const unsigned kp = cvt_pk_bf16(kv[i][0] * ek[0], kv[i][1] * ek[1]);
        ktv[0][i] = (unsigned short)(kp & 0xffffu); ktv[1][i] = (unsigned short)(kp >> 16);
        if (PASS3) {
            const int l = l0 + i;
            *(unsigned*)&Ks[l * QS + c0] = kp;
            const unsigned qr = *(const unsigned*)&Qs[l * QS + c0];
            *(unsigned*)&Qs[l * QS + c0] = cvt_pk_bf16(bf2f((bf16_t)(qr & 0xffffu)) * eq[0], bf2f((bf16_t)(qr >> 16)) * eq[1]);
        }
    }
#pragma unroll
    for (int c = 0; c < 2; ++c) {
        if (RS == 8) {
            u32x4 v;
            v.x = (unsigned)ktv[c][0] | ((unsigned)ktv[c][1] << 16); v.y = (unsigned)ktv[c][2] | ((unsigned)ktv[c][3] << 16);
            v.z = (unsigned)ktv[c][RS > 4 ? 4 : 0] | ((unsigned)ktv[c][RS > 4 ? 5 : 0] << 16); v.w = (unsigned)ktv[c][RS > 4 ? 6 : 0] | ((unsigned)ktv[c][RS > 4 ? 7 : 0] << 16);
            *(u32x4*)&Kt[(c0 + c) * 72 + l0] = v;
        } else {
            u32x2 v;
            v.x = (unsigned)ktv[c][0] | ((unsigned)ktv[c][1] << 16); v.y = (unsigned)ktv[c][2] | ((unsigned)ktv[c][3] << 16);
            *(u32x2*)&Kt[(c0 + c) * 72 + l0] = v;
        }
    }
    {
        const int vp = t & 63, vq = t >> 6;
        unsigned vr[8];
#pragma unroll
        for (int i = 0; i < 8; ++i) vr[i] = *(const unsigned*)&Vraw[(vq * 8 + i) * 136 + 2 * vp];
        u32x4 lo, hi;
        lo.x = (vr[0] & 0xffffu) | (vr[1] << 16); lo.y = (vr[2] & 0xffffu) | (vr[3] << 16); lo.z = (vr[4] & 0xffffu) | (vr[5] << 16); lo.w = (vr[6] & 0xffffu) | (vr[7] << 16);
        hi.x = (vr[0] >> 16) | (vr[1] & 0xffff0000u); hi.y = (vr[2] >> 16) | (vr[3] & 0xffff0000u); hi.z = (vr[4] >> 16) | (vr[5] & 0xffff0000u); hi.w = (vr[6] >> 16) | (vr[7] & 0xffff0000u);
        *(u32x4*)&Vt[(2 * vp) * 72 + vq * 8] = lo;
        *(u32x4*)&Vt[(2 * vp + 1) * 72 + vq * 8] = hi;
    }
    lds_sync();
}

DEVINL bf16x8 ldfrag(const bf16_t* base, int ld, int fr, int fq, int k0) { return *(const bf16x8*)(base + fr * ld + k0 + fq * 8); }

template <int DK, bool GLA, int DIR>
DEVINL void rec_load_a2(const Params& p, int h, float (&a2c)[2][16], float (&abv)[2]) {
#pragma unroll
    for (int c = 0; c < 2; ++c) { abv[c] = 0.f;
#pragma unroll
        for (int r = 0; r < 16; ++r) a2c[c][r] = 0.f; }
    if (GLA) {
        const int c0 = (tid_opaque() % (DK / 2)) * 2;
#pragma unroll
        for (int c = 0; c < 2; ++c) {
#pragma unroll
            for (int r = 0; r < 16; ++r) a2c[c][r] = p.gla_a2[(DIR * 16 + r) * 256 + h * 64 + c0 + c];
            abv[c] = p.gla_ab[DIR * 256 + h * 64 + c0 + c];
        }
    }
}

template <int DK, bool GLA, int DIR>
DEVINL void rec_pass1_unit(const Params& p, char* smem, const bf16_t* P, int b, int h, int cg, float* slots, float* decs) {
    using L = RecL<DK>; using G = RecGeo<DK, GLA>;
    constexpr int KT = G::KT;
    bf16_t* Kt = (bf16_t*)(smem + L::oKt); bf16_t* Vt = (bf16_t*)(smem + L::oVt); float* emid = (float*)(smem + L::oEmid);
    const int t = tid_opaque(), w = t >> 6, lane = t & 63, fr = lane & 15, fq = lane >> 4;
    float a2c[2][16], abv[2];
    rec_load_a2<DK, GLA, DIR>(p, h, a2c, abv);
    f32x4 accS[KT];
#pragma unroll
    for (int kt = 0; kt < KT; ++kt) accS[kt] = (f32x4){0.f, 0.f, 0.f, 0.f};
    float bsum[2] = {0.f, 0.f};
    const int nch = (cg == 0) ? 4 : G::GC;
    auto chunk_row0 = [&](int ci) { const int pc = (cg == 0) ? (DIR == 0 ? ci : 3 - ci) : (DIR == 0 ? (4 + (cg - 1) * G::GC + ci) : (67 - (cg - 1) * G::GC - ci)); return b * RPB + pc * 64; };
    RawRegs raw;
    rec_load_raw<DK, GLA, DIR, false>(p, P, chunk_row0(0), h, raw);
    for (int ci = 0; ci < nch; ++ci) {
        const bool has_next = ci + 1 < nch;
        rec_prep<DK, GLA, DIR, false>(p, smem, P, raw, has_next, has_next ? chunk_row0(ci + 1) : 0, h, a2c, abv, bsum);
        bf16x8 av[2];
#pragma unroll
        for (int ks = 0; ks < 2; ++ks) av[ks] = ldfrag(Vt + (w * 16) * 72, 72, fr, fq, ks * 32);
#pragma unroll
        for (int kt = 0; kt < KT; ++kt) {
            const f32x4 e4 = *(const f32x4*)&emid[kt * 16 + fq * 4];
            f32x4 c = accS[kt] * e4;
#pragma unroll
            for (int ks = 0; ks < 2; ++ks) c = __builtin_amdgcn_mfma_f32_16x16x32_bf16(ldfrag(Kt + (kt * 16) * 72, 72, fr, fq, ks * 32), av[ks], c, 0, 0, 0);
            accS[kt] = c;
        }
        lds_sync();
    }
    const size_t chain = ((size_t)(b * G::H + h) * 2 + DIR);
    float* sl = slots + (chain * G::NS + cg) * (size_t)(128 * DK);
#pragma unroll
    for (int kt = 0; kt < KT; ++kt) *(f32x4*)&sl[(w * 16 + fr) * DK + kt * 16 + fq * 4] = accS[kt];
    if (t < DK / 2) { decs[(chain * G::NS + cg) * DK + 2 * t] = bsum[0]; decs[(chain * G::NS + cg) * DK + 2 * t + 1] = bsum[1]; }
}

template <int DK, bool GLA, int DIR>
DEVINL void rec_pass3_chunk(const Params& p, char* smem, const bf16_t* P, bf16_t* CAT, int row0, int h, f32x4 (&accS)[DK / 16], const float* gnorm) {
    using L = RecL<DK>; using C = RecCols<GLA>;
    constexpr int KT = DK / 16, QS = L::QS, KS = DK / 32;
    bf16_t* Qs = (bf16_t*)(smem + L::oQs); bf16_t* Ks = (bf16_t*)(smem + L::oKs); bf16_t* Kt = (bf16_t*)(smem + L::oKt); bf16_t* Vt = (bf16_t*)(smem + L::oVt);
    bf16_t* At = (bf16_t*)(smem + L::oAt); bf16_t* St = (bf16_t*)(smem + L::oSt);
    float* emid = (float*)(smem + L::oEmid); float* eend = (float*)(smem + L::oEend); float* red = (float*)(smem + L::oRed);
    const int t = tid_opaque(), w = t >> 6, lane = t & 63, fr = lane & 15, fq = lane >> 4;
    u32x2 obv[4], gbv[4];
    if (DIR == 0) {
        const size_t prow = (size_t)(row0 + (w & 3) * 16 + fr);
        const bf16_t* cp0 = CAT + prow * 1024 + h * 128 + (w >> 2) * 64 + fq * 4;
        const bf16_t* gp0 = P + prow * C::LDP + C::GOFF + h * 128 + (w >> 2) * 64 + fq * 4;
#pragma unroll
        for (int n = 0; n < 4; ++n) { obv[n] = *(const u32x2*)(cp0 + n * 16); gbv[n] = *(const u32x2*)(gp0 + n * 16); }
    }
#pragma unroll
    for (int kt = 0; kt < KT; ++kt) {
        const f32x4 e4 = *(const f32x4*)&emid[kt * 16 + fq * 4];
        accS[kt] = accS[kt] * e4;
        *(u32x2*)&St[(w * 16 + fr) * QS + kt * 16 + fq * 4] = pk4(accS[kt]);
    }
    {
        const int lt = w >> 1, st0 = (w & 1) * 2;
        bf16x8 aq[KS];
#pragma unroll
        for (int ks = 0; ks < KS; ++ks) aq[ks] = ldfrag(Qs + (lt * 16) * QS, QS, fr, fq, ks * 32);
#pragma unroll
        for (int s2 = 0; s2 < 2; ++s2) {
            const int st = st0 + s2;
            f32x4 c = (f32x4){0.f, 0.f, 0.f, 0.f};
#pragma unroll
            for (int ks = 0; ks < KS; ++ks) c = __builtin_amdgcn_mfma_f32_16x16x32_bf16(ldfrag(Ks + (st * 16) * QS, QS, fr, fq, ks * 32), aq[ks], c, 0, 0, 0);
            const int l = lt * 16 + fr;
#pragma unroll
            for (int j = 0; j < 4; ++j) { const int sidx = st * 16 + fq * 4 + j; const bool keep = (DIR == 0) ? (sidx <= l) : (sidx >= l); c[j] = keep ? c[j] : 0.f; }
            *(u32x2*)&At[l * 72 + st * 16 + fq * 4] = pk4(c);
        }
    }
    lds_sync();
    const int lt = w & 3, vt0 = (w >> 2) * 4;
    f32x4 o[4];
    {
        bf16x8 aa[2], aq[KS];
#pragma unroll
        for (int ks = 0; ks < 2; ++ks) aa[ks] = ldfrag(At + (lt * 16) * 72, 72, fr, fq, ks * 32);
#pragma unroll
        for (int ks = 0; ks < KS; ++ks) aq[ks] = ldfrag(Qs + (lt * 16) * QS, QS, fr, fq, ks * 32);
#pragma unroll
        for (int n = 0; n < 4; ++n) {
            const int vt = vt0 + n;
            f32x4 c = (f32x4){0.f, 0.f, 0.f, 0.f};
#pragma unroll
            for (int ks = 0; ks < 2; ++ks) c = __builtin_amdgcn_mfma_f32_16x16x32_bf16(ldfrag(Vt + (vt * 16) * 72, 72, fr, fq, ks * 32), aa[ks], c, 0, 0, 0);
#pragma unroll
            for (int ks = 0; ks < KS; ++ks) c = __builtin_amdgcn_mfma_f32_16x16x32_bf16(ldfrag(St + (vt * 16) * QS, QS, fr, fq, ks * 32), aq[ks], c, 0, 0, 0);
            o[n] = c;
        }
    }
    {
        bf16x8 av[2];
#pragma unroll
        for (int ks = 0; ks < 2; ++ks) av[ks] = ldfrag(Vt + (w * 16) * 72, 72, fr, fq, ks * 32);
#pragma unroll
        for (int kt = 0; kt < KT; ++kt) {
            f32x4 c = accS[kt];
#pragma unroll
            for (int ks = 0; ks < 2; ++ks) c = __builtin_amdgcn_mfma_f32_16x16x32_bf16(ldfrag(Kt + (kt * 16) * 72, 72, fr, fq, ks * 32), av[ks], c, 0, 0, 0);
            const f32x4 e4 = *(const f32x4*)&eend[kt * 16 + fq * 4];
            accS[kt] = c * e4;
        }
    }
    const int l = lt * 16 + fr;
    const size_t row = (size_t)(row0 + l);
    bf16_t* cp = CAT + row * 1024 + h * 128 + vt0 * 16 + fq * 4;
    if (DIR == 1) {
#pragma unroll
        for (int n = 0; n < 4; ++n) *(u32x2*)(cp + n * 16) = pk4(o[n]);
    } else {
        float ss = 0.f;
#pragma unroll
        for (int n = 0; n < 4; ++n) {
            const u32x2 ob = obv[n];
            o[n][0] += bf2f((bf16_t)(ob.x & 0xffff)); o[n][1] += bf2f((bf16_t)(ob.x >> 16));
            o[n][2] += bf2f((bf16_t)(ob.y & 0xffff)); o[n][3] += bf2f((bf16_t)(ob.y >> 16));
            ss += o[n][0] * o[n][0] + o[n][1] * o[n][1] + o[n][2] * o[n][2] + o[n][3] * o[n][3];
        }
        ss += __shfl_xor(ss, 16);
        ss += __shfl_xor(ss, 32);
        if (fq == 0) red[l * 2 + (w >> 2)] = ss;
        lds_sync();
        const float tot = red[l * 2] + red[l * 2 + 1];
        const float rstd = rsqrtf(tot * (1.0f / 128.0f) + EPS);
#pragma unroll
        for (int n = 0; n < 4; ++n) {
            const u32x2 gb = gbv[n];
            const f32x4 gn = *(const f32x4*)(gnorm + vt0 * 16 + n * 16 + fq * 4);
            f32x4 gv;
            gv[0] = bf2f((bf16_t)(gb.x & 0xffff)); gv[1] = bf2f((bf16_t)(gb.x >> 16)); gv[2] = bf2f((bf16_t)(gb.y & 0xffff)); gv[3] = bf2f((bf16_t)(gb.y >> 16));
            f32x4 r4;
#pragma unroll
            for (int j = 0; j < 4; ++j) { const float g = GLA ? siluf_(gv[j]) : gv[j]; r4[j] = o[n][j] * rstd * gn[j] * g; }
            *(u32x2*)(cp + n * 16) = pk4(r4);
        }
    }
    lds_sync();
}

template <int DK, bool GLA, int DIR>
DEVINL void rec_pass3_sweep(const Params& p, char* smem, const bf16_t* P, bf16_t* CAT, int b, int h, int c_lo, int nch, int slot, const float* slots, const float* gnorm) {
    using G = RecGeo<DK, GLA>;
    constexpr int KT = G::KT;
    const int t = tid_opaque(), w = t >> 6, lane = t & 63, fr = lane & 15, fq = lane >> 4;
    float a2c[2][16], abv[2];
    rec_load_a2<DK, GLA, DIR>(p, h, a2c, abv);
    f32x4 accS[KT];
    if (slot >= 0) {
        const size_t chain = ((size_t)(b * G::H + h) * 2 + DIR);
        const float* sl = slots + (chain * G::NS + slot) * (size_t)(128 * DK);
#pragma unroll
        for (int kt = 0; kt < KT; ++kt) accS[kt] = *(const f32x4*)&sl[(w * 16 + fr) * DK + kt * 16 + fq * 4];
    } else {
#pragma unroll
        for (int kt = 0; kt < KT; ++kt) accS[kt] = (f32x4){0.f, 0.f, 0.f, 0.f};
    }
    float bsum[2] = {0.f, 0.f};
    float* gn_lds = (float*)(smem + RecL<DK>::oRed + 64 * 2 * 4);
    if (DIR == 0) { if (t < 128) gn_lds[t] = gnorm[t]; }
    auto chunk_row0 = [&](int ci) { const int pc = (DIR == 0) ? (c_lo + ci) : (c_lo + nch - 1 - ci); return b * RPB + pc * 64; };
    RawRegs raw;
    rec_load_raw<DK, GLA, DIR, true>(p, P, chunk_row0(0), h, raw);
    for (int ci = 0; ci < nch; ++ci) {
        const bool has_next = ci + 1 < nch;
        rec_prep<DK, GLA, DIR, true>(p, smem, P, raw, has_next, has_next ? chunk_row0(ci + 1) : 0, h, a2c, abv, bsum);
        rec_pass3_chunk<DK, GLA, DIR>(p, smem, P, CAT, chunk_row0(ci), h, accS, gn_lds);
    }
}

template <int DK, bool GLA>
DEVINL void rec_pass3_unit(const Params& p, char* smem, const bf16_t* P, bf16_t* CAT, int b, int h, int gi, const float* slots, const float* gnorm) {
    using G = RecGeo<DK, GLA>;
    int c_lo, nch, slot_f, slot_b;
    if (GLA) {
        if (gi == 0) { c_lo = 0; nch = 4; slot_f = -1; slot_b = -1; }
        else { const int pg = gi - 1; c_lo = 4 + pg * G::GC; nch = G::GC; slot_f = pg; slot_b = G::NS - 1 - pg; }
    } else { const int pg = gi; c_lo = 4 + pg * G::GC; nch = G::GC; slot_f = pg; slot_b = G::NS - 1 - pg; }
    rec_pass3_sweep<DK, GLA, 1>(p, smem, P, CAT, b, h, c_lo, nch, slot_b, slots, gnorm);
    asm volatile("s_waitcnt vmcnt(0)" ::: "memory");
    rec_pass3_sweep<DK, GLA, 0>(p, smem, P, CAT, b, h, c_lo, nch, slot_f, slots, gnorm);
}

template <int DK, bool GLA>
DEVINL void rec_scan(float* slots, const float* decs, int bid, int nb) {
    using G = RecGeo<DK, GLA>;
    constexpr int NCHAIN = NBATCH * G::H * 2, PER = 128 * DK / 4;
    const int total = NCHAIN * PER;
    for (int i = bid * NTHR + tid_opaque(); i < total; i += nb * NTHR) {
        const int chain = i / PER, e = i - chain * PER;
        const int k4 = (e * 4) % DK;
        f32x4 run = (f32x4){0.f, 0.f, 0.f, 0.f};
#pragma unroll 1
        for (int s0 = 0; s0 < G::NS; s0 += 8) {
            f32x4 a[8], d4[8];
#pragma unroll
            for (int j = 0; j < 8; ++j) {
                d4[j] = *(const f32x4*)&decs[((size_t)chain * G::NS + s0 + j) * DK + k4];
                a[j] = *(const f32x4*)(slots + ((size_t)chain * G::NS + s0 + j) * (size_t)(128 * DK) + (size_t)e * 4);
            }
#pragma unroll
            for (int j = 0; j < 8; ++j) {
#pragma unroll
                for (int q = 0; q < 4; ++q) run[q] = __expf(d4[j][q]) * run[q] + a[j][q];
                *(f32x4*)(slots + ((size_t)chain * G::NS + s0 + j) * (size_t)(128 * DK) + (size_t)e * 4) = run;
            }
        }
    }
}

DEVINL size_t s5_idx(int b, int di, int pc, int g, int pp) { return ((((size_t)(b * 2 + di) * NCH + pc) * 32 + g) * 64 + pp) * 2; }

constexpr int S5_BU_LD = 20;
constexpr int S5_WAVE_LDS = 128 * S5_BU_LD * 4 + 16 * 136 * 2;
static_assert(8 * S5_WAVE_LDS <= LDS_BYTES, "s5 lds");

DEVINL void s5_load_afr(const Params& p, int row0, int g, int fr, int fq, bf16x8 (&afr)[4]) {
    const bf16x8 z = (bf16x8){0, 0, 0, 0, 0, 0, 0, 0};
#pragma unroll
    for (int sb = 0; sb < 4; ++sb) afr[sb] = (fq < 2) ? *(const bf16x8*)(p.P + (size_t)(row0 + sb * 16 + fr) * 2048 + 1536 + g * 16 + fq * 8) : z;
}
DEVINL void s5_load_bfr(const Params& p, int di, int g, int fr, int fq, bf16x8 (&bfr)[8]) {
    const bf16x8 z = (bf16x8){0, 0, 0, 0, 0, 0, 0, 0};
#pragma unroll
    for (int nt = 0; nt < 8; ++nt) bfr[nt] = (fq < 2) ? *(const bf16x8*)(p.bbm + ((size_t)((di * 32 + g) * 128 + nt * 16 + fr)) * 16 + fq * 8) : z;
}
DEVINL void s5_bu_subblock(float* BuT, const bf16x8& a, const bf16x8 (&bfr)[8], int fr, int fq) {
#pragma unroll
    for (int nt = 0; nt < 8; ++nt) {
        f32x4 c = (f32x4){0.f, 0.f, 0.f, 0.f};
        c = __builtin_amdgcn_mfma_f32_16x16x32_bf16(a, bfr[nt], c, 0, 0, 0);
        *(f32x4*)&BuT[(nt * 16 + fr) * S5_BU_LD + fq * 4] = c;
    }
}
template <int DIR, bool XS>
DEVINL void s5_scan16(const float* BuT, bf16_t* Xs, int lane, float are, float aim, float& xr, float& xi) {
    f32x4 br[4], bi[4];
#pragma unroll
    for (int q = 0; q < 4; ++q) { br[q] = *(const f32x4*)&BuT[lane * S5_BU_LD + q * 4]; bi[q] = *(const f32x4*)&BuT[(64 + lane) * S5_BU_LD + q * 4]; }
#pragma unroll
    for (int tt = 0; tt < 16; ++tt) {
        const int tl = DIR ? (15 - tt) : tt;
        const float nr = are * xr - aim * xi + br[tl >> 2][tl & 3], ni = are * xi + aim * xr + bi[tl >> 2][tl & 3];
        xr = nr; xi = ni;
        if (XS) { const unsigned pkd = cvt_pk_bf16(xr, xi); Xs[tl * 136 + lane] = (bf16_t)(pkd & 0xffffu); Xs[tl * 136 + 64 + lane] = (bf16_t)(pkd >> 16); }
    }
}
template <int DIR>
DEVINL void s5_pass1_task(const Params& p, float* BuT, int b, int pc, int g, const bf16x8 (&afr)[4], int lane, int fr, int fq) {
    bf16x8 bfr[8];
    s5_load_bfr(p, DIR, g, fr, fq, bfr);
    const float are = p.atab[((DIR * 32 + g) * 64 + lane) * 2], aim = p.atab[((DIR * 32 + g) * 64 + lane) * 2 + 1];
    float xr = 0.f, xi = 0.f;
#pragma unroll
    for (int sbi = 0; sbi < 4; ++sbi) {
        const int sb = DIR ? (3 - sbi) : sbi;
        s5_bu_subblock(BuT, afr[sb], bfr, fr, fq);
        asm volatile("s_waitcnt lgkmcnt(0)" ::: "memory");
        s5_scan16<DIR, false>(BuT, nullptr, lane, are, aim, xr, xi);
        asm volatile("s_waitcnt lgkmcnt(0)" ::: "memory");
    }
    float* o = p.s5xend + s5_idx(b, DIR, pc, g, lane);
    o[0] = xr; o[1] = xi;
}
DEVINL void s5_pass1_unit(const Params& p, char* smem, int b, int pc, int half) {
    const int t = tid_opaque(), w = t >> 6, lane = t & 63, fr = lane & 15, fq = lane >> 4;
    float* BuT = (float*)(smem + w * S5_WAVE_LDS);
    const int row0 = b * RPB + pc * 64;
#pragma unroll 1
    for (int q = 0; q < 2; ++q) {
        const int g = half * 16 + w * 2 + q;
        bf16x8 afr[4];
        s5_load_afr(p, row0, g, fr, fq, afr);
        s5_pass1_task<0>(p, BuT, b, pc, g, afr, lane, fr, fq);
        s5_pass1_task<1>(p, BuT, b, pc, g, afr, lane, fr, fq);
    }
}
DEVINL void s5_scan(const Params& p, int bid, int nb) {
    for (int i = bid * NTHR + tid_opaque(); i < NBATCH * 2 * 32 * 64; i += nb * NTHR) {
        const int pp = i & 63, g = (i >> 6) & 31, di = (i >> 11) & 1, b = i >> 12;
        const float ar = p.a64tab[((di * 32 + g) * 64 + pp) * 2], ai = p.a64tab[((di * 32 + g) * 64 + pp) * 2 + 1];
        float cr = 0.f, ci = 0.f;
#pragma unroll 1
        for (int c0 = 0; c0 < NCH; c0 += 17) {
            float er[17], ei[17];
#pragma unroll
            for (int j = 0; j < 17; ++j) {
                const int ch = c0 + j, pc = di ? (ch < 4 ? 3 - ch : 71 - ch) : ch;
                const size_t ix = s5_idx(b, di, pc, g, pp);
                er[j] = p.s5xend[ix]; ei[j] = p.s5xend[ix + 1];
            }
#pragma unroll
            for (int j = 0; j < 17; ++j) {
                const int ch = c0 + j, pc = di ? (ch < 4 ? 3 - ch : 71 - ch) : ch;
                const size_t ix = s5_idx(b, di, pc, g, pp);
                p.s5carry[ix] = cr; p.s5carry[ix + 1] = ci;
                const float nr = ar * cr - ai * ci + er[j], ni = ar * ci + ai * cr + ei[j];
                cr = nr; ci = ni;
            }
        }
    }
}
template <int DIR>
DEVINL void s5_pass3_task(const Params& p, float* BuT, bf16_t* Xs, int b, int pc, int g, const bf16x8 (&afr)[4], f32x4 (&acc)[4], int lane, int fr, int fq) {
    bf16x8 bfr[8];
    s5_load_bfr(p, DIR, g, fr, fq, bfr);
    bf16x8 cb[4];
#pragma unroll
    for (int ks = 0; ks < 4; ++ks) cb[ks] = *(const bf16x8*)(p.cmt + ((size_t)(g * 16 + fr)) * 256 + DIR * 128 + ks * 32 + fq * 8);
    const float are = p.atab[((DIR * 32 + g) * 64 + lane) * 2], aim = p.atab[((DIR * 32 + g) * 64 + lane) * 2 + 1];
    const size_t cix = s5_idx(b, DIR, pc, g, lane);
    float xr = p.s5carry[cix], xi = p.s5carry[cix + 1];
#pragma unroll
    for (int sbi = 0; sbi < 4; ++sbi) {
        const int sb = DIR ? (3 - sbi) : sbi;
        s5_bu_subblock(BuT, afr[sb], bfr, fr, fq);
        asm volatile("s_waitcnt lgkmcnt(0)" ::: "memory");
        s5_scan16<DIR, true>(BuT, Xs, lane, are, aim, xr, xi);
        asm volatile("s_waitcnt lgkmcnt(0)" ::: "memory");
        f32x4 c = acc[sb];
#pragma unroll
        for (int ks = 0; ks < 4; ++ks) {
            const bf16x8 a = *(const bf16x8*)(Xs + fr * 136 + ks * 32 + fq * 8);
            c = __builtin_amdgcn_mfma_f32_16x16x32_bf16(cb[ks], a, c, 0, 0, 0);
        }
        acc[sb] = c;
        asm volatile("s_waitcnt lgkmcnt(0)" ::: "memory");
    }
}
DEVINL void s5_pass3_unit(const Params& p, char* smem, int b, int pc, int half) {
    const int t = tid_opaque(), w = t >> 6, lane = t & 63, fr = lane & 15, fq = lane >> 4;
    float* BuT = (float*)(smem + w * S5_WAVE_LDS);
    bf16_t* Xs = (bf16_t*)(smem + w * S5_WAVE_LDS + 128 * S5_BU_LD * 4);
    const int row0 = b * RPB + pc * 64;
#pragma unroll 1
    for (int q = 0; q < 2; ++q) {
        const int g = half * 16 + w * 2 + q;
        bf16x8 afr[4];
        s5_load_afr(p, row0, g, fr, fq, afr);
        f32x4 acc[4];
#pragma unroll
        for (int sb = 0; sb < 4; ++sb) acc[sb] = (f32x4){0.f, 0.f, 0.f, 0.f};
        s5_pass3_task<1>(p, BuT, Xs, b, pc, g, afr, acc, lane, fr, fq);
        s5_pass3_task<0>(p, BuT, Xs, b, pc, g, afr, acc, lane, fr, fq);
        const f32x4 d4 = *(const f32x4*)(p.s5_d + g * 16 + fq * 4);
#pragma unroll
        for (int sb = 0; sb < 4; ++sb) {
            const int tok = sb * 16 + fr;
            const u32x2 ub = *(const u32x2*)(p.P + (size_t)(row0 + tok) * 2048 + 1536 + g * 16 + fq * 4);
            f32x4 uv; uv[0] = bf2f((bf16_t)(ub.x & 0xffff)); uv[1] = bf2f((bf16_t)(ub.x >> 16)); uv[2] = bf2f((bf16_t)(ub.y & 0xffff)); uv[3] = bf2f((bf16_t)(ub.y >> 16));
            f32x4 r4;
#pragma unroll
            for (int j = 0; j < 4; ++j) r4[j] = gelu_tanh(acc[sb][j] + d4[j] * uv[j]);
            *(u32x2*)(p.s5a + (size_t)(row0 + tok) * 512 + g * 16 + fq * 4) = pk4(r4);
        }
    }
}

struct UnitQueue {
    int* counter; int* slot; int total, nb, u, pend;
    DEVINL void init(int* counter_, char* smem, int total_, int bid, int nb_) {
        counter = counter_; slot = (int*)(smem + LDS_BYTES - 64); total = total_; nb = nb_; u = sgpr(bid); pend = 0;
        if (tid_opaque() == 0) pend = atomicAdd(counter, 1) + nb;
    }
    DEVINL bool valid() const { return u < total; }
    DEVINL void advance() {
        if (tid_opaque() == 0) { *slot = pend; pend = atomicAdd(counter, 1) + nb; }
        lds_sync();
        u = sgpr(*slot);
        lds_sync();
    }
};

DEVINL void phase_prologue(const Params& p, char* smem, int bid, int nb) {
    UnitQueue Q; Q.init(p.cnt + 242, smem, T0_END, bid, nb);
    for (; Q.valid(); Q.advance()) prologue_task(p, smem, Q.u);
}

template <int LAYER>
DEVINL void phase_rec1(const Params& p, char* smem, int bid, int nb) {
    if (LAYER == 0) {
        constexpr int NG = 8 * 4 * 2 * 16;
        constexpr int NS5 = NBATCH * NCH * 2;
        UnitQueue Q; Q.init(p.cnt + 240, smem, NG + NS5, bid, nb);
        for (; Q.valid(); Q.advance()) {
            const int u = Q.u;
            if (u < NG) {
                const int cg = u & 15, dir = (u >> 4) & 1, h = (u >> 5) & 3, b = u >> 7;
                if (dir == 0) rec_pass1_unit<64, true, 0>(p, smem, p.P, b, h, cg, p.gslots, p.gdecs);
                else rec_pass1_unit<64, true, 1>(p, smem, p.P, b, h, cg, p.gslots, p.gdecs);
            } else { const int v = u - NG; s5_pass1_unit(p, smem, (v >> 1) / NCH, (v >> 1) % NCH, v & 1); }
        }
    } else {
        constexpr int NG = 8 * 8 * 2 * 8;
        for (int u = bid; u < NG; u += nb) {
            const int cg = u & 7, dir = (u >> 3) & 1, h = (u >> 4) & 7, b = u >> 7;
            if (dir == 0) rec_pass1_unit<128, false, 0>(p, smem, p.P, b, h, cg, p.hslots, p.hdecs);
            else rec_pass1_unit<128, false, 1>(p, smem, p.P, b, h, cg, p.hslots, p.hdecs);
        }
    }
}
template <int LAYER>
DEVINL void phase_scan(const Params& p, char* smem, int bid, int nb) {
    if (LAYER == 0) { rec_scan<64, true>(p.gslots, p.gdecs, bid, nb); s5_scan(p, bid, nb); }
    else rec_scan<128, false>(p.hslots, p.hdecs, bid, nb);
}
template <int LAYER>
DEVINL void phase_rec3(const Params& p, char* smem, int bid, int nb) {
    if (LAYER == 0) {
        constexpr int NG = 8 * 4 * 17;
        constexpr int NS5 = NBATCH * NCH * 2;
        UnitQueue Q; Q.init(p.cnt + 241, smem, NG + NS5, bid, nb);
        for (; Q.valid(); Q.advance()) {
            const int u = Q.u;
            if (u < NG) { const int gi = u % 17, h = (u / 17) & 3, b = u / 68; rec_pass3_unit<64, true>(p, smem, p.P, p.H, b, h, gi, p.gslots, p.gla_norm); }
            else { const int v = u - NG; s5_pass3_unit(p, smem, (v >> 1) / NCH, (v >> 1) % NCH, v & 1); }
        }
    } else {
        constexpr int NG = 8 * 8 * 8;
        for (int u = bid; u < NG; u += nb) { const int gi = u & 7, h = (u >> 3) & 7, b = u >> 6; rec_pass3_unit<128, false>(p, smem, p.P, p.H, b, h, gi, p.hslots, p.hg_norm); }
    }
}

DEVINL void phase_final(const Params& p, int bid, int nb) {
    const int t = tid_opaque(), w = t >> 6, lane = t & 63;
    for (int rg = bid; rg < NLAT / 8; rg += nb) {
        float* res = p.out + (size_t)(rg * 8 + w) * D;
        f32x4 v[4];
        float ss = 0.f;
#pragma unroll
        for (int i = 0; i < 4; ++i) { v[i] = *(const f32x4*)(res + lane * 4 + i * 256); ss += v[i][0] * v[i][0] + v[i][1] * v[i][1] + v[i][2] * v[i][2] + v[i][3] * v[i][3]; }
#pragma unroll
        for (int o = 32; o >= 1; o >>= 1) ss += __shfl_xor(ss, o);
        const float rstd = rsqrtf(ss * (1.0f / 1024.0f) + EPS);
#pragma unroll
        for (int i = 0; i < 4; ++i) { const f32x4 g4 = *(const f32x4*)(p.final_norm + lane * 4 + i * 256); *(f32x4*)(res + lane * 4 + i * 256) = v[i] * rstd * g4; }
    }
}

constexpr int NPHASE = 23;
constexpr int MEGA_LDS = LDS_BYTES + 16 + 1024;
static_assert(sizeof(Params) <= 1024 && sizeof(Params) % 8 == 0, "params block");
template <int PH>
DEVINL void run_phase(const Params& p, char* smem, int bid, int nb) {
    if (PH == 0) phase_prologue(p, smem, bid, nb);
    if (PH == 1) phase_pre<0>(p, smem, bid, nb);
    if (PH == 2) phase_gemm<0>(p, smem, bid, nb);
    if (PH == 3) phase_rec1<0>(p, smem, bid, nb);
    if (PH == 4) phase_scan<0>(p, smem, bid, nb);
    if (PH == 5) phase_rec3<0>(p, smem, bid, nb);
    if (PH == 6) phase_gemm<1>(p, smem, bid, nb);
    if (PH == 7) phase_gemm<2>(p, smem, bid, nb);
    if (PH == 8) phase_pre<1>(p, smem, bid, nb);
    if (PH == 9) phase_list<0>(p, smem, bid, nb);
    if (PH == 10) phase_moe<0, 1>(p, smem, bid, nb);
    if (PH == 11) phase_moe<0, 2>(p, smem, bid, nb);
    if (PH == 12) phase_pre<2>(p, smem, bid, nb);
    if (PH == 13) phase_gemm<3>(p, smem, bid, nb);
    if (PH == 14) phase_rec1<1>(p, smem, bid, nb);
    if (PH == 15) phase_scan<1>(p, smem, bid, nb);
    if (PH == 16) phase_rec3<1>(p, smem, bid, nb);
    if (PH == 17) phase_gemm<4>(p, smem, bid, nb);
    if (PH == 18) phase_pre<3>(p, smem, bid, nb);
    if (PH == 19) phase_list<1>(p, smem, bid, nb);
    if (PH == 20) phase_moe<1, 1>(p, smem, bid, nb);
    if (PH == 21) phase_moe<1, 2>(p, smem, bid, nb);
    if (PH == 22) phase_final(p, bid, nb);
}

extern __shared__ __attribute__((aligned(16))) char dyn_smem[];

#if ONE_LAUNCH
template <int PH> struct PhaseSeq {
    static DEVINL void run(const Params& p, char* smem, const XcdBarrier& bar) {
        PhaseSeq<PH - 1>::run(p, smem, bar);
        xcd_barrier(bar);
        run_phase<PH>(p, smem, (int)blockIdx.x, (int)gridDim.x);
#ifdef DUP_MASK
        if ((DUP_MASK >> PH) & 1) { xcd_barrier(bar); run_phase<PH>(p, smem, (int)blockIdx.x, (int)gridDim.x); }
#endif
    }
};
template <> struct PhaseSeq<0> {
    static DEVINL void run(const Params& p, char* smem, const XcdBarrier& bar) {
        run_phase<0>(p, smem, (int)blockIdx.x, (int)gridDim.x);
#ifdef DUP_MASK
        if (DUP_MASK & 1) { xcd_barrier(bar); run_phase<0>(p, smem, (int)blockIdx.x, (int)gridDim.x); }
#endif
    }
};
__global__ void __launch_bounds__(NTHR, 2) mega_kernel(Params pk) {
    volatile LAS unsigned* st = (volatile LAS unsigned*)(dyn_smem + LDS_BYTES);
    unsigned long long* lp = (unsigned long long*)(dyn_smem + LDS_BYTES + 16);
    const unsigned long long* ka = (const unsigned long long*)__builtin_amdgcn_kernarg_segment_ptr();
    if (threadIdx.x < sizeof(Params) / 8) lp[threadIdx.x] = ka[threadIdx.x];
    if (threadIdx.x == 0) { st[0] = 0u; st[1] = 0u; st[2] = 0u; st[3] = 0u; }
    __syncthreads();
    const Params& p = *(const Params*)lp;
    XcdBarrier bar = xcd_barrier_post(p.bar, st);
    PhaseSeq<NPHASE - 1>::run(p, dyn_smem, bar);
}
#else
template <int PH>
__global__ void __launch_bounds__(NTHR, 2) phase_kernel(Params p) {
    run_phase<PH>(p, dyn_smem, (int)blockIdx.x, (int)gridDim.x);
}
template <int PH> struct Launcher {
    static void go(const Params& p, int grid, hipStream_t s) {
        Launcher<PH - 1>::go(p, grid, s);
        static bool attr = false;
        if (!attr) { hipFuncSetAttribute((const void*)phase_kernel<PH>, hipFuncAttributeMaxDynamicSharedMemorySize, LDS_BYTES + 16); attr = true; }
        phase_kernel<PH><<<grid, NTHR, LDS_BYTES + 16, s>>>(p);
    }
};
template <> struct Launcher<-1> { static void go(const Params&, int, hipStream_t) {} };
#endif

static size_t align_up(size_t v, size_t a) { return (v + a - 1) / a * a; }

extern "C" void kernel_launch(void* const* d_in, const int* in_sizes, int n_in, void* d_out, int out_size, void* d_ws, size_t ws_size, hipStream_t stream) {
    (void)in_sizes; (void)n_in; (void)out_size;
    Params p;
    memset(&p, 0, sizeof(p));
    const float* const* in = (const float* const*)d_in;
    p.x = in[0]; p.c = in[1]; p.ctx = in[2]; p.c_ctx = in[3]; p.ada_w = in[4]; p.ada_b = in[5]; p.norm_mix = in[6]; p.norm_ffn = in[7];
    p.ab_w_in = in[8]; p.ab_w_out = in[9]; p.gla_a2 = in[10]; p.gla_ab = in[11]; p.gla_norm = in[12];
    p.s5_lam_re = in[13]; p.s5_lam_im = in[14]; p.s5_log_dt = in[15]; p.s5_b_re = in[16]; p.s5_b_im = in[17]; p.s5_c_re = in[18]; p.s5_c_im = in[19];
    p.s5_d = in[20]; p.glu_w = in[21]; p.glu_b = in[22]; p.hg_w_in = in[23]; p.hg_w_out = in[24]; p.hg_lb = in[25]; p.hg_norm = in[26];
    p.router_w = in[27]; p.router_bias = in[28]; p.moe_wg = in[29]; p.moe_wu = in[30]; p.moe_wd = in[31]; p.final_norm = in[32];
    p.out = (float*)d_out;

    char* ws = (char*)d_ws;
    size_t o = 0;
    auto take = [&](size_t bytes) { char* r = ws + o; o = align_up(o + bytes, 256); return r; };
    p.bar = (unsigned*)take(XCD_BAR_WORDS * 4);
    p.cnt = (int*)take(256 * 4);
    p.mod = (float*)take((size_t)2 * 9 * 6144 * 4);
    p.pos = (float*)take(64 * 512 * 4);
    p.lb = (float*)take(1024 * 4);
    p.atab = (float*)take(2 * 32 * 64 * 2 * 4);
    p.a64tab = (float*)take(2 * 32 * 64 * 2 * 4);
    p.cmt = (bf16_t*)take((size_t)32 * 16 * 256 * 2);
    p.bbm = (bf16_t*)take((size_t)2 * 32 * 128 * 16 * 2);
    p.wrt = (bf16_t*)take((size_t)2 * 2 * 32 * 1024 * 2);
    p.RT = (float4*)take((size_t)R * 16);
    p.list = (int*)take((size_t)ACT_ROWS * 4);
    p.wl = (float*)take((size_t)ACT_ROWS * 4);
    p.wh = (float*)take((size_t)ACT_ROWS * 4);
    p.cx = (float*)take((size_t)NBATCH * CTXL * D * 4);
    p.wt_in0 = (bf16_t*)take((size_t)2048 * 1024 * 2);
    p.wt_out0 = (bf16_t*)take((size_t)1024 * 1024 * 2);
    p.glu_t = (bf16_t*)take((size_t)512 * 512 * 2);
    p.wt_in1 = (bf16_t*)take((size_t)5120 * 1024 * 2);
    p.wt_out1 = (bf16_t*)take((size_t)1024 * 1024 * 2);
    p.H = (bf16_t*)take((size_t)R * 1024 * 2);
    const size_t big = o;
    p.P = (bf16_t*)(ws + big);
    size_t o0 = big + (size_t)R * 2048 * 2;
    auto take0 = [&](size_t bytes) { char* r = ws + o0; o0 = align_up(o0 + bytes, 256); return r; };
    p.gslots = (float*)take0((size_t)64 * 16 * 128 * 64 * 4);
    p.gdecs = (float*)take0((size_t)64 * 16 * 64 * 4);
    p.s5xend = (float*)take0((size_t)NBATCH * 2 * NCH * 32 * 64 * 2 * 4);
    p.s5carry = (float*)take0((size_t)NBATCH * 2 * NCH * 32 * 64 * 2 * 4);
    p.s5a = (bf16_t*)take0((size_t)R * 512 * 2);
    p.AF = (float*)take0((size_t)R * 32 * 4);
    p.wgu_t = (bf16_t*)take0((size_t)32 * 512 * 1024 * 2);
    p.wd_t = (bf16_t*)take0((size_t)32 * 1024 * 256 * 2);
    p.hs = (bf16_t*)(ws + big);
    p.act = (bf16_t*)(ws + big + (size_t)ACT_ROWS * 1024 * 2);
    if (big + (size_t)ACT_ROWS * 1024 * 2 + (size_t)ACT_ROWS * 512 * 2 > (size_t)((char*)p.s5a - ws)) fprintf(stderr, "moe overlay overlaps live buffers\n");
    size_t o1 = big + (size_t)R * 5120 * 2;
    auto take1 = [&](size_t bytes) { char* r = ws + o1; o1 = align_up(o1 + bytes, 256); return r; };
    p.hslots = (float*)take1((size_t)128 * 8 * 128 * 128 * 4);
    p.hdecs = (float*)take1((size_t)128 * 8 * 128 * 4);
    const size_t need = o0 > o1 ? o0 : o1;
    if (need > ws_size) fprintf(stderr, "workspace too small: need %zu have %zu\n", need, ws_size);

    const int grid = 256;
#if ONE_LAUNCH
    static bool attr = false;
    if (!attr) { hipFuncSetAttribute((const void*)mega_kernel, hipFuncAttributeMaxDynamicSharedMemorySize, MEGA_LDS); attr = true; }
    hipMemsetAsync(p.bar, 0, XCD_BAR_WORDS * 4 + 256 * 4, stream);
    mega_kernel<<<grid, NTHR, MEGA_LDS, stream>>>(p);
#else
    Launcher<NPHASE - 1>::go(p, grid, stream);
#endif
}
```

```cpp
#include <hip/hip_runtime.h>
#include <stdint.h>
#include <string.h>
#include <stdio.h>

#ifndef ONE_LAUNCH
#define ONE_LAUNCH 1
#endif

typedef unsigned short bf16_t;
typedef short bf16x8 __attribute__((ext_vector_type(8)));
typedef float f32x4 __attribute__((ext_vector_type(4)));
typedef unsigned u32x4 __attribute__((ext_vector_type(4)));
typedef unsigned u32x2 __attribute__((ext_vector_type(2)));
#define DEVINL __device__ __forceinline__

constexpr int D = 1024, NBATCH = 8, SEQ = 4096, CTXL = 256;
constexpr int RPB = SEQ + CTXL;
constexpr int R = NBATCH * RPB;
constexpr int NLAT = NBATCH * SEQ;
constexpr int NCH = RPB / 64;
constexpr float EPS = 1e-6f;
constexpr int NTHR = 512;
constexpr int LDS_BYTES = 136 * 1024;
constexpr int ACT_ROWS = 47104;

#define XB_TMO      128
#define XB_XCNT(j)  (256  + 64 * (j))
#define XB_XSUB(j)  (1280 + 64 * (j))
#define XB_XGEN(j)  (2304 + 64 * (j))
#define XB_TOP      3328
#define XB_TOPGEN   3392
#define XCD_BAR_WORDS 3456
#define XB_SPIN_CAP (1u << 18)
#define LAS __attribute__((address_space(3)))

__device__ __forceinline__ unsigned xb_ld(unsigned* p)              { return __hip_atomic_load(p, __ATOMIC_RELAXED, __HIP_MEMORY_SCOPE_AGENT); }
__device__ __forceinline__ unsigned xb_add(unsigned* p, unsigned v) { return __hip_atomic_fetch_add(p, v, __ATOMIC_RELAXED, __HIP_MEMORY_SCOPE_AGENT); }
__device__ __forceinline__ unsigned xb_xcc_id() { return (unsigned)__builtin_amdgcn_s_getreg((3 << 11) | 20) & 0xFu; }
#define XB_SPIN(cond, bar) do { unsigned _sp = 0; while (cond) { __builtin_amdgcn_s_sleep(1); \
    if ((++_sp & 255u) == 0u) { if (xb_ld(&(bar)[XB_TMO])) break; if (_sp > XB_SPIN_CAP) { atomicAdd(&(bar)[XB_TMO], 1u); break; } } } } while (0)

struct XcdBarrier {
    unsigned* bar; unsigned x;
    volatile LAS unsigned* st;
};
__device__ __forceinline__ XcdBarrier xcd_barrier_post(unsigned* bar, volatile LAS unsigned* st) {
    XcdBarrier b; b.bar = bar; b.x = xb_xcc_id(); b.st = st;
    if (threadIdx.x == 0) (void)xb_add(&bar[XB_XCNT(b.x)], 1u);
    return b;
}
__device__ __forceinline__ void xcd_barrier_complete(unsigned* bar, unsigned x, unsigned& nloc, unsigned& nx) {
    const unsigned G = gridDim.x * gridDim.y * gridDim.z;
    unsigned sum, cnt, mine, sp = 0u;
    for (;;) {
        sum = 0u; cnt = 0u; mine = 0u;
#pragma unroll
        for (unsigned j = 0; j < 16; ++j) { const unsigned c = xb_ld(&bar[XB_XCNT(j)]); sum += c; cnt += (c > 0u) ? 1u : 0u; mine = (j == x) ? c : mine; }
        if (sum == G) break;
        __builtin_amdgcn_s_sleep(1);
        if ((++sp & 255u) == 0u) { if (xb_ld(&bar[XB_TMO])) break; if (sp > XB_SPIN_CAP) { atomicAdd(&bar[XB_TMO], 1u); break; } }
    }
    nloc = mine > 0u ? mine : 1u; nx = cnt > 0u ? cnt : 1u;
}
__device__ __forceinline__ void xcd_barrier(const XcdBarrier& b) {
    asm volatile("s_waitcnt vmcnt(0)" ::: "memory");
    __syncthreads();
    if (threadIdx.x == 0) {
        unsigned* bar = b.bar;
        __builtin_amdgcn_s_waitcnt(0);
        unsigned nloc = b.st[0], nx = b.st[1];
        if (nloc == 0u) { xcd_barrier_complete(bar, b.x, nloc, nx); b.st[0] = nloc; b.st[1] = nx; }
        const unsigned old = xb_add(&bar[XB_XSUB(b.x)], 1u);
        const unsigned gen = old / nloc;
        if (old + 1u == (gen + 1u) * nloc) {
            __builtin_amdgcn_fence(__ATOMIC_RELEASE, "agent");
            asm volatile("s_waitcnt vmcnt(0)" ::: "memory");
            const unsigned og = xb_add(&bar[XB_TOP], 1u);
            const unsigned tg = og / nx;
            if (og + 1u == (tg + 1u) * nx) xb_add(&bar[XB_TOPGEN], 1u);
            else XB_SPIN(xb_ld(&bar[XB_TOPGEN]) == tg, bar);
            __builtin_amdgcn_fence(__ATOMIC_ACQUIRE, "agent");
            xb_add(&bar[XB_XGEN(b.x)], 1u);
            asm volatile("s_waitcnt vmcnt(0)" ::: "memory");
        } else {
            XB_SPIN(xb_ld(&bar[XB_XGEN(b.x)]) == gen, bar);
            __builtin_amdgcn_fence(__ATOMIC_ACQUIRE, "agent");
            asm volatile("s_waitcnt vmcnt(0)" ::: "memory");
        }
    }
    __syncthreads();
}

struct Params {
    const float *x, *c, *ctx, *c_ctx, *ada_w, *ada_b, *norm_mix, *norm_ffn, *ab_w_in, *ab_w_out, *gla_a2, *gla_ab, *gla_norm;
    const float *s5_lam_re, *s5_lam_im, *s5_log_dt, *s5_b_re, *s5_b_im, *s5_c_re, *s5_c_im, *s5_d, *glu_w, *glu_b;
    const float *hg_w_in, *hg_w_out, *hg_lb, *hg_norm, *router_w, *router_bias, *moe_wg, *moe_wu, *moe_wd, *final_norm;
    float* out;
    unsigned* bar;
    int* cnt;
    float *mod, *pos, *lb, *atab, *a64tab;
    bf16_t* cmt; bf16_t* bbm; bf16_t* wrt;
    float4* RT;
    int* list; float *wl, *wh;
    float* cx;
    int* sor; int* blkcnt;
    bf16_t *wt_in0, *wt_out0, *glu_t, *wt_in1, *wt_out1;
    bf16_t* H;
    bf16_t* P;
    float *gslots, *gdecs;
    float *s5xend, *s5carry;
    bf16_t* s5a;
    bf16_t *wgu_t, *wd_t, *act, *hs;
    float* AF;
    float *hslots, *hdecs;
};

DEVINL int tid_opaque() { int t = threadIdx.x; asm volatile("" : "+v"(t)); return t; }
DEVINL void lds_sync() { asm volatile("s_waitcnt lgkmcnt(0)" ::: "memory"); __builtin_amdgcn_s_barrier(); asm volatile("" ::: "memory"); }

DEVINL int sgpr(int v) { return __builtin_amdgcn_readfirstlane(v); }
template <class T> DEVINL T* sgpr_ptr(T* ptr) {
    const unsigned long long v = (unsigned long long)ptr;
    const unsigned lo = (unsigned)__builtin_amdgcn_readfirstlane((int)(unsigned)v), hi = (unsigned)__builtin_amdgcn_readfirstlane((int)(unsigned)(v >> 32));
    return (T*)(__attribute__((address_space(1))) T*)(((unsigned long long)hi << 32) | lo);
}
DEVINL unsigned cvt_pk_bf16(float lo, float hi) { unsigned r; asm volatile("v_cvt_pk_bf16_f32 %0, %1, %2" : "=v"(r) : "v"(lo), "v"(hi)); return r; }
DEVINL float bf2f(bf16_t v) { return __uint_as_float(((unsigned)v) << 16); }
DEVINL bf16_t f2bf(float f) { unsigned u = __float_as_uint(f); u += 0x7fffu + ((u >> 16) & 1u); return (bf16_t)(u >> 16); }
DEVINL unsigned pk2(float lo, float hi) { return cvt_pk_bf16(lo, hi); }
DEVINL u32x2 pk4(f32x4 v) { u32x2 r; r.x = pk2(v[0], v[1]); r.y = pk2(v[2], v[3]); return r; }
DEVINL float h2f(unsigned short v) { return (float)__builtin_bit_cast(_Float16, v); }
DEVINL unsigned short f2h(float f) { return __builtin_bit_cast(unsigned short, (_Float16)f); }
DEVINL float sigmoidf_(float x) { return __builtin_amdgcn_rcpf(1.0f + __expf(-x)); }
DEVINL float siluf_(float x) { return x * sigmoidf_(x); }
DEVINL float logsigmoidf_(float x) { return fminf(x, 0.0f) - __logf(1.0f + __expf(-fabsf(x))); }
DEVINL float gelu_tanh(float y) { float z = 0.7978845608028654f * (y + 0.044715f * y * y * y); float th = 1.0f - 2.0f * __builtin_amdgcn_rcpf(__expf(2.0f * z) + 1.0f); return 0.5f * y * (1.0f + th); }
DEVINL float* resid_row(const Params& p, int r) {
    const int b = r / RPB, j = r - b * RPB;
    return (j < CTXL) ? (p.cx + (size_t)(b * CTXL + j) * D) : (p.out + (size_t)(b * SEQ + (j - CTXL)) * D);
}
DEVINL int row_batch_mod(int r) { const int b = r / RPB, j = r - b * RPB; return (j < CTXL) ? 8 : b; }

template <int K>
DEVINL f32x4 mma_lds(f32x4 c, const bf16_t* A, int lda, const bf16_t* Bt, int ldb, int fr, int fq) {
#pragma unroll
    for (int k0 = 0; k0 < K; k0 += 32) {
        const bf16x8 a = *(const bf16x8*)(A + fr * lda + k0 + fq * 8);
        const bf16x8 b = *(const bf16x8*)(Bt + fr * ldb + k0 + fq * 8);
        c = __builtin_amdgcn_mfma_f32_16x16x32_bf16(b, a, c, 0, 0, 0);
    }
    return c;
}

DEVINL void cvt_tile(const float* colp, int ld, int k0, int n0, bf16_t* dst, int ldd, char* smem, int lrow = -1) {
    float (*T)[257] = (float (*)[257])smem;
    const int t = tid_opaque(), nl = lrow >= 0 ? lrow : (t & 63), ks = t >> 6;
    const float* sp = colp + (size_t)(k0 + ks * 32) * ld;
#pragma unroll
    for (int i0 = 0; i0 < 32; i0 += 16) {
        float v[16];
#pragma unroll
        for (int i = 0; i < 16; ++i) v[i] = sp[(size_t)(i0 + i) * ld];
#pragma unroll
        for (int i = 0; i < 16; ++i) T[nl][ks * 32 + i0 + i] = v[i];
    }
    __syncthreads();
    const int n2 = t >> 3, kc = t & 7;
#pragma unroll
    for (int j = 0; j < 4; ++j) {
        const int k = j * 64 + kc * 8;
        u32x4 v;
        v.x = pk2(T[n2][k + 0], T[n2][k + 1]); v.y = pk2(T[n2][k + 2], T[n2][k + 3]);
        v.z = pk2(T[n2][k + 4], T[n2][k + 5]); v.w = pk2(T[n2][k + 6], T[n2][k + 7]);
        *(u32x4*)(dst + (size_t)(n0 + n2) * ldd + k0 + k) = v;
    }
    __syncthreads();
}

constexpr int NT_GU = 1024, NT_WD = 512;
DEVINL void moe_cvt_task(const Params& p, int layer, int tid, char* smem) {
    if (tid < NT_GU) {
        const int e = tid >> 5, rem = tid & 31, nb = rem >> 2, kb = rem & 3;
        const float* wg = p.moe_wg + (size_t)(layer * 32 + e) * 1024 * 256;
        const float* wu = p.moe_wu + (size_t)(layer * 32 + e) * 1024 * 256;
        const int nl = tid_opaque() & 63, isup = nl >> 5, ul = nl & 31;
        const int ub = (nb >> 2) * 128 + (nb & 3) * 32;
        const float* cp = (isup ? wu : wg) + ub + ul;
        const int lrow = (ul >> 2) * 8 + isup * 4 + (ul & 3);
        cvt_tile(cp, 256, kb * 256, nb * 64, p.wgu_t + (size_t)e * 512 * 1024, 1024, smem, lrow);
    } else {
        const int t2 = tid - NT_GU, e = t2 >> 4, nb = t2 & 15;
        const float* wd = p.moe_wd + (size_t)(layer * 32 + e) * 256 * 1024;
        cvt_tile(wd + nb * 64 + (tid_opaque() & 63), 1024, 0, nb * 64, p.wd_t + (size_t)e * 1024 * 256, 256, smem);
    }
}

constexpr int NT_MISC = 9, NT_MOD = 192, NT_IN0 = 128, NT_OUT0 = 64, NT_GLU = 16, NT_IN1 = 320, NT_OUT1 = 64, NT_POS = 64, NT_S5 = 64;
constexpr int T0_MOD = NT_MISC, T0_IN0 = T0_MOD + NT_MOD, T0_OUT0 = T0_IN0 + NT_IN0, T0_GLU = T0_OUT0 + NT_OUT0, T0_IN1 = T0_GLU + NT_GLU, T0_OUT1 = T0_IN1 + NT_IN1,
              T0_MOE = T0_OUT1 + NT_OUT1, T0_POS = T0_MOE + NT_GU + NT_WD, T0_S5 = T0_POS + NT_POS, T0_END = T0_S5 + NT_S5;

DEVINL void prologue_task(const Params& p, char* smem, int task) {
    const int t = tid_opaque();
    {
        if (task < T0_MOD) {
            if (task == 0) {
                for (int i = t; i < 1024; i += NTHR) p.lb[i] = sigmoidf_(p.hg_lb[1024 + i] - p.hg_lb[i]);
            } else {
                for (int i = (task - 1) * 8192 + t; i < task * 8192; i += NTHR) {
                    const int which = i >> 15, e = (i >> 10) & 31, k = i & 1023;
                    const float v = which ? p.ab_w_in[(size_t)k * 2080 + 1536 + e] : p.router_w[k * 32 + e];
                    const bf16_t hi = f2bf(v); const bf16_t lo = f2bf(v - bf2f(hi));
                    p.wrt[((size_t)(which * 2 + 0) * 32 + e) * 1024 + k] = hi;
                    p.wrt[((size_t)(which * 2 + 1) * 32 + e) * 1024 + k] = lo;
                }
            }
        } else if (task < T0_IN0) {
            float* sc = (float*)smem;
            float* red = sc + 9 * 1024;
            for (int i = t; i < 9 * 1024; i += NTHR) { const int rr = i >> 10, k = i & 1023; const float v = rr < 8 ? p.c[rr * 1024 + k] : p.c_ctx[k]; sc[i] = siluf_(v); }
            __syncthreads();
            const int tk = task - T0_MOD, l = tk / 96, c0 = (tk % 96) * 64, col = t & 63, kp = t >> 6;
            const float* wp = p.ada_w + ((size_t)l * 1024 + kp * 128) * 6144 + c0 + col;
            float acc[9];
#pragma unroll
            for (int rr = 0; rr < 9; ++rr) acc[rr] = 0.f;
#pragma unroll 1
            for (int k = 0; k < 128; k += 16) {
                float w16[16];
#pragma unroll
                for (int j = 0; j < 16; ++j) w16[j] = wp[(size_t)(k + j) * 6144];
#pragma unroll
                for (int rr = 0; rr < 9; ++rr) {
#pragma unroll
                    for (int j = 0; j < 16; j += 4) {
                        const f32x4 s4 = *(const f32x4*)&sc[rr * 1024 + kp * 128 + k + j];
                        acc[rr] += s4[0] * w16[j] + s4[1] * w16[j + 1] + s4[2] * w16[j + 2] + s4[3] * w16[j + 3];
                    }
                }
            }
#pragma unroll
            for (int rr = 0; rr < 9; ++rr) red[(kp * 9 + rr) * 64 + col] = acc[rr];
            __syncthreads();
            for (int o = t; o < 576; o += NTHR) {
                const int rr = o >> 6, cc = o & 63;
                float sv = p.ada_b[l * 6144 + c0 + cc];
#pragma unroll
                for (int q = 0; q < 8; ++q) sv += red[(q * 9 + rr) * 64 + cc];
                p.mod[((size_t)l * 9 + rr) * 6144 + c0 + cc] = sv;
            }
            __syncthreads();
        } else if (task < T0_OUT0) {
            const int tt = task - T0_IN0, nbk = tt >> 2, kb = tt & 3;
            const int n = nbk * 64 + (t & 63);
            const float* cp = p.ab_w_in + (n < 1536 ? n : n + 32);
            cvt_tile(cp, 2080, kb * 256, nbk * 64, p.wt_in0, 1024, smem);
        } else if (task < T0_GLU) {
            const int tt = task - T0_OUT0, nbk = tt >> 2, kb = tt & 3;
            cvt_tile(p.ab_w_out + nbk * 64 + (t & 63), 1024, kb * 256, nbk * 64, p.wt_out0, 1024, smem);
        } else if (task < T0_IN1) {
            const int tt = task - T0_GLU, nbk = tt >> 1, kb = tt & 1;
            cvt_tile(p.glu_w + nbk * 64 + (t & 63), 512, kb * 256, nbk * 64, p.glu_t, 512, smem);
        } else if (task < T0_OUT1) {
            const int tt = task - T0_IN1, nbk = tt >> 2, kb = tt & 3;
            cvt_tile(p.hg_w_in + nbk * 64 + (t & 63), 5120, kb * 256, nbk * 64, p.wt_in1, 1024, smem);
        } else if (task < T0_MOE) {
            const int tt = task - T0_OUT1, nbk = tt >> 2, kb = tt & 3;
            cvt_tile(p.hg_w_out + nbk * 64 + (t & 63), 1024, kb * 256, nbk * 64, p.wt_out1, 1024, smem);
        } else if (task < T0_POS) {
            moe_cvt_task(p, 0, task - T0_MOE, smem);
        } else if (task < T0_S5) {
            const int pi = task - T0_POS;
            const int j = t, jj = j & 255;
            const float omega = __expf(-9.210340371976184f * (float)jj * (1.0f / 256.0f));
            const float ang = (float)pi * omega;
            p.pos[pi * 512 + j] = (j < 256) ? sinf(ang) : cosf(ang);
        } else {
            const int tt = task - T0_S5, di = tt >> 5, g = tt & 31;
            const int pp = t & 63, hs = t >> 6;
            const float dt = __expf(p.s5_log_dt[di * 32 + g]);
            const float lr = p.s5_lam_re[(di * 32 + g) * 64 + pp], li = p.s5_lam_im[(di * 32 + g) * 64 + pp];
            const float mag = __expf(lr * dt);
            const float are = mag * cosf(li * dt), aim = mag * sinf(li * dt);
            const float den = lr * lr + li * li;
            const float fre = ((are - 1.0f) * lr + aim * li) / den;
            const float fim = (aim * lr - (are - 1.0f) * li) / den;
            if (hs == 0) {
                p.atab[((di * 32 + g) * 64 + pp) * 2 + 0] = are; p.atab[((di * 32 + g) * 64 + pp) * 2 + 1] = aim;
                float xr = are, xi = aim;
#pragma unroll
                for (int q = 0; q < 6; ++q) { const float nr = xr * xr - xi * xi, ni = 2.0f * xr * xi; xr = nr; xi = ni; }
                p.a64tab[((di * 32 + g) * 64 + pp) * 2 + 0] = xr; p.a64tab[((di * 32 + g) * 64 + pp) * 2 + 1] = xi;
            }
#pragma unroll
            for (int q = 0; q < 2; ++q) {
                const int h = hs * 2 + q;
                const float bre = p.s5_b_re[((size_t)((di * 32 + g) * 64 + pp)) * 16 + h], bim = p.s5_b_im[((size_t)((di * 32 + g) * 64 + pp)) * 16 + h];
                p.bbm[((size_t)((di * 32 + g) * 128 + pp)) * 16 + h] = f2bf(fre * bre - fim * bim);
                p.bbm[((size_t)((di * 32 + g) * 128 + 64 + pp)) * 16 + h] = f2bf(fre * bim + fim * bre);
                const float cre = p.s5_c_re[((size_t)((di * 32 + g) * 16 + h)) * 64 + pp], cim = p.s5_c_im[((size_t)((di * 32 + g) * 16 + h)) * 64 + pp];
                bf16_t* cm = p.cmt + ((size_t)(g * 16 + h)) * 256 + di * 128;
                cm[pp] = f2bf(cre); cm[64 + pp] = f2bf(-cim);
            }
        }
    }
}

constexpr int PRE_LD = 1028;
template <int MODE>
DEVINL void phase_pre(const Params& p, char* smem, int bid, int nb) {
    constexpr bool GEMV = (MODE == 0 || MODE == 1 || MODE == 3);
    constexpr int L = (MODE >= 2) ? 1 : 0;
    constexpr bool FFN = (MODE == 1 || MODE == 3);
    float* hrow = (float*)smem;
    float* part = hrow + 16 * PRE_LD;
    float* logit = part + 8 * 16 * 32;
    int* lcnt = (int*)(logit + 512);
    static_assert((16 * PRE_LD + 8 * 16 * 32 + 512 + 64) * 4 <= LDS_BYTES, "pre lds");
    const int t = tid_opaque(), w = t >> 6, lane = t & 63, fr = lane & 15, fq = lane >> 4;
    bf16x8 bh[4][2], bl[4][2];
    if (GEMV) {
        const bf16_t* wt = p.wrt + (size_t)(MODE == 0 ? 1 : 0) * 2 * 32 * 1024;
#pragma unroll
        for (int ks = 0; ks < 4; ++ks)
#pragma unroll
            for (int nt = 0; nt < 2; ++nt) {
                const size_t off = (size_t)(nt * 16 + fr) * 1024 + w * 128 + ks * 32 + fq * 8;
                bh[ks][nt] = *(const bf16x8*)(wt + off);
                bl[ks][nt] = *(const bf16x8*)(wt + 32 * 1024 + off);
            }
    }
    if (FFN) { if (t < 64) lcnt[t] = 0; }
    __syncthreads();
    const float* gain = (FFN ? p.norm_ffn : p.norm_mix) + L * 1024;
    const int ngroups = (MODE == 3) ? (NLAT / 16) : (R / 16);
    auto row_of = [&](int rg, int rw) { const int i = rg * 16 + w * 2 + rw; return (MODE == 3) ? ((i >> 12) * RPB + CTXL + (i & 4095)) : i; };
    auto load_rows = [&](int rg, f32x4 (&vv)[2][4]) {
#pragma unroll
        for (int rw = 0; rw < 2; ++rw) {
            const int r = row_of(rg, rw);
            const int b = r / RPB, j = r - b * RPB;
            const bool isctx = j < CTXL;
            const float* src;
            if (MODE == 0) src = isctx ? (p.ctx + (size_t)(b * CTXL + j) * D) : (p.x + (size_t)(b * SEQ + (j - CTXL)) * D);
            else src = isctx ? (p.cx + (size_t)(b * CTXL + j) * D) : (p.out + (size_t)(b * SEQ + (j - CTXL)) * D);
#pragma unroll
            for (int i = 0; i < 4; ++i) vv[rw][i] = *(const f32x4*)(src + lane * 4 + i * 256);
        }
    };
    f32x4 g4[4];
#pragma unroll
    for (int i = 0; i < 4; ++i) g4[i] = *(const f32x4*)(gain + lane * 4 + i * 256);
    f32x4 vcur[2][4];
    if (bid < ngroups) load_rows(bid, vcur);
    for (int rg = bid; rg < ngroups; rg += nb) {
        f32x4 vnxt[2][4];
        const bool has_next = rg + nb < ngroups;
        if (has_next) load_rows(rg + nb, vnxt);
#pragma unroll
        for (int rw = 0; rw < 2; ++rw) {
            const int lrow = w * 2 + rw;
            const int r = row_of(rg, rw);
            const int b = r / RPB, j = r - b * RPB;
            const bool isctx = j < CTXL;
            const float* modv = p.mod + ((size_t)(L * 9 + (isctx ? 8 : b))) * 6144 + (FFN ? 3072 : 0);
            float* res = isctx ? (p.cx + (size_t)(b * CTXL + j) * D) : (p.out + (size_t)(b * SEQ + (j - CTXL)) * D);
            f32x4 v[4];
#pragma unroll
            for (int i = 0; i < 4; ++i) v[i] = vcur[rw][i];
            if (MODE == 0) {
                if (!isctx) {
                    const int n = j - CTXL, prow = n >> 6, pcol = n & 63;
#pragma unroll
                    for (int i = 0; i < 4; ++i) {
                        const int c = lane * 4 + i * 256;
                        const f32x4 pe = (c < 512) ? *(const f32x4*)(p.pos + prow * 512 + c) : *(const f32x4*)(p.pos + pcol * 512 + (c - 512));
                        v[i] += pe;
                    }
                }
#pragma unroll
                for (int i = 0; i < 4; ++i) *(f32x4*)(res + lane * 4 + i * 256) = v[i];
            }
            float ss = 0.f;
#pragma unroll
            for (int i = 0; i < 4; ++i) ss += v[i][0] * v[i][0] + v[i][1] * v[i][1] + v[i][2] * v[i][2] + v[i][3] * v[i][3];
#pragma unroll
            for (int o = 32; o >= 1; o >>= 1) ss += __shfl_xor(ss, o);
            const float rstd = rsqrtf(ss * (1.0f / 1024.0f) + EPS);
            f32x4 sh4[4], sc4[4];
#pragma unroll
            for (int i = 0; i < 4; ++i) { const int c = lane * 4 + i * 256; sh4[i] = *(const f32x4*)(modv + c); sc4[i] = *(const f32x4*)(modv + 1024 + c); }
#pragma unroll
            for (int i = 0; i < 4; ++i) {
                const int c = lane * 4 + i * 256;
                f32x4 hv;
#pragma unroll
                for (int q = 0; q < 4; ++q) hv[q] = v[i][q] * rstd * g4[i][q] * (1.0f + sc4[i][q]) + sh4[i][q];
                *(u32x2*)(p.H + (size_t)r * D + c) = pk4(hv);
                if (GEMV) *(f32x4*)(hrow + lrow * PRE_LD + c) = hv;
            }
        }
#pragma unroll
        for (int rw = 0; rw < 2; ++rw)
#pragma unroll
            for (int i = 0; i < 4; ++i) vcur[rw][i] = vnxt[rw][i];
        if (GEMV) {
            lds_sync();
            f32x4 c0 = (f32x4){0.f, 0.f, 0.f, 0.f}, c1 = c0;
#pragma unroll
            for (int ks = 0; ks < 4; ++ks) {
                const float* hp = hrow + fr * PRE_LD + w * 128 + ks * 32 + fq * 8;
                const f32x4 x0 = *(const f32x4*)hp, x1 = *(const f32x4*)(hp + 4);
                u32x4 hi, lo;
                hi.x = cvt_pk_bf16(x0[0], x0[1]); hi.y = cvt_pk_bf16(x0[2], x0[3]); hi.z = cvt_pk_bf16(x1[0], x1[1]); hi.w = cvt_pk_bf16(x1[2], x1[3]);
                lo.x = cvt_pk_bf16(x0[0] - __uint_as_float(hi.x << 16), x0[1] - __uint_as_float(hi.x & 0xffff0000u));
                lo.y = cvt_pk_bf16(x0[2] - __uint_as_float(hi.y << 16), x0[3] - __uint_as_float(hi.y & 0xffff0000u));
                lo.z = cvt_pk_bf16(x1[0] - __uint_as_float(hi.z << 16), x1[1] - __uint_as_float(hi.z & 0xffff0000u));
                lo.w = cvt_pk_bf16(x1[2] - __uint_as_float(hi.w << 16), x1[3] - __uint_as_float(hi.w & 0xffff0000u));
                const bf16x8 ah = __builtin_bit_cast(bf16x8, hi), al = __builtin_bit_cast(bf16x8, lo);
                c0 = __builtin_amdgcn_mfma_f32_16x16x32_bf16(bh[ks][0], ah, c0, 0, 0, 0);
                c0 = __builtin_amdgcn_mfma_f32_16x16x32_bf16(bl[ks][0], ah, c0, 0, 0, 0);
                c0 = __builtin_amdgcn_mfma_f32_16x16x32_bf16(bh[ks][0], al, c0, 0, 0, 0);
                c1 = __builtin_amdgcn_mfma_f32_16x16x32_bf16(bh[ks][1], ah, c1, 0, 0, 0);
                c1 = __builtin_amdgcn_mfma_f32_16x16x32_bf16(bl[ks][1], ah, c1, 0, 0, 0);
                c1 = __builtin_amdgcn_mfma_f32_16x16x32_bf16(bh[ks][1], al, c1, 0, 0, 0);
            }
            *(f32x4*)&part[(w * 16 + fr) * 32 + fq * 4] = c0;
            *(f32x4*)&part[(w * 16 + fr) * 32 + 16 + fq * 4] = c1;
            lds_sync();
            {
                const int row = t >> 5, e2 = t & 31;
                float s = 0.f;
#pragma unroll
                for (int q = 0; q < 8; ++q) s += part[(q * 16 + row) * 32 + e2];
                if (MODE == 0) p.AF[(size_t)(rg * 16 + row) * 32 + e2] = s;
                else logit[row * 32 + e2] = s;
            }
            if (FFN) {
                lds_sync();
                if (t < 16) {
                    int rr;
                    if (MODE == 3) { const int i = rg * 16 + t; rr = (i >> 12) * RPB + CTXL + (i & 4095); } else rr = rg * 16 + t;
                    float best = -3.0e38f; int bg = 0, bi1 = 0, bi2 = 1; float ba1 = 0.f, ba2 = 0.f;
#pragma unroll 1
                    for (int g = 0; g < 8; ++g) {
                        float m1 = -3.0e38f, m2 = -3.0e38f, a1 = 0.f, a2 = 0.f; int i1 = 0, i2 = 0;
#pragma unroll
                        for (int e = 0; e < 4; ++e) {
                            const float a = sigmoidf_(logit[t * 32 + g * 4 + e]);
                            const float sv = a + p.router_bias[g * 4 + e];
                            if (sv > m1) { m2 = m1; i2 = i1; a2 = a1; m1 = sv; i1 = e; a1 = a; }
                            else if (sv > m2) { m2 = sv; i2 = e; a2 = a; }
                        }
                        const float gs = m1 + m2;
                        if (gs > best) { best = gs; bg = g; bi1 = i1; bi2 = i2; ba1 = a1; ba2 = a2; }
                    }
                    const float inv = 1.0f / (ba1 + ba2);
                    const float w1 = ba1 * inv, w2 = ba2 * inv;
                    const int lo = bi1 < bi2 ? bi1 : bi2, hi = bi1 < bi2 ? bi2 : bi1;
                    const float wlo = bi1 < bi2 ? w1 : w2, whi = bi1 < bi2 ? w2 : w1;
                    const int pair = (lo == 0) ? (hi - 1) : (lo == 1 ? (hi + 1) : 5);
                    const int bucket = bg * 6 + pair;
                    float4 rec; rec.x = __int_as_float(bucket); rec.y = wlo; rec.z = whi; rec.w = 0.f;
                    p.RT[rr] = rec;
                    atomicAdd(&lcnt[bucket], 1);
                }
            }
            lds_sync();
        }
    }
    if (FFN) {
        __syncthreads();
        if (t < 48) p.blkcnt[((size_t)L * 256 + bid) * 48 + t] = lcnt[t];
    }
    if (MODE == 3) {
        __syncthreads();
        for (int task = bid; task < NT_GU + NT_WD; task += nb) moe_cvt_task(p, 1, task, smem);
    }
}

struct GemmSmem { bf16_t A[2][128][72]; bf16_t B[2][256][72]; };
static_assert(sizeof(GemmSmem) <= LDS_BYTES, "gemm lds");

template <class Epi>
DEVINL void gemm_tile(const bf16_t* __restrict__ A, int lda, const int* __restrict__ rowlist, int m0, int mvalid,
                      const bf16_t* __restrict__ Bt0, const bf16_t* __restrict__ Bt1, int ldb, int kseg, int K, Epi& epi, char* smem) {
    GemmSmem& S = *(GemmSmem*)smem;
    const int t = tid_opaque(), w = t >> 6, lane = t & 63, fr = lane & 15, fq = lane >> 4, wr = w >> 2, wc = w & 3;
    const int ch = t & 7, rr = t >> 3;
    const bf16_t* ap[2];
#pragma unroll
    for (int i = 0; i < 2; ++i) {
        const int ri = rr + i * 64, gi = ri < mvalid ? ri : 0;
        const int grow = rowlist ? rowlist[m0 + gi] : (m0 + gi);
        ap[i] = A + (size_t)grow * lda + ch * 8;
    }
    u32x4 ra[2], rb[4];
    f32x4 acc[4][4];
#pragma unroll
    for (int m = 0; m < 4; ++m)
#pragma unroll
        for (int n = 0; n < 4; ++n) acc[m][n] = (f32x4){0.f, 0.f, 0.f, 0.f};
    const int nk = K >> 6;
#define GT_GLOAD(kt) do { const int _k0 = (kt) * 64; \
        _Pragma("unroll") for (int i = 0; i < 2; ++i) ra[i] = *(const u32x4*)(ap[i] + _k0); \
        const bf16_t* _bb = (_k0 < kseg) ? (Bt0 + _k0) : (Bt1 + (_k0 - kseg)); \
        _Pragma("unroll") for (int i = 0; i < 4; ++i) rb[i] = *(const u32x4*)(_bb + (size_t)(rr + i * 64) * ldb + ch * 8); } while (0)
#define GT_SSTORE(buf) do { \
        _Pragma("unroll") for (int i = 0; i < 2; ++i) *(u32x4*)&S.A[buf][rr + i * 64][ch * 8] = ra[i]; \
        _Pragma("unroll") for (int i = 0; i < 4; ++i) *(u32x4*)&S.B[buf][rr + i * 64][ch * 8] = rb[i]; } while (0)
    GT_GLOAD(0);
    GT_SSTORE(0);
    __syncthreads();
    for (int kt = 0; kt < nk; ++kt) {
        const int cur = kt & 1;
        if (kt + 1 < nk) GT_GLOAD(kt + 1);
#pragma unroll
        for (int kk = 0; kk < 2; ++kk) {
            bf16x8 a[4], b[4];
#pragma unroll
            for (int m = 0; m < 4; ++m) a[m] = *(const bf16x8*)&S.A[cur][wr * 64 + m * 16 + fr][kk * 32 + fq * 8];
#pragma unroll
            for (int n = 0; n < 4; ++n) b[n] = *(const bf16x8*)&S.B[cur][wc * 64 + n * 16 + fr][kk * 32 + fq * 8];
#pragma unroll
            for (int m = 0; m < 4; ++m)
#pragma unroll
                for (int n = 0; n < 4; ++n) acc[m][n] = __builtin_amdgcn_mfma_f32_16x16x32_bf16(b[n], a[m], acc[m][n], 0, 0, 0);
        }
        if (kt + 1 < nk) GT_SSTORE(cur ^ 1);
        __syncthreads();
    }
#undef GT_GLOAD
#undef GT_SSTORE
    epi(acc, wr * 64, wc * 64, fr, fq);
}

struct EpiP0 {
    bf16_t* P; int m0, n0;
    DEVINL void operator()(const f32x4 (&acc)[4][4], int mb, int nbs, int fr, int fq) const {
        const float sc = (n0 < 256) ? 0.125f : 1.0f;
#pragma unroll
        for (int m = 0; m < 4; ++m) {
            bf16_t* rp = P + (size_t)(m0 + mb + m * 16 + fr) * 2048 + n0 + nbs + fq * 4;
#pragma unroll
            for (int n = 0; n < 4; ++n) *(u32x2*)(rp + n * 16) = pk4(acc[m][n] * sc);
        }
    }
};
struct EpiP1 {
    bf16_t* P; const float* lb; int m0, n0;
    DEVINL void operator()(const f32x4 (&acc)[4][4], int mb, int nbs, int fr, int fq) const {
        const int cb = n0 >> 10;
#pragma unroll
        for (int m = 0; m < 4; ++m) {
            bf16_t* rp = P + (size_t)(m0 + mb + m * 16 + fr) * 5120 + n0 + nbs + fq * 4;
#pragma unroll
            for (int n = 0; n < 4; ++n) {
                const f32x4 a = acc[m][n];
                u32x2 o;
                if (cb == 1 || cb == 2) {
                    const int cc = ((n0 + nbs + n * 16 + fq * 4) & 1023);
                    const f32x4 l4 = *(const f32x4*)(lb + cc);
                    unsigned short hv[4];
#pragma unroll
                    for (int j = 0; j < 4; ++j) hv[j] = f2h((1.0f - l4[j]) * sigmoidf_(-a[j]));
                    o.x = (unsigned)hv[0] | ((unsigned)hv[1] << 16); o.y = (unsigned)hv[2] | ((unsigned)hv[3] << 16);
                } else if (cb == 0 || cb == 4) {
                    f32x4 s;
#pragma unroll
                    for (int j = 0; j < 4; ++j) s[j] = siluf_(a[j]);
                    o = pk4(s);
                } else o = pk4(a);
                *(u32x2*)(rp + n * 16) = o;
            }
        }
    }
};
struct EpiGlu {
    bf16_t* CAT; const bf16_t* s5a; const float* gb; int m0, n0;
    DEVINL void operator()(const f32x4 (&acc)[4][4], int mb, int nbs, int fr, int fq) const {
        f32x4 b4[4];
#pragma unroll
        for (int n = 0; n < 4; ++n) b4[n] = *(const f32x4*)(gb + n0 + nbs + n * 16 + fq * 4);
        u32x2 av[4][4];
#pragma unroll
        for (int m = 0; m < 4; ++m)
#pragma unroll
            for (int n = 0; n < 4; ++n) av[m][n] = *(const u32x2*)(s5a + (size_t)(m0 + mb + m * 16 + fr) * 512 + n0 + nbs + n * 16 + fq * 4);
#pragma unroll
        for (int m = 0; m < 4; ++m) {
            const size_t row = (size_t)(m0 + mb + m * 16 + fr);
#pragma unroll
            for (int n = 0; n < 4; ++n) {
                const int col = n0 + nbs + n * 16 + fq * 4;
                f32x4 o;
                o[0] = bf2f((bf16_t)(av[m][n].x & 0xffff)) * sigmoidf_(acc[m][n][0] + b4[n][0]);
                o[1] = bf2f((bf16_t)(av[m][n].x >> 16)) * sigmoidf_(acc[m][n][1] + b4[n][1]);
                o[2] = bf2f((bf16_t)(av[m][n].y & 0xffff)) * sigmoidf_(acc[m][n][2] + b4[n][2]);
                o[3] = bf2f((bf16_t)(av[m][n].y >> 16)) * sigmoidf_(acc[m][n][3] + b4[n][3]);
                *(u32x2*)(CAT + row * 1024 + 512 + col) = pk4(o);
            }
        }
    }
};
struct EpiOut {
    const Params* p; const float* gate; int m0, n0;
    DEVINL void operator()(const f32x4 (&acc)[4][4], int mb, int nbs, int fr, int fq) const {
        const float* gp = gate + (size_t)8 * 6144;
        f32x4 g4[4];
#pragma unroll
        for (int n = 0; n < 4; ++n) g4[n] = *(const f32x4*)(gp + n0 + nbs + n * 16 + fq * 4);
        f32x4 x4[4][4];
#pragma unroll
        for (int m = 0; m < 4; ++m) {
            const float* rp = resid_row(*p, m0 + mb + m * 16 + fr);
#pragma unroll
            for (int n = 0; n < 4; ++n) x4[m][n] = *(const f32x4*)(rp + n0 + nbs + n * 16 + fq * 4);
        }
#pragma unroll
        for (int m = 0; m < 4; ++m) {
            float* rp = resid_row(*p, m0 + mb + m * 16 + fr);
#pragma unroll
            for (int n = 0; n < 4; ++n) *(f32x4*)(rp + n0 + nbs + n * 16 + fq * 4) = x4[m][n] + g4[n] * acc[m][n];
        }
    }
};

namespace pg8 {
#define PG8_LAS __attribute__((address_space(3)))
constexpr int BM = 256, BK = 64, HALF = 128, HTB = HALF * BK * 2, STAGE_BYTES = 8 * HTB, NXCD = 8, WGM = 8;
DEVINL int lds_byte(int r, int c) { const int st = (r >> 4) * 2 + (c >> 5), rr = r & 15, cc = c & 31, ob = rr * 64 + cc * 2; return st * 1024 + (ob ^ (((ob >> 9) & 1) << 5)); }
DEVINL void stage_rc(int b, int& R_, int& C_) { const int st = b / 1024, sb = b % 1024, swz = sb ^ (((sb >> 9) & 1) << 5); R_ = (st >> 1) * 16 + swz / 64; C_ = (st & 1) * 32 + (swz % 64) / 2; }
DEVINL int perm32(int rho) { const int n = rho >> 4, i = rho & 15; return 8 * (i >> 2) + 4 * n + (i & 3); }
struct Unit { int pm, pn; const char* A; const char* B0; const char* B1; int mvalid, aux; };

template <class Epi, class Sched>
DEVINL void gemm_phase(PG8_LAS unsigned char* lds, const Sched& S, const Epi& E) {
    const int tid = tid_opaque(), wid = __builtin_amdgcn_readfirstlane(tid >> 6), lane = tid & 63, wr = wid >> 2, wc = wid & 3, fr = lane & 15, fq = lane >> 4;
    const int K = S.K, nt = K / BK, ldb = S.ldb, ksplit = S.ksplit;
    unsigned voffA[2], voffB[2];
#pragma unroll
    for (int i = 0; i < 2; ++i) { int R_, C_; stage_rc(tid * 16 + i * 8192, R_, C_); const int Rb = Epi::PERM ? ((R_ & ~31) + perm32(R_ & 31)) : R_;
        voffA[i] = (unsigned)(R_ * K + C_) * 2u; voffB[i] = (unsigned)(Rb * ldb + C_) * 2u; }
    const size_t kstep = (size_t)(BK * 2);
    const size_t hstepA = (size_t)HALF * K * 2, hstepB = (size_t)HALF * ldb * 2;
    const unsigned ldsw = (unsigned)wid * 1024u;
    const int aoff = lds_byte(wr * 64 + fr, fq * 8), boff = lds_byte(wc * 32 + fr, fq * 8);
#define PG8_SA(b, h) (((b) * 2 + (h)) * HTB)
#define PG8_SB(b, h) ((4 + (b) * 2 + (h)) * HTB)
#define PG8_STAGE(bufoff, gbase, voff) do { _Pragma("unroll") for (int _i = 0; _i < 2; ++_i) \
        __builtin_amdgcn_global_load_lds((const unsigned*)((const char*)(gbase) + (voff)[_i]), (PG8_LAS unsigned*)(lds + (bufoff) + ldsw + _i * 8192), 16, 0, 0); } while (0)
#define PG8_LDA(dst, b, h) do { _Pragma("unroll") for (int m = 0; m < 4; ++m) _Pragma("unroll") for (int k = 0; k < 2; ++k) dst[m][k] = *(const PG8_LAS bf16x8*)(lds + PG8_SA(b, h) + aoff + m * 2048 + k * 1024); } while (0)
#define PG8_LDB(dst, b, h) do { _Pragma("unroll") for (int n = 0; n < 2; ++n) _Pragma("unroll") for (int k = 0; k < 2; ++k) dst[n][k] = *(const PG8_LAS bf16x8*)(lds + PG8_SB(b, h) + boff + n * 2048 + k * 1024); } while (0)
#define PG8_MMA(ai, bj, At, Bt) do { __builtin_amdgcn_s_setprio(1); _Pragma("unroll") for (int m = 0; m < 4; ++m) _Pragma("unroll") for (int n = 0; n < 2; ++n) _Pragma("unroll") for (int k = 0; k < 2; ++k) \
        acc[ai][bj][m][n] = __builtin_amdgcn_mfma_f32_16x16x32_bf16(Bt[n][k], At[m][k], acc[ai][bj][m][n], 0, 0, 0); __builtin_amdgcn_s_setprio(0); } while (0)
#define PG8_WAIT_V(n) asm volatile("s_waitcnt vmcnt(" #n ")" ::: "memory")
#define PG8_WAIT_L(n) asm volatile("s_waitcnt lgkmcnt(" #n ")" ::: "memory")
#define PG8_BAR __builtin_amdgcn_s_barrier()
#define PG8_SCHED __builtin_amdgcn_sched_barrier(0)
#define PG8_BPTR(u, kt) (((kt) < ksplit ? (u).B0 : (u).B1) + (size_t)(kt) * kstep)
    Unit cur, nxt; int ui = 0;
    if (!S.next(0, cur)) return;
    f32x4 acc[2][2][4][2];
#pragma unroll
    for (int a = 0; a < 2; ++a)
#pragma unroll
        for (int b = 0; b < 2; ++b)
#pragma unroll
            for (int m = 0; m < 4; ++m)
#pragma unroll
                for (int n = 0; n < 2; ++n) acc[a][b][m][n] = (f32x4){0.f, 0.f, 0.f, 0.f};
    bf16x8 At[4][2], B0[2][2], B1[2][2];
    const char* cA = cur.A;
    { const char* cB0 = PG8_BPTR(cur, 0); const char* cB1 = PG8_BPTR(cur, 1);
      PG8_STAGE(PG8_SB(0, 0), cB0, voffB); PG8_STAGE(PG8_SA(0, 0), cA, voffA); PG8_STAGE(PG8_SB(0, 1), cB0 + hstepB, voffB); PG8_STAGE(PG8_SA(0, 1), cA + hstepA, voffA);
      if (wr == 1) PG8_BAR;
      PG8_WAIT_V(4); PG8_BAR;
      PG8_STAGE(PG8_SB(1, 0), cB1, voffB); PG8_STAGE(PG8_SA(1, 0), cA + kstep, voffA); PG8_STAGE(PG8_SB(1, 1), cB1 + hstepB, voffB);
      PG8_WAIT_V(6); PG8_BAR; }
    for (;;) {
        const bool has_next = S.next(ui + 1, nxt);
        if (!has_next) nxt = cur;
        const char* nA = nxt.A;
        for (int t = 0; t < nt; t += 2) {
            const bool last = (t == nt - 2);
            const char* a1 = cA + (size_t)(t + 1) * kstep;
            const char* a2 = last ? nA : cA + (size_t)(t + 2) * kstep;
            const char* b2 = last ? PG8_BPTR(nxt, 0) : PG8_BPTR(cur, t + 2);
            const char* a3 = a2 + kstep;
            const char* b3 = last ? PG8_BPTR(nxt, 1) : PG8_BPTR(cur, t + 3);
            PG8_LDB(B0, 0, 0); PG8_SCHED; PG8_LDA(At, 0, 0); PG8_STAGE(PG8_SA(1, 1), a1 + hstepA, voffA);
            PG8_WAIT_L(8); PG8_BAR; PG8_WAIT_L(0); PG8_MMA(0, 0, At, B0); PG8_BAR; PG8_SCHED;
            PG8_LDB(B1, 0, 1); PG8_STAGE(PG8_SB(0, 0), b2, voffB);
            PG8_BAR; PG8_WAIT_L(0); PG8_MMA(0, 1, At, B1); PG8_BAR;
            PG8_LDA(At, 0, 1); PG8_STAGE(PG8_SA(0, 0), a2, voffA);
            PG8_BAR; PG8_WAIT_L(0); PG8_MMA(1, 0, At, B0); PG8_BAR; PG8_SCHED;
            PG8_STAGE(PG8_SB(0, 1), b2 + hstepB, voffB);
            PG8_WAIT_V(6); PG8_BAR; PG8_MMA(1, 1, At, B1); PG8_BAR;
            PG8_LDB(B0, 1, 0); PG8_SCHED; PG8_LDA(At, 1, 0); PG8_STAGE(PG8_SA(0, 1), a2 + hstepA, voffA);
            PG8_WAIT_L(8); PG8_BAR; PG8_WAIT_L(0); PG8_MMA(0, 0, At, B0); PG8_BAR; PG8_SCHED;
            PG8_LDB(B1, 1, 1); PG8_STAGE(PG8_SB(1, 0), b3, voffB);
            PG8_BAR; PG8_WAIT_L(0); PG8_MMA(0, 1, At, B1); PG8_BAR;
            PG8_LDA(At, 1, 1); PG8_STAGE(PG8_SA(1, 0), a3, voffA);
            PG8_BAR; PG8_WAIT_L(0); PG8_MMA(1, 0, At, B0); PG8_BAR; PG8_SCHED;
            PG8_STAGE(PG8_SB(1, 1), b3 + hstepB, voffB);
            PG8_WAIT_V(6); PG8_BAR; PG8_MMA(1, 1, At, B1); PG8_BAR;
        }
        E(acc, cur, wr, wc, fr, fq);
        if (!has_next) break;
#pragma unroll
        for (int a = 0; a < 2; ++a)
#pragma unroll
            for (int b = 0; b < 2; ++b)
#pragma unroll
                for (int m = 0; m < 4; ++m)
#pragma unroll
                    for (int n = 0; n < 2; ++n) acc[a][b][m][n] = (f32x4){0.f, 0.f, 0.f, 0.f};
        cur = nxt; cA = nA; ++ui;
    }
    PG8_WAIT_V(0);
    if (wr == 0) PG8_BAR;
    PG8_BAR;
#undef PG8_SA
#undef PG8_SB
#undef PG8_STAGE
#undef PG8_LDA
#undef PG8_LDB
#undef PG8_MMA
#undef PG8_WAIT_V
#undef PG8_WAIT_L
#undef PG8_BAR
#undef PG8_SCHED
#undef PG8_BPTR
}

struct DenseSched {
    const char* A; const char* Bt; int K, ldb, ksplit, nM, nN, G, c, lat;
    DEVINL void init(const bf16_t* A_, const bf16_t* Bt_, int N, int K_, int G_, int c_, int lat_) {
        A = (const char*)A_; Bt = (const char*)Bt_; K = K_; ldb = K_; ksplit = K_ / BK; nM = lat_ ? 128 : 136; nN = N / BM; G = G_; c = c_; lat = lat_; }
    DEVINL bool next(int i, Unit& u) const {
        const int nwg = nM * nN;
        const long Lq = (long)i * G + c; if (Lq >= nwg) return false;
        int wgid = (int)Lq; { const int q = nwg / NXCD, r = nwg % NXCD, xcd = wgid % NXCD, off = wgid / NXCD; wgid = (xcd < r ? xcd * (q + 1) : r * (q + 1) + (xcd - r) * q) + off; }
        const int nig = WGM * nN, gid = wgid / nig, fm = gid * WGM, gsz = (nM - fm) < WGM ? (nM - fm) : WGM;
        int pm = fm + ((wgid % nig) % gsz); const int pn = (wgid % nig) / gsz;
        if (lat) pm = (pm >> 4) * 17 + 1 + (pm & 15);
        u.pm = pm; u.pn = pn; u.A = A + (size_t)pm * BM * K * 2; u.B0 = Bt + (size_t)pn * BM * K * 2; u.B1 = u.B0; u.mvalid = 256; u.aux = 0;
        return true;
    }
};
}

struct GEpiP0 {
    static constexpr bool PERM = true;
    bf16_t* P;
    DEVINL void operator()(const f32x4 (&acc)[2][2][4][2], const pg8::Unit& u, int wr, int wc, int fr, int fq) const {
        const float sc = (u.pn == 0) ? 0.125f : 1.0f;
        const int row0 = u.pm * 256 + wr * 64 + fr, col0 = u.pn * 256 + wc * 32 + 8 * fq;
#pragma unroll
        for (int ai = 0; ai < 2; ++ai)
#pragma unroll
            for (int m = 0; m < 4; ++m) {
                bf16_t* rp = P + (size_t)(row0 + ai * 128 + m * 16) * 2048 + col0;
#pragma unroll
                for (int bj = 0; bj < 2; ++bj) {
                    const u32x2 a = pk4(acc[ai][bj][m][0] * sc), b = pk4(acc[ai][bj][m][1] * sc);
                    u32x4 w; w.x = a.x; w.y = a.y; w.z = b.x; w.w = b.y;
                    *(u32x4*)(rp + bj * 128) = w;
                }
            }
    }
};
struct GEpiP1 {
    static constexpr bool PERM = true;
    bf16_t* P; const float* lb;
    DEVINL void operator()(const f32x4 (&acc)[2][2][4][2], const pg8::Unit& u, int wr, int wc, int fr, int fq) const {
        const int cb = u.pn >> 2;
        const int row0 = u.pm * 256 + wr * 64 + fr, col0 = u.pn * 256 + wc * 32 + 8 * fq;
        f32x4 oml[2][2];
        if (cb == 1 || cb == 2) {
#pragma unroll
            for (int bj = 0; bj < 2; ++bj)
#pragma unroll
                for (int n = 0; n < 2; ++n) { const f32x4 l4 = *(const f32x4*)(lb + ((col0 + bj * 128) & 1023) + 4 * n); oml[bj][n] = 1.0f - l4; }
        }
#pragma unroll
        for (int ai = 0; ai < 2; ++ai)
#pragma unroll
            for (int m = 0; m < 4; ++m) {
                bf16_t* rp = P + (size_t)(row0 + ai * 128 + m * 16) * 5120 + col0;
#pragma unroll
                for (int bj = 0; bj < 2; ++bj) {
                    u32x4 w;
                    if (cb == 1 || cb == 2) {
                        unsigned short hv[8];
#pragma unroll
                        for (int n = 0; n < 2; ++n)
#pragma unroll
                            for (int j = 0; j < 4; ++j) hv[n * 4 + j] = f2h(oml[bj][n][j] * sigmoidf_(-acc[ai][bj][m][n][j]));
                        w.x = (unsigned)hv[0] | ((unsigned)hv[1] << 16); w.y = (unsigned)hv[2] | ((unsigned)hv[3] << 16);
                        w.z = (unsigned)hv[4] | ((unsigned)hv[5] << 16); w.w = (unsigned)hv[6] | ((unsigned)hv[7] << 16);
                    } else {
                        f32x4 v0 = acc[ai][bj][m][0], v1 = acc[ai][bj][m][1];
                        if (cb == 0 || cb == 4) {
#pragma unroll
                            for (int j = 0; j < 4; ++j) { v0[j] = siluf_(v0[j]); v1[j] = siluf_(v1[j]); }
                        }
                        const u32x2 a = pk4(v0), b = pk4(v1);
                        w.x = a.x; w.y = a.y; w.z = b.x; w.w = b.y;
                    }
                    *(u32x4*)(rp + bj * 128) = w;
                }
            }
    }
};
struct GEpiGlu {
    static constexpr bool PERM = true;
    bf16_t* CAT; const bf16_t* s5a; const float* gb;
    DEVINL void operator()(const f32x4 (&acc)[2][2][4][2], const pg8::Unit& u, int wr, int wc, int fr, int fq) const {
        const int row0 = u.pm * 256 + wr * 64 + fr, col0 = u.pn * 256 + wc * 32 + 8 * fq;
        f32x4 bv[2][2];
#pragma unroll
        for (int bj = 0; bj < 2; ++bj)
#pragma unroll
            for (int n = 0; n < 2; ++n) bv[bj][n] = *(const f32x4*)(gb + col0 + bj * 128 + 4 * n);
#pragma unroll
        for (int ai = 0; ai < 2; ++ai) {
            u32x4 av[4][2];
#pragma unroll
            for (int m = 0; m < 4; ++m)
#pragma unroll
                for (int bj = 0; bj < 2; ++bj) av[m][bj] = *(const u32x4*)(s5a + (size_t)(row0 + ai * 128 + m * 16) * 512 + col0 + bj * 128);
#pragma unroll
            for (int m = 0; m < 4; ++m) {
                const size_t row = (size_t)(row0 + ai * 128 + m * 16);
#pragma unroll
                for (int bj = 0; bj < 2; ++bj) {
                    const u32x4 a = av[m][bj];
                    f32x4 o0, o1;
                    o0[0] = bf2f((bf16_t)(a.x & 0xffff)) * sigmoidf_(acc[ai][bj][m][0][0] + bv[bj][0][0]);
                    o0[1] = bf2f((bf16_t)(a.x >> 16)) * sigmoidf_(acc[ai][bj][m][0][1] + bv[bj][0][1]);
                    o0[2] = bf2f((bf16_t)(a.y & 0xffff)) * sigmoidf_(acc[ai][bj][m][0][2] + bv[bj][0][2]);
                    o0[3] = bf2f((bf16_t)(a.y >> 16)) * sigmoidf_(acc[ai][bj][m][0][3] + bv[bj][0][3]);
                    o1[0] = bf2f((bf16_t)(a.z & 0xffff)) * sigmoidf_(acc[ai][bj][m][1][0] + bv[bj][1][0]);
                    o1[1] = bf2f((bf16_t)(a.z >> 16)) * sigmoidf_(acc[ai][bj][m][1][1] + bv[bj][1][1]);
                    o1[2] = bf2f((bf16_t)(a.w & 0xffff)) * sigmoidf_(acc[ai][bj][m][1][2] + bv[bj][1][2]);
                    o1[3] = bf2f((bf16_t)(a.w >> 16)) * sigmoidf_(acc[ai][bj][m][1][3] + bv[bj][1][3]);
                    const u32x2 x = pk4(o0), y = pk4(o1);
                    u32x4 w; w.x = x.x; w.y = x.y; w.z = y.x; w.w = y.y;
                    *(u32x4*)(CAT + row * 1024 + 512 + col0 + bj * 128) = w;
                }
            }
        }
    }
};
struct GEpiOut {
    static constexpr bool PERM = false;
    float* out; const float* gate;
    DEVINL void operator()(const f32x4 (&acc)[2][2][4][2], const pg8::Unit& u, int wr, int wc, int fr, int fq) const {
        const int b = u.pm / 17, lt = u.pm - b * 17 - 1;
        const float* gp = gate + (size_t)b * 6144;
        const int col0 = u.pn * 256 + wc * 32 + 4 * fq;
        float* base = out + ((size_t)b * SEQ + lt * 256 + wr * 64 + fr) * D;
        f32x4 g4[2][2];
#pragma unroll
        for (int bj = 0; bj < 2; ++bj)
#pragma unroll
            for (int n = 0; n < 2; ++n) g4[bj][n] = *(const f32x4*)(gp + col0 + bj * 128 + n * 16);
#pragma unroll
        for (int ai = 0; ai < 2; ++ai)
#pragma unroll
            for (int mp = 0; mp < 4; mp += 2) {
                f32x4 x4[2][2][2];
#pragma unroll
                for (int q = 0; q < 2; ++q)
#pragma unroll
                    for (int bj = 0; bj < 2; ++bj)
#pragma unroll
                        for (int n = 0; n < 2; ++n) x4[q][bj][n] = *(const f32x4*)(base + (size_t)(ai * 128 + (mp + q) * 16) * D + col0 + bj * 128 + n * 16);
                asm volatile("" ::: "memory");
#pragma unroll
                for (int q = 0; q < 2; ++q)
#pragma unroll
                    for (int bj = 0; bj < 2; ++bj)
#pragma unroll
                        for (int n = 0; n < 2; ++n) *(f32x4*)(base + (size_t)(ai * 128 + (mp + q) * 16) * D + col0 + bj * 128 + n * 16) = x4[q][bj][n] + g4[bj][n] * acc[ai][bj][mp + q][n];
                asm volatile("" ::: "memory");
            }
    }
};
struct GEpiMoe1 {
    static constexpr bool PERM = true;
    bf16_t* act; const float* wl; const float* wh;
    DEVINL void operator()(const f32x4 (&acc)[2][2][4][2], const pg8::Unit& u, int wr, int wc, int fr, int fq) const {
        const int half = u.pn >> 1;
        const float* wsel = half ? wh : wl;
        const int cbase = half * 256 + (u.pn & 1) * 128 + 16 * wc + 4 * fq;
        float wv[2][4];
#pragma unroll
        for (int ai = 0; ai < 2; ++ai)
#pragma unroll
            for (int m = 0; m < 4; ++m) { const int lr = ai * 128 + wr * 64 + m * 16 + fr; wv[ai][m] = (lr < u.mvalid) ? wsel[u.pm * 256 + lr] : 0.f; }
#pragma unroll
        for (int ai = 0; ai < 2; ++ai)
#pragma unroll
            for (int m = 0; m < 4; ++m) {
                const int slot = u.pm * 256 + ai * 128 + wr * 64 + m * 16 + fr;
#pragma unroll
                for (int bj = 0; bj < 2; ++bj) {
                    f32x4 o;
#pragma unroll
                    for (int j = 0; j < 4; ++j) o[j] = wv[ai][m] * siluf_(acc[ai][bj][m][0][j]) * acc[ai][bj][m][1][j];
                    *(u32x2*)(act + (size_t)slot * 512 + cbase + 64 * bj) = pk4(o);
                }
            }
    }
};
struct GEpiMoe2 {
    static constexpr bool PERM = false;
    float* out; float* cx; const float* gate; const int* list;
    DEVINL void operator()(const f32x4 (&acc)[2][2][4][2], const pg8::Unit& u, int wr, int wc, int fr, int fq) const {
        const int col0 = u.pn * 256 + wc * 32 + 4 * fq;
        int rows[2][4];
#pragma unroll
        for (int ai = 0; ai < 2; ++ai)
#pragma unroll
            for (int m = 0; m < 4; ++m) { const int lr = ai * 128 + wr * 64 + m * 16 + fr; rows[ai][m] = (lr < u.mvalid) ? list[u.pm * 256 + lr] : -1; }
#pragma unroll
        for (int ai = 0; ai < 2; ++ai)
#pragma unroll
            for (int mp = 0; mp < 4; mp += 2) {
                f32x4 x4[2][2][2], g4[2][2][2];
                float* rp[2];
#pragma unroll
                for (int q = 0; q < 2; ++q) {
                    const int r = rows[ai][mp + q] < 0 ? 0 : rows[ai][mp + q];
                    const int rb = r / RPB, rj = r - rb * RPB;
                    rp[q] = (rj < CTXL) ? (cx + (size_t)(rb * CTXL + rj) * D) : (out + (size_t)(rb * SEQ + (rj - CTXL)) * D);
                    const float* gp = gate + (size_t)((rj < CTXL) ? 8 : rb) * 6144;
#pragma unroll
                    for (int bj = 0; bj < 2; ++bj)
#pragma unroll
                        for (int n = 0; n < 2; ++n) { const int col = col0 + bj * 128 + n * 16; x4[q][bj][n] = *(const f32x4*)(rp[q] + col); g4[q][bj][n] = *(const f32x4*)(gp + col); }
                }
                asm volatile("" ::: "memory");
#pragma unroll
                for (int q = 0; q < 2; ++q)
                    if (rows[ai][mp + q] >= 0) {
#pragma unroll
                        for (int bj = 0; bj < 2; ++bj)
#pragma unroll
                            for (int n = 0; n < 2; ++n) *(f32x4*)(rp[q] + col0 + bj * 128 + n * 16) = x4[q][bj][n] + g4[q][bj][n] * acc[ai][bj][mp + q][n];
                    }
            }
    }
};

template <int WHICH>
DEVINL void phase_gemm(const Params& p, char* smem, int bid, int nb) {
    constexpr int N = (WHICH == 0) ? 2048 : (WHICH == 1) ? 512 : (WHICH == 3) ? 5120 : 1024;
    constexpr int K = (WHICH == 1) ? 512 : 1024;
    PG8_LAS unsigned char* lds = (PG8_LAS unsigned char*)smem;
    pg8::DenseSched S;
    bid = sgpr(bid); nb = sgpr(nb);
    if (WHICH == 0) { S.init(sgpr_ptr(p.H), sgpr_ptr(p.wt_in0), N, K, nb, bid, 1); GEpiP0 e{sgpr_ptr(p.P)}; pg8::gemm_phase(lds, S, e); }
    if (WHICH == 1) { S.init(sgpr_ptr(p.s5a), sgpr_ptr(p.glu_t), N, K, nb, bid, 1); GEpiGlu e{sgpr_ptr(p.H), sgpr_ptr(p.s5a), sgpr_ptr(p.glu_b)}; pg8::gemm_phase(lds, S, e); }
    if (WHICH == 2) { S.init(sgpr_ptr(p.H), sgpr_ptr(p.wt_out0), N, K, nb, bid, 1); GEpiOut e{sgpr_ptr(p.out), sgpr_ptr(p.mod) + 2048}; pg8::gemm_phase(lds, S, e); }
    if (WHICH == 3) { S.init(sgpr_ptr(p.H), sgpr_ptr(p.wt_in1), N, K, nb, bid, 1); GEpiP1 e{sgpr_ptr(p.P), sgpr_ptr(p.lb)}; pg8::gemm_phase(lds, S, e); }
    if (WHICH == 4) { S.init(sgpr_ptr(p.H), sgpr_ptr(p.wt_out1), N, K, nb, bid, 1); GEpiOut e{sgpr_ptr(p.out), sgpr_ptr(p.mod) + 9 * 6144 + 2048}; pg8::gemm_phase(lds, S, e); }
    if (WHICH != 4) {
        constexpr int NT0 = (WHICH == 3) ? 4 : 0, NT1 = (WHICH == 3) ? 16 : N / 256, NTC = NT1 - NT0;
        for (int u = bid; u < 16 * NTC; u += nb) {
            const int mt = u / NTC, nt = NT0 + (u - mt * NTC);
            const int m0 = (mt >> 1) * RPB + (mt & 1) * 128, n0 = nt * 256;
            if (WHICH == 0) { EpiP0 e{p.P, m0, n0}; gemm_tile(p.H, 1024, nullptr, m0, 128, p.wt_in0 + (size_t)n0 * 1024, nullptr, 1024, K, K, e, smem); }
            if (WHICH == 1) { EpiGlu e{p.H, p.s5a, p.glu_b, m0, n0}; gemm_tile(p.s5a, 512, nullptr, m0, 128, p.glu_t + (size_t)n0 * 512, nullptr, 512, K, K, e, smem); }
            if (WHICH == 2) { EpiOut e{&p, p.mod + 2048, m0, n0}; gemm_tile(p.H, 1024, nullptr, m0, 128, p.wt_out0 + (size_t)n0 * 1024, nullptr, 1024, K, K, e, smem); }
            if (WHICH == 3) { EpiP1 e{p.P, p.lb, m0, n0}; gemm_tile(p.H, 1024, nullptr, m0, 128, p.wt_in1 + (size_t)n0 * 1024, nullptr, 1024, K, K, e, smem); }
        }
    }
}

constexpr int MOE_TAB = pg8::STAGE_BYTES;
static_assert(MOE_TAB + 1024 <= LDS_BYTES, "moe tables");
DEVINL void moe_setup(const Params& p, int L, int* tab) {
    const int t = tid_opaque();
    if (t < 48) tab[128 + t] = p.cnt[L * 64 + t];
    __syncthreads();
    if (t == 0) {
        int o = 0, ts = 0;
        for (int b = 0; b < 48; ++b) { const int c = tab[128 + b]; tab[b] = o; tab[64 + b] = ts; const int nt = (c + 255) >> 8; o += nt * 256; ts += nt; }
        tab[48] = o; tab[64 + 48] = ts;
    }
    __syncthreads();
}
template <int L>
DEVINL void phase_list(const Params& p, char* smem, int bid, int nb) {
    int* tab = (int*)(smem + MOE_TAB);
    int* red = (int*)smem;
    int* rsrc = red + 1024; int* rdst = rsrc + 256;
    const int t = tid_opaque(), w = t >> 6, lane = t & 63;
    {
        const int bkt = t & 63, part = t >> 6;
        int tot = 0, pre = 0;
        if (bkt < 48) {
#pragma unroll 8
            for (int q = 0; q < 32; ++q) { const int blk = part * 32 + q; const int c = (blk < nb) ? p.blkcnt[((size_t)L * 256 + blk) * 48 + bkt] : 0; tot += c; pre += (blk < bid) ? c : 0; }
        }
        red[part * 64 + bkt] = tot; red[512 + part * 64 + bkt] = pre;
    }
    __syncthreads();
    if (t < 48) {
        int tot = 0, pre = 0;
#pragma unroll
        for (int q = 0; q < 8; ++q) { tot += red[q * 64 + t]; pre += red[512 + q * 64 + t]; }
        tab[128 + t] = tot; tab[192 + t] = pre;
        if (bid == 0) p.cnt[L * 64 + t] = tot;
    }
    __syncthreads();
    if (t == 0) {
        int o = 0, ts = 0;
        for (int b = 0; b < 48; ++b) { const int c = tab[128 + b]; tab[b] = o; tab[64 + b] = ts; const int nt = (c + 255) >> 8; o += nt * 256; ts += nt; }
        tab[48] = o; tab[64 + 48] = ts;
    }
    __syncthreads();
    if (t < 48) tab[192 + t] += tab[t];
    __syncthreads();
    const int ngroups = L ? (NLAT / 16) : (R / 16);
    const int nmine = (bid < ngroups) ? (((ngroups - 1 - bid) / nb + 1) * 16) : 0;
    if (t < nmine) {
        const int idx = (bid + (t >> 4) * nb) * 16 + (t & 15);
        const int r = L ? ((idx >> 12) * RPB + CTXL + (idx & 4095)) : idx;
        const float4 rec = p.RT[r];
        const int bucket = __float_as_int(rec.x);
        const int slot = atomicAdd(&tab[192 + bucket], 1);
        p.list[slot] = r; p.wl[slot] = rec.y; p.wh[slot] = rec.z; p.sor[r] = slot;
        rsrc[t] = r; rdst[t] = slot;
    }
    __syncthreads();
    for (int q0 = w; q0 < nmine; q0 += 64) {
        u32x4 v0[8], v1[8];
#pragma unroll
        for (int j = 0; j < 8; ++j) {
            const int q = q0 + j * 8;
            if (q < nmine) { const u32x4* src = (const u32x4*)(p.H + (size_t)rsrc[q] * D); v0[j] = src[lane]; v1[j] = src[lane + 64]; }
        }
#pragma unroll
        for (int j = 0; j < 8; ++j) {
            const int q = q0 + j * 8;
            if (q < nmine) { u32x4* dst = (u32x4*)(p.hs + (size_t)rdst[q] * D); dst[lane] = v0[j]; dst[lane + 64] = v1[j]; }
        }
    }
}
struct MoeSched {
    const bf16_t* hs; const bf16_t* wgu_t; const bf16_t* act; const bf16_t* wd_t; const int* tab; int K, ldb, ksplit, G, c, stage, ntiles;
    DEVINL bool next(int i, pg8::Unit& u) const {
        const int x = c & 7, rk = c >> 3, nper = G >> 3;
        const int t0 = (ntiles * x) >> 3, t1 = (ntiles * (x + 1)) >> 3;
        const int li = i * nper + rk;
        if (li >= (t1 - t0) * 4) return false;
        const int tile = t0 + (li >> 2), pn = li & 3;
        int bucket = 0;
        for (int b = 0; b < 48; ++b) if (tile >= tab[64 + b] && tile < tab[64 + b + 1]) bucket = b;
        bucket = sgpr(bucket);
        const int ti = tile - sgpr(tab[64 + bucket]);
        const int m0 = sgpr(tab[bucket]) + ti * 256;
        const int rem = sgpr(tab[128 + bucket]) - ti * 256;
        const int grp = bucket / 6, pair = bucket - grp * 6;
        const int lo = (pair < 3) ? 0 : (pair < 5 ? 1 : 2);
        const int hi = (pair < 3) ? (pair + 1) : (pair < 5 ? (pair - 1) : 3);
        const int ea = grp * 4 + lo, eb = grp * 4 + hi;
        u.pm = m0 >> 8; u.pn = pn; u.mvalid = rem < 256 ? rem : 256; u.aux = 0;
        if (stage == 1) {
            const int e = (pn >> 1) ? eb : ea;
            u.A = (const char*)(hs + (size_t)m0 * 1024);
            u.B0 = (const char*)(wgu_t + ((size_t)e * 512 + (pn & 1) * 256) * 1024); u.B1 = u.B0;
        } else {
            u.A = (const char*)(act + (size_t)m0 * 512);
            u.B0 = (const char*)(wd_t + ((size_t)ea * 1024 + pn * 256) * 256);
            u.B1 = (const char*)(wd_t + ((size_t)eb * 1024 + pn * 256) * 256) - (size_t)4 * 128;
        }
        return true;
    }
};
template <int L, int STAGE>
DEVINL void phase_moe(const Params& p, char* smem, int bid, int nb) {
    int* tab = (int*)(smem + MOE_TAB);
    moe_setup(p, L, tab);
    PG8_LAS unsigned char* lds = (PG8_LAS unsigned char*)smem;
    MoeSched S; S.hs = sgpr_ptr(p.hs); S.wgu_t = sgpr_ptr(p.wgu_t); S.act = sgpr_ptr(p.act); S.wd_t = sgpr_ptr(p.wd_t);
    S.tab = tab; S.G = sgpr(nb); S.c = sgpr(bid); S.stage = STAGE; S.ntiles = sgpr(tab[64 + 48]);
    if (STAGE == 1) { S.K = 1024; S.ldb = 1024; S.ksplit = 16; GEpiMoe1 e{sgpr_ptr(p.act), sgpr_ptr(p.wl), sgpr_ptr(p.wh)}; pg8::gemm_phase(lds, S, e); }
    else { S.K = 512; S.ldb = 256; S.ksplit = 4; GEpiMoe2 e{sgpr_ptr(p.out), sgpr_ptr(p.cx), sgpr_ptr(p.mod) + (size_t)L * 9 * 6144 + 5120, sgpr_ptr(p.list)}; pg8::gemm_phase(lds, S, e); }
    __syncthreads();
}

template <int DK> struct RecL {
    static constexpr int QS = DK + 8;
    static constexpr int oQs = 0;
    static constexpr int oKs = oQs + 64 * QS * 2;
    static constexpr int oKt = oKs + 64 * QS * 2;
    static constexpr int oVt = oKt + DK * 72 * 2;
    static constexpr int oAt = oVt + 128 * 72 * 2;
    static constexpr int oSt = oAt + 64 * 72 * 2;
    static constexpr int oPart = oSt + 128 * 136 * 2;
    static constexpr int oEmid = oPart + 8 * 128 * 4;
    static constexpr int oEend = oEmid + 128 * 4;
    static constexpr int oAF = oEend + 128 * 4;
    static constexpr int oRed = oAF + 64 * 32 * 4;
    static constexpr int total = oRed + 64 * 2 * 4 + 128 * 4;
};
static_assert(RecL<128>::total <= LDS_BYTES, "rec lds");

template <bool GLA> struct RecCols {
    static constexpr int LDP = GLA ? 2048 : 5120;
    static constexpr int QOFF = 0;
    static constexpr int KOFF = 256;
    static constexpr int KF = 1024, KB = 2048;
    static constexpr int VOFF = GLA ? 512 : 3072;
    static constexpr int GOFF = GLA ? 1024 : 4096;
};
template <int DK, bool GLA> struct RecGeo {
    static constexpr int GC = GLA ? 4 : 8;
    static constexpr int NS = GLA ? 16 : 8;
    static constexpr int H = GLA ? 4 : 8;
    static constexpr int KT = DK / 16;
};

struct RawRegs { u32x4 q[2], k[2], v[2], af; };

template <int DK, bool GLA, int DIR, bool PASS3>
DEVINL void rec_load_raw(const Params& p, const bf16_t* __restrict__ P, int row0, int h, RawRegs& r) {
    using C = RecCols<GLA>; constexpr int LDP = C::LDP;
    const int t = tid_opaque();
    if (GLA) {
        const int row = t >> 3, c8 = (t & 7) * 8;
        const bf16_t* rp = P + (size_t)(row0 + row) * LDP + h * 64 + c8;
        if (PASS3) r.q[0] = *(const u32x4*)(rp + C::QOFF);
        r.k[0] = *(const u32x4*)(rp + C::KOFF);
        r.af = *(const u32x4*)(p.AF + (size_t)(row0 + row) * 32 + (t & 7) * 4);
    } else {
#pragma unroll
        for (int i = 0; i < 2; ++i) {
            const int row = (t >> 4) + i * 32, c8 = (t & 15) * 8;
            const bf16_t* rp = P + (size_t)(row0 + row) * LDP + h * 128 + c8;
            if (PASS3) r.q[i] = *(const u32x4*)(rp + C::QOFF);
            r.k[i] = *(const u32x4*)(rp + (DIR ? C::KB : C::KF));
        }
    }
#pragma unroll
    for (int i = 0; i < 2; ++i) {
        const int row = (t >> 4) + i * 32, c8 = (t & 15) * 8;
        r.v[i] = *(const u32x4*)(P + (size_t)(row0 + row) * LDP + C::VOFF + h * 128 + c8);
    }
}

template <int DK, bool GLA, int DIR, bool PASS3>
DEVINL void rec_prep(const Params& p, char* smem, const bf16_t* __restrict__ P, RawRegs& raw, bool has_next, int next_row0, int h,
                     const float (&a2c)[2][16], const float (&abv)[2], float (&bsum)[2]) {
    using L = RecL<DK>;
    constexpr int NCP = DK / 2, NSEG = NTHR / NCP, RS = 64 / NSEG, QS = L::QS;
    constexpr bool ref_end = !PASS3;
    bf16_t* Qs = (bf16_t*)(smem + L::oQs); bf16_t* Ks = (bf16_t*)(smem + L::oKs); bf16_t* Kt = (bf16_t*)(smem + L::oKt); bf16_t* Vt = (bf16_t*)(smem + L::oVt);
    bf16_t* Vraw = (bf16_t*)(smem + L::oSt);
    float* part = (float*)(smem + L::oPart); float* emid = (float*)(smem + L::oEmid); float* eend = (float*)(smem + L::oEend); float* AFs = (float*)(smem + L::oAF);
    const int t = tid_opaque();
    if (GLA) {
        const int row = t >> 3, c8 = (t & 7) * 8;
        if (PASS3) *(u32x4*)&Qs[row * QS + c8] = raw.q[0];
        *(u32x4*)&Ks[row * QS + c8] = raw.k[0];
        *(u32x4*)&AFs[row * 32 + (t & 7) * 4] = raw.af;
    } else {
#pragma unroll
        for (int i = 0; i < 2; ++i) {
            const int row = (t >> 4) + i * 32, c8 = (t & 15) * 8;
            if (PASS3) *(u32x4*)&Qs[row * QS + c8] = raw.q[i];
            *(u32x4*)&Ks[row * QS + c8] = raw.k[i];
        }
    }
#pragma unroll
    for (int i = 0; i < 2; ++i) { const int row = (t >> 4) + i * 32, c8 = (t & 15) * 8; *(u32x4*)&Vraw[row * 136 + c8] = raw.v[i]; }
    lds_sync();
    if (has_next) rec_load_raw<DK, GLA, DIR, PASS3>(p, P, next_row0, h, raw);
    const int cp = t % NCP, seg = t / NCP, c0 = cp * 2, l0 = seg * RS;
    float dv[RS][2];
    float kv[RS][2];
#pragma unroll
    for (int i = 0; i < RS; ++i) {
        const unsigned kr = *(const unsigned*)&Ks[(l0 + i) * QS + c0];
        if (GLA) {
            kv[i][0] = bf2f((bf16_t)(kr & 0xffffu)); kv[i][1] = bf2f((bf16_t)(kr >> 16));
            const float* ar = &AFs[(l0 + i) * 32 + DIR * 16];
            float s0 = abv[0], s1 = abv[1];
#pragma unroll
            for (int r = 0; r < 16; ++r) { const float av = ar[r]; s0 += av * a2c[0][r]; s1 += av * a2c[1][r]; }
            dv[i][0] = logsigmoidf_(s0) * 0.0625f; dv[i][1] = logsigmoidf_(s1) * 0.0625f;
        } else {
            kv[i][0] = h2f((unsigned short)(kr & 0xffffu)); kv[i][1] = h2f((unsigned short)(kr >> 16));
            dv[i][0] = 1.0f - kv[i][0]; dv[i][1] = 1.0f - kv[i][1];
        }
    }
    {
        float s0 = GLA ? 0.f : 1.f, s1 = GLA ? 0.f : 1.f;
#pragma unroll
        for (int i = 0; i < RS; ++i) { if (GLA) { s0 += dv[i][0]; s1 += dv[i][1]; } else { s0 *= dv[i][0]; s1 *= dv[i][1]; } }
        float2 pv; pv.x = s0; pv.y = s1;
        *(float2*)&part[seg * DK + c0] = pv;
    }
    lds_sync();
    float tot[2], base[2], mid[2];
#pragma unroll
    for (int c = 0; c < 2; ++c) { tot[c] = GLA ? 0.f : 1.f; base[c] = tot[c]; mid[c] = tot[c]; }
#pragma unroll
    for (int sg = 0; sg < NSEG; ++sg) {
        const float2 pv = *(const float2*)&part[sg * DK + c0];
        const bool before = (DIR == 0) ? (sg < seg) : (sg > seg);
        const bool firsthalf = (DIR == 0) ? (sg < NSEG / 2) : (sg >= NSEG / 2);
        if (GLA) { tot[0] += pv.x; tot[1] += pv.y; if (before) { base[0] += pv.x; base[1] += pv.y; } if (firsthalf) { mid[0] += pv.x; mid[1] += pv.y; } }
        else { tot[0] *= pv.x; tot[1] *= pv.y; if (before) { base[0] *= pv.x; base[1] *= pv.y; } if (firsthalf) { mid[0] *= pv.x; mid[1] *= pv.y; } }
    }
    float ref[2], iref[2];
#pragma unroll
    for (int c = 0; c < 2; ++c) { ref[c] = ref_end ? tot[c] : mid[c]; iref[c] = GLA ? 0.f : __builtin_amdgcn_rcpf(ref[c]); }
    if (seg == 0) {
#pragma unroll
        for (int c = 0; c < 2; ++c) {
            if (GLA) { emid[c0 + c] = __expf(ref[c]); eend[c0 + c] = __expf(tot[c] - ref[c]); bsum[c] += tot[c]; }
            else { emid[c0 + c] = ref[c]; eend[c0 + c] = tot[c] * iref[c]; bsum[c] += __logf(tot[c]); }
        }
    }
    unsigned short ktv[2][RS];
    float run[2] = {base[0], base[1]};
#pragma unroll
    for (int ii = 0; ii < RS; ++ii) {
        const int i = (DIR == 0) ? ii : (RS - 1 - ii);
        float ek[2], eq[2];
#pragma unroll
        for (int c = 0; c < 2; ++c) {
            if (GLA) { run[c] += dv[i][c]; ek[c] = __expf(ref[c] - run[c]); eq[c] = PASS3 ? __expf(run[c] - ref[c]) : 0.f; }
            else { run[c] *= dv[i][c]; ek[c] = ref[c] * __builtin_amdgcn_rcpf(run[c]); eq[c] = run[c] * iref[c]; }
        }
        const unsigned kp = cvt_pk_bf16(kv[i][0] * ek[0], kv[i][1] * ek[1]);
        ktv[0][i] = (unsigned short)(kp & 0xffffu); ktv[1][i] = (unsigned short)(kp >> 16);
        if (PASS3) {
            const int l = l0 + i;
            *(unsigned*)&Ks[l * QS + c0] = kp;
            const unsigned qr = *(const unsigned*)&Qs[l * QS + c0];
            *(unsigned*)&Qs[l * QS + c0] = cvt_pk_bf16(bf2f((bf16_t)(qr & 0xffffu)) * eq[0], bf2f((bf16_t)(qr >> 16)) * eq[1]);
        }
    }
#pragma unroll
    for (int c = 0; c < 2; ++c) {
        if (RS == 8) {
            u32x4 v;
            v.x = (unsigned)ktv[c][0] | ((unsigned)ktv[c][1] << 16); v.y = (unsigned)ktv[c][2] | ((unsigned)ktv[c][3] << 16);
            v.z = (unsigned)ktv[c][RS > 4 ? 4 : 0] | ((unsigned)ktv[c][RS > 4 ? 5 : 0] << 16); v.w = (unsigned)ktv[c][RS > 4 ? 6 : 0] | ((unsigned)ktv[c][RS > 4 ? 7 : 0] << 16);
            *(u32x4*)&Kt[(c0 + c) * 72 + l0] = v;
        } else {
            u32x2 v;
            v.x = (unsigned)ktv[c][0] | ((unsigned)ktv[c][1] << 16); v.y = (unsigned)ktv[c][2] | ((unsigned)ktv[c][3] << 16);
            *(u32x2*)&Kt[(c0 + c) * 72 + l0] = v;
        }
    }
    {
        const int vp = t & 63, vq = t >> 6;
        unsigned vr[8];
#pragma unroll
        for (int i = 0; i < 8; ++i) vr[i] = *(const unsigned*)&Vraw[(vq * 8 + i) * 136 + 2 * vp];
        u32x4 lo, hi;
        lo.x = (vr[0] & 0xffffu) | (vr[1] << 16); lo.y = (vr[2] & 0xffffu) | (vr[3] << 16); lo.z = (vr[4] & 0xffffu) | (vr[5] << 16); lo.w = (vr[6] & 0xffffu) | (vr[7] << 16);
        hi.x = (vr[0] >> 16) | (vr[1] & 0xffff0000u); hi.y = (vr[2] >> 16) | (vr[3] & 0xffff0000u); hi.z = (vr[4] >> 16) | (vr[5] & 0xffff0000u); hi.w = (vr[6] >> 16) | (vr[7] & 0xffff0000u);
        *(u32x4*)&Vt[(2 * vp) * 72 + vq * 8] = lo;
        *(u32x4*)&Vt[(2 * vp + 1) * 72 + vq * 8] = hi;
    }
    lds_sync();
}

DEVINL bf16x8 ldfrag(const bf16_t* base, int ld, int fr, int fq, int k0) { return *(const bf16x8*)(base + fr * ld + k0 + fq * 8); }

template <int DK, bool GLA, int DIR>
DEVINL void rec_load_a2(const Params& p, int h, float (&a2c)[2][16], float (&abv)[2]) {
#pragma unroll
    for (int c = 0; c < 2; ++c) { abv[c] = 0.f;
#pragma unroll
        for (int r = 0; r < 16; ++r) a2c[c][r] = 0.f; }
    if (GLA) {
        const int c0 = (tid_opaque() % (DK / 2)) * 2;
#pragma unroll
        for (int c = 0; c < 2; ++c) {
#pragma unroll
            for (int r = 0; r < 16; ++r) a2c[c][r] = p.gla_a2[(DIR * 16 + r) * 256 + h * 64 + c0 + c];
            abv[c] = p.gla_ab[DIR * 256 + h * 64 + c0 + c];
        }
    }
}

template <int DK, bool GLA, int DIR>
DEVINL void rec_pass1_unit(const Params& p, char* smem, const bf16_t* P, int b, int h, int cg, float* slots, float* decs) {
    using L = RecL<DK>; using G = RecGeo<DK, GLA>;
    constexpr int KT = G::KT;
    bf16_t* Kt = (bf16_t*)(smem + L::oKt); bf16_t* Vt = (bf16_t*)(smem + L::oVt); float* emid = (float*)(smem + L::oEmid);
    const int t = tid_opaque(), w = t >> 6, lane = t & 63, fr = lane & 15, fq = lane >> 4;
    float a2c[2][16], abv[2];
    rec_load_a2<DK, GLA, DIR>(p, h, a2c, abv);
    f32x4 accS[KT];
#pragma unroll
    for (int kt = 0; kt < KT; ++kt) accS[kt] = (f32x4){0.f, 0.f, 0.f, 0.f};
    float bsum[2] = {0.f, 0.f};
    const int nch = (cg == 0) ? 4 : G::GC;
    auto chunk_row0 = [&](int ci) { const int pc = (cg == 0) ? (DIR == 0 ? ci : 3 - ci) : (DIR == 0 ? (4 + (cg - 1) * G::GC + ci) : (67 - (cg - 1) * G::GC - ci)); return b * RPB + pc * 64; };
    RawRegs raw;
    rec_load_raw<DK, GLA, DIR, false>(p, P, chunk_row0(0), h, raw);
    for (int ci = 0; ci < nch; ++ci) {
        const bool has_next = ci + 1 < nch;
        rec_prep<DK, GLA, DIR, false>(p, smem, P, raw, has_next, has_next ? chunk_row0(ci + 1) : 0, h, a2c, abv, bsum);
        bf16x8 av[2];
#pragma unroll
        for (int ks = 0; ks < 2; ++ks) av[ks] = ldfrag(Vt + (w * 16) * 72, 72, fr, fq, ks * 32);
#pragma unroll
        for (int kt = 0; kt < KT; ++kt) {
            const f32x4 e4 = *(const f32x4*)&emid[kt * 16 + fq * 4];
            f32x4 c = accS[kt] * e4;
#pragma unroll
            for (int ks = 0; ks < 2; ++ks) c = __builtin_amdgcn_mfma_f32_16x16x32_bf16(ldfrag(Kt + (kt * 16) * 72, 72, fr, fq, ks * 32), av[ks], c, 0, 0, 0);
            accS[kt] = c;
        }
        lds_sync();
    }
    const size_t chain = ((size_t)(b * G::H + h) * 2 + DIR);
    float* sl = slots + (chain * G::NS + cg) * (size_t)(128 * DK);
#pragma unroll
    for (int kt = 0; kt < KT; ++kt) *(f32x4*)&sl[(w * 16 + fr) * DK + kt * 16 + fq * 4] = accS[kt];
    if (t < DK / 2) { decs[(chain * G::NS + cg) * DK + 2 * t] = bsum[0]; decs[(chain * G::NS + cg) * DK + 2 * t + 1] = bsum[1]; }
}

template <int DK, bool GLA, int DIR>
DEVINL void rec_pass3_chunk(const Params& p, char* smem, const bf16_t* P, bf16_t* CAT, int row0, int h, f32x4 (&accS)[DK / 16], const float* gnorm) {
    using L = RecL<DK>; using C = RecCols<GLA>;
    constexpr int KT = DK / 16, QS = L::QS, KS = DK / 32;
    bf16_t* Qs = (bf16_t*)(smem + L::oQs); bf16_t* Ks = (bf16_t*)(smem + L::oKs); bf16_t* Kt = (bf16_t*)(smem + L::oKt); bf16_t* Vt = (bf16_t*)(smem + L::oVt);
    bf16_t* At = (bf16_t*)(smem + L::oAt); bf16_t* St = (bf16_t*)(smem + L::oSt);
    float* emid = (float*)(smem + L::oEmid); float* eend = (float*)(smem + L::oEend); float* red = (float*)(smem + L::oRed);
    const int t = tid_opaque(), w = t >> 6, lane = t & 63, fr = lane & 15, fq = lane >> 4;
    u32x2 obv[4], gbv[4];
    if (DIR == 0) {
        const size_t prow = (size_t)(row0 + (w & 3) * 16 + fr);
        const bf16_t* cp0 = CAT + prow * 1024 + h * 128 + (w >> 2) * 64 + fq * 4;
        const bf16_t* gp0 = P + prow * C::LDP + C::GOFF + h * 128 + (w >> 2) * 64 + fq * 4;
#pragma unroll
        for (int n = 0; n < 4; ++n) { obv[n] = *(const u32x2*)(cp0 + n * 16); gbv[n] = *(const u32x2*)(gp0 + n * 16); }
    }
#pragma unroll
    for (int kt = 0; kt < KT; ++kt) {
        const f32x4 e4 = *(const f32x4*)&emid[kt * 16 + fq * 4];
        accS[kt] = accS[kt] * e4;
        *(u32x2*)&St[(w * 16 + fr) * QS + kt * 16 + fq * 4] = pk4(accS[kt]);
    }
    {
        const int lt = w >> 1, st0 = (w & 1) * 2;
        bf16x8 aq[KS];
#pragma unroll
        for (int ks = 0; ks < KS; ++ks) aq[ks] = ldfrag(Qs + (lt * 16) * QS, QS, fr, fq, ks * 32);
#pragma unroll
        for (int s2 = 0; s2 < 2; ++s2) {
            const int st = st0 + s2;
            f32x4 c = (f32x4){0.f, 0.f, 0.f, 0.f};
#pragma unroll
            for (int ks = 0; ks < KS; ++ks) c = __builtin_amdgcn_mfma_f32_16x16x32_bf16(ldfrag(Ks + (st * 16) * QS, QS, fr, fq, ks * 32), aq[ks], c, 0, 0, 0);
            const int l = lt * 16 + fr;
#pragma unroll
            for (int j = 0; j < 4; ++j) { const int sidx = st * 16 + fq * 4 + j; const bool keep = (DIR == 0) ? (sidx <= l) : (sidx >= l); c[j] = keep ? c[j] : 0.f; }
            *(u32x2*)&At[l * 72 + st * 16 + fq * 4] = pk4(c);
        }
    }
    lds_sync();
    const int lt = w & 3, vt0 = (w >> 2) * 4;
    f32x4 o[4];
    {
        bf16x8 aa[2], aq[KS];
#pragma unroll
        for (int ks = 0; ks < 2; ++ks) aa[ks] = ldfrag(At + (lt * 16) * 72, 72, fr, fq, ks * 32);
#pragma unroll
        for (int ks = 0; ks < KS; ++ks) aq[ks] = ldfrag(Qs + (lt * 16) * QS, QS, fr, fq, ks * 32);
#pragma unroll
        for (int n = 0; n < 4; ++n) {
            const int vt = vt0 + n;
            f32x4 c = (f32x4){0.f, 0.f, 0.f, 0.f};
#pragma unroll
            for (int ks = 0; ks < 2; ++ks) c = __builtin_amdgcn_mfma_f32_16x16x32_bf16(ldfrag(Vt + (vt * 16) * 72, 72, fr, fq, ks * 32), aa[ks], c, 0, 0, 0);
#pragma unroll
            for (int ks = 0; ks < KS; ++ks) c = __builtin_amdgcn_mfma_f32_16x16x32_bf16(ldfrag(St + (vt * 16) * QS, QS, fr, fq, ks * 32), aq[ks], c, 0, 0, 0);
            o[n] = c;
        }
    }
    {
        bf16x8 av[2];
#pragma unroll
        for (int ks = 0; ks < 2; ++ks) av[ks] = ldfrag(Vt + (w * 16) * 72, 72, fr, fq, ks * 32);
#pragma unroll
        for (int kt = 0; kt < KT; ++kt) {
            f32x4 c = accS[kt];
#pragma unroll
            for (int ks = 0; ks < 2; ++ks) c = __builtin_amdgcn_mfma_f32_16x16x32_bf16(ldfrag(Kt + (kt * 16) * 72, 72, fr, fq, ks * 32), av[ks], c, 0, 0, 0);
            const f32x4 e4 = *(const f32x4*)&eend[kt * 16 + fq * 4];
            accS[kt] = c * e4;
        }
    }
    const int l = lt * 16 + fr;
    const size_t row = (size_t)(row0 + l);
    bf16_t* cp = CAT + row * 1024 + h * 128 + vt0 * 16 + fq * 4;
    if (DIR == 1) {
#pragma unroll
        for (int n = 0; n < 4; ++n) *(u32x2*)(cp + n * 16) = pk4(o[n]);
    } else {
        float ss = 0.f;
#pragma unroll
        for (int n = 0; n < 4; ++n) {
            const u32x2 ob = obv[n];
            o[n][0] += bf2f((bf16_t)(ob.x & 0xffff)); o[n][1] += bf2f((bf16_t)(ob.x >> 16));
            o[n][2] += bf2f((bf16_t)(ob.y & 0xffff)); o[n][3] += bf2f((bf16_t)(ob.y >> 16));
            ss += o[n][0] * o[n][0] + o[n][1] * o[n][1] + o[n][2] * o[n][2] + o[n][3] * o[n][3];
        }
        ss += __shfl_xor(ss, 16);
        ss += __shfl_xor(ss, 32);
        if (fq == 0) red[l * 2 + (w >> 2)] = ss;
        lds_sync();
        const float tot = red[l * 2] + red[l * 2 + 1];
        const float rstd = rsqrtf(tot * (1.0f / 128.0f) + EPS);
#pragma unroll
        for (int n = 0; n < 4; ++n) {
            const u32x2 gb = gbv[n];
            const f32x4 gn = *(const f32x4*)(gnorm + vt0 * 16 + n * 16 + fq * 4);
            f32x4 gv;
            gv[0] = bf2f((bf16_t)(gb.x & 0xffff)); gv[1] = bf2f((bf16_t)(gb.x >> 16)); gv[2] = bf2f((bf16_t)(gb.y & 0xffff)); gv[3] = bf2f((bf16_t)(gb.y >> 16));
            f32x4 r4;
#pragma unroll
            for (int j = 0; j < 4; ++j) { const float g = GLA ? siluf_(gv[j]) : gv[j]; r4[j] = o[n][j] * rstd * gn[j] * g; }
            *(u32x2*)(cp + n * 16) = pk4(r4);
        }
    }
    lds_sync();
}

template <int DK, bool GLA, int DIR>
DEVINL void rec_pass3_sweep(const Params& p, char* smem, const bf16_t* P, bf16_t* CAT, int b, int h, int c_lo, int nch, int slot, const float* slots, const float* gnorm) {
    using G = RecGeo<DK, GLA>;
    constexpr int KT = G::KT;
    const int t = tid_opaque(), w = t >> 6, lane = t & 63, fr = lane & 15, fq = lane >> 4;
    float a2c[2][16], abv[2];
    rec_load_a2<DK, GLA, DIR>(p, h, a2c, abv);
    f32x4 accS[KT];
    if (slot >= 0) {
        const size_t chain = ((size_t)(b * G::H + h) * 2 + DIR);
        const float* sl = slots + (chain * G::NS + slot) * (size_t)(128 * DK);
#pragma unroll
        for (int kt = 0; kt < KT; ++kt) accS[kt] = *(const f32x4*)&sl[(w * 16 + fr) * DK + kt * 16 + fq * 4];
    } else {
#pragma unroll
        for (int kt = 0; kt < KT; ++kt) accS[kt] = (f32x4){0.f, 0.f, 0.f, 0.f};
    }
    float bsum[2] = {0.f, 0.f};
    float* gn_lds = (float*)(smem + RecL<DK>::oRed + 64 * 2 * 4);
    if (DIR == 0) { if (t < 128) gn_lds[t] = gnorm[t]; }
    auto chunk_row0 = [&](int ci) { const int pc = (DIR == 0) ? (c_lo + ci) : (c_lo + nch - 1 - ci); return b * RPB + pc * 64; };
    RawRegs raw;
    rec_load_raw<DK, GLA, DIR, true>(p, P, chunk_row0(0), h, raw);
    for (int ci = 0; ci < nch; ++ci) {
        const bool has_next = ci + 1 < nch;
        rec_prep<DK, GLA, DIR, true>(p, smem, P, raw, has_next, has_next ? chunk_row0(ci + 1) : 0, h, a2c, abv, bsum);
        rec_pass3_chunk<DK, GLA, DIR>(p, smem, P, CAT, chunk_row0(ci), h, accS, gn_lds);
    }
}

template <int DK, bool GLA>
DEVINL void rec_pass3_unit(const Params& p, char* smem, const bf16_t* P, bf16_t* CAT, int b, int h, int gi, const float* slots, const float* gnorm) {
    using G = RecGeo<DK, GLA>;
    int c_lo, nch, slot_f, slot_b;
    if (GLA) {
        if (gi == 0) { c_lo = 0; nch = 4; slot_f = -1; slot_b = -1; }
        else { const int pg = gi - 1; c_lo = 4 + pg * G::GC; nch = G::GC; slot_f = pg; slot_b = G::NS - 1 - pg; }
    } else { const int pg = gi; c_lo = 4 + pg * G::GC; nch = G::GC; slot_f = pg; slot_b = G::NS - 1 - pg; }
    rec_pass3_sweep<DK, GLA, 1>(p, smem, P, CAT, b, h, c_lo, nch, slot_b, slots, gnorm);
    asm volatile("s_waitcnt vmcnt(0)" ::: "memory");
    rec_pass3_sweep<DK, GLA, 0>(p, smem, P, CAT, b, h, c_lo, nch, slot_f, slots, gnorm);
}

template <int DK, bool GLA>
DEVINL void rec_scan(float* slots, const float* decs, int bid, int nb) {
    using G = RecGeo<DK, GLA>;
    constexpr int NCHAIN = NBATCH * G::H * 2, PER = 128 * DK / 4;
    const int total = NCHAIN * PER;
    for (int i = bid * NTHR + tid_opaque(); i < total; i += nb * NTHR) {
        const int chain = i / PER, e = i - chain * PER;
        const int k4 = (e * 4) % DK;
        f32x4 run = (f32x4){0.f, 0.f, 0.f, 0.f};
#pragma unroll 1
        for (int s0 = 0; s0 < G::NS; s0 += 8) {
            f32x4 a[8], d4[8];
#pragma unroll
            for (int j = 0; j < 8; ++j) {
                d4[j] = *(const f32x4*)&decs[((size_t)chain * G::NS + s0 + j) * DK + k4];
                a[j] = *(const f32x4*)(slots + ((size_t)chain * G::NS + s0 + j) * (size_t)(128 * DK) + (size_t)e * 4);
            }
#pragma unroll
            for (int j = 0; j < 8; ++j) {
#pragma unroll
                for (int q = 0; q < 4; ++q) run[q] = __expf(d4[j][q]) * run[q] + a[j][q];
                *(f32x4*)(slots + ((size_t)chain * G::NS + s0 + j) * (size_t)(128 * DK) + (size_t)e * 4) = run;
            }
        }
    }
}

DEVINL size_t s5_idx(int b, int di, int pc, int g, int pp) { return ((((size_t)(b * 2 + di) * NCH + pc) * 32 + g) * 64 + pp) * 2; }

constexpr int S5_BU_LD = 20;
constexpr int S5_WAVE_LDS = 128 * S5_BU_LD * 4 + 16 * 136 * 2;
static_assert(8 * S5_WAVE_LDS <= LDS_BYTES, "s5 lds");

DEVINL void s5_load_afr(const Params& p, int row0, int g, int fr, int fq, bf16x8 (&afr)[4]) {
    const bf16x8 z = (bf16x8){0, 0, 0, 0, 0, 0, 0, 0};
#pragma unroll
    for (int sb = 0; sb < 4; ++sb) afr[sb] = (fq < 2) ? *(const bf16x8*)(p.P + (size_t)(row0 + sb * 16 + fr) * 2048 + 1536 + g * 16 + fq * 8) : z;
}
DEVINL void s5_load_bfr(const Params& p, int di, int g, int fr, int fq, bf16x8 (&bfr)[8]) {
    const bf16x8 z = (bf16x8){0, 0, 0, 0, 0, 0, 0, 0};
#pragma unroll
    for (int nt = 0; nt < 8; ++nt) bfr[nt] = (fq < 2) ? *(const bf16x8*)(p.bbm + ((size_t)((di * 32 + g) * 128 + nt * 16 + fr)) * 16 + fq * 8) : z;
}
DEVINL void s5_bu_subblock(float* BuT, const bf16x8& a, const bf16x8 (&bfr)[8], int fr, int fq) {
#pragma unroll
    for (int nt = 0; nt < 8; ++nt) {
        f32x4 c = (f32x4){0.f, 0.f, 0.f, 0.f};
        c = __builtin_amdgcn_mfma_f32_16x16x32_bf16(a, bfr[nt], c, 0, 0, 0);
        *(f32x4*)&BuT[(nt * 16 + fr) * S5_BU_LD + fq * 4] = c;
    }
}
template <int DIR, bool XS>
DEVINL void s5_scan16(const float* BuT, bf16_t* Xs, int lane, float are, float aim, float& xr, float& xi) {
    f32x4 br[4], bi[4];
#pragma unroll
    for (int q = 0; q < 4; ++q) { br[q] = *(const f32x4*)&BuT[lane * S5_BU_LD + q * 4]; bi[q] = *(const f32x4*)&BuT[(64 + lane) * S5_BU_LD + q * 4]; }
#pragma unroll
    for (int tt = 0; tt < 16; ++tt) {
        const int tl = DIR ? (15 - tt) : tt;
        const float nr = are * xr - aim * xi + br[tl >> 2][tl & 3], ni = are * xi + aim * xr + bi[tl >> 2][tl & 3];
        xr = nr; xi = ni;
        if (XS) { const unsigned pkd = cvt_pk_bf16(xr, xi); Xs[tl * 136 + lane] = (bf16_t)(pkd & 0xffffu); Xs[tl * 136 + 64 + lane] = (bf16_t)(pkd >> 16); }
    }
}
template <int DIR>
DEVINL void s5_pass1_task(const Params& p, float* BuT, int b, int pc, int g, const bf16x8 (&afr)[4], int lane, int fr, int fq) {
    bf16x8 bfr[8];
    s5_load_bfr(p, DIR, g, fr, fq, bfr);
    const float are = p.atab[((DIR * 32 + g) * 64 + lane) * 2], aim = p.atab[((DIR * 32 + g) * 64 + lane) * 2 + 1];
    float xr = 0.f, xi = 0.f;
#pragma unroll
    for (int sbi = 0; sbi < 4; ++sbi) {
        const int sb = DIR ? (3 - sbi) : sbi;
        s5_bu_subblock(BuT, afr[sb], bfr, fr, fq);
        asm volatile("s_waitcnt lgkmcnt(0)" ::: "memory");
        s5_scan16<DIR, false>(BuT, nullptr, lane, are, aim, xr, xi);
        asm volatile("s_waitcnt lgkmcnt(0)" ::: "memory");
    }
    float* o = p.s5xend + s5_idx(b, DIR, pc, g, lane);
    o[0] = xr; o[1] = xi;
}
DEVINL void s5_pass1_unit(const Params& p, char* smem, int b, int pc, int half) {
    const int t = tid_opaque(), w = t >> 6, lane = t & 63, fr = lane & 15, fq = lane >> 4;
    float* BuT = (float*)(smem + w * S5_WAVE_LDS);
    const int row0 = b * RPB + pc * 64;
#pragma unroll 1
    for (int q = 0; q < 2; ++q) {
        const int g = half * 16 + w * 2 + q;
        bf16x8 afr[4];
        s5_load_afr(p, row0, g, fr, fq, afr);
        s5_pass1_task<0>(p, BuT, b, pc, g, afr, lane, fr, fq);
        s5_pass1_task<1>(p, BuT, b, pc, g, afr, lane, fr, fq);
    }
}
DEVINL void s5_scan(const Params& p, int bid, int nb) {
    for (int i = bid * NTHR + tid_opaque(); i < NBATCH * 2 * 32 * 64; i += nb * NTHR) {
        const int pp = i & 63, g = (i >> 6) & 31, di = (i >> 11) & 1, b = i >> 12;
        const float ar = p.a64tab[((di * 32 + g) * 64 + pp) * 2], ai = p.a64tab[((di * 32 + g) * 64 + pp) * 2 + 1];
        float cr = 0.f, ci = 0.f;
#pragma unroll 1
        for (int c0 = 0; c0 < NCH; c0 += 17) {
            float er[17], ei[17];
#pragma unroll
            for (int j = 0; j < 17; ++j) {
                const int ch = c0 + j, pc = di ? (ch < 4 ? 3 - ch : 71 - ch) : ch;
                const size_t ix = s5_idx(b, di, pc, g, pp);
                er[j] = p.s5xend[ix]; ei[j] = p.s5xend[ix + 1];
            }
#pragma unroll
            for (int j = 0; j < 17; ++j) {
                const int ch = c0 + j, pc = di ? (ch < 4 ? 3 - ch : 71 - ch) : ch;
                const size_t ix = s5_idx(b, di, pc, g, pp);
                p.s5carry[ix] = cr; p.s5carry[ix + 1] = ci;
                const float nr = ar * cr - ai * ci + er[j], ni = ar * ci + ai * cr + ei[j];
                cr = nr; ci = ni;
            }
        }
    }
}
template <int DIR>
DEVINL void s5_pass3_task(const Params& p, float* BuT, bf16_t* Xs, int b, int pc, int g, const bf16x8 (&afr)[4], f32x4 (&acc)[4], int lane, int fr, int fq) {
    bf16x8 bfr[8];
    s5_load_bfr(p, DIR, g, fr, fq, bfr);
    bf16x8 cb[4];
#pragma unroll
    for (int ks = 0; ks < 4; ++ks) cb[ks] = *(const bf16x8*)(p.cmt + ((size_t)(g * 16 + fr)) * 256 + DIR * 128 + ks * 32 + fq * 8);
    const float are = p.atab[((DIR * 32 + g) * 64 + lane) * 2], aim = p.atab[((DIR * 32 + g) * 64 + lane) * 2 + 1];
    const size_t cix = s5_idx(b, DIR, pc, g, lane);
    float xr = p.s5carry[cix], xi = p.s5carry[cix + 1];
#pragma unroll
    for (int sbi = 0; sbi < 4; ++sbi) {
        const int sb = DIR ? (3 - sbi) : sbi;
        s5_bu_subblock(BuT, afr[sb], bfr, fr, fq);
        asm volatile("s_waitcnt lgkmcnt(0)" ::: "memory");
        s5_scan16<DIR, true>(BuT, Xs, lane, are, aim, xr, xi);
        asm volatile("s_waitcnt lgkmcnt(0)" ::: "memory");
        f32x4 c = acc[sb];
#pragma unroll
        for (int ks = 0; ks < 4; ++ks) {
            const bf16x8 a = *(const bf16x8*)(Xs + fr * 136 + ks * 32 + fq * 8);
            c = __builtin_amdgcn_mfma_f32_16x16x32_bf16(cb[ks], a, c, 0, 0, 0);
        }
        acc[sb] = c;
        asm volatile("s_waitcnt lgkmcnt(0)" ::: "memory");
    }
}
DEVINL void s5_pass3_unit(const Params& p, char* smem, int b, int pc, int half) {
    const int t = tid_opaque(), w = t >> 6, lane = t & 63, fr = lane & 15, fq = lane >> 4;
    float* BuT = (float*)(smem + w * S5_WAVE_LDS);
    bf16_t* Xs = (bf16_t*)(smem + w * S5_WAVE_LDS + 128 * S5_BU_LD * 4);
    const int row0 = b * RPB + pc * 64;
#pragma unroll 1
    for (int q = 0; q < 2; ++q) {
        const int g = half * 16 + w * 2 + q;
        bf16x8 afr[4];
        s5_load_afr(p, row0, g, fr, fq, afr);
        f32x4 acc[4];
#pragma unroll
        for (int sb = 0; sb < 4; ++sb) acc[sb] = (f32x4){0.f, 0.f, 0.f, 0.f};
        s5_pass3_task<1>(p, BuT, Xs, b, pc, g, afr, acc, lane, fr, fq);
        s5_pass3_task<0>(p, BuT, Xs, b, pc, g, afr, acc, lane, fr, fq);
        const f32x4 d4 = *(const f32x4*)(p.s5_d + g * 16 + fq * 4);
#pragma unroll
        for (int sb = 0; sb < 4; ++sb) {
            const int tok = sb * 16 + fr;
            const u32x2 ub = *(const u32x2*)(p.P + (size_t)(row0 + tok) * 2048 + 1536 + g * 16 + fq * 4);
            f32x4 uv; uv[0] = bf2f((bf16_t)(ub.x & 0xffff)); uv[1] = bf2f((bf16_t)(ub.x >> 16)); uv[2] = bf2f((bf16_t)(ub.y & 0xffff)); uv[3] = bf2f((bf16_t)(ub.y >> 16));
            f32x4 r4;
#pragma unroll
            for (int j = 0; j < 4; ++j) r4[j] = gelu_tanh(acc[sb][j] + d4[j] * uv[j]);
            *(u32x2*)(p.s5a + (size_t)(row0 + tok) * 512 + g * 16 + fq * 4) = pk4(r4);
        }
    }
}

struct UnitQueue {
    int* counter; int* slot; int total, nb, u, pend;
    DEVINL void init(int* counter_, char* smem, int total_, int bid, int nb_) {
        counter = counter_; slot = (int*)(smem + LDS_BYTES - 64); total = total_; nb = nb_; u = sgpr(bid); pend = 0;
        if (tid_opaque() == 0) pend = atomicAdd(counter, 1) + nb;
    }
    DEVINL bool valid() const { return u < total; }
    DEVINL void advance() {
        if (tid_opaque() == 0) { *slot = pend; pend = atomicAdd(counter, 1) + nb; }
        lds_sync();
        u = sgpr(*slot);
        lds_sync();
    }
};

DEVINL void phase_prologue(const Params& p, char* smem, int bid, int nb) {
    UnitQueue Q; Q.init(p.cnt + 242, smem, T0_END, bid, nb);
    for (; Q.valid(); Q.advance()) prologue_task(p, smem, Q.u);
}

template <int LAYER>
DEVINL void phase_rec1(const Params& p, char* smem, int bid, int nb) {
    if (LAYER == 0) {
        constexpr int NG = 8 * 4 * 2 * 16;
        constexpr int NS5 = NBATCH * NCH * 2;
        UnitQueue Q; Q.init(p.cnt + 240, smem, NG + NS5, bid, nb);
        for (; Q.valid(); Q.advance()) {
            const int u = Q.u;
            if (u < NG) {
                const int cg = u & 15, dir = (u >> 4) & 1, h = (u >> 5) & 3, b = u >> 7;
                if (dir == 0) rec_pass1_unit<64, true, 0>(p, smem, p.P, b, h, cg, p.gslots, p.gdecs);
                else rec_pass1_unit<64, true, 1>(p, smem, p.P, b, h, cg, p.gslots, p.gdecs);
            } else { const int v = u - NG; s5_pass1_unit(p, smem, (v >> 1) / NCH, (v >> 1) % NCH, v & 1); }
        }
    } else {
        constexpr int NG = 8 * 8 * 2 * 8;
        for (int u = bid; u < NG; u += nb) {
            const int cg = u & 7, dir = (u >> 3) & 1, h = (u >> 4) & 7, b = u >> 7;
            if (dir == 0) rec_pass1_unit<128, false, 0>(p, smem, p.P, b, h, cg, p.hslots, p.hdecs);
            else rec_pass1_unit<128, false, 1>(p, smem, p.P, b, h, cg, p.hslots, p.hdecs);
        }
    }
}
template <int LAYER>
DEVINL void phase_scan(const Params& p, char* smem, int bid, int nb) {
    if (LAYER == 0) { rec_scan<64, true>(p.gslots, p.gdecs, bid, nb); s5_scan(p, bid, nb); }
    else rec_scan<128, false>(p.hslots, p.hdecs, bid, nb);
}
template <int LAYER>
DEVINL void phase_rec3(const Params& p, char* smem, int bid, int nb) {
    if (LAYER == 0) {
        constexpr int NG = 8 * 4 * 17;
        constexpr int NS5 = NBATCH * NCH * 2;
        UnitQueue Q; Q.init(p.cnt + 241, smem, NG + NS5, bid, nb);
        for (; Q.valid(); Q.advance()) {
            const int u = Q.u;
            if (u < NG) { const int gi = u % 17, h = (u / 17) & 3, b = u / 68; rec_pass3_unit<64, true>(p, smem, p.P, p.H, b, h, gi, p.gslots, p.gla_norm); }
            else { const int v = u - NG; s5_pass3_unit(p, smem, (v >> 1) / NCH, (v >> 1) % NCH, v & 1); }
        }
    } else {
        constexpr int NG = 8 * 8 * 8;
        for (int u = bid; u < NG; u += nb) { const int gi = u & 7, h = (u >> 3) & 7, b = u >> 6; rec_pass3_unit<128, false>(p, smem, p.P, p.H, b, h, gi, p.hslots, p.hg_norm); }
    }
}

DEVINL void phase_final(const Params& p, int bid, int nb) {
    const int t = tid_opaque(), w = t >> 6, lane = t & 63;
    f32x4 gn[4];
#pragma unroll
    for (int i = 0; i < 4; ++i) gn[i] = *(const f32x4*)(p.final_norm + lane * 4 + i * 256);
    for (int rg = bid; rg < NLAT / 16; rg += nb) {
        f32x4 v[2][4];
#pragma unroll
        for (int rw = 0; rw < 2; ++rw) {
            const float* res = p.out + (size_t)(rg * 16 + w * 2 + rw) * D;
#pragma unroll
            for (int i = 0; i < 4; ++i) v[rw][i] = *(const f32x4*)(res + lane * 4 + i * 256);
        }
#pragma unroll
        for (int rw = 0; rw < 2; ++rw) {
            float* res = p.out + (size_t)(rg * 16 + w * 2 + rw) * D;
            float ss = 0.f;
#pragma unroll
            for (int i = 0; i < 4; ++i) ss += v[rw][i][0] * v[rw][i][0] + v[rw][i][1] * v[rw][i][1] + v[rw][i][2] * v[rw][i][2] + v[rw][i][3] * v[rw][i][3];
#pragma unroll
            for (int o = 32; o >= 1; o >>= 1) ss += __shfl_xor(ss, o);
            const float rstd = rsqrtf(ss * (1.0f / 1024.0f) + EPS);
#pragma unroll
            for (int i = 0; i < 4; ++i) *(f32x4*)(res + lane * 4 + i * 256) = v[rw][i] * rstd * gn[i];
        }
    }
}

constexpr int NPHASE = 23;
constexpr int MEGA_LDS = LDS_BYTES + 16 + 1024;
static_assert(sizeof(Params) <= 1024 && sizeof(Params) % 8 == 0, "params block");
template <int PH>
DEVINL void run_phase(const Params& p, char* smem, int bid, int nb) {
    if (PH == 0) phase_prologue(p, smem, bid, nb);
    if (PH == 1) phase_pre<0>(p, smem, bid, nb);
    if (PH == 2) phase_gemm<0>(p, smem, bid, nb);
    if (PH == 3) phase_rec1<0>(p, smem, bid, nb);
    if (PH == 4) phase_scan<0>(p, smem, bid, nb);
    if (PH == 5) phase_rec3<0>(p, smem, bid, nb);
    if (PH == 6) phase_gemm<1>(p, smem, bid, nb);
    if (PH == 7) phase_gemm<2>(p, smem, bid, nb);
    if (PH == 8) phase_pre<1>(p, smem, bid, nb);
    if (PH == 9) phase_list<0>(p, smem, bid, nb);
    if (PH == 10) phase_moe<0, 1>(p, smem, bid, nb);
    if (PH == 11) phase_moe<0, 2>(p, smem, bid, nb);
    if (PH == 12) phase_pre<2>(p, smem, bid, nb);
    if (PH == 13) phase_gemm<3>(p, smem, bid, nb);
    if (PH == 14) phase_rec1<1>(p, smem, bid, nb);
    if (PH == 15) phase_scan<1>(p, smem, bid, nb);
    if (PH == 16) phase_rec3<1>(p, smem, bid, nb);
    if (PH == 17) phase_gemm<4>(p, smem, bid, nb);
    if (PH == 18) phase_pre<3>(p, smem, bid, nb);
    if (PH == 19) phase_list<1>(p, smem, bid, nb);
    if (PH == 20) phase_moe<1, 1>(p, smem, bid, nb);
    if (PH == 21) phase_moe<1, 2>(p, smem, bid, nb);
    if (PH == 22) phase_final(p, bid, nb);
}

extern __shared__ __attribute__((aligned(16))) char dyn_smem[];

#if ONE_LAUNCH
template <int PH> struct PhaseSeq {
    static DEVINL void run(const Params& p, char* smem, const XcdBarrier& bar) {
        PhaseSeq<PH - 1>::run(p, smem, bar);
        xcd_barrier(bar);
        run_phase<PH>(p, smem, (int)blockIdx.x, (int)gridDim.x);
#ifdef DUP_MASK
        if ((DUP_MASK >> PH) & 1) { xcd_barrier(bar); run_phase<PH>(p, smem, (int)blockIdx.x, (int)gridDim.x); }
#endif
    }
};
template <> struct PhaseSeq<0> {
    static DEVINL void run(const Params& p, char* smem, const XcdBarrier& bar) {
        run_phase<0>(p, smem, (int)blockIdx.x, (int)gridDim.x);
#ifdef DUP_MASK
        if (DUP_MASK & 1) { xcd_barrier(bar); run_phase<0>(p, smem, (int)blockIdx.x, (int)gridDim.x); }
#endif
    }
};
__global__ void __launch_bounds__(NTHR, 2) mega_kernel(Params p) {
    volatile LAS unsigned* st = (volatile LAS unsigned*)(dyn_smem + LDS_BYTES);
    if (threadIdx.x == 0) { st[0] = 0u; st[1] = 0u; st[2] = 0u; st[3] = 0u; }
    __syncthreads();
    XcdBarrier bar = xcd_barrier_post(p.bar, st);
    PhaseSeq<NPHASE - 1>::run(p, dyn_smem, bar);
}
#else
template <int PH>
__global__ void __launch_bounds__(NTHR, 2) phase_kernel(Params p) {
    run_phase<PH>(p, dyn_smem, (int)blockIdx.x, (int)gridDim.x);
}
template <int PH> struct Launcher {
    static void go(const Params& p, int grid, hipStream_t s) {
        Launcher<PH - 1>::go(p, grid, s);
        static bool attr = false;
        if (!attr) { hipFuncSetAttribute((const void*)phase_kernel<PH>, hipFuncAttributeMaxDynamicSharedMemorySize, LDS_BYTES + 16); attr = true; }
        phase_kernel<PH><<<grid, NTHR, LDS_BYTES + 16, s>>>(p);
    }
};
template <> struct Launcher<-1> { static void go(const Params&, int, hipStream_t) {} };
#endif

static size_t align_up(size_t v, size_t a) { return (v + a - 1) / a * a; }

extern "C" void kernel_launch(void* const* d_in, const int* in_sizes, int n_in, void* d_out, int out_size, void* d_ws, size_t ws_size, hipStream_t stream) {
    (void)in_sizes; (void)n_in; (void)out_size;
    Params p;
    memset(&p, 0, sizeof(p));
    const float* const* in = (const float* const*)d_in;
    p.x = in[0]; p.c = in[1]; p.ctx = in[2]; p.c_ctx = in[3]; p.ada_w = in[4]; p.ada_b = in[5]; p.norm_mix = in[6]; p.norm_ffn = in[7];
    p.ab_w_in = in[8]; p.ab_w_out = in[9]; p.gla_a2 = in[10]; p.gla_ab = in[11]; p.gla_norm = in[12];
    p.s5_lam_re = in[13]; p.s5_lam_im = in[14]; p.s5_log_dt = in[15]; p.s5_b_re = in[16]; p.s5_b_im = in[17]; p.s5_c_re = in[18]; p.s5_c_im = in[19];
    p.s5_d = in[20]; p.glu_w = in[21]; p.glu_b = in[22]; p.hg_w_in = in[23]; p.hg_w_out = in[24]; p.hg_lb = in[25]; p.hg_norm = in[26];
    p.router_w = in[27]; p.router_bias = in[28]; p.moe_wg = in[29]; p.moe_wu = in[30]; p.moe_wd = in[31]; p.final_norm = in[32];
    p.out = (float*)d_out;

    char* ws = (char*)d_ws;
    size_t o = 0;
    auto take = [&](size_t bytes) { char* r = ws + o; o = align_up(o + bytes, 256); return r; };
    p.bar = (unsigned*)take(XCD_BAR_WORDS * 4);
    p.cnt = (int*)take(256 * 4);
    p.mod = (float*)take((size_t)2 * 9 * 6144 * 4);
    p.pos = (float*)take(64 * 512 * 4);
    p.lb = (float*)take(1024 * 4);
    p.atab = (float*)take(2 * 32 * 64 * 2 * 4);
    p.a64tab = (float*)take(2 * 32 * 64 * 2 * 4);
    p.cmt = (bf16_t*)take((size_t)32 * 16 * 256 * 2);
    p.bbm = (bf16_t*)take((size_t)2 * 32 * 128 * 16 * 2);
    p.wrt = (bf16_t*)take((size_t)2 * 2 * 32 * 1024 * 2);
    p.RT = (float4*)take((size_t)R * 16);
    p.list = (int*)take((size_t)ACT_ROWS * 4);
    p.wl = (float*)take((size_t)ACT_ROWS * 4);
    p.wh = (float*)take((size_t)ACT_ROWS * 4);
    p.cx = (float*)take((size_t)NBATCH * CTXL * D * 4);
    p.sor = (int*)take((size_t)R * 4);
    p.blkcnt = (int*)take((size_t)2 * 256 * 48 * 4);
    p.wt_in0 = (bf16_t*)take((size_t)2048 * 1024 * 2);
    p.wt_out0 = (bf16_t*)take((size_t)1024 * 1024 * 2);
    p.glu_t = (bf16_t*)take((size_t)512 * 512 * 2);
    p.wt_in1 = (bf16_t*)take((size_t)5120 * 1024 * 2);
    p.wt_out1 = (bf16_t*)take((size_t)1024 * 1024 * 2);
    p.H = (bf16_t*)take((size_t)R * 1024 * 2);
    const size_t big = o;
    p.P = (bf16_t*)(ws + big);
    size_t o0 = big + (size_t)R * 2048 * 2;
    auto take0 = [&](size_t bytes) { char* r = ws + o0; o0 = align_up(o0 + bytes, 256); return r; };
    p.gslots = (float*)take0((size_t)64 * 16 * 128 * 64 * 4);
    p.gdecs = (float*)take0((size_t)64 * 16 * 64 * 4);
    p.s5xend = (float*)take0((size_t)NBATCH * 2 * NCH * 32 * 64 * 2 * 4);
    p.s5carry = (float*)take0((size_t)NBATCH * 2 * NCH * 32 * 64 * 2 * 4);
    p.s5a = (bf16_t*)take0((size_t)R * 512 * 2);
    p.AF = (float*)take0((size_t)R * 32 * 4);
    p.wgu_t = (bf16_t*)take0((size_t)32 * 512 * 1024 * 2);
    p.wd_t = (bf16_t*)take0((size_t)32 * 1024 * 256 * 2);
    p.hs = (bf16_t*)(ws + big);
    p.act = (bf16_t*)(ws + big + (size_t)ACT_ROWS * 1024 * 2);
    if (big + (size_t)ACT_ROWS * 1024 * 2 + (size_t)ACT_ROWS * 512 * 2 > (size_t)((char*)p.s5a - ws)) fprintf(stderr, "moe overlay overlaps live buffers\n");
    size_t o1 = big + (size_t)R * 5120 * 2;
    auto take1 = [&](size_t bytes) { char* r = ws + o1; o1 = align_up(o1 + bytes, 256); return r; };
    p.hslots = (float*)take1((size_t)128 * 8 * 128 * 128 * 4);
    p.hdecs = (float*)take1((size_t)128 * 8 * 128 * 4);
    const size_t need = o0 > o1 ? o0 : o1;
    if (need > ws_size) fprintf(stderr, "workspace too small: need %zu have %zu\n", need, ws_size);

    const int grid = 256;
#if ONE_LAUNCH
    static bool attr = false;
    if (!attr) { hipFuncSetAttribute((const void*)mega_kernel, hipFuncAttributeMaxDynamicSharedMemorySize, MEGA_LDS); attr = true; }
    hipMemsetAsync(p.bar, 0, XCD_BAR_WORDS * 4 + 256 * 4, stream);
    mega_kernel<<<grid, NTHR, MEGA_LDS, stream>>>(p);
#else
    Launcher<NPHASE - 1>::go(p, grid, stream);
#endif
}
```

```cpp
#include <hip/hip_runtime.h>
#include <stdint.h>
#include <string.h>
#include <stdio.h>

#ifndef ONE_LAUNCH
#define ONE_LAUNCH 1
#endif

typedef unsigned short bf16_t;
typedef short bf16x8 __attribute__((ext_vector_type(8)));
typedef float f32x4 __attribute__((ext_vector_type(4)));
typedef unsigned u32x4 __attribute__((ext_vector_type(4)));
typedef unsigned u32x2 __attribute__((ext_vector_type(2)));
#define DEVINL __device__ __forceinline__

constexpr int D = 1024, NBATCH = 8, SEQ = 4096, CTXL = 256;
constexpr int RPB = SEQ + CTXL;
constexpr int R = NBATCH * RPB;
constexpr int NLAT = NBATCH * SEQ;
constexpr int NCH = RPB / 64;
constexpr float EPS = 1e-6f;
constexpr int NTHR = 512;
constexpr int LDS_BYTES = 136 * 1024;
constexpr int ACT_ROWS = 47104;

#define XB_TMO      128
#define XB_XCNT(j)  (256  + 64 * (j))
#define XB_XSUB(j)  (1280 + 64 * (j))
#define XB_XGEN(j)  (2304 + 64 * (j))
#define XB_TOP      3328
#define XB_TOPGEN   3392
#define XCD_BAR_WORDS 3456
#define XB_SPIN_CAP (1u << 18)
#define LAS __attribute__((address_space(3)))

__device__ __forceinline__ unsigned xb_ld(unsigned* p)              { return __hip_atomic_load(p, __ATOMIC_RELAXED, __HIP_MEMORY_SCOPE_AGENT); }
__device__ __forceinline__ unsigned xb_add(unsigned* p, unsigned v) { return __hip_atomic_fetch_add(p, v, __ATOMIC_RELAXED, __HIP_MEMORY_SCOPE_AGENT); }
__device__ __forceinline__ unsigned xb_xcc_id() { return (unsigned)__builtin_amdgcn_s_getreg((3 << 11) | 20) & 0xFu; }
#define XB_SPIN(cond, bar) do { unsigned _sp = 0; while (cond) { __builtin_amdgcn_s_sleep(1); \
    if ((++_sp & 255u) == 0u) { if (xb_ld(&(bar)[XB_TMO])) break; if (_sp > XB_SPIN_CAP) { atomicAdd(&(bar)[XB_TMO], 1u); break; } } } } while (0)

struct XcdBarrier {
    unsigned* bar; unsigned x;
    volatile LAS unsigned* st;
};
__device__ __forceinline__ XcdBarrier xcd_barrier_post(unsigned* bar, volatile LAS unsigned* st) {
    XcdBarrier b; b.bar = bar; b.x = xb_xcc_id(); b.st = st;
    if (threadIdx.x == 0) (void)xb_add(&bar[XB_XCNT(b.x)], 1u);
    return b;
}
__device__ __forceinline__ void xcd_barrier_complete(unsigned* bar, unsigned x, unsigned& nloc, unsigned& nx) {
    const unsigned G = gridDim.x * gridDim.y * gridDim.z;
    unsigned sum, cnt, mine, sp = 0u;
    for (;;) {
        sum = 0u; cnt = 0u; mine = 0u;
#pragma unroll
        for (unsigned j = 0; j < 16; ++j) { const unsigned c = xb_ld(&bar[XB_XCNT(j)]); sum += c; cnt += (c > 0u) ? 1u : 0u; mine = (j == x) ? c : mine; }
        if (sum == G) break;
        __builtin_amdgcn_s_sleep(1);
        if ((++sp & 255u) == 0u) { if (xb_ld(&bar[XB_TMO])) break; if (sp > XB_SPIN_CAP) { atomicAdd(&bar[XB_TMO], 1u); break; } }
    }
    nloc = mine > 0u ? mine : 1u; nx = cnt > 0u ? cnt : 1u;
}
__device__ __forceinline__ void xcd_barrier(const XcdBarrier& b) {
    asm volatile("s_waitcnt vmcnt(0)" ::: "memory");
    __syncthreads();
    if (threadIdx.x == 0) {
        unsigned* bar = b.bar;
        __builtin_amdgcn_s_waitcnt(0);
        unsigned nloc = b.st[0], nx = b.st[1];
        if (nloc == 0u) { xcd_barrier_complete(bar, b.x, nloc, nx); b.st[0] = nloc; b.st[1] = nx; }
        const unsigned old = xb_add(&bar[XB_XSUB(b.x)], 1u);
        const unsigned gen = old / nloc;
        if (old + 1u == (gen + 1u) * nloc) {
            __builtin_amdgcn_fence(__ATOMIC_RELEASE, "agent");
            asm volatile("s_waitcnt vmcnt(0)" ::: "memory");
            const unsigned og = xb_add(&bar[XB_TOP], 1u);
            const unsigned tg = og / nx;
            if (og + 1u == (tg + 1u) * nx) xb_add(&bar[XB_TOPGEN], 1u);
            else XB_SPIN(xb_ld(&bar[XB_TOPGEN]) == tg, bar);
            __builtin_amdgcn_fence(__ATOMIC_ACQUIRE, "agent");
            xb_add(&bar[XB_XGEN(b.x)], 1u);
            asm volatile("s_waitcnt vmcnt(0)" ::: "memory");
        } else {
            XB_SPIN(xb_ld(&bar[XB_XGEN(b.x)]) == gen, bar);
            __builtin_amdgcn_fence(__ATOMIC_ACQUIRE, "agent");
            asm volatile("s_waitcnt vmcnt(0)" ::: "memory");
        }
    }
    __syncthreads();
}

struct Params {
    const float *x, *c, *ctx, *c_ctx, *ada_w, *ada_b, *norm_mix, *norm_ffn, *ab_w_in, *ab_w_out, *gla_a2, *gla_ab, *gla_norm;
    const float *s5_lam_re, *s5_lam_im, *s5_log_dt, *s5_b_re, *s5_b_im, *s5_c_re, *s5_c_im, *s5_d, *glu_w, *glu_b;
    const float *hg_w_in, *hg_w_out, *hg_lb, *hg_norm, *router_w, *router_bias, *moe_wg, *moe_wu, *moe_wd, *final_norm;
    float* out;
    unsigned* bar;
    int* cnt;
    float *mod, *pos, *lb, *atab, *a64tab;
    bf16_t* cmt; bf16_t* bbm; bf16_t* wrt;
    float4* RT;
    int* list; float *wl, *wh;
    float* cx;
    bf16_t* Y; bf16_t* y2;
    int* sor; int* blkcnt;
    bf16_t *wt_in0, *wt_out0, *glu_t, *wt_in1, *wt_out1;
    bf16_t* H;
    bf16_t* P;
    float *gslots, *gdecs;
    float *s5xend, *s5carry;
    bf16_t* s5a;
    bf16_t *wgu_t, *wd_t, *act, *hs;
    float* AF;
    float *hslots, *hdecs;
};

DEVINL int tid_opaque() { int t = threadIdx.x; asm volatile("" : "+v"(t)); return t; }
DEVINL void lds_sync() { asm volatile("s_waitcnt lgkmcnt(0)" ::: "memory"); __builtin_amdgcn_s_barrier(); asm volatile("" ::: "memory"); }

DEVINL int sgpr(int v) { return __builtin_amdgcn_readfirstlane(v); }
template <class T> DEVINL T* sgpr_ptr(T* ptr) {
    const unsigned long long v = (unsigned long long)ptr;
    const unsigned lo = (unsigned)__builtin_amdgcn_readfirstlane((int)(unsigned)v), hi = (unsigned)__builtin_amdgcn_readfirstlane((int)(unsigned)(v >> 32));
    return (T*)(__attribute__((address_space(1))) T*)(((unsigned long long)hi << 32) | lo);
}
DEVINL unsigned cvt_pk_bf16(float lo, float hi) { unsigned r; asm volatile("v_cvt_pk_bf16_f32 %0, %1, %2" : "=v"(r) : "v"(lo), "v"(hi)); return r; }
DEVINL float bf2f(bf16_t v) { return __uint_as_float(((unsigned)v) << 16); }
DEVINL bf16_t f2bf(float f) { unsigned u = __float_as_uint(f); u += 0x7fffu + ((u >> 16) & 1u); return (bf16_t)(u >> 16); }
DEVINL unsigned pk2(float lo, float hi) { return cvt_pk_bf16(lo, hi); }
DEVINL u32x2 pk4(f32x4 v) { u32x2 r; r.x = pk2(v[0], v[1]); r.y = pk2(v[2], v[3]); return r; }
DEVINL float h2f(unsigned short v) { return (float)__builtin_bit_cast(_Float16, v); }
DEVINL unsigned short f2h(float f) { return __builtin_bit_cast(unsigned short, (_Float16)f); }
DEVINL float sigmoidf_(float x) { return __builtin_amdgcn_rcpf(1.0f + __expf(-x)); }
DEVINL float siluf_(float x) { return x * sigmoidf_(x); }
DEVINL float logsigmoidf_(float x) { return fminf(x, 0.0f) - __logf(1.0f + __expf(-fabsf(x))); }
DEVINL float gelu_tanh(float y) { float z = 0.7978845608028654f * (y + 0.044715f * y * y * y); float th = 1.0f - 2.0f * __builtin_amdgcn_rcpf(__expf(2.0f * z) + 1.0f); return 0.5f * y * (1.0f + th); }
DEVINL float* resid_row(const Params& p, int r) {
    const int b = r / RPB, j = r - b * RPB;
    return (j < CTXL) ? (p.cx + (size_t)(b * CTXL + j) * D) : (p.out + (size_t)(b * SEQ + (j - CTXL)) * D);
}
DEVINL int row_batch_mod(int r) { const int b = r / RPB, j = r - b * RPB; return (j < CTXL) ? 8 : b; }

template <int K>
DEVINL f32x4 mma_lds(f32x4 c, const bf16_t* A, int lda, const bf16_t* Bt, int ldb, int fr, int fq) {
#pragma unroll
    for (int k0 = 0; k0 < K; k0 += 32) {
        const bf16x8 a = *(const bf16x8*)(A + fr * lda + k0 + fq * 8);
        const bf16x8 b = *(const bf16x8*)(Bt + fr * ldb + k0 + fq * 8);
        c = __builtin_amdgcn_mfma_f32_16x16x32_bf16(b, a, c, 0, 0, 0);
    }
    return c;
}

DEVINL void cvt_tile(const float* colp, int ld, int k0, int n0, bf16_t* dst, int ldd, char* smem, int lrow = -1) {
    float (*T)[257] = (float (*)[257])smem;
    const int t = tid_opaque(), nl = lrow >= 0 ? lrow : (t & 63), ks = t >> 6;
    const float* sp = colp + (size_t)(k0 + ks * 32) * ld;
#pragma unroll
    for (int i0 = 0; i0 < 32; i0 += 16) {
        float v[16];
#pragma unroll
        for (int i = 0; i < 16; ++i) v[i] = sp[(size_t)(i0 + i) * ld];
#pragma unroll
        for (int i = 0; i < 16; ++i) T[nl][ks * 32 + i0 + i] = v[i];
    }
    __syncthreads();
    const int n2 = t >> 3, kc = t & 7;
#pragma unroll
    for (int j = 0; j < 4; ++j) {
        const int k = j * 64 + kc * 8;
        u32x4 v;
        v.x = pk2(T[n2][k + 0], T[n2][k + 1]); v.y = pk2(T[n2][k + 2], T[n2][k + 3]);
        v.z = pk2(T[n2][k + 4], T[n2][k + 5]); v.w = pk2(T[n2][k + 6], T[n2][k + 7]);
        *(u32x4*)(dst + (size_t)(n0 + n2) * ldd + k0 + k) = v;
    }
    __syncthreads();
}

constexpr int NT_GU = 1024, NT_WD = 512;
DEVINL void moe_cvt_task(const Params& p, int layer, int tid, char* smem) {
    if (tid < NT_GU) {
        const int e = tid >> 5, rem = tid & 31, nb = rem >> 2, kb = rem & 3;
        const float* wg = p.moe_wg + (size_t)(layer * 32 + e) * 1024 * 256;
        const float* wu = p.moe_wu + (size_t)(layer * 32 + e) * 1024 * 256;
        const int nl = tid_opaque() & 63, isup = nl >> 5, ul = nl & 31;
        const int ub = (nb >> 2) * 128 + (nb & 3) * 32;
        const float* cp = (isup ? wu : wg) + ub + ul;
        const int lrow = (ul >> 2) * 8 + isup * 4 + (ul & 3);
        cvt_tile(cp, 256, kb * 256, nb * 64, p.wgu_t + (size_t)e * 512 * 1024, 1024, smem, lrow);
    } else {
        const int t2 = tid - NT_GU, e = t2 >> 4, nb = t2 & 15;
        const float* wd = p.moe_wd + (size_t)(layer * 32 + e) * 256 * 1024;
        cvt_tile(wd + nb * 64 + (tid_opaque() & 63), 1024, 0, nb * 64, p.wd_t + (size_t)e * 1024 * 256, 256, smem);
    }
}

constexpr int NT_MISC = 9, NT_MOD = 192, NT_IN0 = 128, NT_OUT0 = 64, NT_GLU = 16, NT_IN1 = 320, NT_OUT1 = 64, NT_POS = 64, NT_S5 = 64;
constexpr int T0_MOD = NT_MISC, T0_IN0 = T0_MOD + NT_MOD, T0_OUT0 = T0_IN0 + NT_IN0, T0_GLU = T0_OUT0 + NT_OUT0, T0_IN1 = T0_GLU + NT_GLU, T0_OUT1 = T0_IN1 + NT_IN1,
              T0_MOE = T0_OUT1 + NT_OUT1, T0_POS = T0_MOE + NT_GU + NT_WD, T0_S5 = T0_POS + NT_POS, T0_END = T0_S5 + NT_S5;

DEVINL void prologue_task(const Params& p, char* smem, int task) {
    const int t = tid_opaque();
    {
        if (task < T0_MOD) {
            if (task == 0) {
                for (int i = t; i < 1024; i += NTHR) p.lb[i] = sigmoidf_(p.hg_lb[1024 + i] - p.hg_lb[i]);
            } else {
                for (int i = (task - 1) * 8192 + t; i < task * 8192; i += NTHR) {
                    const int which = i >> 15, e = (i >> 10) & 31, k = i & 1023;
                    const float v = which ? p.ab_w_in[(size_t)k * 2080 + 1536 + e] : p.router_w[k * 32 + e];
                    const bf16_t hi = f2bf(v); const bf16_t lo = f2bf(v - bf2f(hi));
                    p.wrt[((size_t)(which * 2 + 0) * 32 + e) * 1024 + k] = hi;
                    p.wrt[((size_t)(which * 2 + 1) * 32 + e) * 1024 + k] = lo;
                }
            }
        } else if (task < T0_IN0) {
            float* sc = (float*)smem;
            float* red = sc + 9 * 1024;
            for (int i = t; i < 9 * 1024; i += NTHR) { const int rr = i >> 10, k = i & 1023; const float v = rr < 8 ? p.c[rr * 1024 + k] : p.c_ctx[k]; sc[i] = siluf_(v); }
            __syncthreads();
            const int tk = task - T0_MOD, l = tk / 96, c0 = (tk % 96) * 64, col = t & 63, kp = t >> 6;
            const float* wp = p.ada_w + ((size_t)l * 1024 + kp * 128) * 6144 + c0 + col;
            float acc[9];
#pragma unroll
            for (int rr = 0; rr < 9; ++rr) acc[rr] = 0.f;
#pragma unroll 1
            for (int k = 0; k < 128; k += 16) {
                float w16[16];
#pragma unroll
                for (int j = 0; j < 16; ++j) w16[j] = wp[(size_t)(k + j) * 6144];
#pragma unroll
                for (int rr = 0; rr < 9; ++rr) {
#pragma unroll
                    for (int j = 0; j < 16; j += 4) {
                        const f32x4 s4 = *(const f32x4*)&sc[rr * 1024 + kp * 128 + k + j];
                        acc[rr] += s4[0] * w16[j] + s4[1] * w16[j + 1] + s4[2] * w16[j + 2] + s4[3] * w16[j + 3];
                    }
                }
            }
#pragma unroll
            for (int rr = 0; rr < 9; ++rr) red[(kp * 9 + rr) * 64 + col] = acc[rr];
            __syncthreads();
            for (int o = t; o < 576; o += NTHR) {
                const int rr = o >> 6, cc = o & 63;
                float sv = p.ada_b[l * 6144 + c0 + cc];
#pragma unroll
                for (int q = 0; q < 8; ++q) sv += red[(q * 9 + rr) * 64 + cc];
                p.mod[((size_t)l * 9 + rr) * 6144 + c0 + cc] = sv;
            }
            __syncthreads();
        } else if (task < T0_OUT0) {
            const int tt = task - T0_IN0, nbk = tt >> 2, kb = tt & 3;
            const int n = nbk * 64 + (t & 63);
            const float* cp = p.ab_w_in + (n < 1536 ? n : n + 32);
            cvt_tile(cp, 2080, kb * 256, nbk * 64, p.wt_in0, 1024, smem);
        } else if (task < T0_GLU) {
            const int tt = task - T0_OUT0, nbk = tt >> 2, kb = tt & 3;
            cvt_tile(p.ab_w_out + nbk * 64 + (t & 63), 1024, kb * 256, nbk * 64, p.wt_out0, 1024, smem);
        } else if (task < T0_IN1) {
            const int tt = task - T0_GLU, nbk = tt >> 1, kb = tt & 1;
            cvt_tile(p.glu_w + nbk * 64 + (t & 63), 512, kb * 256, nbk * 64, p.glu_t, 512, smem);
        } else if (task < T0_OUT1) {
            const int tt = task - T0_IN1, nbk = tt >> 2, kb = tt & 3;
            cvt_tile(p.hg_w_in + nbk * 64 + (t & 63), 5120, kb * 256, nbk * 64, p.wt_in1, 1024, smem);
        } else if (task < T0_MOE) {
            const int tt = task - T0_OUT1, nbk = tt >> 2, kb = tt & 3;
            cvt_tile(p.hg_w_out + nbk * 64 + (t & 63), 1024, kb * 256, nbk * 64, p.wt_out1, 1024, smem);
        } else if (task < T0_POS) {
            moe_cvt_task(p, 0, task - T0_MOE, smem);
        } else if (task < T0_S5) {
            const int pi = task - T0_POS;
            const int j = t, jj = j & 255;
            const float omega = __expf(-9.210340371976184f * (float)jj * (1.0f / 256.0f));
            const float ang = (float)pi * omega;
            p.pos[pi * 512 + j] = (j < 256) ? sinf(ang) : cosf(ang);
        } else {
            const int tt = task - T0_S5, di = tt >> 5, g = tt & 31;
            const int pp = t & 63, hs = t >> 6;
            const float dt = __expf(p.s5_log_dt[di * 32 + g]);
            const float lr = p.s5_lam_re[(di * 32 + g) * 64 + pp], li = p.s5_lam_im[(di * 32 + g) * 64 + pp];
            const float mag = __expf(lr * dt);
            const float are = mag * cosf(li * dt), aim = mag * sinf(li * dt);
            const float den = lr * lr + li * li;
            const float fre = ((are - 1.0f) * lr + aim * li) / den;
            const float fim = (aim * lr - (are - 1.0f) * li) / den;
            if (hs == 0) {
                p.atab[((di * 32 + g) * 64 + pp) * 2 + 0] = are; p.atab[((di * 32 + g) * 64 + pp) * 2 + 1] = aim;
                float xr = are, xi = aim;
#pragma unroll
                for (int q = 0; q < 6; ++q) { const float nr = xr * xr - xi * xi, ni = 2.0f * xr * xi; xr = nr; xi = ni; }
                p.a64tab[((di * 32 + g) * 64 + pp) * 2 + 0] = xr; p.a64tab[((di * 32 + g) * 64 + pp) * 2 + 1] = xi;
            }
#pragma unroll
            for (int q = 0; q < 2; ++q) {
                const int h = hs * 2 + q;
                const float bre = p.s5_b_re[((size_t)((di * 32 + g) * 64 + pp)) * 16 + h], bim = p.s5_b_im[((size_t)((di * 32 + g) * 64 + pp)) * 16 + h];
                p.bbm[((size_t)((di * 32 + g) * 128 + pp)) * 16 + h] = f2bf(fre * bre - fim * bim);
                p.bbm[((size_t)((di * 32 + g) * 128 + 64 + pp)) * 16 + h] = f2bf(fre * bim + fim * bre);
                const float cre = p.s5_c_re[((size_t)((di * 32 + g) * 16 + h)) * 64 + pp], cim = p.s5_c_im[((size_t)((di * 32 + g) * 16 + h)) * 64 + pp];
                bf16_t* cm = p.cmt + ((size_t)(g * 16 + h)) * 256 + di * 128;
                cm[pp] = f2bf(cre); cm[64 + pp] = f2bf(-cim);
            }
        }
    }
}

constexpr int PRE_LD = 1028;
template <int MODE>
DEVINL void phase_pre(const Params& p, char* smem, int bid, int nb) {
    constexpr bool GEMV = (MODE == 0 || MODE == 1 || MODE == 3);
    constexpr int L = (MODE >= 2) ? 1 : 0;
    constexpr bool FFN = (MODE == 1 || MODE == 3);
    float* hrow = (float*)smem;
    float* part = hrow + 16 * PRE_LD;
    float* logit = part + 8 * 16 * 32;
    int* lcnt = (int*)(logit + 512);
    static_assert((16 * PRE_LD + 8 * 16 * 32 + 512 + 64) * 4 <= LDS_BYTES, "pre lds");
    const int t = tid_opaque(), w = t >> 6, lane = t & 63, fr = lane & 15, fq = lane >> 4;
    bf16x8 bh[4][2], bl[4][2];
    if (GEMV) {
        const bf16_t* wt = p.wrt + (size_t)(MODE == 0 ? 1 : 0) * 2 * 32 * 1024;
#pragma unroll
        for (int ks = 0; ks < 4; ++ks)
#pragma unroll
            for (int nt = 0; nt < 2; ++nt) {
                const size_t off = (size_t)(nt * 16 + fr) * 1024 + w * 128 + ks * 32 + fq * 8;
                bh[ks][nt] = *(const bf16x8*)(wt + off);
                bl[ks][nt] = *(const bf16x8*)(wt + 32 * 1024 + off);
            }
    }
    if (FFN) { if (t < 64) lcnt[t] = 0; }
    __syncthreads();
    const float* gain = (FFN ? p.norm_ffn : p.norm_mix) + L * 1024;
    const int ngroups = (MODE == 3) ? (NLAT / 16) : (R / 16);
    constexpr bool UPD_ROW = (MODE == 1 || MODE == 3);
    constexpr bool UPD_SLOT = (MODE == 2);
    auto row_of = [&](int rg, int rw) { const int i = rg * 16 + w * 2 + rw; return (MODE == 3) ? ((i >> 12) * RPB + CTXL + (i & 4095)) : i; };
    auto load_rows = [&](int rg, f32x4 (&vv)[2][4], u32x2 (&uu)[2][4], int (&ss)[2]) {
#pragma unroll
        for (int rw = 0; rw < 2; ++rw) {
            const int r = row_of(rg, rw);
            const int b = r / RPB, j = r - b * RPB;
            const bool isctx = j < CTXL;
            const float* src;
            if (MODE == 0) src = isctx ? (p.ctx + (size_t)(b * CTXL + j) * D) : (p.x + (size_t)(b * SEQ + (j - CTXL)) * D);
            else src = isctx ? (p.cx + (size_t)(b * CTXL + j) * D) : (p.out + (size_t)(b * SEQ + (j - CTXL)) * D);
#pragma unroll
            for (int i = 0; i < 4; ++i) vv[rw][i] = *(const f32x4*)(src + lane * 4 + i * 256);
            if (UPD_ROW) {
#pragma unroll
                for (int i = 0; i < 4; ++i) uu[rw][i] = *(const u32x2*)(p.Y + (size_t)r * D + lane * 4 + i * 256);
            }
            if (UPD_SLOT) ss[rw] = p.sor[r];

        }
    };
    f32x4 g4[4];
#pragma unroll
    for (int i = 0; i < 4; ++i) g4[i] = *(const f32x4*)(gain + lane * 4 + i * 256);
    for (int rg = bid; rg < ngroups; rg += nb) {
        f32x4 vcur[2][4]; u32x2 ucur[2][4]; int scur[2] = {0, 0};
        load_rows(rg, vcur, ucur, scur);
        if (UPD_SLOT) {
#pragma unroll
            for (int rw = 0; rw < 2; ++rw)
#pragma unroll
                for (int i = 0; i < 4; ++i) ucur[rw][i] = *(const u32x2*)(p.y2 + (size_t)scur[rw] * D + lane * 4 + i * 256);
        }
        f32x4 sh4[4], sc4[4], gu4[4], pe[2][4];
        {
            const int r0 = row_of(rg, 0);
            const int b0 = r0 / RPB, j0 = r0 - b0 * RPB;
            const int mb = (j0 < CTXL) ? 8 : b0;
            const float* modv = p.mod + ((size_t)(L * 9 + mb)) * 6144 + (FFN ? 3072 : 0);
            const float* gatev = p.mod + ((size_t)((MODE == 3 ? 1 : 0) * 9 + mb)) * 6144 + (MODE == 2 ? 5120 : 2048);
#pragma unroll
            for (int i = 0; i < 4; ++i) {
                const int c = lane * 4 + i * 256;
                sh4[i] = *(const f32x4*)(modv + c); sc4[i] = *(const f32x4*)(modv + 1024 + c);
                if (MODE != 0) gu4[i] = *(const f32x4*)(gatev + c);
            }
            if (MODE == 0) {
#pragma unroll
                for (int rw = 0; rw < 2; ++rw) {
                    const int j = j0 + rw;
                    const int n = (j < CTXL) ? 0 : (j - CTXL), prow = n >> 6, pcol = n & 63;
#pragma unroll
                    for (int i = 0; i < 4; ++i) {
                        const int c = lane * 4 + i * 256;
                        pe[rw][i] = (c < 512) ? *(const f32x4*)(p.pos + prow * 512 + c) : *(const f32x4*)(p.pos + pcol * 512 + (c - 512));
                    }
                }
            }
        }
#pragma unroll
        for (int rw = 0; rw < 2; ++rw) {
            const int lrow = w * 2 + rw;
            const int r = row_of(rg, rw);
            const int b = r / RPB, j = r - b * RPB;
            const bool isctx = j < CTXL;
            float* res = isctx ? (p.cx + (size_t)(b * CTXL + j) * D) : (p.out + (size_t)(b * SEQ + (j - CTXL)) * D);
            f32x4 v[4];
#pragma unroll
            for (int i = 0; i < 4; ++i) v[i] = vcur[rw][i];
            if (MODE == 0) {
                if (!isctx) {
#pragma unroll
                    for (int i = 0; i < 4; ++i) v[i] += pe[rw][i];
                }
            } else if ((UPD_ROW && !(MODE == 1 && isctx)) || UPD_SLOT) {
#pragma unroll
                for (int i = 0; i < 4; ++i) {
                    const u32x2 ub = ucur[rw][i];
                    v[i][0] += gu4[i][0] * bf2f((bf16_t)(ub.x & 0xffffu)); v[i][1] += gu4[i][1] * bf2f((bf16_t)(ub.x >> 16));
                    v[i][2] += gu4[i][2] * bf2f((bf16_t)(ub.y & 0xffffu)); v[i][3] += gu4[i][3] * bf2f((bf16_t)(ub.y >> 16));
                }
            }
#pragma unroll
            for (int i = 0; i < 4; ++i) *(f32x4*)(res + lane * 4 + i * 256) = v[i];
            float ss = 0.f;
#pragma unroll
            for (int i = 0; i < 4; ++i) ss += v[i][0] * v[i][0] + v[i][1] * v[i][1] + v[i][2] * v[i][2] + v[i][3] * v[i][3];
#pragma unroll
            for (int o = 32; o >= 1; o >>= 1) ss += __shfl_xor(ss, o);
            const float rstd = rsqrtf(ss * (1.0f / 1024.0f) + EPS);
#pragma unroll
            for (int i = 0; i < 4; ++i) {
                const int c = lane * 4 + i * 256;
                f32x4 hv;
#pragma unroll
                for (int q = 0; q < 4; ++q) hv[q] = v[i][q] * rstd * g4[i][q] * (1.0f + sc4[i][q]) + sh4[i][q];
                *(u32x2*)(p.H + (size_t)r * D + c) = pk4(hv);
                if (GEMV) *(f32x4*)(hrow + lrow * PRE_LD + c) = hv;
            }
        }
        if (GEMV) {
            lds_sync();
            f32x4 c0 = (f32x4){0.f, 0.f, 0.f, 0.f}, c1 = c0;
#pragma unroll
            for (int ks = 0; ks < 4; ++ks) {
                const float* hp = hrow + fr * PRE_LD + w * 128 + ks * 32 + fq * 8;
                const f32x4 x0 = *(const f32x4*)hp, x1 = *(const f32x4*)(hp + 4);
                u32x4 hi, lo;
                hi.x = cvt_pk_bf16(x0[0], x0[1]); hi.y = cvt_pk_bf16(x0[2], x0[3]); hi.z = cvt_pk_bf16(x1[0], x1[1]); hi.w = cvt_pk_bf16(x1[2], x1[3]);
                lo.x = cvt_pk_bf16(x0[0] - __uint_as_float(hi.x << 16), x0[1] - __uint_as_float(hi.x & 0xffff0000u));
                lo.y = cvt_pk_bf16(x0[2] - __uint_as_float(hi.y << 16), x0[3] - __uint_as_float(hi.y & 0xffff0000u));
                lo.z = cvt_pk_bf16(x1[0] - __uint_as_float(hi.z << 16), x1[1] - __uint_as_float(hi.z & 0xffff0000u));
                lo.w = cvt_pk_bf16(x1[2] - __uint_as_float(hi.w << 16), x1[3] - __uint_as_float(hi.w & 0xffff0000u));
                const bf16x8 ah = __builtin_bit_cast(bf16x8, hi), al = __builtin_bit_cast(bf16x8, lo);
                c0 = __builtin_amdgcn_mfma_f32_16x16x32_bf16(bh[ks][0], ah, c0, 0, 0, 0);
                c0 = __builtin_amdgcn_mfma_f32_16x16x32_bf16(bl[ks][0], ah, c0, 0, 0, 0);
                c0 = __builtin_amdgcn_mfma_f32_16x16x32_bf16(bh[ks][0], al, c0, 0, 0, 0);
                c1 = __builtin_amdgcn_mfma_f32_16x16x32_bf16(bh[ks][1], ah, c1, 0, 0, 0);
                c1 = __builtin_amdgcn_mfma_f32_16x16x32_bf16(bl[ks][1], ah, c1, 0, 0, 0);
                c1 = __builtin_amdgcn_mfma_f32_16x16x32_bf16(bh[ks][1], al, c1, 0, 0, 0);
            }
            *(f32x4*)&part[(w * 16 + fr) * 32 + fq * 4] = c0;
            *(f32x4*)&part[(w * 16 + fr) * 32 + 16 + fq * 4] = c1;
            lds_sync();
            {
                const int row = t >> 5, e2 = t & 31;
                float s = 0.f;
#pragma unroll
                for (int q = 0; q < 8; ++q) s += part[(q * 16 + row) * 32 + e2];
                if (MODE == 0) p.AF[(size_t)(rg * 16 + row) * 32 + e2] = s;
                else logit[row * 32 + e2] = s;
            }
            if (FFN) {
                lds_sync();
                if (t < 16) {
                    int rr;
                    if (MODE == 3) { const int i = rg * 16 + t; rr = (i >> 12) * RPB + CTXL + (i & 4095); } else rr = rg * 16 + t;
                    float best = -3.0e38f; int bg = 0, bi1 = 0, bi2 = 1; float ba1 = 0.f, ba2 = 0.f;
#pragma unroll 1
                    for (int g = 0; g < 8; ++g) {
                        float m1 = -3.0e38f, m2 = -3.0e38f, a1 = 0.f, a2 = 0.f; int i1 = 0, i2 = 0;
#pragma unroll
                        for (int e = 0; e < 4; ++e) {
                            const float a = sigmoidf_(logit[t * 32 + g * 4 + e]);
                            const float sv = a + p.router_bias[g * 4 + e];
                            if (sv > m1) { m2 = m1; i2 = i1; a2 = a1; m1 = sv; i1 = e; a1 = a; }
                            else if (sv > m2) { m2 = sv; i2 = e; a2 = a; }
                        }
                        const float gs = m1 + m2;
                        if (gs > best) { best = gs; bg = g; bi1 = i1; bi2 = i2; ba1 = a1; ba2 = a2; }
                    }
                    const float inv = 1.0f / (ba1 + ba2);
                    const float w1 = ba1 * inv, w2 = ba2 * inv;
                    const int lo = bi1 < bi2 ? bi1 : bi2, hi = bi1 < bi2 ? bi2 : bi1;
                    const float wlo = bi1 < bi2 ? w1 : w2, whi = bi1 < bi2 ? w2 : w1;
                    const int pair = (lo == 0) ? (hi - 1) : (lo == 1 ? (hi + 1) : 5);
                    const int bucket = bg * 6 + pair;
                    float4 rec; rec.x = __int_as_float(bucket); rec.y = wlo; rec.z = whi; rec.w = 0.f;
                    p.RT[rr] = rec;
                    atomicAdd(&lcnt[bucket], 1);
                }
            }
            lds_sync();
        }
    }
    if (FFN) {
        __syncthreads();
        if (t < 48) p.blkcnt[((size_t)L * 256 + bid) * 48 + t] = lcnt[t];
    }
    if (MODE == 3) {
        __syncthreads();
        for (int task = bid; task < NT_GU + NT_WD; task += nb) moe_cvt_task(p, 1, task, smem);
    }
}

struct GemmSmem { bf16_t A[2][128][72]; bf16_t B[2][256][72]; };
static_assert(sizeof(GemmSmem) <= LDS_BYTES, "gemm lds");

template <class Epi>
DEVINL void gemm_tile(const bf16_t* __restrict__ A, int lda, const int* __restrict__ rowlist, int m0, int mvalid,
                      const bf16_t* __restrict__ Bt0, const bf16_t* __restrict__ Bt1, int ldb, int kseg, int K, Epi& epi, char* smem) {
    GemmSmem& S = *(GemmSmem*)smem;
    const int t = tid_opaque(), w = t >> 6, lane = t & 63, fr = lane & 15, fq = lane >> 4, wr = w >> 2, wc = w & 3;
    const int ch = t & 7, rr = t >> 3;
    const bf16_t* ap[2];
#pragma unroll
    for (int i = 0; i < 2; ++i) {
        const int ri = rr + i * 64, gi = ri < mvalid ? ri : 0;
        const int grow = rowlist ? rowlist[m0 + gi] : (m0 + gi);
        ap[i] = A + (size_t)grow * lda + ch * 8;
    }
    u32x4 ra[2], rb[4];
    f32x4 acc[4][4];
#pragma unroll
    for (int m = 0; m < 4; ++m)
#pragma unroll
        for (int n = 0; n < 4; ++n) acc[m][n] = (f32x4){0.f, 0.f, 0.f, 0.f};
    const int nk = K >> 6;
#define GT_GLOAD(kt) do { const int _k0 = (kt) * 64; \
        _Pragma("unroll") for (int i = 0; i < 2; ++i) ra[i] = *(const u32x4*)(ap[i] + _k0); \
        const bf16_t* _bb = (_k0 < kseg) ? (Bt0 + _k0) : (Bt1 + (_k0 - kseg)); \
        _Pragma("unroll") for (int i = 0; i < 4; ++i) rb[i] = *(const u32x4*)(_bb + (size_t)(rr + i * 64) * ldb + ch * 8); } while (0)
#define GT_SSTORE(buf) do { \
        _Pragma("unroll") for (int i = 0; i < 2; ++i) *(u32x4*)&S.A[buf][rr + i * 64][ch * 8] = ra[i]; \
        _Pragma("unroll") for (int i = 0; i < 4; ++i) *(u32x4*)&S.B[buf][rr + i * 64][ch * 8] = rb[i]; } while (0)
    GT_GLOAD(0);
    GT_SSTORE(0);
    __syncthreads();
    for (int kt = 0; kt < nk; ++kt) {
        const int cur = kt & 1;
        if (kt + 1 < nk) GT_GLOAD(kt + 1);
#pragma unroll
        for (int kk = 0; kk < 2; ++kk) {
            bf16x8 a[4], b[4];
#pragma unroll
            for (int m = 0; m < 4; ++m) a[m] = *(const bf16x8*)&S.A[cur][wr * 64 + m * 16 + fr][kk * 32 + fq * 8];
#pragma unroll
            for (int n = 0; n < 4; ++n) b[n] = *(const bf16x8*)&S.B[cur][wc * 64 + n * 16 + fr][kk * 32 + fq * 8];
#pragma unroll
            for (int m = 0; m < 4; ++m)
#pragma unroll
                for (int n = 0; n < 4; ++n) acc[m][n] = __builtin_amdgcn_mfma_f32_16x16x32_bf16(b[n], a[m], acc[m][n], 0, 0, 0);
        }
        if (kt + 1 < nk) GT_SSTORE(cur ^ 1);
        __syncthreads();
    }
#undef GT_GLOAD
#undef GT_SSTORE
    epi(acc, wr * 64, wc * 64, fr, fq);
}

struct EpiP0 {
    bf16_t* P; int m0, n0;
    DEVINL void operator()(const f32x4 (&acc)[4][4], int mb, int nbs, int fr, int fq) const {
        const float sc = (n0 < 256) ? 0.125f : 1.0f;
#pragma unroll
        for (int m = 0; m < 4; ++m) {
            bf16_t* rp = P + (size_t)(m0 + mb + m * 16 + fr) * 2048 + n0 + nbs + fq * 4;
#pragma unroll
            for (int n = 0; n < 4; ++n) *(u32x2*)(rp + n * 16) = pk4(acc[m][n] * sc);
        }
    }
};
struct EpiP1 {
    bf16_t* P; const float* lb; int m0, n0;
    DEVINL void operator()(const f32x4 (&acc)[4][4], int mb, int nbs, int fr, int fq) const {
        const int cb = n0 >> 10;
#pragma unroll
        for (int m = 0; m < 4; ++m) {
            bf16_t* rp = P + (size_t)(m0 + mb + m * 16 + fr) * 5120 + n0 + nbs + fq * 4;
#pragma unroll
            for (int n = 0; n < 4; ++n) {
                const f32x4 a = acc[m][n];
                u32x2 o;
                if (cb == 1 || cb == 2) {
                    const int cc = ((n0 + nbs + n * 16 + fq * 4) & 1023);
                    const f32x4 l4 = *(const f32x4*)(lb + cc);
                    unsigned short hv[4];
#pragma unroll
                    for (int j = 0; j < 4; ++j) hv[j] = f2h((1.0f - l4[j]) * sigmoidf_(-a[j]));
                    o.x = (unsigned)hv[0] | ((unsigned)hv[1] << 16); o.y = (unsigned)hv[2] | ((unsigned)hv[3] << 16);
                } else if (cb == 0 || cb == 4) {
                    f32x4 s;
#pragma unroll
                    for (int j = 0; j < 4; ++j) s[j] = siluf_(a[j]);
                    o = pk4(s);
                } else o = pk4(a);
                *(u32x2*)(rp + n * 16) = o;
            }
        }
    }
};
struct EpiGlu {
    bf16_t* CAT; const bf16_t* s5a; const float* gb; int m0, n0;
    DEVINL void operator()(const f32x4 (&acc)[4][4], int mb, int nbs, int fr, int fq) const {
        f32x4 b4[4];
#pragma unroll
        for (int n = 0; n < 4; ++n) b4[n] = *(const f32x4*)(gb + n0 + nbs + n * 16 + fq * 4);
        u32x2 av[4][4];
#pragma unroll
        for (int m = 0; m < 4; ++m)
#pragma unroll
            for (int n = 0; n < 4; ++n) av[m][n] = *(const u32x2*)(s5a + (size_t)(m0 + mb + m * 16 + fr) * 512 + n0 + nbs + n * 16 + fq * 4);
#pragma unroll
        for (int m = 0; m < 4; ++m) {
            const size_t row = (size_t)(m0 + mb + m * 16 + fr);
#pragma unroll
            for (int n = 0; n < 4; ++n) {
                const int col = n0 + nbs + n * 16 + fq * 4;
                f32x4 o;
                o[0] = bf2f((bf16_t)(av[m][n].x & 0xffff)) * sigmoidf_(acc[m][n][0] + b4[n][0]);
                o[1] = bf2f((bf16_t)(av[m][n].x >> 16)) * sigmoidf_(acc[m][n][1] + b4[n][1]);
                o[2] = bf2f((bf16_t)(av[m][n].y & 0xffff)) * sigmoidf_(acc[m][n][2] + b4[n][2]);
                o[3] = bf2f((bf16_t)(av[m][n].y >> 16)) * sigmoidf_(acc[m][n][3] + b4[n][3]);
                *(u32x2*)(CAT + row * 1024 + 512 + col) = pk4(o);
            }
        }
    }
};
struct EpiOut {
    const Params* p; const float* gate; int m0, n0;
    DEVINL void operator()(const f32x4 (&acc)[4][4], int mb, int nbs, int fr, int fq) const {
        const float* gp = gate + (size_t)8 * 6144;
        f32x4 g4[4];
#pragma unroll
        for (int n = 0; n < 4; ++n) g4[n] = *(const f32x4*)(gp + n0 + nbs + n * 16 + fq * 4);
        f32x4 x4[4][4];
#pragma unroll
        for (int m = 0; m < 4; ++m) {
            const float* rp = resid_row(*p, m0 + mb + m * 16 + fr);
#pragma unroll
            for (int n = 0; n < 4; ++n) x4[m][n] = *(const f32x4*)(rp + n0 + nbs + n * 16 + fq * 4);
        }
#pragma unroll
        for (int m = 0; m < 4; ++m) {
            float* rp = resid_row(*p, m0 + mb + m * 16 + fr);
#pragma unroll
            for (int n = 0; n < 4; ++n) *(f32x4*)(rp + n0 + nbs + n * 16 + fq * 4) = x4[m][n] + g4[n] * acc[m][n];
        }
    }
};

struct EpiY {
    bf16_t* O; int m0, n0;
    DEVINL void operator()(const f32x4 (&acc)[4][4], int mb, int nbs, int fr, int fq) const {
#pragma unroll
        for (int m = 0; m < 4; ++m) {
            bf16_t* rp = O + (size_t)(m0 + mb + m * 16 + fr) * 1024 + n0 + nbs + fq * 4;
#pragma unroll
            for (int n = 0; n < 4; ++n) *(u32x2*)(rp + n * 16) = pk4(acc[m][n]);
        }
    }
};

namespace pg8 {
#define PG8_LAS __attribute__((address_space(3)))
constexpr int BM = 256, BK = 64, HALF = 128, HTB = HALF * BK * 2, STAGE_BYTES = 8 * HTB, NXCD = 8, WGM = 8;
DEVINL int lds_byte(int r, int c) { const int st = (r >> 4) * 2 + (c >> 5), rr = r & 15, cc = c & 31, ob = rr * 64 + cc * 2; return st * 1024 + (ob ^ (((ob >> 9) & 1) << 5)); }
DEVINL void stage_rc(int b, int& R_, int& C_) { const int st = b / 1024, sb = b % 1024, swz = sb ^ (((sb >> 9) & 1) << 5); R_ = (st >> 1) * 16 + swz / 64; C_ = (st & 1) * 32 + (swz % 64) / 2; }
DEVINL int perm32(int rho) { const int n = rho >> 4, i = rho & 15; return 8 * (i >> 2) + 4 * n + (i & 3); }
struct Unit { int pm, pn; const char* A; const char* B0; const char* B1; int mvalid, aux; };

template <class Epi, class Sched>
DEVINL void gemm_phase(PG8_LAS unsigned char* lds, const Sched& S, const Epi& E) {
    const int tid = tid_opaque(), wid = __builtin_amdgcn_readfirstlane(tid >> 6), lane = tid & 63, wr = wid >> 2, wc = wid & 3, fr = lane & 15, fq = lane >> 4;
    const int K = S.K, nt = K / BK, ldb = S.ldb, ksplit = S.ksplit;
    unsigned voffA[2], voffB[2];
#pragma unroll
    for (int i = 0; i < 2; ++i) { int R_, C_; stage_rc(tid * 16 + i * 8192, R_, C_); const int Rb = Epi::PERM ? ((R_ & ~31) + perm32(R_ & 31)) : R_;
        voffA[i] = (unsigned)(R_ * K + C_) * 2u; voffB[i] = (unsigned)(Rb * ldb + C_) * 2u; }
    const size_t kstep = (size_t)(BK * 2);
    const size_t hstepA = (size_t)HALF * K * 2, hstepB = (size_t)HALF * ldb * 2;
    const unsigned ldsw = (unsigned)wid * 1024u;
    const int aoff = lds_byte(wr * 64 + fr, fq * 8), boff = lds_byte(wc * 32 + fr, fq * 8);
#define PG8_SA(b, h) (((b) * 2 + (h)) * HTB)
#define PG8_SB(b, h) ((4 + (b) * 2 + (h)) * HTB)
#define PG8_STAGE(bufoff, gbase, voff) do { _Pragma("unroll") for (int _i = 0; _i < 2; ++_i) \
        __builtin_amdgcn_global_load_lds((const unsigned*)((const char*)(gbase) + (voff)[_i]), (PG8_LAS unsigned*)(lds + (bufoff) + ldsw + _i * 8192), 16, 0, 0); } while (0)
#define PG8_LDA(dst, b, h) do { _Pragma("unroll") for (int m = 0; m < 4; ++m) _Pragma("unroll") for (int k = 0; k < 2; ++k) dst[m][k] = *(const PG8_LAS bf16x8*)(lds + PG8_SA(b, h) + aoff + m * 2048 + k * 1024); } while (0)
#define PG8_LDB(dst, b, h) do { _Pragma("unroll") for (int n = 0; n < 2; ++n) _Pragma("unroll") for (int k = 0; k < 2; ++k) dst[n][k] = *(const PG8_LAS bf16x8*)(lds + PG8_SB(b, h) + boff + n * 2048 + k * 1024); } while (0)
#define PG8_MMA(ai, bj, At, Bt) do { __builtin_amdgcn_s_setprio(1); _Pragma("unroll") for (int m = 0; m < 4; ++m) _Pragma("unroll") for (int n = 0; n < 2; ++n) _Pragma("unroll") for (int k = 0; k < 2; ++k) \
        acc[ai][bj][m][n] = __builtin_amdgcn_mfma_f32_16x16x32_bf16(Bt[n][k], At[m][k], acc[ai][bj][m][n], 0, 0, 0); __builtin_amdgcn_s_setprio(0); } while (0)
#define PG8_WAIT_V(n) asm volatile("s_waitcnt vmcnt(" #n ")" ::: "memory")
#define PG8_WAIT_L(n) asm volatile("s_waitcnt lgkmcnt(" #n ")" ::: "memory")
#define PG8_BAR __builtin_amdgcn_s_barrier()
#define PG8_SCHED __builtin_amdgcn_sched_barrier(0)
#define PG8_BPTR(u, kt) (((kt) < ksplit ? (u).B0 : (u).B1) + (size_t)(kt) * kstep)
    Unit cur, nxt; int ui = 0;
    if (!S.next(0, cur)) return;
    f32x4 acc[2][2][4][2];
#pragma unroll
    for (int a = 0; a < 2; ++a)
#pragma unroll
        for (int b = 0; b < 2; ++b)
#pragma unroll
            for (int m = 0; m < 4; ++m)
#pragma unroll
                for (int n = 0; n < 2; ++n) acc[a][b][m][n] = (f32x4){0.f, 0.f, 0.f, 0.f};
    bf16x8 At[4][2], B0[2][2], B1[2][2];
    const char* cA = cur.A;
    { const char* cB0 = PG8_BPTR(cur, 0); const char* cB1 = PG8_BPTR(cur, 1);
      PG8_STAGE(PG8_SB(0, 0), cB0, voffB); PG8_STAGE(PG8_SA(0, 0), cA, voffA); PG8_STAGE(PG8_SB(0, 1), cB0 + hstepB, voffB); PG8_STAGE(PG8_SA(0, 1), cA + hstepA, voffA);
      if (wr == 1) PG8_BAR;
      PG8_WAIT_V(4); PG8_BAR;
      PG8_STAGE(PG8_SB(1, 0), cB1, voffB); PG8_STAGE(PG8_SA(1, 0), cA + kstep, voffA); PG8_STAGE(PG8_SB(1, 1), cB1 + hstepB, voffB);
      PG8_WAIT_V(6); PG8_BAR; }
    for (;;) {
        const bool has_next = S.next(ui + 1, nxt);
        if (!has_next) nxt = cur;
        const char* nA = nxt.A;
        for (int t = 0; t < nt; t += 2) {
            const bool last = (t == nt - 2);
            const char* a1 = cA + (size_t)(t + 1) * kstep;
            const char* a2 = last ? nA : cA + (size_t)(t + 2) * kstep;
            const char* b2 = last ? PG8_BPTR(nxt, 0) : PG8_BPTR(cur, t + 2);
            const char* a3 = a2 + kstep;
            const char* b3 = last ? PG8_BPTR(nxt, 1) : PG8_BPTR(cur, t + 3);
            PG8_LDB(B0, 0, 0); PG8_SCHED; PG8_LDA(At, 0, 0); PG8_STAGE(PG8_SA(1, 1), a1 + hstepA, voffA);
            PG8_WAIT_L(8); PG8_BAR; PG8_WAIT_L(0); PG8_MMA(0, 0, At, B0); PG8_BAR; PG8_SCHED;
            PG8_LDB(B1, 0, 1); PG8_STAGE(PG8_SB(0, 0), b2, voffB);
            PG8_BAR; PG8_WAIT_L(0); PG8_MMA(0, 1, At, B1); PG8_BAR;
            PG8_LDA(At, 0, 1); PG8_STAGE(PG8_SA(0, 0), a2, voffA);
            PG8_BAR; PG8_WAIT_L(0); PG8_MMA(1, 0, At, B0); PG8_BAR; PG8_SCHED;
            PG8_STAGE(PG8_SB(0, 1), b2 + hstepB, voffB);
            PG8_WAIT_V(6); PG8_BAR; PG8_MMA(1, 1, At, B1); PG8_BAR;
            PG8_LDB(B0, 1, 0); PG8_SCHED; PG8_LDA(At, 1, 0); PG8_STAGE(PG8_SA(0, 1), a2 + hstepA, voffA);
            PG8_WAIT_L(8); PG8_BAR; PG8_WAIT_L(0); PG8_MMA(0, 0, At, B0); PG8_BAR; PG8_SCHED;
            PG8_LDB(B1, 1, 1); PG8_STAGE(PG8_SB(1, 0), b3, voffB);
            PG8_BAR; PG8_WAIT_L(0); PG8_MMA(0, 1, At, B1); PG8_BAR;
            PG8_LDA(At, 1, 1); PG8_STAGE(PG8_SA(1, 0), a3, voffA);
            PG8_BAR; PG8_WAIT_L(0); PG8_MMA(1, 0, At, B0); PG8_BAR; PG8_SCHED;
            PG8_STAGE(PG8_SB(1, 1), b3 + hstepB, voffB);
            PG8_WAIT_V(6); PG8_BAR; PG8_MMA(1, 1, At, B1); PG8_BAR;
        }
        E(acc, cur, wr, wc, fr, fq);
        if (!has_next) break;
#pragma unroll
        for (int a = 0; a < 2; ++a)
#pragma unroll
            for (int b = 0; b < 2; ++b)
#pragma unroll
                for (int m = 0; m < 4; ++m)
#pragma unroll
                    for (int n = 0; n < 2; ++n) acc[a][b][m][n] = (f32x4){0.f, 0.f, 0.f, 0.f};
        cur = nxt; cA = nA; ++ui;
    }
    PG8_WAIT_V(0);
    if (wr == 0) PG8_BAR;
    PG8_BAR;
#undef PG8_SA
#undef PG8_SB
#undef PG8_STAGE
#undef PG8_LDA
#undef PG8_LDB
#undef PG8_MMA
#undef PG8_WAIT_V
#undef PG8_WAIT_L
#undef PG8_BAR
#undef PG8_SCHED
#undef PG8_BPTR
}

struct DenseSched {
    const char* A; const char* Bt; int K, ldb, ksplit, nM, nN, G, c, lat;
    DEVINL void init(const bf16_t* A_, const bf16_t* Bt_, int N, int K_, int G_, int c_, int lat_) {
        A = (const char*)A_; Bt = (const char*)Bt_; K = K_; ldb = K_; ksplit = K_ / BK; nM = lat_ ? 128 : 136; nN = N / BM; G = G_; c = c_; lat = lat_; }
    DEVINL bool next(int i, Unit& u) const {
        const int nwg = nM * nN;
        const long Lq = (long)i * G + c; if (Lq >= nwg) return false;
        int wgid = (int)Lq; { const int q = nwg / NXCD, r = nwg % NXCD, xcd = wgid % NXCD, off = wgid / NXCD; wgid = (xcd < r ? xcd * (q + 1) : r * (q + 1) + (xcd - r) * q) + off; }
        const int nig = WGM * nN, gid = wgid / nig, fm = gid * WGM, gsz = (nM - fm) < WGM ? (nM - fm) : WGM;
        int pm = fm + ((wgid % nig) % gsz); const int pn = (wgid % nig) / gsz;
        if (lat) pm = (pm >> 4) * 17 + 1 + (pm & 15);
        u.pm = pm; u.pn = pn; u.A = A + (size_t)pm * BM * K * 2; u.B0 = Bt + (size_t)pn * BM * K * 2; u.B1 = u.B0; u.mvalid = 256; u.aux = 0;
        return true;
    }
};
}

struct GEpiP0 {
    static constexpr bool PERM = true;
    bf16_t* P;
    DEVINL void operator()(const f32x4 (&acc)[2][2][4][2], const pg8::Unit& u, int wr, int wc, int fr, int fq) const {
        const float sc = (u.pn == 0) ? 0.125f : 1.0f;
        const int row0 = u.pm * 256 + wr * 64 + fr, col0 = u.pn * 256 + wc * 32 + 8 * fq;
#pragma unroll
        for (int ai = 0; ai < 2; ++ai)
#pragma unroll
            for (int m = 0; m < 4; ++m) {
                bf16_t* rp = P + (size_t)(row0 + ai * 128 + m * 16) * 2048 + col0;
#pragma unroll
                for (int bj = 0; bj < 2; ++bj) {
                    const u32x2 a = pk4(acc[ai][bj][m][0] * sc), b = pk4(acc[ai][bj][m][1] * sc);
                    u32x4 w; w.x = a.x; w.y = a.y; w.z = b.x; w.w = b.y;
                    *(u32x4*)(rp + bj * 128) = w;
                }
            }
    }
};
struct GEpiP1 {
    static constexpr bool PERM = true;
    bf16_t* P; const float* lb;
    DEVINL void operator()(const f32x4 (&acc)[2][2][4][2], const pg8::Unit& u, int wr, int wc, int fr, int fq) const {
        const int cb = u.pn >> 2;
        const int row0 = u.pm * 256 + wr * 64 + fr, col0 = u.pn * 256 + wc * 32 + 8 * fq;
        f32x4 oml[2][2];
        if (cb == 1 || cb == 2) {
#pragma unroll
            for (int bj = 0; bj < 2; ++bj)
#pragma unroll
                for (int n = 0; n < 2; ++n) { const f32x4 l4 = *(const f32x4*)(lb + ((col0 + bj * 128) & 1023) + 4 * n); oml[bj][n] = 1.0f - l4; }
        }
#pragma unroll
        for (int ai = 0; ai < 2; ++ai)
#pragma unroll
            for (int m = 0; m < 4; ++m) {
                bf16_t* rp = P + (size_t)(row0 + ai * 128 + m * 16) * 5120 + col0;
#pragma unroll
                for (int bj = 0; bj < 2; ++bj) {
                    u32x4 w;
                    if (cb == 1 || cb == 2) {
                        unsigned short hv[8];
#pragma unroll
                        for (int n = 0; n < 2; ++n)
#pragma unroll
                            for (int j = 0; j < 4; ++j) hv[n * 4 + j] = f2h(oml[bj][n][j] * sigmoidf_(-acc[ai][bj][m][n][j]));
                        w.x = (unsigned)hv[0] | ((unsigned)hv[1] << 16); w.y = (unsigned)hv[2] | ((unsigned)hv[3] << 16);
                        w.z = (unsigned)hv[4] | ((unsigned)hv[5] << 16); w.w = (unsigned)hv[6] | ((unsigned)hv[7] << 16);
                    } else {
                        f32x4 v0 = acc[ai][bj][m][0], v1 = acc[ai][bj][m][1];
                        if (cb == 0 || cb == 4) {
#pragma unroll
                            for (int j = 0; j < 4; ++j) { v0[j] = siluf_(v0[j]); v1[j] = siluf_(v1[j]); }
                        }
                        const u32x2 a = pk4(v0), b = pk4(v1);
                        w.x = a.x; w.y = a.y; w.z = b.x; w.w = b.y;
                    }
                    *(u32x4*)(rp + bj * 128) = w;
                }
            }
    }
};
struct GEpiGlu {
    static constexpr bool PERM = true;
    bf16_t* CAT; const bf16_t* s5a; const float* gb;
    DEVINL void operator()(const f32x4 (&acc)[2][2][4][2], const pg8::Unit& u, int wr, int wc, int fr, int fq) const {
        const int row0 = u.pm * 256 + wr * 64 + fr, col0 = u.pn * 256 + wc * 32 + 8 * fq;
        f32x4 bv[2][2];
#pragma unroll
        for (int bj = 0; bj < 2; ++bj)
#pragma unroll
            for (int n = 0; n < 2; ++n) bv[bj][n] = *(const f32x4*)(gb + col0 + bj * 128 + 4 * n);
#pragma unroll
        for (int ai = 0; ai < 2; ++ai) {
            u32x4 av[4][2];
#pragma unroll
            for (int m = 0; m < 4; ++m)
#pragma unroll
                for (int bj = 0; bj < 2; ++bj) av[m][bj] = *(const u32x4*)(s5a + (size_t)(row0 + ai * 128 + m * 16) * 512 + col0 + bj * 128);
#pragma unroll
            for (int m = 0; m < 4; ++m) {
                const size_t row = (size_t)(row0 + ai * 128 + m * 16);
#pragma unroll
                for (int bj = 0; bj < 2; ++bj) {
                    const u32x4 a = av[m][bj];
                    f32x4 o0, o1;
                    o0[0] = bf2f((bf16_t)(a.x & 0xffff)) * sigmoidf_(acc[ai][bj][m][0][0] + bv[bj][0][0]);
                    o0[1] = bf2f((bf16_t)(a.x >> 16)) * sigmoidf_(acc[ai][bj][m][0][1] + bv[bj][0][1]);
                    o0[2] = bf2f((bf16_t)(a.y & 0xffff)) * sigmoidf_(acc[ai][bj][m][0][2] + bv[bj][0][2]);
                    o0[3] = bf2f((bf16_t)(a.y >> 16)) * sigmoidf_(acc[ai][bj][m][0][3] + bv[bj][0][3]);
                    o1[0] = bf2f((bf16_t)(a.z & 0xffff)) * sigmoidf_(acc[ai][bj][m][1][0] + bv[bj][1][0]);
                    o1[1] = bf2f((bf16_t)(a.z >> 16)) * sigmoidf_(acc[ai][bj][m][1][1] + bv[bj][1][1]);
                    o1[2] = bf2f((bf16_t)(a.w & 0xffff)) * sigmoidf_(acc[ai][bj][m][1][2] + bv[bj][1][2]);
                    o1[3] = bf2f((bf16_t)(a.w >> 16)) * sigmoidf_(acc[ai][bj][m][1][3] + bv[bj][1][3]);
                    const u32x2 x = pk4(o0), y = pk4(o1);
                    u32x4 w; w.x = x.x; w.y = x.y; w.z = y.x; w.w = y.y;
                    *(u32x4*)(CAT + row * 1024 + 512 + col0 + bj * 128) = w;
                }
            }
        }
    }
};
struct GEpiOut {
    static constexpr bool PERM = false;
    float* out; const float* gate;
    DEVINL void operator()(const f32x4 (&acc)[2][2][4][2], const pg8::Unit& u, int wr, int wc, int fr, int fq) const {
        const int b = u.pm / 17, lt = u.pm - b * 17 - 1;
        const float* gp = gate + (size_t)b * 6144;
        const int col0 = u.pn * 256 + wc * 32 + 4 * fq;
        float* base = out + ((size_t)b * SEQ + lt * 256 + wr * 64 + fr) * D;
        f32x4 g4[2][2];
#pragma unroll
        for (int bj = 0; bj < 2; ++bj)
#pragma unroll
            for (int n = 0; n < 2; ++n) g4[bj][n] = *(const f32x4*)(gp + col0 + bj * 128 + n * 16);
#pragma unroll
        for (int ai = 0; ai < 2; ++ai)
#pragma unroll
            for (int mp = 0; mp < 4; mp += 2) {
                f32x4 x4[2][2][2];
#pragma unroll
                for (int q = 0; q < 2; ++q)
#pragma unroll
                    for (int bj = 0; bj < 2; ++bj)
#pragma unroll
                        for (int n = 0; n < 2; ++n) x4[q][bj][n] = *(const f32x4*)(base + (size_t)(ai * 128 + (mp + q) * 16) * D + col0 + bj * 128 + n * 16);
                asm volatile("" ::: "memory");
#pragma unroll
                for (int q = 0; q < 2; ++q)
#pragma unroll
                    for (int bj = 0; bj < 2; ++bj)
#pragma unroll
                        for (int n = 0; n < 2; ++n) *(f32x4*)(base + (size_t)(ai * 128 + (mp + q) * 16) * D + col0 + bj * 128 + n * 16) = x4[q][bj][n] + g4[bj][n] * acc[ai][bj][mp + q][n];
                asm volatile("" ::: "memory");
            }
    }
};
struct GEpiY {
    static constexpr bool PERM = true;
    bf16_t* O;
    DEVINL void operator()(const f32x4 (&acc)[2][2][4][2], const pg8::Unit& u, int wr, int wc, int fr, int fq) const {
        const int row0 = u.pm * 256 + wr * 64 + fr, col0 = u.pn * 256 + wc * 32 + 8 * fq;
#pragma unroll
        for (int ai = 0; ai < 2; ++ai)
#pragma unroll
            for (int m = 0; m < 4; ++m) {
                bf16_t* rp = O + (size_t)(row0 + ai * 128 + m * 16) * 1024 + col0;
#pragma unroll
                for (int bj = 0; bj < 2; ++bj) {
                    const u32x2 a = pk4(acc[ai][bj][m][0]), b = pk4(acc[ai][bj][m][1]);
                    u32x4 w; w.x = a.x; w.y = a.y; w.z = b.x; w.w = b.y;
                    *(u32x4*)(rp + bj * 128) = w;
                }
            }
    }
};
struct GEpiMoe1 {
    static constexpr bool PERM = true;
    bf16_t* act; const float* wl; const float* wh;
    DEVINL void operator()(const f32x4 (&acc)[2][2][4][2], const pg8::Unit& u, int wr, int wc, int fr, int fq) const {
        const int half = u.pn >> 1;
        const float* wsel = half ? wh : wl;
        const int cbase = half * 256 + (u.pn & 1) * 128 + 16 * wc + 4 * fq;
        float wv[2][4];
#pragma unroll
        for (int ai = 0; ai < 2; ++ai)
#pragma unroll
            for (int m = 0; m < 4; ++m) { const int lr = ai * 128 + wr * 64 + m * 16 + fr; wv[ai][m] = (lr < u.mvalid) ? wsel[u.pm * 256 + lr] : 0.f; }
#pragma unroll
        for (int ai = 0; ai < 2; ++ai)
#pragma unroll
            for (int m = 0; m < 4; ++m) {
                const int slot = u.pm * 256 + ai * 128 + wr * 64 + m * 16 + fr;
#pragma unroll
                for (int bj = 0; bj < 2; ++bj) {
                    f32x4 o;
#pragma unroll
                    for (int j = 0; j < 4; ++j) o[j] = wv[ai][m] * siluf_(acc[ai][bj][m][0][j]) * acc[ai][bj][m][1][j];
                    *(u32x2*)(act + (size_t)slot * 512 + cbase + 64 * bj) = pk4(o);
                }
            }
    }
};
struct GEpiMoe2 {
    static constexpr bool PERM = false;
    float* out; float* cx; const float* gate; const int* list;
    DEVINL void operator()(const f32x4 (&acc)[2][2][4][2], const pg8::Unit& u, int wr, int wc, int fr, int fq) const {
        const int col0 = u.pn * 256 + wc * 32 + 4 * fq;
        int rows[2][4];
#pragma unroll
        for (int ai = 0; ai < 2; ++ai)
#pragma unroll
            for (int m = 0; m < 4; ++m) { const int lr = ai * 128 + wr * 64 + m * 16 + fr; rows[ai][m] = (lr < u.mvalid) ? list[u.pm * 256 + lr] : -1; }
#pragma unroll
        for (int ai = 0; ai < 2; ++ai)
#pragma unroll
            for (int mp = 0; mp < 4; mp += 2) {
                f32x4 x4[2][2][2], g4[2][2][2];
                float* rp[2];
#pragma unroll
                for (int q = 0; q < 2; ++q) {
                    const int r = rows[ai][mp + q] < 0 ? 0 : rows[ai][mp + q];
                    const int rb = r / RPB, rj = r - rb * RPB;
                    rp[q] = (rj < CTXL) ? (cx + (size_t)(rb * CTXL + rj) * D) : (out + (size_t)(rb * SEQ + (rj - CTXL)) * D);
                    const float* gp = gate + (size_t)((rj < CTXL) ? 8 : rb) * 6144;
#pragma unroll
                    for (int bj = 0; bj < 2; ++bj)
#pragma unroll
                        for (int n = 0; n < 2; ++n) { const int col = col0 + bj * 128 + n * 16; x4[q][bj][n] = *(const f32x4*)(rp[q] + col); g4[q][bj][n] = *(const f32x4*)(gp + col); }
                }
                asm volatile("" ::: "memory");
#pragma unroll
                for (int q = 0; q < 2; ++q)
                    if (rows[ai][mp + q] >= 0) {
#pragma unroll
                        for (int bj = 0; bj < 2; ++bj)
#pragma unroll
                            for (int n = 0; n < 2; ++n) *(f32x4*)(rp[q] + col0 + bj * 128 + n * 16) = x4[q][bj][n] + g4[q][bj][n] * acc[ai][bj][mp + q][n];
                    }
            }
    }
};

template <int WHICH>
DEVINL void phase_gemm(const Params& p, char* smem, int bid, int nb) {
    constexpr int N = (WHICH == 0) ? 2048 : (WHICH == 1) ? 512 : (WHICH == 3) ? 5120 : 1024;
    constexpr int K = (WHICH == 1) ? 512 : 1024;
    PG8_LAS unsigned char* lds = (PG8_LAS unsigned char*)smem;
    pg8::DenseSched S;
    bid = sgpr(bid); nb = sgpr(nb);
    if (WHICH == 0) { S.init(sgpr_ptr(p.H), sgpr_ptr(p.wt_in0), N, K, nb, bid, 1); GEpiP0 e{sgpr_ptr(p.P)}; pg8::gemm_phase(lds, S, e); }
    if (WHICH == 1) { S.init(sgpr_ptr(p.s5a), sgpr_ptr(p.glu_t), N, K, nb, bid, 1); GEpiGlu e{sgpr_ptr(p.H), sgpr_ptr(p.s5a), sgpr_ptr(p.glu_b)}; pg8::gemm_phase(lds, S, e); }
    if (WHICH == 2) { S.init(sgpr_ptr(p.H), sgpr_ptr(p.wt_out0), N, K, nb, bid, 1); GEpiY e{sgpr_ptr(p.Y)}; pg8::gemm_phase(lds, S, e); }
    if (WHICH == 3) { S.init(sgpr_ptr(p.H), sgpr_ptr(p.wt_in1), N, K, nb, bid, 1); GEpiP1 e{sgpr_ptr(p.P), sgpr_ptr(p.lb)}; pg8::gemm_phase(lds, S, e); }
    if (WHICH == 4) { S.init(sgpr_ptr(p.H), sgpr_ptr(p.wt_out1), N, K, nb, bid, 1); GEpiY e{sgpr_ptr(p.Y)}; pg8::gemm_phase(lds, S, e); }
    if (WHICH != 4) {
        constexpr int NT0 = (WHICH == 3) ? 4 : 0, NT1 = (WHICH == 3) ? 16 : N / 256, NTC = NT1 - NT0;
        for (int u = bid; u < 16 * NTC; u += nb) {
            const int mt = u / NTC, nt = NT0 + (u - mt * NTC);
            const int m0 = (mt >> 1) * RPB + (mt & 1) * 128, n0 = nt * 256;
            if (WHICH == 0) { EpiP0 e{p.P, m0, n0}; gemm_tile(p.H, 1024, nullptr, m0, 128, p.wt_in0 + (size_t)n0 * 1024, nullptr, 1024, K, K, e, smem); }
            if (WHICH == 1) { EpiGlu e{p.H, p.s5a, p.glu_b, m0, n0}; gemm_tile(p.s5a, 512, nullptr, m0, 128, p.glu_t + (size_t)n0 * 512, nullptr, 512, K, K, e, smem); }
            if (WHICH == 2) { EpiOut e{&p, p.mod + 2048, m0, n0}; gemm_tile(p.H, 1024, nullptr, m0, 128, p.wt_out0 + (size_t)n0 * 1024, nullptr, 1024, K, K, e, smem); }
            if (WHICH == 3) { EpiP1 e{p.P, p.lb, m0, n0}; gemm_tile(p.H, 1024, nullptr, m0, 128, p.wt_in1 + (size_t)n0 * 1024, nullptr, 1024, K, K, e, smem); }
        }
    }
}

constexpr int MOE_TAB = pg8::STAGE_BYTES;
static_assert(MOE_TAB + 1024 <= LDS_BYTES, "moe tables");
DEVINL void moe_setup(const Params& p, int L, int* tab) {
    const int t = tid_opaque();
    if (t < 48) tab[128 + t] = p.cnt[L * 64 + t];
    __syncthreads();
    if (t == 0) {
        int o = 0, ts = 0;
        for (int b = 0; b < 48; ++b) { const int c = tab[128 + b]; tab[b] = o; tab[64 + b] = ts; const int nt = (c + 255) >> 8; o += nt * 256; ts += nt; }
        tab[48] = o; tab[64 + 48] = ts;
    }
    __syncthreads();
}
template <int L>
DEVINL void phase_list(const Params& p, char* smem, int bid, int nb) {
    int* tab = (int*)(smem + MOE_TAB);
    int* red = (int*)smem;
    int* rsrc = red + 1024; int* rdst = rsrc + 256;
    const int t = tid_opaque(), w = t >> 6, lane = t & 63;
    {
        const int bkt = t & 63, part = t >> 6;
        int tot = 0, pre = 0;
        if (bkt < 48) {
#pragma unroll 8
            for (int q = 0; q < 32; ++q) { const int blk = part * 32 + q; const int c = (blk < nb) ? p.blkcnt[((size_t)L * 256 + blk) * 48 + bkt] : 0; tot += c; pre += (blk < bid) ? c : 0; }
        }
        red[part * 64 + bkt] = tot; red[512 + part * 64 + bkt] = pre;
    }
    __syncthreads();
    if (t < 48) {
        int tot = 0, pre = 0;
#pragma unroll
        for (int q = 0; q < 8; ++q) { tot += red[q * 64 + t]; pre += red[512 + q * 64 + t]; }
        tab[128 + t] = tot; tab[192 + t] = pre;
        if (bid == 0) p.cnt[L * 64 + t] = tot;
    }
    __syncthreads();
    if (t == 0) {
        int o = 0, ts = 0;
        for (int b = 0; b < 48; ++b) { const int c = tab[128 + b]; tab[b] = o; tab[64 + b] = ts; const int nt = (c + 255) >> 8; o += nt * 256; ts += nt; }
        tab[48] = o; tab[64 + 48] = ts;
    }
    __syncthreads();
    if (t < 48) tab[192 + t] += tab[t];
    __syncthreads();
    const int ngroups = L ? (NLAT / 16) : (R / 16);
    const int nmine = (bid < ngroups) ? (((ngroups - 1 - bid) / nb + 1) * 16) : 0;
    if (t < nmine) {
        const int idx = (bid + (t >> 4) * nb) * 16 + (t & 15);
        const int r = L ? ((idx >> 12) * RPB + CTXL + (idx & 4095)) : idx;
        const float4 rec = p.RT[r];
        const int bucket = __float_as_int(rec.x);
        const int slot = atomicAdd(&tab[192 + bucket], 1);
        p.list[slot] = r; p.wl[slot] = rec.y; p.wh[slot] = rec.z; p.sor[r] = slot;
        rsrc[t] = r; rdst[t] = slot;
    }
    __syncthreads();
    for (int q0 = w; q0 < nmine; q0 += 64) {
        u32x4 v0[8], v1[8];
#pragma unroll
        for (int j = 0; j < 8; ++j) {
            const int q = q0 + j * 8;
            if (q < nmine) { const u32x4* src = (const u32x4*)(p.H + (size_t)rsrc[q] * D); v0[j] = src[lane]; v1[j] = src[lane + 64]; }
        }
#pragma unroll
        for (int j = 0; j < 8; ++j) {
            const int q = q0 + j * 8;
            if (q < nmine) { u32x4* dst = (u32x4*)(p.hs + (size_t)rdst[q] * D); dst[lane] = v0[j]; dst[lane + 64] = v1[j]; }
        }
    }
}
struct MoeSched {
    const bf16_t* hs; const bf16_t* wgu_t; const bf16_t* act; const bf16_t* wd_t; const int* tab; int K, ldb, ksplit, G, c, stage, ntiles;
    DEVINL bool next(int i, pg8::Unit& u) const {
        const int x = c & 7, rk = c >> 3, nper = G >> 3;
        const int t0 = (ntiles * x) >> 3, t1 = (ntiles * (x + 1)) >> 3;
        const int li = i * nper + rk;
        if (li >= (t1 - t0) * 4) return false;
        const int tile = t0 + (li >> 2), pn = li & 3;
        int bucket = 0;
        for (int b = 0; b < 48; ++b) if (tile >= tab[64 + b] && tile < tab[64 + b + 1]) bucket = b;
        bucket = sgpr(bucket);
        const int ti = tile - sgpr(tab[64 + bucket]);
        const int m0 = sgpr(tab[bucket]) + ti * 256;
        const int rem = sgpr(tab[128 + bucket]) - ti * 256;
        const int grp = bucket / 6, pair = bucket - grp * 6;
        const int lo = (pair < 3) ? 0 : (pair < 5 ? 1 : 2);
        const int hi = (pair < 3) ? (pair + 1) : (pair < 5 ? (pair - 1) : 3);
        const int ea = grp * 4 + lo, eb = grp * 4 + hi;
        u.pm = m0 >> 8; u.pn = pn; u.mvalid = rem < 256 ? rem : 256; u.aux = 0;
        if (stage == 1) {
            const int e = (pn >> 1) ? eb : ea;
            u.A = (const char*)(hs + (size_t)m0 * 1024);
            u.B0 = (const char*)(wgu_t + ((size_t)e * 512 + (pn & 1) * 256) * 1024); u.B1 = u.B0;
        } else {
            u.A = (const char*)(act + (size_t)m0 * 512);
            u.B0 = (const char*)(wd_t + ((size_t)ea * 1024 + pn * 256) * 256);
            u.B1 = (const char*)(wd_t + ((size_t)eb * 1024 + pn * 256) * 256) - (size_t)4 * 128;
        }
        return true;
    }
};
template <int L, int STAGE>
DEVINL void phase_moe(const Params& p, char* smem, int bid, int nb) {
    int* tab = (int*)(smem + MOE_TAB);
    moe_setup(p, L, tab);
    PG8_LAS unsigned char* lds = (PG8_LAS unsigned char*)smem;
    MoeSched S; S.hs = sgpr_ptr(p.hs); S.wgu_t = sgpr_ptr(p.wgu_t); S.act = sgpr_ptr(p.act); S.wd_t = sgpr_ptr(p.wd_t);
    S.tab = tab; S.G = sgpr(nb); S.c = sgpr(bid); S.stage = STAGE; S.ntiles = sgpr(tab[64 + 48]);
    if (STAGE == 1) { S.K = 1024; S.ldb = 1024; S.ksplit = 16; GEpiMoe1 e{sgpr_ptr(p.act), sgpr_ptr(p.wl), sgpr_ptr(p.wh)}; pg8::gemm_phase(lds, S, e); }
    else { S.K = 512; S.ldb = 256; S.ksplit = 4; GEpiY e{sgpr_ptr(p.y2)}; pg8::gemm_phase(lds, S, e); }
    __syncthreads();
}

template <int DK> struct RecL {
    static constexpr int QS = DK + 8;
    static constexpr int oQs = 0;
    static constexpr int oKs = oQs + 64 * QS * 2;
    static constexpr int oKt = oKs + 64 * QS * 2;
    static constexpr int oVt = oKt + DK * 72 * 2;
    static constexpr int oAt = oVt + 128 * 72 * 2;
    static constexpr int oSt = oAt + 64 * 72 * 2;
    static constexpr int oPart = oSt + 128 * 136 * 2;
    static constexpr int oEmid = oPart + 8 * 128 * 4;
    static constexpr int oEend = oEmid + 128 * 4;
    static constexpr int oAF = oEend + 128 * 4;
    static constexpr int oRed = oAF + 64 * 32 * 4;
    static constexpr int total = oRed + 64 * 2 * 4 + 128 * 4;
};
static_assert(RecL<128>::total <= LDS_BYTES, "rec lds");

template <bool GLA> struct RecCols {
    static constexpr int LDP = GLA ? 2048 : 5120;
    static constexpr int QOFF = 0;
    static constexpr int KOFF = 256;
    static constexpr int KF = 1024, KB = 2048;
    static constexpr int VOFF = GLA ? 512 : 3072;
    static constexpr int GOFF = GLA ? 1024 : 4096;
};
template <int DK, bool GLA> struct RecGeo {
    static constexpr int GC = GLA ? 4 : 8;
    static constexpr int NS = GLA ? 16 : 8;
    static constexpr int H = GLA ? 4 : 8;
    static constexpr int KT = DK / 16;
};

struct RawRegs { u32x4 q[2], k[2], v[2], af; };

template <int DK, bool GLA, int DIR, bool PASS3>
DEVINL void rec_load_raw(const Params& p, const bf16_t* __restrict__ P, int row0, int h, RawRegs& r) {
    using C = RecCols<GLA>; constexpr int LDP = C::LDP;
    const int t = tid_opaque();
    if (GLA) {
        const int row = t >> 3, c8 = (t & 7) * 8;
        const bf16_t* rp = P + (size_t)(row0 + row) * LDP + h * 64 + c8;
        if (PASS3) r.q[0] = *(const u32x4*)(rp + C::QOFF);
        r.k[0] = *(const u32x4*)(rp + C::KOFF);
        r.af = *(const u32x4*)(p.AF + (size_t)(row0 + row) * 32 + (t & 7) * 4);
    } else {
#pragma unroll
        for (int i = 0; i < 2; ++i) {
            const int row = (t >> 4) + i * 32, c8 = (t & 15) * 8;
            const bf16_t* rp = P + (size_t)(row0 + row) * LDP + h * 128 + c8;
            if (PASS3) r.q[i] = *(const u32x4*)(rp + C::QOFF);
            r.k[i] = *(const u32x4*)(rp + (DIR ? C::KB : C::KF));
        }
    }
#pragma unroll
    for (int i = 0; i < 2; ++i) {
        const int row = (t >> 4) + i * 32, c8 = (t & 15) * 8;
        r.v[i] = *(const u32x4*)(P + (size_t)(row0 + row) * LDP + C::VOFF + h * 128 + c8);
    }
}

template <int DK, bool GLA, int DIR, bool PASS3>
DEVINL void rec_prep(const Params& p, char* smem, const bf16_t* __restrict__ P, RawRegs& raw, bool has_next, int next_row0, int h,
                     const float (&a2c)[2][16], const float (&abv)[2], float (&bsum)[2]) {
    using L = RecL<DK>;
    constexpr int NCP = DK / 2, NSEG = NTHR / NCP, RS = 64 / NSEG, QS = L::QS;
    constexpr bool ref_end = !PASS3;
    bf16_t* Qs = (bf16_t*)(smem + L::oQs); bf16_t* Ks = (bf16_t*)(smem + L::oKs); bf16_t* Kt = (bf16_t*)(smem + L::oKt); bf16_t* Vt = (bf16_t*)(smem + L::oVt);
    bf16_t* Vraw = (bf16_t*)(smem + L::oSt);
    float* part = (float*)(smem + L::oPart); float* emid = (float*)(smem + L::oEmid); float* eend = (float*)(smem + L::oEend); float* AFs = (float*)(smem + L::oAF);
    const int t = tid_opaque();
    if (GLA) {
        const int row = t >> 3, c8 = (t & 7) * 8;
        if (PASS3) *(u32x4*)&Qs[row * QS + c8] = raw.q[0];
        *(u32x4*)&Ks[row * QS + c8] = raw.k[0];
        *(u32x4*)&AFs[row * 32 + (t & 7) * 4] = raw.af;
    } else {
#pragma unroll
        for (int i = 0; i < 2; ++i) {
            const int row = (t >> 4) + i * 32, c8 = (t & 15) * 8;
            if (PASS3) *(u32x4*)&Qs[row * QS + c8] = raw.q[i];
            *(u32x4*)&Ks[row * QS + c8] = raw.k[i];
        }
    }
#pragma unroll
    for (int i = 0; i < 2; ++i) { const int row = (t >> 4) + i * 32, c8 = (t & 15) * 8; *(u32x4*)&Vraw[row * 136 + c8] = raw.v[i]; }
    lds_sync();
    if (has_next) rec_load_raw<DK, GLA, DIR, PASS3>(p, P, next_row0, h, raw);
    const int cp = t % NCP, seg = t / NCP, c0 = cp * 2, l0 = seg * RS;
    float dv[RS][2];
    float kv[RS][2];
#pragma unroll
    for (int i = 0; i < RS; ++i) {
        const unsigned kr = *(const unsigned*)&Ks[(l0 + i) * QS + c0];
        if (GLA) {
            kv[i][0] = bf2f((bf16_t)(kr & 0xffffu)); kv[i][1] = bf2f((bf16_t)(kr >> 16));
            const float* ar = &AFs[(l0 + i) * 32 + DIR * 16];
            float s0 = abv[0], s1 = abv[1];
#pragma unroll
            for (int r = 0; r < 16; ++r) { const float av = ar[r]; s0 += av * a2c[0][r]; s1 += av * a2c[1][r]; }
            dv[i][0] = logsigmoidf_(s0) * 0.0625f; dv[i][1] = logsigmoidf_(s1) * 0.0625f;
        } else {
            kv[i][0] = h2f((unsigned short)(kr & 0xffffu)); kv[i][1] = h2f((unsigned short)(kr >> 16));
            dv[i][0] = 1.0f - kv[i][0]; dv[i][1] = 1.0f - kv[i][1];
        }
    }
    {
        float s0 = GLA ? 0.f : 1.f, s1 = GLA ? 0.f : 1.f;
#pragma unroll
        for (int i = 0; i < RS; ++i) { if (GLA) { s0 += dv[i][0]; s1 += dv[i][1]; } else { s0 *= dv[i][0]; s1 *= dv[i][1]; } }
        float2 pv; pv.x = s0; pv.y = s1;
        *(float2*)&part[seg * DK + c0] = pv;
    }
    lds_sync();
    float tot[2], base[2], mid[2];
#pragma unroll
    for (int c = 0; c < 2; ++c) { tot[c] = GLA ? 0.f : 1.f; base[c] = tot[c]; mid[c] = tot[c]; }
#pragma unroll
    for (int sg = 0; sg < NSEG; ++sg) {
        const float2 pv = *(const float2*)&part[sg * DK + c0];
        const bool before = (DIR == 0) ? (sg < seg) : (sg > seg);
        const bool firsthalf = (DIR == 0) ? (sg < NSEG / 2) : (sg >= NSEG / 2);
        if (GLA) { tot[0] += pv.x; tot[1] += pv.y; if (before) { base[0] += pv.x; base[1] += pv.y; } if (firsthalf) { mid[0] += pv.x; mid[1] += pv.y; } }
        else { tot[0] *= pv.x; tot[1] *= pv.y; if (before) { base[0] *= pv.x; base[1] *= pv.y; } if (firsthalf) { mid[0] *= pv.x; mid[1] *= pv.y; } }
    }
    float ref[2], iref[2];
#pragma unroll
    for (int c = 0; c < 2; ++c) { ref[c] = ref_end ? tot[c] : mid[c]; iref[c] = GLA ? 0.f : __builtin_amdgcn_rcpf(ref[c]); }
    if (seg == 0) {
#pragma unroll
        for (int c = 0; c < 2; ++c) {
            if (GLA) { emid[c0 + c] = __expf(ref[c]); eend[c0 + c] = __expf(tot[c] - ref[c]); bsum[c] += tot[c]; }
            else { emid[c0 + c] = ref[c]; eend[c0 + c] = tot[c] * iref[c]; bsum[c] += __logf(tot[c]); }
        }
    }
    unsigned short ktv[2][RS];
    float run[2] = {base[0], base[1]};
#pragma unroll
    for (int ii = 0; ii < RS; ++ii) {
        const int i = (DIR == 0) ? ii : (RS - 1 - ii);
        float ek[2], eq[2];
#pragma unroll
        for (int c = 0; c < 2; ++c) {
            if (GLA) { run[c] += dv[i][c]; ek[c] = __expf(ref[c] - run[c]); eq[c] = PASS3 ? __expf(run[c] - ref[c]) : 0.f; }
            else { run[c] *= dv[i][c]; ek[c] = ref[c] * __builtin_amdgcn_rcpf(run[c]); eq[c] = run[c] * iref[c]; }
        }
        const unsigned kp = cvt_pk_bf16(kv[i][0] * ek[0], kv[i][1] * ek[1]);
        ktv[0][i] = (unsigned short)(kp & 0xffffu); ktv[1][i] = (unsigned short)(kp >> 16);
        if (PASS3) {
            const int l = l0 + i;
            *(unsigned*)&Ks[l * QS + c0] = kp;
            const unsigned qr = *(const unsigned*)&Qs[l * QS + c0];
            *(unsigned*)&Qs[l * QS + c0] = cvt_pk_bf16(bf2f((bf16_t)(qr & 0xffffu)) * eq[0], bf2f((bf16_t)(qr >> 16)) * eq[1]);
        }
    }
#pragma unroll
    for (int c = 0; c < 2; ++c) {
        if (RS == 8) {
            u32x4 v;
            v.x = (unsigned)ktv[c][0] | ((unsigned)ktv[c][1] << 16); v.y = (unsigned)ktv[c][2] | ((unsigned)ktv[c][3] << 16);
            v.z = (unsigned)ktv[c][RS > 4 ? 4 : 0] | ((unsigned)ktv[c][RS > 4 ? 5 : 0] << 16); v.w = (unsigned)ktv[c][RS > 4 ? 6 : 0] | ((unsigned)ktv[c][RS > 4 ? 7 : 0] << 16);
            *(u32x4*)&Kt[(c0 + c) * 72 + l0] = v;
        } else {
            u32x2 v;
            v.x = (unsigned)ktv[c][0] | ((unsigned)ktv[c][1] << 16); v.y = (unsigned)ktv[c][2] | ((unsigned)ktv[c][3] << 16);
            *(u32x2*)&Kt[(c0 + c) * 72 + l0] = v;
        }
    }
    {
        const int vp = t & 63, vq = t >> 6;
        unsigned vr[8];
#pragma unroll
        for (int i = 0; i < 8; ++i) vr[i] = *(const unsigned*)&Vraw[(vq * 8 + i) * 136 + 2 * vp];
        u32x4 lo, hi;
        lo.x = (vr[0] & 0xffffu) | (vr[1] << 16); lo.y = (vr[2] & 0xffffu) | (vr[3] << 16); lo.z = (vr[4] & 0xffffu) | (vr[5] << 16); lo.w = (vr[6] & 0xffffu) | (vr[7] << 16);
        hi.x = (vr[0] >> 16) | (vr[1] & 0xffff0000u); hi.y = (vr[2] >> 16) | (vr[3] & 0xffff0000u); hi.z = (vr[4] >> 16) | (vr[5] & 0xffff0000u); hi.w = (vr[6] >> 16) | (vr[7] & 0xffff0000u);
        *(u32x4*)&Vt[(2 * vp) * 72 + vq * 8] = lo;
        *(u32x4*)&Vt[(2 * vp + 1) * 72 + vq * 8] = hi;
    }
    lds_sync();
}

DEVINL bf16x8 ldfrag(const bf16_t* base, int ld, int fr, int fq, int k0) { return *(const bf16x8*)(base + fr * ld + k0 + fq * 8); }

template <int DK, bool GLA, int DIR>
DEVINL void rec_load_a2(const Params& p, int h, float (&a2c)[2][16], float (&abv)[2]) {
#pragma unroll
    for (int c = 0; c < 2; ++c) { abv[c] = 0.f;
#pragma unroll
        for (int r = 0; r < 16; ++r) a2c[c][r] = 0.f; }
    if (GLA) {
        const int c0 = (tid_opaque() % (DK / 2)) * 2;
#pragma unroll
        for (int c = 0; c < 2; ++c) {
#pragma unroll
            for (int r = 0; r < 16; ++r) a2c[c][r] = p.gla_a2[(DIR * 16 + r) * 256 + h * 64 + c0 + c];
            abv[c] = p.gla_ab[DIR * 256 + h * 64 + c0 + c];
        }
    }
}

template <int DK, bool GLA, int DIR>
DEVINL void rec_pass1_unit(const Params& p, char* smem, const bf16_t* P, int b, int h, int cg, float* slots, float* decs) {
    using L = RecL<DK>; using G = RecGeo<DK, GLA>;
    constexpr int KT = G::KT;
    bf16_t* Kt = (bf16_t*)(smem + L::oKt); bf16_t* Vt = (bf16_t*)(smem + L::oVt); float* emid = (float*)(smem + L::oEmid);
    const int t = tid_opaque(), w = t >> 6, lane = t & 63, fr = lane & 15, fq = lane >> 4;
    float a2c[2][16], abv[2];
    rec_load_a2<DK, GLA, DIR>(p, h, a2c, abv);
    f32x4 accS[KT];
#pragma unroll
    for (int kt = 0; kt < KT; ++kt) accS[kt] = (f32x4){0.f, 0.f, 0.f, 0.f};
    float bsum[2] = {0.f, 0.f};
    const int nch = (cg == 0) ? 4 : G::GC;
    auto chunk_row0 = [&](int ci) { const int pc = (cg == 0) ? (DIR == 0 ? ci : 3 - ci) : (DIR == 0 ? (4 + (cg - 1) * G::GC + ci) : (67 - (cg - 1) * G::GC - ci)); return b * RPB + pc * 64; };
    RawRegs raw;
    rec_load_raw<DK, GLA, DIR, false>(p, P, chunk_row0(0), h, raw);
    for (int ci = 0; ci < nch; ++ci) {
        const bool has_next = ci + 1 < nch;
        rec_prep<DK, GLA, DIR, false>(p, smem, P, raw, has_next, has_next ? chunk_row0(ci + 1) : 0, h, a2c, abv, bsum);
        bf16x8 av[2];
#pragma unroll
        for (int ks = 0; ks < 2; ++ks) av[ks] = ldfrag(Vt + (w * 16) * 72, 72, fr, fq, ks * 32);
#pragma unroll
        for (int kt = 0; kt < KT; ++kt) {
            const f32x4 e4 = *(const f32x4*)&emid[kt * 16 + fq * 4];
            f32x4 c = accS[kt] * e4;
#pragma unroll
            for (int ks = 0; ks < 2; ++ks) c = __builtin_amdgcn_mfma_f32_16x16x32_bf16(ldfrag(Kt + (kt * 16) * 72, 72, fr, fq, ks * 32), av[ks], c, 0, 0, 0);
            accS[kt] = c;
        }
        lds_sync();
    }
    const size_t chain = ((size_t)(b * G::H + h) * 2 + DIR);
    float* sl = slots + (chain * G::NS + cg) * (size_t)(128 * DK);
#pragma unroll
    for (int kt = 0; kt < KT; ++kt) *(f32x4*)&sl[(w * 16 + fr) * DK + kt * 16 + fq * 4] = accS[kt];
    if (t < DK / 2) { decs[(chain * G::NS + cg) * DK + 2 * t] = bsum[0]; decs[(chain * G::NS + cg) * DK + 2 * t + 1] = bsum[1]; }
}

template <int DK, bool GLA, int DIR>
DEVINL void rec_pass3_chunk(const Params& p, char* smem, const bf16_t* P, bf16_t* CAT, int row0, int h, f32x4 (&accS)[DK / 16], const float* gnorm) {
    using L = RecL<DK>; using C = RecCols<GLA>;
    constexpr int KT = DK / 16, QS = L::QS, KS = DK / 32;
    bf16_t* Qs = (bf16_t*)(smem + L::oQs); bf16_t* Ks = (bf16_t*)(smem + L::oKs); bf16_t* Kt = (bf16_t*)(smem + L::oKt); bf16_t* Vt = (bf16_t*)(smem + L::oVt);
    bf16_t* At = (bf16_t*)(smem + L::oAt); bf16_t* St = (bf16_t*)(smem + L::oSt);
    float* emid = (float*)(smem + L::oEmid); float* eend = (float*)(smem + L::oEend); float* red = (float*)(smem + L::oRed);
    const int t = tid_opaque(), w = t >> 6, lane = t & 63, fr = lane & 15, fq = lane >> 4;
    u32x2 obv[4], gbv[4];
    if (DIR == 0) {
        const size_t prow = (size_t)(row0 + (w & 3) * 16 + fr);
        const bf16_t* cp0 = CAT + prow * 1024 + h * 128 + (w >> 2) * 64 + fq * 4;
        const bf16_t* gp0 = P + prow * C::LDP + C::GOFF + h * 128 + (w >> 2) * 64 + fq * 4;
#pragma unroll
        for (int n = 0; n < 4; ++n) { obv[n] = *(const u32x2*)(cp0 + n * 16); gbv[n] = *(const u32x2*)(gp0 + n * 16); }
    }
#pragma unroll
    for (int kt = 0; kt < KT; ++kt) {
        const f32x4 e4 = *(const f32x4*)&emid[kt * 16 + fq * 4];
        accS[kt] = accS[kt] * e4;
        *(u32x2*)&St[(w * 16 + fr) * QS + kt * 16 + fq * 4] = pk4(accS[kt]);
    }
    {
        const int lt = w >> 1, st0 = (w & 1) * 2;
        bf16x8 aq[KS];
#pragma unroll
        for (int ks = 0; ks < KS; ++ks) aq[ks] = ldfrag(Qs + (lt * 16) * QS, QS, fr, fq, ks * 32);
#pragma unroll
        for (int s2 = 0; s2 < 2; ++s2) {
            const int st = st0 + s2;
            f32x4 c = (f32x4){0.f, 0.f, 0.f, 0.f};
#pragma unroll
            for (int ks = 0; ks < KS; ++ks) c = __builtin_amdgcn_mfma_f32_16x16x32_bf16(ldfrag(Ks + (st * 16) * QS, QS, fr, fq, ks * 32), aq[ks], c, 0, 0, 0);
            const int l = lt * 16 + fr;
#pragma unroll
            for (int j = 0; j < 4; ++j) { const int sidx = st * 16 + fq * 4 + j; const bool keep = (DIR == 0) ? (sidx <= l) : (sidx >= l); c[j] = keep ? c[j] : 0.f; }
            *(u32x2*)&At[l * 72 + st * 16 + fq * 4] = pk4(c);
        }
    }
    lds_sync();
    const int lt = w & 3, vt0 = (w >> 2) * 4;
    f32x4 o[4];
    {
        bf16x8 aa[2], aq[KS];
#pragma unroll
        for (int ks = 0; ks < 2; ++ks) aa[ks] = ldfrag(At + (lt * 16) * 72, 72, fr, fq, ks * 32);
#pragma unroll
        for (int ks = 0; ks < KS; ++ks) aq[ks] = ldfrag(Qs + (lt * 16) * QS, QS, fr, fq, ks * 32);
#pragma unroll
        for (int n = 0; n < 4; ++n) {
            const int vt = vt0 + n;
            f32x4 c = (f32x4){0.f, 0.f, 0.f, 0.f};
#pragma unroll
            for (int ks = 0; ks < 2; ++ks) c = __builtin_amdgcn_mfma_f32_16x16x32_bf16(ldfrag(Vt + (vt * 16) * 72, 72, fr, fq, ks * 32), aa[ks], c, 0, 0, 0);
#pragma unroll
            for (int ks = 0; ks < KS; ++ks) c = __builtin_amdgcn_mfma_f32_16x16x32_bf16(ldfrag(St + (vt * 16) * QS, QS, fr, fq, ks * 32), aq[ks], c, 0, 0, 0);
            o[n] = c;
        }
    }
    {
        bf16x8 av[2];
#pragma unroll
        for (int ks = 0; ks < 2; ++ks) av[ks] = ldfrag(Vt + (w * 16) * 72, 72, fr, fq, ks * 32);
#pragma unroll
        for (int kt = 0; kt < KT; ++kt) {
            f32x4 c = accS[kt];
#pragma unroll
            for (int ks = 0; ks < 2; ++ks) c = __builtin_amdgcn_mfma_f32_16x16x32_bf16(ldfrag(Kt + (kt * 16) * 72, 72, fr, fq, ks * 32), av[ks], c, 0, 0, 0);
            const f32x4 e4 = *(const f32x4*)&eend[kt * 16 + fq * 4];
            accS[kt] = c * e4;
        }
    }
    const int l = lt * 16 + fr;
    const size_t row = (size_t)(row0 + l);
    bf16_t* cp = CAT + row * 1024 + h * 128 + vt0 * 16 + fq * 4;
    if (DIR == 1) {
#pragma unroll
        for (int n = 0; n < 4; ++n) *(u32x2*)(cp + n * 16) = pk4(o[n]);
    } else {
        float ss = 0.f;
#pragma unroll
        for (int n = 0; n < 4; ++n) {
            const u32x2 ob = obv[n];
            o[n][0] += bf2f((bf16_t)(ob.x & 0xffff)); o[n][1] += bf2f((bf16_t)(ob.x >> 16));
            o[n][2] += bf2f((bf16_t)(ob.y & 0xffff)); o[n][3] += bf2f((bf16_t)(ob.y >> 16));
            ss += o[n][0] * o[n][0] + o[n][1] * o[n][1] + o[n][2] * o[n][2] + o[n][3] * o[n][3];
        }
        ss += __shfl_xor(ss, 16);
        ss += __shfl_xor(ss, 32);
        if (fq == 0) red[l * 2 + (w >> 2)] = ss;
        lds_sync();
        const float tot = red[l * 2] + red[l * 2 + 1];
        const float rstd = rsqrtf(tot * (1.0f / 128.0f) + EPS);
#pragma unroll
        for (int n = 0; n < 4; ++n) {
            const u32x2 gb = gbv[n];
            const f32x4 gn = *(const f32x4*)(gnorm + vt0 * 16 + n * 16 + fq * 4);
            f32x4 gv;
            gv[0] = bf2f((bf16_t)(gb.x & 0xffff)); gv[1] = bf2f((bf16_t)(gb.x >> 16)); gv[2] = bf2f((bf16_t)(gb.y & 0xffff)); gv[3] = bf2f((bf16_t)(gb.y >> 16));
            f32x4 r4;
#pragma unroll
            for (int j = 0; j < 4; ++j) { const float g = GLA ? siluf_(gv[j]) : gv[j]; r4[j] = o[n][j] * rstd * gn[j] * g; }
            *(u32x2*)(cp + n * 16) = pk4(r4);
        }
    }
    lds_sync();
}

template <int DK, bool GLA, int DIR>
DEVINL void rec_pass3_sweep(const Params& p, char* smem, const bf16_t* P, bf16_t* CAT, int b, int h, int c_lo, int nch, int slot, const float* slots, const float* gnorm) {
    using G = RecGeo<DK, GLA>;
    constexpr int KT = G::KT;
    const int t = tid_opaque(), w = t >> 6, lane = t & 63, fr = lane & 15, fq = lane >> 4;
    float a2c[2][16], abv[2];
    rec_load_a2<DK, GLA, DIR>(p, h, a2c, abv);
    f32x4 accS[KT];
    if (slot >= 0) {
        const size_t chain = ((size_t)(b * G::H + h) * 2 + DIR);
        const float* sl = slots + (chain * G::NS + slot) * (size_t)(128 * DK);
#pragma unroll
        for (int kt = 0; kt < KT; ++kt) accS[kt] = *(const f32x4*)&sl[(w * 16 + fr) * DK + kt * 16 + fq * 4];
    } else {
#pragma unroll
        for (int kt = 0; kt < KT; ++kt) accS[kt] = (f32x4){0.f, 0.f, 0.f, 0.f};
    }
    float bsum[2] = {0.f, 0.f};
    float* gn_lds = (float*)(smem + RecL<DK>::oRed + 64 * 2 * 4);
    if (DIR == 0) { if (t < 128) gn_lds[t] = gnorm[t]; }
    auto chunk_row0 = [&](int ci) { const int pc = (DIR == 0) ? (c_lo + ci) : (c_lo + nch - 1 - ci); return b * RPB + pc * 64; };
    RawRegs raw;
    rec_load_raw<DK, GLA, DIR, true>(p, P, chunk_row0(0), h, raw);
    for (int ci = 0; ci < nch; ++ci) {
        const bool has_next = ci + 1 < nch;
        rec_prep<DK, GLA, DIR, true>(p, smem, P, raw, has_next, has_next ? chunk_row0(ci + 1) : 0, h, a2c, abv, bsum);
        rec_pass3_chunk<DK, GLA, DIR>(p, smem, P, CAT, chunk_row0(ci), h, accS, gn_lds);
    }
}

template <int DK, bool GLA>
DEVINL void rec_pass3_unit(const Params& p, char* smem, const bf16_t* P, bf16_t* CAT, int b, int h, int gi, const float* slots, const float* gnorm) {
    using G = RecGeo<DK, GLA>;
    int c_lo, nch, slot_f, slot_b;
    if (GLA) {
        if (gi == 0) { c_lo = 0; nch = 4; slot_f = -1; slot_b = -1; }
        else { const int pg = gi - 1; c_lo = 4 + pg * G::GC; nch = G::GC; slot_f = pg; slot_b = G::NS - 1 - pg; }
    } else { const int pg = gi; c_lo = 4 + pg * G::GC; nch = G::GC; slot_f = pg; slot_b = G::NS - 1 - pg; }
    rec_pass3_sweep<DK, GLA, 1>(p, smem, P, CAT, b, h, c_lo, nch, slot_b, slots, gnorm);
    asm volatile("s_waitcnt vmcnt(0)" ::: "memory");
    rec_pass3_sweep<DK, GLA, 0>(p, smem, P, CAT, b, h, c_lo, nch, slot_f, slots, gnorm);
}

template <int DK, bool GLA>
DEVINL void rec_scan(float* slots, const float* decs, int bid, int nb) {
    using G = RecGeo<DK, GLA>;
    constexpr int NCHAIN = NBATCH * G::H * 2, PER = 128 * DK / 4;
    const int total = NCHAIN * PER;
    for (int i = bid * NTHR + tid_opaque(); i < total; i += nb * NTHR) {
        const int chain = i / PER, e = i - chain * PER;
        const int k4 = (e * 4) % DK;
        f32x4 run = (f32x4){0.f, 0.f, 0.f, 0.f};
#pragma unroll 1
        for (int s0 = 0; s0 < G::NS; s0 += 8) {
            f32x4 a[8], d4[8];
#pragma unroll
            for (int j = 0; j < 8; ++j) {
                d4[j] = *(const f32x4*)&decs[((size_t)chain * G::NS + s0 + j) * DK + k4];
                a[j] = *(const f32x4*)(slots + ((size_t)chain * G::NS + s0 + j) * (size_t)(128 * DK) + (size_t)e * 4);
            }
#pragma unroll
            for (int j = 0; j < 8; ++j) {
#pragma unroll
                for (int q = 0; q < 4; ++q) run[q] = __expf(d4[j][q]) * run[q] + a[j][q];
                *(f32x4*)(slots + ((size_t)chain * G::NS + s0 + j) * (size_t)(128 * DK) + (size_t)e * 4) = run;
            }
        }
    }
}

DEVINL size_t s5_idx(int b, int di, int pc, int g, int pp) { return ((((size_t)(b * 2 + di) * NCH + pc) * 32 + g) * 64 + pp) * 2; }

constexpr int S5_BU_LD = 20;
constexpr int S5_WAVE_LDS = 128 * S5_BU_LD * 4 + 16 * 136 * 2;
static_assert(8 * S5_WAVE_LDS <= LDS_BYTES, "s5 lds");

DEVINL void s5_load_afr(const Params& p, int row0, int g, int fr, int fq, bf16x8 (&afr)[4]) {
    const bf16x8 z = (bf16x8){0, 0, 0, 0, 0, 0, 0, 0};
#pragma unroll
    for (int sb = 0; sb < 4; ++sb) afr[sb] = (fq < 2) ? *(const bf16x8*)(p.P + (size_t)(row0 + sb * 16 + fr) * 2048 + 1536 + g * 16 + fq * 8) : z;
}
DEVINL void s5_load_bfr(const Params& p, int di, int g, int fr, int fq, bf16x8 (&bfr)[8]) {
    const bf16x8 z = (bf16x8){0, 0, 0, 0, 0, 0, 0, 0};
#pragma unroll
    for (int nt = 0; nt < 8; ++nt) bfr[nt] = (fq < 2) ? *(const bf16x8*)(p.bbm + ((size_t)((di * 32 + g) * 128 + nt * 16 + fr)) * 16 + fq * 8) : z;
}
DEVINL void s5_bu_subblock(float* BuT, const bf16x8& a, const bf16x8 (&bfr)[8], int fr, int fq) {
#pragma unroll
    for (int nt = 0; nt < 8; ++nt) {
        f32x4 c = (f32x4){0.f, 0.f, 0.f, 0.f};
        c = __builtin_amdgcn_mfma_f32_16x16x32_bf16(a, bfr[nt], c, 0, 0, 0);
        *(f32x4*)&BuT[(nt * 16 + fr) * S5_BU_LD + fq * 4] = c;
    }
}
template <int DIR, bool XS>
DEVINL void s5_scan16(const float* BuT, bf16_t* Xs, int lane, float are, float aim, float& xr, float& xi) {
    f32x4 br[4], bi[4];
#pragma unroll
    for (int q = 0; q < 4; ++q) { br[q] = *(const f32x4*)&BuT[lane * S5_BU_LD + q * 4]; bi[q] = *(const f32x4*)&BuT[(64 + lane) * S5_BU_LD + q * 4]; }
#pragma unroll
    for (int tt = 0; tt < 16; ++tt) {
        const int tl = DIR ? (15 - tt) : tt;
        const float nr = are * xr - aim * xi + br[tl >> 2][tl & 3], ni = are * xi + aim * xr + bi[tl >> 2][tl & 3];
        xr = nr; xi = ni;
        if (XS) { const unsigned pkd = cvt_pk_bf16(xr, xi); Xs[tl * 136 + lane] = (bf16_t)(pkd & 0xffffu); Xs[tl * 136 + 64 + lane] = (bf16_t)(pkd >> 16); }
    }
}
template <int DIR>
DEVINL void s5_pass1_task(const Params& p, float* BuT, int b, int pc, int g, const bf16x8 (&afr)[4], int lane, int fr, int fq) {
    bf16x8 bfr[8];
    s5_load_bfr(p, DIR, g, fr, fq, bfr);
    const float are = p.atab[((DIR * 32 + g) * 64 + lane) * 2], aim = p.atab[((DIR * 32 + g) * 64 + lane) * 2 + 1];
    float xr = 0.f, xi = 0.f;
#pragma unroll
    for (int sbi = 0; sbi < 4; ++sbi) {
        const int sb = DIR ? (3 - sbi) : sbi;
        s5_bu_subblock(BuT, afr[sb], bfr, fr, fq);
        asm volatile("s_waitcnt lgkmcnt(0)" ::: "memory");
        s5_scan16<DIR, false>(BuT, nullptr, lane, are, aim, xr, xi);
        asm volatile("s_waitcnt lgkmcnt(0)" ::: "memory");
    }
    float* o = p.s5xend + s5_idx(b, DIR, pc, g, lane);
    o[0] = xr; o[1] = xi;
}
DEVINL void s5_pass1_unit(const Params& p, char* smem, int b, int pc, int half) {
    const int t = tid_opaque(), w = t >> 6, lane = t & 63, fr = lane & 15, fq = lane >> 4;
    float* BuT = (float*)(smem + w * S5_WAVE_LDS);
    const int row0 = b * RPB + pc * 64;
#pragma unroll 1
    for (int q = 0; q < 2; ++q) {
        const int g = half * 16 + w * 2 + q;
        bf16x8 afr[4];
        s5_load_afr(p, row0, g, fr, fq, afr);
        s5_pass1_task<0>(p, BuT, b, pc, g, afr, lane, fr, fq);
        s5_pass1_task<1>(p, BuT, b, pc, g, afr, lane, fr, fq);
    }
}
DEVINL void s5_scan(const Params& p, int bid, int nb) {
    for (int i = bid * NTHR + tid_opaque(); i < NBATCH * 2 * 32 * 64; i += nb * NTHR) {
        const int pp = i & 63, g = (i >> 6) & 31, di = (i >> 11) & 1, b = i >> 12;
        const float ar = p.a64tab[((di * 32 + g) * 64 + pp) * 2], ai = p.a64tab[((di * 32 + g) * 64 + pp) * 2 + 1];
        float cr = 0.f, ci = 0.f;
#pragma unroll 1
        for (int c0 = 0; c0 < NCH; c0 += 17) {
            float er[17], ei[17];
#pragma unroll
            for (int j = 0; j < 17; ++j) {
                const int ch = c0 + j, pc = di ? (ch < 4 ? 3 - ch : 71 - ch) : ch;
                const size_t ix = s5_idx(b, di, pc, g, pp);
                er[j] = p.s5xend[ix]; ei[j] = p.s5xend[ix + 1];
            }
#pragma unroll
            for (int j = 0; j < 17; ++j) {
                const int ch = c0 + j, pc = di ? (ch < 4 ? 3 - ch : 71 - ch) : ch;
                const size_t ix = s5_idx(b, di, pc, g, pp);
                p.s5carry[ix] = cr; p.s5carry[ix + 1] = ci;
                const float nr = ar * cr - ai * ci + er[j], ni = ar * ci + ai * cr + ei[j];
                cr = nr; ci = ni;
            }
        }
    }
}
template <int DIR>
DEVINL void s5_pass3_task(const Params& p, float* BuT, bf16_t* Xs, int b, int pc, int g, const bf16x8 (&afr)[4], f32x4 (&acc)[4], int lane, int fr, int fq) {
    bf16x8 bfr[8];
    s5_load_bfr(p, DIR, g, fr, fq, bfr);
    bf16x8 cb[4];
#pragma unroll
    for (int ks = 0; ks < 4; ++ks) cb[ks] = *(const bf16x8*)(p.cmt + ((size_t)(g * 16 + fr)) * 256 + DIR * 128 + ks * 32 + fq * 8);
    const float are = p.atab[((DIR * 32 + g) * 64 + lane) * 2], aim = p.atab[((DIR * 32 + g) * 64 + lane) * 2 + 1];
    const size_t cix = s5_idx(b, DIR, pc, g, lane);
    float xr = p.s5carry[cix], xi = p.s5carry[cix + 1];
#pragma unroll
    for (int sbi = 0; sbi < 4; ++sbi) {
        const int sb = DIR ? (3 - sbi) : sbi;
        s5_bu_subblock(BuT, afr[sb], bfr, fr, fq);
        asm volatile("s_waitcnt lgkmcnt(0)" ::: "memory");
        s5_scan16<DIR, true>(BuT, Xs, lane, are, aim, xr, xi);
        asm volatile("s_waitcnt lgkmcnt(0)" ::: "memory");
        f32x4 c = acc[sb];
#pragma unroll
        for (int ks = 0; ks < 4; ++ks) {
            const bf16x8 a = *(const bf16x8*)(Xs + fr * 136 + ks * 32 + fq * 8);
            c = __builtin_amdgcn_mfma_f32_16x16x32_bf16(cb[ks], a, c, 0, 0, 0);
        }
        acc[sb] = c;
        asm volatile("s_waitcnt lgkmcnt(0)" ::: "memory");
    }
}
DEVINL void s5_pass3_unit(const Params& p, char* smem, int b, int pc, int half) {
    const int t = tid_opaque(), w = t >> 6, lane = t & 63, fr = lane & 15, fq = lane >> 4;
    float* BuT = (float*)(smem + w * S5_WAVE_LDS);
    bf16_t* Xs = (bf16_t*)(smem + w * S5_WAVE_LDS + 128 * S5_BU_LD * 4);
    const int row0 = b * RPB + pc * 64;
#pragma unroll 1
    for (int q = 0; q < 2; ++q) {
        const int g = half * 16 + w * 2 + q;
        bf16x8 afr[4];
        s5_load_afr(p, row0, g, fr, fq, afr);
        f32x4 acc[4];
#pragma unroll
        for (int sb = 0; sb < 4; ++sb) acc[sb] = (f32x4){0.f, 0.f, 0.f, 0.f};
        s5_pass3_task<1>(p, BuT, Xs, b, pc, g, afr, acc, lane, fr, fq);
        s5_pass3_task<0>(p, BuT, Xs, b, pc, g, afr, acc, lane, fr, fq);
        const f32x4 d4 = *(const f32x4*)(p.s5_d + g * 16 + fq * 4);
#pragma unroll
        for (int sb = 0; sb < 4; ++sb) {
            const int tok = sb * 16 + fr;
            const u32x2 ub = *(const u32x2*)(p.P + (size_t)(row0 + tok) * 2048 + 1536 + g * 16 + fq * 4);
            f32x4 uv; uv[0] = bf2f((bf16_t)(ub.x & 0xffff)); uv[1] = bf2f((bf16_t)(ub.x >> 16)); uv[2] = bf2f((bf16_t)(ub.y & 0xffff)); uv[3] = bf2f((bf16_t)(ub.y >> 16));
            f32x4 r4;
#pragma unroll
            for (int j = 0; j < 4; ++j) r4[j] = gelu_tanh(acc[sb][j] + d4[j] * uv[j]);
            *(u32x2*)(p.s5a + (size_t)(row0 + tok) * 512 + g * 16 + fq * 4) = pk4(r4);
        }
    }
}

struct UnitQueue {
    int* counter; int* slot; int total, nb, u, pend;
    DEVINL void init(int* counter_, char* smem, int total_, int bid, int nb_) {
        counter = counter_; slot = (int*)(smem + LDS_BYTES - 64); total = total_; nb = nb_; u = sgpr(bid); pend = 0;
        if (tid_opaque() == 0) pend = atomicAdd(counter, 1) + nb;
    }
    DEVINL bool valid() const { return u < total; }
    DEVINL void advance() {
        if (tid_opaque() == 0) { *slot = pend; pend = atomicAdd(counter, 1) + nb; }
        lds_sync();
        u = sgpr(*slot);
        lds_sync();
    }
};

DEVINL void phase_prologue(const Params& p, char* smem, int bid, int nb) {
    UnitQueue Q; Q.init(p.cnt + 242, smem, T0_END, bid, nb);
    for (; Q.valid(); Q.advance()) prologue_task(p, smem, Q.u);
}

template <int LAYER>
DEVINL void phase_rec1(const Params& p, char* smem, int bid, int nb) {
    if (LAYER == 0) {
        constexpr int NG = 8 * 4 * 2 * 16;
        constexpr int NS5 = NBATCH * NCH * 2;
        UnitQueue Q; Q.init(p.cnt + 240, smem, NG + NS5, bid, nb);
        for (; Q.valid(); Q.advance()) {
            const int u = Q.u;
            if (u < NG) {
                const int cg = u & 15, dir = (u >> 4) & 1, h = (u >> 5) & 3, b = u >> 7;
                if (dir == 0) rec_pass1_unit<64, true, 0>(p, smem, p.P, b, h, cg, p.gslots, p.gdecs);
                else rec_pass1_unit<64, true, 1>(p, smem, p.P, b, h, cg, p.gslots, p.gdecs);
            } else { const int v = u - NG; s5_pass1_unit(p, smem, (v >> 1) / NCH, (v >> 1) % NCH, v & 1); }
        }
    } else {
        constexpr int NG = 8 * 8 * 2 * 8;
        for (int u = bid; u < NG; u += nb) {
            const int cg = u & 7, dir = (u >> 3) & 1, h = (u >> 4) & 7, b = u >> 7;
            if (dir == 0) rec_pass1_unit<128, false, 0>(p, smem, p.P, b, h, cg, p.hslots, p.hdecs);
            else rec_pass1_unit<128, false, 1>(p, smem, p.P, b, h, cg, p.hslots, p.hdecs);
        }
    }
}
template <int LAYER>
DEVINL void phase_scan(const Params& p, char* smem, int bid, int nb) {
    if (LAYER == 0) { rec_scan<64, true>(p.gslots, p.gdecs, bid, nb); s5_scan(p, bid, nb); }
    else rec_scan<128, false>(p.hslots, p.hdecs, bid, nb);
}
template <int LAYER>
DEVINL void phase_rec3(const Params& p, char* smem, int bid, int nb) {
    if (LAYER == 0) {
        constexpr int NG = 8 * 4 * 17;
        constexpr int NS5 = NBATCH * NCH * 2;
        UnitQueue Q; Q.init(p.cnt + 241, smem, NG + NS5, bid, nb);
        for (; Q.valid(); Q.advance()) {
            const int u = Q.u;
            if (u < NG) { const int gi = u % 17, h = (u / 17) & 3, b = u / 68; rec_pass3_unit<64, true>(p, smem, p.P, p.H, b, h, gi, p.gslots, p.gla_norm); }
            else { const int v = u - NG; s5_pass3_unit(p, smem, (v >> 1) / NCH, (v >> 1) % NCH, v & 1); }
        }
    } else {
        constexpr int NG = 8 * 8 * 8;
        for (int u = bid; u < NG; u += nb) { const int gi = u & 7, h = (u >> 3) & 7, b = u >> 6; rec_pass3_unit<128, false>(p, smem, p.P, p.H, b, h, gi, p.hslots, p.hg_norm); }
    }
}

DEVINL void phase_final(const Params& p, int bid, int nb) {
    const int t = tid_opaque(), w = t >> 6, lane = t & 63;
    f32x4 gn[4];
#pragma unroll
    for (int i = 0; i < 4; ++i) gn[i] = *(const f32x4*)(p.final_norm + lane * 4 + i * 256);
    for (int rg = bid; rg < NLAT / 16; rg += nb) {
        const int i0 = rg * 16 + w * 2, b = i0 >> 12;
        const float* gatev = p.mod + ((size_t)(9 + b)) * 6144 + 5120;
        f32x4 v[2][4], gu[4]; u32x2 ub[2][4];
#pragma unroll
        for (int rw = 0; rw < 2; ++rw) {
            const int i = i0 + rw;
            const int slot = p.sor[(i >> 12) * RPB + CTXL + (i & 4095)];
            const float* res = p.out + (size_t)i * D;
#pragma unroll
            for (int q = 0; q < 4; ++q) { v[rw][q] = *(const f32x4*)(res + lane * 4 + q * 256); ub[rw][q] = *(const u32x2*)(p.y2 + (size_t)slot * D + lane * 4 + q * 256); }
        }
#pragma unroll
        for (int q = 0; q < 4; ++q) gu[q] = *(const f32x4*)(gatev + lane * 4 + q * 256);
#pragma unroll
        for (int rw = 0; rw < 2; ++rw) {
            float* res = p.out + (size_t)(i0 + rw) * D;
            float ss = 0.f;
#pragma unroll
            for (int q = 0; q < 4; ++q) {
                const u32x2 u = ub[rw][q];
                v[rw][q][0] += gu[q][0] * bf2f((bf16_t)(u.x & 0xffffu)); v[rw][q][1] += gu[q][1] * bf2f((bf16_t)(u.x >> 16));
                v[rw][q][2] += gu[q][2] * bf2f((bf16_t)(u.y & 0xffffu)); v[rw][q][3] += gu[q][3] * bf2f((bf16_t)(u.y >> 16));
                ss += v[rw][q][0] * v[rw][q][0] + v[rw][q][1] * v[rw][q][1] + v[rw][q][2] * v[rw][q][2] + v[rw][q][3] * v[rw][q][3];
            }
#pragma unroll
            for (int o = 32; o >= 1; o >>= 1) ss += __shfl_xor(ss, o);
            const float rstd = rsqrtf(ss * (1.0f / 1024.0f) + EPS);
#pragma unroll
            for (int q = 0; q < 4; ++q) *(f32x4*)(res + lane * 4 + q * 256) = v[rw][q] * rstd * gn[q];
        }
    }
}

constexpr int NPHASE = 23;
constexpr int MEGA_LDS = LDS_BYTES + 16 + 1024;
static_assert(sizeof(Params) <= 1024 && sizeof(Params) % 8 == 0, "params block");
template <int PH>
DEVINL void run_phase(const Params& p, char* smem, int bid, int nb) {
    if (PH == 0) phase_prologue(p, smem, bid, nb);
    if (PH == 1) phase_pre<0>(p, smem, bid, nb);
    if (PH == 2) phase_gemm<0>(p, smem, bid, nb);
    if (PH == 3) phase_rec1<0>(p, smem, bid, nb);
    if (PH == 4) phase_scan<0>(p, smem, bid, nb);
    if (PH == 5) phase_rec3<0>(p, smem, bid, nb);
    if (PH == 6) phase_gemm<1>(p, smem, bid, nb);
    if (PH == 7) phase_gemm<2>(p, smem, bid, nb);
    if (PH == 8) phase_pre<1>(p, smem, bid, nb);
    if (PH == 9) phase_list<0>(p, smem, bid, nb);
    if (PH == 10) phase_moe<0, 1>(p, smem, bid, nb);
    if (PH == 11) phase_moe<0, 2>(p, smem, bid, nb);
    if (PH == 12) phase_pre<2>(p, smem, bid, nb);
    if (PH == 13) phase_gemm<3>(p, smem, bid, nb);
    if (PH == 14) phase_rec1<1>(p, smem, bid, nb);
    if (PH == 15) phase_scan<1>(p, smem, bid, nb);
    if (PH == 16) phase_rec3<1>(p, smem, bid, nb);
    if (PH == 17) phase_gemm<4>(p, smem, bid, nb);
    if (PH == 18) phase_pre<3>(p, smem, bid, nb);
    if (PH == 19) phase_list<1>(p, smem, bid, nb);
    if (PH == 20) phase_moe<1, 1>(p, smem, bid, nb);
    if (PH == 21) phase_moe<1, 2>(p, smem, bid, nb);
    if (PH == 22) phase_final(p, bid, nb);
}

extern __shared__ __attribute__((aligned(16))) char dyn_smem[];

#if ONE_LAUNCH
template <int PH> struct PhaseSeq {
    static DEVINL void run(const Params& p, char* smem, const XcdBarrier& bar) {
        PhaseSeq<PH - 1>::run(p, smem, bar);
        xcd_barrier(bar);
        run_phase<PH>(p, smem, (int)blockIdx.x, (int)gridDim.x);
#ifdef DUP_MASK
        if ((DUP_MASK >> PH) & 1) { xcd_barrier(bar); run_phase<PH>(p, smem, (int)blockIdx.x, (int)gridDim.x); }
#endif
    }
};
template <> struct PhaseSeq<0> {
    static DEVINL void run(const Params& p, char* smem, const XcdBarrier& bar) {
        run_phase<0>(p, smem, (int)blockIdx.x, (int)gridDim.x);
#ifdef DUP_MASK
        if (DUP_MASK & 1) { xcd_barrier(bar); run_phase<0>(p, smem, (int)blockIdx.x, (int)gridDim.x); }
#endif
    }
};
__global__ void __launch_bounds__(NTHR, 2) mega_kernel(Params p) {
    volatile LAS unsigned* st = (volatile LAS unsigned*)(dyn_smem + LDS_BYTES);
    if (threadIdx.x == 0) { st[0] = 0u; st[1] = 0u; st[2] = 0u; st[3] = 0u; }
    __syncthreads();
    XcdBarrier bar = xcd_barrier_post(p.bar, st);
    PhaseSeq<NPHASE - 1>::run(p, dyn_smem, bar);
}
#else
template <int PH>
__global__ void __launch_bounds__(NTHR, 2) phase_kernel(Params p) {
    run_phase<PH>(p, dyn_smem, (int)blockIdx.x, (int)gridDim.x);
}
template <int PH> struct Launcher {
    static void go(const Params& p, int grid, hipStream_t s) {
        Launcher<PH - 1>::go(p, grid, s);
        static bool attr = false;
        if (!attr) { hipFuncSetAttribute((const void*)phase_kernel<PH>, hipFuncAttributeMaxDynamicSharedMemorySize, LDS_BYTES + 16); attr = true; }
        phase_kernel<PH><<<grid, NTHR, LDS_BYTES + 16, s>>>(p);
    }
};
template <> struct Launcher<-1> { static void go(const Params&, int, hipStream_t) {} };
#endif

static size_t align_up(size_t v, size_t a) { return (v + a - 1) / a * a; }

extern "C" void kernel_launch(void* const* d_in, const int* in_sizes, int n_in, void* d_out, int out_size, void* d_ws, size_t ws_size, hipStream_t stream) {
    (void)in_sizes; (void)n_in; (void)out_size;
    Params p;
    memset(&p, 0, sizeof(p));
    const float* const* in = (const float* const*)d_in;
    p.x = in[0]; p.c = in[1]; p.ctx = in[2]; p.c_ctx = in[3]; p.ada_w = in[4]; p.ada_b = in[5]; p.norm_mix = in[6]; p.norm_ffn = in[7];
    p.ab_w_in = in[8]; p.ab_w_out = in[9]; p.gla_a2 = in[10]; p.gla_ab = in[11]; p.gla_norm = in[12];
    p.s5_lam_re = in[13]; p.s5_lam_im = in[14]; p.s5_log_dt = in[15]; p.s5_b_re = in[16]; p.s5_b_im = in[17]; p.s5_c_re = in[18]; p.s5_c_im = in[19];
    p.s5_d = in[20]; p.glu_w = in[21]; p.glu_b = in[22]; p.hg_w_in = in[23]; p.hg_w_out = in[24]; p.hg_lb = in[25]; p.hg_norm = in[26];
    p.router_w = in[27]; p.router_bias = in[28]; p.moe_wg = in[29]; p.moe_wu = in[30]; p.moe_wd = in[31]; p.final_norm = in[32];
    p.out = (float*)d_out;

    char* ws = (char*)d_ws;
    size_t o = 0;
    auto take = [&](size_t bytes) { char* r = ws + o; o = align_up(o + bytes, 256); return r; };
    p.bar = (unsigned*)take(XCD_BAR_WORDS * 4);
    p.cnt = (int*)take(256 * 4);
    p.mod = (float*)take((size_t)2 * 9 * 6144 * 4);
    p.pos = (float*)take(64 * 512 * 4);
    p.lb = (float*)take(1024 * 4);
    p.atab = (float*)take(2 * 32 * 64 * 2 * 4);
    p.a64tab = (float*)take(2 * 32 * 64 * 2 * 4);
    p.cmt = (bf16_t*)take((size_t)32 * 16 * 256 * 2);
    p.bbm = (bf16_t*)take((size_t)2 * 32 * 128 * 16 * 2);
    p.wrt = (bf16_t*)take((size_t)2 * 2 * 32 * 1024 * 2);
    p.RT = (float4*)take((size_t)R * 16);
    p.list = (int*)take((size_t)ACT_ROWS * 4);
    p.wl = (float*)take((size_t)ACT_ROWS * 4);
    p.wh = (float*)take((size_t)ACT_ROWS * 4);
    p.cx = (float*)take((size_t)NBATCH * CTXL * D * 4);
    p.sor = (int*)take((size_t)R * 4);
    p.blkcnt = (int*)take((size_t)2 * 256 * 48 * 4);
    p.wt_in0 = (bf16_t*)take((size_t)2048 * 1024 * 2);
    p.wt_out0 = (bf16_t*)take((size_t)1024 * 1024 * 2);
    p.glu_t = (bf16_t*)take((size_t)512 * 512 * 2);
    p.wt_in1 = (bf16_t*)take((size_t)5120 * 1024 * 2);
    p.wt_out1 = (bf16_t*)take((size_t)1024 * 1024 * 2);
    p.H = (bf16_t*)take((size_t)R * 1024 * 2);
    const size_t big = o;
    p.P = (bf16_t*)(ws + big);
    size_t o0 = big + (size_t)R * 2048 * 2;
    auto take0 = [&](size_t bytes) { char* r = ws + o0; o0 = align_up(o0 + bytes, 256); return r; };
    p.gslots = (float*)take0((size_t)64 * 16 * 128 * 64 * 4);
    p.gdecs = (float*)take0((size_t)64 * 16 * 64 * 4);
    p.s5xend = (float*)take0((size_t)NBATCH * 2 * NCH * 32 * 64 * 2 * 4);
    p.s5carry = (float*)take0((size_t)NBATCH * 2 * NCH * 32 * 64 * 2 * 4);
    p.s5a = (bf16_t*)take0((size_t)R * 512 * 2);
    p.AF = (float*)take0((size_t)R * 32 * 4);
    p.wgu_t = (bf16_t*)take0((size_t)32 * 512 * 1024 * 2);
    p.wd_t = (bf16_t*)take0((size_t)32 * 1024 * 256 * 2);
    p.hs = (bf16_t*)(ws + big);
    p.Y = (bf16_t*)(ws + big);
    p.y2 = (bf16_t*)(ws + big);
    p.act = (bf16_t*)(ws + big + (size_t)ACT_ROWS * 1024 * 2);
    if (big + (size_t)ACT_ROWS * 1024 * 2 + (size_t)ACT_ROWS * 512 * 2 > (size_t)((char*)p.s5a - ws)) fprintf(stderr, "moe overlay overlaps live buffers\n");
    size_t o1 = big + (size_t)R * 5120 * 2;
    auto take1 = [&](size_t bytes) { char* r = ws + o1; o1 = align_up(o1 + bytes, 256); return r; };
    p.hslots = (float*)take1((size_t)128 * 8 * 128 * 128 * 4);
    p.hdecs = (float*)take1((size_t)128 * 8 * 128 * 4);
    const size_t need = o0 > o1 ? o0 : o1;
    if (need > ws_size) fprintf(stderr, "workspace too small: need %zu have %zu\n", need, ws_size);

    const int grid = 256;
#if ONE_LAUNCH
    static bool attr = false;
    if (!attr) { hipFuncSetAttribute((const void*)mega_kernel, hipFuncAttributeMaxDynamicSharedMemorySize, MEGA_LDS); attr = true; }
    hipMemsetAsync(p.bar, 0, XCD_BAR_WORDS * 4 + 256 * 4, stream);
    mega_kernel<<<grid, NTHR, MEGA_LDS, stream>>>(p);
#else
    Launcher<NPHASE - 1>::go(p, grid, stream);
#endif
}
```

```cpp
#include <hip/hip_runtime.h>
#include <stdint.h>
#include <string.h>
#include <stdio.h>

#ifndef ONE_LAUNCH
#define ONE_LAUNCH 1
#endif

typedef unsigned short bf16_t;
typedef short bf16x8 __attribute__((ext_vector_type(8)));
typedef float f32x4 __attribute__((ext_vector_type(4)));
typedef unsigned u32x4 __attribute__((ext_vector_type(4)));
typedef unsigned u32x2 __attribute__((ext_vector_type(2)));
#define DEVINL __device__ __forceinline__

constexpr int D = 1024, NBATCH = 8, SEQ = 4096, CTXL = 256;
constexpr int RPB = SEQ + CTXL;
constexpr int R = NBATCH * RPB;
constexpr int NLAT = NBATCH * SEQ;
constexpr int NCH = RPB / 64;
constexpr float EPS = 1e-6f;
constexpr int NTHR = 512;
constexpr int LDS_BYTES = 136 * 1024;
constexpr int ACT_ROWS = 47104;

#define XB_TMO      128
#define XB_XCNT(j)  (256  + 64 * (j))
#define XB_XSUB(j)  (1280 + 64 * (j))
#define XB_XGEN(j)  (2304 + 64 * (j))
#define XB_TOP      3328
#define XB_TOPGEN   3392
#define XCD_BAR_WORDS 3456
#define XB_SPIN_CAP (1u << 18)
#define LAS __attribute__((address_space(3)))

__device__ __forceinline__ unsigned xb_ld(unsigned* p)              { return __hip_atomic_load(p, __ATOMIC_RELAXED, __HIP_MEMORY_SCOPE_AGENT); }
__device__ __forceinline__ unsigned xb_add(unsigned* p, unsigned v) { return __hip_atomic_fetch_add(p, v, __ATOMIC_RELAXED, __HIP_MEMORY_SCOPE_AGENT); }
__device__ __forceinline__ unsigned xb_xcc_id() { return (unsigned)__builtin_amdgcn_s_getreg((3 << 11) | 20) & 0xFu; }
#define XB_SPIN(cond, bar) do { unsigned _sp = 0; while (cond) { __builtin_amdgcn_s_sleep(1); \
    if ((++_sp & 255u) == 0u) { if (xb_ld(&(bar)[XB_TMO])) break; if (_sp > XB_SPIN_CAP) { atomicAdd(&(bar)[XB_TMO], 1u); break; } } } } while (0)

struct XcdBarrier {
    unsigned* bar; unsigned x;
    volatile LAS unsigned* st;
};
__device__ __forceinline__ XcdBarrier xcd_barrier_post(unsigned* bar, volatile LAS unsigned* st) {
    XcdBarrier b; b.bar = bar; b.x = xb_xcc_id(); b.st = st;
    if (threadIdx.x == 0) (void)xb_add(&bar[XB_XCNT(b.x)], 1u);
    return b;
}
__device__ __forceinline__ void xcd_barrier_complete(unsigned* bar, unsigned x, unsigned& nloc, unsigned& nx) {
    const unsigned G = gridDim.x * gridDim.y * gridDim.z;
    unsigned sum, cnt, mine, sp = 0u;
    for (;;) {
        sum = 0u; cnt = 0u; mine = 0u;
#pragma unroll
        for (unsigned j = 0; j < 16; ++j) { const unsigned c = xb_ld(&bar[XB_XCNT(j)]); sum += c; cnt += (c > 0u) ? 1u : 0u; mine = (j == x) ? c : mine; }
        if (sum == G) break;
        __builtin_amdgcn_s_sleep(1);
        if ((++sp & 255u) == 0u) { if (xb_ld(&bar[XB_TMO])) break; if (sp > XB_SPIN_CAP) { atomicAdd(&bar[XB_TMO], 1u); break; } }
    }
    nloc = mine > 0u ? mine : 1u; nx = cnt > 0u ? cnt : 1u;
}
__device__ __forceinline__ void xcd_barrier(const XcdBarrier& b) {
    asm volatile("s_waitcnt vmcnt(0)" ::: "memory");
    __syncthreads();
    if (threadIdx.x == 0) {
        unsigned* bar = b.bar;
        __builtin_amdgcn_s_waitcnt(0);
        unsigned nloc = b.st[0], nx = b.st[1];
        if (nloc == 0u) { xcd_barrier_complete(bar, b.x, nloc, nx); b.st[0] = nloc; b.st[1] = nx; }
        const unsigned old = xb_add(&bar[XB_XSUB(b.x)], 1u);
        const unsigned gen = old / nloc;
        if (old + 1u == (gen + 1u) * nloc) {
            __builtin_amdgcn_fence(__ATOMIC_RELEASE, "agent");
            asm volatile("s_waitcnt vmcnt(0)" ::: "memory");
            const unsigned og = xb_add(&bar[XB_TOP], 1u);
            const unsigned tg = og / nx;
            if (og + 1u == (tg + 1u) * nx) xb_add(&bar[XB_TOPGEN], 1u);
            else XB_SPIN(xb_ld(&bar[XB_TOPGEN]) == tg, bar);
            __builtin_amdgcn_fence(__ATOMIC_ACQUIRE, "agent");
            xb_add(&bar[XB_XGEN(b.x)], 1u);
            asm volatile("s_waitcnt vmcnt(0)" ::: "memory");
        } else {
            XB_SPIN(xb_ld(&bar[XB_XGEN(b.x)]) == gen, bar);
            __builtin_amdgcn_fence(__ATOMIC_ACQUIRE, "agent");
            asm volatile("s_waitcnt vmcnt(0)" ::: "memory");
        }
    }
    __syncthreads();
}

struct Params {
    const float *x, *c, *ctx, *c_ctx, *ada_w, *ada_b, *norm_mix, *norm_ffn, *ab_w_in, *ab_w_out, *gla_a2, *gla_ab, *gla_norm;
    const float *s5_lam_re, *s5_lam_im, *s5_log_dt, *s5_b_re, *s5_b_im, *s5_c_re, *s5_c_im, *s5_d, *glu_w, *glu_b;
    const float *hg_w_in, *hg_w_out, *hg_lb, *hg_norm, *router_w, *router_bias, *moe_wg, *moe_wu, *moe_wd, *final_norm;
    float* out;
    unsigned* bar;
    int* qheads;
    int* cnt;
    float *mod, *pos, *lb, *atab, *a64tab;
    bf16_t* cmt; bf16_t* bbm; bf16_t* wrt;
    float4* RT;
    int* list; float *wl, *wh;
    float* cx;
    bf16_t* Y; bf16_t* y2;
    int* sor; int* blkcnt;
    bf16_t *wt_in0, *wt_out0, *glu_t, *wt_in1, *wt_out1;
    bf16_t* H;
    bf16_t* P;
    float *gslots, *gdecs;
    float *s5xend, *s5carry;
    bf16_t* s5a;
    bf16_t *wgu_t, *wd_t, *act, *hs;
    float* AF;
    float *hslots, *hdecs;
};

DEVINL int tid_opaque() { int t = threadIdx.x; asm volatile("" : "+v"(t)); return t; }
DEVINL void lds_sync() { asm volatile("s_waitcnt lgkmcnt(0)" ::: "memory"); __builtin_amdgcn_s_barrier(); asm volatile("" ::: "memory"); }

DEVINL int sgpr(int v) { return __builtin_amdgcn_readfirstlane(v); }
template <class T> DEVINL T* sgpr_ptr(T* ptr) {
    const unsigned long long v = (unsigned long long)ptr;
    const unsigned lo = (unsigned)__builtin_amdgcn_readfirstlane((int)(unsigned)v), hi = (unsigned)__builtin_amdgcn_readfirstlane((int)(unsigned)(v >> 32));
    return (T*)(__attribute__((address_space(1))) T*)(((unsigned long long)hi << 32) | lo);
}
DEVINL unsigned cvt_pk_bf16(float lo, float hi) { unsigned r; asm volatile("v_cvt_pk_bf16_f32 %0, %1, %2" : "=v"(r) : "v"(lo), "v"(hi)); return r; }
DEVINL float bf2f(bf16_t v) { return __uint_as_float(((unsigned)v) << 16); }
DEVINL bf16_t f2bf(float f) { unsigned u = __float_as_uint(f); u += 0x7fffu + ((u >> 16) & 1u); return (bf16_t)(u >> 16); }
DEVINL unsigned pk2(float lo, float hi) { return cvt_pk_bf16(lo, hi); }
DEVINL u32x2 pk4(f32x4 v) { u32x2 r; r.x = pk2(v[0], v[1]); r.y = pk2(v[2], v[3]); return r; }
DEVINL float h2f(unsigned short v) { return (float)__builtin_bit_cast(_Float16, v); }
DEVINL unsigned short f2h(float f) { return __builtin_bit_cast(unsigned short, (_Float16)f); }
DEVINL float sigmoidf_(float x) { return __builtin_amdgcn_rcpf(1.0f + __expf(-x)); }
DEVINL float siluf_(float x) { return x * sigmoidf_(x); }
DEVINL float logsigmoidf_(float x) { return fminf(x, 0.0f) - __logf(1.0f + __expf(-fabsf(x))); }
DEVINL float gelu_tanh(float y) { float z = 0.7978845608028654f * (y + 0.044715f * y * y * y); float th = 1.0f - 2.0f * __builtin_amdgcn_rcpf(__expf(2.0f * z) + 1.0f); return 0.5f * y * (1.0f + th); }
DEVINL float* resid_row(const Params& p, int r) {
    const int b = r / RPB, j = r - b * RPB;
    return (j < CTXL) ? (p.cx + (size_t)(b * CTXL + j) * D) : (p.out + (size_t)(b * SEQ + (j - CTXL)) * D);
}
DEVINL int row_batch_mod(int r) { const int b = r / RPB, j = r - b * RPB; return (j < CTXL) ? 8 : b; }

template <int K>
DEVINL f32x4 mma_lds(f32x4 c, const bf16_t* A, int lda, const bf16_t* Bt, int ldb, int fr, int fq) {
#pragma unroll
    for (int k0 = 0; k0 < K; k0 += 32) {
        const bf16x8 a = *(const bf16x8*)(A + fr * lda + k0 + fq * 8);
        const bf16x8 b = *(const bf16x8*)(Bt + fr * ldb + k0 + fq * 8);
        c = __builtin_amdgcn_mfma_f32_16x16x32_bf16(b, a, c, 0, 0, 0);
    }
    return c;
}

DEVINL void cvt_tile(const float* colp, int ld, int k0, int n0, bf16_t* dst, int ldd, char* smem, int lrow = -1) {
    float (*T)[257] = (float (*)[257])smem;
    const int t = tid_opaque(), nl = lrow >= 0 ? lrow : (t & 63), ks = t >> 6;
    const float* sp = colp + (size_t)(k0 + ks * 32) * ld;
#pragma unroll
    for (int i0 = 0; i0 < 32; i0 += 16) {
        float v[16];
#pragma unroll
        for (int i = 0; i < 16; ++i) v[i] = sp[(size_t)(i0 + i) * ld];
#pragma unroll
        for (int i = 0; i < 16; ++i) T[nl][ks * 32 + i0 + i] = v[i];
    }
    __syncthreads();
    const int n2 = t >> 3, kc = t & 7;
#pragma unroll
    for (int j = 0; j < 4; ++j) {
        const int k = j * 64 + kc * 8;
        u32x4 v;
        v.x = pk2(T[n2][k + 0], T[n2][k + 1]); v.y = pk2(T[n2][k + 2], T[n2][k + 3]);
        v.z = pk2(T[n2][k + 4], T[n2][k + 5]); v.w = pk2(T[n2][k + 6], T[n2][k + 7]);
        *(u32x4*)(dst + (size_t)(n0 + n2) * ldd + k0 + k) = v;
    }
    __syncthreads();
}

constexpr int NT_GU = 1024, NT_WD = 512;
DEVINL void moe_cvt_task(const Params& p, int layer, int tid, char* smem) {
    if (tid < NT_GU) {
        const int e = tid >> 5, rem = tid & 31, nb = rem >> 2, kb = rem & 3;
        const float* wg = p.moe_wg + (size_t)(layer * 32 + e) * 1024 * 256;
        const float* wu = p.moe_wu + (size_t)(layer * 32 + e) * 1024 * 256;
        const int nl = tid_opaque() & 63, isup = nl >> 5, ul = nl & 31;
        const int ub = (nb >> 2) * 128 + (nb & 3) * 32;
        const float* cp = (isup ? wu : wg) + ub + ul;
        const int lrow = (ul >> 2) * 8 + isup * 4 + (ul & 3);
        cvt_tile(cp, 256, kb * 256, nb * 64, p.wgu_t + (size_t)e * 512 * 1024, 1024, smem, lrow);
    } else {
        const int t2 = tid - NT_GU, e = t2 >> 4, nb = t2 & 15;
        const float* wd = p.moe_wd + (size_t)(layer * 32 + e) * 256 * 1024;
        cvt_tile(wd + nb * 64 + (tid_opaque() & 63), 1024, 0, nb * 64, p.wd_t + (size_t)e * 1024 * 256, 256, smem);
    }
}

constexpr int NT_MISC = 9, NT_MOD = 192, NT_IN0 = 128, NT_OUT0 = 64, NT_GLU = 16, NT_IN1 = 320, NT_OUT1 = 64, NT_POS = 64, NT_S5 = 64;
constexpr int T0_MOD = NT_MISC, T0_IN0 = T0_MOD + NT_MOD, T0_OUT0 = T0_IN0 + NT_IN0, T0_GLU = T0_OUT0 + NT_OUT0, T0_IN1 = T0_GLU + NT_GLU, T0_OUT1 = T0_IN1 + NT_IN1,
              T0_MOE = T0_OUT1 + NT_OUT1, T0_POS = T0_MOE + NT_GU + NT_WD, T0_S5 = T0_POS + NT_POS, T0_END = T0_S5 + NT_S5;

DEVINL void prologue_task(const Params& p, char* smem, int task) {
    const int t = tid_opaque();
    {
        if (task < T0_MOD) {
            if (task == 0) {
                for (int i = t; i < 1024; i += NTHR) p.lb[i] = sigmoidf_(p.hg_lb[1024 + i] - p.hg_lb[i]);
            } else {
                for (int i = (task - 1) * 8192 + t; i < task * 8192; i += NTHR) {
                    const int which = i >> 15, e = (i >> 10) & 31, k = i & 1023;
                    const float v = which ? p.ab_w_in[(size_t)k * 2080 + 1536 + e] : p.router_w[k * 32 + e];
                    const bf16_t hi = f2bf(v); const bf16_t lo = f2bf(v - bf2f(hi));
                    p.wrt[((size_t)(which * 2 + 0) * 32 + e) * 1024 + k] = hi;
                    p.wrt[((size_t)(which * 2 + 1) * 32 + e) * 1024 + k] = lo;
                }
            }
        } else if (task < T0_IN0) {
            float* sc = (float*)smem;
            float* red = sc + 9 * 1024;
            for (int i = t; i < 9 * 1024; i += NTHR) { const int rr = i >> 10, k = i & 1023; const float v = rr < 8 ? p.c[rr * 1024 + k] : p.c_ctx[k]; sc[i] = siluf_(v); }
            __syncthreads();
            const int tk = task - T0_MOD, l = tk / 96, c0 = (tk % 96) * 64, col = t & 63, kp = t >> 6;
            const float* wp = p.ada_w + ((size_t)l * 1024 + kp * 128) * 6144 + c0 + col;
            float acc[9];
#pragma unroll
            for (int rr = 0; rr < 9; ++rr) acc[rr] = 0.f;
#pragma unroll 1
            for (int k = 0; k < 128; k += 16) {
                float w16[16];
#pragma unroll
                for (int j = 0; j < 16; ++j) w16[j] = wp[(size_t)(k + j) * 6144];
#pragma unroll
                for (int rr = 0; rr < 9; ++rr) {
#pragma unroll
                    for (int j = 0; j < 16; j += 4) {
                        const f32x4 s4 = *(const f32x4*)&sc[rr * 1024 + kp * 128 + k + j];
                        acc[rr] += s4[0] * w16[j] + s4[1] * w16[j + 1] + s4[2] * w16[j + 2] + s4[3] * w16[j + 3];
                    }
                }
            }
#pragma unroll
            for (int rr = 0; rr < 9; ++rr) red[(kp * 9 + rr) * 64 + col] = acc[rr];
            __syncthreads();
            for (int o = t; o < 576; o += NTHR) {
                const int rr = o >> 6, cc = o & 63;
                float sv = p.ada_b[l * 6144 + c0 + cc];
#pragma unroll
                for (int q = 0; q < 8; ++q) sv += red[(q * 9 + rr) * 64 + cc];
                p.mod[((size_t)l * 9 + rr) * 6144 + c0 + cc] = sv;
            }
            __syncthreads();
        } else if (task < T0_OUT0) {
            const int tt = task - T0_IN0, nbk = tt >> 2, kb = tt & 3;
            const int n = nbk * 64 + (t & 63);
            const float* cp = p.ab_w_in + (n < 1536 ? n : n + 32);
            cvt_tile(cp, 2080, kb * 256, nbk * 64, p.wt_in0, 1024, smem);
        } else if (task < T0_GLU) {
            const int tt = task - T0_OUT0, nbk = tt >> 2, kb = tt & 3;
            cvt_tile(p.ab_w_out + nbk * 64 + (t & 63), 1024, kb * 256, nbk * 64, p.wt_out0, 1024, smem);
        } else if (task < T0_IN1) {
            const int tt = task - T0_GLU, nbk = tt >> 1, kb = tt & 1;
            cvt_tile(p.glu_w + nbk * 64 + (t & 63), 512, kb * 256, nbk * 64, p.glu_t, 512, smem);
        } else if (task < T0_OUT1) {
            const int tt = task - T0_IN1, nbk = tt >> 2, kb = tt & 3;
            cvt_tile(p.hg_w_in + nbk * 64 + (t & 63), 5120, kb * 256, nbk * 64, p.wt_in1, 1024, smem);
        } else if (task < T0_MOE) {
            const int tt = task - T0_OUT1, nbk = tt >> 2, kb = tt & 3;
            cvt_tile(p.hg_w_out + nbk * 64 + (t & 63), 1024, kb * 256, nbk * 64, p.wt_out1, 1024, smem);
        } else if (task < T0_POS) {
            moe_cvt_task(p, 0, task - T0_MOE, smem);
        } else if (task < T0_S5) {
            const int pi = task - T0_POS;
            const int j = t, jj = j & 255;
            const float omega = __expf(-9.210340371976184f * (float)jj * (1.0f / 256.0f));
            const float ang = (float)pi * omega;
            p.pos[pi * 512 + j] = (j < 256) ? sinf(ang) : cosf(ang);
        } else {
            const int tt = task - T0_S5, di = tt >> 5, g = tt & 31;
            const int pp = t & 63, hs = t >> 6;
            const float dt = __expf(p.s5_log_dt[di * 32 + g]);
            const float lr = p.s5_lam_re[(di * 32 + g) * 64 + pp], li = p.s5_lam_im[(di * 32 + g) * 64 + pp];
            const float mag = __expf(lr * dt);
            const float are = mag * cosf(li * dt), aim = mag * sinf(li * dt);
            const float den = lr * lr + li * li;
            const float fre = ((are - 1.0f) * lr + aim * li) / den;
            const float fim = (aim * lr - (are - 1.0f) * li) / den;
            if (hs == 0) {
                p.atab[((di * 32 + g) * 64 + pp) * 2 + 0] = are; p.atab[((di * 32 + g) * 64 + pp) * 2 + 1] = aim;
                float xr = are, xi = aim;
#pragma unroll
                for (int q = 0; q < 6; ++q) { const float nr = xr * xr - xi * xi, ni = 2.0f * xr * xi; xr = nr; xi = ni; }
                p.a64tab[((di * 32 + g) * 64 + pp) * 2 + 0] = xr; p.a64tab[((di * 32 + g) * 64 + pp) * 2 + 1] = xi;
            }
#pragma unroll
            for (int q = 0; q < 2; ++q) {
                const int h = hs * 2 + q;
                const float bre = p.s5_b_re[((size_t)((di * 32 + g) * 64 + pp)) * 16 + h], bim = p.s5_b_im[((size_t)((di * 32 + g) * 64 + pp)) * 16 + h];
                p.bbm[((size_t)((di * 32 + g) * 128 + pp)) * 16 + h] = f2bf(fre * bre - fim * bim);
                p.bbm[((size_t)((di * 32 + g) * 128 + 64 + pp)) * 16 + h] = f2bf(fre * bim + fim * bre);
                const float cre = p.s5_c_re[((size_t)((di * 32 + g) * 16 + h)) * 64 + pp], cim = p.s5_c_im[((size_t)((di * 32 + g) * 16 + h)) * 64 + pp];
                bf16_t* cm = p.cmt + ((size_t)(g * 16 + h)) * 256 + di * 128;
                cm[2 * pp] = f2bf(cre); cm[2 * pp + 1] = f2bf(-cim);
            }
        }
    }
}

constexpr int PRE_LD = 1028;
template <int MODE>
DEVINL void phase_pre(const Params& p, char* smem, int bid, int nb) {
    constexpr bool GEMV = (MODE == 0 || MODE == 1 || MODE == 3);
    constexpr int L = (MODE >= 2) ? 1 : 0;
    constexpr bool FFN = (MODE == 1 || MODE == 3);
    float* hrow = (float*)smem;
    float* part = hrow + 16 * PRE_LD;
    float* logit = part + 8 * 16 * 32;
    int* lcnt = (int*)(logit + 512);
    static_assert((16 * PRE_LD + 8 * 16 * 32 + 512 + 64) * 4 <= LDS_BYTES, "pre lds");
    const int t = tid_opaque(), w = t >> 6, lane = t & 63, fr = lane & 15, fq = lane >> 4;
    bf16x8 bh[4][2], bl[4][2];
    if (GEMV) {
        const bf16_t* wt = p.wrt + (size_t)(MODE == 0 ? 1 : 0) * 2 * 32 * 1024;
#pragma unroll
        for (int ks = 0; ks < 4; ++ks)
#pragma unroll
            for (int nt = 0; nt < 2; ++nt) {
                const size_t off = (size_t)(nt * 16 + fr) * 1024 + w * 128 + ks * 32 + fq * 8;
                bh[ks][nt] = *(const bf16x8*)(wt + off);
                bl[ks][nt] = *(const bf16x8*)(wt + 32 * 1024 + off);
            }
    }
    if (FFN) { if (t < 64) lcnt[t] = 0; }
    __syncthreads();
    const float* gain = (FFN ? p.norm_ffn : p.norm_mix) + L * 1024;
    const int ngroups = (MODE == 3) ? (NLAT / 16) : (R / 16);
    constexpr bool UPD_ROW = (MODE == 1 || MODE == 3);
    constexpr bool UPD_SLOT = (MODE == 2);
    auto row_of = [&](int rg, int rw) { const int i = rg * 16 + w * 2 + rw; return (MODE == 3) ? ((i >> 12) * RPB + CTXL + (i & 4095)) : i; };
    auto load_rows = [&](int rg, f32x4 (&vv)[2][4], u32x2 (&uu)[2][4], int (&ss)[2]) {
#pragma unroll
        for (int rw = 0; rw < 2; ++rw) {
            const int r = row_of(rg, rw);
            const int b = r / RPB, j = r - b * RPB;
            const bool isctx = j < CTXL;
            const float* src;
            if (MODE == 0) src = isctx ? (p.ctx + (size_t)(b * CTXL + j) * D) : (p.x + (size_t)(b * SEQ + (j - CTXL)) * D);
            else src = isctx ? (p.cx + (size_t)(b * CTXL + j) * D) : (p.out + (size_t)(b * SEQ + (j - CTXL)) * D);
#pragma unroll
            for (int i = 0; i < 4; ++i) vv[rw][i] = *(const f32x4*)(src + lane * 4 + i * 256);
            if (UPD_ROW) {
#pragma unroll
                for (int i = 0; i < 4; ++i) uu[rw][i] = *(const u32x2*)(p.Y + (size_t)r * D + lane * 4 + i * 256);
            }
            if (UPD_SLOT) ss[rw] = p.sor[r];

        }
    };
    f32x4 g4[4];
#pragma unroll
    for (int i = 0; i < 4; ++i) g4[i] = *(const f32x4*)(gain + lane * 4 + i * 256);
    for (int rg = bid; rg < ngroups; rg += nb) {
        f32x4 vcur[2][4]; u32x2 ucur[2][4]; int scur[2] = {0, 0};
        load_rows(rg, vcur, ucur, scur);
        if (UPD_SLOT) {
#pragma unroll
            for (int rw = 0; rw < 2; ++rw)
#pragma unroll
                for (int i = 0; i < 4; ++i) ucur[rw][i] = *(const u32x2*)(p.y2 + (size_t)scur[rw] * D + lane * 4 + i * 256);
        }
        f32x4 sh4[4], sc4[4], gu4[4], pe[2][4];
        {
            const int r0 = row_of(rg, 0);
            const int b0 = r0 / RPB, j0 = r0 - b0 * RPB;
            const int mb = (j0 < CTXL) ? 8 : b0;
            const float* modv = p.mod + ((size_t)(L * 9 + mb)) * 6144 + (FFN ? 3072 : 0);
            const float* gatev = p.mod + ((size_t)((MODE == 3 ? 1 : 0) * 9 + mb)) * 6144 + (MODE == 2 ? 5120 : 2048);
#pragma unroll
            for (int i = 0; i < 4; ++i) {
                const int c = lane * 4 + i * 256;
                sh4[i] = *(const f32x4*)(modv + c); sc4[i] = *(const f32x4*)(modv + 1024 + c);
                if (MODE != 0) gu4[i] = *(const f32x4*)(gatev + c);
            }
            if (MODE == 0) {
#pragma unroll
                for (int rw = 0; rw < 2; ++rw) {
                    const int j = j0 + rw;
                    const int n = (j < CTXL) ? 0 : (j - CTXL), prow = n >> 6, pcol = n & 63;
#pragma unroll
                    for (int i = 0; i < 4; ++i) {
                        const int c = lane * 4 + i * 256;
                        pe[rw][i] = (c < 512) ? *(const f32x4*)(p.pos + prow * 512 + c) : *(const f32x4*)(p.pos + pcol * 512 + (c - 512));
                    }
                }
            }
        }
#pragma unroll
        for (int rw = 0; rw < 2; ++rw) {
            const int lrow = w * 2 + rw;
            const int r = row_of(rg, rw);
            const int b = r / RPB, j = r - b * RPB;
            const bool isctx = j < CTXL;
            float* res = isctx ? (p.cx + (size_t)(b * CTXL + j) * D) : (p.out + (size_t)(b * SEQ + (j - CTXL)) * D);
            f32x4 v[4];
#pragma unroll
            for (int i = 0; i < 4; ++i) v[i] = vcur[rw][i];
            if (MODE == 0) {
                if (!isctx) {
#pragma unroll
                    for (int i = 0; i < 4; ++i) v[i] += pe[rw][i];
                }
            } else if ((UPD_ROW && !(MODE == 1 && isctx)) || UPD_SLOT) {
#pragma unroll
                for (int i = 0; i < 4; ++i) {
                    const u32x2 ub = ucur[rw][i];
                    v[i][0] += gu4[i][0] * bf2f((bf16_t)(ub.x & 0xffffu)); v[i][1] += gu4[i][1] * bf2f((bf16_t)(ub.x >> 16));
                    v[i][2] += gu4[i][2] * bf2f((bf16_t)(ub.y & 0xffffu)); v[i][3] += gu4[i][3] * bf2f((bf16_t)(ub.y >> 16));
                }
            }
#pragma unroll
            for (int i = 0; i < 4; ++i) *(f32x4*)(res + lane * 4 + i * 256) = v[i];
            float ss = 0.f;
#pragma unroll
            for (int i = 0; i < 4; ++i) ss += v[i][0] * v[i][0] + v[i][1] * v[i][1] + v[i][2] * v[i][2] + v[i][3] * v[i][3];
#pragma unroll
            for (int o = 32; o >= 1; o >>= 1) ss += __shfl_xor(ss, o);
            const float rstd = rsqrtf(ss * (1.0f / 1024.0f) + EPS);
#pragma unroll
            for (int i = 0; i < 4; ++i) {
                const int c = lane * 4 + i * 256;
                f32x4 hv;
#pragma unroll
                for (int q = 0; q < 4; ++q) hv[q] = v[i][q] * rstd * g4[i][q] * (1.0f + sc4[i][q]) + sh4[i][q];
                *(u32x2*)(p.H + (size_t)r * D + c) = pk4(hv);
                if (GEMV) *(f32x4*)(hrow + lrow * PRE_LD + c) = hv;
            }
        }
        if (GEMV) {
            lds_sync();
            f32x4 c0 = (f32x4){0.f, 0.f, 0.f, 0.f}, c1 = c0;
#pragma unroll
            for (int ks = 0; ks < 4; ++ks) {
                const float* hp = hrow + fr * PRE_LD + w * 128 + ks * 32 + fq * 8;
                const f32x4 x0 = *(const f32x4*)hp, x1 = *(const f32x4*)(hp + 4);
                u32x4 hi, lo;
                hi.x = cvt_pk_bf16(x0[0], x0[1]); hi.y = cvt_pk_bf16(x0[2], x0[3]); hi.z = cvt_pk_bf16(x1[0], x1[1]); hi.w = cvt_pk_bf16(x1[2], x1[3]);
                lo.x = cvt_pk_bf16(x0[0] - __uint_as_float(hi.x << 16), x0[1] - __uint_as_float(hi.x & 0xffff0000u));
                lo.y = cvt_pk_bf16(x0[2] - __uint_as_float(hi.y << 16), x0[3] - __uint_as_float(hi.y & 0xffff0000u));
                lo.z = cvt_pk_bf16(x1[0] - __uint_as_float(hi.z << 16), x1[1] - __uint_as_float(hi.z & 0xffff0000u));
                lo.w = cvt_pk_bf16(x1[2] - __uint_as_float(hi.w << 16), x1[3] - __uint_as_float(hi.w & 0xffff0000u));
                const bf16x8 ah = __builtin_bit_cast(bf16x8, hi), al = __builtin_bit_cast(bf16x8, lo);
                c0 = __builtin_amdgcn_mfma_f32_16x16x32_bf16(bh[ks][0], ah, c0, 0, 0, 0);
                c0 = __builtin_amdgcn_mfma_f32_16x16x32_bf16(bl[ks][0], ah, c0, 0, 0, 0);
                c0 = __builtin_amdgcn_mfma_f32_16x16x32_bf16(bh[ks][0], al, c0, 0, 0, 0);
                c1 = __builtin_amdgcn_mfma_f32_16x16x32_bf16(bh[ks][1], ah, c1, 0, 0, 0);
                c1 = __builtin_amdgcn_mfma_f32_16x16x32_bf16(bl[ks][1], ah, c1, 0, 0, 0);
                c1 = __builtin_amdgcn_mfma_f32_16x16x32_bf16(bh[ks][1], al, c1, 0, 0, 0);
            }
            *(f32x4*)&part[(w * 16 + fr) * 32 + fq * 4] = c0;
            *(f32x4*)&part[(w * 16 + fr) * 32 + 16 + fq * 4] = c1;
            lds_sync();
            {
                const int row = t >> 5, e2 = t & 31;
                float s = 0.f;
#pragma unroll
                for (int q = 0; q < 8; ++q) s += part[(q * 16 + row) * 32 + e2];
                if (MODE == 0) p.AF[(size_t)(rg * 16 + row) * 32 + e2] = s;
                else logit[row * 32 + e2] = s;
            }
            if (FFN) {
                lds_sync();
                if (t < 16) {
                    int rr;
                    if (MODE == 3) { const int i = rg * 16 + t; rr = (i >> 12) * RPB + CTXL + (i & 4095); } else rr = rg * 16 + t;
                    float best = -3.0e38f; int bg = 0, bi1 = 0, bi2 = 1; float ba1 = 0.f, ba2 = 0.f;
#pragma unroll 1
                    for (int g = 0; g < 8; ++g) {
                        float m1 = -3.0e38f, m2 = -3.0e38f, a1 = 0.f, a2 = 0.f; int i1 = 0, i2 = 0;
#pragma unroll
                        for (int e = 0; e < 4; ++e) {
                            const float a = sigmoidf_(logit[t * 32 + g * 4 + e]);
                            const float sv = a + p.router_bias[g * 4 + e];
                            if (sv > m1) { m2 = m1; i2 = i1; a2 = a1; m1 = sv; i1 = e; a1 = a; }
                            else if (sv > m2) { m2 = sv; i2 = e; a2 = a; }
                        }
                        const float gs = m1 + m2;
                        if (gs > best) { best = gs; bg = g; bi1 = i1; bi2 = i2; ba1 = a1; ba2 = a2; }
                    }
                    const float inv = 1.0f / (ba1 + ba2);
                    const float w1 = ba1 * inv, w2 = ba2 * inv;
                    const int lo = bi1 < bi2 ? bi1 : bi2, hi = bi1 < bi2 ? bi2 : bi1;
                    const float wlo = bi1 < bi2 ? w1 : w2, whi = bi1 < bi2 ? w2 : w1;
                    const int pair = (lo == 0) ? (hi - 1) : (lo == 1 ? (hi + 1) : 5);
                    const int bucket = bg * 6 + pair;
                    float4 rec; rec.x = __int_as_float(bucket); rec.y = wlo; rec.z = whi; rec.w = 0.f;
                    p.RT[rr] = rec;
                    atomicAdd(&lcnt[bucket], 1);
                }
            }
            lds_sync();
        }
    }
    if (FFN) {
        __syncthreads();
        if (t < 48) p.blkcnt[((size_t)L * 256 + bid) * 48 + t] = lcnt[t];
    }
    if (MODE == 3) {
        __syncthreads();
        for (int task = bid; task < NT_GU + NT_WD; task += nb) moe_cvt_task(p, 1, task, smem);
    }
}

struct GemmSmem { bf16_t A[2][128][72]; bf16_t B[2][256][72]; };
static_assert(sizeof(GemmSmem) <= LDS_BYTES, "gemm lds");

template <class Epi>
DEVINL void gemm_tile(const bf16_t* __restrict__ A, int lda, const int* __restrict__ rowlist, int m0, int mvalid,
                      const bf16_t* __restrict__ Bt0, const bf16_t* __restrict__ Bt1, int ldb, int kseg, int K, Epi& epi, char* smem) {
    GemmSmem& S = *(GemmSmem*)smem;
    const int t = tid_opaque(), w = t >> 6, lane = t & 63, fr = lane & 15, fq = lane >> 4, wr = w >> 2, wc = w & 3;
    const int ch = t & 7, rr = t >> 3;
    const bf16_t* ap[2];
#pragma unroll
    for (int i = 0; i < 2; ++i) {
        const int ri = rr + i * 64, gi = ri < mvalid ? ri : 0;
        const int grow = rowlist ? rowlist[m0 + gi] : (m0 + gi);
        ap[i] = A + (size_t)grow * lda + ch * 8;
    }
    u32x4 ra[2], rb[4];
    f32x4 acc[4][4];
#pragma unroll
    for (int m = 0; m < 4; ++m)
#pragma unroll
        for (int n = 0; n < 4; ++n) acc[m][n] = (f32x4){0.f, 0.f, 0.f, 0.f};
    const int nk = K >> 6;
#define GT_GLOAD(kt) do { const int _k0 = (kt) * 64; \
        _Pragma("unroll") for (int i = 0; i < 2; ++i) ra[i] = *(const u32x4*)(ap[i] + _k0); \
        const bf16_t* _bb = (_k0 < kseg) ? (Bt0 + _k0) : (Bt1 + (_k0 - kseg)); \
        _Pragma("unroll") for (int i = 0; i < 4; ++i) rb[i] = *(const u32x4*)(_bb + (size_t)(rr + i * 64) * ldb + ch * 8); } while (0)
#define GT_SSTORE(buf) do { \
        _Pragma("unroll") for (int i = 0; i < 2; ++i) *(u32x4*)&S.A[buf][rr + i * 64][ch * 8] = ra[i]; \
        _Pragma("unroll") for (int i = 0; i < 4; ++i) *(u32x4*)&S.B[buf][rr + i * 64][ch * 8] = rb[i]; } while (0)
    GT_GLOAD(0);
    GT_SSTORE(0);
    __syncthreads();
    for (int kt = 0; kt < nk; ++kt) {
        const int cur = kt & 1;
        if (kt + 1 < nk) GT_GLOAD(kt + 1);
#pragma unroll
        for (int kk = 0; kk < 2; ++kk) {
            bf16x8 a[4], b[4];
#pragma unroll
            for (int m = 0; m < 4; ++m) a[m] = *(const bf16x8*)&S.A[cur][wr * 64 + m * 16 + fr][kk * 32 + fq * 8];
#pragma unroll
            for (int n = 0; n < 4; ++n) b[n] = *(const bf16x8*)&S.B[cur][wc * 64 + n * 16 + fr][kk * 32 + fq * 8];
#pragma unroll
            for (int m = 0; m < 4; ++m)
#pragma unroll
                for (int n = 0; n < 4; ++n) acc[m][n] = __builtin_amdgcn_mfma_f32_16x16x32_bf16(b[n], a[m], acc[m][n], 0, 0, 0);
        }
        if (kt + 1 < nk) GT_SSTORE(cur ^ 1);
        __syncthreads();
    }
#undef GT_GLOAD
#undef GT_SSTORE
    epi(acc, wr * 64, wc * 64, fr, fq);
}

struct EpiP0 {
    bf16_t* P; int m0, n0;
    DEVINL void operator()(const f32x4 (&acc)[4][4], int mb, int nbs, int fr, int fq) const {
        const float sc = (n0 < 256) ? 0.125f : 1.0f;
#pragma unroll
        for (int m = 0; m < 4; ++m) {
            bf16_t* rp = P + (size_t)(m0 + mb + m * 16 + fr) * 2048 + n0 + nbs + fq * 4;
#pragma unroll
            for (int n = 0; n < 4; ++n) *(u32x2*)(rp + n * 16) = pk4(acc[m][n] * sc);
        }
    }
};
struct EpiP1 {
    bf16_t* P; const float* lb; int m0, n0;
    DEVINL void operator()(const f32x4 (&acc)[4][4], int mb, int nbs, int fr, int fq) const {
        const int cb = n0 >> 10;
#pragma unroll
        for (int m = 0; m < 4; ++m) {
            bf16_t* rp = P + (size_t)(m0 + mb + m * 16 + fr) * 5120 + n0 + nbs + fq * 4;
#pragma unroll
            for (int n = 0; n < 4; ++n) {
                const f32x4 a = acc[m][n];
                u32x2 o;
                if (cb == 1 || cb == 2) {
                    const int cc = ((n0 + nbs + n * 16 + fq * 4) & 1023);
                    const f32x4 l4 = *(const f32x4*)(lb + cc);
                    unsigned short hv[4];
#pragma unroll
                    for (int j = 0; j < 4; ++j) hv[j] = f2h((1.0f - l4[j]) * sigmoidf_(-a[j]));
                    o.x = (unsigned)hv[0] | ((unsigned)hv[1] << 16); o.y = (unsigned)hv[2] | ((unsigned)hv[3] << 16);
                } else if (cb == 0 || cb == 4) {
                    f32x4 s;
#pragma unroll
                    for (int j = 0; j < 4; ++j) s[j] = siluf_(a[j]);
                    o = pk4(s);
                } else o = pk4(a);
                *(u32x2*)(rp + n * 16) = o;
            }
        }
    }
};
struct EpiGlu {
    bf16_t* CAT; const bf16_t* s5a; const float* gb; int m0, n0;
    DEVINL void operator()(const f32x4 (&acc)[4][4], int mb, int nbs, int fr, int fq) const {
        f32x4 b4[4];
#pragma unroll
        for (int n = 0; n < 4; ++n) b4[n] = *(const f32x4*)(gb + n0 + nbs + n * 16 + fq * 4);
        u32x2 av[4][4];
#pragma unroll
        for (int m = 0; m < 4; ++m)
#pragma unroll
            for (int n = 0; n < 4; ++n) av[m][n] = *(const u32x2*)(s5a + (size_t)(m0 + mb + m * 16 + fr) * 512 + n0 + nbs + n * 16 + fq * 4);
#pragma unroll
        for (int m = 0; m < 4; ++m) {
            const size_t row = (size_t)(m0 + mb + m * 16 + fr);
#pragma unroll
            for (int n = 0; n < 4; ++n) {
                const int col = n0 + nbs + n * 16 + fq * 4;
                f32x4 o;
                o[0] = bf2f((bf16_t)(av[m][n].x & 0xffff)) * sigmoidf_(acc[m][n][0] + b4[n][0]);
                o[1] = bf2f((bf16_t)(av[m][n].x >> 16)) * sigmoidf_(acc[m][n][1] + b4[n][1]);
                o[2] = bf2f((bf16_t)(av[m][n].y & 0xffff)) * sigmoidf_(acc[m][n][2] + b4[n][2]);
                o[3] = bf2f((bf16_t)(av[m][n].y >> 16)) * sigmoidf_(acc[m][n][3] + b4[n][3]);
                *(u32x2*)(CAT + row * 1024 + 512 + col) = pk4(o);
            }
        }
    }
};
struct EpiOut {
    const Params* p; const float* gate; int m0, n0;
    DEVINL void operator()(const f32x4 (&acc)[4][4], int mb, int nbs, int fr, int fq) const {
        const float* gp = gate + (size_t)8 * 6144;
        f32x4 g4[4];
#pragma unroll
        for (int n = 0; n < 4; ++n) g4[n] = *(const f32x4*)(gp + n0 + nbs + n * 16 + fq * 4);
        f32x4 x4[4][4];
#pragma unroll
        for (int m = 0; m < 4; ++m) {
            const float* rp = resid_row(*p, m0 + mb + m * 16 + fr);
#pragma unroll
            for (int n = 0; n < 4; ++n) x4[m][n] = *(const f32x4*)(rp + n0 + nbs + n * 16 + fq * 4);
        }
#pragma unroll
        for (int m = 0; m < 4; ++m) {
            float* rp = resid_row(*p, m0 + mb + m * 16 + fr);
#pragma unroll
            for (int n = 0; n < 4; ++n) *(f32x4*)(rp + n0 + nbs + n * 16 + fq * 4) = x4[m][n] + g4[n] * acc[m][n];
        }
    }
};

struct EpiY {
    bf16_t* O; int m0, n0;
    DEVINL void operator()(const f32x4 (&acc)[4][4], int mb, int nbs, int fr, int fq) const {
#pragma unroll
        for (int m = 0; m < 4; ++m) {
            bf16_t* rp = O + (size_t)(m0 + mb + m * 16 + fr) * 1024 + n0 + nbs + fq * 4;
#pragma unroll
            for (int n = 0; n < 4; ++n) *(u32x2*)(rp + n * 16) = pk4(acc[m][n]);
        }
    }
};

namespace pg8 {
#define PG8_LAS __attribute__((address_space(3)))
constexpr int BM = 256, BK = 64, HALF = 128, HTB = HALF * BK * 2, STAGE_BYTES = 8 * HTB, NXCD = 8, WGM = 8;
DEVINL int lds_byte(int r, int c) { const int st = (r >> 4) * 2 + (c >> 5), rr = r & 15, cc = c & 31, ob = rr * 64 + cc * 2; return st * 1024 + (ob ^ (((ob >> 9) & 1) << 5)); }
DEVINL void stage_rc(int b, int& R_, int& C_) { const int st = b / 1024, sb = b % 1024, swz = sb ^ (((sb >> 9) & 1) << 5); R_ = (st >> 1) * 16 + swz / 64; C_ = (st & 1) * 32 + (swz % 64) / 2; }
DEVINL int perm32(int rho) { const int n = rho >> 4, i = rho & 15; return 8 * (i >> 2) + 4 * n + (i & 3); }
struct Unit { int pm, pn; const char* A; const char* B0; const char* B1; int mvalid, aux; };

template <class Epi, class Sched>
DEVINL void gemm_phase(PG8_LAS unsigned char* lds, const Sched& S, const Epi& E) {
    const int tid = tid_opaque(), wid = __builtin_amdgcn_readfirstlane(tid >> 6), lane = tid & 63, wr = wid >> 2, wc = wid & 3, fr = lane & 15, fq = lane >> 4;
    const int K = S.K, nt = K / BK, ldb = S.ldb, ksplit = S.ksplit;
    unsigned voffA[2], voffB[2];
#pragma unroll
    for (int i = 0; i < 2; ++i) { int R_, C_; stage_rc(tid * 16 + i * 8192, R_, C_); const int Rb = Epi::PERM ? ((R_ & ~31) + perm32(R_ & 31)) : R_;
        voffA[i] = (unsigned)(R_ * K + C_) * 2u; voffB[i] = (unsigned)(Rb * ldb + C_) * 2u; }
    const size_t kstep = (size_t)(BK * 2);
    const size_t hstepA = (size_t)HALF * K * 2, hstepB = (size_t)HALF * ldb * 2;
    const unsigned ldsw = (unsigned)wid * 1024u;
    const int aoff = lds_byte(wr * 64 + fr, fq * 8), boff = lds_byte(wc * 32 + fr, fq * 8);
#define PG8_SA(b, h) (((b) * 2 + (h)) * HTB)
#define PG8_SB(b, h) ((4 + (b) * 2 + (h)) * HTB)
#define PG8_STAGE(bufoff, gbase, voff) do { _Pragma("unroll") for (int _i = 0; _i < 2; ++_i) \
        __builtin_amdgcn_global_load_lds((const unsigned*)((const char*)(gbase) + (voff)[_i]), (PG8_LAS unsigned*)(lds + (bufoff) + ldsw + _i * 8192), 16, 0, 0); } while (0)
#define PG8_LDA(dst, b, h) do { _Pragma("unroll") for (int m = 0; m < 4; ++m) _Pragma("unroll") for (int k = 0; k < 2; ++k) dst[m][k] = *(const PG8_LAS bf16x8*)(lds + PG8_SA(b, h) + aoff + m * 2048 + k * 1024); } while (0)
#define PG8_LDB(dst, b, h) do { _Pragma("unroll") for (int n = 0; n < 2; ++n) _Pragma("unroll") for (int k = 0; k < 2; ++k) dst[n][k] = *(const PG8_LAS bf16x8*)(lds + PG8_SB(b, h) + boff + n * 2048 + k * 1024); } while (0)
#define PG8_MMA(ai, bj, At, Bt) do { __builtin_amdgcn_s_setprio(1); _Pragma("unroll") for (int m = 0; m < 4; ++m) _Pragma("unroll") for (int n = 0; n < 2; ++n) _Pragma("unroll") for (int k = 0; k < 2; ++k) \
        acc[ai][bj][m][n] = __builtin_amdgcn_mfma_f32_16x16x32_bf16(Bt[n][k], At[m][k], acc[ai][bj][m][n], 0, 0, 0); __builtin_amdgcn_s_setprio(0); } while (0)
#define PG8_WAIT_V(n) asm volatile("s_waitcnt vmcnt(" #n ")" ::: "memory")
#define PG8_WAIT_L(n) asm volatile("s_waitcnt lgkmcnt(" #n ")" ::: "memory")
#define PG8_BAR __builtin_amdgcn_s_barrier()
#define PG8_SCHED __builtin_amdgcn_sched_barrier(0)
#define PG8_BPTR(u, kt) (((kt) < ksplit ? (u).B0 : (u).B1) + (size_t)(kt) * kstep)
    Unit cur, nxt; int ui = 0;
    if (!S.next(0, cur)) return;
    f32x4 acc[2][2][4][2];
#pragma unroll
    for (int a = 0; a < 2; ++a)
#pragma unroll
        for (int b = 0; b < 2; ++b)
#pragma unroll
            for (int m = 0; m < 4; ++m)
#pragma unroll
                for (int n = 0; n < 2; ++n) acc[a][b][m][n] = (f32x4){0.f, 0.f, 0.f, 0.f};
    bf16x8 At[4][2], B0[2][2], B1[2][2];
    const char* cA = cur.A;
    { const char* cB0 = PG8_BPTR(cur, 0); const char* cB1 = PG8_BPTR(cur, 1);
      PG8_STAGE(PG8_SB(0, 0), cB0, voffB); PG8_STAGE(PG8_SA(0, 0), cA, voffA); PG8_STAGE(PG8_SB(0, 1), cB0 + hstepB, voffB); PG8_STAGE(PG8_SA(0, 1), cA + hstepA, voffA);
      if (wr == 1) PG8_BAR;
      PG8_WAIT_V(4); PG8_BAR;
      PG8_STAGE(PG8_SB(1, 0), cB1, voffB); PG8_STAGE(PG8_SA(1, 0), cA + kstep, voffA); PG8_STAGE(PG8_SB(1, 1), cB1 + hstepB, voffB);
      PG8_WAIT_V(6); PG8_BAR; }
    for (;;) {
        const bool has_next = S.next(ui + 1, nxt);
        if (!has_next) nxt = cur;
        const char* nA = nxt.A;
        for (int t = 0; t < nt; t += 2) {
            const bool last = (t == nt - 2);
            const char* a1 = cA + (size_t)(t + 1) * kstep;
            const char* a2 = last ? nA : cA + (size_t)(t + 2) * kstep;
            const char* b2 = last ? PG8_BPTR(nxt, 0) : PG8_BPTR(cur, t + 2);
            const char* a3 = a2 + kstep;
            const char* b3 = last ? PG8_BPTR(nxt, 1) : PG8_BPTR(cur, t + 3);
            PG8_LDB(B0, 0, 0); PG8_SCHED; PG8_LDA(At, 0, 0); PG8_STAGE(PG8_SA(1, 1), a1 + hstepA, voffA);
            PG8_WAIT_L(8); PG8_BAR; PG8_WAIT_L(0); PG8_MMA(0, 0, At, B0); PG8_BAR; PG8_SCHED;
            PG8_LDB(B1, 0, 1); PG8_STAGE(PG8_SB(0, 0), b2, voffB);
            PG8_BAR; PG8_WAIT_L(0); PG8_MMA(0, 1, At, B1); PG8_BAR;
            PG8_LDA(At, 0, 1); PG8_STAGE(PG8_SA(0, 0), a2, voffA);
            PG8_BAR; PG8_WAIT_L(0); PG8_MMA(1, 0, At, B0); PG8_BAR; PG8_SCHED;
            PG8_STAGE(PG8_SB(0, 1), b2 + hstepB, voffB);
            PG8_WAIT_V(6); PG8_BAR; PG8_MMA(1, 1, At, B1); PG8_BAR;
            PG8_LDB(B0, 1, 0); PG8_SCHED; PG8_LDA(At, 1, 0); PG8_STAGE(PG8_SA(0, 1), a2 + hstepA, voffA);
            PG8_WAIT_L(8); PG8_BAR; PG8_WAIT_L(0); PG8_MMA(0, 0, At, B0); PG8_BAR; PG8_SCHED;
            PG8_LDB(B1, 1, 1); PG8_STAGE(PG8_SB(1, 0), b3, voffB);
            PG8_BAR; PG8_WAIT_L(0); PG8_MMA(0, 1, At, B1); PG8_BAR;
            PG8_LDA(At, 1, 1); PG8_STAGE(PG8_SA(1, 0), a3, voffA);
            PG8_BAR; PG8_WAIT_L(0); PG8_MMA(1, 0, At, B0); PG8_BAR; PG8_SCHED;
            PG8_STAGE(PG8_SB(1, 1), b3 + hstepB, voffB);
            PG8_WAIT_V(6); PG8_BAR; PG8_MMA(1, 1, At, B1); PG8_BAR;
        }
        E(acc, cur, wr, wc, fr, fq);
        if (!has_next) break;
#pragma unroll
        for (int a = 0; a < 2; ++a)
#pragma unroll
            for (int b = 0; b < 2; ++b)
#pragma unroll
                for (int m = 0; m < 4; ++m)
#pragma unroll
                    for (int n = 0; n < 2; ++n) acc[a][b][m][n] = (f32x4){0.f, 0.f, 0.f, 0.f};
        cur = nxt; cA = nA; ++ui;
    }
    PG8_WAIT_V(0);
    if (wr == 0) PG8_BAR;
    PG8_BAR;
#undef PG8_SA
#undef PG8_SB
#undef PG8_STAGE
#undef PG8_LDA
#undef PG8_LDB
#undef PG8_MMA
#undef PG8_WAIT_V
#undef PG8_WAIT_L
#undef PG8_BAR
#undef PG8_SCHED
#undef PG8_BPTR
}

struct DenseSched {
    const char* A; const char* Bt; int K, ldb, ksplit, nM, nN, G, c, lat;
    DEVINL void init(const bf16_t* A_, const bf16_t* Bt_, int N, int K_, int G_, int c_, int lat_) {
        A = (const char*)A_; Bt = (const char*)Bt_; K = K_; ldb = K_; ksplit = K_ / BK; nM = lat_ ? 128 : 136; nN = N / BM; G = G_; c = c_; lat = lat_; }
    DEVINL bool next(int i, Unit& u) const {
        const int nwg = nM * nN;
        const long Lq = (long)i * G + c; if (Lq >= nwg) return false;
        int wgid = (int)Lq; { const int q = nwg / NXCD, r = nwg % NXCD, xcd = wgid % NXCD, off = wgid / NXCD; wgid = (xcd < r ? xcd * (q + 1) : r * (q + 1) + (xcd - r) * q) + off; }
        const int nig = WGM * nN, gid = wgid / nig, fm = gid * WGM, gsz = (nM - fm) < WGM ? (nM - fm) : WGM;
        int pm = fm + ((wgid % nig) % gsz); const int pn = (wgid % nig) / gsz;
        if (lat) pm = (pm >> 4) * 17 + 1 + (pm & 15);
        u.pm = pm; u.pn = pn; u.A = A + (size_t)pm * BM * K * 2; u.B0 = Bt + (size_t)pn * BM * K * 2; u.B1 = u.B0; u.mvalid = 256; u.aux = 0;
        return true;
    }
};
}

struct GEpiP0 {
    static constexpr bool PERM = true;
    bf16_t* P;
    DEVINL void operator()(const f32x4 (&acc)[2][2][4][2], const pg8::Unit& u, int wr, int wc, int fr, int fq) const {
        const float sc = (u.pn == 0) ? 0.125f : 1.0f;
        const int row0 = u.pm * 256 + wr * 64 + fr, col0 = u.pn * 256 + wc * 32 + 8 * fq;
#pragma unroll
        for (int ai = 0; ai < 2; ++ai)
#pragma unroll
            for (int m = 0; m < 4; ++m) {
                bf16_t* rp = P + (size_t)(row0 + ai * 128 + m * 16) * 2048 + col0;
#pragma unroll
                for (int bj = 0; bj < 2; ++bj) {
                    const u32x2 a = pk4(acc[ai][bj][m][0] * sc), b = pk4(acc[ai][bj][m][1] * sc);
                    u32x4 w; w.x = a.x; w.y = a.y; w.z = b.x; w.w = b.y;
                    *(u32x4*)(rp + bj * 128) = w;
                }
            }
    }
};
struct GEpiP1 {
    static constexpr bool PERM = true;
    bf16_t* P; const float* lb;
    DEVINL void operator()(const f32x4 (&acc)[2][2][4][2], const pg8::Unit& u, int wr, int wc, int fr, int fq) const {
        const int cb = u.pn >> 2;
        const int row0 = u.pm * 256 + wr * 64 + fr, col0 = u.pn * 256 + wc * 32 + 8 * fq;
        f32x4 oml[2][2];
        if (cb == 1 || cb == 2) {
#pragma unroll
            for (int bj = 0; bj < 2; ++bj)
#pragma unroll
                for (int n = 0; n < 2; ++n) { const f32x4 l4 = *(const f32x4*)(lb + ((col0 + bj * 128) & 1023) + 4 * n); oml[bj][n] = 1.0f - l4; }
        }
#pragma unroll
        for (int ai = 0; ai < 2; ++ai)
#pragma unroll
            for (int m = 0; m < 4; ++m) {
                bf16_t* rp = P + (size_t)(row0 + ai * 128 + m * 16) * 5120 + col0;
#pragma unroll
                for (int bj = 0; bj < 2; ++bj) {
                    u32x4 w;
                    if (cb == 1 || cb == 2) {
                        unsigned short hv[8];
#pragma unroll
                        for (int n = 0; n < 2; ++n)
#pragma unroll
                            for (int j = 0; j < 4; ++j) hv[n * 4 + j] = f2h(oml[bj][n][j] * sigmoidf_(-acc[ai][bj][m][n][j]));
                        w.x = (unsigned)hv[0] | ((unsigned)hv[1] << 16); w.y = (unsigned)hv[2] | ((unsigned)hv[3] << 16);
                        w.z = (unsigned)hv[4] | ((unsigned)hv[5] << 16); w.w = (unsigned)hv[6] | ((unsigned)hv[7] << 16);
                    } else {
                        f32x4 v0 = acc[ai][bj][m][0], v1 = acc[ai][bj][m][1];
                        if (cb == 0 || cb == 4) {
#pragma unroll
                            for (int j = 0; j < 4; ++j) { v0[j] = siluf_(v0[j]); v1[j] = siluf_(v1[j]); }
                        }
                        const u32x2 a = pk4(v0), b = pk4(v1);
                        w.x = a.x; w.y = a.y; w.z = b.x; w.w = b.y;
                    }
                    *(u32x4*)(rp + bj * 128) = w;
                }
            }
    }
};
struct GEpiGlu {
    static constexpr bool PERM = true;
    bf16_t* CAT; const bf16_t* s5a; const float* gb;
    DEVINL void operator()(const f32x4 (&acc)[2][2][4][2], const pg8::Unit& u, int wr, int wc, int fr, int fq) const {
        const int row0 = u.pm * 256 + wr * 64 + fr, col0 = u.pn * 256 + wc * 32 + 8 * fq;
        f32x4 bv[2][2];
#pragma unroll
        for (int bj = 0; bj < 2; ++bj)
#pragma unroll
            for (int n = 0; n < 2; ++n) bv[bj][n] = *(const f32x4*)(gb + col0 + bj * 128 + 4 * n);
#pragma unroll
        for (int ai = 0; ai < 2; ++ai) {
            u32x4 av[4][2];
#pragma unroll
            for (int m = 0; m < 4; ++m)
#pragma unroll
                for (int bj = 0; bj < 2; ++bj) av[m][bj] = *(const u32x4*)(s5a + (size_t)(row0 + ai * 128 + m * 16) * 512 + col0 + bj * 128);
#pragma unroll
            for (int m = 0; m < 4; ++m) {
                const size_t row = (size_t)(row0 + ai * 128 + m * 16);
#pragma unroll
                for (int bj = 0; bj < 2; ++bj) {
                    const u32x4 a = av[m][bj];
                    f32x4 o0, o1;
                    o0[0] = bf2f((bf16_t)(a.x & 0xffff)) * sigmoidf_(acc[ai][bj][m][0][0] + bv[bj][0][0]);
                    o0[1] = bf2f((bf16_t)(a.x >> 16)) * sigmoidf_(acc[ai][bj][m][0][1] + bv[bj][0][1]);
                    o0[2] = bf2f((bf16_t)(a.y & 0xffff)) * sigmoidf_(acc[ai][bj][m][0][2] + bv[bj][0][2]);
                    o0[3] = bf2f((bf16_t)(a.y >> 16)) * sigmoidf_(acc[ai][bj][m][0][3] + bv[bj][0][3]);
                    o1[0] = bf2f((bf16_t)(a.z & 0xffff)) * sigmoidf_(acc[ai][bj][m][1][0] + bv[bj][1][0]);
                    o1[1] = bf2f((bf16_t)(a.z >> 16)) * sigmoidf_(acc[ai][bj][m][1][1] + bv[bj][1][1]);
                    o1[2] = bf2f((bf16_t)(a.w & 0xffff)) * sigmoidf_(acc[ai][bj][m][1][2] + bv[bj][1][2]);
                    o1[3] = bf2f((bf16_t)(a.w >> 16)) * sigmoidf_(acc[ai][bj][m][1][3] + bv[bj][1][3]);
                    const u32x2 x = pk4(o0), y = pk4(o1);
                    u32x4 w; w.x = x.x; w.y = x.y; w.z = y.x; w.w = y.y;
                    *(u32x4*)(CAT + row * 1024 + 512 + col0 + bj * 128) = w;
                }
            }
        }
    }
};
struct GEpiOut {
    static constexpr bool PERM = false;
    float* out; const float* gate;
    DEVINL void operator()(const f32x4 (&acc)[2][2][4][2], const pg8::Unit& u, int wr, int wc, int fr, int fq) const {
        const int b = u.pm / 17, lt = u.pm - b * 17 - 1;
        const float* gp = gate + (size_t)b * 6144;
        const int col0 = u.pn * 256 + wc * 32 + 4 * fq;
        float* base = out + ((size_t)b * SEQ + lt * 256 + wr * 64 + fr) * D;
        f32x4 g4[2][2];
#pragma unroll
        for (int bj = 0; bj < 2; ++bj)
#pragma unroll
            for (int n = 0; n < 2; ++n) g4[bj][n] = *(const f32x4*)(gp + col0 + bj * 128 + n * 16);
#pragma unroll
        for (int ai = 0; ai < 2; ++ai)
#pragma unroll
            for (int mp = 0; mp < 4; mp += 2) {
                f32x4 x4[2][2][2];
#pragma unroll
                for (int q = 0; q < 2; ++q)
#pragma unroll
                    for (int bj = 0; bj < 2; ++bj)
#pragma unroll
                        for (int n = 0; n < 2; ++n) x4[q][bj][n] = *(const f32x4*)(base + (size_t)(ai * 128 + (mp + q) * 16) * D + col0 + bj * 128 + n * 16);
                asm volatile("" ::: "memory");
#pragma unroll
                for (int q = 0; q < 2; ++q)
#pragma unroll
                    for (int bj = 0; bj < 2; ++bj)
#pragma unroll
                        for (int n = 0; n < 2; ++n) *(f32x4*)(base + (size_t)(ai * 128 + (mp + q) * 16) * D + col0 + bj * 128 + n * 16) = x4[q][bj][n] + g4[bj][n] * acc[ai][bj][mp + q][n];
                asm volatile("" ::: "memory");
            }
    }
};
struct GEpiY {
    static constexpr bool PERM = true;
    bf16_t* O;
    DEVINL void operator()(const f32x4 (&acc)[2][2][4][2], const pg8::Unit& u, int wr, int wc, int fr, int fq) const {
        const int row0 = u.pm * 256 + wr * 64 + fr, col0 = u.pn * 256 + wc * 32 + 8 * fq;
#pragma unroll
        for (int ai = 0; ai < 2; ++ai)
#pragma unroll
            for (int m = 0; m < 4; ++m) {
                bf16_t* rp = O + (size_t)(row0 + ai * 128 + m * 16) * 1024 + col0;
#pragma unroll
                for (int bj = 0; bj < 2; ++bj) {
                    const u32x2 a = pk4(acc[ai][bj][m][0]), b = pk4(acc[ai][bj][m][1]);
                    u32x4 w; w.x = a.x; w.y = a.y; w.z = b.x; w.w = b.y;
                    *(u32x4*)(rp + bj * 128) = w;
                }
            }
    }
};
struct GEpiMoe1 {
    static constexpr bool PERM = true;
    bf16_t* act; const float* wl; const float* wh;
    DEVINL void operator()(const f32x4 (&acc)[2][2][4][2], const pg8::Unit& u, int wr, int wc, int fr, int fq) const {
        const int half = u.pn >> 1;
        const float* wsel = half ? wh : wl;
        const int cbase = half * 256 + (u.pn & 1) * 128 + 16 * wc + 4 * fq;
        float wv[2][4];
#pragma unroll
        for (int ai = 0; ai < 2; ++ai)
#pragma unroll
            for (int m = 0; m < 4; ++m) { const int lr = ai * 128 + wr * 64 + m * 16 + fr; wv[ai][m] = (lr < u.mvalid) ? wsel[u.pm * 256 + lr] : 0.f; }
#pragma unroll
        for (int ai = 0; ai < 2; ++ai)
#pragma unroll
            for (int m = 0; m < 4; ++m) {
                const int slot = u.pm * 256 + ai * 128 + wr * 64 + m * 16 + fr;
#pragma unroll
                for (int bj = 0; bj < 2; ++bj) {
                    f32x4 o;
#pragma unroll
                    for (int j = 0; j < 4; ++j) o[j] = wv[ai][m] * siluf_(acc[ai][bj][m][0][j]) * acc[ai][bj][m][1][j];
                    *(u32x2*)(act + (size_t)slot * 512 + cbase + 64 * bj) = pk4(o);
                }
            }
    }
};
struct GEpiMoe2 {
    static constexpr bool PERM = false;
    float* out; float* cx; const float* gate; const int* list;
    DEVINL void operator()(const f32x4 (&acc)[2][2][4][2], const pg8::Unit& u, int wr, int wc, int fr, int fq) const {
        const int col0 = u.pn * 256 + wc * 32 + 4 * fq;
        int rows[2][4];
#pragma unroll
        for (int ai = 0; ai < 2; ++ai)
#pragma unroll
            for (int m = 0; m < 4; ++m) { const int lr = ai * 128 + wr * 64 + m * 16 + fr; rows[ai][m] = (lr < u.mvalid) ? list[u.pm * 256 + lr] : -1; }
#pragma unroll
        for (int ai = 0; ai < 2; ++ai)
#pragma unroll
            for (int mp = 0; mp < 4; mp += 2) {
                f32x4 x4[2][2][2], g4[2][2][2];
                float* rp[2];
#pragma unroll
                for (int q = 0; q < 2; ++q) {
                    const int r = rows[ai][mp + q] < 0 ? 0 : rows[ai][mp + q];
                    const int rb = r / RPB, rj = r - rb * RPB;
                    rp[q] = (rj < CTXL) ? (cx + (size_t)(rb * CTXL + rj) * D) : (out + (size_t)(rb * SEQ + (rj - CTXL)) * D);
                    const float* gp = gate + (size_t)((rj < CTXL) ? 8 : rb) * 6144;
#pragma unroll
                    for (int bj = 0; bj < 2; ++bj)
#pragma unroll
                        for (int n = 0; n < 2; ++n) { const int col = col0 + bj * 128 + n * 16; x4[q][bj][n] = *(const f32x4*)(rp[q] + col); g4[q][bj][n] = *(const f32x4*)(gp + col); }
                }
                asm volatile("" ::: "memory");
#pragma unroll
                for (int q = 0; q < 2; ++q)
                    if (rows[ai][mp + q] >= 0) {
#pragma unroll
                        for (int bj = 0; bj < 2; ++bj)
#pragma unroll
                            for (int n = 0; n < 2; ++n) *(f32x4*)(rp[q] + col0 + bj * 128 + n * 16) = x4[q][bj][n] + g4[q][bj][n] * acc[ai][bj][mp + q][n];
                    }
            }
    }
};

template <int WHICH>
DEVINL void phase_gemm(const Params& p, char* smem, int bid, int nb) {
    constexpr int N = (WHICH == 0) ? 2048 : (WHICH == 1) ? 512 : (WHICH == 3) ? 5120 : 1024;
    constexpr int K = (WHICH == 1) ? 512 : 1024;
    PG8_LAS unsigned char* lds = (PG8_LAS unsigned char*)smem;
    pg8::DenseSched S;
    bid = sgpr(bid); nb = sgpr(nb);
    if (WHICH == 0) { S.init(sgpr_ptr(p.H), sgpr_ptr(p.wt_in0), N, K, nb, bid, 1); GEpiP0 e{sgpr_ptr(p.P)}; pg8::gemm_phase(lds, S, e); }
    if (WHICH == 1) { S.init(sgpr_ptr(p.s5a), sgpr_ptr(p.glu_t), N, K, nb, bid, 1); GEpiGlu e{sgpr_ptr(p.H), sgpr_ptr(p.s5a), sgpr_ptr(p.glu_b)}; pg8::gemm_phase(lds, S, e); }
    if (WHICH == 2) { S.init(sgpr_ptr(p.H), sgpr_ptr(p.wt_out0), N, K, nb, bid, 1); GEpiY e{sgpr_ptr(p.Y)}; pg8::gemm_phase(lds, S, e); }
    if (WHICH == 3) {
        float* lbl = (float*)(smem + pg8::STAGE_BYTES + 1024);
        for (int i = tid_opaque(); i < 1024; i += NTHR) lbl[i] = p.lb[i];
        __syncthreads();
        S.init(sgpr_ptr(p.H), sgpr_ptr(p.wt_in1), N, K, nb, bid, 1); GEpiP1 e{sgpr_ptr(p.P), lbl}; pg8::gemm_phase(lds, S, e);
    }
    if (WHICH == 4) { S.init(sgpr_ptr(p.H), sgpr_ptr(p.wt_out1), N, K, nb, bid, 1); GEpiY e{sgpr_ptr(p.Y)}; pg8::gemm_phase(lds, S, e); }
    if (WHICH != 4) {
        constexpr int NT0 = (WHICH == 3) ? 4 : 0, NT1 = (WHICH == 3) ? 16 : N / 256, NTC = NT1 - NT0;
        for (int u = bid; u < 16 * NTC; u += nb) {
            const int mt = u / NTC, nt = NT0 + (u - mt * NTC);
            const int m0 = (mt >> 1) * RPB + (mt & 1) * 128, n0 = nt * 256;
            if (WHICH == 0) { EpiP0 e{p.P, m0, n0}; gemm_tile(p.H, 1024, nullptr, m0, 128, p.wt_in0 + (size_t)n0 * 1024, nullptr, 1024, K, K, e, smem); }
            if (WHICH == 1) { EpiGlu e{p.H, p.s5a, p.glu_b, m0, n0}; gemm_tile(p.s5a, 512, nullptr, m0, 128, p.glu_t + (size_t)n0 * 512, nullptr, 512, K, K, e, smem); }
            if (WHICH == 2) { EpiOut e{&p, p.mod + 2048, m0, n0}; gemm_tile(p.H, 1024, nullptr, m0, 128, p.wt_out0 + (size_t)n0 * 1024, nullptr, 1024, K, K, e, smem); }
            if (WHICH == 3) { EpiP1 e{p.P, p.lb, m0, n0}; gemm_tile(p.H, 1024, nullptr, m0, 128, p.wt_in1 + (size_t)n0 * 1024, nullptr, 1024, K, K, e, smem); }
        }
    }
}

constexpr int MOE_TAB = pg8::STAGE_BYTES;
static_assert(MOE_TAB + 1024 <= LDS_BYTES, "moe tables");
DEVINL void moe_setup(const Params& p, int L, int* tab) {
    const int t = tid_opaque();
    if (t < 48) tab[128 + t] = p.cnt[L * 64 + t];
    __syncthreads();
    if (t == 0) {
        int o = 0, ts = 0;
        for (int b = 0; b < 48; ++b) { const int c = tab[128 + b]; tab[b] = o; tab[64 + b] = ts; const int nt = (c + 255) >> 8; o += nt * 256; ts += nt; }
        tab[48] = o; tab[64 + 48] = ts;
    }
    __syncthreads();
}
template <int L>
DEVINL void phase_list(const Params& p, char* smem, int bid, int nb) {
    int* tab = (int*)(smem + MOE_TAB);
    int* red = (int*)smem;
    int* rsrc = red + 1024; int* rdst = rsrc + 256;
    const int t = tid_opaque(), w = t >> 6, lane = t & 63;
    {
        const int bkt = t & 63, part = t >> 6;
        int tot = 0, pre = 0;
        if (bkt < 48) {
#pragma unroll 8
            for (int q = 0; q < 32; ++q) { const int blk = part * 32 + q; const int c = (blk < nb) ? p.blkcnt[((size_t)L * 256 + blk) * 48 + bkt] : 0; tot += c; pre += (blk < bid) ? c : 0; }
        }
        red[part * 64 + bkt] = tot; red[512 + part * 64 + bkt] = pre;
    }
    __syncthreads();
    if (t < 48) {
        int tot = 0, pre = 0;
#pragma unroll
        for (int q = 0; q < 8; ++q) { tot += red[q * 64 + t]; pre += red[512 + q * 64 + t]; }
        tab[128 + t] = tot; tab[192 + t] = pre;
        if (bid == 0) p.cnt[L * 64 + t] = tot;
    }
    __syncthreads();
    if (t == 0) {
        int o = 0, ts = 0;
        for (int b = 0; b < 48; ++b) { const int c = tab[128 + b]; tab[b] = o; tab[64 + b] = ts; const int nt = (c + 255) >> 8; o += nt * 256; ts += nt; }
        tab[48] = o; tab[64 + 48] = ts;
    }
    __syncthreads();
    if (t < 48) tab[192 + t] += tab[t];
    __syncthreads();
    const int ngroups = L ? (NLAT / 16) : (R / 16);
    const int nmine = (bid < ngroups) ? (((ngroups - 1 - bid) / nb + 1) * 16) : 0;
    if (t < nmine) {
        const int idx = (bid + (t >> 4) * nb) * 16 + (t & 15);
        const int r = L ? ((idx >> 12) * RPB + CTXL + (idx & 4095)) : idx;
        const float4 rec = p.RT[r];
        const int bucket = __float_as_int(rec.x);
        const int slot = atomicAdd(&tab[192 + bucket], 1);
        p.list[slot] = r; p.wl[slot] = rec.y; p.wh[slot] = rec.z; p.sor[r] = slot;
        rsrc[t] = r; rdst[t] = slot;
    }
    __syncthreads();
    for (int q0 = w; q0 < nmine; q0 += 64) {
        u32x4 v0[8], v1[8];
#pragma unroll
        for (int j = 0; j < 8; ++j) {
            const int q = q0 + j * 8;
            if (q < nmine) { const u32x4* src = (const u32x4*)(p.H + (size_t)rsrc[q] * D); v0[j] = src[lane]; v1[j] = src[lane + 64]; }
        }
#pragma unroll
        for (int j = 0; j < 8; ++j) {
            const int q = q0 + j * 8;
            if (q < nmine) { u32x4* dst = (u32x4*)(p.hs + (size_t)rdst[q] * D); dst[lane] = v0[j]; dst[lane + 64] = v1[j]; }
        }
    }
}
struct MoeSched {
    const bf16_t* hs; const bf16_t* wgu_t; const bf16_t* act; const bf16_t* wd_t; const int* tab; int K, ldb, ksplit, G, c, stage, ntiles;
    DEVINL bool next(int i, pg8::Unit& u) const {
        const int x = c & 7, rk = c >> 3, nper = G >> 3;
        const int t0 = (ntiles * x) >> 3, t1 = (ntiles * (x + 1)) >> 3;
        const int li = i * nper + rk;
        if (li >= (t1 - t0) * 4) return false;
        const int tile = t0 + (li >> 2), pn = li & 3;
        int bucket = 0;
        for (int b = 0; b < 48; ++b) if (tile >= tab[64 + b] && tile < tab[64 + b + 1]) bucket = b;
        bucket = sgpr(bucket);
        const int ti = tile - sgpr(tab[64 + bucket]);
        const int m0 = sgpr(tab[bucket]) + ti * 256;
        const int rem = sgpr(tab[128 + bucket]) - ti * 256;
        const int grp = bucket / 6, pair = bucket - grp * 6;
        const int lo = (pair < 3) ? 0 : (pair < 5 ? 1 : 2);
        const int hi = (pair < 3) ? (pair + 1) : (pair < 5 ? (pair - 1) : 3);
        const int ea = grp * 4 + lo, eb = grp * 4 + hi;
        u.pm = m0 >> 8; u.pn = pn; u.mvalid = rem < 256 ? rem : 256; u.aux = 0;
        if (stage == 1) {
            const int e = (pn >> 1) ? eb : ea;
            u.A = (const char*)(hs + (size_t)m0 * 1024);
            u.B0 = (const char*)(wgu_t + ((size_t)e * 512 + (pn & 1) * 256) * 1024); u.B1 = u.B0;
        } else {
            u.A = (const char*)(act + (size_t)m0 * 512);
            u.B0 = (const char*)(wd_t + ((size_t)ea * 1024 + pn * 256) * 256);
            u.B1 = (const char*)(wd_t + ((size_t)eb * 1024 + pn * 256) * 256) - (size_t)4 * 128;
        }
        return true;
    }
};
template <int L, int STAGE>
DEVINL void phase_moe(const Params& p, char* smem, int bid, int nb) {
    int* tab = (int*)(smem + MOE_TAB);
    moe_setup(p, L, tab);
    PG8_LAS unsigned char* lds = (PG8_LAS unsigned char*)smem;
    MoeSched S; S.hs = sgpr_ptr(p.hs); S.wgu_t = sgpr_ptr(p.wgu_t); S.act = sgpr_ptr(p.act); S.wd_t = sgpr_ptr(p.wd_t);
    S.tab = tab; S.G = sgpr(nb); S.c = sgpr(bid); S.stage = STAGE; S.ntiles = sgpr(tab[64 + 48]);
    if (STAGE == 1) { S.K = 1024; S.ldb = 1024; S.ksplit = 16; GEpiMoe1 e{sgpr_ptr(p.act), sgpr_ptr(p.wl), sgpr_ptr(p.wh)}; pg8::gemm_phase(lds, S, e); }
    else { S.K = 512; S.ldb = 256; S.ksplit = 4; GEpiY e{sgpr_ptr(p.y2)}; pg8::gemm_phase(lds, S, e); }
    __syncthreads();
}

template <int DK> struct RecL {
    static constexpr int QS = DK + 8;
    static constexpr int oQs = 0;
    static constexpr int oKs = oQs + 64 * QS * 2;
    static constexpr int oKt = oKs + 64 * QS * 2;
    static constexpr int oVt = oKt + DK * 72 * 2;
    static constexpr int oAt = oVt + 128 * 72 * 2;
    static constexpr int oSt = oAt + 64 * 72 * 2;
    static constexpr int oPart = oSt + 128 * 136 * 2;
    static constexpr int oEmid = oPart + 8 * 128 * 4;
    static constexpr int oEend = oEmid + 128 * 4;
    static constexpr int oAF = oEend + 128 * 4;
    static constexpr int oRed = oAF + 64 * 32 * 4;
    static constexpr int total = oRed + 64 * 2 * 4 + 128 * 4;
};
static_assert(RecL<128>::total <= LDS_BYTES, "rec lds");

template <bool GLA> struct RecCols {
    static constexpr int LDP = GLA ? 2048 : 5120;
    static constexpr int QOFF = 0;
    static constexpr int KOFF = 256;
    static constexpr int KF = 1024, KB = 2048;
    static constexpr int VOFF = GLA ? 512 : 3072;
    static constexpr int GOFF = GLA ? 1024 : 4096;
};
template <int DK, bool GLA> struct RecGeo {
    static constexpr int GC = GLA ? 4 : 8;
    static constexpr int NS = GLA ? 16 : 8;
    static constexpr int H = GLA ? 4 : 8;
    static constexpr int KT = DK / 16;
};

struct RawRegs { u32x4 q[2], k[2], v[2], af; };

template <int DK, bool GLA, int DIR, bool PASS3>
DEVINL void rec_load_raw(const Params& p, const bf16_t* __restrict__ P, int row0, int h, RawRegs& r) {
    using C = RecCols<GLA>; constexpr int LDP = C::LDP;
    const int t = tid_opaque();
    if (GLA) {
        const int row = t >> 3, c8 = (t & 7) * 8;
        const bf16_t* rp = P + (size_t)(row0 + row) * LDP + h * 64 + c8;
        if (PASS3) r.q[0] = *(const u32x4*)(rp + C::QOFF);
        r.k[0] = *(const u32x4*)(rp + C::KOFF);
        r.af = *(const u32x4*)(p.AF + (size_t)(row0 + row) * 32 + (t & 7) * 4);
    } else {
#pragma unroll
        for (int i = 0; i < 2; ++i) {
            const int row = (t >> 4) + i * 32, c8 = (t & 15) * 8;
            const bf16_t* rp = P + (size_t)(row0 + row) * LDP + h * 128 + c8;
            if (PASS3) r.q[i] = *(const u32x4*)(rp + C::QOFF);
            r.k[i] = *(const u32x4*)(rp + (DIR ? C::KB : C::KF));
        }
    }
#pragma unroll
    for (int i = 0; i < 2; ++i) {
        const int row = (t >> 4) + i * 32, c8 = (t & 15) * 8;
        r.v[i] = *(const u32x4*)(P + (size_t)(row0 + row) * LDP + C::VOFF + h * 128 + c8);
    }
}

template <int DK, bool GLA, int DIR, bool PASS3>
DEVINL void rec_prep(const Params& p, char* smem, const bf16_t* __restrict__ P, RawRegs& raw, bool has_next, int next_row0, int h,
                     const float (&a2c)[2][16], const float (&abv)[2], float (&bsum)[2]) {
    using L = RecL<DK>;
    constexpr int NCP = DK / 2, NSEG = NTHR / NCP, RS = 64 / NSEG, QS = L::QS;
    constexpr bool ref_end = !PASS3;
    bf16_t* Qs = (bf16_t*)(smem + L::oQs); bf16_t* Ks = (bf16_t*)(smem + L::oKs); bf16_t* Kt = (bf16_t*)(smem + L::oKt); bf16_t* Vt = (bf16_t*)(smem + L::oVt);
    bf16_t* Vraw = (bf16_t*)(smem + L::oSt);
    float* part = (float*)(smem + L::oPart); float* emid = (float*)(smem + L::oEmid); float* eend = (float*)(smem + L::oEend); float* AFs = (float*)(smem + L::oAF);
    const int t = tid_opaque();
    if (GLA) {
        const int row = t >> 3, c8 = (t & 7) * 8;
        if (PASS3) *(u32x4*)&Qs[row * QS + c8] = raw.q[0];
        *(u32x4*)&Ks[row * QS + c8] = raw.k[0];
        *(u32x4*)&AFs[row * 32 + (t & 7) * 4] = raw.af;
    } else {
#pragma unroll
        for (int i = 0; i < 2; ++i) {
            const int row = (t >> 4) + i * 32, c8 = (t & 15) * 8;
            if (PASS3) *(u32x4*)&Qs[row * QS + c8] = raw.q[i];
            *(u32x4*)&Ks[row * QS + c8] = raw.k[i];
        }
    }
#pragma unroll
    for (int i = 0; i < 2; ++i) { const int row = (t >> 4) + i * 32, c8 = (t & 15) * 8; *(u32x4*)&Vraw[row * 136 + c8] = raw.v[i]; }
    lds_sync();
    if (has_next) rec_load_raw<DK, GLA, DIR, PASS3>(p, P, next_row0, h, raw);
    const int cp = t % NCP, seg = t / NCP, c0 = cp * 2, l0 = seg * RS;
    float dv[RS][2];
    float kv[RS][2];
#pragma unroll
    for (int i = 0; i < RS; ++i) {
        const unsigned kr = *(const unsigned*)&Ks[(l0 + i) * QS + c0];
        if (GLA) {
            kv[i][0] = bf2f((bf16_t)(kr & 0xffffu)); kv[i][1] = bf2f((bf16_t)(kr >> 16));
            const float* ar = &AFs[(l0 + i) * 32 + DIR * 16];
            float s0 = abv[0], s1 = abv[1];
#pragma unroll
            for (int r = 0; r < 16; ++r) { const float av = ar[r]; s0 += av * a2c[0][r]; s1 += av * a2c[1][r]; }
            dv[i][0] = logsigmoidf_(s0) * 0.0625f; dv[i][1] = logsigmoidf_(s1) * 0.0625f;
        } else {
            kv[i][0] = h2f((unsigned short)(kr & 0xffffu)); kv[i][1] = h2f((unsigned short)(kr >> 16));
            dv[i][0] = 1.0f - kv[i][0]; dv[i][1] = 1.0f - kv[i][1];
        }
    }
    {
        float s0 = GLA ? 0.f : 1.f, s1 = GLA ? 0.f : 1.f;
#pragma unroll
        for (int i = 0; i < RS; ++i) { if (GLA) { s0 += dv[i][0]; s1 += dv[i][1]; } else { s0 *= dv[i][0]; s1 *= dv[i][1]; } }
        float2 pv; pv.x = s0; pv.y = s1;
        *(float2*)&part[seg * DK + c0] = pv;
    }
    lds_sync();
    float tot[2], base[2], mid[2];
#pragma unroll
    for (int c = 0; c < 2; ++c) { tot[c] = GLA ? 0.f : 1.f; base[c] = tot[c]; mid[c] = tot[c]; }
#pragma unroll
    for (int sg = 0; sg < NSEG; ++sg) {
        const float2 pv = *(const float2*)&part[sg * DK + c0];
        const bool before = (DIR == 0) ? (sg < seg) : (sg > seg);
        const bool firsthalf = (DIR == 0) ? (sg < NSEG / 2) : (sg >= NSEG / 2);
        if (GLA) { tot[0] += pv.x; tot[1] += pv.y; if (before) { base[0] += pv.x; base[1] += pv.y; } if (firsthalf) { mid[0] += pv.x; mid[1] += pv.y; } }
        else { tot[0] *= pv.x; tot[1] *= pv.y; if (before) { base[0] *= pv.x; base[1] *= pv.y; } if (firsthalf) { mid[0] *= pv.x; mid[1] *= pv.y; } }
    }
    float ref[2], iref[2];
#pragma unroll
    for (int c = 0; c < 2; ++c) { ref[c] = ref_end ? tot[c] : mid[c]; iref[c] = GLA ? 0.f : __builtin_amdgcn_rcpf(ref[c]); }
    if (seg == 0) {
#pragma unroll
        for (int c = 0; c < 2; ++c) {
            if (GLA) { emid[c0 + c] = __expf(ref[c]); eend[c0 + c] = __expf(tot[c] - ref[c]); bsum[c] += tot[c]; }
            else { emid[c0 + c] = ref[c]; eend[c0 + c] = tot[c] * iref[c]; bsum[c] += __logf(tot[c]); }
        }
    }
    unsigned short ktv[2][RS];
    float run[2] = {base[0], base[1]};
#pragma unroll
    for (int ii = 0; ii < RS; ++ii) {
        const int i = (DIR == 0) ? ii : (RS - 1 - ii);
        float ek[2], eq[2];
#pragma unroll
        for (int c = 0; c < 2; ++c) {
            if (GLA) { run[c] += dv[i][c]; ek[c] = __expf(ref[c] - run[c]); eq[c] = PASS3 ? __expf(run[c] - ref[c]) : 0.f; }
            else { run[c] *= dv[i][c]; ek[c] = ref[c] * __builtin_amdgcn_rcpf(run[c]); eq[c] = run[c] * iref[c]; }
        }
        const unsigned kp = cvt_pk_bf16(kv[i][0] * ek[0], kv[i][1] * ek[1]);
        ktv[0][i] = (unsigned short)(kp & 0xffffu); ktv[1][i] = (unsigned short)(kp >> 16);
        if (PASS3) {
            const int l = l0 + i;
            *(unsigned*)&Ks[l * QS + c0] = kp;
            const unsigned qr = *(const unsigned*)&Qs[l * QS + c0];
            *(unsigned*)&Qs[l * QS + c0] = cvt_pk_bf16(bf2f((bf16_t)(qr & 0xffffu)) * eq[0], bf2f((bf16_t)(qr >> 16)) * eq[1]);
        }
    }
#pragma unroll
    for (int c = 0; c < 2; ++c) {
        if (RS == 8) {
            u32x4 v;
            v.x = (unsigned)ktv[c][0] | ((unsigned)ktv[c][1] << 16); v.y = (unsigned)ktv[c][2] | ((unsigned)ktv[c][3] << 16);
            v.z = (unsigned)ktv[c][RS > 4 ? 4 : 0] | ((unsigned)ktv[c][RS > 4 ? 5 : 0] << 16); v.w = (unsigned)ktv[c][RS > 4 ? 6 : 0] | ((unsigned)ktv[c][RS > 4 ? 7 : 0] << 16);
            *(u32x4*)&Kt[(c0 + c) * 72 + l0] = v;
        } else {
            u32x2 v;
            v.x = (unsigned)ktv[c][0] | ((unsigned)ktv[c][1] << 16); v.y = (unsigned)ktv[c][2] | ((unsigned)ktv[c][3] << 16);
            *(u32x2*)&Kt[(c0 + c) * 72 + l0] = v;
        }
    }
    {
        const int vp = t & 63, vq = t >> 6;
        unsigned vr[8];
#pragma unroll
        for (int i = 0; i < 8; ++i) vr[i] = *(const unsigned*)&Vraw[(vq * 8 + i) * 136 + 2 * vp];
        u32x4 lo, hi;
        lo.x = (vr[0] & 0xffffu) | (vr[1] << 16); lo.y = (vr[2] & 0xffffu) | (vr[3] << 16); lo.z = (vr[4] & 0xffffu) | (vr[5] << 16); lo.w = (vr[6] & 0xffffu) | (vr[7] << 16);
        hi.x = (vr[0] >> 16) | (vr[1] & 0xffff0000u); hi.y = (vr[2] >> 16) | (vr[3] & 0xffff0000u); hi.z = (vr[4] >> 16) | (vr[5] & 0xffff0000u); hi.w = (vr[6] >> 16) | (vr[7] & 0xffff0000u);
        *(u32x4*)&Vt[(2 * vp) * 72 + vq * 8] = lo;
        *(u32x4*)&Vt[(2 * vp + 1) * 72 + vq * 8] = hi;
    }
    lds_sync();
}

DEVINL bf16x8 ldfrag(const bf16_t* base, int ld, int fr, int fq, int k0) { return *(const bf16x8*)(base + fr * ld + k0 + fq * 8); }

template <int DK, bool GLA, int DIR>
DEVINL void rec_load_a2(const Params& p, int h, float (&a2c)[2][16], float (&abv)[2]) {
#pragma unroll
    for (int c = 0; c < 2; ++c) { abv[c] = 0.f;
#pragma unroll
        for (int r = 0; r < 16; ++r) a2c[c][r] = 0.f; }
    if (GLA) {
        const int c0 = (tid_opaque() % (DK / 2)) * 2;
#pragma unroll
        for (int c = 0; c < 2; ++c) {
#pragma unroll
            for (int r = 0; r < 16; ++r) a2c[c][r] = p.gla_a2[(DIR * 16 + r) * 256 + h * 64 + c0 + c];
            abv[c] = p.gla_ab[DIR * 256 + h * 64 + c0 + c];
        }
    }
}

template <int DK, bool GLA, int DIR>
DEVINL void rec_pass1_unit(const Params& p, char* smem, const bf16_t* P, int b, int h, int cg, float* slots, float* decs) {
    using L = RecL<DK>; using G = RecGeo<DK, GLA>;
    constexpr int KT = G::KT;
    bf16_t* Kt = (bf16_t*)(smem + L::oKt); bf16_t* Vt = (bf16_t*)(smem + L::oVt); float* emid = (float*)(smem + L::oEmid);
    const int t = tid_opaque(), w = t >> 6, lane = t & 63, fr = lane & 15, fq = lane >> 4;
    float a2c[2][16], abv[2];
    rec_load_a2<DK, GLA, DIR>(p, h, a2c, abv);
    f32x4 accS[KT];
#pragma unroll
    for (int kt = 0; kt < KT; ++kt) accS[kt] = (f32x4){0.f, 0.f, 0.f, 0.f};
    float bsum[2] = {0.f, 0.f};
    const int nch = (cg == 0) ? 4 : G::GC;
    auto chunk_row0 = [&](int ci) { const int pc = (cg == 0) ? (DIR == 0 ? ci : 3 - ci) : (DIR == 0 ? (4 + (cg - 1) * G::GC + ci) : (67 - (cg - 1) * G::GC - ci)); return b * RPB + pc * 64; };
    RawRegs raw;
    rec_load_raw<DK, GLA, DIR, false>(p, P, chunk_row0(0), h, raw);
    for (int ci = 0; ci < nch; ++ci) {
        const bool has_next = ci + 1 < nch;
        rec_prep<DK, GLA, DIR, false>(p, smem, P, raw, has_next, has_next ? chunk_row0(ci + 1) : 0, h, a2c, abv, bsum);
        bf16x8 av[2];
#pragma unroll
        for (int ks = 0; ks < 2; ++ks) av[ks] = ldfrag(Vt + (w * 16) * 72, 72, fr, fq, ks * 32);
#pragma unroll
        for (int kt = 0; kt < KT; ++kt) {
            const f32x4 e4 = *(const f32x4*)&emid[kt * 16 + fq * 4];
            f32x4 c = accS[kt] * e4;
#pragma unroll
            for (int ks = 0; ks < 2; ++ks) c = __builtin_amdgcn_mfma_f32_16x16x32_bf16(ldfrag(Kt + (kt * 16) * 72, 72, fr, fq, ks * 32), av[ks], c, 0, 0, 0);
            accS[kt] = c;
        }
        lds_sync();
    }
    const size_t chain = ((size_t)(b * G::H + h) * 2 + DIR);
    float* sl = slots + (chain * G::NS + cg) * (size_t)(128 * DK);
#pragma unroll
    for (int kt = 0; kt < KT; ++kt) *(f32x4*)&sl[(w * 16 + fr) * DK + kt * 16 + fq * 4] = accS[kt];
    if (t < DK / 2) { decs[(chain * G::NS + cg) * DK + 2 * t] = bsum[0]; decs[(chain * G::NS + cg) * DK + 2 * t + 1] = bsum[1]; }
}

template <int DK, bool GLA, int DIR>
DEVINL void rec_pass3_chunk(const Params& p, char* smem, const bf16_t* P, bf16_t* CAT, int row0, int h, f32x4 (&accS)[DK / 16], const float* gnorm) {
    using L = RecL<DK>; using C = RecCols<GLA>;
    constexpr int KT = DK / 16, QS = L::QS, KS = DK / 32;
    bf16_t* Qs = (bf16_t*)(smem + L::oQs); bf16_t* Ks = (bf16_t*)(smem + L::oKs); bf16_t* Kt = (bf16_t*)(smem + L::oKt); bf16_t* Vt = (bf16_t*)(smem + L::oVt);
    bf16_t* At = (bf16_t*)(smem + L::oAt); bf16_t* St = (bf16_t*)(smem + L::oSt);
    float* emid = (float*)(smem + L::oEmid); float* eend = (float*)(smem + L::oEend); float* red = (float*)(smem + L::oRed);
    const int t = tid_opaque(), w = t >> 6, lane = t & 63, fr = lane & 15, fq = lane >> 4;
    u32x2 obv[4], gbv[4];
    if (DIR == 0) {
        const size_t prow = (size_t)(row0 + (w & 3) * 16 + fr);
        const bf16_t* cp0 = CAT + prow * 1024 + h * 128 + (w >> 2) * 64 + fq * 4;
        const bf16_t* gp0 = P + prow * C::LDP + C::GOFF + h * 128 + (w >> 2) * 64 + fq * 4;
#pragma unroll
        for (int n = 0; n < 4; ++n) { obv[n] = *(const u32x2*)(cp0 + n * 16); gbv[n] = *(const u32x2*)(gp0 + n * 16); }
    }
#pragma unroll
    for (int kt = 0; kt < KT; ++kt) {
        const f32x4 e4 = *(const f32x4*)&emid[kt * 16 + fq * 4];
        accS[kt] = accS[kt] * e4;
        *(u32x2*)&St[(w * 16 + fr) * QS + kt * 16 + fq * 4] = pk4(accS[kt]);
    }
    {
        const int lt = w >> 1, st0 = (w & 1) * 2;
        bf16x8 aq[KS];
#pragma unroll
        for (int ks = 0; ks < KS; ++ks) aq[ks] = ldfrag(Qs + (lt * 16) * QS, QS, fr, fq, ks * 32);
#pragma unroll
        for (int s2 = 0; s2 < 2; ++s2) {
            const int st = st0 + s2;
            f32x4 c = (f32x4){0.f, 0.f, 0.f, 0.f};
#pragma unroll
            for (int ks = 0; ks < KS; ++ks) c = __builtin_amdgcn_mfma_f32_16x16x32_bf16(ldfrag(Ks + (st * 16) * QS, QS, fr, fq, ks * 32), aq[ks], c, 0, 0, 0);
            const int l = lt * 16 + fr;
#pragma unroll
            for (int j = 0; j < 4; ++j) { const int sidx = st * 16 + fq * 4 + j; const bool keep = (DIR == 0) ? (sidx <= l) : (sidx >= l); c[j] = keep ? c[j] : 0.f; }
            *(u32x2*)&At[l * 72 + st * 16 + fq * 4] = pk4(c);
        }
    }
    lds_sync();
    const int lt = w & 3, vt0 = (w >> 2) * 4;
    f32x4 o[4];
    {
        bf16x8 aa[2], aq[KS];
#pragma unroll
        for (int ks = 0; ks < 2; ++ks) aa[ks] = ldfrag(At + (lt * 16) * 72, 72, fr, fq, ks * 32);
#pragma unroll
        for (int ks = 0; ks < KS; ++ks) aq[ks] = ldfrag(Qs + (lt * 16) * QS, QS, fr, fq, ks * 32);
#pragma unroll
        for (int n = 0; n < 4; ++n) {
            const int vt = vt0 + n;
            f32x4 c = (f32x4){0.f, 0.f, 0.f, 0.f};
#pragma unroll
            for (int ks = 0; ks < 2; ++ks) c = __builtin_amdgcn_mfma_f32_16x16x32_bf16(ldfrag(Vt + (vt * 16) * 72, 72, fr, fq, ks * 32), aa[ks], c, 0, 0, 0);
#pragma unroll
            for (int ks = 0; ks < KS; ++ks) c = __builtin_amdgcn_mfma_f32_16x16x32_bf16(ldfrag(St + (vt * 16) * QS, QS, fr, fq, ks * 32), aq[ks], c, 0, 0, 0);
            o[n] = c;
        }
    }
    {
        bf16x8 av[2];
#pragma unroll
        for (int ks = 0; ks < 2; ++ks) av[ks] = ldfrag(Vt + (w * 16) * 72, 72, fr, fq, ks * 32);
#pragma unroll
        for (int kt = 0; kt < KT; ++kt) {
            f32x4 c = accS[kt];
#pragma unroll
            for (int ks = 0; ks < 2; ++ks) c = __builtin_amdgcn_mfma_f32_16x16x32_bf16(ldfrag(Kt + (kt * 16) * 72, 72, fr, fq, ks * 32), av[ks], c, 0, 0, 0);
            const f32x4 e4 = *(const f32x4*)&eend[kt * 16 + fq * 4];
            accS[kt] = c * e4;
        }
    }
    const int l = lt * 16 + fr;
    const size_t row = (size_t)(row0 + l);
    bf16_t* cp = CAT + row * 1024 + h * 128 + vt0 * 16 + fq * 4;
    if (DIR == 1) {
#pragma unroll
        for (int n = 0; n < 4; ++n) *(u32x2*)(cp + n * 16) = pk4(o[n]);
    } else {
        float ss = 0.f;
#pragma unroll
        for (int n = 0; n < 4; ++n) {
            const u32x2 ob = obv[n];
            o[n][0] += bf2f((bf16_t)(ob.x & 0xffff)); o[n][1] += bf2f((bf16_t)(ob.x >> 16));
            o[n][2] += bf2f((bf16_t)(ob.y & 0xffff)); o[n][3] += bf2f((bf16_t)(ob.y >> 16));
            ss += o[n][0] * o[n][0] + o[n][1] * o[n][1] + o[n][2] * o[n][2] + o[n][3] * o[n][3];
        }
        ss += __shfl_xor(ss, 16);
        ss += __shfl_xor(ss, 32);
        if (fq == 0) red[l * 2 + (w >> 2)] = ss;
        lds_sync();
        const float tot = red[l * 2] + red[l * 2 + 1];
        const float rstd = rsqrtf(tot * (1.0f / 128.0f) + EPS);
#pragma unroll
        for (int n = 0; n < 4; ++n) {
            const u32x2 gb = gbv[n];
            const f32x4 gn = *(const f32x4*)(gnorm + vt0 * 16 + n * 16 + fq * 4);
            f32x4 gv;
            gv[0] = bf2f((bf16_t)(gb.x & 0xffff)); gv[1] = bf2f((bf16_t)(gb.x >> 16)); gv[2] = bf2f((bf16_t)(gb.y & 0xffff)); gv[3] = bf2f((bf16_t)(gb.y >> 16));
            f32x4 r4;
#pragma unroll
            for (int j = 0; j < 4; ++j) { const float g = GLA ? siluf_(gv[j]) : gv[j]; r4[j] = o[n][j] * rstd * gn[j] * g; }
            *(u32x2*)(cp + n * 16) = pk4(r4);
        }
    }
    lds_sync();
}

template <int DK, bool GLA, int DIR, int PRB = 0>
DEVINL void rec_pass3_sweep(const Params& p, char* smem, const bf16_t* P, bf16_t* CAT, int b, int h, int c_lo, int nch, int slot, const float* slots, const float* gnorm) {
    using G = RecGeo<DK, GLA>;
    constexpr int KT = G::KT;
    const int t = tid_opaque(), w = t >> 6, lane = t & 63, fr = lane & 15, fq = lane >> 4;
    float a2c[2][16], abv[2];
    rec_load_a2<DK, GLA, DIR>(p, h, a2c, abv);
    f32x4 accS[KT];
    if (slot >= 0) {
        const size_t chain = ((size_t)(b * G::H + h) * 2 + DIR);
        const float* sl = slots + (chain * G::NS + slot) * (size_t)(128 * DK);
#pragma unroll
        for (int kt = 0; kt < KT; ++kt) accS[kt] = *(const f32x4*)&sl[(w * 16 + fr) * DK + kt * 16 + fq * 4];
    } else {
#pragma unroll
        for (int kt = 0; kt < KT; ++kt) accS[kt] = (f32x4){0.f, 0.f, 0.f, 0.f};
    }
    float bsum[2] = {0.f, 0.f};
    float* gn_lds = (float*)(smem + RecL<DK>::oRed + 64 * 2 * 4);
    if (DIR == 0) { if (t < 128) gn_lds[t] = gnorm[t]; }
    auto chunk_row0 = [&](int ci) { const int pc = (DIR == 0) ? (c_lo + ci) : (c_lo + nch - 1 - ci); return b * RPB + pc * 64; };
    RawRegs raw;
    rec_load_raw<DK, GLA, DIR, true>(p, P, chunk_row0(0), h, raw);
    for (int ci = 0; ci < nch; ++ci) {
        const bool has_next = ci + 1 < nch;
        if (PRB != 2 || ci == 0) rec_prep<DK, GLA, DIR, true>(p, smem, P, raw, has_next, has_next ? chunk_row0(ci + 1) : 0, h, a2c, abv, bsum);
        if (PRB != 1) rec_pass3_chunk<DK, GLA, DIR>(p, smem, P, CAT, chunk_row0(ci), h, accS, gn_lds);
    }
}

template <int DK, bool GLA, int PRB = 0>
DEVINL void rec_pass3_unit(const Params& p, char* smem, const bf16_t* P, bf16_t* CAT, int b, int h, int gi, const float* slots, const float* gnorm) {
    using G = RecGeo<DK, GLA>;
    int c_lo, nch, slot_f, slot_b;
    if (GLA) {
        if (gi == 0) { c_lo = 0; nch = 4; slot_f = -1; slot_b = -1; }
        else { const int pg = gi - 1; c_lo = 4 + pg * G::GC; nch = G::GC; slot_f = pg; slot_b = G::NS - 1 - pg; }
    } else { const int pg = gi; c_lo = 4 + pg * G::GC; nch = G::GC; slot_f = pg; slot_b = G::NS - 1 - pg; }
    rec_pass3_sweep<DK, GLA, 1, PRB>(p, smem, P, CAT, b, h, c_lo, nch, slot_b, slots, gnorm);
    asm volatile("s_waitcnt vmcnt(0)" ::: "memory");
    rec_pass3_sweep<DK, GLA, 0, PRB>(p, smem, P, CAT, b, h, c_lo, nch, slot_f, slots, gnorm);
}

template <int DK, bool GLA>
DEVINL void rec_scan(float* slots, const float* decs, int bid, int nb) {
    using G = RecGeo<DK, GLA>;
    constexpr int NCHAIN = NBATCH * G::H * 2, PER = 128 * DK / 4;
    const int total = NCHAIN * PER;
    for (int i = bid * NTHR + tid_opaque(); i < total; i += nb * NTHR) {
        const int chain = i / PER, e = i - chain * PER;
        const int k4 = (e * 4) % DK;
        f32x4 run = (f32x4){0.f, 0.f, 0.f, 0.f};
#pragma unroll 1
        for (int s0 = 0; s0 < G::NS; s0 += 8) {
            f32x4 a[8], d4[8];
#pragma unroll
            for (int j = 0; j < 8; ++j) {
                d4[j] = *(const f32x4*)&decs[((size_t)chain * G::NS + s0 + j) * DK + k4];
                a[j] = *(const f32x4*)(slots + ((size_t)chain * G::NS + s0 + j) * (size_t)(128 * DK) + (size_t)e * 4);
            }
#pragma unroll
            for (int j = 0; j < 8; ++j) {
#pragma unroll
                for (int q = 0; q < 4; ++q) run[q] = __expf(d4[j][q]) * run[q] + a[j][q];
                *(f32x4*)(slots + ((size_t)chain * G::NS + s0 + j) * (size_t)(128 * DK) + (size_t)e * 4) = run;
            }
        }
    }
}

DEVINL size_t s5_idx(int b, int di, int pc, int g, int pp) { return ((((size_t)(b * 2 + di) * NCH + pc) * 32 + g) * 64 + pp) * 2; }

constexpr int S5_BU_LD = 20;
constexpr int S5_WAVE_LDS = 128 * S5_BU_LD * 4 + 16 * 136 * 2;
static_assert(8 * S5_WAVE_LDS <= LDS_BYTES, "s5 lds");

DEVINL void s5_load_afr(const Params& p, int row0, int g, int fr, int fq, bf16x8 (&afr)[4]) {
    const bf16x8 z = (bf16x8){0, 0, 0, 0, 0, 0, 0, 0};
#pragma unroll
    for (int sb = 0; sb < 4; ++sb) afr[sb] = (fq < 2) ? *(const bf16x8*)(p.P + (size_t)(row0 + sb * 16 + fr) * 2048 + 1536 + g * 16 + fq * 8) : z;
}
DEVINL void s5_load_bfr(const Params& p, int di, int g, int fr, int fq, bf16x8 (&bfr)[8]) {
    const bf16x8 z = (bf16x8){0, 0, 0, 0, 0, 0, 0, 0};
#pragma unroll
    for (int nt = 0; nt < 8; ++nt) bfr[nt] = (fq < 2) ? *(const bf16x8*)(p.bbm + ((size_t)((di * 32 + g) * 128 + nt * 16 + fr)) * 16 + fq * 8) : z;
}
DEVINL void s5_bu_subblock(float* BuT, const bf16x8& a, const bf16x8 (&bfr)[8], int fr, int fq) {
#pragma unroll
    for (int nt = 0; nt < 8; ++nt) {
        f32x4 c = (f32x4){0.f, 0.f, 0.f, 0.f};
        c = __builtin_amdgcn_mfma_f32_16x16x32_bf16(a, bfr[nt], c, 0, 0, 0);
        *(f32x4*)&BuT[(nt * 16 + fr) * S5_BU_LD + fq * 4] = c;
    }
}
template <int DIR, bool XS>
DEVINL void s5_scan16(const float* BuT, bf16_t* Xs, int lane, float are, float aim, float& xr, float& xi) {
    f32x4 br[4], bi[4];
#pragma unroll
    for (int q = 0; q < 4; ++q) { br[q] = *(const f32x4*)&BuT[lane * S5_BU_LD + q * 4]; bi[q] = *(const f32x4*)&BuT[(64 + lane) * S5_BU_LD + q * 4]; }
#pragma unroll
    for (int tt = 0; tt < 16; ++tt) {
        const int tl = DIR ? (15 - tt) : tt;
        const float nr = are * xr - aim * xi + br[tl >> 2][tl & 3], ni = are * xi + aim * xr + bi[tl >> 2][tl & 3];
        xr = nr; xi = ni;
        if (XS) *(unsigned*)&Xs[tl * 136 + 2 * lane] = cvt_pk_bf16(xr, xi);
    }
}
template <int DIR>
DEVINL void s5_pass1_task(const Params& p, float* BuT, int b, int pc, int g, const bf16x8 (&afr)[4], int lane, int fr, int fq) {
    bf16x8 bfr[8];
    s5_load_bfr(p, DIR, g, fr, fq, bfr);
    const float are = p.atab[((DIR * 32 + g) * 64 + lane) * 2], aim = p.atab[((DIR * 32 + g) * 64 + lane) * 2 + 1];
    float xr = 0.f, xi = 0.f;
#pragma unroll
    for (int sbi = 0; sbi < 4; ++sbi) {
        const int sb = DIR ? (3 - sbi) : sbi;
        s5_bu_subblock(BuT, afr[sb], bfr, fr, fq);
        asm volatile("s_waitcnt lgkmcnt(0)" ::: "memory");
        s5_scan16<DIR, false>(BuT, nullptr, lane, are, aim, xr, xi);
        asm volatile("s_waitcnt lgkmcnt(0)" ::: "memory");
    }
    float* o = p.s5xend + s5_idx(b, DIR, pc, g, lane);
    o[0] = xr; o[1] = xi;
}
DEVINL void s5_pass1_unit(const Params& p, char* smem, int b, int pc, int half) {
    const int t = tid_opaque(), w = t >> 6, lane = t & 63, fr = lane & 15, fq = lane >> 4;
    float* BuT = (float*)(smem + w * S5_WAVE_LDS);
    const int row0 = b * RPB + pc * 64;
#pragma unroll 1
    for (int q = 0; q < 2; ++q) {
        const int g = half * 16 + w * 2 + q;
        bf16x8 afr[4];
        s5_load_afr(p, row0, g, fr, fq, afr);
        s5_pass1_task<0>(p, BuT, b, pc, g, afr, lane, fr, fq);
        s5_pass1_task<1>(p, BuT, b, pc, g, afr, lane, fr, fq);
    }
}
DEVINL void s5_scan(const Params& p, int bid, int nb) {
    for (int i = bid * NTHR + tid_opaque(); i < NBATCH * 2 * 32 * 64; i += nb * NTHR) {
        const int pp = i & 63, g = (i >> 6) & 31, di = (i >> 11) & 1, b = i >> 12;
        const float ar = p.a64tab[((di * 32 + g) * 64 + pp) * 2], ai = p.a64tab[((di * 32 + g) * 64 + pp) * 2 + 1];
        float cr = 0.f, ci = 0.f;
#pragma unroll 1
        for (int c0 = 0; c0 < NCH; c0 += 17) {
            float er[17], ei[17];
#pragma unroll
            for (int j = 0; j < 17; ++j) {
                const int ch = c0 + j, pc = di ? (ch < 4 ? 3 - ch : 71 - ch) : ch;
                const size_t ix = s5_idx(b, di, pc, g, pp);
                er[j] = p.s5xend[ix]; ei[j] = p.s5xend[ix + 1];
            }
#pragma unroll
            for (int j = 0; j < 17; ++j) {
                const int ch = c0 + j, pc = di ? (ch < 4 ? 3 - ch : 71 - ch) : ch;
                const size_t ix = s5_idx(b, di, pc, g, pp);
                p.s5carry[ix] = cr; p.s5carry[ix + 1] = ci;
                const float nr = ar * cr - ai * ci + er[j], ni = ar * ci + ai * cr + ei[j];
                cr = nr; ci = ni;
            }
        }
    }
}
template <int DIR>
DEVINL void s5_pass3_task(const Params& p, float* BuT, bf16_t* Xs, int b, int pc, int g, const bf16x8 (&afr)[4], f32x4 (&acc)[4], int lane, int fr, int fq) {
    bf16x8 bfr[8];
    s5_load_bfr(p, DIR, g, fr, fq, bfr);
    bf16x8 cb[4];
#pragma unroll
    for (int ks = 0; ks < 4; ++ks) cb[ks] = *(const bf16x8*)(p.cmt + ((size_t)(g * 16 + fr)) * 256 + DIR * 128 + ks * 32 + fq * 8);
    const float are = p.atab[((DIR * 32 + g) * 64 + lane) * 2], aim = p.atab[((DIR * 32 + g) * 64 + lane) * 2 + 1];
    const size_t cix = s5_idx(b, DIR, pc, g, lane);
    float xr = p.s5carry[cix], xi = p.s5carry[cix + 1];
#pragma unroll
    for (int sbi = 0; sbi < 4; ++sbi) {
        const int sb = DIR ? (3 - sbi) : sbi;
        s5_bu_subblock(BuT, afr[sb], bfr, fr, fq);
        asm volatile("s_waitcnt lgkmcnt(0)" ::: "memory");
        s5_scan16<DIR, true>(BuT, Xs, lane, are, aim, xr, xi);
        asm volatile("s_waitcnt lgkmcnt(0)" ::: "memory");
        f32x4 c = acc[sb];
#pragma unroll
        for (int ks = 0; ks < 4; ++ks) {
            const bf16x8 a = *(const bf16x8*)(Xs + fr * 136 + ks * 32 + fq * 8);
            c = __builtin_amdgcn_mfma_f32_16x16x32_bf16(cb[ks], a, c, 0, 0, 0);
        }
        acc[sb] = c;
        asm volatile("s_waitcnt lgkmcnt(0)" ::: "memory");
    }
}
DEVINL void s5_pass3_unit(const Params& p, char* smem, int b, int pc, int half) {
    const int t = tid_opaque(), w = t >> 6, lane = t & 63, fr = lane & 15, fq = lane >> 4;
    float* BuT = (float*)(smem + w * S5_WAVE_LDS);
    bf16_t* Xs = (bf16_t*)(smem + w * S5_WAVE_LDS + 128 * S5_BU_LD * 4);
    const int row0 = b * RPB + pc * 64;
#pragma unroll 1
    for (int q = 0; q < 2; ++q) {
        const int g = half * 16 + w * 2 + q;
        bf16x8 afr[4];
        s5_load_afr(p, row0, g, fr, fq, afr);
        f32x4 acc[4];
#pragma unroll
        for (int sb = 0; sb < 4; ++sb) acc[sb] = (f32x4){0.f, 0.f, 0.f, 0.f};
        s5_pass3_task<1>(p, BuT, Xs, b, pc, g, afr, acc, lane, fr, fq);
        s5_pass3_task<0>(p, BuT, Xs, b, pc, g, afr, acc, lane, fr, fq);
        const f32x4 d4 = *(const f32x4*)(p.s5_d + g * 16 + fq * 4);
#pragma unroll
        for (int sb = 0; sb < 4; ++sb) {
            const int tok = sb * 16 + fr;
            const u32x2 ub = *(const u32x2*)(p.P + (size_t)(row0 + tok) * 2048 + 1536 + g * 16 + fq * 4);
            f32x4 uv; uv[0] = bf2f((bf16_t)(ub.x & 0xffff)); uv[1] = bf2f((bf16_t)(ub.x >> 16)); uv[2] = bf2f((bf16_t)(ub.y & 0xffff)); uv[3] = bf2f((bf16_t)(ub.y >> 16));
            f32x4 r4;
#pragma unroll
            for (int j = 0; j < 4; ++j) r4[j] = gelu_tanh(acc[sb][j] + d4[j] * uv[j]);
            *(u32x2*)(p.s5a + (size_t)(row0 + tok) * 512 + g * 16 + fq * 4) = pk4(r4);
        }
    }
}

struct UnitQueue {
    int* counter; int* slot; int total, shard, k, pend, per;
    static constexpr int NSH = 32;
    DEVINL void init(int* heads, int q, char* smem, int total_, int bid, int nb) {
        shard = sgpr(bid) & (NSH - 1); counter = heads + (q * NSH + shard) * 16; slot = (int*)(smem + LDS_BYTES - 64); total = total_;
        per = (sgpr(nb) - 1 - shard) / NSH + 1;
        k = sgpr(bid) >> 5; pend = 0;
        if (tid_opaque() == 0) pend = atomicAdd(counter, 1) + per;
    }
    DEVINL int unit() const { return shard + NSH * k; }
    DEVINL bool valid() const { return unit() < total; }
    DEVINL void advance() {
        if (tid_opaque() == 0) { *slot = pend; pend = atomicAdd(counter, 1) + per; }
        lds_sync();
        k = sgpr(*slot);
        lds_sync();
    }
};

DEVINL void phase_prologue(const Params& p, char* smem, int bid, int nb) {
    UnitQueue Q; Q.init(p.qheads, 0, smem, T0_END, bid, nb);
    for (; Q.valid(); Q.advance()) prologue_task(p, smem, Q.unit());
}

template <int LAYER>
DEVINL void phase_rec1(const Params& p, char* smem, int bid, int nb) {
    if (LAYER == 0) {
        constexpr int NG = 8 * 4 * 2 * 16;
        constexpr int NS5 = NBATCH * NCH * 2;
        UnitQueue Q; Q.init(p.qheads, 1, smem, NG + NS5, bid, nb);
        for (; Q.valid(); Q.advance()) {
            const int u = Q.unit();
            if (u < NG) {
                const int cg = u & 15, dir = (u >> 4) & 1, h = (u >> 5) & 3, b = u >> 7;
                if (dir == 0) rec_pass1_unit<64, true, 0>(p, smem, p.P, b, h, cg, p.gslots, p.gdecs);
                else rec_pass1_unit<64, true, 1>(p, smem, p.P, b, h, cg, p.gslots, p.gdecs);
            } else { const int v = u - NG; s5_pass1_unit(p, smem, (v >> 1) / NCH, (v >> 1) % NCH, v & 1); }
        }
    } else {
        constexpr int NG = 8 * 8 * 2 * 8;
        for (int u = bid; u < NG; u += nb) {
            const int cg = u & 7, dir = (u >> 3) & 1, h = (u >> 4) & 7, b = u >> 7;
            if (dir == 0) rec_pass1_unit<128, false, 0>(p, smem, p.P, b, h, cg, p.hslots, p.hdecs);
            else rec_pass1_unit<128, false, 1>(p, smem, p.P, b, h, cg, p.hslots, p.hdecs);
        }
    }
}
template <int LAYER>
DEVINL void phase_scan(const Params& p, char* smem, int bid, int nb) {
    if (LAYER == 0) { rec_scan<64, true>(p.gslots, p.gdecs, bid, nb); s5_scan(p, bid, nb); }
    else rec_scan<128, false>(p.hslots, p.hdecs, bid, nb);
}
template <int LAYER>
DEVINL void phase_rec3(const Params& p, char* smem, int bid, int nb) {
    if (LAYER == 0) {
        constexpr int NG = 8 * 4 * 17;
        constexpr int NS5 = NBATCH * NCH * 2;
        UnitQueue Q; Q.init(p.qheads, 2, smem, NG + NS5, bid, nb);
        for (; Q.valid(); Q.advance()) {
            const int u = Q.unit();
            if (u < NG) { const int gi = u % 17, h = (u / 17) & 3, b = u / 68; rec_pass3_unit<64, true>(p, smem, p.P, p.H, b, h, gi, p.gslots, p.gla_norm); }
            else { const int v = u - NG; s5_pass3_unit(p, smem, (v >> 1) / NCH, (v >> 1) % NCH, v & 1); }
        }
    } else {
        constexpr int NG = 8 * 8 * 8;
        for (int u = bid; u < NG; u += nb) { const int gi = u & 7, h = (u >> 3) & 7, b = u >> 6; rec_pass3_unit<128, false>(p, smem, p.P, p.H, b, h, gi, p.hslots, p.hg_norm); }
    }
}

DEVINL void phase_final(const Params& p, int bid, int nb) {
    const int t = tid_opaque(), w = t >> 6, lane = t & 63;
    f32x4 gn[4];
#pragma unroll
    for (int i = 0; i < 4; ++i) gn[i] = *(const f32x4*)(p.final_norm + lane * 4 + i * 256);
    for (int rg = bid; rg < NLAT / 16; rg += nb) {
        const int i0 = rg * 16 + w * 2, b = i0 >> 12;
        const float* gatev = p.mod + ((size_t)(9 + b)) * 6144 + 5120;
        f32x4 v[2][4], gu[4]; u32x2 ub[2][4];
#pragma unroll
        for (int rw = 0; rw < 2; ++rw) {
            const int i = i0 + rw;
            const int slot = p.sor[(i >> 12) * RPB + CTXL + (i & 4095)];
            const float* res = p.out + (size_t)i * D;
#pragma unroll
            for (int q = 0; q < 4; ++q) { v[rw][q] = *(const f32x4*)(res + lane * 4 + q * 256); ub[rw][q] = *(const u32x2*)(p.y2 + (size_t)slot * D + lane * 4 + q * 256); }
        }
#pragma unroll
        for (int q = 0; q < 4; ++q) gu[q] = *(const f32x4*)(gatev + lane * 4 + q * 256);
#pragma unroll
        for (int rw = 0; rw < 2; ++rw) {
            float* res = p.out + (size_t)(i0 + rw) * D;
            float ss = 0.f;
#pragma unroll
            for (int q = 0; q < 4; ++q) {
                const u32x2 u = ub[rw][q];
                v[rw][q][0] += gu[q][0] * bf2f((bf16_t)(u.x & 0xffffu)); v[rw][q][1] += gu[q][1] * bf2f((bf16_t)(u.x >> 16));
                v[rw][q][2] += gu[q][2] * bf2f((bf16_t)(u.y & 0xffffu)); v[rw][q][3] += gu[q][3] * bf2f((bf16_t)(u.y >> 16));
                ss += v[rw][q][0] * v[rw][q][0] + v[rw][q][1] * v[rw][q][1] + v[rw][q][2] * v[rw][q][2] + v[rw][q][3] * v[rw][q][3];
            }
#pragma unroll
            for (int o = 32; o >= 1; o >>= 1) ss += __shfl_xor(ss, o);
            const float rstd = rsqrtf(ss * (1.0f / 1024.0f) + EPS);
#pragma unroll
            for (int q = 0; q < 4; ++q) *(f32x4*)(res + lane * 4 + q * 256) = v[rw][q] * rstd * gn[q];
        }
    }
}

constexpr int NPHASE = 23;
constexpr int MEGA_LDS = LDS_BYTES + 16 + 1024;
static_assert(sizeof(Params) <= 1024 && sizeof(Params) % 8 == 0, "params block");
template <int PH>
DEVINL void run_phase(const Params& p, char* smem, int bid, int nb) {
    if (PH == 0) phase_prologue(p, smem, bid, nb);
    if (PH == 1) phase_pre<0>(p, smem, bid, nb);
    if (PH == 2) phase_gemm<0>(p, smem, bid, nb);
    if (PH == 3) phase_rec1<0>(p, smem, bid, nb);
    if (PH == 4) phase_scan<0>(p, smem, bid, nb);
    if (PH == 5) phase_rec3<0>(p, smem, bid, nb);
    if (PH == 6) phase_gemm<1>(p, smem, bid, nb);
    if (PH == 7) phase_gemm<2>(p, smem, bid, nb);
    if (PH == 8) phase_pre<1>(p, smem, bid, nb);
    if (PH == 9) phase_list<0>(p, smem, bid, nb);
    if (PH == 10) phase_moe<0, 1>(p, smem, bid, nb);
    if (PH == 11) phase_moe<0, 2>(p, smem, bid, nb);
    if (PH == 12) phase_pre<2>(p, smem, bid, nb);
    if (PH == 13) phase_gemm<3>(p, smem, bid, nb);
    if (PH == 14) phase_rec1<1>(p, smem, bid, nb);
    if (PH == 15) phase_scan<1>(p, smem, bid, nb);
    if (PH == 16) phase_rec3<1>(p, smem, bid, nb);
    if (PH == 17) phase_gemm<4>(p, smem, bid, nb);
    if (PH == 18) phase_pre<3>(p, smem, bid, nb);
    if (PH == 19) phase_list<1>(p, smem, bid, nb);
    if (PH == 20) phase_moe<1, 1>(p, smem, bid, nb);
    if (PH == 21) phase_moe<1, 2>(p, smem, bid, nb);
    if (PH == 22) phase_final(p, bid, nb);
}

extern __shared__ __attribute__((aligned(16))) char dyn_smem[];

#if ONE_LAUNCH
template <int PH> struct PhaseSeq {
    static DEVINL void run(const Params& p, char* smem, const XcdBarrier& bar) {
        PhaseSeq<PH - 1>::run(p, smem, bar);
        xcd_barrier(bar);
        run_phase<PH>(p, smem, (int)blockIdx.x, (int)gridDim.x);
#ifdef DUP_MASK
        if ((DUP_MASK >> PH) & 1) { xcd_barrier(bar); run_phase<PH>(p, smem, (int)blockIdx.x, (int)gridDim.x); }
#endif
    }
};
template <> struct PhaseSeq<0> {
    static DEVINL void run(const Params& p, char* smem, const XcdBarrier& bar) {
        run_phase<0>(p, smem, (int)blockIdx.x, (int)gridDim.x);
#ifdef DUP_MASK
        if (DUP_MASK & 1) { xcd_barrier(bar); run_phase<0>(p, smem, (int)blockIdx.x, (int)gridDim.x); }
#endif
    }
};
__global__ void __launch_bounds__(NTHR, 2) mega_kernel(Params p) {
    volatile LAS unsigned* st = (volatile LAS unsigned*)(dyn_smem + LDS_BYTES);
    if (threadIdx.x == 0) { st[0] = 0u; st[1] = 0u; st[2] = 0u; st[3] = 0u; }
    __syncthreads();
    XcdBarrier bar = xcd_barrier_post(p.bar, st);
#ifdef PROBE_ID
    {
        const int bid = (int)blockIdx.x, nb = (int)gridDim.x;
        if (PROBE_ID == 1) for (int v = bid; v < NBATCH * NCH * 2; v += nb) s5_pass1_unit(p, dyn_smem, (v >> 1) / NCH, (v >> 1) % NCH, v & 1);
        if (PROBE_ID == 2) for (int u = bid; u < 1024; u += nb) { const int cg = u & 15, dir = (u >> 4) & 1, h = (u >> 5) & 3, b = u >> 7;
            if (dir == 0) rec_pass1_unit<64, true, 0>(p, dyn_smem, p.P, b, h, cg, p.gslots, p.gdecs); else rec_pass1_unit<64, true, 1>(p, dyn_smem, p.P, b, h, cg, p.gslots, p.gdecs); }
        if (PROBE_ID == 3) for (int v = bid; v < NBATCH * NCH * 2; v += nb) s5_pass3_unit(p, dyn_smem, (v >> 1) / NCH, (v >> 1) % NCH, v & 1);
        if (PROBE_ID == 4) for (int u = bid; u < 8 * 4 * 17; u += nb) { const int gi = u % 17, h = (u / 17) & 3, b = u / 68; rec_pass3_unit<64, true>(p, dyn_smem, p.P, p.H, b, h, gi, p.gslots, p.gla_norm); }
        if (PROBE_ID == 6) for (int u = bid; u < 512; u += nb) { const int gi = u & 7, h = (u >> 3) & 7, b = u >> 6; rec_pass3_unit<128, false, RECPROBE>(p, dyn_smem, p.P, p.H, b, h, gi, p.hslots, p.hg_norm); }
        if (PROBE_ID == 5) for (int u = bid; u < 1024 + NBATCH * NCH * 2; u += nb) {
            if (u < 1024) { const int cg = u & 15, dir = (u >> 4) & 1, h = (u >> 5) & 3, b = u >> 7;
                if (dir == 0) rec_pass1_unit<64, true, 0>(p, dyn_smem, p.P, b, h, cg, p.gslots, p.gdecs); else rec_pass1_unit<64, true, 1>(p, dyn_smem, p.P, b, h, cg, p.gslots, p.gdecs); }
            else { const int v = u - 1024; s5_pass1_unit(p, dyn_smem, (v >> 1) / NCH, (v >> 1) % NCH, v & 1); } }
        xcd_barrier(bar);
    }
#endif
#ifdef PREFIX_K
    PhaseSeq<PREFIX_K>::run(p, dyn_smem, bar);
    xcd_barrier(bar);
    if (blockIdx.x == 0) { if (threadIdx.x < 256) p.cnt[threadIdx.x] = 0; for (int i = threadIdx.x; i < 3 * 32 * 16; i += NTHR) p.qheads[i] = 0; }
    xcd_barrier(bar);
#endif
    PhaseSeq<NPHASE - 1>::run(p, dyn_smem, bar);
}
#else
template <int PH>
__global__ void __launch_bounds__(NTHR, 2) phase_kernel(Params p) {
    run_phase<PH>(p, dyn_smem, (int)blockIdx.x, (int)gridDim.x);
}
template <int PH> struct Launcher {
    static void go(const Params& p, int grid, hipStream_t s) {
        Launcher<PH - 1>::go(p, grid, s);
        static bool attr = false;
        if (!attr) { hipFuncSetAttribute((const void*)phase_kernel<PH>, hipFuncAttributeMaxDynamicSharedMemorySize, LDS_BYTES + 16); attr = true; }
        phase_kernel<PH><<<grid, NTHR, LDS_BYTES + 16, s>>>(p);
    }
};
template <> struct Launcher<-1> { static void go(const Params&, int, hipStream_t) {} };
#endif

static size_t align_up(size_t v, size_t a) { return (v + a - 1) / a * a; }

extern "C" void kernel_launch(void* const* d_in, const int* in_sizes, int n_in, void* d_out, int out_size, void* d_ws, size_t ws_size, hipStream_t stream) {
    (void)in_sizes; (void)n_in; (void)out_size;
    Params p;
    memset(&p, 0, sizeof(p));
    const float* const* in = (const float* const*)d_in;
    p.x = in[0]; p.c = in[1]; p.ctx = in[2]; p.c_ctx = in[3]; p.ada_w = in[4]; p.ada_b = in[5]; p.norm_mix = in[6]; p.norm_ffn = in[7];
    p.ab_w_in = in[8]; p.ab_w_out = in[9]; p.gla_a2 = in[10]; p.gla_ab = in[11]; p.gla_norm = in[12];
    p.s5_lam_re = in[13]; p.s5_lam_im = in[14]; p.s5_log_dt = in[15]; p.s5_b_re = in[16]; p.s5_b_im = in[17]; p.s5_c_re = in[18]; p.s5_c_im = in[19];
    p.s5_d = in[20]; p.glu_w = in[21]; p.glu_b = in[22]; p.hg_w_in = in[23]; p.hg_w_out = in[24]; p.hg_lb = in[25]; p.hg_norm = in[26];
    p.router_w = in[27]; p.router_bias = in[28]; p.moe_wg = in[29]; p.moe_wu = in[30]; p.moe_wd = in[31]; p.final_norm = in[32];
    p.out = (float*)d_out;

    char* ws = (char*)d_ws;
    size_t o = 0;
    auto take = [&](size_t bytes) { char* r = ws + o; o = align_up(o + bytes, 256); return r; };
    p.bar = (unsigned*)take(XCD_BAR_WORDS * 4);
    p.cnt = (int*)take(256 * 4);
    p.qheads = (int*)take(3 * 32 * 16 * 4);
    p.mod = (float*)take((size_t)2 * 9 * 6144 * 4);
    p.pos = (float*)take(64 * 512 * 4);
    p.lb = (float*)take(1024 * 4);
    p.atab = (float*)take(2 * 32 * 64 * 2 * 4);
    p.a64tab = (float*)take(2 * 32 * 64 * 2 * 4);
    p.cmt = (bf16_t*)take((size_t)32 * 16 * 256 * 2);
    p.bbm = (bf16_t*)take((size_t)2 * 32 * 128 * 16 * 2);
    p.wrt = (bf16_t*)take((size_t)2 * 2 * 32 * 1024 * 2);
    p.RT = (float4*)take((size_t)R * 16);
    p.list = (int*)take((size_t)ACT_ROWS * 4);
    p.wl = (float*)take((size_t)ACT_ROWS * 4);
    p.wh = (float*)take((size_t)ACT_ROWS * 4);
    p.cx = (float*)take((size_t)NBATCH * CTXL * D * 4);
    p.sor = (int*)take((size_t)R * 4);
    p.blkcnt = (int*)take((size_t)2 * 256 * 48 * 4);
    p.wt_in0 = (bf16_t*)take((size_t)2048 * 1024 * 2);
    p.wt_out0 = (bf16_t*)take((size_t)1024 * 1024 * 2);
    p.glu_t = (bf16_t*)take((size_t)512 * 512 * 2);
    p.wt_in1 = (bf16_t*)take((size_t)5120 * 1024 * 2);
    p.wt_out1 = (bf16_t*)take((size_t)1024 * 1024 * 2);
    p.H = (bf16_t*)take((size_t)R * 1024 * 2);
    const size_t big = o;
    p.P = (bf16_t*)(ws + big);
    size_t o0 = big + (size_t)R * 2048 * 2;
    auto take0 = [&](size_t bytes) { char* r = ws + o0; o0 = align_up(o0 + bytes, 256); return r; };
    p.gslots = (float*)take0((size_t)64 * 16 * 128 * 64 * 4);
    p.gdecs = (float*)take0((size_t)64 * 16 * 64 * 4);
    p.s5xend = (float*)take0((size_t)NBATCH * 2 * NCH * 32 * 64 * 2 * 4);
    p.s5carry = (float*)take0((size_t)NBATCH * 2 * NCH * 32 * 64 * 2 * 4);
    p.s5a = (bf16_t*)take0((size_t)R * 512 * 2);
    p.AF = (float*)take0((size_t)R * 32 * 4);
    p.wgu_t = (bf16_t*)take0((size_t)32 * 512 * 1024 * 2);
    p.wd_t = (bf16_t*)take0((size_t)32 * 1024 * 256 * 2);
    p.hs = (bf16_t*)(ws + big);
    p.Y = (bf16_t*)(ws + big);
    p.y2 = (bf16_t*)(ws + big);
    p.act = (bf16_t*)(ws + big + (size_t)ACT_ROWS * 1024 * 2);
    if (big + (size_t)ACT_ROWS * 1024 * 2 + (size_t)ACT_ROWS * 512 * 2 > (size_t)((char*)p.s5a - ws)) fprintf(stderr, "moe overlay overlaps live buffers\n");
    size_t o1 = big + (size_t)R * 5120 * 2;
    auto take1 = [&](size_t bytes) { char* r = ws + o1; o1 = align_up(o1 + bytes, 256); return r; };
    p.hslots = (float*)take1((size_t)128 * 8 * 128 * 128 * 4);
    p.hdecs = (float*)take1((size_t)128 * 8 * 128 * 4);
    const size_t need = o0 > o1 ? o0 : o1;
    if (need > ws_size) fprintf(stderr, "workspace too small: need %zu have %zu\n", need, ws_size);

    static int grid = 0;
    if (!grid) {
        int dev = 0, cus = 0;
        if (hipGetDevice(&dev) != hipSuccess || hipDeviceGetAttribute(&cus, hipDeviceAttributeMultiprocessorCount, dev) != hipSuccess || cus <= 0) cus = 256;
        grid = cus > 256 ? 256 : (cus & ~7);
    }
#if ONE_LAUNCH
    static bool attr = false;
    if (!attr) { hipFuncSetAttribute((const void*)mega_kernel, hipFuncAttributeMaxDynamicSharedMemorySize, MEGA_LDS); attr = true; }
    hipMemsetAsync(p.bar, 0, XCD_BAR_WORDS * 4 + 256 * 4 + 3 * 32 * 16 * 4, stream);
    mega_kernel<<<grid, NTHR, MEGA_LDS, stream>>>(p);
#else
    Launcher<NPHASE - 1>::go(p, grid, stream);
#endif
}
```

```cpp
#include <hip/hip_runtime.h>
#include <stdint.h>
#include <string.h>
#include <stdio.h>

#ifndef ONE_LAUNCH
#define ONE_LAUNCH 1
#endif

typedef unsigned short bf16_t;
typedef short bf16x8 __attribute__((ext_vector_type(8)));
typedef float f32x4 __attribute__((ext_vector_type(4)));
typedef unsigned u32x4 __attribute__((ext_vector_type(4)));
typedef unsigned u32x2 __attribute__((ext_vector_type(2)));
#define DEVINL __device__ __forceinline__

constexpr int D = 1024, NBATCH = 8, SEQ = 4096, CTXL = 256;
constexpr int RPB = SEQ + CTXL;
constexpr int R = NBATCH * RPB;
constexpr int NLAT = NBATCH * SEQ;
constexpr int NCH = RPB / 64;
constexpr float EPS = 1e-6f;
constexpr int NTHR = 512;
constexpr int LDS_BYTES = 136 * 1024;
constexpr int ACT_ROWS = 47104;

#define XB_TMO      128
#define XB_XCNT(j)  (256  + 64 * (j))
#define XB_XSUB(j)  (1280 + 64 * (j))
#define XB_XGEN(j)  (2304 + 64 * (j))
#define XB_TOP      3328
#define XB_TOPGEN   3392
#define XCD_BAR_WORDS 3456
#define XB_SPIN_CAP (1u << 18)
#define LAS __attribute__((address_space(3)))

__device__ __forceinline__ unsigned xb_ld(unsigned* p)              { return __hip_atomic_load(p, __ATOMIC_RELAXED, __HIP_MEMORY_SCOPE_AGENT); }
__device__ __forceinline__ unsigned xb_add(unsigned* p, unsigned v) { return __hip_atomic_fetch_add(p, v, __ATOMIC_RELAXED, __HIP_MEMORY_SCOPE_AGENT); }
__device__ __forceinline__ unsigned xb_xcc_id() { return (unsigned)__builtin_amdgcn_s_getreg((3 << 11) | 20) & 0xFu; }
#define XB_SPIN(cond, bar) do { unsigned _sp = 0; while (cond) { __builtin_amdgcn_s_sleep(1); \
    if ((++_sp & 255u) == 0u) { if (xb_ld(&(bar)[XB_TMO])) break; if (_sp > XB_SPIN_CAP) { atomicAdd(&(bar)[XB_TMO], 1u); break; } } } } while (0)

struct XcdBarrier {
    unsigned* bar; unsigned x;
    volatile LAS unsigned* st;
};
__device__ __forceinline__ XcdBarrier xcd_barrier_post(unsigned* bar, volatile LAS unsigned* st) {
    XcdBarrier b; b.bar = bar; b.x = xb_xcc_id(); b.st = st;
    if (threadIdx.x == 0) (void)xb_add(&bar[XB_XCNT(b.x)], 1u);
    return b;
}
__device__ __forceinline__ void xcd_barrier_complete(unsigned* bar, unsigned x, unsigned& nloc, unsigned& nx) {
    const unsigned G = gridDim.x * gridDim.y * gridDim.z;
    unsigned sum, cnt, mine, sp = 0u;
    for (;;) {
        sum = 0u; cnt = 0u; mine = 0u;
#pragma unroll
        for (unsigned j = 0; j < 16; ++j) { const unsigned c = xb_ld(&bar[XB_XCNT(j)]); sum += c; cnt += (c > 0u) ? 1u : 0u; mine = (j == x) ? c : mine; }
        if (sum == G) break;
        __builtin_amdgcn_s_sleep(1);
        if ((++sp & 255u) == 0u) { if (xb_ld(&bar[XB_TMO])) break; if (sp > XB_SPIN_CAP) { atomicAdd(&bar[XB_TMO], 1u); break; } }
    }
    nloc = mine > 0u ? mine : 1u; nx = cnt > 0u ? cnt : 1u;
}
__device__ __forceinline__ void xcd_barrier(const XcdBarrier& b) {
    asm volatile("s_waitcnt vmcnt(0)" ::: "memory");
    __syncthreads();
    if (threadIdx.x == 0) {
        unsigned* bar = b.bar;
        __builtin_amdgcn_s_waitcnt(0);
        unsigned nloc = b.st[0], nx = b.st[1];
        if (nloc == 0u) { xcd_barrier_complete(bar, b.x, nloc, nx); b.st[0] = nloc; b.st[1] = nx; }
        const unsigned old = xb_add(&bar[XB_XSUB(b.x)], 1u);
        const unsigned gen = old / nloc;
        if (old + 1u == (gen + 1u) * nloc) {
            __builtin_amdgcn_fence(__ATOMIC_RELEASE, "agent");
            asm volatile("s_waitcnt vmcnt(0)" ::: "memory");
            const unsigned og = xb_add(&bar[XB_TOP], 1u);
            const unsigned tg = og / nx;
            if (og + 1u == (tg + 1u) * nx) xb_add(&bar[XB_TOPGEN], 1u);
            else XB_SPIN(xb_ld(&bar[XB_TOPGEN]) == tg, bar);
            __builtin_amdgcn_fence(__ATOMIC_ACQUIRE, "agent");
            xb_add(&bar[XB_XGEN(b.x)], 1u);
            asm volatile("s_waitcnt vmcnt(0)" ::: "memory");
        } else {
            XB_SPIN(xb_ld(&bar[XB_XGEN(b.x)]) == gen, bar);
            __builtin_amdgcn_fence(__ATOMIC_ACQUIRE, "agent");
            asm volatile("s_waitcnt vmcnt(0)" ::: "memory");
        }
    }
    __syncthreads();
}

struct Params {
    const float *x, *c, *ctx, *c_ctx, *ada_w, *ada_b, *norm_mix, *norm_ffn, *ab_w_in, *ab_w_out, *gla_a2, *gla_ab, *gla_norm;
    const float *s5_lam_re, *s5_lam_im, *s5_log_dt, *s5_b_re, *s5_b_im, *s5_c_re, *s5_c_im, *s5_d, *glu_w, *glu_b;
    const float *hg_w_in, *hg_w_out, *hg_lb, *hg_norm, *router_w, *router_bias, *moe_wg, *moe_wu, *moe_wd, *final_norm;
    float* out;
    unsigned* bar;
    int* qheads;
    int* cnt;
    float *mod, *pos, *lb, *atab, *a64tab;
    bf16_t* cmt; bf16_t* bbm; bf16_t* wrt;
    float4* RT;
    int* list; float *wl, *wh;
    float* cx;
    bf16_t* Y; bf16_t* y2;
    int* sor; int* blkcnt;
    bf16_t *wt_in0, *wt_out0, *glu_t, *wt_in1, *wt_out1;
    bf16_t* H;
    bf16_t* P;
    float *gslots, *gdecs;
    float *s5xend, *s5carry;
    bf16_t* s5a;
    bf16_t *wgu_t, *wd_t, *act, *hs;
    float* AF;
    float *hslots, *hdecs;
};

DEVINL int tid_opaque() { int t = threadIdx.x; asm volatile("" : "+v"(t)); return t; }
DEVINL void lds_sync() { asm volatile("s_waitcnt lgkmcnt(0)" ::: "memory"); __builtin_amdgcn_s_barrier(); asm volatile("" ::: "memory"); }

DEVINL int sgpr(int v) { return __builtin_amdgcn_readfirstlane(v); }
template <class T> DEVINL T* sgpr_ptr(T* ptr) {
    const unsigned long long v = (unsigned long long)ptr;
    const unsigned lo = (unsigned)__builtin_amdgcn_readfirstlane((int)(unsigned)v), hi = (unsigned)__builtin_amdgcn_readfirstlane((int)(unsigned)(v >> 32));
    return (T*)(__attribute__((address_space(1))) T*)(((unsigned long long)hi << 32) | lo);
}
DEVINL unsigned cvt_pk_bf16(float lo, float hi) { unsigned r; asm volatile("v_cvt_pk_bf16_f32 %0, %1, %2" : "=v"(r) : "v"(lo), "v"(hi)); return r; }
DEVINL float bf2f(bf16_t v) { return __uint_as_float(((unsigned)v) << 16); }
DEVINL bf16_t f2bf(float f) { unsigned u = __float_as_uint(f); u += 0x7fffu + ((u >> 16) & 1u); return (bf16_t)(u >> 16); }
DEVINL unsigned pk2(float lo, float hi) { return cvt_pk_bf16(lo, hi); }
DEVINL u32x2 pk4(f32x4 v) { u32x2 r; r.x = pk2(v[0], v[1]); r.y = pk2(v[2], v[3]); return r; }
DEVINL float h2f(unsigned short v) { return (float)__builtin_bit_cast(_Float16, v); }
DEVINL unsigned short f2h(float f) { return __builtin_bit_cast(unsigned short, (_Float16)f); }
DEVINL float sigmoidf_(float x) { return __builtin_amdgcn_rcpf(1.0f + __expf(-x)); }
DEVINL float siluf_(float x) { return x * sigmoidf_(x); }
DEVINL float logsigmoidf_(float x) { return fminf(x, 0.0f) - __logf(1.0f + __expf(-fabsf(x))); }
DEVINL float gelu_tanh(float y) { float z = 0.7978845608028654f * (y + 0.044715f * y * y * y); float th = 1.0f - 2.0f * __builtin_amdgcn_rcpf(__expf(2.0f * z) + 1.0f); return 0.5f * y * (1.0f + th); }
DEVINL float* resid_row(const Params& p, int r) {
    const int b = r / RPB, j = r - b * RPB;
    return (j < CTXL) ? (p.cx + (size_t)(b * CTXL + j) * D) : (p.out + (size_t)(b * SEQ + (j - CTXL)) * D);
}
DEVINL int row_batch_mod(int r) { const int b = r / RPB, j = r - b * RPB; return (j < CTXL) ? 8 : b; }

template <int K>
DEVINL f32x4 mma_lds(f32x4 c, const bf16_t* A, int lda, const bf16_t* Bt, int ldb, int fr, int fq) {
#pragma unroll
    for (int k0 = 0; k0 < K; k0 += 32) {
        const bf16x8 a = *(const bf16x8*)(A + fr * lda + k0 + fq * 8);
        const bf16x8 b = *(const bf16x8*)(Bt + fr * ldb + k0 + fq * 8);
        c = __builtin_amdgcn_mfma_f32_16x16x32_bf16(b, a, c, 0, 0, 0);
    }
    return c;
}

DEVINL void cvt_tile(const float* colp, int ld, int k0, int n0, bf16_t* dst, int ldd, char* smem, int lrow = -1) {
    float (*T)[257] = (float (*)[257])smem;
    const int t = tid_opaque(), nl = lrow >= 0 ? lrow : (t & 63), ks = t >> 6;
    const float* sp = colp + (size_t)(k0 + ks * 32) * ld;
#pragma unroll
    for (int i0 = 0; i0 < 32; i0 += 16) {
        float v[16];
#pragma unroll
        for (int i = 0; i < 16; ++i) v[i] = sp[(size_t)(i0 + i) * ld];
#pragma unroll
        for (int i = 0; i < 16; ++i) T[nl][ks * 32 + i0 + i] = v[i];
    }
    __syncthreads();
    const int n2 = t >> 3, kc = t & 7;
#pragma unroll
    for (int j = 0; j < 4; ++j) {
        const int k = j * 64 + kc * 8;
        u32x4 v;
        v.x = pk2(T[n2][k + 0], T[n2][k + 1]); v.y = pk2(T[n2][k + 2], T[n2][k + 3]);
        v.z = pk2(T[n2][k + 4], T[n2][k + 5]); v.w = pk2(T[n2][k + 6], T[n2][k + 7]);
        *(u32x4*)(dst + (size_t)(n0 + n2) * ldd + k0 + k) = v;
    }
    __syncthreads();
}

constexpr int NT_GU = 1024, NT_WD = 512;
DEVINL void moe_cvt_task(const Params& p, int layer, int tid, char* smem) {
    if (tid < NT_GU) {
        const int e = tid >> 5, rem = tid & 31, nb = rem >> 2, kb = rem & 3;
        const float* wg = p.moe_wg + (size_t)(layer * 32 + e) * 1024 * 256;
        const float* wu = p.moe_wu + (size_t)(layer * 32 + e) * 1024 * 256;
        const int nl = tid_opaque() & 63, isup = nl >> 5, ul = nl & 31;
        const int ub = (nb >> 2) * 128 + (nb & 3) * 32;
        const float* cp = (isup ? wu : wg) + ub + ul;
        const int lrow = (ul >> 2) * 8 + isup * 4 + (ul & 3);
        cvt_tile(cp, 256, kb * 256, nb * 64, p.wgu_t + (size_t)e * 512 * 1024, 1024, smem, lrow);
    } else {
        const int t2 = tid - NT_GU, e = t2 >> 4, nb = t2 & 15;
        const float* wd = p.moe_wd + (size_t)(layer * 32 + e) * 256 * 1024;
        cvt_tile(wd + nb * 64 + (tid_opaque() & 63), 1024, 0, nb * 64, p.wd_t + (size_t)e * 1024 * 256, 256, smem);
    }
}

constexpr int NT_MISC = 9, NT_MOD = 192, NT_IN0 = 128, NT_OUT0 = 64, NT_GLU = 16, NT_IN1 = 320, NT_OUT1 = 64, NT_POS = 64, NT_S5 = 64;
constexpr int T0_MOD = NT_MISC, T0_IN0 = T0_MOD + NT_MOD, T0_OUT0 = T0_IN0 + NT_IN0, T0_GLU = T0_OUT0 + NT_OUT0, T0_IN1 = T0_GLU + NT_GLU, T0_OUT1 = T0_IN1 + NT_IN1,
              T0_MOE = T0_OUT1 + NT_OUT1, T0_POS = T0_MOE + NT_GU + NT_WD, T0_S5 = T0_POS + NT_POS, T0_END = T0_S5 + NT_S5;

DEVINL void prologue_task(const Params& p, char* smem, int task) {
    const int t = tid_opaque();
    {
        if (task < T0_MOD) {
            if (task == 0) {
                for (int i = t; i < 1024; i += NTHR) p.lb[i] = sigmoidf_(p.hg_lb[1024 + i] - p.hg_lb[i]);
            } else {
                for (int i = (task - 1) * 8192 + t; i < task * 8192; i += NTHR) {
                    const int which = i >> 15, e = (i >> 10) & 31, k = i & 1023;
                    const float v = which ? p.ab_w_in[(size_t)k * 2080 + 1536 + e] : p.router_w[k * 32 + e];
                    const bf16_t hi = f2bf(v); const bf16_t lo = f2bf(v - bf2f(hi));
                    p.wrt[((size_t)(which * 2 + 0) * 32 + e) * 1024 + k] = hi;
                    p.wrt[((size_t)(which * 2 + 1) * 32 + e) * 1024 + k] = lo;
                }
            }
        } else if (task < T0_IN0) {
            float* sc = (float*)smem;
            float* red = sc + 9 * 1024;
            for (int i = t; i < 9 * 1024; i += NTHR) { const int rr = i >> 10, k = i & 1023; const float v = rr < 8 ? p.c[rr * 1024 + k] : p.c_ctx[k]; sc[i] = siluf_(v); }
            __syncthreads();
            const int tk = task - T0_MOD, l = tk / 96, c0 = (tk % 96) * 64, col = t & 63, kp = t >> 6;
            const float* wp = p.ada_w + ((size_t)l * 1024 + kp * 128) * 6144 + c0 + col;
            float acc[9];
#pragma unroll
            for (int rr = 0; rr < 9; ++rr) acc[rr] = 0.f;
#pragma unroll 1
            for (int k = 0; k < 128; k += 16) {
                float w16[16];
#pragma unroll
                for (int j = 0; j < 16; ++j) w16[j] = wp[(size_t)(k + j) * 6144];
#pragma unroll
                for (int rr = 0; rr < 9; ++rr) {
#pragma unroll
                    for (int j = 0; j < 16; j += 4) {
                        const f32x4 s4 = *(const f32x4*)&sc[rr * 1024 + kp * 128 + k + j];
                        acc[rr] += s4[0] * w16[j] + s4[1] * w16[j + 1] + s4[2] * w16[j + 2] + s4[3] * w16[j + 3];
                    }
                }
            }
#pragma unroll
            for (int rr = 0; rr < 9; ++rr) red[(kp * 9 + rr) * 64 + col] = acc[rr];
            __syncthreads();
            for (int o = t; o < 576; o += NTHR) {
                const int rr = o >> 6, cc = o & 63;
                float sv = p.ada_b[l * 6144 + c0 + cc];
#pragma unroll
                for (int q = 0; q < 8; ++q) sv += red[(q * 9 + rr) * 64 + cc];
                p.mod[((size_t)l * 9 + rr) * 6144 + c0 + cc] = sv;
            }
            __syncthreads();
        } else if (task < T0_OUT0) {
            const int tt = task - T0_IN0, nbk = tt >> 2, kb = tt & 3;
            const int n = nbk * 64 + (t & 63);
            const float* cp = p.ab_w_in + (n < 1536 ? n : n + 32);
            cvt_tile(cp, 2080, kb * 256, nbk * 64, p.wt_in0, 1024, smem);
        } else if (task < T0_GLU) {
            const int tt = task - T0_OUT0, nbk = tt >> 2, kb = tt & 3;
            cvt_tile(p.ab_w_out + nbk * 64 + (t & 63), 1024, kb * 256, nbk * 64, p.wt_out0, 1024, smem);
        } else if (task < T0_IN1) {
            const int tt = task - T0_GLU, nbk = tt >> 1, kb = tt & 1;
            cvt_tile(p.glu_w + nbk * 64 + (t & 63), 512, kb * 256, nbk * 64, p.glu_t, 512, smem);
        } else if (task < T0_OUT1) {
            const int tt = task - T0_IN1, nbk = tt >> 2, kb = tt & 3;
            cvt_tile(p.hg_w_in + nbk * 64 + (t & 63), 5120, kb * 256, nbk * 64, p.wt_in1, 1024, smem);
        } else if (task < T0_MOE) {
            const int tt = task - T0_OUT1, nbk = tt >> 2, kb = tt & 3;
            cvt_tile(p.hg_w_out + nbk * 64 + (t & 63), 1024, kb * 256, nbk * 64, p.wt_out1, 1024, smem);
        } else if (task < T0_POS) {
            moe_cvt_task(p, 0, task - T0_MOE, smem);
        } else if (task < T0_S5) {
            const int pi = task - T0_POS;
            const int j = t, jj = j & 255;
            const float omega = __expf(-9.210340371976184f * (float)jj * (1.0f / 256.0f));
            const float ang = (float)pi * omega;
            p.pos[pi * 512 + j] = (j < 256) ? sinf(ang) : cosf(ang);
        } else {
            const int tt = task - T0_S5, di = tt >> 5, g = tt & 31;
            const int pp = t & 63, hs = t >> 6;
            const float dt = __expf(p.s5_log_dt[di * 32 + g]);
            const float lr = p.s5_lam_re[(di * 32 + g) * 64 + pp], li = p.s5_lam_im[(di * 32 + g) * 64 + pp];
            const float mag = __expf(lr * dt);
            const float are = mag * cosf(li * dt), aim = mag * sinf(li * dt);
            const float den = lr * lr + li * li;
            const float fre = ((are - 1.0f) * lr + aim * li) / den;
            const float fim = (aim * lr - (are - 1.0f) * li) / den;
            if (hs == 0) {
                p.atab[((di * 32 + g) * 64 + pp) * 2 + 0] = are; p.atab[((di * 32 + g) * 64 + pp) * 2 + 1] = aim;
                float xr = are, xi = aim;
#pragma unroll
                for (int q = 0; q < 6; ++q) { const float nr = xr * xr - xi * xi, ni = 2.0f * xr * xi; xr = nr; xi = ni; }
                p.a64tab[((di * 32 + g) * 64 + pp) * 2 + 0] = xr; p.a64tab[((di * 32 + g) * 64 + pp) * 2 + 1] = xi;
            }
#pragma unroll
            for (int q = 0; q < 2; ++q) {
                const int h = hs * 2 + q;
                const float bre = p.s5_b_re[((size_t)((di * 32 + g) * 64 + pp)) * 16 + h], bim = p.s5_b_im[((size_t)((di * 32 + g) * 64 + pp)) * 16 + h];
                p.bbm[((size_t)((di * 32 + g) * 128 + pp)) * 16 + h] = f2bf(fre * bre - fim * bim);
                p.bbm[((size_t)((di * 32 + g) * 128 + 64 + pp)) * 16 + h] = f2bf(fre * bim + fim * bre);
                const float cre = p.s5_c_re[((size_t)((di * 32 + g) * 16 + h)) * 64 + pp], cim = p.s5_c_im[((size_t)((di * 32 + g) * 16 + h)) * 64 + pp];
                bf16_t* cm = p.cmt + ((size_t)(g * 16 + h)) * 256 + di * 128;
                cm[2 * pp] = f2bf(cre); cm[2 * pp + 1] = f2bf(-cim);
            }
        }
    }
}

constexpr int PRE_LD = 1028;
template <int MODE>
DEVINL void phase_pre(const Params& p, char* smem, int bid, int nb) {
    constexpr bool GEMV = (MODE == 0 || MODE == 1 || MODE == 3);
    constexpr int L = (MODE >= 2) ? 1 : 0;
    constexpr bool FFN = (MODE == 1 || MODE == 3);
    float* hrow = (float*)smem;
    float* part = hrow + 16 * PRE_LD;
    float* logit = part + 8 * 16 * 32;
    int* lcnt = (int*)(logit + 512);
    static_assert((16 * PRE_LD + 8 * 16 * 32 + 512 + 64) * 4 <= LDS_BYTES, "pre lds");
    const int t = tid_opaque(), w = t >> 6, lane = t & 63, fr = lane & 15, fq = lane >> 4;
    bf16x8 bh[4][2], bl[4][2];
    if (GEMV) {
        const bf16_t* wt = p.wrt + (size_t)(MODE == 0 ? 1 : 0) * 2 * 32 * 1024;
#pragma unroll
        for (int ks = 0; ks < 4; ++ks)
#pragma unroll
            for (int nt = 0; nt < 2; ++nt) {
                const size_t off = (size_t)(nt * 16 + fr) * 1024 + w * 128 + ks * 32 + fq * 8;
                bh[ks][nt] = *(const bf16x8*)(wt + off);
                bl[ks][nt] = *(const bf16x8*)(wt + 32 * 1024 + off);
            }
    }
    if (FFN) { if (t < 64) lcnt[t] = 0; }
    __syncthreads();
    const float* gain = (FFN ? p.norm_ffn : p.norm_mix) + L * 1024;
    const int ngroups = (MODE == 3) ? (NLAT / 16) : (R / 16);
    constexpr bool UPD_ROW = (MODE == 1 || MODE == 3);
    constexpr bool UPD_SLOT = (MODE == 2);
    auto row_of = [&](int rg, int rw) { const int i = rg * 16 + w * 2 + rw; return (MODE == 3) ? ((i >> 12) * RPB + CTXL + (i & 4095)) : i; };
    auto load_rows = [&](int rg, f32x4 (&vv)[2][4], u32x2 (&uu)[2][4], int (&ss)[2]) {
#pragma unroll
        for (int rw = 0; rw < 2; ++rw) {
            const int r = row_of(rg, rw);
            const int b = r / RPB, j = r - b * RPB;
            const bool isctx = j < CTXL;
            const float* src;
            if (MODE == 0) src = isctx ? (p.ctx + (size_t)(b * CTXL + j) * D) : (p.x + (size_t)(b * SEQ + (j - CTXL)) * D);
            else src = isctx ? (p.cx + (size_t)(b * CTXL + j) * D) : (p.out + (size_t)(b * SEQ + (j - CTXL)) * D);
#pragma unroll
            for (int i = 0; i < 4; ++i) vv[rw][i] = *(const f32x4*)(src + lane * 4 + i * 256);
            if (UPD_ROW) {
#pragma unroll
                for (int i = 0; i < 4; ++i) uu[rw][i] = *(const u32x2*)(p.Y + (size_t)r * D + lane * 4 + i * 256);
            }
            if (UPD_SLOT) ss[rw] = p.sor[r];

        }
    };
    f32x4 g4[4];
#pragma unroll
    for (int i = 0; i < 4; ++i) g4[i] = *(const f32x4*)(gain + lane * 4 + i * 256);
    for (int rg = bid; rg < ngroups; rg += nb) {
        f32x4 vcur[2][4]; u32x2 ucur[2][4]; int scur[2] = {0, 0};
        load_rows(rg, vcur, ucur, scur);
        if (UPD_SLOT) {
#pragma unroll
            for (int rw = 0; rw < 2; ++rw)
#pragma unroll
                for (int i = 0; i < 4; ++i) ucur[rw][i] = *(const u32x2*)(p.y2 + (size_t)scur[rw] * D + lane * 4 + i * 256);
        }
        f32x4 sh4[4], sc4[4], gu4[4], pe[2][4];
        {
            const int r0 = row_of(rg, 0);
            const int b0 = r0 / RPB, j0 = r0 - b0 * RPB;
            const int mb = (j0 < CTXL) ? 8 : b0;
            const float* modv = p.mod + ((size_t)(L * 9 + mb)) * 6144 + (FFN ? 3072 : 0);
            const float* gatev = p.mod + ((size_t)((MODE == 3 ? 1 : 0) * 9 + mb)) * 6144 + (MODE == 2 ? 5120 : 2048);
#pragma unroll
            for (int i = 0; i < 4; ++i) {
                const int c = lane * 4 + i * 256;
                sh4[i] = *(const f32x4*)(modv + c); sc4[i] = *(const f32x4*)(modv + 1024 + c);
                if (MODE != 0) gu4[i] = *(const f32x4*)(gatev + c);
            }
            if (MODE == 0) {
#pragma unroll
                for (int rw = 0; rw < 2; ++rw) {
                    const int j = j0 + rw;
                    const int n = (j < CTXL) ? 0 : (j - CTXL), prow = n >> 6, pcol = n & 63;
#pragma unroll
                    for (int i = 0; i < 4; ++i) {
                        const int c = lane * 4 + i * 256;
                        pe[rw][i] = (c < 512) ? *(const f32x4*)(p.pos + prow * 512 + c) : *(const f32x4*)(p.pos + pcol * 512 + (c - 512));
                    }
                }
            }
        }
#pragma unroll
        for (int rw = 0; rw < 2; ++rw) {
            const int lrow = w * 2 + rw;
            const int r = row_of(rg, rw);
            const int b = r / RPB, j = r - b * RPB;
            const bool isctx = j < CTXL;
            float* res = isctx ? (p.cx + (size_t)(b * CTXL + j) * D) : (p.out + (size_t)(b * SEQ + (j - CTXL)) * D);
            f32x4 v[4];
#pragma unroll
            for (int i = 0; i < 4; ++i) v[i] = vcur[rw][i];
            if (MODE == 0) {
                if (!isctx) {
#pragma unroll
                    for (int i = 0; i < 4; ++i) v[i] += pe[rw][i];
                }
            } else if ((UPD_ROW && !(MODE == 1 && isctx)) || UPD_SLOT) {
#pragma unroll
                for (int i = 0; i < 4; ++i) {
                    const u32x2 ub = ucur[rw][i];
                    v[i][0] += gu4[i][0] * bf2f((bf16_t)(ub.x & 0xffffu)); v[i][1] += gu4[i][1] * bf2f((bf16_t)(ub.x >> 16));
                    v[i][2] += gu4[i][2] * bf2f((bf16_t)(ub.y & 0xffffu)); v[i][3] += gu4[i][3] * bf2f((bf16_t)(ub.y >> 16));
                }
            }
#pragma unroll
            for (int i = 0; i < 4; ++i) *(f32x4*)(res + lane * 4 + i * 256) = v[i];
            float ss = 0.f;
#pragma unroll
            for (int i = 0; i < 4; ++i) ss += v[i][0] * v[i][0] + v[i][1] * v[i][1] + v[i][2] * v[i][2] + v[i][3] * v[i][3];
#pragma unroll
            for (int o = 32; o >= 1; o >>= 1) ss += __shfl_xor(ss, o);
            const float rstd = rsqrtf(ss * (1.0f / 1024.0f) + EPS);
#pragma unroll
            for (int i = 0; i < 4; ++i) {
                const int c = lane * 4 + i * 256;
                f32x4 hv;
#pragma unroll
                for (int q = 0; q < 4; ++q) hv[q] = v[i][q] * rstd * g4[i][q] * (1.0f + sc4[i][q]) + sh4[i][q];
                *(u32x2*)(p.H + (size_t)r * D + c) = pk4(hv);
                if (GEMV) *(f32x4*)(hrow + lrow * PRE_LD + c) = hv;
            }
        }
        if (GEMV) {
            lds_sync();
            f32x4 c0 = (f32x4){0.f, 0.f, 0.f, 0.f}, c1 = c0;
#pragma unroll
            for (int ks = 0; ks < 4; ++ks) {
                const float* hp = hrow + fr * PRE_LD + w * 128 + ks * 32 + fq * 8;
                const f32x4 x0 = *(const f32x4*)hp, x1 = *(const f32x4*)(hp + 4);
                u32x4 hi, lo;
                hi.x = cvt_pk_bf16(x0[0], x0[1]); hi.y = cvt_pk_bf16(x0[2], x0[3]); hi.z = cvt_pk_bf16(x1[0], x1[1]); hi.w = cvt_pk_bf16(x1[2], x1[3]);
                lo.x = cvt_pk_bf16(x0[0] - __uint_as_float(hi.x << 16), x0[1] - __uint_as_float(hi.x & 0xffff0000u));
                lo.y = cvt_pk_bf16(x0[2] - __uint_as_float(hi.y << 16), x0[3] - __uint_as_float(hi.y & 0xffff0000u));
                lo.z = cvt_pk_bf16(x1[0] - __uint_as_float(hi.z << 16), x1[1] - __uint_as_float(hi.z & 0xffff0000u));
                lo.w = cvt_pk_bf16(x1[2] - __uint_as_float(hi.w << 16), x1[3] - __uint_as_float(hi.w & 0xffff0000u));
                const bf16x8 ah = __builtin_bit_cast(bf16x8, hi), al = __builtin_bit_cast(bf16x8, lo);
                c0 = __builtin_amdgcn_mfma_f32_16x16x32_bf16(bh[ks][0], ah, c0, 0, 0, 0);
                c0 = __builtin_amdgcn_mfma_f32_16x16x32_bf16(bl[ks][0], ah, c0, 0, 0, 0);
                c0 = __builtin_amdgcn_mfma_f32_16x16x32_bf16(bh[ks][0], al, c0, 0, 0, 0);
                c1 = __builtin_amdgcn_mfma_f32_16x16x32_bf16(bh[ks][1], ah, c1, 0, 0, 0);
                c1 = __builtin_amdgcn_mfma_f32_16x16x32_bf16(bl[ks][1], ah, c1, 0, 0, 0);
                c1 = __builtin_amdgcn_mfma_f32_16x16x32_bf16(bh[ks][1], al, c1, 0, 0, 0);
            }
            *(f32x4*)&part[(w * 16 + fr) * 32 + fq * 4] = c0;
            *(f32x4*)&part[(w * 16 + fr) * 32 + 16 + fq * 4] = c1;
            lds_sync();
            {
                const int row = t >> 5, e2 = t & 31;
                float s = 0.f;
#pragma unroll
                for (int q = 0; q < 8; ++q) s += part[(q * 16 + row) * 32 + e2];
                if (MODE == 0) p.AF[(size_t)(rg * 16 + row) * 32 + e2] = s;
                else logit[row * 32 + e2] = s;
            }
            if (FFN) {
                lds_sync();
                if (t < 16) {
                    int rr;
                    if (MODE == 3) { const int i = rg * 16 + t; rr = (i >> 12) * RPB + CTXL + (i & 4095); } else rr = rg * 16 + t;
                    float best = -3.0e38f; int bg = 0, bi1 = 0, bi2 = 1; float ba1 = 0.f, ba2 = 0.f;
#pragma unroll 1
                    for (int g = 0; g < 8; ++g) {
                        float m1 = -3.0e38f, m2 = -3.0e38f, a1 = 0.f, a2 = 0.f; int i1 = 0, i2 = 0;
#pragma unroll
                        for (int e = 0; e < 4; ++e) {
                            const float a = sigmoidf_(logit[t * 32 + g * 4 + e]);
                            const float sv = a + p.router_bias[g * 4 + e];
                            if (sv > m1) { m2 = m1; i2 = i1; a2 = a1; m1 = sv; i1 = e; a1 = a; }
                            else if (sv > m2) { m2 = sv; i2 = e; a2 = a; }
                        }
                        const float gs = m1 + m2;
                        if (gs > best) { best = gs; bg = g; bi1 = i1; bi2 = i2; ba1 = a1; ba2 = a2; }
                    }
                    const float inv = 1.0f / (ba1 + ba2);
                    const float w1 = ba1 * inv, w2 = ba2 * inv;
                    const int lo = bi1 < bi2 ? bi1 : bi2, hi = bi1 < bi2 ? bi2 : bi1;
                    const float wlo = bi1 < bi2 ? w1 : w2, whi = bi1 < bi2 ? w2 : w1;
                    const int pair = (lo == 0) ? (hi - 1) : (lo == 1 ? (hi + 1) : 5);
                    const int bucket = bg * 6 + pair;
                    float4 rec; rec.x = __int_as_float(bucket); rec.y = wlo; rec.z = whi; rec.w = 0.f;
                    p.RT[rr] = rec;
                    atomicAdd(&lcnt[bucket], 1);
                }
            }
            lds_sync();
        }
    }
    if (FFN) {
        __syncthreads();
        if (t < 48) p.blkcnt[((size_t)L * 256 + bid) * 48 + t] = lcnt[t];
    }
    if (MODE == 3) {
        __syncthreads();
        for (int task = bid; task < NT_GU + NT_WD; task += nb) moe_cvt_task(p, 1, task, smem);
    }
}

struct GemmSmem { bf16_t A[2][128][72]; bf16_t B[2][256][72]; };
static_assert(sizeof(GemmSmem) <= LDS_BYTES, "gemm lds");

template <class Epi>
DEVINL void gemm_tile(const bf16_t* __restrict__ A, int lda, const int* __restrict__ rowlist, int m0, int mvalid,
                      const bf16_t* __restrict__ Bt0, const bf16_t* __restrict__ Bt1, int ldb, int kseg, int K, Epi& epi, char* smem) {
    GemmSmem& S = *(GemmSmem*)smem;
    const int t = tid_opaque(), w = t >> 6, lane = t & 63, fr = lane & 15, fq = lane >> 4, wr = w >> 2, wc = w & 3;
    const int ch = t & 7, rr = t >> 3;
    const bf16_t* ap[2];
#pragma unroll
    for (int i = 0; i < 2; ++i) {
        const int ri = rr + i * 64, gi = ri < mvalid ? ri : 0;
        const int grow = rowlist ? rowlist[m0 + gi] : (m0 + gi);
        ap[i] = A + (size_t)grow * lda + ch * 8;
    }
    u32x4 ra[2], rb[4];
    f32x4 acc[4][4];
#pragma unroll
    for (int m = 0; m < 4; ++m)
#pragma unroll
        for (int n = 0; n < 4; ++n) acc[m][n] = (f32x4){0.f, 0.f, 0.f, 0.f};
    const int nk = K >> 6;
#define GT_GLOAD(kt) do { const int _k0 = (kt) * 64; \
        _Pragma("unroll") for (int i = 0; i < 2; ++i) ra[i] = *(const u32x4*)(ap[i] + _k0); \
        const bf16_t* _bb = (_k0 < kseg) ? (Bt0 + _k0) : (Bt1 + (_k0 - kseg)); \
        _Pragma("unroll") for (int i = 0; i < 4; ++i) rb[i] = *(const u32x4*)(_bb + (size_t)(rr + i * 64) * ldb + ch * 8); } while (0)
#define GT_SSTORE(buf) do { \
        _Pragma("unroll") for (int i = 0; i < 2; ++i) *(u32x4*)&S.A[buf][rr + i * 64][ch * 8] = ra[i]; \
        _Pragma("unroll") for (int i = 0; i < 4; ++i) *(u32x4*)&S.B[buf][rr + i * 64][ch * 8] = rb[i]; } while (0)
    GT_GLOAD(0);
    GT_SSTORE(0);
    __syncthreads();
    for (int kt = 0; kt < nk; ++kt) {
        const int cur = kt & 1;
        if (kt + 1 < nk) GT_GLOAD(kt + 1);
#pragma unroll
        for (int kk = 0; kk < 2; ++kk) {
            bf16x8 a[4], b[4];
#pragma unroll
            for (int m = 0; m < 4; ++m) a[m] = *(const bf16x8*)&S.A[cur][wr * 64 + m * 16 + fr][kk * 32 + fq * 8];
#pragma unroll
            for (int n = 0; n < 4; ++n) b[n] = *(const bf16x8*)&S.B[cur][wc * 64 + n * 16 + fr][kk * 32 + fq * 8];
#pragma unroll
            for (int m = 0; m < 4; ++m)
#pragma unroll
                for (int n = 0; n < 4; ++n) acc[m][n] = __builtin_amdgcn_mfma_f32_16x16x32_bf16(b[n], a[m], acc[m][n], 0, 0, 0);
        }
        if (kt + 1 < nk) GT_SSTORE(cur ^ 1);
        __syncthreads();
    }
#undef GT_GLOAD
#undef GT_SSTORE
    epi(acc, wr * 64, wc * 64, fr, fq);
}

struct EpiP0 {
    bf16_t* P; int m0, n0;
    DEVINL void operator()(const f32x4 (&acc)[4][4], int mb, int nbs, int fr, int fq) const {
        const float sc = (n0 < 256) ? 0.125f : 1.0f;
#pragma unroll
        for (int m = 0; m < 4; ++m) {
            bf16_t* rp = P + (size_t)(m0 + mb + m * 16 + fr) * 2048 + n0 + nbs + fq * 4;
#pragma unroll
            for (int n = 0; n < 4; ++n) *(u32x2*)(rp + n * 16) = pk4(acc[m][n] * sc);
        }
    }
};
struct EpiP1 {
    bf16_t* P; const float* lb; int m0, n0;
    DEVINL void operator()(const f32x4 (&acc)[4][4], int mb, int nbs, int fr, int fq) const {
        const int cb = n0 >> 10;
#pragma unroll
        for (int m = 0; m < 4; ++m) {
            bf16_t* rp = P + (size_t)(m0 + mb + m * 16 + fr) * 5120 + n0 + nbs + fq * 4;
#pragma unroll
            for (int n = 0; n < 4; ++n) {
                const f32x4 a = acc[m][n];
                u32x2 o;
                if (cb == 1 || cb == 2) {
                    const int cc = ((n0 + nbs + n * 16 + fq * 4) & 1023);
                    const f32x4 l4 = *(const f32x4*)(lb + cc);
                    unsigned short hv[4];
#pragma unroll
                    for (int j = 0; j < 4; ++j) hv[j] = f2h((1.0f - l4[j]) * sigmoidf_(-a[j]));
                    o.x = (unsigned)hv[0] | ((unsigned)hv[1] << 16); o.y = (unsigned)hv[2] | ((unsigned)hv[3] << 16);
                } else if (cb == 0 || cb == 4) {
                    f32x4 s;
#pragma unroll
                    for (int j = 0; j < 4; ++j) s[j] = siluf_(a[j]);
                    o = pk4(s);
                } else o = pk4(a);
                *(u32x2*)(rp + n * 16) = o;
            }
        }
    }
};
struct EpiGlu {
    bf16_t* CAT; const bf16_t* s5a; const float* gb; int m0, n0;
    DEVINL void operator()(const f32x4 (&acc)[4][4], int mb, int nbs, int fr, int fq) const {
        f32x4 b4[4];
#pragma unroll
        for (int n = 0; n < 4; ++n) b4[n] = *(const f32x4*)(gb + n0 + nbs + n * 16 + fq * 4);
        u32x2 av[4][4];
#pragma unroll
        for (int m = 0; m < 4; ++m)
#pragma unroll
            for (int n = 0; n < 4; ++n) av[m][n] = *(const u32x2*)(s5a + (size_t)(m0 + mb + m * 16 + fr) * 512 + n0 + nbs + n * 16 + fq * 4);
#pragma unroll
        for (int m = 0; m < 4; ++m) {
            const size_t row = (size_t)(m0 + mb + m * 16 + fr);
#pragma unroll
            for (int n = 0; n < 4; ++n) {
                const int col = n0 + nbs + n * 16 + fq * 4;
                f32x4 o;
                o[0] = bf2f((bf16_t)(av[m][n].x & 0xffff)) * sigmoidf_(acc[m][n][0] + b4[n][0]);
                o[1] = bf2f((bf16_t)(av[m][n].x >> 16)) * sigmoidf_(acc[m][n][1] + b4[n][1]);
                o[2] = bf2f((bf16_t)(av[m][n].y & 0xffff)) * sigmoidf_(acc[m][n][2] + b4[n][2]);
                o[3] = bf2f((bf16_t)(av[m][n].y >> 16)) * sigmoidf_(acc[m][n][3] + b4[n][3]);
                *(u32x2*)(CAT + row * 1024 + 512 + col) = pk4(o);
            }
        }
    }
};
struct EpiOut {
    const Params* p; const float* gate; int m0, n0;
    DEVINL void operator()(const f32x4 (&acc)[4][4], int mb, int nbs, int fr, int fq) const {
        const float* gp = gate + (size_t)8 * 6144;
        f32x4 g4[4];
#pragma unroll
        for (int n = 0; n < 4; ++n) g4[n] = *(const f32x4*)(gp + n0 + nbs + n * 16 + fq * 4);
        f32x4 x4[4][4];
#pragma unroll
        for (int m = 0; m < 4; ++m) {
            const float* rp = resid_row(*p, m0 + mb + m * 16 + fr);
#pragma unroll
            for (int n = 0; n < 4; ++n) x4[m][n] = *(const f32x4*)(rp + n0 + nbs + n * 16 + fq * 4);
        }
#pragma unroll
        for (int m = 0; m < 4; ++m) {
            float* rp = resid_row(*p, m0 + mb + m * 16 + fr);
#pragma unroll
            for (int n = 0; n < 4; ++n) *(f32x4*)(rp + n0 + nbs + n * 16 + fq * 4) = x4[m][n] + g4[n] * acc[m][n];
        }
    }
};

struct EpiY {
    bf16_t* O; int m0, n0;
    DEVINL void operator()(const f32x4 (&acc)[4][4], int mb, int nbs, int fr, int fq) const {
#pragma unroll
        for (int m = 0; m < 4; ++m) {
            bf16_t* rp = O + (size_t)(m0 + mb + m * 16 + fr) * 1024 + n0 + nbs + fq * 4;
#pragma unroll
            for (int n = 0; n < 4; ++n) *(u32x2*)(rp + n * 16) = pk4(acc[m][n]);
        }
    }
};

namespace pg8 {
#define PG8_LAS __attribute__((address_space(3)))
constexpr int BM = 256, BK = 64, HALF = 128, HTB = HALF * BK * 2, STAGE_BYTES = 8 * HTB, NXCD = 8, WGM = 8;
DEVINL int lds_byte(int r, int c) { const int st = (r >> 4) * 2 + (c >> 5), rr = r & 15, cc = c & 31, ob = rr * 64 + cc * 2; return st * 1024 + (ob ^ (((ob >> 9) & 1) << 5)); }
DEVINL void stage_rc(int b, int& R_, int& C_) { const int st = b / 1024, sb = b % 1024, swz = sb ^ (((sb >> 9) & 1) << 5); R_ = (st >> 1) * 16 + swz / 64; C_ = (st & 1) * 32 + (swz % 64) / 2; }
DEVINL int perm32(int rho) { const int n = rho >> 4, i = rho & 15; return 8 * (i >> 2) + 4 * n + (i & 3); }
struct Unit { int pm, pn; const char* A; const char* B0; const char* B1; int mvalid, aux; };

template <class Epi, class Sched>
DEVINL void gemm_phase(PG8_LAS unsigned char* lds, const Sched& S, const Epi& E) {
    const int tid = tid_opaque(), wid = __builtin_amdgcn_readfirstlane(tid >> 6), lane = tid & 63, wr = wid >> 2, wc = wid & 3, fr = lane & 15, fq = lane >> 4;
    const int K = S.K, nt = K / BK, ldb = S.ldb, ksplit = S.ksplit;
    unsigned voffA[2], voffB[2];
#pragma unroll
    for (int i = 0; i < 2; ++i) { int R_, C_; stage_rc(tid * 16 + i * 8192, R_, C_); const int Rb = Epi::PERM ? ((R_ & ~31) + perm32(R_ & 31)) : R_;
        voffA[i] = (unsigned)(R_ * K + C_) * 2u; voffB[i] = (unsigned)(Rb * ldb + C_) * 2u; }
    const size_t kstep = (size_t)(BK * 2);
    const size_t hstepA = (size_t)HALF * K * 2, hstepB = (size_t)HALF * ldb * 2;
    const unsigned ldsw = (unsigned)wid * 1024u;
    const int aoff = lds_byte(wr * 64 + fr, fq * 8), boff = lds_byte(wc * 32 + fr, fq * 8);
    unsigned va[2][2], vn[2][2];
    auto gather_offs = [&](const Unit& u, unsigned (&v)[2][2]) {
#pragma unroll
        for (int h = 0; h < 2; ++h)
#pragma unroll
            for (int i = 0; i < 2; ++i) { int R_, C_; stage_rc(tid * 16 + i * 8192, R_, C_); v[h][i] = (unsigned)(S.a_row(u, h * HALF + R_) * K + C_) * 2u; }
    };
#define PG8_STAGE_A(bufoff, base, h, usenext) do { if constexpr (Sched::GATHER) { \
        unsigned _v[2] = {(usenext) ? vn[h][0] : va[h][0], (usenext) ? vn[h][1] : va[h][1]}; PG8_STAGE(bufoff, base, _v); \
    } else { PG8_STAGE(bufoff, (base) + (h) * hstepA, voffA); } } while (0)
#define PG8_SA(b, h) (((b) * 2 + (h)) * HTB)
#define PG8_SB(b, h) ((4 + (b) * 2 + (h)) * HTB)
#define PG8_STAGE(bufoff, gbase, voff) do { _Pragma("unroll") for (int _i = 0; _i < 2; ++_i) \
        __builtin_amdgcn_global_load_lds((const unsigned*)((const char*)(gbase) + (voff)[_i]), (PG8_LAS unsigned*)(lds + (bufoff) + ldsw + _i * 8192), 16, 0, 0); } while (0)
#define PG8_LDA(dst, b, h) do { _Pragma("unroll") for (int m = 0; m < 4; ++m) _Pragma("unroll") for (int k = 0; k < 2; ++k) dst[m][k] = *(const PG8_LAS bf16x8*)(lds + PG8_SA(b, h) + aoff + m * 2048 + k * 1024); } while (0)
#define PG8_LDB(dst, b, h) do { _Pragma("unroll") for (int n = 0; n < 2; ++n) _Pragma("unroll") for (int k = 0; k < 2; ++k) dst[n][k] = *(const PG8_LAS bf16x8*)(lds + PG8_SB(b, h) + boff + n * 2048 + k * 1024); } while (0)
#define PG8_MMA(ai, bj, At, Bt) do { __builtin_amdgcn_s_setprio(1); _Pragma("unroll") for (int m = 0; m < 4; ++m) _Pragma("unroll") for (int n = 0; n < 2; ++n) _Pragma("unroll") for (int k = 0; k < 2; ++k) \
        acc[ai][bj][m][n] = __builtin_amdgcn_mfma_f32_16x16x32_bf16(Bt[n][k], At[m][k], acc[ai][bj][m][n], 0, 0, 0); __builtin_amdgcn_s_setprio(0); } while (0)
#define PG8_WAIT_V(n) asm volatile("s_waitcnt vmcnt(" #n ")" ::: "memory")
#define PG8_WAIT_L(n) asm volatile("s_waitcnt lgkmcnt(" #n ")" ::: "memory")
#define PG8_BAR __builtin_amdgcn_s_barrier()
#define PG8_SCHED __builtin_amdgcn_sched_barrier(0)
#define PG8_BPTR(u, kt) (((kt) < ksplit ? (u).B0 : (u).B1) + (size_t)(kt) * kstep)
    Unit cur, nxt; int ui = 0;
    if (!S.next(0, cur)) return;
    f32x4 acc[2][2][4][2];
#pragma unroll
    for (int a = 0; a < 2; ++a)
#pragma unroll
        for (int b = 0; b < 2; ++b)
#pragma unroll
            for (int m = 0; m < 4; ++m)
#pragma unroll
                for (int n = 0; n < 2; ++n) acc[a][b][m][n] = (f32x4){0.f, 0.f, 0.f, 0.f};
    bf16x8 At[4][2], B0[2][2], B1[2][2];
    const char* cA = cur.A;
    if constexpr (Sched::GATHER) gather_offs(cur, va);
    { const char* cB0 = PG8_BPTR(cur, 0); const char* cB1 = PG8_BPTR(cur, 1);
      PG8_STAGE(PG8_SB(0, 0), cB0, voffB); PG8_STAGE_A(PG8_SA(0, 0), cA, 0, false); PG8_STAGE(PG8_SB(0, 1), cB0 + hstepB, voffB); PG8_STAGE_A(PG8_SA(0, 1), cA, 1, false);
      if (wr == 1) PG8_BAR;
      PG8_WAIT_V(4); PG8_BAR;
      PG8_STAGE(PG8_SB(1, 0), cB1, voffB); PG8_STAGE_A(PG8_SA(1, 0), cA + kstep, 0, false); PG8_STAGE(PG8_SB(1, 1), cB1 + hstepB, voffB);
      PG8_WAIT_V(6); PG8_BAR; }
    for (;;) {
        const bool has_next = S.next(ui + 1, nxt);
        if (!has_next) nxt = cur;
        const char* nA = nxt.A;
        if constexpr (Sched::GATHER) {
            if (has_next) gather_offs(nxt, vn);
            else {
#pragma unroll
                for (int h = 0; h < 2; ++h) { vn[h][0] = va[h][0]; vn[h][1] = va[h][1]; }
            }
        }
        for (int t = 0; t < nt; t += 2) {
            const bool last = (t == nt - 2);
            const char* a1 = cA + (size_t)(t + 1) * kstep;
            const char* a2 = last ? nA : cA + (size_t)(t + 2) * kstep;
            const char* b2 = last ? PG8_BPTR(nxt, 0) : PG8_BPTR(cur, t + 2);
            const char* a3 = a2 + kstep;
            const char* b3 = last ? PG8_BPTR(nxt, 1) : PG8_BPTR(cur, t + 3);
            PG8_LDB(B0, 0, 0); PG8_SCHED; PG8_LDA(At, 0, 0); PG8_STAGE_A(PG8_SA(1, 1), a1, 1, false);
            PG8_WAIT_L(8); PG8_BAR; PG8_WAIT_L(0); PG8_MMA(0, 0, At, B0); PG8_BAR; PG8_SCHED;
            PG8_LDB(B1, 0, 1); PG8_STAGE(PG8_SB(0, 0), b2, voffB);
            PG8_BAR; PG8_WAIT_L(0); PG8_MMA(0, 1, At, B1); PG8_BAR;
            PG8_LDA(At, 0, 1); PG8_STAGE_A(PG8_SA(0, 0), a2, 0, last);
            PG8_BAR; PG8_WAIT_L(0); PG8_MMA(1, 0, At, B0); PG8_BAR; PG8_SCHED;
            PG8_STAGE(PG8_SB(0, 1), b2 + hstepB, voffB);
            PG8_WAIT_V(6); PG8_BAR; PG8_MMA(1, 1, At, B1); PG8_BAR;
            PG8_LDB(B0, 1, 0); PG8_SCHED; PG8_LDA(At, 1, 0); PG8_STAGE_A(PG8_SA(0, 1), a2, 1, last);
            PG8_WAIT_L(8); PG8_BAR; PG8_WAIT_L(0); PG8_MMA(0, 0, At, B0); PG8_BAR; PG8_SCHED;
            PG8_LDB(B1, 1, 1); PG8_STAGE(PG8_SB(1, 0), b3, voffB);
            PG8_BAR; PG8_WAIT_L(0); PG8_MMA(0, 1, At, B1); PG8_BAR;
            PG8_LDA(At, 1, 1); PG8_STAGE_A(PG8_SA(1, 0), a3, 0, last);
            PG8_BAR; PG8_WAIT_L(0); PG8_MMA(1, 0, At, B0); PG8_BAR; PG8_SCHED;
            PG8_STAGE(PG8_SB(1, 1), b3 + hstepB, voffB);
            PG8_WAIT_V(6); PG8_BAR; PG8_MMA(1, 1, At, B1); PG8_BAR;
        }
        E(acc, cur, wr, wc, fr, fq);
        if (!has_next) break;
#pragma unroll
        for (int a = 0; a < 2; ++a)
#pragma unroll
            for (int b = 0; b < 2; ++b)
#pragma unroll
                for (int m = 0; m < 4; ++m)
#pragma unroll
                    for (int n = 0; n < 2; ++n) acc[a][b][m][n] = (f32x4){0.f, 0.f, 0.f, 0.f};
        cur = nxt; cA = nA; ++ui;
        if constexpr (Sched::GATHER) {
#pragma unroll
            for (int h = 0; h < 2; ++h) { va[h][0] = vn[h][0]; va[h][1] = vn[h][1]; }
        }
    }
    PG8_WAIT_V(0);
    if (wr == 0) PG8_BAR;
    PG8_BAR;
#undef PG8_SA
#undef PG8_SB
#undef PG8_STAGE
#undef PG8_STAGE_A
#undef PG8_LDA
#undef PG8_LDB
#undef PG8_MMA
#undef PG8_WAIT_V
#undef PG8_WAIT_L
#undef PG8_BAR
#undef PG8_SCHED
#undef PG8_BPTR
}

struct DenseSched {
    static constexpr bool GATHER = false;
    DEVINL int a_row(const Unit&, int) const { return 0; }
    const char* A; const char* Bt; int K, ldb, ksplit, nM, nN, G, c, lat;
    DEVINL void init(const bf16_t* A_, const bf16_t* Bt_, int N, int K_, int G_, int c_, int lat_) {
        A = (const char*)A_; Bt = (const char*)Bt_; K = K_; ldb = K_; ksplit = K_ / BK; nM = lat_ ? 128 : 136; nN = N / BM; G = G_; c = c_; lat = lat_; }
    DEVINL bool next(int i, Unit& u) const {
        const int nwg = nM * nN;
        const long Lq = (long)i * G + c; if (Lq >= nwg) return false;
        int wgid = (int)Lq; { const int q = nwg / NXCD, r = nwg % NXCD, xcd = wgid % NXCD, off = wgid / NXCD; wgid = (xcd < r ? xcd * (q + 1) : r * (q + 1) + (xcd - r) * q) + off; }
        const int nig = WGM * nN, gid = wgid / nig, fm = gid * WGM, gsz = (nM - fm) < WGM ? (nM - fm) : WGM;
        int pm = fm + ((wgid % nig) % gsz); const int pn = (wgid % nig) / gsz;
        if (lat) pm = (pm >> 4) * 17 + 1 + (pm & 15);
        u.pm = pm; u.pn = pn; u.A = A + (size_t)pm * BM * K * 2; u.B0 = Bt + (size_t)pn * BM * K * 2; u.B1 = u.B0; u.mvalid = 256; u.aux = 0;
        return true;
    }
};
}

struct GEpiP0 {
    static constexpr bool PERM = true;
    bf16_t* P;
    DEVINL void operator()(const f32x4 (&acc)[2][2][4][2], const pg8::Unit& u, int wr, int wc, int fr, int fq) const {
        const float sc = (u.pn == 0) ? 0.125f : 1.0f;
        const int row0 = u.pm * 256 + wr * 64 + fr, col0 = u.pn * 256 + wc * 32 + 8 * fq;
#pragma unroll
        for (int ai = 0; ai < 2; ++ai)
#pragma unroll
            for (int m = 0; m < 4; ++m) {
                bf16_t* rp = P + (size_t)(row0 + ai * 128 + m * 16) * 2048 + col0;
#pragma unroll
                for (int bj = 0; bj < 2; ++bj) {
                    const u32x2 a = pk4(acc[ai][bj][m][0] * sc), b = pk4(acc[ai][bj][m][1] * sc);
                    u32x4 w; w.x = a.x; w.y = a.y; w.z = b.x; w.w = b.y;
                    *(u32x4*)(rp + bj * 128) = w;
                }
            }
    }
};
struct GEpiP1 {
    static constexpr bool PERM = true;
    bf16_t* P; const float* lb;
    DEVINL void operator()(const f32x4 (&acc)[2][2][4][2], const pg8::Unit& u, int wr, int wc, int fr, int fq) const {
        const int cb = u.pn >> 2;
        const int row0 = u.pm * 256 + wr * 64 + fr, col0 = u.pn * 256 + wc * 32 + 8 * fq;
        f32x4 oml[2][2];
        if (cb == 1 || cb == 2) {
#pragma unroll
            for (int bj = 0; bj < 2; ++bj)
#pragma unroll
                for (int n = 0; n < 2; ++n) { const f32x4 l4 = *(const f32x4*)(lb + ((col0 + bj * 128) & 1023) + 4 * n); oml[bj][n] = 1.0f - l4; }
        }
#pragma unroll
        for (int ai = 0; ai < 2; ++ai)
#pragma unroll
            for (int m = 0; m < 4; ++m) {
                bf16_t* rp = P + (size_t)(row0 + ai * 128 + m * 16) * 5120 + col0;
#pragma unroll
                for (int bj = 0; bj < 2; ++bj) {
                    u32x4 w;
                    if (cb == 1 || cb == 2) {
                        unsigned short hv[8];
#pragma unroll
                        for (int n = 0; n < 2; ++n)
#pragma unroll
                            for (int j = 0; j < 4; ++j) hv[n * 4 + j] = f2h(oml[bj][n][j] * sigmoidf_(-acc[ai][bj][m][n][j]));
                        w.x = (unsigned)hv[0] | ((unsigned)hv[1] << 16); w.y = (unsigned)hv[2] | ((unsigned)hv[3] << 16);
                        w.z = (unsigned)hv[4] | ((unsigned)hv[5] << 16); w.w = (unsigned)hv[6] | ((unsigned)hv[7] << 16);
                    } else {
                        f32x4 v0 = acc[ai][bj][m][0], v1 = acc[ai][bj][m][1];
                        if (cb == 0 || cb == 4) {
#pragma unroll
                            for (int j = 0; j < 4; ++j) { v0[j] = siluf_(v0[j]); v1[j] = siluf_(v1[j]); }
                        }
                        const u32x2 a = pk4(v0), b = pk4(v1);
                        w.x = a.x; w.y = a.y; w.z = b.x; w.w = b.y;
                    }
                    *(u32x4*)(rp + bj * 128) = w;
                }
            }
    }
};
struct GEpiGlu {
    static constexpr bool PERM = true;
    bf16_t* CAT; const bf16_t* s5a; const float* gb;
    DEVINL void operator()(const f32x4 (&acc)[2][2][4][2], const pg8::Unit& u, int wr, int wc, int fr, int fq) const {
        const int row0 = u.pm * 256 + wr * 64 + fr, col0 = u.pn * 256 + wc * 32 + 8 * fq;
        f32x4 bv[2][2];
#pragma unroll
        for (int bj = 0; bj < 2; ++bj)
#pragma unroll
            for (int n = 0; n < 2; ++n) bv[bj][n] = *(const f32x4*)(gb + col0 + bj * 128 + 4 * n);
#pragma unroll
        for (int ai = 0; ai < 2; ++ai) {
            u32x4 av[4][2];
#pragma unroll
            for (int m = 0; m < 4; ++m)
#pragma unroll
                for (int bj = 0; bj < 2; ++bj) av[m][bj] = *(const u32x4*)(s5a + (size_t)(row0 + ai * 128 + m * 16) * 512 + col0 + bj * 128);
#pragma unroll
            for (int m = 0; m < 4; ++m) {
                const size_t row = (size_t)(row0 + ai * 128 + m * 16);
#pragma unroll
                for (int bj = 0; bj < 2; ++bj) {
                    const u32x4 a = av[m][bj];
                    f32x4 o0, o1;
                    o0[0] = bf2f((bf16_t)(a.x & 0xffff)) * sigmoidf_(acc[ai][bj][m][0][0] + bv[bj][0][0]);
                    o0[1] = bf2f((bf16_t)(a.x >> 16)) * sigmoidf_(acc[ai][bj][m][0][1] + bv[bj][0][1]);
                    o0[2] = bf2f((bf16_t)(a.y & 0xffff)) * sigmoidf_(acc[ai][bj][m][0][2] + bv[bj][0][2]);
                    o0[3] = bf2f((bf16_t)(a.y >> 16)) * sigmoidf_(acc[ai][bj][m][0][3] + bv[bj][0][3]);
                    o1[0] = bf2f((bf16_t)(a.z & 0xffff)) * sigmoidf_(acc[ai][bj][m][1][0] + bv[bj][1][0]);
                    o1[1] = bf2f((bf16_t)(a.z >> 16)) * sigmoidf_(acc[ai][bj][m][1][1] + bv[bj][1][1]);
                    o1[2] = bf2f((bf16_t)(a.w & 0xffff)) * sigmoidf_(acc[ai][bj][m][1][2] + bv[bj][1][2]);
                    o1[3] = bf2f((bf16_t)(a.w >> 16)) * sigmoidf_(acc[ai][bj][m][1][3] + bv[bj][1][3]);
                    const u32x2 x = pk4(o0), y = pk4(o1);
                    u32x4 w; w.x = x.x; w.y = x.y; w.z = y.x; w.w = y.y;
                    *(u32x4*)(CAT + row * 1024 + 512 + col0 + bj * 128) = w;
                }
            }
        }
    }
};
struct GEpiOut {
    static constexpr bool PERM = false;
    float* out; const float* gate;
    DEVINL void operator()(const f32x4 (&acc)[2][2][4][2], const pg8::Unit& u, int wr, int wc, int fr, int fq) const {
        const int b = u.pm / 17, lt = u.pm - b * 17 - 1;
        const float* gp = gate + (size_t)b * 6144;
        const int col0 = u.pn * 256 + wc * 32 + 4 * fq;
        float* base = out + ((size_t)b * SEQ + lt * 256 + wr * 64 + fr) * D;
        f32x4 g4[2][2];
#pragma unroll
        for (int bj = 0; bj < 2; ++bj)
#pragma unroll
            for (int n = 0; n < 2; ++n) g4[bj][n] = *(const f32x4*)(gp + col0 + bj * 128 + n * 16);
#pragma unroll
        for (int ai = 0; ai < 2; ++ai)
#pragma unroll
            for (int mp = 0; mp < 4; mp += 2) {
                f32x4 x4[2][2][2];
#pragma unroll
                for (int q = 0; q < 2; ++q)
#pragma unroll
                    for (int bj = 0; bj < 2; ++bj)
#pragma unroll
                        for (int n = 0; n < 2; ++n) x4[q][bj][n] = *(const f32x4*)(base + (size_t)(ai * 128 + (mp + q) * 16) * D + col0 + bj * 128 + n * 16);
                asm volatile("" ::: "memory");
#pragma unroll
                for (int q = 0; q < 2; ++q)
#pragma unroll
                    for (int bj = 0; bj < 2; ++bj)
#pragma unroll
                        for (int n = 0; n < 2; ++n) *(f32x4*)(base + (size_t)(ai * 128 + (mp + q) * 16) * D + col0 + bj * 128 + n * 16) = x4[q][bj][n] + g4[bj][n] * acc[ai][bj][mp + q][n];
                asm volatile("" ::: "memory");
            }
    }
};
struct GEpiY {
    static constexpr bool PERM = true;
    bf16_t* O;
    DEVINL void operator()(const f32x4 (&acc)[2][2][4][2], const pg8::Unit& u, int wr, int wc, int fr, int fq) const {
        const int row0 = u.pm * 256 + wr * 64 + fr, col0 = u.pn * 256 + wc * 32 + 8 * fq;
#pragma unroll
        for (int ai = 0; ai < 2; ++ai)
#pragma unroll
            for (int m = 0; m < 4; ++m) {
                bf16_t* rp = O + (size_t)(row0 + ai * 128 + m * 16) * 1024 + col0;
#pragma unroll
                for (int bj = 0; bj < 2; ++bj) {
                    const u32x2 a = pk4(acc[ai][bj][m][0]), b = pk4(acc[ai][bj][m][1]);
                    u32x4 w; w.x = a.x; w.y = a.y; w.z = b.x; w.w = b.y;
                    *(u32x4*)(rp + bj * 128) = w;
                }
            }
    }
};
struct GEpiMoe1 {
    static constexpr bool PERM = true;
    bf16_t* act; const float* wl; const float* wh;
    DEVINL void operator()(const f32x4 (&acc)[2][2][4][2], const pg8::Unit& u, int wr, int wc, int fr, int fq) const {
        const int half = u.pn >> 1;
        const float* wsel = half ? wh : wl;
        const int cbase = half * 256 + (u.pn & 1) * 128 + 16 * wc + 4 * fq;
        float wv[2][4];
#pragma unroll
        for (int ai = 0; ai < 2; ++ai)
#pragma unroll
            for (int m = 0; m < 4; ++m) { const int lr = ai * 128 + wr * 64 + m * 16 + fr; wv[ai][m] = (lr < u.mvalid) ? wsel[u.pm * 256 + lr] : 0.f; }
#pragma unroll
        for (int ai = 0; ai < 2; ++ai)
#pragma unroll
            for (int m = 0; m < 4; ++m) {
                const int slot = u.pm * 256 + ai * 128 + wr * 64 + m * 16 + fr;
#pragma unroll
                for (int bj = 0; bj < 2; ++bj) {
                    f32x4 o;
#pragma unroll
                    for (int j = 0; j < 4; ++j) o[j] = wv[ai][m] * siluf_(acc[ai][bj][m][0][j]) * acc[ai][bj][m][1][j];
                    *(u32x2*)(act + (size_t)slot * 512 + cbase + 64 * bj) = pk4(o);
                }
            }
    }
};
struct GEpiMoe2 {
    static constexpr bool PERM = false;
    float* out; float* cx; const float* gate; const int* list;
    DEVINL void operator()(const f32x4 (&acc)[2][2][4][2], const pg8::Unit& u, int wr, int wc, int fr, int fq) const {
        const int col0 = u.pn * 256 + wc * 32 + 4 * fq;
        int rows[2][4];
#pragma unroll
        for (int ai = 0; ai < 2; ++ai)
#pragma unroll
            for (int m = 0; m < 4; ++m) { const int lr = ai * 128 + wr * 64 + m * 16 + fr; rows[ai][m] = (lr < u.mvalid) ? list[u.pm * 256 + lr] : -1; }
#pragma unroll
        for (int ai = 0; ai < 2; ++ai)
#pragma unroll
            for (int mp = 0; mp < 4; mp += 2) {
                f32x4 x4[2][2][2], g4[2][2][2];
                float* rp[2];
#pragma unroll
                for (int q = 0; q < 2; ++q) {
                    const int r = rows[ai][mp + q] < 0 ? 0 : rows[ai][mp + q];
                    const int rb = r / RPB, rj = r - rb * RPB;
                    rp[q] = (rj < CTXL) ? (cx + (size_t)(rb * CTXL + rj) * D) : (out + (size_t)(rb * SEQ + (rj - CTXL)) * D);
                    const float* gp = gate + (size_t)((rj < CTXL) ? 8 : rb) * 6144;
#pragma unroll
                    for (int bj = 0; bj < 2; ++bj)
#pragma unroll
                        for (int n = 0; n < 2; ++n) { const int col = col0 + bj * 128 + n * 16; x4[q][bj][n] = *(const f32x4*)(rp[q] + col); g4[q][bj][n] = *(const f32x4*)(gp + col); }
                }
                asm volatile("" ::: "memory");
#pragma unroll
                for (int q = 0; q < 2; ++q)
                    if (rows[ai][mp + q] >= 0) {
#pragma unroll
                        for (int bj = 0; bj < 2; ++bj)
#pragma unroll
                            for (int n = 0; n < 2; ++n) *(f32x4*)(rp[q] + col0 + bj * 128 + n * 16) = x4[q][bj][n] + g4[q][bj][n] * acc[ai][bj][mp + q][n];
                    }
            }
    }
};

template <int WHICH>
DEVINL void phase_gemm(const Params& p, char* smem, int bid, int nb) {
    constexpr int N = (WHICH == 0) ? 2048 : (WHICH == 1) ? 512 : (WHICH == 3) ? 5120 : 1024;
    constexpr int K = (WHICH == 1) ? 512 : 1024;
    PG8_LAS unsigned char* lds = (PG8_LAS unsigned char*)smem;
    pg8::DenseSched S;
    bid = sgpr(bid); nb = sgpr(nb);
    if (WHICH == 0) { S.init(sgpr_ptr(p.H), sgpr_ptr(p.wt_in0), N, K, nb, bid, 1); GEpiP0 e{sgpr_ptr(p.P)}; pg8::gemm_phase(lds, S, e); }
    if (WHICH == 1) { S.init(sgpr_ptr(p.s5a), sgpr_ptr(p.glu_t), N, K, nb, bid, 1); GEpiGlu e{sgpr_ptr(p.H), sgpr_ptr(p.s5a), sgpr_ptr(p.glu_b)}; pg8::gemm_phase(lds, S, e); }
    if (WHICH == 2) { S.init(sgpr_ptr(p.H), sgpr_ptr(p.wt_out0), N, K, nb, bid, 1); GEpiY e{sgpr_ptr(p.Y)}; pg8::gemm_phase(lds, S, e); }
    if (WHICH == 3) {
        float* lbl = (float*)(smem + pg8::STAGE_BYTES + 1024);
        for (int i = tid_opaque(); i < 1024; i += NTHR) lbl[i] = p.lb[i];
        __syncthreads();
        S.init(sgpr_ptr(p.H), sgpr_ptr(p.wt_in1), N, K, nb, bid, 1); GEpiP1 e{sgpr_ptr(p.P), lbl}; pg8::gemm_phase(lds, S, e);
    }
    if (WHICH == 4) { S.init(sgpr_ptr(p.H), sgpr_ptr(p.wt_out1), N, K, nb, bid, 1); GEpiY e{sgpr_ptr(p.Y)}; pg8::gemm_phase(lds, S, e); }
    if (WHICH != 4) {
        constexpr int NT0 = (WHICH == 3) ? 4 : 0, NT1 = (WHICH == 3) ? 16 : N / 256, NTC = NT1 - NT0;
        for (int u = bid; u < 16 * NTC; u += nb) {
            const int mt = u / NTC, nt = NT0 + (u - mt * NTC);
            const int m0 = (mt >> 1) * RPB + (mt & 1) * 128, n0 = nt * 256;
            if (WHICH == 0) { EpiP0 e{p.P, m0, n0}; gemm_tile(p.H, 1024, nullptr, m0, 128, p.wt_in0 + (size_t)n0 * 1024, nullptr, 1024, K, K, e, smem); }
            if (WHICH == 1) { EpiGlu e{p.H, p.s5a, p.glu_b, m0, n0}; gemm_tile(p.s5a, 512, nullptr, m0, 128, p.glu_t + (size_t)n0 * 512, nullptr, 512, K, K, e, smem); }
            if (WHICH == 2) { EpiOut e{&p, p.mod + 2048, m0, n0}; gemm_tile(p.H, 1024, nullptr, m0, 128, p.wt_out0 + (size_t)n0 * 1024, nullptr, 1024, K, K, e, smem); }
            if (WHICH == 3) { EpiP1 e{p.P, p.lb, m0, n0}; gemm_tile(p.H, 1024, nullptr, m0, 128, p.wt_in1 + (size_t)n0 * 1024, nullptr, 1024, K, K, e, smem); }
        }
    }
}

constexpr int MOE_TAB = pg8::STAGE_BYTES;
static_assert(MOE_TAB + 1024 <= LDS_BYTES, "moe tables");
DEVINL void moe_setup(const Params& p, int L, int* tab) {
    const int t = tid_opaque();
    if (t < 48) tab[128 + t] = p.cnt[L * 64 + t];
    __syncthreads();
    if (t == 0) {
        int o = 0, ts = 0;
        for (int b = 0; b < 48; ++b) { const int c = tab[128 + b]; tab[b] = o; tab[64 + b] = ts; const int nt = (c + 255) >> 8; o += nt * 256; ts += nt; }
        tab[48] = o; tab[64 + 48] = ts;
    }
    __syncthreads();
}
template <int L>
DEVINL void phase_list(const Params& p, char* smem, int bid, int nb) {
    int* tab = (int*)(smem + MOE_TAB);
    int* red = (int*)smem;
    int* rsrc = red + 1024; int* rdst = rsrc + 256;
    const int t = tid_opaque(), w = t >> 6, lane = t & 63;
    {
        const int bkt = t & 63, part = t >> 6;
        int tot = 0, pre = 0;
        if (bkt < 48) {
#pragma unroll 8
            for (int q = 0; q < 32; ++q) { const int blk = part * 32 + q; const int c = (blk < nb) ? p.blkcnt[((size_t)L * 256 + blk) * 48 + bkt] : 0; tot += c; pre += (blk < bid) ? c : 0; }
        }
        red[part * 64 + bkt] = tot; red[512 + part * 64 + bkt] = pre;
    }
    __syncthreads();
    if (t < 48) {
        int tot = 0, pre = 0;
#pragma unroll
        for (int q = 0; q < 8; ++q) { tot += red[q * 64 + t]; pre += red[512 + q * 64 + t]; }
        tab[128 + t] = tot; tab[192 + t] = pre;
        if (bid == 0) p.cnt[L * 64 + t] = tot;
    }
    __syncthreads();
    if (t == 0) {
        int o = 0, ts = 0;
        for (int b = 0; b < 48; ++b) { const int c = tab[128 + b]; tab[b] = o; tab[64 + b] = ts; const int nt = (c + 255) >> 8; o += nt * 256; ts += nt; }
        tab[48] = o; tab[64 + 48] = ts;
    }
    __syncthreads();
    if (t < 48) tab[192 + t] += tab[t];
    __syncthreads();
    const int ngroups = L ? (NLAT / 16) : (R / 16);
    const int nmine = (bid < ngroups) ? (((ngroups - 1 - bid) / nb + 1) * 16) : 0;
    if (t < nmine) {
        const int idx = (bid + (t >> 4) * nb) * 16 + (t & 15);
        const int r = L ? ((idx >> 12) * RPB + CTXL + (idx & 4095)) : idx;
        const float4 rec = p.RT[r];
        const int bucket = __float_as_int(rec.x);
        const int slot = atomicAdd(&tab[192 + bucket], 1);
        p.list[slot] = r; p.wl[slot] = rec.y; p.wh[slot] = rec.z; p.sor[r] = slot;
    }
    __syncthreads();
}
template <int STAGE>
struct MoeSched {
    static constexpr bool GATHER = (STAGE == 1);
    static constexpr int stage = STAGE;
    const bf16_t* hs; const bf16_t* wgu_t; const bf16_t* act; const bf16_t* wd_t; const int* tab; const int* list; int K, ldb, ksplit, G, c, ntiles;
    DEVINL int a_row(const pg8::Unit& u, int r) const { return list[(u.pm << 8) + (r < u.mvalid ? r : 0)]; }
    DEVINL bool next(int i, pg8::Unit& u) const {
        const int x = c & 7, rk = c >> 3, nper = G >> 3;
        const int t0 = (ntiles * x) >> 3, t1 = (ntiles * (x + 1)) >> 3;
        const int li = i * nper + rk;
        if (li >= (t1 - t0) * 4) return false;
        const int tile = t0 + (li >> 2), pn = li & 3;
        int bucket = 0;
        for (int b = 0; b < 48; ++b) if (tile >= tab[64 + b] && tile < tab[64 + b + 1]) bucket = b;
        bucket = sgpr(bucket);
        const int ti = tile - sgpr(tab[64 + bucket]);
        const int m0 = sgpr(tab[bucket]) + ti * 256;
        const int rem = sgpr(tab[128 + bucket]) - ti * 256;
        const int grp = bucket / 6, pair = bucket - grp * 6;
        const int lo = (pair < 3) ? 0 : (pair < 5 ? 1 : 2);
        const int hi = (pair < 3) ? (pair + 1) : (pair < 5 ? (pair - 1) : 3);
        const int ea = grp * 4 + lo, eb = grp * 4 + hi;
        u.pm = m0 >> 8; u.pn = pn; u.mvalid = rem < 256 ? rem : 256; u.aux = 0;
        if (stage == 1) {
            const int e = (pn >> 1) ? eb : ea;
            u.A = (const char*)hs;
            u.B0 = (const char*)(wgu_t + ((size_t)e * 512 + (pn & 1) * 256) * 1024); u.B1 = u.B0;
        } else {
            u.A = (const char*)(act + (size_t)m0 * 512);
            u.B0 = (const char*)(wd_t + ((size_t)ea * 1024 + pn * 256) * 256);
            u.B1 = (const char*)(wd_t + ((size_t)eb * 1024 + pn * 256) * 256) - (size_t)4 * 128;
        }
        return true;
    }
};
template <int L, int STAGE>
DEVINL void phase_moe(const Params& p, char* smem, int bid, int nb) {
    int* tab = (int*)(smem + MOE_TAB);
    moe_setup(p, L, tab);
    PG8_LAS unsigned char* lds = (PG8_LAS unsigned char*)smem;
    MoeSched<STAGE> S; S.hs = sgpr_ptr(p.H); S.wgu_t = sgpr_ptr(p.wgu_t); S.act = sgpr_ptr(p.act); S.wd_t = sgpr_ptr(p.wd_t); S.list = sgpr_ptr(p.list);
    S.tab = tab; S.G = sgpr(nb); S.c = sgpr(bid); S.ntiles = sgpr(tab[64 + 48]);
    if (STAGE == 1) { S.K = 1024; S.ldb = 1024; S.ksplit = 16; GEpiMoe1 e{sgpr_ptr(p.act), sgpr_ptr(p.wl), sgpr_ptr(p.wh)}; pg8::gemm_phase(lds, S, e); }
    else { S.K = 512; S.ldb = 256; S.ksplit = 4; GEpiY e{sgpr_ptr(p.y2)}; pg8::gemm_phase(lds, S, e); }
    __syncthreads();
}

template <int DK> struct RecL {
    static constexpr int QS = DK + 8;
    static constexpr int oQs = 0;
    static constexpr int oKs = oQs + 64 * QS * 2;
    static constexpr int oKt = oKs + 64 * QS * 2;
    static constexpr int oVt = oKt + DK * 72 * 2;
    static constexpr int oAt = oVt + 128 * 72 * 2;
    static constexpr int oSt = oAt + 64 * 72 * 2;
    static constexpr int oPart = oSt + 128 * 136 * 2;
    static constexpr int oEmid = oPart + 8 * 128 * 4;
    static constexpr int oEend = oEmid + 128 * 4;
    static constexpr int oAF = oEend + 128 * 4;
    static constexpr int oRed = oAF + 64 * 32 * 4;
    static constexpr int total = oRed + 64 * 2 * 4 + 128 * 4;
};
static_assert(RecL<128>::total <= LDS_BYTES, "rec lds");

template <bool GLA> struct RecCols {
    static constexpr int LDP = GLA ? 2048 : 5120;
    static constexpr int QOFF = 0;
    static constexpr int KOFF = 256;
    static constexpr int KF = 1024, KB = 2048;
    static constexpr int VOFF = GLA ? 512 : 3072;
    static constexpr int GOFF = GLA ? 1024 : 4096;
};
template <int DK, bool GLA> struct RecGeo {
    static constexpr int GC = GLA ? 4 : 8;
    static constexpr int NS = GLA ? 16 : 8;
    static constexpr int H = GLA ? 4 : 8;
    static constexpr int KT = DK / 16;
};

struct RawRegs { u32x4 q[2], k[2], v[2], af; };

template <int DK, bool GLA, int DIR, bool PASS3>
DEVINL void rec_load_raw(const Params& p, const bf16_t* __restrict__ P, int row0, int h, RawRegs& r) {
    using C = RecCols<GLA>; constexpr int LDP = C::LDP;
    const int t = tid_opaque();
    if (GLA) {
        const int row = t >> 3, c8 = (t & 7) * 8;
        const bf16_t* rp = P + (size_t)(row0 + row) * LDP + h * 64 + c8;
        if (PASS3) r.q[0] = *(const u32x4*)(rp + C::QOFF);
        r.k[0] = *(const u32x4*)(rp + C::KOFF);
        r.af = *(const u32x4*)(p.AF + (size_t)(row0 + row) * 32 + (t & 7) * 4);
    } else {
#pragma unroll
        for (int i = 0; i < 2; ++i) {
            const int row = (t >> 4) + i * 32, c8 = (t & 15) * 8;
            const bf16_t* rp = P + (size_t)(row0 + row) * LDP + h * 128 + c8;
            if (PASS3) r.q[i] = *(const u32x4*)(rp + C::QOFF);
            r.k[i] = *(const u32x4*)(rp + (DIR ? C::KB : C::KF));
        }
    }
#pragma unroll
    for (int i = 0; i < 2; ++i) {
        const int row = (t >> 4) + i * 32, c8 = (t & 15) * 8;
        r.v[i] = *(const u32x4*)(P + (size_t)(row0 + row) * LDP + C::VOFF + h * 128 + c8);
    }
}

template <int DK, bool GLA, int DIR, bool PASS3>
DEVINL void rec_prep(const Params& p, char* smem, const bf16_t* __restrict__ P, RawRegs& raw, bool has_next, int next_row0, int h,
                     const float (&a2c)[2][16], const float (&abv)[2], float (&bsum)[2]) {
    using L = RecL<DK>;
    constexpr int NCP = DK / 2, NSEG = NTHR / NCP, RS = 64 / NSEG, QS = L::QS;
    constexpr bool ref_end = !PASS3;
    bf16_t* Qs = (bf16_t*)(smem + L::oQs); bf16_t* Ks = (bf16_t*)(smem + L::oKs); bf16_t* Kt = (bf16_t*)(smem + L::oKt); bf16_t* Vt = (bf16_t*)(smem + L::oVt);
    bf16_t* Vraw = (bf16_t*)(smem + L::oSt);
    float* part = (float*)(smem + L::oPart); float* emid = (float*)(smem + L::oEmid); float* eend = (float*)(smem + L::oEend); float* AFs = (float*)(smem + L::oAF);
    const int t = tid_opaque();
    if (GLA) {
        const int row = t >> 3, c8 = (t & 7) * 8;
        if (PASS3) *(u32x4*)&Qs[row * QS + c8] = raw.q[0];
        *(u32x4*)&Ks[row * QS + c8] = raw.k[0];
        *(u32x4*)&AFs[row * 32 + (t & 7) * 4] = raw.af;
    } else {
#pragma unroll
        for (int i = 0; i < 2; ++i) {
            const int row = (t >> 4) + i * 32, c8 = (t & 15) * 8;
            if (PASS3) *(u32x4*)&Qs[row * QS + c8] = raw.q[i];
            *(u32x4*)&Ks[row * QS + c8] = raw.k[i];
        }
    }
#pragma unroll
    for (int i = 0; i < 2; ++i) { const int row = (t >> 4) + i * 32, c8 = (t & 15) * 8; *(u32x4*)&Vraw[row * 136 + c8] = raw.v[i]; }
    lds_sync();
    if (has_next) rec_load_raw<DK, GLA, DIR, PASS3>(p, P, next_row0, h, raw);
    const int cp = t % NCP, seg = t / NCP, c0 = cp * 2, l0 = seg * RS;
    float dv[RS][2];
    float kv[RS][2];
#pragma unroll
    for (int i = 0; i < RS; ++i) {
        const unsigned kr = *(const unsigned*)&Ks[(l0 + i) * QS + c0];
        if (GLA) {
            kv[i][0] = bf2f((bf16_t)(kr & 0xffffu)); kv[i][1] = bf2f((bf16_t)(kr >> 16));
            const float* ar = &AFs[(l0 + i) * 32 + DIR * 16];
            float s0 = abv[0], s1 = abv[1];
#pragma unroll
            for (int r = 0; r < 16; ++r) { const float av = ar[r]; s0 += av * a2c[0][r]; s1 += av * a2c[1][r]; }
            dv[i][0] = logsigmoidf_(s0) * 0.0625f; dv[i][1] = logsigmoidf_(s1) * 0.0625f;
        } else {
            kv[i][0] = h2f((unsigned short)(kr & 0xffffu)); kv[i][1] = h2f((unsigned short)(kr >> 16));
            dv[i][0] = 1.0f - kv[i][0]; dv[i][1] = 1.0f - kv[i][1];
        }
    }
    {
        float s0 = GLA ? 0.f : 1.f, s1 = GLA ? 0.f : 1.f;
#pragma unroll
        for (int i = 0; i < RS; ++i) { if (GLA) { s0 += dv[i][0]; s1 += dv[i][1]; } else { s0 *= dv[i][0]; s1 *= dv[i][1]; } }
        float2 pv; pv.x = s0; pv.y = s1;
        *(float2*)&part[seg * DK + c0] = pv;
    }
    lds_sync();
    float tot[2], base[2], mid[2];
#pragma unroll
    for (int c = 0; c < 2; ++c) { tot[c] = GLA ? 0.f : 1.f; base[c] = tot[c]; mid[c] = tot[c]; }
#pragma unroll
    for (int sg = 0; sg < NSEG; ++sg) {
        const float2 pv = *(const float2*)&part[sg * DK + c0];
        const bool before = (DIR == 0) ? (sg < seg) : (sg > seg);
        const bool firsthalf = (DIR == 0) ? (sg < NSEG / 2) : (sg >= NSEG / 2);
        if (GLA) { tot[0] += pv.x; tot[1] += pv.y; if (before) { base[0] += pv.x; base[1] += pv.y; } if (firsthalf) { mid[0] += pv.x; mid[1] += pv.y; } }
        else { tot[0] *= pv.x; tot[1] *= pv.y; if (before) { base[0] *= pv.x; base[1] *= pv.y; } if (firsthalf) { mid[0] *= pv.x; mid[1] *= pv.y; } }
    }
    float ref[2], iref[2];
#pragma unroll
    for (int c = 0; c < 2; ++c) { ref[c] = ref_end ? tot[c] : mid[c]; iref[c] = GLA ? 0.f : __builtin_amdgcn_rcpf(ref[c]); }
    if (seg == 0) {
#pragma unroll
        for (int c = 0; c < 2; ++c) {
            if (GLA) { emid[c0 + c] = __expf(ref[c]); eend[c0 + c] = __expf(tot[c] - ref[c]); bsum[c] += tot[c]; }
            else { emid[c0 + c] = ref[c]; eend[c0 + c] = tot[c] * iref[c]; bsum[c] += __logf(tot[c]); }
        }
    }
    unsigned short ktv[2][RS];
    float run[2] = {base[0], base[1]};
#pragma unroll
    for (int ii = 0; ii < RS; ++ii) {
        const int i = (DIR == 0) ? ii : (RS - 1 - ii);
        float ek[2], eq[2];
#pragma unroll
        for (int c = 0; c < 2; ++c) {
            if (GLA) { run[c] += dv[i][c]; ek[c] = __expf(ref[c] - run[c]); eq[c] = PASS3 ? __expf(run[c] - ref[c]) : 0.f; }
            else { run[c] *= dv[i][c]; ek[c] = ref[c] * __builtin_amdgcn_rcpf(run[c]); eq[c] = run[c] * iref[c]; }
        }
        const unsigned kp = cvt_pk_bf16(kv[i][0] * ek[0], kv[i][1] * ek[1]);
        ktv[0][i] = (unsigned short)(kp & 0xffffu); ktv[1][i] = (unsigned short)(kp >> 16);
        if (PASS3) {
            const int l = l0 + i;
            *(unsigned*)&Ks[l * QS + c0] = kp;
            const unsigned qr = *(const unsigned*)&Qs[l * QS + c0];
            *(unsigned*)&Qs[l * QS + c0] = cvt_pk_bf16(bf2f((bf16_t)(qr & 0xffffu)) * eq[0], bf2f((bf16_t)(qr >> 16)) * eq[1]);
        }
    }
#pragma unroll
    for (int c = 0; c < 2; ++c) {
        if (RS == 8) {
            u32x4 v;
            v.x = (unsigned)ktv[c][0] | ((unsigned)ktv[c][1] << 16); v.y = (unsigned)ktv[c][2] | ((unsigned)ktv[c][3] << 16);
            v.z = (unsigned)ktv[c][RS > 4 ? 4 : 0] | ((unsigned)ktv[c][RS > 4 ? 5 : 0] << 16); v.w = (unsigned)ktv[c][RS > 4 ? 6 : 0] | ((unsigned)ktv[c][RS > 4 ? 7 : 0] << 16);
            *(u32x4*)&Kt[(c0 + c) * 72 + l0] = v;
        } else {
            u32x2 v;
            v.x = (unsigned)ktv[c][0] | ((unsigned)ktv[c][1] << 16); v.y = (unsigned)ktv[c][2] | ((unsigned)ktv[c][3] << 16);
            *(u32x2*)&Kt[(c0 + c) * 72 + l0] = v;
        }
    }
    {
        const int vp = t & 63, vq = t >> 6;
        unsigned vr[8];
#pragma unroll
        for (int i = 0; i < 8; ++i) vr[i] = *(const unsigned*)&Vraw[(vq * 8 + i) * 136 + 2 * vp];
        u32x4 lo, hi;
        lo.x = (vr[0] & 0xffffu) | (vr[1] << 16); lo.y = (vr[2] & 0xffffu) | (vr[3] << 16); lo.z = (vr[4] & 0xffffu) | (vr[5] << 16); lo.w = (vr[6] & 0xffffu) | (vr[7] << 16);
        hi.x = (vr[0] >> 16) | (vr[1] & 0xffff0000u); hi.y = (vr[2] >> 16) | (vr[3] & 0xffff0000u); hi.z = (vr[4] >> 16) | (vr[5] & 0xffff0000u); hi.w = (vr[6] >> 16) | (vr[7] & 0xffff0000u);
        *(u32x4*)&Vt[(2 * vp) * 72 + vq * 8] = lo;
        *(u32x4*)&Vt[(2 * vp + 1) * 72 + vq * 8] = hi;
    }
    lds_sync();
}

DEVINL bf16x8 ldfrag(const bf16_t* base, int ld, int fr, int fq, int k0) { return *(const bf16x8*)(base + fr * ld + k0 + fq * 8); }

template <int DK, bool GLA, int DIR>
DEVINL void rec_load_a2(const Params& p, int h, float (&a2c)[2][16], float (&abv)[2]) {
#pragma unroll
    for (int c = 0; c < 2; ++c) { abv[c] = 0.f;
#pragma unroll
        for (int r = 0; r < 16; ++r) a2c[c][r] = 0.f; }
    if (GLA) {
        const int c0 = (tid_opaque() % (DK / 2)) * 2;
#pragma unroll
        for (int c = 0; c < 2; ++c) {
#pragma unroll
            for (int r = 0; r < 16; ++r) a2c[c][r] = p.gla_a2[(DIR * 16 + r) * 256 + h * 64 + c0 + c];
            abv[c] = p.gla_ab[DIR * 256 + h * 64 + c0 + c];
        }
    }
}

template <int DK, bool GLA, int DIR>
DEVINL void rec_pass1_unit(const Params& p, char* smem, const bf16_t* P, int b, int h, int cg, float* slots, float* decs) {
    using L = RecL<DK>; using G = RecGeo<DK, GLA>;
    constexpr int KT = G::KT;
    bf16_t* Kt = (bf16_t*)(smem + L::oKt); bf16_t* Vt = (bf16_t*)(smem + L::oVt); float* emid = (float*)(smem + L::oEmid);
    const int t = tid_opaque(), w = t >> 6, lane = t & 63, fr = lane & 15, fq = lane >> 4;
    float a2c[2][16], abv[2];
    rec_load_a2<DK, GLA, DIR>(p, h, a2c, abv);
    f32x4 accS[KT];
#pragma unroll
    for (int kt = 0; kt < KT; ++kt) accS[kt] = (f32x4){0.f, 0.f, 0.f, 0.f};
    float bsum[2] = {0.f, 0.f};
    const int nch = (cg == 0) ? 4 : G::GC;
    auto chunk_row0 = [&](int ci) { const int pc = (cg == 0) ? (DIR == 0 ? ci : 3 - ci) : (DIR == 0 ? (4 + (cg - 1) * G::GC + ci) : (67 - (cg - 1) * G::GC - ci)); return b * RPB + pc * 64; };
    RawRegs raw;
    rec_load_raw<DK, GLA, DIR, false>(p, P, chunk_row0(0), h, raw);
    for (int ci = 0; ci < nch; ++ci) {
        const bool has_next = ci + 1 < nch;
        rec_prep<DK, GLA, DIR, false>(p, smem, P, raw, has_next, has_next ? chunk_row0(ci + 1) : 0, h, a2c, abv, bsum);
        bf16x8 av[2];
#pragma unroll
        for (int ks = 0; ks < 2; ++ks) av[ks] = ldfrag(Vt + (w * 16) * 72, 72, fr, fq, ks * 32);
#pragma unroll
        for (int kt = 0; kt < KT; ++kt) {
            const f32x4 e4 = *(const f32x4*)&emid[kt * 16 + fq * 4];
            f32x4 c = accS[kt] * e4;
#pragma unroll
            for (int ks = 0; ks < 2; ++ks) c = __builtin_amdgcn_mfma_f32_16x16x32_bf16(ldfrag(Kt + (kt * 16) * 72, 72, fr, fq, ks * 32), av[ks], c, 0, 0, 0);
            accS[kt] = c;
        }
        lds_sync();
    }
    const size_t chain = ((size_t)(b * G::H + h) * 2 + DIR);
    float* sl = slots + (chain * G::NS + cg) * (size_t)(128 * DK);
#pragma unroll
    for (int kt = 0; kt < KT; ++kt) *(f32x4*)&sl[(w * 16 + fr) * DK + kt * 16 + fq * 4] = accS[kt];
    if (t < DK / 2) { decs[(chain * G::NS + cg) * DK + 2 * t] = bsum[0]; decs[(chain * G::NS + cg) * DK + 2 * t + 1] = bsum[1]; }
}

template <int DK, bool GLA, int DIR>
DEVINL void rec_pass3_chunk(const Params& p, char* smem, const bf16_t* P, bf16_t* CAT, int row0, int h, f32x4 (&accS)[DK / 16], const float* gnorm) {
    using L = RecL<DK>; using C = RecCols<GLA>;
    constexpr int KT = DK / 16, QS = L::QS, KS = DK / 32;
    bf16_t* Qs = (bf16_t*)(smem + L::oQs); bf16_t* Ks = (bf16_t*)(smem + L::oKs); bf16_t* Kt = (bf16_t*)(smem + L::oKt); bf16_t* Vt = (bf16_t*)(smem + L::oVt);
    bf16_t* At = (bf16_t*)(smem + L::oAt); bf16_t* St = (bf16_t*)(smem + L::oSt);
    float* emid = (float*)(smem + L::oEmid); float* eend = (float*)(smem + L::oEend); float* red = (float*)(smem + L::oRed);
    const int t = tid_opaque(), w = t >> 6, lane = t & 63, fr = lane & 15, fq = lane >> 4;
    u32x2 obv[4], gbv[4];
    if (DIR == 0) {
        const size_t prow = (size_t)(row0 + (w & 3) * 16 + fr);
        const bf16_t* cp0 = CAT + prow * 1024 + h * 128 + (w >> 2) * 64 + fq * 4;
        const bf16_t* gp0 = P + prow * C::LDP + C::GOFF + h * 128 + (w >> 2) * 64 + fq * 4;
#pragma unroll
        for (int n = 0; n < 4; ++n) { obv[n] = *(const u32x2*)(cp0 + n * 16); gbv[n] = *(const u32x2*)(gp0 + n * 16); }
    }
#pragma unroll
    for (int kt = 0; kt < KT; ++kt) {
        const f32x4 e4 = *(const f32x4*)&emid[kt * 16 + fq * 4];
        accS[kt] = accS[kt] * e4;
        *(u32x2*)&St[(w * 16 + fr) * QS + kt * 16 + fq * 4] = pk4(accS[kt]);
    }
    {
        const int lt = w >> 1, st0 = (w & 1) * 2;
        bf16x8 aq[KS];
#pragma unroll
        for (int ks = 0; ks < KS; ++ks) aq[ks] = ldfrag(Qs + (lt * 16) * QS, QS, fr, fq, ks * 32);
#pragma unroll
        for (int s2 = 0; s2 < 2; ++s2) {
            const int st = st0 + s2;
            f32x4 c = (f32x4){0.f, 0.f, 0.f, 0.f};
#pragma unroll
            for (int ks = 0; ks < KS; ++ks) c = __builtin_amdgcn_mfma_f32_16x16x32_bf16(ldfrag(Ks + (st * 16) * QS, QS, fr, fq, ks * 32), aq[ks], c, 0, 0, 0);
            const int l = lt * 16 + fr;
#pragma unroll
            for (int j = 0; j < 4; ++j) { const int sidx = st * 16 + fq * 4 + j; const bool keep = (DIR == 0) ? (sidx <= l) : (sidx >= l); c[j] = keep ? c[j] : 0.f; }
            *(u32x2*)&At[l * 72 + st * 16 + fq * 4] = pk4(c);
        }
    }
    lds_sync();
    const int lt = w & 3, vt0 = (w >> 2) * 4;
    f32x4 o[4];
    {
        bf16x8 aa[2], aq[KS];
#pragma unroll
        for (int ks = 0; ks < 2; ++ks) aa[ks] = ldfrag(At + (lt * 16) * 72, 72, fr, fq, ks * 32);
#pragma unroll
        for (int ks = 0; ks < KS; ++ks) aq[ks] = ldfrag(Qs + (lt * 16) * QS, QS, fr, fq, ks * 32);
#pragma unroll
        for (int n = 0; n < 4; ++n) {
            const int vt = vt0 + n;
            f32x4 c = (f32x4){0.f, 0.f, 0.f, 0.f};
#pragma unroll
            for (int ks = 0; ks < 2; ++ks) c = __builtin_amdgcn_mfma_f32_16x16x32_bf16(ldfrag(Vt + (vt * 16) * 72, 72, fr, fq, ks * 32), aa[ks], c, 0, 0, 0);
#pragma unroll
            for (int ks = 0; ks < KS; ++ks) c = __builtin_amdgcn_mfma_f32_16x16x32_bf16(ldfrag(St + (vt * 16) * QS, QS, fr, fq, ks * 32), aq[ks], c, 0, 0, 0);
            o[n] = c;
        }
    }
    {
        bf16x8 av[2];
#pragma unroll
        for (int ks = 0; ks < 2; ++ks) av[ks] = ldfrag(Vt + (w * 16) * 72, 72, fr, fq, ks * 32);
#pragma unroll
        for (int kt = 0; kt < KT; ++kt) {
            f32x4 c = accS[kt];
#pragma unroll
            for (int ks = 0; ks < 2; ++ks) c = __builtin_amdgcn_mfma_f32_16x16x32_bf16(ldfrag(Kt + (kt * 16) * 72, 72, fr, fq, ks * 32), av[ks], c, 0, 0, 0);
            const f32x4 e4 = *(const f32x4*)&eend[kt * 16 + fq * 4];
            accS[kt] = c * e4;
        }
    }
    const int l = lt * 16 + fr;
    const size_t row = (size_t)(row0 + l);
    bf16_t* cp = CAT + row * 1024 + h * 128 + vt0 * 16 + fq * 4;
    if (DIR == 1) {
#pragma unroll
        for (int n = 0; n < 4; ++n) *(u32x2*)(cp + n * 16) = pk4(o[n]);
    } else {
        float ss = 0.f;
#pragma unroll
        for (int n = 0; n < 4; ++n) {
            const u32x2 ob = obv[n];
            o[n][0] += bf2f((bf16_t)(ob.x & 0xffff)); o[n][1] += bf2f((bf16_t)(ob.x >> 16));
            o[n][2] += bf2f((bf16_t)(ob.y & 0xffff)); o[n][3] += bf2f((bf16_t)(ob.y >> 16));
            ss += o[n][0] * o[n][0] + o[n][1] * o[n][1] + o[n][2] * o[n][2] + o[n][3] * o[n][3];
        }
        ss += __shfl_xor(ss, 16);
        ss += __shfl_xor(ss, 32);
        if (fq == 0) red[l * 2 + (w >> 2)] = ss;
        lds_sync();
        const float tot = red[l * 2] + red[l * 2 + 1];
        const float rstd = rsqrtf(tot * (1.0f / 128.0f) + EPS);
#pragma unroll
        for (int n = 0; n < 4; ++n) {
            const u32x2 gb = gbv[n];
            const f32x4 gn = *(const f32x4*)(gnorm + vt0 * 16 + n * 16 + fq * 4);
            f32x4 gv;
            gv[0] = bf2f((bf16_t)(gb.x & 0xffff)); gv[1] = bf2f((bf16_t)(gb.x >> 16)); gv[2] = bf2f((bf16_t)(gb.y & 0xffff)); gv[3] = bf2f((bf16_t)(gb.y >> 16));
            f32x4 r4;
#pragma unroll
            for (int j = 0; j < 4; ++j) { const float g = GLA ? siluf_(gv[j]) : gv[j]; r4[j] = o[n][j] * rstd * gn[j] * g; }
            *(u32x2*)(cp + n * 16) = pk4(r4);
        }
    }
    lds_sync();
}

template <int DK, bool GLA, int DIR, int PRB = 0>
DEVINL void rec_pass3_sweep(const Params& p, char* smem, const bf16_t* P, bf16_t* CAT, int b, int h, int c_lo, int nch, int slot, const float* slots, const float* gnorm) {
    using G = RecGeo<DK, GLA>;
    constexpr int KT = G::KT;
    const int t = tid_opaque(), w = t >> 6, lane = t & 63, fr = lane & 15, fq = lane >> 4;
    float a2c[2][16], abv[2];
    rec_load_a2<DK, GLA, DIR>(p, h, a2c, abv);
    f32x4 accS[KT];
    if (slot >= 0) {
        const size_t chain = ((size_t)(b * G::H + h) * 2 + DIR);
        const float* sl = slots + (chain * G::NS + slot) * (size_t)(128 * DK);
#pragma unroll
        for (int kt = 0; kt < KT; ++kt) accS[kt] = *(const f32x4*)&sl[(w * 16 + fr) * DK + kt * 16 + fq * 4];
    } else {
#pragma unroll
        for (int kt = 0; kt < KT; ++kt) accS[kt] = (f32x4){0.f, 0.f, 0.f, 0.f};
    }
    float bsum[2] = {0.f, 0.f};
    float* gn_lds = (float*)(smem + RecL<DK>::oRed + 64 * 2 * 4);
    if (DIR == 0) { if (t < 128) gn_lds[t] = gnorm[t]; }
    auto chunk_row0 = [&](int ci) { const int pc = (DIR == 0) ? (c_lo + ci) : (c_lo + nch - 1 - ci); return b * RPB + pc * 64; };
    RawRegs raw;
    rec_load_raw<DK, GLA, DIR, true>(p, P, chunk_row0(0), h, raw);
    for (int ci = 0; ci < nch; ++ci) {
        const bool has_next = ci + 1 < nch;
        if (PRB != 2 || ci == 0) rec_prep<DK, GLA, DIR, true>(p, smem, P, raw, has_next, has_next ? chunk_row0(ci + 1) : 0, h, a2c, abv, bsum);
        if (PRB != 1) rec_pass3_chunk<DK, GLA, DIR>(p, smem, P, CAT, chunk_row0(ci), h, accS, gn_lds);
    }
}

template <int DK, bool GLA, int PRB = 0>
DEVINL void rec_pass3_unit(const Params& p, char* smem, const bf16_t* P, bf16_t* CAT, int b, int h, int gi, const float* slots, const float* gnorm) {
    using G = RecGeo<DK, GLA>;
    int c_lo, nch, slot_f, slot_b;
    if (GLA) {
        if (gi == 0) { c_lo = 0; nch = 4; slot_f = -1; slot_b = -1; }
        else { const int pg = gi - 1; c_lo = 4 + pg * G::GC; nch = G::GC; slot_f = pg; slot_b = G::NS - 1 - pg; }
    } else { const int pg = gi; c_lo = 4 + pg * G::GC; nch = G::GC; slot_f = pg; slot_b = G::NS - 1 - pg; }
    rec_pass3_sweep<DK, GLA, 1, PRB>(p, smem, P, CAT, b, h, c_lo, nch, slot_b, slots, gnorm);
    asm volatile("s_waitcnt vmcnt(0)" ::: "memory");
    rec_pass3_sweep<DK, GLA, 0, PRB>(p, smem, P, CAT, b, h, c_lo, nch, slot_f, slots, gnorm);
}

template <int DK, bool GLA>
DEVINL void rec_scan(float* slots, const float* decs, int bid, int nb) {
    using G = RecGeo<DK, GLA>;
    constexpr int NCHAIN = NBATCH * G::H * 2, PER = 128 * DK / 4;
    const int total = NCHAIN * PER;
    for (int i = bid * NTHR + tid_opaque(); i < total; i += nb * NTHR) {
        const int chain = i / PER, e = i - chain * PER;
        const int k4 = (e * 4) % DK;
        f32x4 run = (f32x4){0.f, 0.f, 0.f, 0.f};
#pragma unroll 1
        for (int s0 = 0; s0 < G::NS; s0 += 8) {
            f32x4 a[8], d4[8];
#pragma unroll
            for (int j = 0; j < 8; ++j) {
                d4[j] = *(const f32x4*)&decs[((size_t)chain * G::NS + s0 + j) * DK + k4];
                a[j] = *(const f32x4*)(slots + ((size_t)chain * G::NS + s0 + j) * (size_t)(128 * DK) + (size_t)e * 4);
            }
#pragma unroll
            for (int j = 0; j < 8; ++j) {
#pragma unroll
                for (int q = 0; q < 4; ++q) run[q] = __expf(d4[j][q]) * run[q] + a[j][q];
                *(f32x4*)(slots + ((size_t)chain * G::NS + s0 + j) * (size_t)(128 * DK) + (size_t)e * 4) = run;
            }
        }
    }
}

DEVINL size_t s5_idx(int b, int di, int pc, int g, int pp) { return ((((size_t)(b * 2 + di) * NCH + pc) * 32 + g) * 64 + pp) * 2; }

constexpr int S5_BU_LD = 20;
constexpr int S5_WAVE_LDS = 128 * S5_BU_LD * 4 + 16 * 136 * 2;
static_assert(8 * S5_WAVE_LDS <= LDS_BYTES, "s5 lds");

DEVINL void s5_load_afr(const Params& p, int row0, int g, int fr, int fq, bf16x8 (&afr)[4]) {
    const bf16x8 z = (bf16x8){0, 0, 0, 0, 0, 0, 0, 0};
#pragma unroll
    for (int sb = 0; sb < 4; ++sb) afr[sb] = (fq < 2) ? *(const bf16x8*)(p.P + (size_t)(row0 + sb * 16 + fr) * 2048 + 1536 + g * 16 + fq * 8) : z;
}
DEVINL void s5_load_bfr(const Params& p, int di, int g, int fr, int fq, bf16x8 (&bfr)[8]) {
    const bf16x8 z = (bf16x8){0, 0, 0, 0, 0, 0, 0, 0};
#pragma unroll
    for (int nt = 0; nt < 8; ++nt) bfr[nt] = (fq < 2) ? *(const bf16x8*)(p.bbm + ((size_t)((di * 32 + g) * 128 + nt * 16 + fr)) * 16 + fq * 8) : z;
}
DEVINL void s5_bu_subblock(float* BuT, const bf16x8& a, const bf16x8 (&bfr)[8], int fr, int fq) {
#pragma unroll
    for (int nt = 0; nt < 8; ++nt) {
        f32x4 c = (f32x4){0.f, 0.f, 0.f, 0.f};
        c = __builtin_amdgcn_mfma_f32_16x16x32_bf16(a, bfr[nt], c, 0, 0, 0);
        *(f32x4*)&BuT[(nt * 16 + fr) * S5_BU_LD + fq * 4] = c;
    }
}
template <int DIR, bool XS>
DEVINL void s5_scan16(const float* BuT, bf16_t* Xs, int lane, float are, float aim, float& xr, float& xi) {
    f32x4 br[4], bi[4];
#pragma unroll
    for (int q = 0; q < 4; ++q) { br[q] = *(const f32x4*)&BuT[lane * S5_BU_LD + q * 4]; bi[q] = *(const f32x4*)&BuT[(64 + lane) * S5_BU_LD + q * 4]; }
#pragma unroll
    for (int tt = 0; tt < 16; ++tt) {
        const int tl = DIR ? (15 - tt) : tt;
        const float nr = are * xr - aim * xi + br[tl >> 2][tl & 3], ni = are * xi + aim * xr + bi[tl >> 2][tl & 3];
        xr = nr; xi = ni;
        if (XS) *(unsigned*)&Xs[tl * 136 + 2 * lane] = cvt_pk_bf16(xr, xi);
    }
}
template <int DIR>
DEVINL void s5_pass1_task(const Params& p, float* BuT, int b, int pc, int g, const bf16x8 (&afr)[4], int lane, int fr, int fq) {
    bf16x8 bfr[8];
    s5_load_bfr(p, DIR, g, fr, fq, bfr);
    const float are = p.atab[((DIR * 32 + g) * 64 + lane) * 2], aim = p.atab[((DIR * 32 + g) * 64 + lane) * 2 + 1];
    float xr = 0.f, xi = 0.f;
#pragma unroll
    for (int sbi = 0; sbi < 4; ++sbi) {
        const int sb = DIR ? (3 - sbi) : sbi;
        s5_bu_subblock(BuT, afr[sb], bfr, fr, fq);
        asm volatile("s_waitcnt lgkmcnt(0)" ::: "memory");
        s5_scan16<DIR, false>(BuT, nullptr, lane, are, aim, xr, xi);
        asm volatile("s_waitcnt lgkmcnt(0)" ::: "memory");
    }
    float* o = p.s5xend + s5_idx(b, DIR, pc, g, lane);
    o[0] = xr; o[1] = xi;
}
DEVINL void s5_pass1_unit(const Params& p, char* smem, int b, int pc, int half) {
    const int t = tid_opaque(), w = t >> 6, lane = t & 63, fr = lane & 15, fq = lane >> 4;
    float* BuT = (float*)(smem + w * S5_WAVE_LDS);
    const int row0 = b * RPB + pc * 64;
#pragma unroll 1
    for (int q = 0; q < 2; ++q) {
        const int g = half * 16 + w * 2 + q;
        bf16x8 afr[4];
        s5_load_afr(p, row0, g, fr, fq, afr);
        s5_pass1_task<0>(p, BuT, b, pc, g, afr, lane, fr, fq);
        s5_pass1_task<1>(p, BuT, b, pc, g, afr, lane, fr, fq);
    }
}
DEVINL void s5_scan(const Params& p, int bid, int nb) {
    for (int i = bid * NTHR + tid_opaque(); i < NBATCH * 2 * 32 * 64; i += nb * NTHR) {
        const int pp = i & 63, g = (i >> 6) & 31, di = (i >> 11) & 1, b = i >> 12;
        const float ar = p.a64tab[((di * 32 + g) * 64 + pp) * 2], ai = p.a64tab[((di * 32 + g) * 64 + pp) * 2 + 1];
        float cr = 0.f, ci = 0.f;
#pragma unroll 1
        for (int c0 = 0; c0 < NCH; c0 += 17) {
            float er[17], ei[17];
#pragma unroll
            for (int j = 0; j < 17; ++j) {
                const int ch = c0 + j, pc = di ? (ch < 4 ? 3 - ch : 71 - ch) : ch;
                const size_t ix = s5_idx(b, di, pc, g, pp);
                er[j] = p.s5xend[ix]; ei[j] = p.s5xend[ix + 1];
            }
#pragma unroll
            for (int j = 0; j < 17; ++j) {
                const int ch = c0 + j, pc = di ? (ch < 4 ? 3 - ch : 71 - ch) : ch;
                const size_t ix = s5_idx(b, di, pc, g, pp);
                p.s5carry[ix] = cr; p.s5carry[ix + 1] = ci;
                const float nr = ar * cr - ai * ci + er[j], ni = ar * ci + ai * cr + ei[j];
                cr = nr; ci = ni;
            }
        }
    }
}
template <int DIR>
DEVINL void s5_pass3_task(const Params& p, float* BuT, bf16_t* Xs, int b, int pc, int g, const bf16x8 (&afr)[4], f32x4 (&acc)[4], int lane, int fr, int fq) {
    bf16x8 bfr[8];
    s5_load_bfr(p, DIR, g, fr, fq, bfr);
    bf16x8 cb[4];
#pragma unroll
    for (int ks = 0; ks < 4; ++ks) cb[ks] = *(const bf16x8*)(p.cmt + ((size_t)(g * 16 + fr)) * 256 + DIR * 128 + ks * 32 + fq * 8);
    const float are = p.atab[((DIR * 32 + g) * 64 + lane) * 2], aim = p.atab[((DIR * 32 + g) * 64 + lane) * 2 + 1];
    const size_t cix = s5_idx(b, DIR, pc, g, lane);
    float xr = p.s5carry[cix], xi = p.s5carry[cix + 1];
#pragma unroll
    for (int sbi = 0; sbi < 4; ++sbi) {
        const int sb = DIR ? (3 - sbi) : sbi;
        s5_bu_subblock(BuT, afr[sb], bfr, fr, fq);
        asm volatile("s_waitcnt lgkmcnt(0)" ::: "memory");
        s5_scan16<DIR, true>(BuT, Xs, lane, are, aim, xr, xi);
        asm volatile("s_waitcnt lgkmcnt(0)" ::: "memory");
        f32x4 c = acc[sb];
#pragma unroll
        for (int ks = 0; ks < 4; ++ks) {
            const bf16x8 a = *(const bf16x8*)(Xs + fr * 136 + ks * 32 + fq * 8);
            c = __builtin_amdgcn_mfma_f32_16x16x32_bf16(cb[ks], a, c, 0, 0, 0);
        }
        acc[sb] = c;
        asm volatile("s_waitcnt lgkmcnt(0)" ::: "memory");
    }
}
DEVINL void s5_pass3_unit(const Params& p, char* smem, int b, int pc, int half) {
    const int t = tid_opaque(), w = t >> 6, lane = t & 63, fr = lane & 15, fq = lane >> 4;
    float* BuT = (float*)(smem + w * S5_WAVE_LDS);
    bf16_t* Xs = (bf16_t*)(smem + w * S5_WAVE_LDS + 128 * S5_BU_LD * 4);
    const int row0 = b * RPB + pc * 64;
#pragma unroll 1
    for (int q = 0; q < 2; ++q) {
        const int g = half * 16 + w * 2 + q;
        bf16x8 afr[4];
        s5_load_afr(p, row0, g, fr, fq, afr);
        f32x4 acc[4];
#pragma unroll
        for (int sb = 0; sb < 4; ++sb) acc[sb] = (f32x4){0.f, 0.f, 0.f, 0.f};
        s5_pass3_task<1>(p, BuT, Xs, b, pc, g, afr, acc, lane, fr, fq);
        s5_pass3_task<0>(p, BuT, Xs, b, pc, g, afr, acc, lane, fr, fq);
        const f32x4 d4 = *(const f32x4*)(p.s5_d + g * 16 + fq * 4);
#pragma unroll
        for (int sb = 0; sb < 4; ++sb) {
            const int tok = sb * 16 + fr;
            const u32x2 ub = *(const u32x2*)(p.P + (size_t)(row0 + tok) * 2048 + 1536 + g * 16 + fq * 4);
            f32x4 uv; uv[0] = bf2f((bf16_t)(ub.x & 0xffff)); uv[1] = bf2f((bf16_t)(ub.x >> 16)); uv[2] = bf2f((bf16_t)(ub.y & 0xffff)); uv[3] = bf2f((bf16_t)(ub.y >> 16));
            f32x4 r4;
#pragma unroll
            for (int j = 0; j < 4; ++j) r4[j] = gelu_tanh(acc[sb][j] + d4[j] * uv[j]);
            *(u32x2*)(p.s5a + (size_t)(row0 + tok) * 512 + g * 16 + fq * 4) = pk4(r4);
        }
    }
}

struct UnitQueue {
    int* counter; int* slot; int total, shard, k, pend, per;
    static constexpr int NSH = 32;
    DEVINL void init(int* heads, int q, char* smem, int total_, int bid, int nb) {
        shard = sgpr(bid) & (NSH - 1); counter = heads + (q * NSH + shard) * 16; slot = (int*)(smem + LDS_BYTES - 64); total = total_;
        per = (sgpr(nb) - 1 - shard) / NSH + 1;
        k = sgpr(bid) >> 5; pend = 0;
        if (tid_opaque() == 0) pend = atomicAdd(counter, 1) + per;
    }
    DEVINL int unit() const { return shard + NSH * k; }
    DEVINL bool valid() const { return unit() < total; }
    DEVINL void advance() {
        if (tid_opaque() == 0) { *slot = pend; pend = atomicAdd(counter, 1) + per; }
        lds_sync();
        k = sgpr(*slot);
        lds_sync();
    }
};

DEVINL void phase_prologue(const Params& p, char* smem, int bid, int nb) {
    UnitQueue Q; Q.init(p.qheads, 0, smem, T0_END, bid, nb);
    for (; Q.valid(); Q.advance()) prologue_task(p, smem, Q.unit());
}

template <int LAYER>
DEVINL void phase_rec1(const Params& p, char* smem, int bid, int nb) {
    if (LAYER == 0) {
        constexpr int NG = 8 * 4 * 2 * 16;
        constexpr int NS5 = NBATCH * NCH * 2;
        UnitQueue Q; Q.init(p.qheads, 1, smem, NG + NS5, bid, nb);
        for (; Q.valid(); Q.advance()) {
            const int u = Q.unit();
            if (u < NG) {
                const int cg = u & 15, dir = (u >> 4) & 1, h = (u >> 5) & 3, b = u >> 7;
                if (dir == 0) rec_pass1_unit<64, true, 0>(p, smem, p.P, b, h, cg, p.gslots, p.gdecs);
                else rec_pass1_unit<64, true, 1>(p, smem, p.P, b, h, cg, p.gslots, p.gdecs);
            } else { const int v = u - NG; s5_pass1_unit(p, smem, (v >> 1) / NCH, (v >> 1) % NCH, v & 1); }
        }
    } else {
        constexpr int NG = 8 * 8 * 2 * 8;
        for (int u = bid; u < NG; u += nb) {
            const int cg = u & 7, dir = (u >> 3) & 1, h = (u >> 4) & 7, b = u >> 7;
            if (dir == 0) rec_pass1_unit<128, false, 0>(p, smem, p.P, b, h, cg, p.hslots, p.hdecs);
            else rec_pass1_unit<128, false, 1>(p, smem, p.P, b, h, cg, p.hslots, p.hdecs);
        }
    }
}
template <int LAYER>
DEVINL void phase_scan(const Params& p, char* smem, int bid, int nb) {
    if (LAYER == 0) { rec_scan<64, true>(p.gslots, p.gdecs, bid, nb); s5_scan(p, bid, nb); }
    else rec_scan<128, false>(p.hslots, p.hdecs, bid, nb);
}
template <int LAYER>
DEVINL void phase_rec3(const Params& p, char* smem, int bid, int nb) {
    if (LAYER == 0) {
        constexpr int NG = 8 * 4 * 17;
        constexpr int NS5 = NBATCH * NCH * 2;
        UnitQueue Q; Q.init(p.qheads, 2, smem, NG + NS5, bid, nb);
        for (; Q.valid(); Q.advance()) {
            const int u = Q.unit();
            if (u < NG) { const int gi = u % 17, h = (u / 17) & 3, b = u / 68; rec_pass3_unit<64, true>(p, smem, p.P, p.H, b, h, gi, p.gslots, p.gla_norm); }
            else { const int v = u - NG; s5_pass3_unit(p, smem, (v >> 1) / NCH, (v >> 1) % NCH, v & 1); }
        }
    } else {
        constexpr int NG = 8 * 8 * 8;
        for (int u = bid; u < NG; u += nb) { const int gi = u & 7, h = (u >> 3) & 7, b = u >> 6; rec_pass3_unit<128, false>(p, smem, p.P, p.H, b, h, gi, p.hslots, p.hg_norm); }
    }
}

DEVINL void phase_final(const Params& p, int bid, int nb) {
    const int t = tid_opaque(), w = t >> 6, lane = t & 63;
    f32x4 gn[4];
#pragma unroll
    for (int i = 0; i < 4; ++i) gn[i] = *(const f32x4*)(p.final_norm + lane * 4 + i * 256);
    for (int rg = bid; rg < NLAT / 16; rg += nb) {
        const int i0 = rg * 16 + w * 2, b = i0 >> 12;
        const float* gatev = p.mod + ((size_t)(9 + b)) * 6144 + 5120;
        f32x4 v[2][4], gu[4]; u32x2 ub[2][4];
#pragma unroll
        for (int rw = 0; rw < 2; ++rw) {
            const int i = i0 + rw;
            const int slot = p.sor[(i >> 12) * RPB + CTXL + (i & 4095)];
            const float* res = p.out + (size_t)i * D;
#pragma unroll
            for (int q = 0; q < 4; ++q) { v[rw][q] = *(const f32x4*)(res + lane * 4 + q * 256); ub[rw][q] = *(const u32x2*)(p.y2 + (size_t)slot * D + lane * 4 + q * 256); }
        }
#pragma unroll
        for (int q = 0; q < 4; ++q) gu[q] = *(const f32x4*)(gatev + lane * 4 + q * 256);
#pragma unroll
        for (int rw = 0; rw < 2; ++rw) {
            float* res = p.out + (size_t)(i0 + rw) * D;
            float ss = 0.f;
#pragma unroll
            for (int q = 0; q < 4; ++q) {
                const u32x2 u = ub[rw][q];
                v[rw][q][0] += gu[q][0] * bf2f((bf16_t)(u.x & 0xffffu)); v[rw][q][1] += gu[q][1] * bf2f((bf16_t)(u.x >> 16));
                v[rw][q][2] += gu[q][2] * bf2f((bf16_t)(u.y & 0xffffu)); v[rw][q][3] += gu[q][3] * bf2f((bf16_t)(u.y >> 16));
                ss += v[rw][q][0] * v[rw][q][0] + v[rw][q][1] * v[rw][q][1] + v[rw][q][2] * v[rw][q][2] + v[rw][q][3] * v[rw][q][3];
            }
#pragma unroll
            for (int o = 32; o >= 1; o >>= 1) ss += __shfl_xor(ss, o);
            const float rstd = rsqrtf(ss * (1.0f / 1024.0f) + EPS);
#pragma unroll
            for (int q = 0; q < 4; ++q) *(f32x4*)(res + lane * 4 + q * 256) = v[rw][q] * rstd * gn[q];
        }
    }
}

constexpr int NPHASE = 23;
constexpr int MEGA_LDS = LDS_BYTES + 16 + 1024;
static_assert(sizeof(Params) <= 1024 && sizeof(Params) % 8 == 0, "params block");
template <int PH>
DEVINL void run_phase(const Params& p, char* smem, int bid, int nb) {
    if (PH == 0) phase_prologue(p, smem, bid, nb);
    if (PH == 1) phase_pre<0>(p, smem, bid, nb);
    if (PH == 2) phase_gemm<0>(p, smem, bid, nb);
    if (PH == 3) phase_rec1<0>(p, smem, bid, nb);
    if (PH == 4) phase_scan<0>(p, smem, bid, nb);
    if (PH == 5) phase_rec3<0>(p, smem, bid, nb);
    if (PH == 6) phase_gemm<1>(p, smem, bid, nb);
    if (PH == 7) phase_gemm<2>(p, smem, bid, nb);
    if (PH == 8) phase_pre<1>(p, smem, bid, nb);
    if (PH == 9) phase_list<0>(p, smem, bid, nb);
    if (PH == 10) phase_moe<0, 1>(p, smem, bid, nb);
    if (PH == 11) phase_moe<0, 2>(p, smem, bid, nb);
    if (PH == 12) phase_pre<2>(p, smem, bid, nb);
    if (PH == 13) phase_gemm<3>(p, smem, bid, nb);
    if (PH == 14) phase_rec1<1>(p, smem, bid, nb);
    if (PH == 15) phase_scan<1>(p, smem, bid, nb);
    if (PH == 16) phase_rec3<1>(p, smem, bid, nb);
    if (PH == 17) phase_gemm<4>(p, smem, bid, nb);
    if (PH == 18) phase_pre<3>(p, smem, bid, nb);
    if (PH == 19) phase_list<1>(p, smem, bid, nb);
    if (PH == 20) phase_moe<1, 1>(p, smem, bid, nb);
    if (PH == 21) phase_moe<1, 2>(p, smem, bid, nb);
    if (PH == 22) phase_final(p, bid, nb);
}

extern __shared__ __attribute__((aligned(16))) char dyn_smem[];

#if ONE_LAUNCH
template <int PH> struct PhaseSeq {
    static DEVINL void run(const Params& p, char* smem, const XcdBarrier& bar) {
        PhaseSeq<PH - 1>::run(p, smem, bar);
        xcd_barrier(bar);
        run_phase<PH>(p, smem, (int)blockIdx.x, (int)gridDim.x);
#ifdef DUP_MASK
        if ((DUP_MASK >> PH) & 1) { xcd_barrier(bar); run_phase<PH>(p, smem, (int)blockIdx.x, (int)gridDim.x); }
#endif
    }
};
template <> struct PhaseSeq<0> {
    static DEVINL void run(const Params& p, char* smem, const XcdBarrier& bar) {
        run_phase<0>(p, smem, (int)blockIdx.x, (int)gridDim.x);
#ifdef DUP_MASK
        if (DUP_MASK & 1) { xcd_barrier(bar); run_phase<0>(p, smem, (int)blockIdx.x, (int)gridDim.x); }
#endif
    }
};
__global__ void __launch_bounds__(NTHR, 2) mega_kernel(Params p) {
    volatile LAS unsigned* st = (volatile LAS unsigned*)(dyn_smem + LDS_BYTES);
    if (threadIdx.x == 0) { st[0] = 0u; st[1] = 0u; st[2] = 0u; st[3] = 0u; }
    __syncthreads();
    XcdBarrier bar = xcd_barrier_post(p.bar, st);
#ifdef PROBE_ID
    {
        const int bid = (int)blockIdx.x, nb = (int)gridDim.x;
        if (PROBE_ID == 1) for (int v = bid; v < NBATCH * NCH * 2; v += nb) s5_pass1_unit(p, dyn_smem, (v >> 1) / NCH, (v >> 1) % NCH, v & 1);
        if (PROBE_ID == 2) for (int u = bid; u < 1024; u += nb) { const int cg = u & 15, dir = (u >> 4) & 1, h = (u >> 5) & 3, b = u >> 7;
            if (dir == 0) rec_pass1_unit<64, true, 0>(p, dyn_smem, p.P, b, h, cg, p.gslots, p.gdecs); else rec_pass1_unit<64, true, 1>(p, dyn_smem, p.P, b, h, cg, p.gslots, p.gdecs); }
        if (PROBE_ID == 3) for (int v = bid; v < NBATCH * NCH * 2; v += nb) s5_pass3_unit(p, dyn_smem, (v >> 1) / NCH, (v >> 1) % NCH, v & 1);
        if (PROBE_ID == 4) for (int u = bid; u < 8 * 4 * 17; u += nb) { const int gi = u % 17, h = (u / 17) & 3, b = u / 68; rec_pass3_unit<64, true>(p, dyn_smem, p.P, p.H, b, h, gi, p.gslots, p.gla_norm); }
        if (PROBE_ID == 6) for (int u = bid; u < 512; u += nb) { const int gi = u & 7, h = (u >> 3) & 7, b = u >> 6; rec_pass3_unit<128, false, RECPROBE>(p, dyn_smem, p.P, p.H, b, h, gi, p.hslots, p.hg_norm); }
        if (PROBE_ID == 5) for (int u = bid; u < 1024 + NBATCH * NCH * 2; u += nb) {
            if (u < 1024) { const int cg = u & 15, dir = (u >> 4) & 1, h = (u >> 5) & 3, b = u >> 7;
                if (dir == 0) rec_pass1_unit<64, true, 0>(p, dyn_smem, p.P, b, h, cg, p.gslots, p.gdecs); else rec_pass1_unit<64, true, 1>(p, dyn_smem, p.P, b, h, cg, p.gslots, p.gdecs); }
            else { const int v = u - 1024; s5_pass1_unit(p, dyn_smem, (v >> 1) / NCH, (v >> 1) % NCH, v & 1); } }
        xcd_barrier(bar);
    }
#endif
#ifdef PREFIX_K
    PhaseSeq<PREFIX_K>::run(p, dyn_smem, bar);
    xcd_barrier(bar);
    if (blockIdx.x == 0) { if (threadIdx.x < 256) p.cnt[threadIdx.x] = 0; for (int i = threadIdx.x; i < 3 * 32 * 16; i += NTHR) p.qheads[i] = 0; }
    xcd_barrier(bar);
#endif
    PhaseSeq<NPHASE - 1>::run(p, dyn_smem, bar);
}
#else
template <int PH>
__global__ void __launch_bounds__(NTHR, 2) phase_kernel(Params p) {
    run_phase<PH>(p, dyn_smem, (int)blockIdx.x, (int)gridDim.x);
}
template <int PH> struct Launcher {
    static void go(const Params& p, int grid, hipStream_t s) {
        Launcher<PH - 1>::go(p, grid, s);
        static bool attr = false;
        if (!attr) { hipFuncSetAttribute((const void*)phase_kernel<PH>, hipFuncAttributeMaxDynamicSharedMemorySize, LDS_BYTES + 16); attr = true; }
        phase_kernel<PH><<<grid, NTHR, LDS_BYTES + 16, s>>>(p);
    }
};
template <> struct Launcher<-1> { static void go(const Params&, int, hipStream_t) {} };
#endif

static size_t align_up(size_t v, size_t a) { return (v + a - 1) / a * a; }

extern "C" void kernel_launch(void* const* d_in, const int* in_sizes, int n_in, void* d_out, int out_size, void* d_ws, size_t ws_size, hipStream_t stream) {
    (void)in_sizes; (void)n_in; (void)out_size;
    Params p;
    memset(&p, 0, sizeof(p));
    const float* const* in = (const float* const*)d_in;
    p.x = in[0]; p.c = in[1]; p.ctx = in[2]; p.c_ctx = in[3]; p.ada_w = in[4]; p.ada_b = in[5]; p.norm_mix = in[6]; p.norm_ffn = in[7];
    p.ab_w_in = in[8]; p.ab_w_out = in[9]; p.gla_a2 = in[10]; p.gla_ab = in[11]; p.gla_norm = in[12];
    p.s5_lam_re = in[13]; p.s5_lam_im = in[14]; p.s5_log_dt = in[15]; p.s5_b_re = in[16]; p.s5_b_im = in[17]; p.s5_c_re = in[18]; p.s5_c_im = in[19];
    p.s5_d = in[20]; p.glu_w = in[21]; p.glu_b = in[22]; p.hg_w_in = in[23]; p.hg_w_out = in[24]; p.hg_lb = in[25]; p.hg_norm = in[26];
    p.router_w = in[27]; p.router_bias = in[28]; p.moe_wg = in[29]; p.moe_wu = in[30]; p.moe_wd = in[31]; p.final_norm = in[32];
    p.out = (float*)d_out;

    char* ws = (char*)d_ws;
    size_t o = 0;
    auto take = [&](size_t bytes) { char* r = ws + o; o = align_up(o + bytes, 256); return r; };
    p.bar = (unsigned*)take(XCD_BAR_WORDS * 4);
    p.cnt = (int*)take(256 * 4);
    p.qheads = (int*)take(3 * 32 * 16 * 4);
    p.mod = (float*)take((size_t)2 * 9 * 6144 * 4);
    p.pos = (float*)take(64 * 512 * 4);
    p.lb = (float*)take(1024 * 4);
    p.atab = (float*)take(2 * 32 * 64 * 2 * 4);
    p.a64tab = (float*)take(2 * 32 * 64 * 2 * 4);
    p.cmt = (bf16_t*)take((size_t)32 * 16 * 256 * 2);
    p.bbm = (bf16_t*)take((size_t)2 * 32 * 128 * 16 * 2);
    p.wrt = (bf16_t*)take((size_t)2 * 2 * 32 * 1024 * 2);
    p.RT = (float4*)take((size_t)R * 16);
    p.list = (int*)take((size_t)ACT_ROWS * 4);
    p.wl = (float*)take((size_t)ACT_ROWS * 4);
    p.wh = (float*)take((size_t)ACT_ROWS * 4);
    p.cx = (float*)take((size_t)NBATCH * CTXL * D * 4);
    p.sor = (int*)take((size_t)R * 4);
    p.blkcnt = (int*)take((size_t)2 * 256 * 48 * 4);
    p.wt_in0 = (bf16_t*)take((size_t)2048 * 1024 * 2);
    p.wt_out0 = (bf16_t*)take((size_t)1024 * 1024 * 2);
    p.glu_t = (bf16_t*)take((size_t)512 * 512 * 2);
    p.wt_in1 = (bf16_t*)take((size_t)5120 * 1024 * 2);
    p.wt_out1 = (bf16_t*)take((size_t)1024 * 1024 * 2);
    p.H = (bf16_t*)take((size_t)R * 1024 * 2);
    const size_t big = o;
    p.P = (bf16_t*)(ws + big);
    size_t o0 = big + (size_t)R * 2048 * 2;
    auto take0 = [&](size_t bytes) { char* r = ws + o0; o0 = align_up(o0 + bytes, 256); return r; };
    p.gslots = (float*)take0((size_t)64 * 16 * 128 * 64 * 4);
    p.gdecs = (float*)take0((size_t)64 * 16 * 64 * 4);
    p.s5xend = (float*)take0((size_t)NBATCH * 2 * NCH * 32 * 64 * 2 * 4);
    p.s5carry = (float*)take0((size_t)NBATCH * 2 * NCH * 32 * 64 * 2 * 4);
    p.s5a = (bf16_t*)take0((size_t)R * 512 * 2);
    p.AF = (float*)take0((size_t)R * 32 * 4);
    p.wgu_t = (bf16_t*)take0((size_t)32 * 512 * 1024 * 2);
    p.wd_t = (bf16_t*)take0((size_t)32 * 1024 * 256 * 2);
    p.hs = (bf16_t*)(ws + big);
    p.Y = (bf16_t*)(ws + big);
    p.y2 = (bf16_t*)(ws + big);
    p.act = (bf16_t*)(ws + big + (size_t)ACT_ROWS * 1024 * 2);
    if (big + (size_t)ACT_ROWS * 1024 * 2 + (size_t)ACT_ROWS * 512 * 2 > (size_t)((char*)p.s5a - ws)) fprintf(stderr, "moe overlay overlaps live buffers\n");
    size_t o1 = big + (size_t)R * 5120 * 2;
    auto take1 = [&](size_t bytes) { char* r = ws + o1; o1 = align_up(o1 + bytes, 256); return r; };
    p.hslots = (float*)take1((size_t)128 * 8 * 128 * 128 * 4);
    p.hdecs = (float*)take1((size_t)128 * 8 * 128 * 4);
    const size_t need = o0 > o1 ? o0 : o1;
    if (need > ws_size) fprintf(stderr, "workspace too small: need %zu have %zu\n", need, ws_size);

    static int grid = 0;
    if (!grid) {
        int dev = 0, cus = 0;
        if (hipGetDevice(&dev) != hipSuccess || hipDeviceGetAttribute(&cus, hipDeviceAttributeMultiprocessorCount, dev) != hipSuccess || cus <= 0) cus = 256;
        grid = cus > 256 ? 256 : (cus & ~7);
    }
#if ONE_LAUNCH
    static bool attr = false;
    if (!attr) { hipFuncSetAttribute((const void*)mega_kernel, hipFuncAttributeMaxDynamicSharedMemorySize, MEGA_LDS); attr = true; }
    hipMemsetAsync(p.bar, 0, XCD_BAR_WORDS * 4 + 256 * 4 + 3 * 32 * 16 * 4, stream);
    mega_kernel<<<grid, NTHR, MEGA_LDS, stream>>>(p);
#else
    Launcher<NPHASE - 1>::go(p, grid, stream);
#endif
}
```

```cpp
#include <hip/hip_runtime.h>
#include <stdint.h>
#include <string.h>
#include <stdio.h>

#ifndef ONE_LAUNCH
#define ONE_LAUNCH 1
#endif

typedef unsigned short bf16_t;
typedef short bf16x8 __attribute__((ext_vector_type(8)));
typedef float f32x4 __attribute__((ext_vector_type(4)));
typedef unsigned u32x4 __attribute__((ext_vector_type(4)));
typedef unsigned u32x2 __attribute__((ext_vector_type(2)));
#define DEVINL __device__ __forceinline__

constexpr int D = 1024, NBATCH = 8, SEQ = 4096, CTXL = 256;
constexpr int RPB = SEQ + CTXL;
constexpr int R = NBATCH * RPB;
constexpr int NLAT = NBATCH * SEQ;
constexpr int NCH = RPB / 64;
constexpr float EPS = 1e-6f;
constexpr int NTHR = 512;
constexpr int LDS_BYTES = 136 * 1024;
constexpr int ACT_ROWS = 47104;

#define XB_TMO      128
#define XB_XCNT(j)  (256  + 64 * (j))
#define XB_XSUB(j)  (1280 + 64 * (j))
#define XB_XGEN(j)  (2304 + 64 * (j))
#define XB_TOP      3328
#define XB_TOPGEN   3392
#define XCD_BAR_WORDS 3456
#define XB_SPIN_CAP (1u << 18)
#define LAS __attribute__((address_space(3)))

__device__ __forceinline__ unsigned xb_ld(unsigned* p)              { return __hip_atomic_load(p, __ATOMIC_RELAXED, __HIP_MEMORY_SCOPE_AGENT); }
__device__ __forceinline__ unsigned xb_add(unsigned* p, unsigned v) { return __hip_atomic_fetch_add(p, v, __ATOMIC_RELAXED, __HIP_MEMORY_SCOPE_AGENT); }
__device__ __forceinline__ unsigned xb_xcc_id() { return (unsigned)__builtin_amdgcn_s_getreg((3 << 11) | 20) & 0xFu; }
#define XB_SPIN(cond, bar) do { unsigned _sp = 0; while (cond) { __builtin_amdgcn_s_sleep(1); \
    if ((++_sp & 255u) == 0u) { if (xb_ld(&(bar)[XB_TMO])) break; if (_sp > XB_SPIN_CAP) { atomicAdd(&(bar)[XB_TMO], 1u); break; } } } } while (0)

struct XcdBarrier {
    unsigned* bar; unsigned x;
    volatile LAS unsigned* st;
};
__device__ __forceinline__ XcdBarrier xcd_barrier_post(unsigned* bar, volatile LAS unsigned* st) {
    XcdBarrier b; b.bar = bar; b.x = xb_xcc_id(); b.st = st;
    if (threadIdx.x == 0) (void)xb_add(&bar[XB_XCNT(b.x)], 1u);
    return b;
}
__device__ __forceinline__ void xcd_barrier_complete(unsigned* bar, unsigned x, unsigned& nloc, unsigned& nx) {
    const unsigned G = gridDim.x * gridDim.y * gridDim.z;
    unsigned sum, cnt, mine, sp = 0u;
    for (;;) {
        sum = 0u; cnt = 0u; mine = 0u;
#pragma unroll
        for (unsigned j = 0; j < 16; ++j) { const unsigned c = xb_ld(&bar[XB_XCNT(j)]); sum += c; cnt += (c > 0u) ? 1u : 0u; mine = (j == x) ? c : mine; }
        if (sum == G) break;
        __builtin_amdgcn_s_sleep(1);
        if ((++sp & 255u) == 0u) { if (xb_ld(&bar[XB_TMO])) break; if (sp > XB_SPIN_CAP) { atomicAdd(&bar[XB_TMO], 1u); break; } }
    }
    nloc = mine > 0u ? mine : 1u; nx = cnt > 0u ? cnt : 1u;
}
__device__ __forceinline__ void xcd_barrier(const XcdBarrier& b) {
    asm volatile("s_waitcnt vmcnt(0)" ::: "memory");
    __syncthreads();
    if (threadIdx.x == 0) {
        unsigned* bar = b.bar;
        __builtin_amdgcn_s_waitcnt(0);
        unsigned nloc = b.st[0], nx = b.st[1];
        if (nloc == 0u) { xcd_barrier_complete(bar, b.x, nloc, nx); b.st[0] = nloc; b.st[1] = nx; }
        const unsigned old = xb_add(&bar[XB_XSUB(b.x)], 1u);
        const unsigned gen = old / nloc;
        if (old + 1u == (gen + 1u) * nloc) {
            __builtin_amdgcn_fence(__ATOMIC_RELEASE, "agent");
            asm volatile("s_waitcnt vmcnt(0)" ::: "memory");
            const unsigned og = xb_add(&bar[XB_TOP], 1u);
            const unsigned tg = og / nx;
            if (og + 1u == (tg + 1u) * nx) xb_add(&bar[XB_TOPGEN], 1u);
            else XB_SPIN(xb_ld(&bar[XB_TOPGEN]) == tg, bar);
            __builtin_amdgcn_fence(__ATOMIC_ACQUIRE, "agent");
            xb_add(&bar[XB_XGEN(b.x)], 1u);
            asm volatile("s_waitcnt vmcnt(0)" ::: "memory");
        } else {
            XB_SPIN(xb_ld(&bar[XB_XGEN(b.x)]) == gen, bar);
            __builtin_amdgcn_fence(__ATOMIC_ACQUIRE, "agent");
            asm volatile("s_waitcnt vmcnt(0)" ::: "memory");
        }
    }
    __syncthreads();
}

struct Params {
    const float *x, *c, *ctx, *c_ctx, *ada_w, *ada_b, *norm_mix, *norm_ffn, *ab_w_in, *ab_w_out, *gla_a2, *gla_ab, *gla_norm;
    const float *s5_lam_re, *s5_lam_im, *s5_log_dt, *s5_b_re, *s5_b_im, *s5_c_re, *s5_c_im, *s5_d, *glu_w, *glu_b;
    const float *hg_w_in, *hg_w_out, *hg_lb, *hg_norm, *router_w, *router_bias, *moe_wg, *moe_wu, *moe_wd, *final_norm;
    float* out;
    unsigned* bar;
    int* qheads;
    int* cnt;
    float *mod, *pos, *lb, *atab, *a64tab;
    bf16_t* cmt; bf16_t* bbm; bf16_t* wrt;
    float4* RT;
    int* list; float *wl, *wh;
    float* cx;
    bf16_t* Y; bf16_t* y2;
    int* sor; int* blkcnt;
    bf16_t *wt_in0, *wt_out0, *glu_t, *wt_in1, *wt_out1;
    bf16_t* H;
    bf16_t* P;
    float *gslots, *gdecs;
    float *s5xend, *s5carry;
    bf16_t* s5a;
    bf16_t *wgu_t, *wd_t, *act, *hs;
    float* AF;
    float *hslots, *hdecs;
};

DEVINL int tid_opaque() { int t = threadIdx.x; asm volatile("" : "+v"(t)); return t; }
DEVINL void lds_sync() { asm volatile("s_waitcnt lgkmcnt(0)" ::: "memory"); __builtin_amdgcn_s_barrier(); asm volatile("" ::: "memory"); }

DEVINL int sgpr(int v) { return __builtin_amdgcn_readfirstlane(v); }
template <class T> DEVINL T* sgpr_ptr(T* ptr) {
    const unsigned long long v = (unsigned long long)ptr;
    const unsigned lo = (unsigned)__builtin_amdgcn_readfirstlane((int)(unsigned)v), hi = (unsigned)__builtin_amdgcn_readfirstlane((int)(unsigned)(v >> 32));
    return (T*)(__attribute__((address_space(1))) T*)(((unsigned long long)hi << 32) | lo);
}
DEVINL unsigned cvt_pk_bf16(float lo, float hi) { unsigned r; asm volatile("v_cvt_pk_bf16_f32 %0, %1, %2" : "=v"(r) : "v"(lo), "v"(hi)); return r; }
DEVINL float bf2f(bf16_t v) { return __uint_as_float(((unsigned)v) << 16); }
DEVINL bf16_t f2bf(float f) { unsigned u = __float_as_uint(f); u += 0x7fffu + ((u >> 16) & 1u); return (bf16_t)(u >> 16); }
DEVINL unsigned pk2(float lo, float hi) { return cvt_pk_bf16(lo, hi); }
DEVINL u32x2 pk4(f32x4 v) { u32x2 r; r.x = pk2(v[0], v[1]); r.y = pk2(v[2], v[3]); return r; }
DEVINL float h2f(unsigned short v) { return (float)__builtin_bit_cast(_Float16, v); }
DEVINL unsigned short f2h(float f) { return __builtin_bit_cast(unsigned short, (_Float16)f); }
DEVINL float sigmoidf_(float x) { return __builtin_amdgcn_rcpf(1.0f + __expf(-x)); }
DEVINL float siluf_(float x) { return x * sigmoidf_(x); }
DEVINL float logsigmoidf_(float x) { return fminf(x, 0.0f) - __logf(1.0f + __expf(-fabsf(x))); }
DEVINL float gelu_tanh(float y) { float z = 0.7978845608028654f * (y + 0.044715f * y * y * y); float th = 1.0f - 2.0f * __builtin_amdgcn_rcpf(__expf(2.0f * z) + 1.0f); return 0.5f * y * (1.0f + th); }
DEVINL float* resid_row(const Params& p, int r) {
    const int b = r / RPB, j = r - b * RPB;
    return (j < CTXL) ? (p.cx + (size_t)(b * CTXL + j) * D) : (p.out + (size_t)(b * SEQ + (j - CTXL)) * D);
}
DEVINL int row_batch_mod(int r) { const int b = r / RPB, j = r - b * RPB; return (j < CTXL) ? 8 : b; }

template <int K>
DEVINL f32x4 mma_lds(f32x4 c, const bf16_t* A, int lda, const bf16_t* Bt, int ldb, int fr, int fq) {
#pragma unroll
    for (int k0 = 0; k0 < K; k0 += 32) {
        const bf16x8 a = *(const bf16x8*)(A + fr * lda + k0 + fq * 8);
        const bf16x8 b = *(const bf16x8*)(Bt + fr * ldb + k0 + fq * 8);
        c = __builtin_amdgcn_mfma_f32_16x16x32_bf16(b, a, c, 0, 0, 0);
    }
    return c;
}

DEVINL void cvt_tile(const float* colp, int ld, int k0, int n0, bf16_t* dst, int ldd, char* smem, int lrow = -1) {
    float (*T)[257] = (float (*)[257])smem;
    const int t = tid_opaque(), nl = lrow >= 0 ? lrow : (t & 63), ks = t >> 6;
    const float* sp = colp + (size_t)(k0 + ks * 32) * ld;
#pragma unroll
    for (int i0 = 0; i0 < 32; i0 += 16) {
        float v[16];
#pragma unroll
        for (int i = 0; i < 16; ++i) v[i] = sp[(size_t)(i0 + i) * ld];
#pragma unroll
        for (int i = 0; i < 16; ++i) T[nl][ks * 32 + i0 + i] = v[i];
    }
    __syncthreads();
    const int n2 = t >> 3, kc = t & 7;
#pragma unroll
    for (int j = 0; j < 4; ++j) {
        const int k = j * 64 + kc * 8;
        u32x4 v;
        v.x = pk2(T[n2][k + 0], T[n2][k + 1]); v.y = pk2(T[n2][k + 2], T[n2][k + 3]);
        v.z = pk2(T[n2][k + 4], T[n2][k + 5]); v.w = pk2(T[n2][k + 6], T[n2][k + 7]);
        *(u32x4*)(dst + (size_t)(n0 + n2) * ldd + k0 + k) = v;
    }
    __syncthreads();
}

constexpr int NT_GU = 1024, NT_WD = 512;
DEVINL void moe_cvt_task(const Params& p, int layer, int tid, char* smem) {
    if (tid < NT_GU) {
        const int e = tid >> 5, rem = tid & 31, nb = rem >> 2, kb = rem & 3;
        const float* wg = p.moe_wg + (size_t)(layer * 32 + e) * 1024 * 256;
        const float* wu = p.moe_wu + (size_t)(layer * 32 + e) * 1024 * 256;
        const int nl = tid_opaque() & 63, isup = nl >> 5, ul = nl & 31;
        const int ub = (nb >> 2) * 128 + (nb & 3) * 32;
        const float* cp = (isup ? wu : wg) + ub + ul;
        const int lrow = (ul >> 2) * 8 + isup * 4 + (ul & 3);
        cvt_tile(cp, 256, kb * 256, nb * 64, p.wgu_t + (size_t)e * 512 * 1024, 1024, smem, lrow);
    } else {
        const int t2 = tid - NT_GU, e = t2 >> 4, nb = t2 & 15;
        const float* wd = p.moe_wd + (size_t)(layer * 32 + e) * 256 * 1024;
        cvt_tile(wd + nb * 64 + (tid_opaque() & 63), 1024, 0, nb * 64, p.wd_t + (size_t)e * 1024 * 256, 256, smem);
    }
}

constexpr int NT_MISC = 9, NT_MOD = 192, NT_IN0 = 128, NT_OUT0 = 64, NT_GLU = 16, NT_IN1 = 320, NT_OUT1 = 64, NT_POS = 64, NT_S5 = 64;
constexpr int T0_MOD = NT_MISC, T0_IN0 = T0_MOD + NT_MOD, T0_OUT0 = T0_IN0 + NT_IN0, T0_GLU = T0_OUT0 + NT_OUT0, T0_IN1 = T0_GLU + NT_GLU, T0_OUT1 = T0_IN1 + NT_IN1,
              T0_MOE = T0_OUT1 + NT_OUT1, T0_POS = T0_MOE + NT_GU + NT_WD, T0_S5 = T0_POS + NT_POS, T0_END = T0_S5 + NT_S5;

DEVINL void prologue_task(const Params& p, char* smem, int task) {
    const int t = tid_opaque();
    {
        if (task < T0_MOD) {
            if (task == 0) {
                for (int i = t; i < 1024; i += NTHR) p.lb[i] = sigmoidf_(p.hg_lb[1024 + i] - p.hg_lb[i]);
            } else {
                for (int i = (task - 1) * 8192 + t; i < task * 8192; i += NTHR) {
                    const int which = i >> 15, e = (i >> 10) & 31, k = i & 1023;
                    const float v = which ? p.ab_w_in[(size_t)k * 2080 + 1536 + e] : p.router_w[k * 32 + e];
                    const bf16_t hi = f2bf(v); const bf16_t lo = f2bf(v - bf2f(hi));
                    p.wrt[((size_t)(which * 2 + 0) * 32 + e) * 1024 + k] = hi;
                    p.wrt[((size_t)(which * 2 + 1) * 32 + e) * 1024 + k] = lo;
                }
            }
        } else if (task < T0_IN0) {
            float* sc = (float*)smem;
            float* red = sc + 9 * 1024;
            for (int i = t; i < 9 * 1024; i += NTHR) { const int rr = i >> 10, k = i & 1023; const float v = rr < 8 ? p.c[rr * 1024 + k] : p.c_ctx[k]; sc[i] = siluf_(v); }
            __syncthreads();
            const int tk = task - T0_MOD, l = tk / 96, c0 = (tk % 96) * 64, col = t & 63, kp = t >> 6;
            const float* wp = p.ada_w + ((size_t)l * 1024 + kp * 128) * 6144 + c0 + col;
            float acc[9];
#pragma unroll
            for (int rr = 0; rr < 9; ++rr) acc[rr] = 0.f;
#pragma unroll 1
            for (int k = 0; k < 128; k += 16) {
                float w16[16];
#pragma unroll
                for (int j = 0; j < 16; ++j) w16[j] = wp[(size_t)(k + j) * 6144];
#pragma unroll
                for (int rr = 0; rr < 9; ++rr) {
#pragma unroll
                    for (int j = 0; j < 16; j += 4) {
                        const f32x4 s4 = *(const f32x4*)&sc[rr * 1024 + kp * 128 + k + j];
                        acc[rr] += s4[0] * w16[j] + s4[1] * w16[j + 1] + s4[2] * w16[j + 2] + s4[3] * w16[j + 3];
                    }
                }
            }
#pragma unroll
            for (int rr = 0; rr < 9; ++rr) red[(kp * 9 + rr) * 64 + col] = acc[rr];
            __syncthreads();
            for (int o = t; o < 576; o += NTHR) {
                const int rr = o >> 6, cc = o & 63;
                float sv = p.ada_b[l * 6144 + c0 + cc];
#pragma unroll
                for (int q = 0; q < 8; ++q) sv += red[(q * 9 + rr) * 64 + cc];
                p.mod[((size_t)l * 9 + rr) * 6144 + c0 + cc] = sv;
            }
            __syncthreads();
        } else if (task < T0_OUT0) {
            const int tt = task - T0_IN0, nbk = tt >> 2, kb = tt & 3;
            const int n = nbk * 64 + (t & 63);
            const float* cp = p.ab_w_in + (n < 1536 ? n : n + 32);
            cvt_tile(cp, 2080, kb * 256, nbk * 64, p.wt_in0, 1024, smem);
        } else if (task < T0_GLU) {
            const int tt = task - T0_OUT0, nbk = tt >> 2, kb = tt & 3;
            cvt_tile(p.ab_w_out + nbk * 64 + (t & 63), 1024, kb * 256, nbk * 64, p.wt_out0, 1024, smem);
        } else if (task < T0_IN1) {
            const int tt = task - T0_GLU, nbk = tt >> 1, kb = tt & 1;
            cvt_tile(p.glu_w + nbk * 64 + (t & 63), 512, kb * 256, nbk * 64, p.glu_t, 512, smem);
        } else if (task < T0_OUT1) {
            const int tt = task - T0_IN1, nbk = tt >> 2, kb = tt & 3;
            cvt_tile(p.hg_w_in + nbk * 64 + (t & 63), 5120, kb * 256, nbk * 64, p.wt_in1, 1024, smem);
        } else if (task < T0_MOE) {
            const int tt = task - T0_OUT1, nbk = tt >> 2, kb = tt & 3;
            cvt_tile(p.hg_w_out + nbk * 64 + (t & 63), 1024, kb * 256, nbk * 64, p.wt_out1, 1024, smem);
        } else if (task < T0_POS) {
            moe_cvt_task(p, 0, task - T0_MOE, smem);
        } else if (task < T0_S5) {
            const int pi = task - T0_POS;
            const int j = t, jj = j & 255;
            const float omega = __expf(-9.210340371976184f * (float)jj * (1.0f / 256.0f));
            const float ang = (float)pi * omega;
            p.pos[pi * 512 + j] = (j < 256) ? sinf(ang) : cosf(ang);
        } else {
            const int tt = task - T0_S5, di = tt >> 5, g = tt & 31;
            const int pp = t & 63, hs = t >> 6;
            const float dt = __expf(p.s5_log_dt[di * 32 + g]);
            const float lr = p.s5_lam_re[(di * 32 + g) * 64 + pp], li = p.s5_lam_im[(di * 32 + g) * 64 + pp];
            const float mag = __expf(lr * dt);
            const float are = mag * cosf(li * dt), aim = mag * sinf(li * dt);
            const float den = lr * lr + li * li;
            const float fre = ((are - 1.0f) * lr + aim * li) / den;
            const float fim = (aim * lr - (are - 1.0f) * li) / den;
            if (hs == 0) {
                p.atab[((di * 32 + g) * 64 + pp) * 2 + 0] = are; p.atab[((di * 32 + g) * 64 + pp) * 2 + 1] = aim;
                float xr = are, xi = aim;
#pragma unroll
                for (int q = 0; q < 6; ++q) { const float nr = xr * xr - xi * xi, ni = 2.0f * xr * xi; xr = nr; xi = ni; }
                p.a64tab[((di * 32 + g) * 64 + pp) * 2 + 0] = xr; p.a64tab[((di * 32 + g) * 64 + pp) * 2 + 1] = xi;
            }
#pragma unroll
            for (int q = 0; q < 2; ++q) {
                const int h = hs * 2 + q;
                const float bre = p.s5_b_re[((size_t)((di * 32 + g) * 64 + pp)) * 16 + h], bim = p.s5_b_im[((size_t)((di * 32 + g) * 64 + pp)) * 16 + h];
                p.bbm[((size_t)((di * 32 + g) * 128 + pp)) * 16 + h] = f2bf(fre * bre - fim * bim);
                p.bbm[((size_t)((di * 32 + g) * 128 + 64 + pp)) * 16 + h] = f2bf(fre * bim + fim * bre);
                const float cre = p.s5_c_re[((size_t)((di * 32 + g) * 16 + h)) * 64 + pp], cim = p.s5_c_im[((size_t)((di * 32 + g) * 16 + h)) * 64 + pp];
                bf16_t* cm = p.cmt + ((size_t)(g * 16 + h)) * 256 + di * 128;
                cm[2 * pp] = f2bf(cre); cm[2 * pp + 1] = f2bf(-cim);
            }
        }
    }
}

constexpr int PRE_LD = 1028;
template <int MODE>
DEVINL void phase_pre(const Params& p, char* smem, int bid, int nb) {
    constexpr bool GEMV = (MODE == 0 || MODE == 1 || MODE == 3);
    constexpr int L = (MODE >= 2) ? 1 : 0;
    constexpr bool FFN = (MODE == 1 || MODE == 3);
    float* hrow = (float*)smem;
    float* part = hrow + 16 * PRE_LD;
    float* logit = part + 8 * 16 * 32;
    int* lcnt = (int*)(logit + 512);
    static_assert((16 * PRE_LD + 8 * 16 * 32 + 512 + 64) * 4 <= LDS_BYTES, "pre lds");
    const int t = tid_opaque(), w = t >> 6, lane = t & 63, fr = lane & 15, fq = lane >> 4;
    bf16x8 bh[4][2], bl[4][2];
    if (GEMV) {
        const bf16_t* wt = p.wrt + (size_t)(MODE == 0 ? 1 : 0) * 2 * 32 * 1024;
#pragma unroll
        for (int ks = 0; ks < 4; ++ks)
#pragma unroll
            for (int nt = 0; nt < 2; ++nt) {
                const size_t off = (size_t)(nt * 16 + fr) * 1024 + w * 128 + ks * 32 + fq * 8;
                bh[ks][nt] = *(const bf16x8*)(wt + off);
                bl[ks][nt] = *(const bf16x8*)(wt + 32 * 1024 + off);
            }
    }
    if (FFN) { if (t < 64) lcnt[t] = 0; }
    __syncthreads();
    const float* gain = (FFN ? p.norm_ffn : p.norm_mix) + L * 1024;
    const int ngroups = (MODE == 3) ? (NLAT / 16) : (R / 16);
    constexpr bool UPD_Y = (MODE != 0);
    constexpr bool UPD_SLOT = (MODE == 2);
    constexpr bool STORE_RES = (MODE == 0 || MODE == 2);
    auto row_of = [&](int rg, int rw) { const int i = rg * 16 + w * 2 + rw; return (MODE == 3) ? ((i >> 12) * RPB + CTXL + (i & 4095)) : i; };
    f32x4 g4[4];
#pragma unroll
    for (int i = 0; i < 4; ++i) g4[i] = *(const f32x4*)(gain + lane * 4 + i * 256);
    for (int rg = bid; rg < ngroups; rg += nb) {
        f32x4 vcur[2][4]; u32x2 ycur[2][4], scur[2][4];
        int slot[2] = {0, 0};
        if (UPD_SLOT) {
#pragma unroll
            for (int rw = 0; rw < 2; ++rw) slot[rw] = p.sor[row_of(rg, rw)];
        }
#pragma unroll
        for (int rw = 0; rw < 2; ++rw) {
            const int r = row_of(rg, rw);
            const int b = r / RPB, j = r - b * RPB;
            const bool isctx = j < CTXL;
            const float* src;
            if (MODE == 0) src = isctx ? (p.ctx + (size_t)(b * CTXL + j) * D) : (p.x + (size_t)(b * SEQ + (j - CTXL)) * D);
            else src = isctx ? (p.cx + (size_t)(b * CTXL + j) * D) : (p.out + (size_t)(b * SEQ + (j - CTXL)) * D);
#pragma unroll
            for (int i = 0; i < 4; ++i) vcur[rw][i] = *(const f32x4*)(src + lane * 4 + i * 256);
            if (UPD_Y) {
#pragma unroll
                for (int i = 0; i < 4; ++i) ycur[rw][i] = *(const u32x2*)(p.Y + (size_t)r * D + lane * 4 + i * 256);
            }
        }
        if (UPD_SLOT) {
#pragma unroll
            for (int rw = 0; rw < 2; ++rw)
#pragma unroll
                for (int i = 0; i < 4; ++i) scur[rw][i] = *(const u32x2*)(p.y2 + (size_t)slot[rw] * D + lane * 4 + i * 256);
        }
        f32x4 sh4[4], sc4[4], gy4[4], gs4[4], pe[2][4];
        {
            const int r0 = row_of(rg, 0);
            const int b0 = r0 / RPB, j0 = r0 - b0 * RPB;
            const int mb = (j0 < CTXL) ? 8 : b0;
            const float* modv = p.mod + ((size_t)(L * 9 + mb)) * 6144 + (FFN ? 3072 : 0);
            const float* gyv = p.mod + ((size_t)((MODE == 3 ? 1 : 0) * 9 + mb)) * 6144 + 2048;
            const float* gsv = p.mod + ((size_t)mb) * 6144 + 5120;
#pragma unroll
            for (int i = 0; i < 4; ++i) {
                const int c = lane * 4 + i * 256;
                sh4[i] = *(const f32x4*)(modv + c); sc4[i] = *(const f32x4*)(modv + 1024 + c);
                if (UPD_Y) gy4[i] = *(const f32x4*)(gyv + c);
                if (UPD_SLOT) gs4[i] = *(const f32x4*)(gsv + c);
            }
            if (MODE == 0) {
#pragma unroll
                for (int rw = 0; rw < 2; ++rw) {
                    const int j = j0 + rw;
                    const int n = (j < CTXL) ? 0 : (j - CTXL), prow = n >> 6, pcol = n & 63;
#pragma unroll
                    for (int i = 0; i < 4; ++i) {
                        const int c = lane * 4 + i * 256;
                        pe[rw][i] = (c < 512) ? *(const f32x4*)(p.pos + prow * 512 + c) : *(const f32x4*)(p.pos + pcol * 512 + (c - 512));
                    }
                }
            }
        }
#pragma unroll
        for (int rw = 0; rw < 2; ++rw) {
            const int lrow = w * 2 + rw;
            const int r = row_of(rg, rw);
            const int b = r / RPB, j = r - b * RPB;
            const bool isctx = j < CTXL;
            float* res = isctx ? (p.cx + (size_t)(b * CTXL + j) * D) : (p.out + (size_t)(b * SEQ + (j - CTXL)) * D);
            f32x4 v[4];
#pragma unroll
            for (int i = 0; i < 4; ++i) v[i] = vcur[rw][i];
            if (MODE == 0) {
                if (!isctx) {
#pragma unroll
                    for (int i = 0; i < 4; ++i) v[i] += pe[rw][i];
                }
            }
            if (UPD_Y && !isctx) {
#pragma unroll
                for (int i = 0; i < 4; ++i) {
                    const u32x2 ub = ycur[rw][i];
                    v[i][0] += gy4[i][0] * bf2f((bf16_t)(ub.x & 0xffffu)); v[i][1] += gy4[i][1] * bf2f((bf16_t)(ub.x >> 16));
                    v[i][2] += gy4[i][2] * bf2f((bf16_t)(ub.y & 0xffffu)); v[i][3] += gy4[i][3] * bf2f((bf16_t)(ub.y >> 16));
                }
            }
            if (UPD_SLOT) {
#pragma unroll
                for (int i = 0; i < 4; ++i) {
                    const u32x2 ub = scur[rw][i];
                    v[i][0] += gs4[i][0] * bf2f((bf16_t)(ub.x & 0xffffu)); v[i][1] += gs4[i][1] * bf2f((bf16_t)(ub.x >> 16));
                    v[i][2] += gs4[i][2] * bf2f((bf16_t)(ub.y & 0xffffu)); v[i][3] += gs4[i][3] * bf2f((bf16_t)(ub.y >> 16));
                }
            }
            if (STORE_RES) {
#pragma unroll
                for (int i = 0; i < 4; ++i) *(f32x4*)(res + lane * 4 + i * 256) = v[i];
            }
            float ss = 0.f;
#pragma unroll
            for (int i = 0; i < 4; ++i) ss += v[i][0] * v[i][0] + v[i][1] * v[i][1] + v[i][2] * v[i][2] + v[i][3] * v[i][3];
#pragma unroll
            for (int o = 32; o >= 1; o >>= 1) ss += __shfl_xor(ss, o);
            const float rstd = rsqrtf(ss * (1.0f / 1024.0f) + EPS);
#pragma unroll
            for (int i = 0; i < 4; ++i) {
                const int c = lane * 4 + i * 256;
                f32x4 hv;
#pragma unroll
                for (int q = 0; q < 4; ++q) hv[q] = v[i][q] * rstd * g4[i][q] * (1.0f + sc4[i][q]) + sh4[i][q];
                *(u32x2*)(p.H + (size_t)r * D + c) = pk4(hv);
                if (GEMV) *(f32x4*)(hrow + lrow * PRE_LD + c) = hv;
            }
        }
        if (GEMV) {
            lds_sync();
            f32x4 c0 = (f32x4){0.f, 0.f, 0.f, 0.f}, c1 = c0;
#pragma unroll
            for (int ks = 0; ks < 4; ++ks) {
                const float* hp = hrow + fr * PRE_LD + w * 128 + ks * 32 + fq * 8;
                const f32x4 x0 = *(const f32x4*)hp, x1 = *(const f32x4*)(hp + 4);
                u32x4 hi, lo;
                hi.x = cvt_pk_bf16(x0[0], x0[1]); hi.y = cvt_pk_bf16(x0[2], x0[3]); hi.z = cvt_pk_bf16(x1[0], x1[1]); hi.w = cvt_pk_bf16(x1[2], x1[3]);
                lo.x = cvt_pk_bf16(x0[0] - __uint_as_float(hi.x << 16), x0[1] - __uint_as_float(hi.x & 0xffff0000u));
                lo.y = cvt_pk_bf16(x0[2] - __uint_as_float(hi.y << 16), x0[3] - __uint_as_float(hi.y & 0xffff0000u));
                lo.z = cvt_pk_bf16(x1[0] - __uint_as_float(hi.z << 16), x1[1] - __uint_as_float(hi.z & 0xffff0000u));
                lo.w = cvt_pk_bf16(x1[2] - __uint_as_float(hi.w << 16), x1[3] - __uint_as_float(hi.w & 0xffff0000u));
                const bf16x8 ah = __builtin_bit_cast(bf16x8, hi), al = __builtin_bit_cast(bf16x8, lo);
                c0 = __builtin_amdgcn_mfma_f32_16x16x32_bf16(bh[ks][0], ah, c0, 0, 0, 0);
                c0 = __builtin_amdgcn_mfma_f32_16x16x32_bf16(bl[ks][0], ah, c0, 0, 0, 0);
                c0 = __builtin_amdgcn_mfma_f32_16x16x32_bf16(bh[ks][0], al, c0, 0, 0, 0);
                c1 = __builtin_amdgcn_mfma_f32_16x16x32_bf16(bh[ks][1], ah, c1, 0, 0, 0);
                c1 = __builtin_amdgcn_mfma_f32_16x16x32_bf16(bl[ks][1], ah, c1, 0, 0, 0);
                c1 = __builtin_amdgcn_mfma_f32_16x16x32_bf16(bh[ks][1], al, c1, 0, 0, 0);
            }
            *(f32x4*)&part[(w * 16 + fr) * 32 + fq * 4] = c0;
            *(f32x4*)&part[(w * 16 + fr) * 32 + 16 + fq * 4] = c1;
            lds_sync();
            {
                const int row = t >> 5, e2 = t & 31;
                float s = 0.f;
#pragma unroll
                for (int q = 0; q < 8; ++q) s += part[(q * 16 + row) * 32 + e2];
                if (MODE == 0) p.AF[(size_t)(rg * 16 + row) * 32 + e2] = s;
                else logit[row * 32 + e2] = s;
            }
            if (FFN) {
                lds_sync();
                if (t < 128) {
                    const int row = t >> 3, g = t & 7;
                    float m1 = -3.0e38f, m2 = -3.0e38f, a1 = 0.f, a2 = 0.f; int i1 = 0, i2 = 0;
                    const f32x4 lg = *(const f32x4*)&logit[row * 32 + g * 4];
                    const f32x4 rbv = *(const f32x4*)(p.router_bias + g * 4);
#pragma unroll
                    for (int e = 0; e < 4; ++e) {
                        const float a = sigmoidf_(lg[e]);
                        const float sv = a + rbv[e];
                        if (sv > m1) { m2 = m1; i2 = i1; a2 = a1; m1 = sv; i1 = e; a1 = a; }
                        else if (sv > m2) { m2 = sv; i2 = e; a2 = a; }
                    }
                    float best = m1 + m2; int bg = g, pk = i1 | (i2 << 2); float ba1 = a1, ba2 = a2;
#pragma unroll
                    for (int o = 1; o < 8; o <<= 1) {
                        const float ob = __shfl_xor(best, o); const int og = __shfl_xor(bg, o), opk = __shfl_xor(pk, o);
                        const float oa1 = __shfl_xor(ba1, o), oa2 = __shfl_xor(ba2, o);
                        const bool take = (ob > best) || (ob == best && og < bg);
                        best = take ? ob : best; bg = take ? og : bg; pk = take ? opk : pk; ba1 = take ? oa1 : ba1; ba2 = take ? oa2 : ba2;
                    }
                    if (g == 0) {
                        int rr;
                        if (MODE == 3) { const int i = rg * 16 + row; rr = (i >> 12) * RPB + CTXL + (i & 4095); } else rr = rg * 16 + row;
                        const int bi1 = pk & 3, bi2 = pk >> 2;
                        const float inv = 1.0f / (ba1 + ba2);
                        const float w1 = ba1 * inv, w2 = ba2 * inv;
                        const int lo = bi1 < bi2 ? bi1 : bi2, hi = bi1 < bi2 ? bi2 : bi1;
                        const float wlo = bi1 < bi2 ? w1 : w2, whi = bi1 < bi2 ? w2 : w1;
                        const int pair = (lo == 0) ? (hi - 1) : (lo == 1 ? (hi + 1) : 5);
                        const int bucket = bg * 6 + pair;
                        float4 rec; rec.x = __int_as_float(bucket); rec.y = wlo; rec.z = whi; rec.w = 0.f;
                        p.RT[rr] = rec;
                        atomicAdd(&lcnt[bucket], 1);
                    }
                }
            }
            lds_sync();
        }
    }
    if (FFN) {
        __syncthreads();
        if (t < 48) p.blkcnt[((size_t)L * 256 + bid) * 48 + t] = lcnt[t];
    }
    if (MODE == 3) {
        __syncthreads();
        for (int task = bid; task < NT_GU + NT_WD; task += nb) moe_cvt_task(p, 1, task, smem);
    }
}

struct GemmSmem { bf16_t A[2][128][72]; bf16_t B[2][256][72]; };
static_assert(sizeof(GemmSmem) <= LDS_BYTES, "gemm lds");

template <class Epi>
DEVINL void gemm_tile(const bf16_t* __restrict__ A, int lda, const int* __restrict__ rowlist, int m0, int mvalid,
                      const bf16_t* __restrict__ Bt0, const bf16_t* __restrict__ Bt1, int ldb, int kseg, int K, Epi& epi, char* smem) {
    GemmSmem& S = *(GemmSmem*)smem;
    const int t = tid_opaque(), w = t >> 6, lane = t & 63, fr = lane & 15, fq = lane >> 4, wr = w >> 2, wc = w & 3;
    const int ch = t & 7, rr = t >> 3;
    const bf16_t* ap[2];
#pragma unroll
    for (int i = 0; i < 2; ++i) {
        const int ri = rr + i * 64, gi = ri < mvalid ? ri : 0;
        const int grow = rowlist ? rowlist[m0 + gi] : (m0 + gi);
        ap[i] = A + (size_t)grow * lda + ch * 8;
    }
    u32x4 ra[2], rb[4];
    f32x4 acc[4][4];
#pragma unroll
    for (int m = 0; m < 4; ++m)
#pragma unroll
        for (int n = 0; n < 4; ++n) acc[m][n] = (f32x4){0.f, 0.f, 0.f, 0.f};
    const int nk = K >> 6;
#define GT_GLOAD(kt) do { const int _k0 = (kt) * 64; \
        _Pragma("unroll") for (int i = 0; i < 2; ++i) ra[i] = *(const u32x4*)(ap[i] + _k0); \
        const bf16_t* _bb = (_k0 < kseg) ? (Bt0 + _k0) : (Bt1 + (_k0 - kseg)); \
        _Pragma("unroll") for (int i = 0; i < 4; ++i) rb[i] = *(const u32x4*)(_bb + (size_t)(rr + i * 64) * ldb + ch * 8); } while (0)
#define GT_SSTORE(buf) do { \
        _Pragma("unroll") for (int i = 0; i < 2; ++i) *(u32x4*)&S.A[buf][rr + i * 64][ch * 8] = ra[i]; \
        _Pragma("unroll") for (int i = 0; i < 4; ++i) *(u32x4*)&S.B[buf][rr + i * 64][ch * 8] = rb[i]; } while (0)
    GT_GLOAD(0);
    GT_SSTORE(0);
    __syncthreads();
    for (int kt = 0; kt < nk; ++kt) {
        const int cur = kt & 1;
        if (kt + 1 < nk) GT_GLOAD(kt + 1);
#pragma unroll
        for (int kk = 0; kk < 2; ++kk) {
            bf16x8 a[4], b[4];
#pragma unroll
            for (int m = 0; m < 4; ++m) a[m] = *(const bf16x8*)&S.A[cur][wr * 64 + m * 16 + fr][kk * 32 + fq * 8];
#pragma unroll
            for (int n = 0; n < 4; ++n) b[n] = *(const bf16x8*)&S.B[cur][wc * 64 + n * 16 + fr][kk * 32 + fq * 8];
#pragma unroll
            for (int m = 0; m < 4; ++m)
#pragma unroll
                for (int n = 0; n < 4; ++n) acc[m][n] = __builtin_amdgcn_mfma_f32_16x16x32_bf16(b[n], a[m], acc[m][n], 0, 0, 0);
        }
        if (kt + 1 < nk) GT_SSTORE(cur ^ 1);
        __syncthreads();
    }
#undef GT_GLOAD
#undef GT_SSTORE
    epi(acc, wr * 64, wc * 64, fr, fq);
}

struct EpiP0 {
    bf16_t* P; int m0, n0;
    DEVINL void operator()(const f32x4 (&acc)[4][4], int mb, int nbs, int fr, int fq) const {
        const float sc = (n0 < 256) ? 0.125f : 1.0f;
#pragma unroll
        for (int m = 0; m < 4; ++m) {
            bf16_t* rp = P + (size_t)(m0 + mb + m * 16 + fr) * 2048 + n0 + nbs + fq * 4;
#pragma unroll
            for (int n = 0; n < 4; ++n) *(u32x2*)(rp + n * 16) = pk4(acc[m][n] * sc);
        }
    }
};
struct EpiP1 {
    bf16_t* P; const float* lb; int m0, n0;
    DEVINL void operator()(const f32x4 (&acc)[4][4], int mb, int nbs, int fr, int fq) const {
        const int cb = n0 >> 10;
#pragma unroll
        for (int m = 0; m < 4; ++m) {
            bf16_t* rp = P + (size_t)(m0 + mb + m * 16 + fr) * 5120 + n0 + nbs + fq * 4;
#pragma unroll
            for (int n = 0; n < 4; ++n) {
                const f32x4 a = acc[m][n];
                u32x2 o;
                if (cb == 1 || cb == 2) {
                    const int cc = ((n0 + nbs + n * 16 + fq * 4) & 1023);
                    const f32x4 l4 = *(const f32x4*)(lb + cc);
                    unsigned short hv[4];
#pragma unroll
                    for (int j = 0; j < 4; ++j) hv[j] = f2h((1.0f - l4[j]) * sigmoidf_(-a[j]));
                    o.x = (unsigned)hv[0] | ((unsigned)hv[1] << 16); o.y = (unsigned)hv[2] | ((unsigned)hv[3] << 16);
                } else if (cb == 0 || cb == 4) {
                    f32x4 s;
#pragma unroll
                    for (int j = 0; j < 4; ++j) s[j] = siluf_(a[j]);
                    o = pk4(s);
                } else o = pk4(a);
                *(u32x2*)(rp + n * 16) = o;
            }
        }
    }
};
struct EpiGlu {
    bf16_t* CAT; const bf16_t* s5a; const float* gb; int m0, n0;
    DEVINL void operator()(const f32x4 (&acc)[4][4], int mb, int nbs, int fr, int fq) const {
        f32x4 b4[4];
#pragma unroll
        for (int n = 0; n < 4; ++n) b4[n] = *(const f32x4*)(gb + n0 + nbs + n * 16 + fq * 4);
        u32x2 av[4][4];
#pragma unroll
        for (int m = 0; m < 4; ++m)
#pragma unroll
            for (int n = 0; n < 4; ++n) av[m][n] = *(const u32x2*)(s5a + (size_t)(m0 + mb + m * 16 + fr) * 512 + n0 + nbs + n * 16 + fq * 4);
#pragma unroll
        for (int m = 0; m < 4; ++m) {
            const size_t row = (size_t)(m0 + mb + m * 16 + fr);
#pragma unroll
            for (int n = 0; n < 4; ++n) {
                const int col = n0 + nbs + n * 16 + fq * 4;
                f32x4 o;
                o[0] = bf2f((bf16_t)(av[m][n].x & 0xffff)) * sigmoidf_(acc[m][n][0] + b4[n][0]);
                o[1] = bf2f((bf16_t)(av[m][n].x >> 16)) * sigmoidf_(acc[m][n][1] + b4[n][1]);
                o[2] = bf2f((bf16_t)(av[m][n].y & 0xffff)) * sigmoidf_(acc[m][n][2] + b4[n][2]);
                o[3] = bf2f((bf16_t)(av[m][n].y >> 16)) * sigmoidf_(acc[m][n][3] + b4[n][3]);
                *(u32x2*)(CAT + row * 1024 + 512 + col) = pk4(o);
            }
        }
    }
};
struct EpiOut {
    const Params* p; const float* gate; int m0, n0;
    DEVINL void operator()(const f32x4 (&acc)[4][4], int mb, int nbs, int fr, int fq) const {
        const float* gp = gate + (size_t)8 * 6144;
        f32x4 g4[4];
#pragma unroll
        for (int n = 0; n < 4; ++n) g4[n] = *(const f32x4*)(gp + n0 + nbs + n * 16 + fq * 4);
        f32x4 x4[4][4];
#pragma unroll
        for (int m = 0; m < 4; ++m) {
            const float* rp = resid_row(*p, m0 + mb + m * 16 + fr);
#pragma unroll
            for (int n = 0; n < 4; ++n) x4[m][n] = *(const f32x4*)(rp + n0 + nbs + n * 16 + fq * 4);
        }
#pragma unroll
        for (int m = 0; m < 4; ++m) {
            float* rp = resid_row(*p, m0 + mb + m * 16 + fr);
#pragma unroll
            for (int n = 0; n < 4; ++n) *(f32x4*)(rp + n0 + nbs + n * 16 + fq * 4) = x4[m][n] + g4[n] * acc[m][n];
        }
    }
};

struct EpiY {
    bf16_t* O; int m0, n0;
    DEVINL void operator()(const f32x4 (&acc)[4][4], int mb, int nbs, int fr, int fq) const {
#pragma unroll
        for (int m = 0; m < 4; ++m) {
            bf16_t* rp = O + (size_t)(m0 + mb + m * 16 + fr) * 1024 + n0 + nbs + fq * 4;
#pragma unroll
            for (int n = 0; n < 4; ++n) *(u32x2*)(rp + n * 16) = pk4(acc[m][n]);
        }
    }
};

namespace pg8 {
#define PG8_LAS __attribute__((address_space(3)))
constexpr int BM = 256, BK = 64, HALF = 128, HTB = HALF * BK * 2, STAGE_BYTES = 8 * HTB, NXCD = 8, WGM = 8;
DEVINL int lds_byte(int r, int c) { const int st = (r >> 4) * 2 + (c >> 5), rr = r & 15, cc = c & 31, ob = rr * 64 + cc * 2; return st * 1024 + (ob ^ (((ob >> 9) & 1) << 5)); }
DEVINL void stage_rc(int b, int& R_, int& C_) { const int st = b / 1024, sb = b % 1024, swz = sb ^ (((sb >> 9) & 1) << 5); R_ = (st >> 1) * 16 + swz / 64; C_ = (st & 1) * 32 + (swz % 64) / 2; }
DEVINL int perm32(int rho) { const int n = rho >> 4, i = rho & 15; return 8 * (i >> 2) + 4 * n + (i & 3); }
struct Unit { int pm, pn; const char* A; const char* B0; const char* B1; int mvalid, aux; };

template <class Epi, class Sched>
DEVINL void gemm_phase(PG8_LAS unsigned char* lds, const Sched& S, const Epi& E) {
    const int tid = tid_opaque(), wid = __builtin_amdgcn_readfirstlane(tid >> 6), lane = tid & 63, wr = wid >> 2, wc = wid & 3, fr = lane & 15, fq = lane >> 4;
    const int K = S.K, nt = K / BK, ldb = S.ldb, ksplit = S.ksplit;
    unsigned voffA[2], voffB[2];
#pragma unroll
    for (int i = 0; i < 2; ++i) { int R_, C_; stage_rc(tid * 16 + i * 8192, R_, C_); const int Rb = Epi::PERM ? ((R_ & ~31) + perm32(R_ & 31)) : R_;
        voffA[i] = (unsigned)(R_ * K + C_) * 2u; voffB[i] = (unsigned)(Rb * ldb + C_) * 2u; }
    const size_t kstep = (size_t)(BK * 2);
    const size_t hstepA = (size_t)HALF * K * 2, hstepB = (size_t)HALF * ldb * 2;
    const unsigned ldsw = (unsigned)wid * 1024u;
    const int aoff = lds_byte(wr * 64 + fr, fq * 8), boff = lds_byte(wc * 32 + fr, fq * 8);
    unsigned va[2][2], vn[2][2];
    auto gather_offs = [&](const Unit& u, unsigned (&v)[2][2]) {
#pragma unroll
        for (int h = 0; h < 2; ++h)
#pragma unroll
            for (int i = 0; i < 2; ++i) { int R_, C_; stage_rc(tid * 16 + i * 8192, R_, C_); v[h][i] = (unsigned)(S.a_row(u, h * HALF + R_) * K + C_) * 2u; }
    };
#define PG8_STAGE_A(bufoff, base, h, usenext) do { if constexpr (Sched::GATHER) { \
        unsigned _v[2] = {(usenext) ? vn[h][0] : va[h][0], (usenext) ? vn[h][1] : va[h][1]}; PG8_STAGE(bufoff, base, _v); \
    } else { PG8_STAGE(bufoff, (base) + (h) * hstepA, voffA); } } while (0)
#define PG8_SA(b, h) (((b) * 2 + (h)) * HTB)
#define PG8_SB(b, h) ((4 + (b) * 2 + (h)) * HTB)
#define PG8_STAGE(bufoff, gbase, voff) do { _Pragma("unroll") for (int _i = 0; _i < 2; ++_i) \
        __builtin_amdgcn_global_load_lds((const unsigned*)((const char*)(gbase) + (voff)[_i]), (PG8_LAS unsigned*)(lds + (bufoff) + ldsw + _i * 8192), 16, 0, 0); } while (0)
#define PG8_LDA(dst, b, h) do { _Pragma("unroll") for (int m = 0; m < 4; ++m) _Pragma("unroll") for (int k = 0; k < 2; ++k) dst[m][k] = *(const PG8_LAS bf16x8*)(lds + PG8_SA(b, h) + aoff + m * 2048 + k * 1024); } while (0)
#define PG8_LDB(dst, b, h) do { _Pragma("unroll") for (int n = 0; n < 2; ++n) _Pragma("unroll") for (int k = 0; k < 2; ++k) dst[n][k] = *(const PG8_LAS bf16x8*)(lds + PG8_SB(b, h) + boff + n * 2048 + k * 1024); } while (0)
#define PG8_MMA(ai, bj, At, Bt) do { __builtin_amdgcn_s_setprio(1); _Pragma("unroll") for (int m = 0; m < 4; ++m) _Pragma("unroll") for (int n = 0; n < 2; ++n) _Pragma("unroll") for (int k = 0; k < 2; ++k) \
        acc[ai][bj][m][n] = __builtin_amdgcn_mfma_f32_16x16x32_bf16(Bt[n][k], At[m][k], acc[ai][bj][m][n], 0, 0, 0); __builtin_amdgcn_s_setprio(0); } while (0)
#define PG8_WAIT_V(n) asm volatile("s_waitcnt vmcnt(" #n ")" ::: "memory")
#define PG8_WAIT_L(n) asm volatile("s_waitcnt lgkmcnt(" #n ")" ::: "memory")
#define PG8_BAR __builtin_amdgcn_s_barrier()
#define PG8_SCHED __builtin_amdgcn_sched_barrier(0)
#define PG8_BPTR(u, kt) (((kt) < ksplit ? (u).B0 : (u).B1) + (size_t)(kt) * kstep)
    Unit cur, nxt; int ui = 0;
    if (!S.next(0, cur)) return;
    f32x4 acc[2][2][4][2];
#pragma unroll
    for (int a = 0; a < 2; ++a)
#pragma unroll
        for (int b = 0; b < 2; ++b)
#pragma unroll
            for (int m = 0; m < 4; ++m)
#pragma unroll
                for (int n = 0; n < 2; ++n) acc[a][b][m][n] = (f32x4){0.f, 0.f, 0.f, 0.f};
    bf16x8 At[4][2], B0[2][2], B1[2][2];
    const char* cA = cur.A;
    if constexpr (Sched::GATHER) gather_offs(cur, va);
    { const char* cB0 = PG8_BPTR(cur, 0); const char* cB1 = PG8_BPTR(cur, 1);
      PG8_STAGE(PG8_SB(0, 0), cB0, voffB); PG8_STAGE_A(PG8_SA(0, 0), cA, 0, false); PG8_STAGE(PG8_SB(0, 1), cB0 + hstepB, voffB); PG8_STAGE_A(PG8_SA(0, 1), cA, 1, false);
      if (wr == 1) PG8_BAR;
      PG8_WAIT_V(4); PG8_BAR;
      PG8_STAGE(PG8_SB(1, 0), cB1, voffB); PG8_STAGE_A(PG8_SA(1, 0), cA + kstep, 0, false); PG8_STAGE(PG8_SB(1, 1), cB1 + hstepB, voffB);
      PG8_WAIT_V(6); PG8_BAR; }
    for (;;) {
        const bool has_next = S.next(ui + 1, nxt);
        if (!has_next) nxt = cur;
        const char* nA = nxt.A;
        if constexpr (Sched::GATHER) {
            if (has_next) gather_offs(nxt, vn);
            else {
#pragma unroll
                for (int h = 0; h < 2; ++h) { vn[h][0] = va[h][0]; vn[h][1] = va[h][1]; }
            }
        }
        for (int t = 0; t < nt; t += 2) {
            const bool last = (t == nt - 2);
            const char* a1 = cA + (size_t)(t + 1) * kstep;
            const char* a2 = last ? nA : cA + (size_t)(t + 2) * kstep;
            const char* b2 = last ? PG8_BPTR(nxt, 0) : PG8_BPTR(cur, t + 2);
            const char* a3 = a2 + kstep;
            const char* b3 = last ? PG8_BPTR(nxt, 1) : PG8_BPTR(cur, t + 3);
            PG8_LDB(B0, 0, 0); PG8_SCHED; PG8_LDA(At, 0, 0); PG8_STAGE_A(PG8_SA(1, 1), a1, 1, false);
            PG8_WAIT_L(8); PG8_BAR; PG8_WAIT_L(0); PG8_MMA(0, 0, At, B0); PG8_BAR; PG8_SCHED;
            PG8_LDB(B1, 0, 1); PG8_STAGE(PG8_SB(0, 0), b2, voffB);
            PG8_BAR; PG8_WAIT_L(0); PG8_MMA(0, 1, At, B1); PG8_BAR;
            PG8_LDA(At, 0, 1); PG8_STAGE_A(PG8_SA(0, 0), a2, 0, last);
            PG8_BAR; PG8_WAIT_L(0); PG8_MMA(1, 0, At, B0); PG8_BAR; PG8_SCHED;
            PG8_STAGE(PG8_SB(0, 1), b2 + hstepB, voffB);
            PG8_WAIT_V(6); PG8_BAR; PG8_MMA(1, 1, At, B1); PG8_BAR;
            PG8_LDB(B0, 1, 0); PG8_SCHED; PG8_LDA(At, 1, 0); PG8_STAGE_A(PG8_SA(0, 1), a2, 1, last);
            PG8_WAIT_L(8); PG8_BAR; PG8_WAIT_L(0); PG8_MMA(0, 0, At, B0); PG8_BAR; PG8_SCHED;
            PG8_LDB(B1, 1, 1); PG8_STAGE(PG8_SB(1, 0), b3, voffB);
            PG8_BAR; PG8_WAIT_L(0); PG8_MMA(0, 1, At, B1); PG8_BAR;
            PG8_LDA(At, 1, 1); PG8_STAGE_A(PG8_SA(1, 0), a3, 0, last);
            PG8_BAR; PG8_WAIT_L(0); PG8_MMA(1, 0, At, B0); PG8_BAR; PG8_SCHED;
            PG8_STAGE(PG8_SB(1, 1), b3 + hstepB, voffB);
            PG8_WAIT_V(6); PG8_BAR; PG8_MMA(1, 1, At, B1); PG8_BAR;
        }
        E(acc, cur, wr, wc, fr, fq);
        if (!has_next) break;
#pragma unroll
        for (int a = 0; a < 2; ++a)
#pragma unroll
            for (int b = 0; b < 2; ++b)
#pragma unroll
                for (int m = 0; m < 4; ++m)
#pragma unroll
                    for (int n = 0; n < 2; ++n) acc[a][b][m][n] = (f32x4){0.f, 0.f, 0.f, 0.f};
        cur = nxt; cA = nA; ++ui;
        if constexpr (Sched::GATHER) {
#pragma unroll
            for (int h = 0; h < 2; ++h) { va[h][0] = vn[h][0]; va[h][1] = vn[h][1]; }
        }
    }
    PG8_WAIT_V(0);
    if (wr == 0) PG8_BAR;
    PG8_BAR;
#undef PG8_SA
#undef PG8_SB
#undef PG8_STAGE
#undef PG8_STAGE_A
#undef PG8_LDA
#undef PG8_LDB
#undef PG8_MMA
#undef PG8_WAIT_V
#undef PG8_WAIT_L
#undef PG8_BAR
#undef PG8_SCHED
#undef PG8_BPTR
}

struct DenseSched {
    static constexpr bool GATHER = false;
    DEVINL int a_row(const Unit&, int) const { return 0; }
    const char* A; const char* Bt; int K, ldb, ksplit, nM, nN, G, c, lat;
    DEVINL void init(const bf16_t* A_, const bf16_t* Bt_, int N, int K_, int G_, int c_, int lat_) {
        A = (const char*)A_; Bt = (const char*)Bt_; K = K_; ldb = K_; ksplit = K_ / BK; nM = lat_ ? 128 : 136; nN = N / BM; G = G_; c = c_; lat = lat_; }
    DEVINL bool next(int i, Unit& u) const {
        const int nwg = nM * nN;
        const long Lq = (long)i * G + c; if (Lq >= nwg) return false;
        int wgid = (int)Lq; { const int q = nwg / NXCD, r = nwg % NXCD, xcd = wgid % NXCD, off = wgid / NXCD; wgid = (xcd < r ? xcd * (q + 1) : r * (q + 1) + (xcd - r) * q) + off; }
        const int nig = WGM * nN, gid = wgid / nig, fm = gid * WGM, gsz = (nM - fm) < WGM ? (nM - fm) : WGM;
        int pm = fm + ((wgid % nig) % gsz); const int pn = (wgid % nig) / gsz;
        if (lat) pm = (pm >> 4) * 17 + 1 + (pm & 15);
        u.pm = pm; u.pn = pn; u.A = A + (size_t)pm * BM * K * 2; u.B0 = Bt + (size_t)pn * BM * K * 2; u.B1 = u.B0; u.mvalid = 256; u.aux = 0;
        return true;
    }
};
}

struct GEpiP0 {
    static constexpr bool PERM = true;
    bf16_t* P;
    DEVINL void operator()(const f32x4 (&acc)[2][2][4][2], const pg8::Unit& u, int wr, int wc, int fr, int fq) const {
        const float sc = (u.pn == 0) ? 0.125f : 1.0f;
        const int row0 = u.pm * 256 + wr * 64 + fr, col0 = u.pn * 256 + wc * 32 + 8 * fq;
#pragma unroll
        for (int ai = 0; ai < 2; ++ai)
#pragma unroll
            for (int m = 0; m < 4; ++m) {
                bf16_t* rp = P + (size_t)(row0 + ai * 128 + m * 16) * 2048 + col0;
#pragma unroll
                for (int bj = 0; bj < 2; ++bj) {
                    const u32x2 a = pk4(acc[ai][bj][m][0] * sc), b = pk4(acc[ai][bj][m][1] * sc);
                    u32x4 w; w.x = a.x; w.y = a.y; w.z = b.x; w.w = b.y;
                    *(u32x4*)(rp + bj * 128) = w;
                }
            }
    }
};
struct GEpiP1 {
    static constexpr bool PERM = true;
    bf16_t* P; const float* lb;
    DEVINL void operator()(const f32x4 (&acc)[2][2][4][2], const pg8::Unit& u, int wr, int wc, int fr, int fq) const {
        const int cb = u.pn >> 2;
        const int row0 = u.pm * 256 + wr * 64 + fr, col0 = u.pn * 256 + wc * 32 + 8 * fq;
        f32x4 oml[2][2];
        if (cb == 1 || cb == 2) {
#pragma unroll
            for (int bj = 0; bj < 2; ++bj)
#pragma unroll
                for (int n = 0; n < 2; ++n) { const f32x4 l4 = *(const f32x4*)(lb + ((col0 + bj * 128) & 1023) + 4 * n); oml[bj][n] = 1.0f - l4; }
        }
#pragma unroll
        for (int ai = 0; ai < 2; ++ai)
#pragma unroll
            for (int m = 0; m < 4; ++m) {
                bf16_t* rp = P + (size_t)(row0 + ai * 128 + m * 16) * 5120 + col0;
#pragma unroll
                for (int bj = 0; bj < 2; ++bj) {
                    u32x4 w;
                    if (cb == 1 || cb == 2) {
                        unsigned short hv[8];
#pragma unroll
                        for (int n = 0; n < 2; ++n)
#pragma unroll
                            for (int j = 0; j < 4; ++j) hv[n * 4 + j] = f2h(oml[bj][n][j] * sigmoidf_(-acc[ai][bj][m][n][j]));
                        w.x = (unsigned)hv[0] | ((unsigned)hv[1] << 16); w.y = (unsigned)hv[2] | ((unsigned)hv[3] << 16);
                        w.z = (unsigned)hv[4] | ((unsigned)hv[5] << 16); w.w = (unsigned)hv[6] | ((unsigned)hv[7] << 16);
                    } else {
                        f32x4 v0 = acc[ai][bj][m][0], v1 = acc[ai][bj][m][1];
                        if (cb == 0 || cb == 4) {
#pragma unroll
                            for (int j = 0; j < 4; ++j) { v0[j] = siluf_(v0[j]); v1[j] = siluf_(v1[j]); }
                        }
                        const u32x2 a = pk4(v0), b = pk4(v1);
                        w.x = a.x; w.y = a.y; w.z = b.x; w.w = b.y;
                    }
                    *(u32x4*)(rp + bj * 128) = w;
                }
            }
    }
};
struct GEpiGlu {
    static constexpr bool PERM = true;
    bf16_t* CAT; const bf16_t* s5a; const float* gb;
    DEVINL void operator()(const f32x4 (&acc)[2][2][4][2], const pg8::Unit& u, int wr, int wc, int fr, int fq) const {
        const int row0 = u.pm * 256 + wr * 64 + fr, col0 = u.pn * 256 + wc * 32 + 8 * fq;
        f32x4 bv[2][2];
#pragma unroll
        for (int bj = 0; bj < 2; ++bj)
#pragma unroll
            for (int n = 0; n < 2; ++n) bv[bj][n] = *(const f32x4*)(gb + col0 + bj * 128 + 4 * n);
#pragma unroll
        for (int ai = 0; ai < 2; ++ai) {
            u32x4 av[4][2];
#pragma unroll
            for (int m = 0; m < 4; ++m)
#pragma unroll
                for (int bj = 0; bj < 2; ++bj) av[m][bj] = *(const u32x4*)(s5a + (size_t)(row0 + ai * 128 + m * 16) * 512 + col0 + bj * 128);
#pragma unroll
            for (int m = 0; m < 4; ++m) {
                const size_t row = (size_t)(row0 + ai * 128 + m * 16);
#pragma unroll
                for (int bj = 0; bj < 2; ++bj) {
                    const u32x4 a = av[m][bj];
                    f32x4 o0, o1;
                    o0[0] = bf2f((bf16_t)(a.x & 0xffff)) * sigmoidf_(acc[ai][bj][m][0][0] + bv[bj][0][0]);
                    o0[1] = bf2f((bf16_t)(a.x >> 16)) * sigmoidf_(acc[ai][bj][m][0][1] + bv[bj][0][1]);
                    o0[2] = bf2f((bf16_t)(a.y & 0xffff)) * sigmoidf_(acc[ai][bj][m][0][2] + bv[bj][0][2]);
                    o0[3] = bf2f((bf16_t)(a.y >> 16)) * sigmoidf_(acc[ai][bj][m][0][3] + bv[bj][0][3]);
                    o1[0] = bf2f((bf16_t)(a.z & 0xffff)) * sigmoidf_(acc[ai][bj][m][1][0] + bv[bj][1][0]);
                    o1[1] = bf2f((bf16_t)(a.z >> 16)) * sigmoidf_(acc[ai][bj][m][1][1] + bv[bj][1][1]);
                    o1[2] = bf2f((bf16_t)(a.w & 0xffff)) * sigmoidf_(acc[ai][bj][m][1][2] + bv[bj][1][2]);
                    o1[3] = bf2f((bf16_t)(a.w >> 16)) * sigmoidf_(acc[ai][bj][m][1][3] + bv[bj][1][3]);
                    const u32x2 x = pk4(o0), y = pk4(o1);
                    u32x4 w; w.x = x.x; w.y = x.y; w.z = y.x; w.w = y.y;
                    *(u32x4*)(CAT + row * 1024 + 512 + col0 + bj * 128) = w;
                }
            }
        }
    }
};
struct GEpiOut {
    static constexpr bool PERM = false;
    float* out; const float* gate;
    DEVINL void operator()(const f32x4 (&acc)[2][2][4][2], const pg8::Unit& u, int wr, int wc, int fr, int fq) const {
        const int b = u.pm / 17, lt = u.pm - b * 17 - 1;
        const float* gp = gate + (size_t)b * 6144;
        const int col0 = u.pn * 256 + wc * 32 + 4 * fq;
        float* base = out + ((size_t)b * SEQ + lt * 256 + wr * 64 + fr) * D;
        f32x4 g4[2][2];
#pragma unroll
        for (int bj = 0; bj < 2; ++bj)
#pragma unroll
            for (int n = 0; n < 2; ++n) g4[bj][n] = *(const f32x4*)(gp + col0 + bj * 128 + n * 16);
#pragma unroll
        for (int ai = 0; ai < 2; ++ai)
#pragma unroll
            for (int mp = 0; mp < 4; mp += 2) {
                f32x4 x4[2][2][2];
#pragma unroll
                for (int q = 0; q < 2; ++q)
#pragma unroll
                    for (int bj = 0; bj < 2; ++bj)
#pragma unroll
                        for (int n = 0; n < 2; ++n) x4[q][bj][n] = *(const f32x4*)(base + (size_t)(ai * 128 + (mp + q) * 16) * D + col0 + bj * 128 + n * 16);
                asm volatile("" ::: "memory");
#pragma unroll
                for (int q = 0; q < 2; ++q)
#pragma unroll
                    for (int bj = 0; bj < 2; ++bj)
#pragma unroll
                        for (int n = 0; n < 2; ++n) *(f32x4*)(base + (size_t)(ai * 128 + (mp + q) * 16) * D + col0 + bj * 128 + n * 16) = x4[q][bj][n] + g4[bj][n] * acc[ai][bj][mp + q][n];
                asm volatile("" ::: "memory");
            }
    }
};
struct GEpiY {
    static constexpr bool PERM = true;
    bf16_t* O;
    DEVINL void operator()(const f32x4 (&acc)[2][2][4][2], const pg8::Unit& u, int wr, int wc, int fr, int fq) const {
        const int row0 = u.pm * 256 + wr * 64 + fr, col0 = u.pn * 256 + wc * 32 + 8 * fq;
#pragma unroll
        for (int ai = 0; ai < 2; ++ai)
#pragma unroll
            for (int m = 0; m < 4; ++m) {
                bf16_t* rp = O + (size_t)(row0 + ai * 128 + m * 16) * 1024 + col0;
#pragma unroll
                for (int bj = 0; bj < 2; ++bj) {
                    const u32x2 a = pk4(acc[ai][bj][m][0]), b = pk4(acc[ai][bj][m][1]);
                    u32x4 w; w.x = a.x; w.y = a.y; w.z = b.x; w.w = b.y;
                    *(u32x4*)(rp + bj * 128) = w;
                }
            }
    }
};
struct GEpiMoe1 {
    static constexpr bool PERM = true;
    bf16_t* act; const float* wl; const float* wh;
    DEVINL void operator()(const f32x4 (&acc)[2][2][4][2], const pg8::Unit& u, int wr, int wc, int fr, int fq) const {
        const int half = u.pn >> 1;
        const float* wsel = half ? wh : wl;
        const int cbase = half * 256 + (u.pn & 1) * 128 + 16 * wc + 4 * fq;
        float wv[2][4];
#pragma unroll
        for (int ai = 0; ai < 2; ++ai)
#pragma unroll
            for (int m = 0; m < 4; ++m) { const int lr = ai * 128 + wr * 64 + m * 16 + fr; wv[ai][m] = (lr < u.mvalid) ? wsel[u.pm * 256 + lr] : 0.f; }
#pragma unroll
        for (int ai = 0; ai < 2; ++ai)
#pragma unroll
            for (int m = 0; m < 4; ++m) {
                const int slot = u.pm * 256 + ai * 128 + wr * 64 + m * 16 + fr;
#pragma unroll
                for (int bj = 0; bj < 2; ++bj) {
                    f32x4 o;
#pragma unroll
                    for (int j = 0; j < 4; ++j) o[j] = wv[ai][m] * siluf_(acc[ai][bj][m][0][j]) * acc[ai][bj][m][1][j];
                    *(u32x2*)(act + (size_t)slot * 512 + cbase + 64 * bj) = pk4(o);
                }
            }
    }
};
struct GEpiMoe2 {
    static constexpr bool PERM = false;
    float* out; float* cx; const float* gate; const int* list;
    DEVINL void operator()(const f32x4 (&acc)[2][2][4][2], const pg8::Unit& u, int wr, int wc, int fr, int fq) const {
        const int col0 = u.pn * 256 + wc * 32 + 4 * fq;
        int rows[2][4];
#pragma unroll
        for (int ai = 0; ai < 2; ++ai)
#pragma unroll
            for (int m = 0; m < 4; ++m) { const int lr = ai * 128 + wr * 64 + m * 16 + fr; rows[ai][m] = (lr < u.mvalid) ? list[u.pm * 256 + lr] : -1; }
#pragma unroll
        for (int ai = 0; ai < 2; ++ai)
#pragma unroll
            for (int mp = 0; mp < 4; mp += 2) {
                f32x4 x4[2][2][2], g4[2][2][2];
                float* rp[2];
#pragma unroll
                for (int q = 0; q < 2; ++q) {
                    const int r = rows[ai][mp + q] < 0 ? 0 : rows[ai][mp + q];
                    const int rb = r / RPB, rj = r - rb * RPB;
                    rp[q] = (rj < CTXL) ? (cx + (size_t)(rb * CTXL + rj) * D) : (out + (size_t)(rb * SEQ + (rj - CTXL)) * D);
                    const float* gp = gate + (size_t)((rj < CTXL) ? 8 : rb) * 6144;
#pragma unroll
                    for (int bj = 0; bj < 2; ++bj)
#pragma unroll
                        for (int n = 0; n < 2; ++n) { const int col = col0 + bj * 128 + n * 16; x4[q][bj][n] = *(const f32x4*)(rp[q] + col); g4[q][bj][n] = *(const f32x4*)(gp + col); }
                }
                asm volatile("" ::: "memory");
#pragma unroll
                for (int q = 0; q < 2; ++q)
                    if (rows[ai][mp + q] >= 0) {
#pragma unroll
                        for (int bj = 0; bj < 2; ++bj)
#pragma unroll
                            for (int n = 0; n < 2; ++n) *(f32x4*)(rp[q] + col0 + bj * 128 + n * 16) = x4[q][bj][n] + g4[q][bj][n] * acc[ai][bj][mp + q][n];
                    }
            }
    }
};

template <int WHICH>
DEVINL void phase_gemm(const Params& p, char* smem, int bid, int nb) {
    constexpr int N = (WHICH == 0) ? 2048 : (WHICH == 1) ? 512 : (WHICH == 3) ? 5120 : 1024;
    constexpr int K = (WHICH == 1) ? 512 : 1024;
    PG8_LAS unsigned char* lds = (PG8_LAS unsigned char*)smem;
    pg8::DenseSched S;
    bid = sgpr(bid); nb = sgpr(nb);
    if (WHICH == 0) { S.init(sgpr_ptr(p.H), sgpr_ptr(p.wt_in0), N, K, nb, bid, 1); GEpiP0 e{sgpr_ptr(p.P)}; pg8::gemm_phase(lds, S, e); }
    if (WHICH == 1) { S.init(sgpr_ptr(p.s5a), sgpr_ptr(p.glu_t), N, K, nb, bid, 1); GEpiGlu e{sgpr_ptr(p.H), sgpr_ptr(p.s5a), sgpr_ptr(p.glu_b)}; pg8::gemm_phase(lds, S, e); }
    if (WHICH == 2) { S.init(sgpr_ptr(p.H), sgpr_ptr(p.wt_out0), N, K, nb, bid, 1); GEpiY e{sgpr_ptr(p.Y)}; pg8::gemm_phase(lds, S, e); }
    if (WHICH == 3) {
        float* lbl = (float*)(smem + pg8::STAGE_BYTES + 1024);
        for (int i = tid_opaque(); i < 1024; i += NTHR) lbl[i] = p.lb[i];
        __syncthreads();
        S.init(sgpr_ptr(p.H), sgpr_ptr(p.wt_in1), N, K, nb, bid, 1); GEpiP1 e{sgpr_ptr(p.P), lbl}; pg8::gemm_phase(lds, S, e);
    }
    if (WHICH == 4) { S.init(sgpr_ptr(p.H), sgpr_ptr(p.wt_out1), N, K, nb, bid, 1); GEpiY e{sgpr_ptr(p.Y)}; pg8::gemm_phase(lds, S, e); }
    if (WHICH != 4) {
        constexpr int NT0 = (WHICH == 3) ? 4 : 0, NT1 = (WHICH == 3) ? 16 : N / 256, NTC = NT1 - NT0;
        for (int u = bid; u < 16 * NTC; u += nb) {
            const int mt = u / NTC, nt = NT0 + (u - mt * NTC);
            const int m0 = (mt >> 1) * RPB + (mt & 1) * 128, n0 = nt * 256;
            if (WHICH == 0) { EpiP0 e{p.P, m0, n0}; gemm_tile(p.H, 1024, nullptr, m0, 128, p.wt_in0 + (size_t)n0 * 1024, nullptr, 1024, K, K, e, smem); }
            if (WHICH == 1) { EpiGlu e{p.H, p.s5a, p.glu_b, m0, n0}; gemm_tile(p.s5a, 512, nullptr, m0, 128, p.glu_t + (size_t)n0 * 512, nullptr, 512, K, K, e, smem); }
            if (WHICH == 2) { EpiOut e{&p, p.mod + 2048, m0, n0}; gemm_tile(p.H, 1024, nullptr, m0, 128, p.wt_out0 + (size_t)n0 * 1024, nullptr, 1024, K, K, e, smem); }
            if (WHICH == 3) { EpiP1 e{p.P, p.lb, m0, n0}; gemm_tile(p.H, 1024, nullptr, m0, 128, p.wt_in1 + (size_t)n0 * 1024, nullptr, 1024, K, K, e, smem); }
        }
    }
}

constexpr int MOE_TAB = pg8::STAGE_BYTES;
static_assert(MOE_TAB + 1024 <= LDS_BYTES, "moe tables");
DEVINL void moe_setup(const Params& p, int L, int* tab) {
    const int t = tid_opaque();
    if (t < 48) tab[128 + t] = p.cnt[L * 64 + t];
    __syncthreads();
    if (t == 0) {
        int o = 0, ts = 0;
        for (int b = 0; b < 48; ++b) { const int c = tab[128 + b]; tab[b] = o; tab[64 + b] = ts; const int nt = (c + 255) >> 8; o += nt * 256; ts += nt; }
        tab[48] = o; tab[64 + 48] = ts;
    }
    __syncthreads();
}
template <int L>
DEVINL void phase_list(const Params& p, char* smem, int bid, int nb) {
    int* tab = (int*)(smem + MOE_TAB);
    int* red = (int*)smem;
    int* rsrc = red + 1024; int* rdst = rsrc + 256;
    const int t = tid_opaque(), w = t >> 6, lane = t & 63;
    {
        const int bkt = t & 63, part = t >> 6;
        int tot = 0, pre = 0;
        if (bkt < 48) {
#pragma unroll 8
            for (int q = 0; q < 32; ++q) { const int blk = part * 32 + q; const int c = (blk < nb) ? p.blkcnt[((size_t)L * 256 + blk) * 48 + bkt] : 0; tot += c; pre += (blk < bid) ? c : 0; }
        }
        red[part * 64 + bkt] = tot; red[512 + part * 64 + bkt] = pre;
    }
    __syncthreads();
    if (t < 48) {
        int tot = 0, pre = 0;
#pragma unroll
        for (int q = 0; q < 8; ++q) { tot += red[q * 64 + t]; pre += red[512 + q * 64 + t]; }
        tab[128 + t] = tot; tab[192 + t] = pre;
        if (bid == 0) p.cnt[L * 64 + t] = tot;
    }
    __syncthreads();
    if (t == 0) {
        int o = 0, ts = 0;
        for (int b = 0; b < 48; ++b) { const int c = tab[128 + b]; tab[b] = o; tab[64 + b] = ts; const int nt = (c + 255) >> 8; o += nt * 256; ts += nt; }
        tab[48] = o; tab[64 + 48] = ts;
    }
    __syncthreads();
    if (t < 48) tab[192 + t] += tab[t];
    __syncthreads();
    const int ngroups = L ? (NLAT / 16) : (R / 16);
    const int nmine = (bid < ngroups) ? (((ngroups - 1 - bid) / nb + 1) * 16) : 0;
    if (t < nmine) {
        const int idx = (bid + (t >> 4) * nb) * 16 + (t & 15);
        const int r = L ? ((idx >> 12) * RPB + CTXL + (idx & 4095)) : idx;
        const float4 rec = p.RT[r];
        const int bucket = __float_as_int(rec.x);
        const int slot = atomicAdd(&tab[192 + bucket], 1);
        p.list[slot] = r; p.wl[slot] = rec.y; p.wh[slot] = rec.z; p.sor[r] = slot;
    }
    __syncthreads();
}
template <int STAGE>
struct MoeSched {
    static constexpr bool GATHER = (STAGE == 1);
    static constexpr int stage = STAGE;
    const bf16_t* hs; const bf16_t* wgu_t; const bf16_t* act; const bf16_t* wd_t; const int* tab; const int* list; int K, ldb, ksplit, G, c, ntiles;
    DEVINL int a_row(const pg8::Unit& u, int r) const { return list[(u.pm << 8) + (r < u.mvalid ? r : 0)]; }
    DEVINL bool next(int i, pg8::Unit& u) const {
        const int x = c & 7, rk = c >> 3, nper = G >> 3;
        const int t0 = (ntiles * x) >> 3, t1 = (ntiles * (x + 1)) >> 3;
        const int li = i * nper + rk;
        if (li >= (t1 - t0) * 4) return false;
        const int tile = t0 + (li >> 2), pn = li & 3;
        int bucket = 0;
        for (int b = 0; b < 48; ++b) if (tile >= tab[64 + b] && tile < tab[64 + b + 1]) bucket = b;
        bucket = sgpr(bucket);
        const int ti = tile - sgpr(tab[64 + bucket]);
        const int m0 = sgpr(tab[bucket]) + ti * 256;
        const int rem = sgpr(tab[128 + bucket]) - ti * 256;
        const int grp = bucket / 6, pair = bucket - grp * 6;
        const int lo = (pair < 3) ? 0 : (pair < 5 ? 1 : 2);
        const int hi = (pair < 3) ? (pair + 1) : (pair < 5 ? (pair - 1) : 3);
        const int ea = grp * 4 + lo, eb = grp * 4 + hi;
        u.pm = m0 >> 8; u.pn = pn; u.mvalid = rem < 256 ? rem : 256; u.aux = 0;
        if (stage == 1) {
            const int e = (pn >> 1) ? eb : ea;
            u.A = (const char*)hs;
            u.B0 = (const char*)(wgu_t + ((size_t)e * 512 + (pn & 1) * 256) * 1024); u.B1 = u.B0;
        } else {
            u.A = (const char*)(act + (size_t)m0 * 512);
            u.B0 = (const char*)(wd_t + ((size_t)ea * 1024 + pn * 256) * 256);
            u.B1 = (const char*)(wd_t + ((size_t)eb * 1024 + pn * 256) * 256) - (size_t)4 * 128;
        }
        return true;
    }
};
template <int L, int STAGE>
DEVINL void phase_moe(const Params& p, char* smem, int bid, int nb) {
    int* tab = (int*)(smem + MOE_TAB);
    moe_setup(p, L, tab);
    PG8_LAS unsigned char* lds = (PG8_LAS unsigned char*)smem;
    MoeSched<STAGE> S; S.hs = sgpr_ptr(p.H); S.wgu_t = sgpr_ptr(p.wgu_t); S.act = sgpr_ptr(p.act); S.wd_t = sgpr_ptr(p.wd_t); S.list = sgpr_ptr(p.list);
    S.tab = tab; S.G = sgpr(nb); S.c = sgpr(bid); S.ntiles = sgpr(tab[64 + 48]);
    if (STAGE == 1) { S.K = 1024; S.ldb = 1024; S.ksplit = 16; GEpiMoe1 e{sgpr_ptr(p.act), sgpr_ptr(p.wl), sgpr_ptr(p.wh)}; pg8::gemm_phase(lds, S, e); }
    else { S.K = 512; S.ldb = 256; S.ksplit = 4; GEpiY e{sgpr_ptr(p.y2)}; pg8::gemm_phase(lds, S, e); }
    __syncthreads();
}

template <int DK> struct RecL {
    static constexpr int QS = DK + 8;
    static constexpr int oQs = 0;
    static constexpr int oKs = oQs + 64 * QS * 2;
    static constexpr int oKt = oKs + 64 * QS * 2;
    static constexpr int oVt = oKt + DK * 72 * 2;
    static constexpr int oAt = oVt + 128 * 72 * 2;
    static constexpr int oSt = oAt + 64 * 72 * 2;
    static constexpr int oPart = oSt + 128 * 136 * 2;
    static constexpr int oEmid = oPart + 8 * 128 * 4;
    static constexpr int oEend = oEmid + 128 * 4;
    static constexpr int oAF = oEend + 128 * 4;
    static constexpr int oRed = oAF + 64 * 32 * 4;
    static constexpr int total = oRed + 64 * 2 * 4 + 128 * 4;
};
static_assert(RecL<128>::total <= LDS_BYTES, "rec lds");

template <bool GLA> struct RecCols {
    static constexpr int LDP = GLA ? 2048 : 5120;
    static constexpr int QOFF = 0;
    static constexpr int KOFF = 256;
    static constexpr int KF = 1024, KB = 2048;
    static constexpr int VOFF = GLA ? 512 : 3072;
    static constexpr int GOFF = GLA ? 1024 : 4096;
};
template <int DK, bool GLA> struct RecGeo {
    static constexpr int GC = GLA ? 4 : 8;
    static constexpr int NS = GLA ? 16 : 8;
    static constexpr int H = GLA ? 4 : 8;
    static constexpr int KT = DK / 16;
};

struct RawRegs { u32x4 q[2], k[2], v[2], af; };

template <int DK, bool GLA, int DIR, bool PASS3>
DEVINL void rec_load_raw(const Params& p, const bf16_t* __restrict__ P, int row0, int h, RawRegs& r) {
    using C = RecCols<GLA>; constexpr int LDP = C::LDP;
    const int t = tid_opaque();
    if (GLA) {
        const int row = t >> 3, c8 = (t & 7) * 8;
        const bf16_t* rp = P + (size_t)(row0 + row) * LDP + h * 64 + c8;
        if (PASS3) r.q[0] = *(const u32x4*)(rp + C::QOFF);
        r.k[0] = *(const u32x4*)(rp + C::KOFF);
        r.af = *(const u32x4*)(p.AF + (size_t)(row0 + row) * 32 + (t & 7) * 4);
    } else {
#pragma unroll
        for (int i = 0; i < 2; ++i) {
            const int row = (t >> 4) + i * 32, c8 = (t & 15) * 8;
            const bf16_t* rp = P + (size_t)(row0 + row) * LDP + h * 128 + c8;
            if (PASS3) r.q[i] = *(const u32x4*)(rp + C::QOFF);
            r.k[i] = *(const u32x4*)(rp + (DIR ? C::KB : C::KF));
        }
    }
#pragma unroll
    for (int i = 0; i < 2; ++i) {
        const int row = (t >> 4) + i * 32, c8 = (t & 15) * 8;
        r.v[i] = *(const u32x4*)(P + (size_t)(row0 + row) * LDP + C::VOFF + h * 128 + c8);
    }
}

template <int DK, bool GLA, int DIR, bool PASS3>
DEVINL void rec_prep(const Params& p, char* smem, const bf16_t* __restrict__ P, RawRegs& raw, bool has_next, int next_row0, int h,
                     const float (&a2c)[2][16], const float (&abv)[2], float (&bsum)[2]) {
    using L = RecL<DK>;
    constexpr int NCP = DK / 2, NSEG = NTHR / NCP, RS = 64 / NSEG, QS = L::QS;
    constexpr bool ref_end = !PASS3;
    bf16_t* Qs = (bf16_t*)(smem + L::oQs); bf16_t* Ks = (bf16_t*)(smem + L::oKs); bf16_t* Kt = (bf16_t*)(smem + L::oKt); bf16_t* Vt = (bf16_t*)(smem + L::oVt);
    bf16_t* Vraw = (bf16_t*)(smem + L::oSt);
    float* part = (float*)(smem + L::oPart); float* emid = (float*)(smem + L::oEmid); float* eend = (float*)(smem + L::oEend); float* AFs = (float*)(smem + L::oAF);
    const int t = tid_opaque();
    if (GLA) {
        const int row = t >> 3, c8 = (t & 7) * 8;
        if (PASS3) *(u32x4*)&Qs[row * QS + c8] = raw.q[0];
        *(u32x4*)&Ks[row * QS + c8] = raw.k[0];
        *(u32x4*)&AFs[row * 32 + (t & 7) * 4] = raw.af;
    } else {
#pragma unroll
        for (int i = 0; i < 2; ++i) {
            const int row = (t >> 4) + i * 32, c8 = (t & 15) * 8;
            if (PASS3) *(u32x4*)&Qs[row * QS + c8] = raw.q[i];
            *(u32x4*)&Ks[row * QS + c8] = raw.k[i];
        }
    }
#pragma unroll
    for (int i = 0; i < 2; ++i) { const int row = (t >> 4) + i * 32, c8 = (t & 15) * 8; *(u32x4*)&Vraw[row * 136 + c8] = raw.v[i]; }
    lds_sync();
    if (has_next) rec_load_raw<DK, GLA, DIR, PASS3>(p, P, next_row0, h, raw);
    const int cp = t % NCP, seg = t / NCP, c0 = cp * 2, l0 = seg * RS;
    float dv[RS][2];
    float kv[RS][2];
#pragma unroll
    for (int i = 0; i < RS; ++i) {
        const unsigned kr = *(const unsigned*)&Ks[(l0 + i) * QS + c0];
        if (GLA) {
            kv[i][0] = bf2f((bf16_t)(kr & 0xffffu)); kv[i][1] = bf2f((bf16_t)(kr >> 16));
            const float* ar = &AFs[(l0 + i) * 32 + DIR * 16];
            float s0 = abv[0], s1 = abv[1];
#pragma unroll
            for (int r = 0; r < 16; ++r) { const float av = ar[r]; s0 += av * a2c[0][r]; s1 += av * a2c[1][r]; }
            dv[i][0] = logsigmoidf_(s0) * 0.0625f; dv[i][1] = logsigmoidf_(s1) * 0.0625f;
        } else {
            kv[i][0] = h2f((unsigned short)(kr & 0xffffu)); kv[i][1] = h2f((unsigned short)(kr >> 16));
            dv[i][0] = 1.0f - kv[i][0]; dv[i][1] = 1.0f - kv[i][1];
        }
    }
    {
        float s0 = GLA ? 0.f : 1.f, s1 = GLA ? 0.f : 1.f;
#pragma unroll
        for (int i = 0; i < RS; ++i) { if (GLA) { s0 += dv[i][0]; s1 += dv[i][1]; } else { s0 *= dv[i][0]; s1 *= dv[i][1]; } }
        float2 pv; pv.x = s0; pv.y = s1;
        *(float2*)&part[seg * DK + c0] = pv;
    }
    lds_sync();
    float tot[2], base[2], mid[2];
#pragma unroll
    for (int c = 0; c < 2; ++c) { tot[c] = GLA ? 0.f : 1.f; base[c] = tot[c]; mid[c] = tot[c]; }
#pragma unroll
    for (int sg = 0; sg < NSEG; ++sg) {
        const float2 pv = *(const float2*)&part[sg * DK + c0];
        const bool before = (DIR == 0) ? (sg < seg) : (sg > seg);
        const bool firsthalf = (DIR == 0) ? (sg < NSEG / 2) : (sg >= NSEG / 2);
        if (GLA) { tot[0] += pv.x; tot[1] += pv.y; if (before) { base[0] += pv.x; base[1] += pv.y; } if (firsthalf) { mid[0] += pv.x; mid[1] += pv.y; } }
        else { tot[0] *= pv.x; tot[1] *= pv.y; if (before) { base[0] *= pv.x; base[1] *= pv.y; } if (firsthalf) { mid[0] *= pv.x; mid[1] *= pv.y; } }
    }
    float ref[2], iref[2];
#pragma unroll
    for (int c = 0; c < 2; ++c) { ref[c] = ref_end ? tot[c] : mid[c]; iref[c] = GLA ? 0.f : __builtin_amdgcn_rcpf(ref[c]); }
    if (seg == 0) {
#pragma unroll
        for (int c = 0; c < 2; ++c) {
            if (PASS3) {
                const float open = GLA ? __expf(ref[c]) : ref[c];
                emid[c0 + c] = open * bsum[c];
                bsum[c] = GLA ? __expf(tot[c] - ref[c]) : tot[c] * iref[c];
            } else if (GLA) { emid[c0 + c] = __expf(ref[c]); eend[c0 + c] = 1.0f; bsum[c] += tot[c]; }
            else { emid[c0 + c] = ref[c]; eend[c0 + c] = 1.0f; bsum[c] += __logf(tot[c]); }
        }
    }
    unsigned short ktv[2][RS];
    float run[2] = {base[0], base[1]};
#pragma unroll
    for (int ii = 0; ii < RS; ++ii) {
        const int i = (DIR == 0) ? ii : (RS - 1 - ii);
        float ek[2], eq[2];
#pragma unroll
        for (int c = 0; c < 2; ++c) {
            if (GLA) { run[c] += dv[i][c]; ek[c] = __expf(ref[c] - run[c]); eq[c] = PASS3 ? __expf(run[c] - ref[c]) : 0.f; }
            else { run[c] *= dv[i][c]; ek[c] = ref[c] * __builtin_amdgcn_rcpf(run[c]); eq[c] = run[c] * iref[c]; }
        }
        const unsigned kp = cvt_pk_bf16(kv[i][0] * ek[0], kv[i][1] * ek[1]);
        ktv[0][i] = (unsigned short)(kp & 0xffffu); ktv[1][i] = (unsigned short)(kp >> 16);
        if (PASS3) {
            const int l = l0 + i;
            *(unsigned*)&Ks[l * QS + c0] = kp;
            const unsigned qr = *(const unsigned*)&Qs[l * QS + c0];
            *(unsigned*)&Qs[l * QS + c0] = cvt_pk_bf16(bf2f((bf16_t)(qr & 0xffffu)) * eq[0], bf2f((bf16_t)(qr >> 16)) * eq[1]);
        }
    }
#pragma unroll
    for (int c = 0; c < 2; ++c) {
        if (RS == 8) {
            u32x4 v;
            v.x = (unsigned)ktv[c][0] | ((unsigned)ktv[c][1] << 16); v.y = (unsigned)ktv[c][2] | ((unsigned)ktv[c][3] << 16);
            v.z = (unsigned)ktv[c][RS > 4 ? 4 : 0] | ((unsigned)ktv[c][RS > 4 ? 5 : 0] << 16); v.w = (unsigned)ktv[c][RS > 4 ? 6 : 0] | ((unsigned)ktv[c][RS > 4 ? 7 : 0] << 16);
            *(u32x4*)&Kt[(c0 + c) * 72 + l0] = v;
        } else {
            u32x2 v;
            v.x = (unsigned)ktv[c][0] | ((unsigned)ktv[c][1] << 16); v.y = (unsigned)ktv[c][2] | ((unsigned)ktv[c][3] << 16);
            *(u32x2*)&Kt[(c0 + c) * 72 + l0] = v;
        }
    }
    {
        const int vp = t & 63, vq = t >> 6;
        unsigned vr[8];
#pragma unroll
        for (int i = 0; i < 8; ++i) vr[i] = *(const unsigned*)&Vraw[(vq * 8 + i) * 136 + 2 * vp];
        u32x4 lo, hi;
        lo.x = (vr[0] & 0xffffu) | (vr[1] << 16); lo.y = (vr[2] & 0xffffu) | (vr[3] << 16); lo.z = (vr[4] & 0xffffu) | (vr[5] << 16); lo.w = (vr[6] & 0xffffu) | (vr[7] << 16);
        hi.x = (vr[0] >> 16) | (vr[1] & 0xffff0000u); hi.y = (vr[2] >> 16) | (vr[3] & 0xffff0000u); hi.z = (vr[4] >> 16) | (vr[5] & 0xffff0000u); hi.w = (vr[6] >> 16) | (vr[7] & 0xffff0000u);
        *(u32x4*)&Vt[(2 * vp) * 72 + vq * 8] = lo;
        *(u32x4*)&Vt[(2 * vp + 1) * 72 + vq * 8] = hi;
    }
    lds_sync();
}

DEVINL bf16x8 ldfrag(const bf16_t* base, int ld, int fr, int fq, int k0) { return *(const bf16x8*)(base + fr * ld + k0 + fq * 8); }

template <int DK, bool GLA, int DIR>
DEVINL void rec_load_a2(const Params& p, int h, float (&a2c)[2][16], float (&abv)[2]) {
#pragma unroll
    for (int c = 0; c < 2; ++c) { abv[c] = 0.f;
#pragma unroll
        for (int r = 0; r < 16; ++r) a2c[c][r] = 0.f; }
    if (GLA) {
        const int c0 = (tid_opaque() % (DK / 2)) * 2;
#pragma unroll
        for (int c = 0; c < 2; ++c) {
#pragma unroll
            for (int r = 0; r < 16; ++r) a2c[c][r] = p.gla_a2[(DIR * 16 + r) * 256 + h * 64 + c0 + c];
            abv[c] = p.gla_ab[DIR * 256 + h * 64 + c0 + c];
        }
    }
}

template <int DK, bool GLA, int DIR>
DEVINL void rec_pass1_unit(const Params& p, char* smem, const bf16_t* P, int b, int h, int cg, float* slots, float* decs) {
    using L = RecL<DK>; using G = RecGeo<DK, GLA>;
    constexpr int KT = G::KT;
    bf16_t* Kt = (bf16_t*)(smem + L::oKt); bf16_t* Vt = (bf16_t*)(smem + L::oVt); float* emid = (float*)(smem + L::oEmid);
    const int t = tid_opaque(), w = t >> 6, lane = t & 63, fr = lane & 15, fq = lane >> 4;
    float a2c[2][16], abv[2];
    rec_load_a2<DK, GLA, DIR>(p, h, a2c, abv);
    f32x4 accS[KT];
#pragma unroll
    for (int kt = 0; kt < KT; ++kt) accS[kt] = (f32x4){0.f, 0.f, 0.f, 0.f};
    float bsum[2] = {0.f, 0.f};
    const int nch = (cg == 0) ? 4 : G::GC;
    auto chunk_row0 = [&](int ci) { const int pc = (cg == 0) ? (DIR == 0 ? ci : 3 - ci) : (DIR == 0 ? (4 + (cg - 1) * G::GC + ci) : (67 - (cg - 1) * G::GC - ci)); return b * RPB + pc * 64; };
    RawRegs raw;
    rec_load_raw<DK, GLA, DIR, false>(p, P, chunk_row0(0), h, raw);
    for (int ci = 0; ci < nch; ++ci) {
        const bool has_next = ci + 1 < nch;
        rec_prep<DK, GLA, DIR, false>(p, smem, P, raw, has_next, has_next ? chunk_row0(ci + 1) : 0, h, a2c, abv, bsum);
        bf16x8 av[2];
#pragma unroll
        for (int ks = 0; ks < 2; ++ks) av[ks] = ldfrag(Vt + (w * 16) * 72, 72, fr, fq, ks * 32);
#pragma unroll
        for (int kt = 0; kt < KT; ++kt) {
            const f32x4 e4 = *(const f32x4*)&emid[kt * 16 + fq * 4];
            f32x4 c = accS[kt] * e4;
#pragma unroll
            for (int ks = 0; ks < 2; ++ks) c = __builtin_amdgcn_mfma_f32_16x16x32_bf16(ldfrag(Kt + (kt * 16) * 72, 72, fr, fq, ks * 32), av[ks], c, 0, 0, 0);
            accS[kt] = c;
        }
        lds_sync();
    }
    const size_t chain = ((size_t)(b * G::H + h) * 2 + DIR);
    float* sl = slots + (chain * G::NS + cg) * (size_t)(128 * DK);
#pragma unroll
    for (int kt = 0; kt < KT; ++kt) *(f32x4*)&sl[(w * 16 + fr) * DK + kt * 16 + fq * 4] = accS[kt];
    if (t < DK / 2) { decs[(chain * G::NS + cg) * DK + 2 * t] = bsum[0]; decs[(chain * G::NS + cg) * DK + 2 * t + 1] = bsum[1]; }
}

template <int DK, bool GLA, int DIR>
DEVINL void rec_pass3_chunk(const Params& p, char* smem, const bf16_t* P, bf16_t* CAT, int row0, int h, f32x4 (&accS)[DK / 16], const float* gnorm) {
    using L = RecL<DK>; using C = RecCols<GLA>;
    constexpr int KT = DK / 16, QS = L::QS, KS = DK / 32;
    bf16_t* Qs = (bf16_t*)(smem + L::oQs); bf16_t* Ks = (bf16_t*)(smem + L::oKs); bf16_t* Kt = (bf16_t*)(smem + L::oKt); bf16_t* Vt = (bf16_t*)(smem + L::oVt);
    bf16_t* At = (bf16_t*)(smem + L::oAt); bf16_t* St = (bf16_t*)(smem + L::oSt);
    float* emid = (float*)(smem + L::oEmid); float* eend = (float*)(smem + L::oEend); float* red = (float*)(smem + L::oRed);
    const int t = tid_opaque(), w = t >> 6, lane = t & 63, fr = lane & 15, fq = lane >> 4;
    u32x2 obv[4], gbv[4];
    if (DIR == 0) {
        const size_t prow = (size_t)(row0 + (w & 3) * 16 + fr);
        const bf16_t* cp0 = CAT + prow * 1024 + h * 128 + (w >> 2) * 64 + fq * 4;
        const bf16_t* gp0 = P + prow * C::LDP + C::GOFF + h * 128 + (w >> 2) * 64 + fq * 4;
#pragma unroll
        for (int n = 0; n < 4; ++n) { obv[n] = *(const u32x2*)(cp0 + n * 16); gbv[n] = *(const u32x2*)(gp0 + n * 16); }
    }
#pragma unroll
    for (int kt = 0; kt < KT; ++kt) {
        const f32x4 e4 = *(const f32x4*)&emid[kt * 16 + fq * 4];
        accS[kt] = accS[kt] * e4;
        *(u32x2*)&St[(w * 16 + fr) * QS + kt * 16 + fq * 4] = pk4(accS[kt]);
    }
    {
        const int lt = w >> 1, st0 = (w & 1) * 2;
        bf16x8 aq[KS];
#pragma unroll
        for (int ks = 0; ks < KS; ++ks) aq[ks] = ldfrag(Qs + (lt * 16) * QS, QS, fr, fq, ks * 32);
#pragma unroll
        for (int s2 = 0; s2 < 2; ++s2) {
            const int st = st0 + s2;
            f32x4 c = (f32x4){0.f, 0.f, 0.f, 0.f};
#pragma unroll
            for (int ks = 0; ks < KS; ++ks) c = __builtin_amdgcn_mfma_f32_16x16x32_bf16(ldfrag(Ks + (st * 16) * QS, QS, fr, fq, ks * 32), aq[ks], c, 0, 0, 0);
            const int l = lt * 16 + fr;
#pragma unroll
            for (int j = 0; j < 4; ++j) { const int sidx = st * 16 + fq * 4 + j; const bool keep = (DIR == 0) ? (sidx <= l) : (sidx >= l); c[j] = keep ? c[j] : 0.f; }
            *(u32x2*)&At[l * 72 + st * 16 + fq * 4] = pk4(c);
        }
    }
    lds_sync();
    const int lt = w & 3, vt0 = (w >> 2) * 4;
    f32x4 o[4];
    {
        bf16x8 aa[2], aq[KS];
#pragma unroll
        for (int ks = 0; ks < 2; ++ks) aa[ks] = ldfrag(At + (lt * 16) * 72, 72, fr, fq, ks * 32);
#pragma unroll
        for (int ks = 0; ks < KS; ++ks) aq[ks] = ldfrag(Qs + (lt * 16) * QS, QS, fr, fq, ks * 32);
#pragma unroll
        for (int n = 0; n < 4; ++n) {
            const int vt = vt0 + n;
            f32x4 c = (f32x4){0.f, 0.f, 0.f, 0.f};
#pragma unroll
            for (int ks = 0; ks < 2; ++ks) c = __builtin_amdgcn_mfma_f32_16x16x32_bf16(ldfrag(Vt + (vt * 16) * 72, 72, fr, fq, ks * 32), aa[ks], c, 0, 0, 0);
#pragma unroll
            for (int ks = 0; ks < KS; ++ks) c = __builtin_amdgcn_mfma_f32_16x16x32_bf16(ldfrag(St + (vt * 16) * QS, QS, fr, fq, ks * 32), aq[ks], c, 0, 0, 0);
            o[n] = c;
        }
    }
    {
        bf16x8 av[2];
#pragma unroll
        for (int ks = 0; ks < 2; ++ks) av[ks] = ldfrag(Vt + (w * 16) * 72, 72, fr, fq, ks * 32);
#pragma unroll
        for (int kt = 0; kt < KT; ++kt) {
            f32x4 c = accS[kt];
#pragma unroll
            for (int ks = 0; ks < 2; ++ks) c = __builtin_amdgcn_mfma_f32_16x16x32_bf16(ldfrag(Kt + (kt * 16) * 72, 72, fr, fq, ks * 32), av[ks], c, 0, 0, 0);
            accS[kt] = c;
        }
    }
    const int l = lt * 16 + fr;
    const size_t row = (size_t)(row0 + l);
    bf16_t* cp = CAT + row * 1024 + h * 128 + vt0 * 16 + fq * 4;
    if (DIR == 1) {
#pragma unroll
        for (int n = 0; n < 4; ++n) *(u32x2*)(cp + n * 16) = pk4(o[n]);
    } else {
        float ss = 0.f;
#pragma unroll
        for (int n = 0; n < 4; ++n) {
            const u32x2 ob = obv[n];
            o[n][0] += bf2f((bf16_t)(ob.x & 0xffff)); o[n][1] += bf2f((bf16_t)(ob.x >> 16));
            o[n][2] += bf2f((bf16_t)(ob.y & 0xffff)); o[n][3] += bf2f((bf16_t)(ob.y >> 16));
            ss += o[n][0] * o[n][0] + o[n][1] * o[n][1] + o[n][2] * o[n][2] + o[n][3] * o[n][3];
        }
        ss += __shfl_xor(ss, 16);
        ss += __shfl_xor(ss, 32);
        if (fq == 0) red[l * 2 + (w >> 2)] = ss;
        lds_sync();
        const float tot = red[l * 2] + red[l * 2 + 1];
        const float rstd = rsqrtf(tot * (1.0f / 128.0f) + EPS);
#pragma unroll
        for (int n = 0; n < 4; ++n) {
            const u32x2 gb = gbv[n];
            const f32x4 gn = *(const f32x4*)(gnorm + vt0 * 16 + n * 16 + fq * 4);
            f32x4 gv;
            gv[0] = bf2f((bf16_t)(gb.x & 0xffff)); gv[1] = bf2f((bf16_t)(gb.x >> 16)); gv[2] = bf2f((bf16_t)(gb.y & 0xffff)); gv[3] = bf2f((bf16_t)(gb.y >> 16));
            f32x4 r4;
#pragma unroll
            for (int j = 0; j < 4; ++j) { const float g = GLA ? siluf_(gv[j]) : gv[j]; r4[j] = o[n][j] * rstd * gn[j] * g; }
            *(u32x2*)(cp + n * 16) = pk4(r4);
        }
    }
    lds_sync();
}

template <int DK, bool GLA, int DIR, int PRB = 0>
DEVINL void rec_pass3_sweep(const Params& p, char* smem, const bf16_t* P, bf16_t* CAT, int b, int h, int c_lo, int nch, int slot, const float* slots, const float* gnorm) {
    using G = RecGeo<DK, GLA>;
    constexpr int KT = G::KT;
    const int t = tid_opaque(), w = t >> 6, lane = t & 63, fr = lane & 15, fq = lane >> 4;
    float a2c[2][16], abv[2];
    rec_load_a2<DK, GLA, DIR>(p, h, a2c, abv);
    f32x4 accS[KT];
    if (slot >= 0) {
        const size_t chain = ((size_t)(b * G::H + h) * 2 + DIR);
        const float* sl = slots + (chain * G::NS + slot) * (size_t)(128 * DK);
#pragma unroll
        for (int kt = 0; kt < KT; ++kt) accS[kt] = *(const f32x4*)&sl[(w * 16 + fr) * DK + kt * 16 + fq * 4];
    } else {
#pragma unroll
        for (int kt = 0; kt < KT; ++kt) accS[kt] = (f32x4){0.f, 0.f, 0.f, 0.f};
    }
    float bsum[2] = {1.f, 1.f};
    float* gn_lds = (float*)(smem + RecL<DK>::oRed + 64 * 2 * 4);
    if (DIR == 0) { if (t < 128) gn_lds[t] = gnorm[t]; }
    auto chunk_row0 = [&](int ci) { const int pc = (DIR == 0) ? (c_lo + ci) : (c_lo + nch - 1 - ci); return b * RPB + pc * 64; };
    RawRegs raw;
    rec_load_raw<DK, GLA, DIR, true>(p, P, chunk_row0(0), h, raw);
    for (int ci = 0; ci < nch; ++ci) {
        const bool has_next = ci + 1 < nch;
        if (PRB != 2 || ci == 0) rec_prep<DK, GLA, DIR, true>(p, smem, P, raw, has_next, has_next ? chunk_row0(ci + 1) : 0, h, a2c, abv, bsum);
        if (PRB != 1) rec_pass3_chunk<DK, GLA, DIR>(p, smem, P, CAT, chunk_row0(ci), h, accS, gn_lds);
    }
}

template <int DK, bool GLA, int PRB = 0>
DEVINL void rec_pass3_unit(const Params& p, char* smem, const bf16_t* P, bf16_t* CAT, int b, int h, int gi, const float* slots, const float* gnorm) {
    using G = RecGeo<DK, GLA>;
    int c_lo, nch, slot_f, slot_b;
    if (GLA) {
        if (gi == 0) { c_lo = 0; nch = 4; slot_f = -1; slot_b = -1; }
        else { const int pg = gi - 1; c_lo = 4 + pg * G::GC; nch = G::GC; slot_f = pg; slot_b = G::NS - 1 - pg; }
    } else { const int pg = gi; c_lo = 4 + pg * G::GC; nch = G::GC; slot_f = pg; slot_b = G::NS - 1 - pg; }
    rec_pass3_sweep<DK, GLA, 1, PRB>(p, smem, P, CAT, b, h, c_lo, nch, slot_b, slots, gnorm);
    asm volatile("s_waitcnt vmcnt(0)" ::: "memory");
    rec_pass3_sweep<DK, GLA, 0, PRB>(p, smem, P, CAT, b, h, c_lo, nch, slot_f, slots, gnorm);
}

template <int DK, bool GLA>
DEVINL void rec_scan(float* slots, const float* decs, int bid, int nb) {
    using G = RecGeo<DK, GLA>;
    constexpr int NCHAIN = NBATCH * G::H * 2, PER = 128 * DK / 4;
    const int total = NCHAIN * PER;
    for (int i = bid * NTHR + tid_opaque(); i < total; i += nb * NTHR) {
        const int chain = i / PER, e = i - chain * PER;
        const int k4 = (e * 4) % DK;
        f32x4 run = (f32x4){0.f, 0.f, 0.f, 0.f};
#pragma unroll 1
        for (int s0 = 0; s0 < G::NS; s0 += 8) {
            f32x4 a[8], d4[8];
#pragma unroll
            for (int j = 0; j < 8; ++j) {
                d4[j] = *(const f32x4*)&decs[((size_t)chain * G::NS + s0 + j) * DK + k4];
                a[j] = *(const f32x4*)(slots + ((size_t)chain * G::NS + s0 + j) * (size_t)(128 * DK) + (size_t)e * 4);
            }
#pragma unroll
            for (int j = 0; j < 8; ++j) {
#pragma unroll
                for (int q = 0; q < 4; ++q) run[q] = __expf(d4[j][q]) * run[q] + a[j][q];
                *(f32x4*)(slots + ((size_t)chain * G::NS + s0 + j) * (size_t)(128 * DK) + (size_t)e * 4) = run;
            }
        }
    }
}

DEVINL size_t s5_idx(int b, int di, int pc, int g, int pp) { return ((((size_t)(b * 2 + di) * NCH + pc) * 32 + g) * 64 + pp) * 2; }

constexpr int S5_BU_LD = 20;
constexpr int S5_WAVE_LDS = 128 * S5_BU_LD * 4 + 16 * 136 * 2;
static_assert(8 * S5_WAVE_LDS <= LDS_BYTES, "s5 lds");

DEVINL void s5_load_afr(const Params& p, int row0, int g, int fr, int fq, bf16x8 (&afr)[4]) {
    const bf16x8 z = (bf16x8){0, 0, 0, 0, 0, 0, 0, 0};
#pragma unroll
    for (int sb = 0; sb < 4; ++sb) afr[sb] = (fq < 2) ? *(const bf16x8*)(p.P + (size_t)(row0 + sb * 16 + fr) * 2048 + 1536 + g * 16 + fq * 8) : z;
}
DEVINL void s5_load_bfr(const Params& p, int di, int g, int fr, int fq, bf16x8 (&bfr)[8]) {
    const bf16x8 z = (bf16x8){0, 0, 0, 0, 0, 0, 0, 0};
#pragma unroll
    for (int nt = 0; nt < 8; ++nt) bfr[nt] = (fq < 2) ? *(const bf16x8*)(p.bbm + ((size_t)((di * 32 + g) * 128 + nt * 16 + fr)) * 16 + fq * 8) : z;
}
DEVINL void s5_bu_subblock(float* BuT, const bf16x8& a, const bf16x8 (&bfr)[8], int fr, int fq) {
#pragma unroll
    for (int nt = 0; nt < 8; ++nt) {
        f32x4 c = (f32x4){0.f, 0.f, 0.f, 0.f};
        c = __builtin_amdgcn_mfma_f32_16x16x32_bf16(a, bfr[nt], c, 0, 0, 0);
        *(f32x4*)&BuT[(nt * 16 + fr) * S5_BU_LD + fq * 4] = c;
    }
}
template <int DIR, bool XS>
DEVINL void s5_scan16(const float* BuT, bf16_t* Xs, int lane, float are, float aim, float& xr, float& xi) {
    f32x4 br[4], bi[4];
#pragma unroll
    for (int q = 0; q < 4; ++q) { br[q] = *(const f32x4*)&BuT[lane * S5_BU_LD + q * 4]; bi[q] = *(const f32x4*)&BuT[(64 + lane) * S5_BU_LD + q * 4]; }
#pragma unroll
    for (int tt = 0; tt < 16; ++tt) {
        const int tl = DIR ? (15 - tt) : tt;
        const float nr = are * xr - aim * xi + br[tl >> 2][tl & 3], ni = are * xi + aim * xr + bi[tl >> 2][tl & 3];
        xr = nr; xi = ni;
        if (XS) *(unsigned*)&Xs[tl * 136 + 2 * lane] = cvt_pk_bf16(xr, xi);
    }
}
template <int DIR>
DEVINL void s5_pass1_task(const Params& p, float* BuT, int b, int pc, int g, const bf16x8 (&afr)[4], int lane, int fr, int fq) {
    bf16x8 bfr[8];
    s5_load_bfr(p, DIR, g, fr, fq, bfr);
    const float are = p.atab[((DIR * 32 + g) * 64 + lane) * 2], aim = p.atab[((DIR * 32 + g) * 64 + lane) * 2 + 1];
    float xr = 0.f, xi = 0.f;
#pragma unroll
    for (int sbi = 0; sbi < 4; ++sbi) {
        const int sb = DIR ? (3 - sbi) : sbi;
        s5_bu_subblock(BuT, afr[sb], bfr, fr, fq);
        asm volatile("s_waitcnt lgkmcnt(0)" ::: "memory");
        s5_scan16<DIR, false>(BuT, nullptr, lane, are, aim, xr, xi);
        asm volatile("s_waitcnt lgkmcnt(0)" ::: "memory");
    }
    float* o = p.s5xend + s5_idx(b, DIR, pc, g, lane);
    o[0] = xr; o[1] = xi;
}
DEVINL void s5_pass1_unit(const Params& p, char* smem, int b, int pc, int half) {
    const int t = tid_opaque(), w = t >> 6, lane = t & 63, fr = lane & 15, fq = lane >> 4;
    float* BuT = (float*)(smem + w * S5_WAVE_LDS);
    const int row0 = b * RPB + pc * 64;
#pragma unroll 1
    for (int q = 0; q < 2; ++q) {
        const int g = half * 16 + w * 2 + q;
        bf16x8 afr[4];
        s5_load_afr(p, row0, g, fr, fq, afr);
        s5_pass1_task<0>(p, BuT, b, pc, g, afr, lane, fr, fq);
        s5_pass1_task<1>(p, BuT, b, pc, g, afr, lane, fr, fq);
    }
}
DEVINL void s5_scan(const Params& p, int bid, int nb) {
    for (int i = bid * NTHR + tid_opaque(); i < NBATCH * 2 * 32 * 64; i += nb * NTHR) {
        const int pp = i & 63, g = (i >> 6) & 31, di = (i >> 11) & 1, b = i >> 12;
        const float ar = p.a64tab[((di * 32 + g) * 64 + pp) * 2], ai = p.a64tab[((di * 32 + g) * 64 + pp) * 2 + 1];
        float cr = 0.f, ci = 0.f;
#pragma unroll 1
        for (int c0 = 0; c0 < NCH; c0 += 17) {
            float er[17], ei[17];
#pragma unroll
            for (int j = 0; j < 17; ++j) {
                const int ch = c0 + j, pc = di ? (ch < 4 ? 3 - ch : 71 - ch) : ch;
                const size_t ix = s5_idx(b, di, pc, g, pp);
                er[j] = p.s5xend[ix]; ei[j] = p.s5xend[ix + 1];
            }
#pragma unroll
            for (int j = 0; j < 17; ++j) {
                const int ch = c0 + j, pc = di ? (ch < 4 ? 3 - ch : 71 - ch) : ch;
                const size_t ix = s5_idx(b, di, pc, g, pp);
                p.s5carry[ix] = cr; p.s5carry[ix + 1] = ci;
                const float nr = ar * cr - ai * ci + er[j], ni = ar * ci + ai * cr + ei[j];
                cr = nr; ci = ni;
            }
        }
    }
}
template <int DIR>
DEVINL void s5_pass3_task(const Params& p, float* BuT, bf16_t* Xs, int b, int pc, int g, const bf16x8 (&afr)[4], f32x4 (&acc)[4], int lane, int fr, int fq) {
    bf16x8 bfr[8];
    s5_load_bfr(p, DIR, g, fr, fq, bfr);
    bf16x8 cb[4];
#pragma unroll
    for (int ks = 0; ks < 4; ++ks) cb[ks] = *(const bf16x8*)(p.cmt + ((size_t)(g * 16 + fr)) * 256 + DIR * 128 + ks * 32 + fq * 8);
    const float are = p.atab[((DIR * 32 + g) * 64 + lane) * 2], aim = p.atab[((DIR * 32 + g) * 64 + lane) * 2 + 1];
    const size_t cix = s5_idx(b, DIR, pc, g, lane);
    float xr = p.s5carry[cix], xi = p.s5carry[cix + 1];
#pragma unroll
    for (int sbi = 0; sbi < 4; ++sbi) {
        const int sb = DIR ? (3 - sbi) : sbi;
        s5_bu_subblock(BuT, afr[sb], bfr, fr, fq);
        asm volatile("s_waitcnt lgkmcnt(0)" ::: "memory");
        s5_scan16<DIR, true>(BuT, Xs, lane, are, aim, xr, xi);
        asm volatile("s_waitcnt lgkmcnt(0)" ::: "memory");
        f32x4 c = acc[sb];
#pragma unroll
        for (int ks = 0; ks < 4; ++ks) {
            const bf16x8 a = *(const bf16x8*)(Xs + fr * 136 + ks * 32 + fq * 8);
            c = __builtin_amdgcn_mfma_f32_16x16x32_bf16(cb[ks], a, c, 0, 0, 0);
        }
        acc[sb] = c;
        asm volatile("s_waitcnt lgkmcnt(0)" ::: "memory");
    }
}
DEVINL void s5_pass3_unit(const Params& p, char* smem, int b, int pc, int half) {
    const int t = tid_opaque(), w = t >> 6, lane = t & 63, fr = lane & 15, fq = lane >> 4;
    float* BuT = (float*)(smem + w * S5_WAVE_LDS);
    bf16_t* Xs = (bf16_t*)(smem + w * S5_WAVE_LDS + 128 * S5_BU_LD * 4);
    const int row0 = b * RPB + pc * 64;
#pragma unroll 1
    for (int q = 0; q < 2; ++q) {
        const int g = half * 16 + w * 2 + q;
        bf16x8 afr[4];
        s5_load_afr(p, row0, g, fr, fq, afr);
        f32x4 acc[4];
#pragma unroll
        for (int sb = 0; sb < 4; ++sb) acc[sb] = (f32x4){0.f, 0.f, 0.f, 0.f};
        s5_pass3_task<1>(p, BuT, Xs, b, pc, g, afr, acc, lane, fr, fq);
        s5_pass3_task<0>(p, BuT, Xs, b, pc, g, afr, acc, lane, fr, fq);
        const f32x4 d4 = *(const f32x4*)(p.s5_d + g * 16 + fq * 4);
#pragma unroll
        for (int sb = 0; sb < 4; ++sb) {
            const int tok = sb * 16 + fr;
            const u32x2 ub = *(const u32x2*)(p.P + (size_t)(row0 + tok) * 2048 + 1536 + g * 16 + fq * 4);
            f32x4 uv; uv[0] = bf2f((bf16_t)(ub.x & 0xffff)); uv[1] = bf2f((bf16_t)(ub.x >> 16)); uv[2] = bf2f((bf16_t)(ub.y & 0xffff)); uv[3] = bf2f((bf16_t)(ub.y >> 16));
            f32x4 r4;
#pragma unroll
            for (int j = 0; j < 4; ++j) r4[j] = gelu_tanh(acc[sb][j] + d4[j] * uv[j]);
            *(u32x2*)(p.s5a + (size_t)(row0 + tok) * 512 + g * 16 + fq * 4) = pk4(r4);
        }
    }
}

struct UnitQueue {
    int* counter; int* slot; int total, shard, k, pend, per;
    static constexpr int NSH = 32;
    DEVINL void init(int* heads, int q, char* smem, int total_, int bid, int nb) {
        shard = sgpr(bid) & (NSH - 1); counter = heads + (q * NSH + shard) * 16; slot = (int*)(smem + LDS_BYTES - 64); total = total_;
        per = (sgpr(nb) - 1 - shard) / NSH + 1;
        k = sgpr(bid) >> 5; pend = 0;
        if (tid_opaque() == 0) pend = atomicAdd(counter, 1) + per;
    }
    DEVINL int unit() const { return shard + NSH * k; }
    DEVINL bool valid() const { return unit() < total; }
    DEVINL void advance() {
        if (tid_opaque() == 0) { *slot = pend; pend = atomicAdd(counter, 1) + per; }
        lds_sync();
        k = sgpr(*slot);
        lds_sync();
    }
};

DEVINL void phase_prologue(const Params& p, char* smem, int bid, int nb) {
    UnitQueue Q; Q.init(p.qheads, 0, smem, T0_END, bid, nb);
    for (; Q.valid(); Q.advance()) prologue_task(p, smem, Q.unit());
}

template <int LAYER>
DEVINL void phase_rec1(const Params& p, char* smem, int bid, int nb) {
    if (LAYER == 0) {
        constexpr int NG = 8 * 4 * 2 * 16;
        constexpr int NS5 = NBATCH * NCH * 2;
        UnitQueue Q; Q.init(p.qheads, 1, smem, NG + NS5, bid, nb);
        for (; Q.valid(); Q.advance()) {
            const int u = Q.unit();
            if (u < NG) {
                const int cg = u & 15, dir = (u >> 4) & 1, h = (u >> 5) & 3, b = u >> 7;
                if (dir == 0) rec_pass1_unit<64, true, 0>(p, smem, p.P, b, h, cg, p.gslots, p.gdecs);
                else rec_pass1_unit<64, true, 1>(p, smem, p.P, b, h, cg, p.gslots, p.gdecs);
            } else { const int v = u - NG; s5_pass1_unit(p, smem, (v >> 1) / NCH, (v >> 1) % NCH, v & 1); }
        }
    } else {
        constexpr int NG = 8 * 8 * 2 * 8;
        for (int u = bid; u < NG; u += nb) {
            const int cg = u & 7, dir = (u >> 3) & 1, h = (u >> 4) & 7, b = u >> 7;
            if (dir == 0) rec_pass1_unit<128, false, 0>(p, smem, p.P, b, h, cg, p.hslots, p.hdecs);
            else rec_pass1_unit<128, false, 1>(p, smem, p.P, b, h, cg, p.hslots, p.hdecs);
        }
    }
}
template <int LAYER>
DEVINL void phase_scan(const Params& p, char* smem, int bid, int nb) {
    if (LAYER == 0) { rec_scan<64, true>(p.gslots, p.gdecs, bid, nb); s5_scan(p, bid, nb); }
    else rec_scan<128, false>(p.hslots, p.hdecs, bid, nb);
}
template <int LAYER>
DEVINL void phase_rec3(const Params& p, char* smem, int bid, int nb) {
    if (LAYER == 0) {
        constexpr int NG = 8 * 4 * 17;
        constexpr int NS5 = NBATCH * NCH * 2;
        UnitQueue Q; Q.init(p.qheads, 2, smem, NG + NS5, bid, nb);
        for (; Q.valid(); Q.advance()) {
            const int u = Q.unit();
            if (u < NG) { const int gi = u % 17, h = (u / 17) & 3, b = u / 68; rec_pass3_unit<64, true>(p, smem, p.P, p.H, b, h, gi, p.gslots, p.gla_norm); }
            else { const int v = u - NG; s5_pass3_unit(p, smem, (v >> 1) / NCH, (v >> 1) % NCH, v & 1); }
        }
    } else {
        constexpr int NG = 8 * 8 * 8;
        for (int u = bid; u < NG; u += nb) { const int gi = u & 7, h = (u >> 3) & 7, b = u >> 6; rec_pass3_unit<128, false>(p, smem, p.P, p.H, b, h, gi, p.hslots, p.hg_norm); }
    }
}

DEVINL void phase_final(const Params& p, int bid, int nb) {
    const int t = tid_opaque(), w = t >> 6, lane = t & 63;
    f32x4 gn[4];
#pragma unroll
    for (int i = 0; i < 4; ++i) gn[i] = *(const f32x4*)(p.final_norm + lane * 4 + i * 256);
    for (int rg = bid; rg < NLAT / 16; rg += nb) {
        const int i0 = rg * 16 + w * 2, b = i0 >> 12;
        const float* gatev = p.mod + ((size_t)(9 + b)) * 6144 + 5120;
        const float* gyv = p.mod + ((size_t)(9 + b)) * 6144 + 2048;
        f32x4 v[2][4], gu[4], gy[4]; u32x2 ub[2][4], yb[2][4];
#pragma unroll
        for (int rw = 0; rw < 2; ++rw) {
            const int i = i0 + rw;
            const int r = (i >> 12) * RPB + CTXL + (i & 4095);
            const int slot = p.sor[r];
            const float* res = p.out + (size_t)i * D;
#pragma unroll
            for (int q = 0; q < 4; ++q) { v[rw][q] = *(const f32x4*)(res + lane * 4 + q * 256); ub[rw][q] = *(const u32x2*)(p.y2 + (size_t)slot * D + lane * 4 + q * 256);
                yb[rw][q] = *(const u32x2*)(p.Y + (size_t)r * D + lane * 4 + q * 256); }
        }
#pragma unroll
        for (int q = 0; q < 4; ++q) { gu[q] = *(const f32x4*)(gatev + lane * 4 + q * 256); gy[q] = *(const f32x4*)(gyv + lane * 4 + q * 256); }
#pragma unroll
        for (int rw = 0; rw < 2; ++rw) {
            float* res = p.out + (size_t)(i0 + rw) * D;
            float ss = 0.f;
#pragma unroll
            for (int q = 0; q < 4; ++q) {
                const u32x2 u = ub[rw][q], y = yb[rw][q];
                v[rw][q][0] += gu[q][0] * bf2f((bf16_t)(u.x & 0xffffu)) + gy[q][0] * bf2f((bf16_t)(y.x & 0xffffu)); v[rw][q][1] += gu[q][1] * bf2f((bf16_t)(u.x >> 16)) + gy[q][1] * bf2f((bf16_t)(y.x >> 16));
                v[rw][q][2] += gu[q][2] * bf2f((bf16_t)(u.y & 0xffffu)) + gy[q][2] * bf2f((bf16_t)(y.y & 0xffffu)); v[rw][q][3] += gu[q][3] * bf2f((bf16_t)(u.y >> 16)) + gy[q][3] * bf2f((bf16_t)(y.y >> 16));
                ss += v[rw][q][0] * v[rw][q][0] + v[rw][q][1] * v[rw][q][1] + v[rw][q][2] * v[rw][q][2] + v[rw][q][3] * v[rw][q][3];
            }
#pragma unroll
            for (int o = 32; o >= 1; o >>= 1) ss += __shfl_xor(ss, o);
            const float rstd = rsqrtf(ss * (1.0f / 1024.0f) + EPS);
#pragma unroll
            for (int q = 0; q < 4; ++q) *(f32x4*)(res + lane * 4 + q * 256) = v[rw][q] * rstd * gn[q];
        }
    }
}

constexpr int NPHASE = 23;
constexpr int MEGA_LDS = LDS_BYTES + 16 + 1024;
static_assert(sizeof(Params) <= 1024 && sizeof(Params) % 8 == 0, "params block");
template <int PH>
DEVINL void run_phase(const Params& p, char* smem, int bid, int nb) {
    if (PH == 0) phase_prologue(p, smem, bid, nb);
    if (PH == 1) phase_pre<0>(p, smem, bid, nb);
    if (PH == 2) phase_gemm<0>(p, smem, bid, nb);
    if (PH == 3) phase_rec1<0>(p, smem, bid, nb);
    if (PH == 4) phase_scan<0>(p, smem, bid, nb);
    if (PH == 5) phase_rec3<0>(p, smem, bid, nb);
    if (PH == 6) phase_gemm<1>(p, smem, bid, nb);
    if (PH == 7) phase_gemm<2>(p, smem, bid, nb);
    if (PH == 8) phase_pre<1>(p, smem, bid, nb);
    if (PH == 9) phase_list<0>(p, smem, bid, nb);
    if (PH == 10) phase_moe<0, 1>(p, smem, bid, nb);
    if (PH == 11) phase_moe<0, 2>(p, smem, bid, nb);
    if (PH == 12) phase_pre<2>(p, smem, bid, nb);
    if (PH == 13) phase_gemm<3>(p, smem, bid, nb);
    if (PH == 14) phase_rec1<1>(p, smem, bid, nb);
    if (PH == 15) phase_scan<1>(p, smem, bid, nb);
    if (PH == 16) phase_rec3<1>(p, smem, bid, nb);
    if (PH == 17) phase_gemm<4>(p, smem, bid, nb);
    if (PH == 18) phase_pre<3>(p, smem, bid, nb);
    if (PH == 19) phase_list<1>(p, smem, bid, nb);
    if (PH == 20) phase_moe<1, 1>(p, smem, bid, nb);
    if (PH == 21) phase_moe<1, 2>(p, smem, bid, nb);
    if (PH == 22) phase_final(p, bid, nb);
}

extern __shared__ __attribute__((aligned(16))) char dyn_smem[];

#if ONE_LAUNCH
template <int PH> struct PhaseSeq {
    static DEVINL void run(const Params& p, char* smem, const XcdBarrier& bar) {
        PhaseSeq<PH - 1>::run(p, smem, bar);
        xcd_barrier(bar);
        run_phase<PH>(p, smem, (int)blockIdx.x, (int)gridDim.x);
#ifdef DUP_MASK
        if ((DUP_MASK >> PH) & 1) { xcd_barrier(bar); run_phase<PH>(p, smem, (int)blockIdx.x, (int)gridDim.x); }
#endif
    }
};
template <> struct PhaseSeq<0> {
    static DEVINL void run(const Params& p, char* smem, const XcdBarrier& bar) {
        run_phase<0>(p, smem, (int)blockIdx.x, (int)gridDim.x);
#ifdef DUP_MASK
        if (DUP_MASK & 1) { xcd_barrier(bar); run_phase<0>(p, smem, (int)blockIdx.x, (int)gridDim.x); }
#endif
    }
};
__global__ void __launch_bounds__(NTHR, 2) mega_kernel(Params p) {
    volatile LAS unsigned* st = (volatile LAS unsigned*)(dyn_smem + LDS_BYTES);
    if (threadIdx.x == 0) { st[0] = 0u; st[1] = 0u; st[2] = 0u; st[3] = 0u; }
    __syncthreads();
    XcdBarrier bar = xcd_barrier_post(p.bar, st);
#ifdef PROBE_ID
    {
        const int bid = (int)blockIdx.x, nb = (int)gridDim.x;
        if (PROBE_ID == 1) for (int v = bid; v < NBATCH * NCH * 2; v += nb) s5_pass1_unit(p, dyn_smem, (v >> 1) / NCH, (v >> 1) % NCH, v & 1);
        if (PROBE_ID == 2) for (int u = bid; u < 1024; u += nb) { const int cg = u & 15, dir = (u >> 4) & 1, h = (u >> 5) & 3, b = u >> 7;
            if (dir == 0) rec_pass1_unit<64, true, 0>(p, dyn_smem, p.P, b, h, cg, p.gslots, p.gdecs); else rec_pass1_unit<64, true, 1>(p, dyn_smem, p.P, b, h, cg, p.gslots, p.gdecs); }
        if (PROBE_ID == 3) for (int v = bid; v < NBATCH * NCH * 2; v += nb) s5_pass3_unit(p, dyn_smem, (v >> 1) / NCH, (v >> 1) % NCH, v & 1);
        if (PROBE_ID == 4) for (int u = bid; u < 8 * 4 * 17; u += nb) { const int gi = u % 17, h = (u / 17) & 3, b = u / 68; rec_pass3_unit<64, true>(p, dyn_smem, p.P, p.H, b, h, gi, p.gslots, p.gla_norm); }
        if (PROBE_ID == 6) for (int u = bid; u < 512; u += nb) { const int gi = u & 7, h = (u >> 3) & 7, b = u >> 6; rec_pass3_unit<128, false, RECPROBE>(p, dyn_smem, p.P, p.H, b, h, gi, p.hslots, p.hg_norm); }
        if (PROBE_ID == 5) for (int u = bid; u < 1024 + NBATCH * NCH * 2; u += nb) {
            if (u < 1024) { const int cg = u & 15, dir = (u >> 4) & 1, h = (u >> 5) & 3, b = u >> 7;
                if (dir == 0) rec_pass1_unit<64, true, 0>(p, dyn_smem, p.P, b, h, cg, p.gslots, p.gdecs); else rec_pass1_unit<64, true, 1>(p, dyn_smem, p.P, b, h, cg, p.gslots, p.gdecs); }
            else { const int v = u - 1024; s5_pass1_unit(p, dyn_smem, (v >> 1) / NCH, (v >> 1) % NCH, v & 1); } }
        xcd_barrier(bar);
    }
#endif
#ifdef PREFIX_K
    PhaseSeq<PREFIX_K>::run(p, dyn_smem, bar);
    xcd_barrier(bar);
    if (blockIdx.x == 0) { if (threadIdx.x < 256) p.cnt[threadIdx.x] = 0; for (int i = threadIdx.x; i < 3 * 32 * 16; i += NTHR) p.qheads[i] = 0; }
    xcd_barrier(bar);
#endif
    PhaseSeq<NPHASE - 1>::run(p, dyn_smem, bar);
}
#else
template <int PH>
__global__ void __launch_bounds__(NTHR, 2) phase_kernel(Params p) {
    run_phase<PH>(p, dyn_smem, (int)blockIdx.x, (int)gridDim.x);
}
template <int PH> struct Launcher {
    static void go(const Params& p, int grid, hipStream_t s) {
        Launcher<PH - 1>::go(p, grid, s);
        static bool attr = false;
        if (!attr) { hipFuncSetAttribute((const void*)phase_kernel<PH>, hipFuncAttributeMaxDynamicSharedMemorySize, LDS_BYTES + 16); attr = true; }
        phase_kernel<PH><<<grid, NTHR, LDS_BYTES + 16, s>>>(p);
    }
};
template <> struct Launcher<-1> { static void go(const Params&, int, hipStream_t) {} };
#endif

static size_t align_up(size_t v, size_t a) { return (v + a - 1) / a * a; }

extern "C" void kernel_launch(void* const* d_in, const int* in_sizes, int n_in, void* d_out, int out_size, void* d_ws, size_t ws_size, hipStream_t stream) {
    (void)in_sizes; (void)n_in; (void)out_size;
    Params p;
    memset(&p, 0, sizeof(p));
    const float* const* in = (const float* const*)d_in;
    p.x = in[0]; p.c = in[1]; p.ctx = in[2]; p.c_ctx = in[3]; p.ada_w = in[4]; p.ada_b = in[5]; p.norm_mix = in[6]; p.norm_ffn = in[7];
    p.ab_w_in = in[8]; p.ab_w_out = in[9]; p.gla_a2 = in[10]; p.gla_ab = in[11]; p.gla_norm = in[12];
    p.s5_lam_re = in[13]; p.s5_lam_im = in[14]; p.s5_log_dt = in[15]; p.s5_b_re = in[16]; p.s5_b_im = in[17]; p.s5_c_re = in[18]; p.s5_c_im = in[19];
    p.s5_d = in[20]; p.glu_w = in[21]; p.glu_b = in[22]; p.hg_w_in = in[23]; p.hg_w_out = in[24]; p.hg_lb = in[25]; p.hg_norm = in[26];
    p.router_w = in[27]; p.router_bias = in[28]; p.moe_wg = in[29]; p.moe_wu = in[30]; p.moe_wd = in[31]; p.final_norm = in[32];
    p.out = (float*)d_out;

    char* ws = (char*)d_ws;
    size_t o = 0;
    auto take = [&](size_t bytes) { char* r = ws + o; o = align_up(o + bytes, 256); return r; };
    p.bar = (unsigned*)take(XCD_BAR_WORDS * 4);
    p.cnt = (int*)take(256 * 4);
    p.qheads = (int*)take(3 * 32 * 16 * 4);
    p.mod = (float*)take((size_t)2 * 9 * 6144 * 4);
    p.pos = (float*)take(64 * 512 * 4);
    p.lb = (float*)take(1024 * 4);
    p.atab = (float*)take(2 * 32 * 64 * 2 * 4);
    p.a64tab = (float*)take(2 * 32 * 64 * 2 * 4);
    p.cmt = (bf16_t*)take((size_t)32 * 16 * 256 * 2);
    p.bbm = (bf16_t*)take((size_t)2 * 32 * 128 * 16 * 2);
    p.wrt = (bf16_t*)take((size_t)2 * 2 * 32 * 1024 * 2);
    p.RT = (float4*)take((size_t)R * 16);
    p.list = (int*)take((size_t)ACT_ROWS * 4);
    p.wl = (float*)take((size_t)ACT_ROWS * 4);
    p.wh = (float*)take((size_t)ACT_ROWS * 4);
    p.cx = (float*)take((size_t)NBATCH * CTXL * D * 4);
    p.sor = (int*)take((size_t)R * 4);
    p.blkcnt = (int*)take((size_t)2 * 256 * 48 * 4);
    p.wt_in0 = (bf16_t*)take((size_t)2048 * 1024 * 2);
    p.wt_out0 = (bf16_t*)take((size_t)1024 * 1024 * 2);
    p.glu_t = (bf16_t*)take((size_t)512 * 512 * 2);
    p.wt_in1 = (bf16_t*)take((size_t)5120 * 1024 * 2);
    p.wt_out1 = (bf16_t*)take((size_t)1024 * 1024 * 2);
    p.H = (bf16_t*)take((size_t)R * 1024 * 2);
    const size_t big = o;
    p.P = (bf16_t*)(ws + big);
    size_t o0 = big + (size_t)R * 2048 * 2;
    auto take0 = [&](size_t bytes) { char* r = ws + o0; o0 = align_up(o0 + bytes, 256); return r; };
    p.gslots = (float*)take0((size_t)64 * 16 * 128 * 64 * 4);
    p.gdecs = (float*)take0((size_t)64 * 16 * 64 * 4);
    p.s5xend = (float*)take0((size_t)NBATCH * 2 * NCH * 32 * 64 * 2 * 4);
    p.s5carry = (float*)take0((size_t)NBATCH * 2 * NCH * 32 * 64 * 2 * 4);
    p.s5a = (bf16_t*)take0((size_t)R * 512 * 2);
    p.AF = (float*)take0((size_t)R * 32 * 4);
    p.wgu_t = (bf16_t*)take0((size_t)32 * 512 * 1024 * 2);
    p.wd_t = (bf16_t*)take0((size_t)32 * 1024 * 256 * 2);
    p.hs = (bf16_t*)(ws + big);
    p.Y = (bf16_t*)(ws + big);
    p.y2 = (bf16_t*)(ws + big + (size_t)R * 1024 * 2);
    p.act = (bf16_t*)(ws + big + (size_t)R * 1024 * 2 + (size_t)ACT_ROWS * 1024 * 2);
    if (big + (size_t)R * 1024 * 2 + (size_t)ACT_ROWS * 1024 * 2 + (size_t)ACT_ROWS * 512 * 2 > (size_t)((char*)p.wgu_t - ws)) fprintf(stderr, "moe overlay overlaps live buffers\n");
    size_t o1 = big + (size_t)R * 5120 * 2;
    auto take1 = [&](size_t bytes) { char* r = ws + o1; o1 = align_up(o1 + bytes, 256); return r; };
    p.hslots = (float*)take1((size_t)128 * 8 * 128 * 128 * 4);
    p.hdecs = (float*)take1((size_t)128 * 8 * 128 * 4);
    const size_t need = o0 > o1 ? o0 : o1;
    if (need > ws_size) fprintf(stderr, "workspace too small: need %zu have %zu\n", need, ws_size);

    static int grid = 0;
    if (!grid) {
        int dev = 0, cus = 0;
        if (hipGetDevice(&dev) != hipSuccess || hipDeviceGetAttribute(&cus, hipDeviceAttributeMultiprocessorCount, dev) != hipSuccess || cus <= 0) cus = 256;
        grid = cus > 256 ? 256 : (cus & ~7);
    }
#if ONE_LAUNCH
    static bool attr = false;
    if (!attr) { hipFuncSetAttribute((const void*)mega_kernel, hipFuncAttributeMaxDynamicSharedMemorySize, MEGA_LDS); attr = true; }
    hipMemsetAsync(p.bar, 0, XCD_BAR_WORDS * 4 + 256 * 4 + 3 * 32 * 16 * 4, stream);
    mega_kernel<<<grid, NTHR, MEGA_LDS, stream>>>(p);
#else
    Launcher<NPHASE - 1>::go(p, grid, stream);
#endif
}
```

```cpp
#include <hip/hip_runtime.h>
#include <stdint.h>
#include <string.h>
#include <stdio.h>

#ifndef ONE_LAUNCH
#define ONE_LAUNCH 1
#endif

typedef unsigned short bf16_t;
typedef short bf16x8 __attribute__((ext_vector_type(8)));
typedef float f32x4 __attribute__((ext_vector_type(4)));
typedef unsigned u32x4 __attribute__((ext_vector_type(4)));
typedef unsigned u32x2 __attribute__((ext_vector_type(2)));
#define DEVINL __device__ __forceinline__

constexpr int D = 1024, NBATCH = 8, SEQ = 4096, CTXL = 256;
constexpr int RPB = SEQ + CTXL;
constexpr int R = NBATCH * RPB;
constexpr int NLAT = NBATCH * SEQ;
constexpr int NCH = RPB / 64;
constexpr float EPS = 1e-6f;
constexpr int NTHR = 512;
constexpr int LDS_BYTES = 136 * 1024;
constexpr int ACT_ROWS = 47104;

#define XB_TMO      128
#define XB_XCNT(j)  (256  + 64 * (j))
#define XB_XSUB(j)  (1280 + 64 * (j))
#define XB_XGEN(j)  (2304 + 64 * (j))
#define XB_TOP      3328
#define XB_TOPGEN   3392
#define XCD_BAR_WORDS 3456
#define XB_SPIN_CAP (1u << 18)
#define LAS __attribute__((address_space(3)))

__device__ __forceinline__ unsigned xb_ld(unsigned* p)              { return __hip_atomic_load(p, __ATOMIC_RELAXED, __HIP_MEMORY_SCOPE_AGENT); }
__device__ __forceinline__ unsigned xb_add(unsigned* p, unsigned v) { return __hip_atomic_fetch_add(p, v, __ATOMIC_RELAXED, __HIP_MEMORY_SCOPE_AGENT); }
__device__ __forceinline__ unsigned xb_xcc_id() { return (unsigned)__builtin_amdgcn_s_getreg((3 << 11) | 20) & 0xFu; }
#define XB_SPIN(cond, bar) do { unsigned _sp = 0; while (cond) { __builtin_amdgcn_s_sleep(1); \
    if ((++_sp & 255u) == 0u) { if (xb_ld(&(bar)[XB_TMO])) break; if (_sp > XB_SPIN_CAP) { atomicAdd(&(bar)[XB_TMO], 1u); break; } } } } while (0)

struct XcdBarrier {
    unsigned* bar; unsigned x;
    volatile LAS unsigned* st;
};
__device__ __forceinline__ XcdBarrier xcd_barrier_post(unsigned* bar, volatile LAS unsigned* st) {
    XcdBarrier b; b.bar = bar; b.x = xb_xcc_id(); b.st = st;
    if (threadIdx.x == 0) (void)xb_add(&bar[XB_XCNT(b.x)], 1u);
    return b;
}
__device__ __forceinline__ void xcd_barrier_complete(unsigned* bar, unsigned x, unsigned& nloc, unsigned& nx) {
    const unsigned G = gridDim.x * gridDim.y * gridDim.z;
    unsigned sum, cnt, mine, sp = 0u;
    for (;;) {
        sum = 0u; cnt = 0u; mine = 0u;
#pragma unroll
        for (unsigned j = 0; j < 16; ++j) { const unsigned c = xb_ld(&bar[XB_XCNT(j)]); sum += c; cnt += (c > 0u) ? 1u : 0u; mine = (j == x) ? c : mine; }
        if (sum == G) break;
        __builtin_amdgcn_s_sleep(1);
        if ((++sp & 255u) == 0u) { if (xb_ld(&bar[XB_TMO])) break; if (sp > XB_SPIN_CAP) { atomicAdd(&bar[XB_TMO], 1u); break; } }
    }
    nloc = mine > 0u ? mine : 1u; nx = cnt > 0u ? cnt : 1u;
}
__device__ __forceinline__ void xcd_barrier(const XcdBarrier& b) {
    asm volatile("s_waitcnt vmcnt(0)" ::: "memory");
    __syncthreads();
    if (threadIdx.x == 0) {
        unsigned* bar = b.bar;
        __builtin_amdgcn_s_waitcnt(0);
        unsigned nloc = b.st[0], nx = b.st[1];
        if (nloc == 0u) { xcd_barrier_complete(bar, b.x, nloc, nx); b.st[0] = nloc; b.st[1] = nx; }
        const unsigned old = xb_add(&bar[XB_XSUB(b.x)], 1u);
        const unsigned gen = old / nloc;
        if (old + 1u == (gen + 1u) * nloc) {
            __builtin_amdgcn_fence(__ATOMIC_RELEASE, "agent");
            asm volatile("s_waitcnt vmcnt(0)" ::: "memory");
            const unsigned og = xb_add(&bar[XB_TOP], 1u);
            const unsigned tg = og / nx;
            if (og + 1u == (tg + 1u) * nx) xb_add(&bar[XB_TOPGEN], 1u);
            else XB_SPIN(xb_ld(&bar[XB_TOPGEN]) == tg, bar);
            __builtin_amdgcn_fence(__ATOMIC_ACQUIRE, "agent");
            xb_add(&bar[XB_XGEN(b.x)], 1u);
            asm volatile("s_waitcnt vmcnt(0)" ::: "memory");
        } else {
            XB_SPIN(xb_ld(&bar[XB_XGEN(b.x)]) == gen, bar);
            __builtin_amdgcn_fence(__ATOMIC_ACQUIRE, "agent");
            asm volatile("s_waitcnt vmcnt(0)" ::: "memory");
        }
    }
    __syncthreads();
}

struct Params {
    const float *x, *c, *ctx, *c_ctx, *ada_w, *ada_b, *norm_mix, *norm_ffn, *ab_w_in, *ab_w_out, *gla_a2, *gla_ab, *gla_norm;
    const float *s5_lam_re, *s5_lam_im, *s5_log_dt, *s5_b_re, *s5_b_im, *s5_c_re, *s5_c_im, *s5_d, *glu_w, *glu_b;
    const float *hg_w_in, *hg_w_out, *hg_lb, *hg_norm, *router_w, *router_bias, *moe_wg, *moe_wu, *moe_wd, *final_norm;
    float* out;
    unsigned* bar;
    int* qheads;
    int* cnt;
    float *mod, *pos, *lb, *atab, *a64tab;
    bf16_t* cmt; bf16_t* bbm; bf16_t* wrt;
    float4* RT;
    int* list; float *wl, *wh;
    float* cx;
    bf16_t* Y; bf16_t* y2;
    int* sor; int* blkcnt;
    bf16_t *wt_in0, *wt_out0, *glu_t, *wt_in1, *wt_out1;
    bf16_t* H;
    bf16_t* xb;
    bf16_t* P;
    float *gslots, *gdecs;
    float *s5xend, *s5carry;
    bf16_t* s5m;
    bf16_t* s5a;
    bf16_t *wgu_t, *wd_t, *act, *hs;
    float* AF;
    float *hslots, *hdecs;
};

DEVINL int tid_opaque() { int t = threadIdx.x; asm volatile("" : "+v"(t)); return t; }
DEVINL void lds_sync() { asm volatile("s_waitcnt lgkmcnt(0)" ::: "memory"); __builtin_amdgcn_s_barrier(); asm volatile("" ::: "memory"); }

DEVINL int sgpr(int v) { return __builtin_amdgcn_readfirstlane(v); }
template <class T> DEVINL T* sgpr_ptr(T* ptr) {
    const unsigned long long v = (unsigned long long)ptr;
    const unsigned lo = (unsigned)__builtin_amdgcn_readfirstlane((int)(unsigned)v), hi = (unsigned)__builtin_amdgcn_readfirstlane((int)(unsigned)(v >> 32));
    return (T*)(__attribute__((address_space(1))) T*)(((unsigned long long)hi << 32) | lo);
}
DEVINL unsigned cvt_pk_bf16(float lo, float hi) { unsigned r; asm volatile("v_cvt_pk_bf16_f32 %0, %1, %2" : "=v"(r) : "v"(lo), "v"(hi)); return r; }
DEVINL float bf2f(bf16_t v) { return __uint_as_float(((unsigned)v) << 16); }
DEVINL bf16_t f2bf(float f) { unsigned u = __float_as_uint(f); u += 0x7fffu + ((u >> 16) & 1u); return (bf16_t)(u >> 16); }
DEVINL unsigned pk2(float lo, float hi) { return cvt_pk_bf16(lo, hi); }
DEVINL u32x2 pk4(f32x4 v) { u32x2 r; r.x = pk2(v[0], v[1]); r.y = pk2(v[2], v[3]); return r; }
DEVINL float h2f(unsigned short v) { return (float)__builtin_bit_cast(_Float16, v); }
DEVINL unsigned short f2h(float f) { return __builtin_bit_cast(unsigned short, (_Float16)f); }
DEVINL float sigmoidf_(float x) { return __builtin_amdgcn_rcpf(1.0f + __expf(-x)); }
DEVINL float siluf_(float x) { return x * sigmoidf_(x); }
DEVINL float logsigmoidf_(float x) { return fminf(x, 0.0f) - __logf(1.0f + __expf(-fabsf(x))); }
DEVINL float gelu_tanh(float y) { float z = 0.7978845608028654f * (y + 0.044715f * y * y * y); float th = 1.0f - 2.0f * __builtin_amdgcn_rcpf(__expf(2.0f * z) + 1.0f); return 0.5f * y * (1.0f + th); }
DEVINL float* resid_row(const Params& p, int r) {
    const int b = r / RPB, j = r - b * RPB;
    return (j < CTXL) ? (p.cx + (size_t)(b * CTXL + j) * D) : (p.out + (size_t)(b * SEQ + (j - CTXL)) * D);
}
DEVINL int row_batch_mod(int r) { const int b = r / RPB, j = r - b * RPB; return (j < CTXL) ? 8 : b; }

template <int K>
DEVINL f32x4 mma_lds(f32x4 c, const bf16_t* A, int lda, const bf16_t* Bt, int ldb, int fr, int fq) {
#pragma unroll
    for (int k0 = 0; k0 < K; k0 += 32) {
        const bf16x8 a = *(const bf16x8*)(A + fr * lda + k0 + fq * 8);
        const bf16x8 b = *(const bf16x8*)(Bt + fr * ldb + k0 + fq * 8);
        c = __builtin_amdgcn_mfma_f32_16x16x32_bf16(b, a, c, 0, 0, 0);
    }
    return c;
}

DEVINL void cvt_tile(const float* colp, int ld, int k0, int n0, bf16_t* dst, int ldd, char* smem, int lrow = -1) {
    float (*T)[257] = (float (*)[257])smem;
    const int t = tid_opaque(), nl = lrow >= 0 ? lrow : (t & 63), ks = t >> 6;
    const float* sp = colp + (size_t)(k0 + ks * 32) * ld;
    {
        float v[32];
#pragma unroll
        for (int i = 0; i < 32; ++i) v[i] = sp[(size_t)i * ld];
#pragma unroll
        for (int i = 0; i < 32; ++i) T[nl][ks * 32 + i] = v[i];
    }
    __syncthreads();
    const int n2 = t >> 3, kc = t & 7;
#pragma unroll
    for (int j = 0; j < 4; ++j) {
        const int k = j * 64 + kc * 8;
        u32x4 v;
        v.x = pk2(T[n2][k + 0], T[n2][k + 1]); v.y = pk2(T[n2][k + 2], T[n2][k + 3]);
        v.z = pk2(T[n2][k + 4], T[n2][k + 5]); v.w = pk2(T[n2][k + 6], T[n2][k + 7]);
        *(u32x4*)(dst + (size_t)(n0 + n2) * ldd + k0 + k) = v;
    }
    __syncthreads();
}

constexpr int NT_GU = 1024, NT_WD = 512;
DEVINL void moe_cvt_task(const Params& p, int layer, int tid, char* smem) {
    if (tid < NT_GU) {
        const int e = tid >> 5, rem = tid & 31, nb = rem >> 2, kb = rem & 3;
        const float* wg = p.moe_wg + (size_t)(layer * 32 + e) * 1024 * 256;
        const float* wu = p.moe_wu + (size_t)(layer * 32 + e) * 1024 * 256;
        const int nl = tid_opaque() & 63, isup = nl >> 5, ul = nl & 31;
        const int ub = (nb >> 2) * 128 + (nb & 3) * 32;
        const float* cp = (isup ? wu : wg) + ub + ul;
        const int lrow = (ul >> 2) * 8 + isup * 4 + (ul & 3);
        cvt_tile(cp, 256, kb * 256, nb * 64, p.wgu_t + (size_t)e * 512 * 1024, 1024, smem, lrow);
    } else {
        const int t2 = tid - NT_GU, e = t2 >> 4, nb = t2 & 15;
        const float* wd = p.moe_wd + (size_t)(layer * 32 + e) * 256 * 1024;
        cvt_tile(wd + nb * 64 + (tid_opaque() & 63), 1024, 0, nb * 64, p.wd_t + (size_t)e * 1024 * 256, 256, smem);
    }
}

constexpr int NT_MISC = 9, NT_MOD = 192, NT_IN0 = 128, NT_OUT0 = 64, NT_GLU = 16, NT_IN1 = 320, NT_OUT1 = 64, NT_POS = 64, NT_S5 = 64;
constexpr int T0_MOD = NT_MISC, T0_IN0 = T0_MOD + NT_MOD, T0_OUT0 = T0_IN0 + NT_IN0, T0_GLU = T0_OUT0 + NT_OUT0, T0_IN1 = T0_GLU + NT_GLU, T0_OUT1 = T0_IN1 + NT_IN1,
              T0_MOE = T0_OUT1 + NT_OUT1, T0_POS = T0_MOE + NT_GU + NT_WD, T0_S5 = T0_POS + NT_POS, T0_END = T0_S5 + NT_S5;

DEVINL void prologue_task(const Params& p, char* smem, int task) {
    const int t = tid_opaque();
    {
        if (task < T0_MOD) {
            if (task == 0) {
                for (int i = t; i < 1024; i += NTHR) p.lb[i] = sigmoidf_(p.hg_lb[1024 + i] - p.hg_lb[i]);
            } else {
                for (int i = (task - 1) * 8192 + t; i < task * 8192; i += NTHR) {
                    const int which = i >> 15, e = (i >> 10) & 31, k = i & 1023;
                    const float v = which ? p.ab_w_in[(size_t)k * 2080 + 1536 + e] : p.router_w[k * 32 + e];
                    const bf16_t hi = f2bf(v); const bf16_t lo = f2bf(v - bf2f(hi));
                    p.wrt[((size_t)(which * 2 + 0) * 32 + e) * 1024 + k] = hi;
                    p.wrt[((size_t)(which * 2 + 1) * 32 + e) * 1024 + k] = lo;
                }
            }
        } else if (task < T0_IN0) {
            float* sc = (float*)smem;
            float* red = sc + 9 * 1024;
            for (int i = t; i < 9 * 1024; i += NTHR) { const int rr = i >> 10, k = i & 1023; const float v = rr < 8 ? p.c[rr * 1024 + k] : p.c_ctx[k]; sc[i] = siluf_(v); }
            __syncthreads();
            const int tk = task - T0_MOD, l = tk / 96, c0 = (tk % 96) * 64, col = t & 63, kp = t >> 6;
            const float* wp = p.ada_w + ((size_t)l * 1024 + kp * 128) * 6144 + c0 + col;
            float acc[9];
#pragma unroll
            for (int rr = 0; rr < 9; ++rr) acc[rr] = 0.f;
#pragma unroll 1
            for (int k = 0; k < 128; k += 16) {
                float w16[16];
#pragma unroll
                for (int j = 0; j < 16; ++j) w16[j] = wp[(size_t)(k + j) * 6144];
#pragma unroll
                for (int rr = 0; rr < 9; ++rr) {
#pragma unroll
                    for (int j = 0; j < 16; j += 4) {
                        const f32x4 s4 = *(const f32x4*)&sc[rr * 1024 + kp * 128 + k + j];
                        acc[rr] += s4[0] * w16[j] + s4[1] * w16[j + 1] + s4[2] * w16[j + 2] + s4[3] * w16[j + 3];
                    }
                }
            }
#pragma unroll
            for (int rr = 0; rr < 9; ++rr) red[(kp * 9 + rr) * 64 + col] = acc[rr];
            __syncthreads();
            for (int o = t; o < 576; o += NTHR) {
                const int rr = o >> 6, cc = o & 63;
                float sv = p.ada_b[l * 6144 + c0 + cc];
#pragma unroll
                for (int q = 0; q < 8; ++q) sv += red[(q * 9 + rr) * 64 + cc];
                p.mod[((size_t)l * 9 + rr) * 6144 + c0 + cc] = sv;
            }
            __syncthreads();
        } else if (task < T0_OUT0) {
            const int tt = task - T0_IN0, nbk = tt >> 2, kb = tt & 3;
            const int n = nbk * 64 + (t & 63);
            const float* cp = p.ab_w_in + (n < 1536 ? n : n + 32);
            cvt_tile(cp, 2080, kb * 256, nbk * 64, p.wt_in0, 1024, smem);
        } else if (task < T0_GLU) {
            const int tt = task - T0_OUT0, nbk = tt >> 2, kb = tt & 3;
            cvt_tile(p.ab_w_out + nbk * 64 + (t & 63), 1024, kb * 256, nbk * 64, p.wt_out0, 1024, smem);
        } else if (task < T0_IN1) {
            const int tt = task - T0_GLU, nbk = tt >> 1, kb = tt & 1;
            cvt_tile(p.glu_w + nbk * 64 + (t & 63), 512, kb * 256, nbk * 64, p.glu_t, 512, smem);
        } else if (task < T0_OUT1) {
            const int tt = task - T0_IN1, nbk = tt >> 2, kb = tt & 3;
            cvt_tile(p.hg_w_in + nbk * 64 + (t & 63), 5120, kb * 256, nbk * 64, p.wt_in1, 1024, smem);
        } else if (task < T0_MOE) {
            const int tt = task - T0_OUT1, nbk = tt >> 2, kb = tt & 3;
            cvt_tile(p.hg_w_out + nbk * 64 + (t & 63), 1024, kb * 256, nbk * 64, p.wt_out1, 1024, smem);
        } else if (task < T0_POS) {
            moe_cvt_task(p, 0, task - T0_MOE, smem);
        } else if (task < T0_S5) {
            const int pi = task - T0_POS;
            const int j = t, jj = j & 255;
            const float omega = __expf(-9.210340371976184f * (float)jj * (1.0f / 256.0f));
            const float ang = (float)pi * omega;
            p.pos[pi * 512 + j] = (j < 256) ? sinf(ang) : cosf(ang);
        } else {
            const int tt = task - T0_S5, di = tt >> 5, g = tt & 31;
            const int pp = t & 63, hs = t >> 6;
            const float dt = __expf(p.s5_log_dt[di * 32 + g]);
            const float lr = p.s5_lam_re[(di * 32 + g) * 64 + pp], li = p.s5_lam_im[(di * 32 + g) * 64 + pp];
            const float mag = __expf(lr * dt);
            const float are = mag * cosf(li * dt), aim = mag * sinf(li * dt);
            const float den = lr * lr + li * li;
            const float fre = ((are - 1.0f) * lr + aim * li) / den;
            const float fim = (aim * lr - (are - 1.0f) * li) / den;
            if (hs == 0) {
                p.atab[((di * 32 + g) * 64 + pp) * 2 + 0] = are; p.atab[((di * 32 + g) * 64 + pp) * 2 + 1] = aim;
                float xr = are, xi = aim;
#pragma unroll
                for (int q = 0; q < 6; ++q) { const float nr = xr * xr - xi * xi, ni = 2.0f * xr * xi; xr = nr; xi = ni; }
                p.a64tab[((di * 32 + g) * 64 + pp) * 2 + 0] = xr; p.a64tab[((di * 32 + g) * 64 + pp) * 2 + 1] = xi;
            }
#pragma unroll
            for (int q = 0; q < 2; ++q) {
                const int h = hs * 2 + q;
                const float bre = p.s5_b_re[((size_t)((di * 32 + g) * 64 + pp)) * 16 + h], bim = p.s5_b_im[((size_t)((di * 32 + g) * 64 + pp)) * 16 + h];
                p.bbm[((size_t)((di * 32 + g) * 128 + pp)) * 16 + h] = f2bf(fre * bre - fim * bim);
                p.bbm[((size_t)((di * 32 + g) * 128 + 64 + pp)) * 16 + h] = f2bf(fre * bim + fim * bre);
                const float cre = p.s5_c_re[((size_t)((di * 32 + g) * 16 + h)) * 64 + pp], cim = p.s5_c_im[((size_t)((di * 32 + g) * 16 + h)) * 64 + pp];
                bf16_t* cm = p.cmt + ((size_t)(g * 16 + h)) * 256 + di * 128;
                cm[2 * pp] = f2bf(cre); cm[2 * pp + 1] = f2bf(-cim);
            }
        }
        if (task >= T0_S5) {
            const int tt2 = task - T0_S5, di2 = tt2 >> 5, g2 = tt2 & 31;
            const int pp = t & 63, tg = t >> 6;
            const float dt = __expf(p.s5_log_dt[di2 * 32 + g2]);
            const float lr = p.s5_lam_re[(di2 * 32 + g2) * 64 + pp], li = p.s5_lam_im[(di2 * 32 + g2) * 64 + pp];
            const float mag1 = __expf(lr * dt);
            const float are = mag1 * cosf(li * dt), aim = mag1 * sinf(li * dt);
            const float den = lr * lr + li * li;
            const float fre = ((are - 1.0f) * lr + aim * li) / den;
            const float fim = (aim * lr - (are - 1.0f) * li) / den;
            float bbr[16], bbi[16];
#pragma unroll
            for (int h = 0; h < 16; ++h) {
                const float bre = p.s5_b_re[((size_t)((di2 * 32 + g2) * 64 + pp)) * 16 + h], bim = p.s5_b_im[((size_t)((di2 * 32 + g2) * 64 + pp)) * 16 + h];
                bbr[h] = fre * bre - fim * bim; bbi[h] = fre * bim + fim * bre;
            }
#pragma unroll 1
            for (int i = 0; i < 8; ++i) {
                const int tk = tg * 8 + i;
                const float e = (float)(di2 ? tk : 63 - tk);
                const float mg = __expf(e * lr * dt);
                const float wr = mg * cosf(e * li * dt), wi = mg * sinf(e * li * dt);
                const int ks = tk >> 1;
#pragma unroll
                for (int hh = 0; hh < 2; ++hh) {
                    const int fq2 = ((tk & 1) << 1) | hh;
                    u32x4 vr, vi;
                    unsigned* pr = (unsigned*)&vr; unsigned* pi2 = (unsigned*)&vi;
#pragma unroll
                    for (int j2 = 0; j2 < 4; ++j2) {
                        const int h0 = hh * 8 + j2 * 2;
                        pr[j2] = cvt_pk_bf16(wr * bbr[h0] - wi * bbi[h0], wr * bbr[h0 + 1] - wi * bbi[h0 + 1]);
                        pi2[j2] = cvt_pk_bf16(wr * bbi[h0] + wi * bbr[h0], wr * bbi[h0 + 1] + wi * bbr[h0 + 1]);
                    }
                    *(u32x4*)(p.s5m + ((((size_t)(tt2 * 8 + (pp >> 4)) * 32 + ks) * 64 + fq2 * 16 + (pp & 15)) * 8)) = vr;
                    *(u32x4*)(p.s5m + ((((size_t)(tt2 * 8 + 4 + (pp >> 4)) * 32 + ks) * 64 + fq2 * 16 + (pp & 15)) * 8)) = vi;
                }
            }
        }
    }
}

template <bool B> struct BoolC { static constexpr bool value = B; };
DEVINL void group_span(int nq, int bid, int nb, int& q_lo, int& q_hi) {
    const int per = (nq + nb - 1) / nb;
    q_lo = bid * per; if (q_lo > nq) q_lo = nq;
    q_hi = q_lo + per; if (q_hi > nq) q_hi = nq;
}
constexpr int PRE_LD = 1028;

template <bool ISCTX>
DEVINL void pre2_stream(const Params& p, int bid, int nb) {
    const int t = tid_opaque(), w = sgpr(t >> 6), lane = t & 63;
    int nrows, q_lo = 0;
    if (ISCTX) { const int gw = bid * 8 + w, nw = nb * 8; nrows = (gw < NBATCH * CTXL) ? ((NBATCH * CTXL - 1 - gw) / nw + 1) : 0; }
    else {
        constexpr int NQ = NBATCH * 256;
        const int per = (NQ + nb - 1) / nb;
        q_lo = bid * per;
        const int q_hi = (q_lo + per < NQ) ? (q_lo + per) : NQ;
        const int ng = q_hi - q_lo - w;
        nrows = (ng > 0) ? (((ng + 7) >> 3) * 16) : 0;
    }
    nrows = sgpr(nrows);
    if (nrows > 0) {
        auto row_at = [&](int n) {
            if (ISCTX) { const int cr = bid * 8 + w + n * (nb * 8); return sgpr((cr >> 8) * RPB + (cr & 255)); }
            const int q = q_lo + w + ((n >> 4) << 3);
            return sgpr(((q >> 8) * 272 + 16 + (q & 255)) * 16 + (n & 15));
        };
        f32x4 g4[4];
#pragma unroll
        for (int i = 0; i < 4; ++i) g4[i] = *(const f32x4*)(p.norm_mix + 1024 + lane * 4 + i * 256);
        f32x4 sh4[4], sc4[4], gy4[4], gs4[4];
        int mb_cur = -1;
        f32x4 vA[4], vB[4]; u32x2 peA[4], peB[4], yA[4], sA[4], yB[4], sB[4];
        auto issue = [&](int r, int slot, f32x4 (&v)[4], u32x2 (&pe)[4], u32x2 (&y)[4], u32x2 (&sv)[4]) {
            const int b = r / RPB, j = r - b * RPB;
            if (ISCTX) {
#pragma unroll
                for (int i = 0; i < 4; ++i) v[i] = *(const f32x4*)(p.cx + (size_t)(b * CTXL + j) * D + lane * 4 + i * 256);
            } else {
#pragma unroll
                for (int i = 0; i < 4; ++i) pe[i] = *(const u32x2*)(p.xb + (size_t)(b * SEQ + (j - CTXL)) * D + lane * 4 + i * 256);
            }
#pragma unroll
            for (int i = 0; i < 4; ++i) sv[i] = *(const u32x2*)(p.y2 + (size_t)slot * D + lane * 4 + i * 256);
            if (!ISCTX) {
#pragma unroll
                for (int i = 0; i < 4; ++i) y[i] = *(const u32x2*)(p.Y + (size_t)r * D + lane * 4 + i * 256);
            }
        };
        int slot_n = p.sor[row_at(0)];
        issue(row_at(0), sgpr(slot_n), vA, peA, yA, sA);
        slot_n = (nrows > 1) ? p.sor[row_at(1)] : 0;
        for (int n = 0; n < nrows; ++n) {
            const int r = row_at(n);
            int slot_nn = 0;
            if (n + 2 < nrows) slot_nn = p.sor[row_at(n + 2)];
            if (n + 1 < nrows) issue(row_at(n + 1), sgpr(slot_n), vB, peB, yB, sB);
            const int b = r / RPB, j = r - b * RPB;
            const int mb = ISCTX ? 8 : b;
            if (mb != mb_cur) {
                mb_cur = mb;
                const float* modv = p.mod + ((size_t)(9 + mb)) * 6144;
                const float* gyv = p.mod + ((size_t)mb) * 6144 + 2048;
                const float* gsv = p.mod + ((size_t)mb) * 6144 + 5120;
#pragma unroll
                for (int i = 0; i < 4; ++i) {
                    const int c = lane * 4 + i * 256;
                    sh4[i] = *(const f32x4*)(modv + c); sc4[i] = *(const f32x4*)(modv + 1024 + c);
                    gy4[i] = *(const f32x4*)(gyv + c); gs4[i] = *(const f32x4*)(gsv + c);
                }
            }
            f32x4 v[4];
#pragma unroll
            for (int i = 0; i < 4; ++i) {
                if (ISCTX) v[i] = vA[i];
                else {
                    const u32x2 xv = peA[i];
                    v[i][0] = bf2f((bf16_t)(xv.x & 0xffffu)); v[i][1] = bf2f((bf16_t)(xv.x >> 16)); v[i][2] = bf2f((bf16_t)(xv.y & 0xffffu)); v[i][3] = bf2f((bf16_t)(xv.y >> 16));
                    const u32x2 ub = yA[i];
                    v[i][0] += gy4[i][0] * bf2f((bf16_t)(ub.x & 0xffffu)); v[i][1] += gy4[i][1] * bf2f((bf16_t)(ub.x >> 16));
                    v[i][2] += gy4[i][2] * bf2f((bf16_t)(ub.y & 0xffffu)); v[i][3] += gy4[i][3] * bf2f((bf16_t)(ub.y >> 16));
                }
                const u32x2 us = sA[i];
                v[i][0] += gs4[i][0] * bf2f((bf16_t)(us.x & 0xffffu)); v[i][1] += gs4[i][1] * bf2f((bf16_t)(us.x >> 16));
                v[i][2] += gs4[i][2] * bf2f((bf16_t)(us.y & 0xffffu)); v[i][3] += gs4[i][3] * bf2f((bf16_t)(us.y >> 16));
            }
#pragma unroll
            for (int i = 0; i < 4; ++i) {
                if (ISCTX) *(f32x4*)(p.cx + (size_t)(b * CTXL + j) * D + lane * 4 + i * 256) = v[i];
                else *(u32x2*)(p.xb + (size_t)(b * SEQ + (j - CTXL)) * D + lane * 4 + i * 256) = pk4(v[i]);
            }
            float ss = 0.f;
#pragma unroll
            for (int i = 0; i < 4; ++i) ss += v[i][0] * v[i][0] + v[i][1] * v[i][1] + v[i][2] * v[i][2] + v[i][3] * v[i][3];
#pragma unroll
            for (int o = 32; o >= 1; o >>= 1) ss += __shfl_xor(ss, o);
            const float rstd = rsqrtf(ss * (1.0f / 1024.0f) + EPS);
#pragma unroll
            for (int i = 0; i < 4; ++i) {
                f32x4 hv;
#pragma unroll
                for (int qq = 0; qq < 4; ++qq) hv[qq] = v[i][qq] * rstd * g4[i][qq] * (1.0f + sc4[i][qq]) + sh4[i][qq];
                *(u32x2*)(p.H + (size_t)r * D + lane * 4 + i * 256) = pk4(hv);
            }
#pragma unroll
            for (int i = 0; i < 4; ++i) { vA[i] = vB[i]; peA[i] = peB[i]; yA[i] = yB[i]; sA[i] = sB[i]; }
            slot_n = slot_nn;
        }
    }
}
template <int MODE>
DEVINL void phase_pre(const Params& p, char* smem, int bid, int nb) {
    constexpr bool GEMV = (MODE == 0 || MODE == 1 || MODE == 3);
    constexpr int L = (MODE >= 2) ? 1 : 0;
    constexpr bool FFN = (MODE == 1 || MODE == 3);
    float* hrow = (float*)smem;
    float* part = hrow + 16 * PRE_LD;
    float* logit = part + 8 * 16 * 32;
    int* lcnt = (int*)(logit + 512);
    float* rbl = (float*)(lcnt + 64);
    static_assert((16 * PRE_LD + 8 * 16 * 32 + 512 + 64 + 32) * 4 <= LDS_BYTES, "pre lds");
    const int t = tid_opaque(), w = t >> 6, lane = t & 63, fr = lane & 15, fq = lane >> 4;
    bf16x8 bh[4][2], bl[4][2];
    if (GEMV) {
        const bf16_t* wt = p.wrt + (size_t)(MODE == 0 ? 1 : 0) * 2 * 32 * 1024;
#pragma unroll
        for (int ks = 0; ks < 4; ++ks)
#pragma unroll
            for (int nt = 0; nt < 2; ++nt) {
                const size_t off = (size_t)(nt * 16 + fr) * 1024 + w * 128 + ks * 32 + fq * 8;
                bh[ks][nt] = *(const bf16x8*)(wt + off);
                bl[ks][nt] = *(const bf16x8*)(wt + 32 * 1024 + off);
            }
    }
    if (FFN) { if (t < 64) lcnt[t] = 0; if (t < 32) rbl[t] = p.router_bias[t]; }
    __syncthreads();
    const float* gain = (FFN ? p.norm_ffn : p.norm_mix) + L * 1024;
    if constexpr (MODE == 2) {
        pre2_stream<false>(p, bid, nb);
        pre2_stream<true>(p, bid, nb);
    } else {
    constexpr bool UPD_Y = (MODE != 0);
    constexpr bool FROM_X = (MODE == 0);
    f32x4 g4[4];
#pragma unroll
    for (int i = 0; i < 4; ++i) g4[i] = *(const f32x4*)(gain + lane * 4 + i * 256);
    auto run_kind = [&](auto CT) {
        constexpr bool ISCTX = decltype(CT)::value;
        constexpr int NQ = ISCTX ? NBATCH * 16 : NBATCH * 256;
        const int t = tid_opaque(), w = t >> 6, lane = t & 63, fr = lane & 15, fq = lane >> 4;
        auto ug_of = [&](int q) { return ISCTX ? ((q >> 4) * 272 + (q & 15)) : ((q >> 8) * 272 + 16 + (q & 255)); };
        auto row_of = [&](int ug, int rw) { return sgpr(ug * 16 + w * 2 + rw); };
        constexpr bool XB_SRC = (!ISCTX && !FROM_X);
        f32x4 vcur[2][4]; u32x2 ycur[2][4], xcur[2][4];
        f32x4 sh4[4], sc4[4], gy4[4], pe[2][4];
        auto issue = [&](int ug) {
#pragma unroll
            for (int rw = 0; rw < 2; ++rw) {
                const int r = row_of(ug, rw);
                const int b = r / RPB, j = r - b * RPB;
                const float* src;
                if (ISCTX) src = (MODE == 0) ? (p.ctx + (size_t)(b * CTXL + j) * D) : (p.cx + (size_t)(b * CTXL + j) * D);
                else src = p.x + (size_t)(b * SEQ + (j - CTXL)) * D;
                if (XB_SRC) {
#pragma unroll
                    for (int i = 0; i < 4; ++i) xcur[rw][i] = *(const u32x2*)(p.xb + (size_t)(b * SEQ + (j - CTXL)) * D + lane * 4 + i * 256);
                } else {
#pragma unroll
                    for (int i = 0; i < 4; ++i) vcur[rw][i] = *(const f32x4*)(src + lane * 4 + i * 256);
                }
                if (UPD_Y && !ISCTX) {
#pragma unroll
                    for (int i = 0; i < 4; ++i) ycur[rw][i] = *(const u32x2*)(p.Y + (size_t)r * D + lane * 4 + i * 256);
                }
            }
        };
        auto issue_mods = [&](int ug) {
            const int r0 = row_of(ug, 0);
            const int b0 = r0 / RPB, j0 = r0 - b0 * RPB;
            const int mb = ISCTX ? 8 : b0;
            const float* gyv = p.mod + ((size_t)((MODE == 3 ? 1 : 0) * 9 + mb)) * 6144 + 2048;
            if (UPD_Y && !ISCTX) {
#pragma unroll
                for (int i = 0; i < 4; ++i) gy4[i] = *(const f32x4*)(gyv + lane * 4 + i * 256);
            }
            if (FROM_X && !ISCTX) {
#pragma unroll
                for (int rw = 0; rw < 2; ++rw) {
                    const int n = j0 + rw - CTXL, prow = n >> 6, pcol = n & 63;
#pragma unroll
                    for (int i = 0; i < 4; ++i) {
                        const int c = lane * 4 + i * 256;
                        pe[rw][i] = (c < 512) ? *(const f32x4*)(p.pos + prow * 512 + c) : *(const f32x4*)(p.pos + pcol * 512 + (c - 512));
                    }
                }
            }
        };
        int q, q_hi;
        group_span(NQ, bid, nb, q, q_hi);
        if (q < q_hi) { issue(ug_of(q)); issue_mods(ug_of(q)); }
        for (; q < q_hi; ++q) {
            const int ug = ug_of(q);
            {
                const int r0 = row_of(ug, 0);
                const int mb = ISCTX ? 8 : (r0 / RPB);
                const float* modv = p.mod + ((size_t)(L * 9 + mb)) * 6144 + (FFN ? 3072 : 0);
#pragma unroll
                for (int i = 0; i < 4; ++i) { sh4[i] = *(const f32x4*)(modv + lane * 4 + i * 256); sc4[i] = *(const f32x4*)(modv + 1024 + lane * 4 + i * 256); }
            }
#pragma unroll
            for (int rw = 0; rw < 2; ++rw) {
                const int lrow = w * 2 + rw;
                const int r = row_of(ug, rw);
                const int b = r / RPB, j = r - b * RPB;
                f32x4 v[4];
                if (XB_SRC) {
#pragma unroll
                    for (int i = 0; i < 4; ++i) {
                        const u32x2 xv = xcur[rw][i];
                        v[i][0] = bf2f((bf16_t)(xv.x & 0xffffu)); v[i][1] = bf2f((bf16_t)(xv.x >> 16)); v[i][2] = bf2f((bf16_t)(xv.y & 0xffffu)); v[i][3] = bf2f((bf16_t)(xv.y >> 16));
                    }
                } else {
#pragma unroll
                    for (int i = 0; i < 4; ++i) v[i] = vcur[rw][i];
                }
                if (FROM_X && !ISCTX) {
#pragma unroll
                    for (int i = 0; i < 4; ++i) { v[i] += pe[rw][i]; *(u32x2*)(p.xb + (size_t)(b * SEQ + (j - CTXL)) * D + lane * 4 + i * 256) = pk4(v[i]); }
                }
                if (UPD_Y && !ISCTX) {
#pragma unroll
                    for (int i = 0; i < 4; ++i) {
                        const u32x2 ub = ycur[rw][i];
                        v[i][0] += gy4[i][0] * bf2f((bf16_t)(ub.x & 0xffffu)); v[i][1] += gy4[i][1] * bf2f((bf16_t)(ub.x >> 16));
                        v[i][2] += gy4[i][2] * bf2f((bf16_t)(ub.y & 0xffffu)); v[i][3] += gy4[i][3] * bf2f((bf16_t)(ub.y >> 16));
                    }
                }
                if (MODE == 0 && ISCTX) {
                    float* res = p.cx + (size_t)(b * CTXL + j) * D;
#pragma unroll
                    for (int i = 0; i < 4; ++i) *(f32x4*)(res + lane * 4 + i * 256) = v[i];
                }
                float ss = 0.f;
#pragma unroll
                for (int i = 0; i < 4; ++i) ss += v[i][0] * v[i][0] + v[i][1] * v[i][1] + v[i][2] * v[i][2] + v[i][3] * v[i][3];
#pragma unroll
                for (int o = 32; o >= 1; o >>= 1) ss += __shfl_xor(ss, o);
                const float rstd = rsqrtf(ss * (1.0f / 1024.0f) + EPS);
#pragma unroll
                for (int i = 0; i < 4; ++i) {
                    const int c = lane * 4 + i * 256;
                    f32x4 hv;
#pragma unroll
                    for (int qq = 0; qq < 4; ++qq) hv[qq] = v[i][qq] * rstd * g4[i][qq] * (1.0f + sc4[i][qq]) + sh4[i][qq];
                    *(u32x2*)(p.H + (size_t)r * D + c) = pk4(hv);
                    *(f32x4*)(hrow + lrow * PRE_LD + c) = hv;
                }
            }
            if (q + 1 < q_hi) issue(ug_of(q + 1));
            {
            const int rg = ug;
            lds_sync();
            f32x4 c0 = (f32x4){0.f, 0.f, 0.f, 0.f}, c1 = c0;
#pragma unroll
            for (int ks = 0; ks < 4; ++ks) {
                const float* hp = hrow + fr * PRE_LD + w * 128 + ks * 32 + fq * 8;
                const f32x4 x0 = *(const f32x4*)hp, x1 = *(const f32x4*)(hp + 4);
                u32x4 hi, lo;
                hi.x = cvt_pk_bf16(x0[0], x0[1]); hi.y = cvt_pk_bf16(x0[2], x0[3]); hi.z = cvt_pk_bf16(x1[0], x1[1]); hi.w = cvt_pk_bf16(x1[2], x1[3]);
                lo.x = cvt_pk_bf16(x0[0] - __uint_as_float(hi.x << 16), x0[1] - __uint_as_float(hi.x & 0xffff0000u));
                lo.y = cvt_pk_bf16(x0[2] - __uint_as_float(hi.y << 16), x0[3] - __uint_as_float(hi.y & 0xffff0000u));
                lo.z = cvt_pk_bf16(x1[0] - __uint_as_float(hi.z << 16), x1[1] - __uint_as_float(hi.z & 0xffff0000u));
                lo.w = cvt_pk_bf16(x1[2] - __uint_as_float(hi.w << 16), x1[3] - __uint_as_float(hi.w & 0xffff0000u));
                const bf16x8 ah = __builtin_bit_cast(bf16x8, hi), al = __builtin_bit_cast(bf16x8, lo);
                c0 = __builtin_amdgcn_mfma_f32_16x16x32_bf16(bh[ks][0], ah, c0, 0, 0, 0);
                c0 = __builtin_amdgcn_mfma_f32_16x16x32_bf16(bl[ks][0], ah, c0, 0, 0, 0);
                c0 = __builtin_amdgcn_mfma_f32_16x16x32_bf16(bh[ks][0], al, c0, 0, 0, 0);
                c1 = __builtin_amdgcn_mfma_f32_16x16x32_bf16(bh[ks][1], ah, c1, 0, 0, 0);
                c1 = __builtin_amdgcn_mfma_f32_16x16x32_bf16(bl[ks][1], ah, c1, 0, 0, 0);
                c1 = __builtin_amdgcn_mfma_f32_16x16x32_bf16(bh[ks][1], al, c1, 0, 0, 0);
            }
            *(f32x4*)&part[(w * 16 + fr) * 32 + fq * 4] = c0;
            *(f32x4*)&part[(w * 16 + fr) * 32 + 16 + fq * 4] = c1;
            lds_sync();
            if (q + 1 < q_hi) issue_mods(ug_of(q + 1));
            {
                const int row = t >> 5, e2 = t & 31;
                float s = 0.f;
#pragma unroll
                for (int q = 0; q < 8; ++q) s += part[(q * 16 + row) * 32 + e2];
                if (MODE == 0) p.AF[(size_t)(rg * 16 + row) * 32 + e2] = s;
                else logit[row * 32 + e2] = s;
            }
            if (FFN) {
                lds_sync();
                if (t < 128) {
                    const int row = t >> 3, g = t & 7;
                    float m1 = -3.0e38f, m2 = -3.0e38f, a1 = 0.f, a2 = 0.f; int i1 = 0, i2 = 0;
                    const f32x4 lg = *(const f32x4*)&logit[row * 32 + g * 4];
                    const f32x4 rbv = *(const f32x4*)&rbl[g * 4];
#pragma unroll
                    for (int e = 0; e < 4; ++e) {
                        const float a = sigmoidf_(lg[e]);
                        const float sv = a + rbv[e];
                        if (sv > m1) { m2 = m1; i2 = i1; a2 = a1; m1 = sv; i1 = e; a1 = a; }
                        else if (sv > m2) { m2 = sv; i2 = e; a2 = a; }
                    }
                    float best = m1 + m2; int bg = g, pk = i1 | (i2 << 2); float ba1 = a1, ba2 = a2;
#pragma unroll
                    for (int o = 1; o < 8; o <<= 1) {
                        const float ob = __shfl_xor(best, o); const int og = __shfl_xor(bg, o), opk = __shfl_xor(pk, o);
                        const float oa1 = __shfl_xor(ba1, o), oa2 = __shfl_xor(ba2, o);
                        const bool take = (ob > best) || (ob == best && og < bg);
                        best = take ? ob : best; bg = take ? og : bg; pk = take ? opk : pk; ba1 = take ? oa1 : ba1; ba2 = take ? oa2 : ba2;
                    }
                    if (g == 0) {
                        int rr;
                        rr = rg * 16 + row;
                        const int bi1 = pk & 3, bi2 = pk >> 2;
                        const float inv = 1.0f / (ba1 + ba2);
                        const float w1 = ba1 * inv, w2 = ba2 * inv;
                        const int lo = bi1 < bi2 ? bi1 : bi2, hi = bi1 < bi2 ? bi2 : bi1;
                        const float wlo = bi1 < bi2 ? w1 : w2, whi = bi1 < bi2 ? w2 : w1;
                        const int pair = (lo == 0) ? (hi - 1) : (lo == 1 ? (hi + 1) : 5);
                        const int bucket = bg * 6 + pair;
                        float4 rec; rec.x = __int_as_float(bucket); rec.y = wlo; rec.z = whi; rec.w = 0.f;
                        p.RT[rr] = rec;
                        atomicAdd(&lcnt[bucket], 1);
                    }
                }
            }
            lds_sync();
            }
        }
    };
    run_kind(BoolC<false>{});
    if (MODE != 3) run_kind(BoolC<true>{});
    }
    if (FFN) {
        __syncthreads();
        if (t < 48) p.blkcnt[((size_t)L * 256 + bid) * 48 + t] = lcnt[t];
    }
    if (MODE == 3) {
        __syncthreads();
        for (int task = bid; task < NT_GU + NT_WD; task += nb) moe_cvt_task(p, 1, task, smem);
    }
}

struct GemmSmem { bf16_t A[2][128][72]; bf16_t B[2][256][72]; };
static_assert(sizeof(GemmSmem) <= LDS_BYTES, "gemm lds");

template <int MM, int NN, class Epi>
DEVINL void gemm_tile(const bf16_t* __restrict__ A, int lda, const int* __restrict__ rowlist, int m0, int mvalid,
                      const bf16_t* __restrict__ Bt0, const bf16_t* __restrict__ Bt1, int ldb, int kseg, int K, Epi& epi, char* smem) {
    GemmSmem& S = *(GemmSmem*)smem;
    constexpr int AI = MM / 2;
    static_assert(MM == 2 || MM == 4, "tile rows");
    const int t = tid_opaque(), w = t >> 6, lane = t & 63, fr = lane & 15, fq = lane >> 4, wr = w >> 2, wc = w & 3;
    const int ch = t & 7, rr = t >> 3;
    const bf16_t* ap[AI];
#pragma unroll
    for (int i = 0; i < AI; ++i) {
        const int ri = rr + i * 64, gi = ri < mvalid ? ri : 0;
        const int grow = rowlist ? rowlist[m0 + gi] : (m0 + gi);
        ap[i] = A + (size_t)grow * lda + ch * 8;
    }
    u32x4 ra0[AI], rb0[NN], ra1[AI], rb1[NN];
    f32x4 acc[MM][NN];
#pragma unroll
    for (int m = 0; m < MM; ++m)
#pragma unroll
        for (int n = 0; n < NN; ++n) acc[m][n] = (f32x4){0.f, 0.f, 0.f, 0.f};
    const int nk = K >> 6;
#define GT_GLOAD(kt, RA, RB) do { const int _k0 = (kt) * 64; \
        _Pragma("unroll") for (int i = 0; i < AI; ++i) RA[i] = *(const u32x4*)(ap[i] + _k0); \
        const bf16_t* _bb = (_k0 < kseg) ? (Bt0 + _k0) : (Bt1 + (_k0 - kseg)); \
        _Pragma("unroll") for (int i = 0; i < NN; ++i) RB[i] = *(const u32x4*)(_bb + (size_t)(rr + i * 64) * ldb + ch * 8); } while (0)
#define GT_SSTORE(buf, RA, RB) do { \
        _Pragma("unroll") for (int i = 0; i < AI; ++i) *(u32x4*)&S.A[buf][rr + i * 64][ch * 8] = RA[i]; \
        _Pragma("unroll") for (int i = 0; i < NN; ++i) *(u32x4*)&S.B[buf][rr + i * 64][ch * 8] = RB[i]; } while (0)
#define GT_MMA(cur) do { \
        _Pragma("unroll") for (int kk = 0; kk < 2; ++kk) { \
            bf16x8 a[MM], b[NN]; \
            _Pragma("unroll") for (int m = 0; m < MM; ++m) a[m] = *(const bf16x8*)&S.A[cur][wr * (16 * MM) + m * 16 + fr][kk * 32 + fq * 8]; \
            _Pragma("unroll") for (int n = 0; n < NN; ++n) b[n] = *(const bf16x8*)&S.B[cur][wc * (16 * NN) + n * 16 + fr][kk * 32 + fq * 8]; \
            _Pragma("unroll") for (int m = 0; m < MM; ++m) \
                _Pragma("unroll") for (int n = 0; n < NN; ++n) acc[m][n] = __builtin_amdgcn_mfma_f32_16x16x32_bf16(b[n], a[m], acc[m][n], 0, 0, 0); } } while (0)
    GT_GLOAD(0, ra0, rb0);
    GT_SSTORE(0, ra0, rb0);
    __syncthreads();
    GT_GLOAD(1, ra1, rb1);
    for (int kt = 0; kt < nk; kt += 2) {
        if (kt + 2 < nk) GT_GLOAD(kt + 2, ra0, rb0);
        GT_MMA(0);
        GT_SSTORE(1, ra1, rb1);
        __syncthreads();
        if (kt + 3 < nk) GT_GLOAD(kt + 3, ra1, rb1);
        GT_MMA(1);
        if (kt + 2 < nk) GT_SSTORE(0, ra0, rb0);
        __syncthreads();
    }
#undef GT_GLOAD
#undef GT_SSTORE
#undef GT_MMA
    epi(acc, wr * (16 * MM), wc * (16 * NN), fr, fq);
}

struct EpiP0 {
    bf16_t* P; int m0, n0;
    template <int MM, int NN>
    DEVINL void operator()(const f32x4 (&acc)[MM][NN], int mb, int nbs, int fr, int fq) const {
        const float sc = (n0 < 256) ? 0.125f : 1.0f;
#pragma unroll
        for (int m = 0; m < MM; ++m) {
            bf16_t* rp = P + (size_t)(m0 + mb + m * 16 + fr) * 2048 + n0 + nbs + fq * 4;
#pragma unroll
            for (int n = 0; n < NN; ++n) *(u32x2*)(rp + n * 16) = pk4(acc[m][n] * sc);
        }
    }
};
struct EpiP1 {
    bf16_t* P; const float* lb; int m0, n0;
    template <int MM, int NN>
    DEVINL void operator()(const f32x4 (&acc)[MM][NN], int mb, int nbs, int fr, int fq) const {
        const int cb = n0 >> 10;
#pragma unroll
        for (int m = 0; m < MM; ++m) {
            bf16_t* rp = P + (size_t)(m0 + mb + m * 16 + fr) * 5120 + n0 + nbs + fq * 4;
#pragma unroll
            for (int n = 0; n < NN; ++n) {
                const f32x4 a = acc[m][n];
                u32x2 o;
                if (cb == 1 || cb == 2) {
                    const int cc = ((n0 + nbs + n * 16 + fq * 4) & 1023);
                    const f32x4 l4 = *(const f32x4*)(lb + cc);
                    unsigned short hv[4];
#pragma unroll
                    for (int j = 0; j < 4; ++j) hv[j] = f2h((1.0f - l4[j]) * sigmoidf_(-a[j]));
                    o.x = (unsigned)hv[0] | ((unsigned)hv[1] << 16); o.y = (unsigned)hv[2] | ((unsigned)hv[3] << 16);
                } else if (cb == 0 || cb == 4) {
                    f32x4 s;
#pragma unroll
                    for (int j = 0; j < 4; ++j) s[j] = siluf_(a[j]);
                    o = pk4(s);
                } else o = pk4(a);
                *(u32x2*)(rp + n * 16) = o;
            }
        }
    }
};
struct EpiGlu {
    bf16_t* CAT; const bf16_t* s5a; const float* gb; int m0, n0;
    template <int MM, int NN>
    DEVINL void operator()(const f32x4 (&acc)[MM][NN], int mb, int nbs, int fr, int fq) const {
        f32x4 b4[NN];
#pragma unroll
        for (int n = 0; n < NN; ++n) b4[n] = *(const f32x4*)(gb + n0 + nbs + n * 16 + fq * 4);
        u32x2 av[MM][NN];
#pragma unroll
        for (int m = 0; m < MM; ++m)
#pragma unroll
            for (int n = 0; n < NN; ++n) av[m][n] = *(const u32x2*)(s5a + (size_t)(m0 + mb + m * 16 + fr) * 512 + n0 + nbs + n * 16 + fq * 4);
#pragma unroll
        for (int m = 0; m < MM; ++m) {
            const size_t row = (size_t)(m0 + mb + m * 16 + fr);
#pragma unroll
            for (int n = 0; n < NN; ++n) {
                const int col = n0 + nbs + n * 16 + fq * 4;
                f32x4 o;
                o[0] = bf2f((bf16_t)(av[m][n].x & 0xffff)) * sigmoidf_(acc[m][n][0] + b4[n][0]);
                o[1] = bf2f((bf16_t)(av[m][n].x >> 16)) * sigmoidf_(acc[m][n][1] + b4[n][1]);
                o[2] = bf2f((bf16_t)(av[m][n].y & 0xffff)) * sigmoidf_(acc[m][n][2] + b4[n][2]);
                o[3] = bf2f((bf16_t)(av[m][n].y >> 16)) * sigmoidf_(acc[m][n][3] + b4[n][3]);
                *(u32x2*)(CAT + row * 1024 + 512 + col) = pk4(o);
            }
        }
    }
};
struct EpiOut {
    const Params* p; const float* gate; int m0, n0;
    template <int MM, int NN>
    DEVINL void operator()(const f32x4 (&acc)[MM][NN], int mb, int nbs, int fr, int fq) const {
        const float* gp = gate + (size_t)8 * 6144;
        f32x4 g4[NN];
#pragma unroll
        for (int n = 0; n < NN; ++n) g4[n] = *(const f32x4*)(gp + n0 + nbs + n * 16 + fq * 4);
        f32x4 x4[MM][NN];
#pragma unroll
        for (int m = 0; m < MM; ++m) {
            const float* rp = resid_row(*p, m0 + mb + m * 16 + fr);
#pragma unroll
            for (int n = 0; n < NN; ++n) x4[m][n] = *(const f32x4*)(rp + n0 + nbs + n * 16 + fq * 4);
        }
#pragma unroll
        for (int m = 0; m < MM; ++m) {
            float* rp = resid_row(*p, m0 + mb + m * 16 + fr);
#pragma unroll
            for (int n = 0; n < NN; ++n) *(f32x4*)(rp + n0 + nbs + n * 16 + fq * 4) = x4[m][n] + g4[n] * acc[m][n];
        }
    }
};

struct EpiY {
    bf16_t* O; int m0, n0;
    template <int MM, int NN>
    DEVINL void operator()(const f32x4 (&acc)[MM][NN], int mb, int nbs, int fr, int fq) const {
#pragma unroll
        for (int m = 0; m < MM; ++m) {
            bf16_t* rp = O + (size_t)(m0 + mb + m * 16 + fr) * 1024 + n0 + nbs + fq * 4;
#pragma unroll
            for (int n = 0; n < NN; ++n) *(u32x2*)(rp + n * 16) = pk4(acc[m][n]);
        }
    }
};

namespace pg8 {
#define PG8_LAS __attribute__((address_space(3)))
constexpr int BM = 256, BK = 64, HALF = 128, HTB = HALF * BK * 2, STAGE_BYTES = 8 * HTB, NXCD = 8, WGM = 8;
DEVINL int lds_byte(int r, int c) { const int st = (r >> 4) * 2 + (c >> 5), rr = r & 15, cc = c & 31, ob = rr * 64 + cc * 2; return st * 1024 + (ob ^ (((ob >> 9) & 1) << 5)); }
DEVINL void stage_rc(int b, int& R_, int& C_) { const int st = b / 1024, sb = b % 1024, swz = sb ^ (((sb >> 9) & 1) << 5); R_ = (st >> 1) * 16 + swz / 64; C_ = (st & 1) * 32 + (swz % 64) / 2; }
DEVINL int perm32(int rho) { const int n = rho >> 4, i = rho & 15; return 8 * (i >> 2) + 4 * n + (i & 3); }
struct Unit { int pm, pn; const char* A; const char* B0; const char* B1; int mvalid, aux; };

template <class Epi, class Sched>
DEVINL void gemm_phase(PG8_LAS unsigned char* lds, const Sched& S, const Epi& E) {
    const int tid = tid_opaque(), wid = __builtin_amdgcn_readfirstlane(tid >> 6), lane = tid & 63, wr = wid >> 2, wc = wid & 3, fr = lane & 15, fq = lane >> 4;
    const int K = S.K, nt = K / BK, ldb = S.ldb, ksplit = S.ksplit;
    unsigned voffA[2], voffB[2];
#pragma unroll
    for (int i = 0; i < 2; ++i) { int R_, C_; stage_rc(tid * 16 + i * 8192, R_, C_); const int Rb = Epi::PERM ? ((R_ & ~31) + perm32(R_ & 31)) : R_;
        voffA[i] = (unsigned)(R_ * K + C_) * 2u; voffB[i] = (unsigned)(Rb * ldb + C_) * 2u; }
    const size_t kstep = (size_t)(BK * 2);
    const size_t hstepA = (size_t)HALF * K * 2, hstepB = (size_t)HALF * ldb * 2;
    const unsigned ldsw = (unsigned)wid * 1024u;
    const int aoff = lds_byte(wr * 64 + fr, fq * 8), boff = lds_byte(wc * 32 + fr, fq * 8);
    unsigned va[2][2], vn[2][2];
    auto gather_offs = [&](const Unit& u, unsigned (&v)[2][2]) {
#pragma unroll
        for (int h = 0; h < 2; ++h)
#pragma unroll
            for (int i = 0; i < 2; ++i) { int R_, C_; stage_rc(tid * 16 + i * 8192, R_, C_); v[h][i] = (unsigned)(S.a_row(u, h * HALF + R_) * K + C_) * 2u; }
    };
#define PG8_STAGE_A(bufoff, base, h, usenext) do { if constexpr (Sched::GATHER) { \
        unsigned _v[2] = {(usenext) ? vn[h][0] : va[h][0], (usenext) ? vn[h][1] : va[h][1]}; PG8_STAGE(bufoff, base, _v); \
    } else { PG8_STAGE(bufoff, (base) + (h) * hstepA, voffA); } } while (0)
#define PG8_SA(b, h) (((b) * 2 + (h)) * HTB)
#define PG8_SB(b, h) ((4 + (b) * 2 + (h)) * HTB)
#define PG8_STAGE(bufoff, gbase, voff) do { _Pragma("unroll") for (int _i = 0; _i < 2; ++_i) \
        __builtin_amdgcn_global_load_lds((const unsigned*)((const char*)(gbase) + (voff)[_i]), (PG8_LAS unsigned*)(lds + (bufoff) + ldsw + _i * 8192), 16, 0, 0); } while (0)
#define PG8_LDA(dst, b, h) do { _Pragma("unroll") for (int m = 0; m < 4; ++m) _Pragma("unroll") for (int k = 0; k < 2; ++k) dst[m][k] = *(const PG8_LAS bf16x8*)(lds + PG8_SA(b, h) + aoff + m * 2048 + k * 1024); } while (0)
#define PG8_LDB(dst, b, h) do { _Pragma("unroll") for (int n = 0; n < 2; ++n) _Pragma("unroll") for (int k = 0; k < 2; ++k) dst[n][k] = *(const PG8_LAS bf16x8*)(lds + PG8_SB(b, h) + boff + n * 2048 + k * 1024); } while (0)
#define PG8_MMA(ai, bj, At, Bt) do { __builtin_amdgcn_s_setprio(1); _Pragma("unroll") for (int m = 0; m < 4; ++m) _Pragma("unroll") for (int n = 0; n < 2; ++n) _Pragma("unroll") for (int k = 0; k < 2; ++k) \
        acc[ai][bj][m][n] = __builtin_amdgcn_mfma_f32_16x16x32_bf16(Bt[n][k], At[m][k], acc[ai][bj][m][n], 0, 0, 0); __builtin_amdgcn_s_setprio(0); } while (0)
#define PG8_WAIT_V(n) asm volatile("s_waitcnt vmcnt(" #n ")" ::: "memory")
#define PG8_WAIT_L(n) asm volatile("s_waitcnt lgkmcnt(" #n ")" ::: "memory")
#define PG8_BAR __builtin_amdgcn_s_barrier()
#define PG8_SCHED __builtin_amdgcn_sched_barrier(0)
#define PG8_BPTR(u, kt) (((kt) < ksplit ? (u).B0 : (u).B1) + (size_t)(kt) * kstep)
    Unit cur, nxt; int ui = 0;
    if (!S.next(0, cur)) return;
    f32x4 acc[2][2][4][2];
#pragma unroll
    for (int a = 0; a < 2; ++a)
#pragma unroll
        for (int b = 0; b < 2; ++b)
#pragma unroll
            for (int m = 0; m < 4; ++m)
#pragma unroll
                for (int n = 0; n < 2; ++n) acc[a][b][m][n] = (f32x4){0.f, 0.f, 0.f, 0.f};
    bf16x8 At[4][2], B0[2][2], B1[2][2];
    const char* cA = cur.A;
    if constexpr (Sched::GATHER) gather_offs(cur, va);
    { const char* cB0 = PG8_BPTR(cur, 0); const char* cB1 = PG8_BPTR(cur, 1);
      PG8_STAGE(PG8_SB(0, 0), cB0, voffB); PG8_STAGE_A(PG8_SA(0, 0), cA, 0, false); PG8_STAGE(PG8_SB(0, 1), cB0 + hstepB, voffB); PG8_STAGE_A(PG8_SA(0, 1), cA, 1, false);
      if (wr == 1) PG8_BAR;
      PG8_WAIT_V(4); PG8_BAR;
      PG8_STAGE(PG8_SB(1, 0), cB1, voffB); PG8_STAGE_A(PG8_SA(1, 0), cA + kstep, 0, false); PG8_STAGE(PG8_SB(1, 1), cB1 + hstepB, voffB);
      PG8_WAIT_V(6); PG8_BAR; }
    for (;;) {
        const bool has_next = S.next(ui + 1, nxt);
        if (!has_next) nxt = cur;
        const char* nA = nxt.A;
        if constexpr (Sched::GATHER) {
            if (has_next) gather_offs(nxt, vn);
            else {
#pragma unroll
                for (int h = 0; h < 2; ++h) { vn[h][0] = va[h][0]; vn[h][1] = va[h][1]; }
            }
        }
        for (int t = 0; t < nt; t += 2) {
            const bool last = (t == nt - 2);
            const char* a1 = cA + (size_t)(t + 1) * kstep;
            const char* a2 = last ? nA : cA + (size_t)(t + 2) * kstep;
            const char* b2 = last ? PG8_BPTR(nxt, 0) : PG8_BPTR(cur, t + 2);
            const char* a3 = a2 + kstep;
            const char* b3 = last ? PG8_BPTR(nxt, 1) : PG8_BPTR(cur, t + 3);
            PG8_LDB(B0, 0, 0); PG8_SCHED; PG8_LDA(At, 0, 0); PG8_STAGE_A(PG8_SA(1, 1), a1, 1, false);
            PG8_WAIT_L(8); PG8_BAR; PG8_WAIT_L(0); PG8_MMA(0, 0, At, B0); PG8_BAR; PG8_SCHED;
            PG8_LDB(B1, 0, 1); PG8_STAGE(PG8_SB(0, 0), b2, voffB);
            PG8_BAR; PG8_WAIT_L(0); PG8_MMA(0, 1, At, B1); PG8_BAR;
            PG8_LDA(At, 0, 1); PG8_STAGE_A(PG8_SA(0, 0), a2, 0, last);
            PG8_BAR; PG8_WAIT_L(0); PG8_MMA(1, 0, At, B0); PG8_BAR; PG8_SCHED;
            PG8_STAGE(PG8_SB(0, 1), b2 + hstepB, voffB);
            PG8_WAIT_V(6); PG8_BAR; PG8_MMA(1, 1, At, B1); PG8_BAR;
            PG8_LDB(B0, 1, 0); PG8_SCHED; PG8_LDA(At, 1, 0); PG8_STAGE_A(PG8_SA(0, 1), a2, 1, last);
            PG8_WAIT_L(8); PG8_BAR; PG8_WAIT_L(0); PG8_MMA(0, 0, At, B0); PG8_BAR; PG8_SCHED;
            PG8_LDB(B1, 1, 1); PG8_STAGE(PG8_SB(1, 0), b3, voffB);
            PG8_BAR; PG8_WAIT_L(0); PG8_MMA(0, 1, At, B1); PG8_BAR;
            PG8_LDA(At, 1, 1); PG8_STAGE_A(PG8_SA(1, 0), a3, 0, last);
            PG8_BAR; PG8_WAIT_L(0); PG8_MMA(1, 0, At, B0); PG8_BAR; PG8_SCHED;
            PG8_STAGE(PG8_SB(1, 1), b3 + hstepB, voffB);
            PG8_WAIT_V(6); PG8_BAR; PG8_MMA(1, 1, At, B1); PG8_BAR;
        }
        E(acc, cur, wr, wc, fr, fq);
        if (!has_next) break;
#pragma unroll
        for (int a = 0; a < 2; ++a)
#pragma unroll
            for (int b = 0; b < 2; ++b)
#pragma unroll
                for (int m = 0; m < 4; ++m)
#pragma unroll
                    for (int n = 0; n < 2; ++n) acc[a][b][m][n] = (f32x4){0.f, 0.f, 0.f, 0.f};
        cur = nxt; cA = nA; ++ui;
        if constexpr (Sched::GATHER) {
#pragma unroll
            for (int h = 0; h < 2; ++h) { va[h][0] = vn[h][0]; va[h][1] = vn[h][1]; }
        }
    }
    PG8_WAIT_V(0);
    if (wr == 0) PG8_BAR;
    PG8_BAR;
#undef PG8_SA
#undef PG8_SB
#undef PG8_STAGE
#undef PG8_STAGE_A
#undef PG8_LDA
#undef PG8_LDB
#undef PG8_MMA
#undef PG8_WAIT_V
#undef PG8_WAIT_L
#undef PG8_BAR
#undef PG8_SCHED
#undef PG8_BPTR
}

struct DenseSched {
    static constexpr bool GATHER = false;
    DEVINL int a_row(const Unit&, int) const { return 0; }
    const char* A; const char* Bt; int K, ldb, ksplit, nM, nN, G, c, lat;
    DEVINL void init(const bf16_t* A_, const bf16_t* Bt_, int N, int K_, int G_, int c_, int lat_) {
        A = (const char*)A_; Bt = (const char*)Bt_; K = K_; ldb = K_; ksplit = K_ / BK; nM = lat_ ? 128 : 136; nN = N / BM; G = G_; c = c_; lat = lat_; }
    DEVINL bool next(int i, Unit& u) const {
        const int nwg = nM * nN;
        const long Lq = (long)i * G + c; if (Lq >= nwg) return false;
        int wgid = (int)Lq; { const int q = nwg / NXCD, r = nwg % NXCD, xcd = wgid % NXCD, off = wgid / NXCD; wgid = (xcd < r ? xcd * (q + 1) : r * (q + 1) + (xcd - r) * q) + off; }
        const int nig = WGM * nN, gid = wgid / nig, fm = gid * WGM, gsz = (nM - fm) < WGM ? (nM - fm) : WGM;
        int pm = fm + ((wgid % nig) % gsz); const int pn = (wgid % nig) / gsz;
        if (lat) pm = (pm >> 4) * 17 + 1 + (pm & 15);
        u.pm = pm; u.pn = pn; u.A = A + (size_t)pm * BM * K * 2; u.B0 = Bt + (size_t)pn * BM * K * 2; u.B1 = u.B0; u.mvalid = 256; u.aux = 0;
        return true;
    }
};
}

struct GEpiP0 {
    static constexpr bool PERM = true;
    bf16_t* P;
    DEVINL void operator()(const f32x4 (&acc)[2][2][4][2], const pg8::Unit& u, int wr, int wc, int fr, int fq) const {
        const float sc = (u.pn == 0) ? 0.125f : 1.0f;
        const int row0 = u.pm * 256 + wr * 64 + fr, col0 = u.pn * 256 + wc * 32 + 8 * fq;
#pragma unroll
        for (int ai = 0; ai < 2; ++ai)
#pragma unroll
            for (int m = 0; m < 4; ++m) {
                bf16_t* rp = P + (size_t)(row0 + ai * 128 + m * 16) * 2048 + col0;
#pragma unroll
                for (int bj = 0; bj < 2; ++bj) {
                    const u32x2 a = pk4(acc[ai][bj][m][0] * sc), b = pk4(acc[ai][bj][m][1] * sc);
                    u32x4 w; w.x = a.x; w.y = a.y; w.z = b.x; w.w = b.y;
                    *(u32x4*)(rp + bj * 128) = w;
                }
            }
    }
};
struct GEpiP1 {
    static constexpr bool PERM = true;
    bf16_t* P; const float* lb;
    DEVINL void operator()(const f32x4 (&acc)[2][2][4][2], const pg8::Unit& u, int wr, int wc, int fr, int fq) const {
        const int cb = u.pn >> 2;
        const int row0 = u.pm * 256 + wr * 64 + fr, col0 = u.pn * 256 + wc * 32 + 8 * fq;
        f32x4 oml[2][2];
        if (cb == 1 || cb == 2) {
#pragma unroll
            for (int bj = 0; bj < 2; ++bj)
#pragma unroll
                for (int n = 0; n < 2; ++n) { const f32x4 l4 = *(const f32x4*)(lb + ((col0 + bj * 128) & 1023) + 4 * n); oml[bj][n] = 1.0f - l4; }
        }
#pragma unroll
        for (int ai = 0; ai < 2; ++ai)
#pragma unroll
            for (int m = 0; m < 4; ++m) {
                bf16_t* rp = P + (size_t)(row0 + ai * 128 + m * 16) * 5120 + col0;
#pragma unroll
                for (int bj = 0; bj < 2; ++bj) {
                    u32x4 w;
                    if (cb == 1 || cb == 2) {
                        unsigned short hv[8];
#pragma unroll
                        for (int n = 0; n < 2; ++n)
#pragma unroll
                            for (int j = 0; j < 4; ++j) hv[n * 4 + j] = f2h(oml[bj][n][j] * sigmoidf_(-acc[ai][bj][m][n][j]));
                        w.x = (unsigned)hv[0] | ((unsigned)hv[1] << 16); w.y = (unsigned)hv[2] | ((unsigned)hv[3] << 16);
                        w.z = (unsigned)hv[4] | ((unsigned)hv[5] << 16); w.w = (unsigned)hv[6] | ((unsigned)hv[7] << 16);
                    } else {
                        f32x4 v0 = acc[ai][bj][m][0], v1 = acc[ai][bj][m][1];
                        if (cb == 0 || cb == 4) {
#pragma unroll
                            for (int j = 0; j < 4; ++j) { v0[j] = siluf_(v0[j]); v1[j] = siluf_(v1[j]); }
                        }
                        const u32x2 a = pk4(v0), b = pk4(v1);
                        w.x = a.x; w.y = a.y; w.z = b.x; w.w = b.y;
                    }
                    *(u32x4*)(rp + bj * 128) = w;
                }
            }
    }
};
struct GEpiGlu {
    static constexpr bool PERM = true;
    bf16_t* CAT; const bf16_t* s5a; const float* gb;
    DEVINL void operator()(const f32x4 (&acc)[2][2][4][2], const pg8::Unit& u, int wr, int wc, int fr, int fq) const {
        const int row0 = u.pm * 256 + wr * 64 + fr, col0 = u.pn * 256 + wc * 32 + 8 * fq;
        f32x4 bv[2][2];
#pragma unroll
        for (int bj = 0; bj < 2; ++bj)
#pragma unroll
            for (int n = 0; n < 2; ++n) bv[bj][n] = *(const f32x4*)(gb + col0 + bj * 128 + 4 * n);
#pragma unroll
        for (int ai = 0; ai < 2; ++ai) {
            u32x4 av[4][2];
#pragma unroll
            for (int m = 0; m < 4; ++m)
#pragma unroll
                for (int bj = 0; bj < 2; ++bj) av[m][bj] = *(const u32x4*)(s5a + (size_t)(row0 + ai * 128 + m * 16) * 512 + col0 + bj * 128);
#pragma unroll
            for (int m = 0; m < 4; ++m) {
                const size_t row = (size_t)(row0 + ai * 128 + m * 16);
#pragma unroll
                for (int bj = 0; bj < 2; ++bj) {
                    const u32x4 a = av[m][bj];
                    f32x4 o0, o1;
                    o0[0] = bf2f((bf16_t)(a.x & 0xffff)) * sigmoidf_(acc[ai][bj][m][0][0] + bv[bj][0][0]);
                    o0[1] = bf2f((bf16_t)(a.x >> 16)) * sigmoidf_(acc[ai][bj][m][0][1] + bv[bj][0][1]);
                    o0[2] = bf2f((bf16_t)(a.y & 0xffff)) * sigmoidf_(acc[ai][bj][m][0][2] + bv[bj][0][2]);
                    o0[3] = bf2f((bf16_t)(a.y >> 16)) * sigmoidf_(acc[ai][bj][m][0][3] + bv[bj][0][3]);
                    o1[0] = bf2f((bf16_t)(a.z & 0xffff)) * sigmoidf_(acc[ai][bj][m][1][0] + bv[bj][1][0]);
                    o1[1] = bf2f((bf16_t)(a.z >> 16)) * sigmoidf_(acc[ai][bj][m][1][1] + bv[bj][1][1]);
                    o1[2] = bf2f((bf16_t)(a.w & 0xffff)) * sigmoidf_(acc[ai][bj][m][1][2] + bv[bj][1][2]);
                    o1[3] = bf2f((bf16_t)(a.w >> 16)) * sigmoidf_(acc[ai][bj][m][1][3] + bv[bj][1][3]);
                    const u32x2 x = pk4(o0), y = pk4(o1);
                    u32x4 w; w.x = x.x; w.y = x.y; w.z = y.x; w.w = y.y;
                    *(u32x4*)(CAT + row * 1024 + 512 + col0 + bj * 128) = w;
                }
            }
        }
    }
};
struct GEpiOut {
    static constexpr bool PERM = false;
    float* out; const float* gate;
    DEVINL void operator()(const f32x4 (&acc)[2][2][4][2], const pg8::Unit& u, int wr, int wc, int fr, int fq) const {
        const int b = u.pm / 17, lt = u.pm - b * 17 - 1;
        const float* gp = gate + (size_t)b * 6144;
        const int col0 = u.pn * 256 + wc * 32 + 4 * fq;
        float* base = out + ((size_t)b * SEQ + lt * 256 + wr * 64 + fr) * D;
        f32x4 g4[2][2];
#pragma unroll
        for (int bj = 0; bj < 2; ++bj)
#pragma unroll
            for (int n = 0; n < 2; ++n) g4[bj][n] = *(const f32x4*)(gp + col0 + bj * 128 + n * 16);
#pragma unroll
        for (int ai = 0; ai < 2; ++ai)
#pragma unroll
            for (int mp = 0; mp < 4; mp += 2) {
                f32x4 x4[2][2][2];
#pragma unroll
                for (int q = 0; q < 2; ++q)
#pragma unroll
                    for (int bj = 0; bj < 2; ++bj)
#pragma unroll
                        for (int n = 0; n < 2; ++n) x4[q][bj][n] = *(const f32x4*)(base + (size_t)(ai * 128 + (mp + q) * 16) * D + col0 + bj * 128 + n * 16);
                asm volatile("" ::: "memory");
#pragma unroll
                for (int q = 0; q < 2; ++q)
#pragma unroll
                    for (int bj = 0; bj < 2; ++bj)
#pragma unroll
                        for (int n = 0; n < 2; ++n) *(f32x4*)(base + (size_t)(ai * 128 + (mp + q) * 16) * D + col0 + bj * 128 + n * 16) = x4[q][bj][n] + g4[bj][n] * acc[ai][bj][mp + q][n];
                asm volatile("" ::: "memory");
            }
    }
};
struct GEpiY {
    static constexpr bool PERM = true;
    bf16_t* O;
    DEVINL void operator()(const f32x4 (&acc)[2][2][4][2], const pg8::Unit& u, int wr, int wc, int fr, int fq) const {
        const int row0 = u.pm * 256 + wr * 64 + fr, col0 = u.pn * 256 + wc * 32 + 8 * fq;
#pragma unroll
        for (int ai = 0; ai < 2; ++ai)
#pragma unroll
            for (int m = 0; m < 4; ++m) {
                bf16_t* rp = O + (size_t)(row0 + ai * 128 + m * 16) * 1024 + col0;
#pragma unroll
                for (int bj = 0; bj < 2; ++bj) {
                    const u32x2 a = pk4(acc[ai][bj][m][0]), b = pk4(acc[ai][bj][m][1]);
                    u32x4 w; w.x = a.x; w.y = a.y; w.z = b.x; w.w = b.y;
                    *(u32x4*)(rp + bj * 128) = w;
                }
            }
    }
};
struct GEpiMoe1 {
    static constexpr bool PERM = true;
    bf16_t* act; const float* wl; const float* wh;
    DEVINL void operator()(const f32x4 (&acc)[2][2][4][2], const pg8::Unit& u, int wr, int wc, int fr, int fq) const {
        const int half = u.pn >> 1;
        const float* wsel = half ? wh : wl;
        const int cbase = half * 256 + (u.pn & 1) * 128 + 16 * wc + 4 * fq;
        float wv[2][4];
#pragma unroll
        for (int ai = 0; ai < 2; ++ai)
#pragma unroll
            for (int m = 0; m < 4; ++m) { const int lr = ai * 128 + wr * 64 + m * 16 + fr; wv[ai][m] = (lr < u.mvalid) ? wsel[u.pm * 256 + lr] : 0.f; }
#pragma unroll
        for (int ai = 0; ai < 2; ++ai)
#pragma unroll
            for (int m = 0; m < 4; ++m) {
                const int slot = u.pm * 256 + ai * 128 + wr * 64 + m * 16 + fr;
#pragma unroll
                for (int bj = 0; bj < 2; ++bj) {
                    f32x4 o;
#pragma unroll
                    for (int j = 0; j < 4; ++j) o[j] = wv[ai][m] * siluf_(acc[ai][bj][m][0][j]) * acc[ai][bj][m][1][j];
                    *(u32x2*)(act + (size_t)slot * 512 + cbase + 64 * bj) = pk4(o);
                }
            }
    }
};
struct GEpiMoe2 {
    static constexpr bool PERM = false;
    float* out; float* cx; const float* gate; const int* list;
    DEVINL void operator()(const f32x4 (&acc)[2][2][4][2], const pg8::Unit& u, int wr, int wc, int fr, int fq) const {
        const int col0 = u.pn * 256 + wc * 32 + 4 * fq;
        int rows[2][4];
#pragma unroll
        for (int ai = 0; ai < 2; ++ai)
#pragma unroll
            for (int m = 0; m < 4; ++m) { const int lr = ai * 128 + wr * 64 + m * 16 + fr; rows[ai][m] = (lr < u.mvalid) ? list[u.pm * 256 + lr] : -1; }
#pragma unroll
        for (int ai = 0; ai < 2; ++ai)
#pragma unroll
            for (int mp = 0; mp < 4; mp += 2) {
                f32x4 x4[2][2][2], g4[2][2][2];
                float* rp[2];
#pragma unroll
                for (int q = 0; q < 2; ++q) {
                    const int r = rows[ai][mp + q] < 0 ? 0 : rows[ai][mp + q];
                    const int rb = r / RPB, rj = r - rb * RPB;
                    rp[q] = (rj < CTXL) ? (cx + (size_t)(rb * CTXL + rj) * D) : (out + (size_t)(rb * SEQ + (rj - CTXL)) * D);
                    const float* gp = gate + (size_t)((rj < CTXL) ? 8 : rb) * 6144;
#pragma unroll
                    for (int bj = 0; bj < 2; ++bj)
#pragma unroll
                        for (int n = 0; n < 2; ++n) { const int col = col0 + bj * 128 + n * 16; x4[q][bj][n] = *(const f32x4*)(rp[q] + col); g4[q][bj][n] = *(const f32x4*)(gp + col); }
                }
                asm volatile("" ::: "memory");
#pragma unroll
                for (int q = 0; q < 2; ++q)
                    if (rows[ai][mp + q] >= 0) {
#pragma unroll
                        for (int bj = 0; bj < 2; ++bj)
#pragma unroll
                            for (int n = 0; n < 2; ++n) *(f32x4*)(rp[q] + col0 + bj * 128 + n * 16) = x4[q][bj][n] + g4[q][bj][n] * acc[ai][bj][mp + q][n];
                    }
            }
    }
};

template <int WHICH>
DEVINL void phase_gemm(const Params& p, char* smem, int bid, int nb) {
    constexpr int N = (WHICH == 0) ? 2048 : (WHICH == 1) ? 512 : (WHICH == 3) ? 5120 : 1024;
    constexpr int K = (WHICH == 1) ? 512 : 1024;
    PG8_LAS unsigned char* lds = (PG8_LAS unsigned char*)smem;
    pg8::DenseSched S;
    bid = sgpr(bid); nb = sgpr(nb);
    if (WHICH == 0) { S.init(sgpr_ptr(p.H), sgpr_ptr(p.wt_in0), N, K, nb, bid, 1); GEpiP0 e{sgpr_ptr(p.P)}; pg8::gemm_phase(lds, S, e); }
    if (WHICH == 1) { S.init(sgpr_ptr(p.s5a), sgpr_ptr(p.glu_t), N, K, nb, bid, 1); GEpiGlu e{sgpr_ptr(p.H), sgpr_ptr(p.s5a), sgpr_ptr(p.glu_b)}; pg8::gemm_phase(lds, S, e); }
    if (WHICH == 2) { S.init(sgpr_ptr(p.H), sgpr_ptr(p.wt_out0), N, K, nb, bid, 1); GEpiY e{sgpr_ptr(p.Y)}; pg8::gemm_phase(lds, S, e); }
    if (WHICH == 3) {
        float* lbl = (float*)(smem + pg8::STAGE_BYTES + 1024);
        for (int i = tid_opaque(); i < 1024; i += NTHR) lbl[i] = p.lb[i];
        __syncthreads();
        S.init(sgpr_ptr(p.H), sgpr_ptr(p.wt_in1), N, K, nb, bid, 1); GEpiP1 e{sgpr_ptr(p.P), lbl}; pg8::gemm_phase(lds, S, e);
    }
    if (WHICH == 4) { S.init(sgpr_ptr(p.H), sgpr_ptr(p.wt_out1), N, K, nb, bid, 1); GEpiY e{sgpr_ptr(p.Y)}; pg8::gemm_phase(lds, S, e); }
    if (WHICH != 4) {
        constexpr int MM = (WHICH == 1 || WHICH == 2) ? 2 : 4, NN = (WHICH == 3) ? 4 : 2;
        constexpr int TM = 32 * MM, TN = 64 * NN, RT = 256 / TM;
        constexpr int NT0 = (WHICH == 3) ? 1024 / TN : 0, NT1 = (WHICH == 3) ? 4096 / TN : N / TN, NTC = NT1 - NT0;
        for (int u = bid; u < NBATCH * RT * NTC; u += nb) {
            const int mt = u / NTC, nt = NT0 + (u - mt * NTC);
            const int m0 = (mt / RT) * RPB + (mt % RT) * TM, n0 = nt * TN;
            if (WHICH == 0) { EpiP0 e{p.P, m0, n0}; gemm_tile<MM, NN>(p.H, 1024, nullptr, m0, TM, p.wt_in0 + (size_t)n0 * 1024, nullptr, 1024, K, K, e, smem); }
            if (WHICH == 1) { EpiGlu e{p.H, p.s5a, p.glu_b, m0, n0}; gemm_tile<MM, NN>(p.s5a, 512, nullptr, m0, TM, p.glu_t + (size_t)n0 * 512, nullptr, 512, K, K, e, smem); }
            if (WHICH == 2) { EpiOut e{&p, p.mod + 2048, m0, n0}; gemm_tile<MM, NN>(p.H, 1024, nullptr, m0, TM, p.wt_out0 + (size_t)n0 * 1024, nullptr, 1024, K, K, e, smem); }
            if (WHICH == 3) { EpiP1 e{p.P, p.lb, m0, n0}; gemm_tile<MM, NN>(p.H, 1024, nullptr, m0, TM, p.wt_in1 + (size_t)n0 * 1024, nullptr, 1024, K, K, e, smem); }
        }
    }
}

constexpr int MOE_TAB = pg8::STAGE_BYTES;
static_assert(MOE_TAB + 1024 <= LDS_BYTES, "moe tables");
DEVINL void bucket_prefix(int* tab, int t) {
    if (t < 64) {
        const int c = (t < 48) ? tab[128 + t] : 0;
        const int nt = (c + 255) >> 8;
        int incl = nt;
#pragma unroll
        for (int o = 1; o < 64; o <<= 1) { const int v = __shfl_up(incl, o); if (t >= o) incl += v; }
        const int excl = incl - nt;
        if (t < 48) { tab[t] = excl * 256; tab[64 + t] = excl; }
        if (t == 47) { tab[48] = incl * 256; tab[64 + 48] = incl; }
    }
}
DEVINL void moe_setup(const Params& p, int L, int* tab) {
    const int t = tid_opaque();
    if (t < 48) tab[128 + t] = p.cnt[L * 64 + t];
    __syncthreads();
    bucket_prefix(tab, t);
    __syncthreads();
    {
        unsigned char* t2b = (unsigned char*)(tab + 192);
        const int ntiles = tab[64 + 48];
        if (t < ntiles) {
            int bucket = 0;
            for (int b = 0; b < 48; ++b) if (t >= tab[64 + b] && t < tab[64 + b + 1]) bucket = b;
            t2b[t] = (unsigned char)bucket;
        }
    }
    __syncthreads();
}
template <int L>
DEVINL void phase_list(const Params& p, char* smem, int bid, int nb) {
    int* tab = (int*)(smem + MOE_TAB);
    int* red = (int*)smem;
    int* rsrc = red + 1024; int* rdst = rsrc + 256;
    const int t = tid_opaque(), w = t >> 6, lane = t & 63;
    {
        const int bkt = t & 63, part = t >> 6;
        int tot = 0, pre = 0;
        if (bkt < 48) {
#pragma unroll 8
            for (int q = 0; q < 32; ++q) { const int blk = part * 32 + q; const int c = (blk < nb) ? p.blkcnt[((size_t)L * 256 + blk) * 48 + bkt] : 0; tot += c; pre += (blk < bid) ? c : 0; }
        }
        red[part * 64 + bkt] = tot; red[512 + part * 64 + bkt] = pre;
    }
    __syncthreads();
    if (t < 48) {
        int tot = 0, pre = 0;
#pragma unroll
        for (int q = 0; q < 8; ++q) { tot += red[q * 64 + t]; pre += red[512 + q * 64 + t]; }
        tab[128 + t] = tot; tab[192 + t] = pre;
        if (bid == 0) p.cnt[L * 64 + t] = tot;
    }
    __syncthreads();
    bucket_prefix(tab, t);
    __syncthreads();
    if (t < 48) tab[192 + t] += tab[t];
    __syncthreads();
    int ql_lo, ql_hi, qc_lo = 0, qc_hi = 0;
    group_span(NLAT / 16, bid, nb, ql_lo, ql_hi);
    if (L == 0) group_span(NBATCH * 16, bid, nb, qc_lo, qc_hi);
    const int nlatg = ql_hi - ql_lo, nctxg = qc_hi - qc_lo;
    const int nmine = (nlatg + nctxg) * 16;
    if (t < nmine) {
        const int gi = t >> 4;
        int r;
        if (gi < nlatg) { const int q = ql_lo + gi; r = ((q >> 8) * 272 + 16 + (q & 255)) * 16 + (t & 15); }
        else { const int q = qc_lo + (gi - nlatg); r = ((q >> 4) * 272 + (q & 15)) * 16 + (t & 15); }
        const float4 rec = p.RT[r];
        const int bucket = __float_as_int(rec.x);
        const int slot = atomicAdd(&tab[192 + bucket], 1);
        p.list[slot] = r; p.wl[slot] = rec.y; p.wh[slot] = rec.z; p.sor[r] = slot;
    }
    __syncthreads();
}
template <int STAGE>
struct MoeSched {
    static constexpr bool GATHER = (STAGE == 1);
    static constexpr int stage = STAGE;
    const bf16_t* hs; const bf16_t* wgu_t; const bf16_t* act; const bf16_t* wd_t; const int* tab; const int* list; int K, ldb, ksplit, G, c, ntiles;
    DEVINL int a_row(const pg8::Unit& u, int r) const { return list[(u.pm << 8) + (r < u.mvalid ? r : 0)]; }
    DEVINL bool next(int i, pg8::Unit& u) const {
        const int x = c & 7, rk = c >> 3, nper = G >> 3;
        const int t0 = (ntiles * x) >> 3, t1 = (ntiles * (x + 1)) >> 3;
        const int li = i * nper + rk;
        if (li >= (t1 - t0) * 4) return false;
        const int tile = t0 + (li >> 2), pn = li & 3;
        const int bucket = sgpr((int)((const unsigned char*)(tab + 192))[tile]);
        const int ti = tile - sgpr(tab[64 + bucket]);
        const int m0 = sgpr(tab[bucket]) + ti * 256;
        const int rem = sgpr(tab[128 + bucket]) - ti * 256;
        const int grp = bucket / 6, pair = bucket - grp * 6;
        const int lo = (pair < 3) ? 0 : (pair < 5 ? 1 : 2);
        const int hi = (pair < 3) ? (pair + 1) : (pair < 5 ? (pair - 1) : 3);
        const int ea = grp * 4 + lo, eb = grp * 4 + hi;
        u.pm = m0 >> 8; u.pn = pn; u.mvalid = rem < 256 ? rem : 256; u.aux = 0;
        if (stage == 1) {
            const int e = (pn >> 1) ? eb : ea;
            u.A = (const char*)hs;
            u.B0 = (const char*)(wgu_t + ((size_t)e * 512 + (pn & 1) * 256) * 1024); u.B1 = u.B0;
        } else {
            u.A = (const char*)(act + (size_t)m0 * 512);
            u.B0 = (const char*)(wd_t + ((size_t)ea * 1024 + pn * 256) * 256);
            u.B1 = (const char*)(wd_t + ((size_t)eb * 1024 + pn * 256) * 256) - (size_t)4 * 128;
        }
        return true;
    }
};
template <int L, int STAGE>
DEVINL void phase_moe(const Params& p, char* smem, int bid, int nb) {
    int* tab = (int*)(smem + MOE_TAB);
    moe_setup(p, L, tab);
    PG8_LAS unsigned char* lds = (PG8_LAS unsigned char*)smem;
    MoeSched<STAGE> S; S.hs = sgpr_ptr(p.H); S.wgu_t = sgpr_ptr(p.wgu_t); S.act = sgpr_ptr(p.act); S.wd_t = sgpr_ptr(p.wd_t); S.list = sgpr_ptr(p.list);
    S.tab = tab; S.G = sgpr(nb); S.c = sgpr(bid); S.ntiles = sgpr(tab[64 + 48]);
    if (STAGE == 1) { S.K = 1024; S.ldb = 1024; S.ksplit = 16; GEpiMoe1 e{sgpr_ptr(p.act), sgpr_ptr(p.wl), sgpr_ptr(p.wh)}; pg8::gemm_phase(lds, S, e); }
    else { S.K = 512; S.ldb = 256; S.ksplit = 4; GEpiY e{sgpr_ptr(p.y2)}; pg8::gemm_phase(lds, S, e); }
    __syncthreads();
}

template <int DK> struct RecL {
    static constexpr int QS = DK + 8;
    static constexpr int oQs = 0;
    static constexpr int oKs = oQs + 64 * QS * 2;
    static constexpr int oKt = oKs + 64 * QS * 2;
    static constexpr int oVt = oKt + DK * 72 * 2;
    static constexpr int oAt = oVt + 128 * 72 * 2;
    static constexpr int oSt = oAt + 64 * 72 * 2;
    static constexpr int oPart = oSt + 128 * 136 * 2;
    static constexpr int oEmid = oPart + 8 * 128 * 4;
    static constexpr int oEend = oEmid + 128 * 4;
    static constexpr int oAF = oEend + 128 * 4;
    static constexpr int oRed = oAF + 64 * 32 * 4;
    static constexpr int total = oRed + 64 * 4 * 4 + 128 * 4;
};
static_assert(RecL<128>::total <= LDS_BYTES, "rec lds");

template <bool GLA> struct RecCols {
    static constexpr int LDP = GLA ? 2048 : 5120;
    static constexpr int QOFF = 0;
    static constexpr int KOFF = 256;
    static constexpr int KF = 1024, KB = 2048;
    static constexpr int VOFF = GLA ? 512 : 3072;
    static constexpr int GOFF = GLA ? 1024 : 4096;
};
template <int DK, bool GLA> struct RecGeo {
    static constexpr int GC = GLA ? 4 : 8;
    static constexpr int NS = GLA ? 16 : 8;
    static constexpr int H = GLA ? 4 : 8;
    static constexpr int KT = DK / 16;
};

struct RawRegs { unsigned q[8], k[8], v[8]; u32x4 af; };

template <int DK, bool GLA, int DIR, bool PASS3>
DEVINL void rec_load_raw(const Params& p, const bf16_t* __restrict__ P, int row0, int h, RawRegs& r) {
    using C = RecCols<GLA>; constexpr int LDP = C::LDP;
    constexpr int NCP = DK / 2, NSEG = NTHR / NCP, RS = 64 / NSEG, SPW = NSEG / 8;
    const int t = tid_opaque();
    const int wid = __builtin_amdgcn_readfirstlane(t >> 6), lane = t & 63;
    const __amdgpu_buffer_rsrc_t rsrc = __builtin_amdgcn_make_buffer_rsrc((void*)P, 0, R * LDP * 2, 0x00020000);
    {
        const unsigned sb = (unsigned)__builtin_amdgcn_readfirstlane(((row0 + wid * SPW * RS) * LDP + h * DK) * 2);
        const unsigned lo = (unsigned)(((lane / NCP) * RS * LDP + (lane % NCP) * 2) * 2);
#pragma unroll
        for (int i = 0; i < RS; ++i) {
            if (PASS3) r.q[i] = __builtin_amdgcn_raw_buffer_load_b32(rsrc, lo, sb + (unsigned)((i * LDP + C::QOFF) * 2), 0);
            r.k[i] = __builtin_amdgcn_raw_buffer_load_b32(rsrc, lo, sb + (unsigned)((i * LDP + (GLA ? C::KOFF : (DIR ? C::KB : C::KF))) * 2), 0);
        }
    }
    {
        const unsigned sb = (unsigned)__builtin_amdgcn_readfirstlane(((row0 + wid * 8) * LDP + C::VOFF + h * 128) * 2);
        const unsigned lo = (unsigned)(lane * 4);
#pragma unroll
        for (int i = 0; i < 8; ++i) r.v[i] = __builtin_amdgcn_raw_buffer_load_b32(rsrc, lo, sb + (unsigned)(i * LDP * 2), 0);
    }
    if (GLA) { const int row = t >> 3; r.af = *(const u32x4*)(p.AF + (size_t)(row0 + row) * 32 + (t & 7) * 4); }
}

template <int DK, bool GLA, int DIR, bool PASS3>
DEVINL void rec_prep(const Params& p, char* smem, const bf16_t* __restrict__ P, RawRegs& raw, bool has_next, int next_row0, int h,
                     const float (&a2c)[2][16], const float (&abv)[2], float (&bsum)[2]) {
    using L = RecL<DK>;
    constexpr int NCP = DK / 2, NSEG = NTHR / NCP, RS = 64 / NSEG, QS = L::QS;
    constexpr bool ref_end = !PASS3;
    bf16_t* Qs = (bf16_t*)(smem + L::oQs); bf16_t* Ks = (bf16_t*)(smem + L::oKs); bf16_t* Kt = (bf16_t*)(smem + L::oKt); bf16_t* Vt = (bf16_t*)(smem + L::oVt);
    float* part = (float*)(smem + L::oPart); float* emid = (float*)(smem + L::oEmid); float* eend = (float*)(smem + L::oEend); float* AFs = (float*)(smem + L::oAF);
    const int t = tid_opaque();
    if (GLA) {
        *(u32x4*)&AFs[(t >> 3) * 32 + (t & 7) * 4] = raw.af;
        lds_sync();
    }
    const int cp = t % NCP, seg = t / NCP, c0 = cp * 2, l0 = seg * RS;
    float dv[RS][2];
    float kv[RS][2];
#pragma unroll
    for (int i = 0; i < RS; ++i) {
        const unsigned kr = raw.k[i];
        if (GLA) {
            kv[i][0] = bf2f((bf16_t)(kr & 0xffffu)); kv[i][1] = bf2f((bf16_t)(kr >> 16));
            const float* ar = &AFs[(l0 + i) * 32 + DIR * 16];
            float s0 = abv[0], s1 = abv[1];
#pragma unroll
            for (int r = 0; r < 16; ++r) { const float av = ar[r]; s0 += av * a2c[0][r]; s1 += av * a2c[1][r]; }
            dv[i][0] = logsigmoidf_(s0) * 0.0625f; dv[i][1] = logsigmoidf_(s1) * 0.0625f;
        } else {
            kv[i][0] = h2f((unsigned short)(kr & 0xffffu)); kv[i][1] = h2f((unsigned short)(kr >> 16));
            dv[i][0] = 1.0f - kv[i][0]; dv[i][1] = 1.0f - kv[i][1];
        }
    }
    {
        float s0 = GLA ? 0.f : 1.f, s1 = GLA ? 0.f : 1.f;
#pragma unroll
        for (int i = 0; i < RS; ++i) { if (GLA) { s0 += dv[i][0]; s1 += dv[i][1]; } else { s0 *= dv[i][0]; s1 *= dv[i][1]; } }
        float2 pv; pv.x = s0; pv.y = s1;
        *(float2*)&part[seg * DK + c0] = pv;
    }
    lds_sync();
    float tot[2], base[2], mid[2];
#pragma unroll
    for (int c = 0; c < 2; ++c) { tot[c] = GLA ? 0.f : 1.f; base[c] = tot[c]; mid[c] = tot[c]; }
#pragma unroll
    for (int sg = 0; sg < NSEG; ++sg) {
        const float2 pv = *(const float2*)&part[sg * DK + c0];
        const bool before = (DIR == 0) ? (sg < seg) : (sg > seg);
        const bool firsthalf = (DIR == 0) ? (sg < NSEG / 2) : (sg >= NSEG / 2);
        if (GLA) { tot[0] += pv.x; tot[1] += pv.y; if (before) { base[0] += pv.x; base[1] += pv.y; } if (firsthalf) { mid[0] += pv.x; mid[1] += pv.y; } }
        else { tot[0] *= pv.x; tot[1] *= pv.y; if (before) { base[0] *= pv.x; base[1] *= pv.y; } if (firsthalf) { mid[0] *= pv.x; mid[1] *= pv.y; } }
    }
    float ref[2], iref[2];
#pragma unroll
    for (int c = 0; c < 2; ++c) { ref[c] = ref_end ? tot[c] : mid[c]; iref[c] = GLA ? 0.f : __builtin_amdgcn_rcpf(ref[c]); }
    if (seg == 0) {
#pragma unroll
        for (int c = 0; c < 2; ++c) {
            if (PASS3) {
                const float open = GLA ? __expf(ref[c]) : ref[c];
                emid[c0 + c] = open * bsum[c];
                bsum[c] = GLA ? __expf(tot[c] - ref[c]) : tot[c] * iref[c];
            } else if (GLA) { emid[c0 + c] = __expf(ref[c]); eend[c0 + c] = 1.0f; bsum[c] += tot[c]; }
            else { emid[c0 + c] = ref[c]; eend[c0 + c] = 1.0f; bsum[c] += __logf(tot[c]); }
        }
    }
    unsigned short ktv[2][RS];
    float run[2] = {base[0], base[1]};
#pragma unroll
    for (int ii = 0; ii < RS; ++ii) {
        const int i = (DIR == 0) ? ii : (RS - 1 - ii);
        float ek[2], eq[2];
#pragma unroll
        for (int c = 0; c < 2; ++c) {
            if (GLA) { run[c] += dv[i][c]; ek[c] = __expf(ref[c] - run[c]); eq[c] = PASS3 ? __expf(run[c] - ref[c]) : 0.f; }
            else { run[c] *= dv[i][c]; ek[c] = ref[c] * __builtin_amdgcn_rcpf(run[c]); eq[c] = run[c] * iref[c]; }
        }
        const unsigned kp = cvt_pk_bf16(kv[i][0] * ek[0], kv[i][1] * ek[1]);
        ktv[0][i] = (unsigned short)(kp & 0xffffu); ktv[1][i] = (unsigned short)(kp >> 16);
        if (PASS3) {
            const int l = l0 + i;
            *(unsigned*)&Ks[l * QS + c0] = kp;
            const unsigned qr = raw.q[i];
            *(unsigned*)&Qs[l * QS + c0] = cvt_pk_bf16(bf2f((bf16_t)(qr & 0xffffu)) * eq[0], bf2f((bf16_t)(qr >> 16)) * eq[1]);
        }
    }
#pragma unroll
    for (int c = 0; c < 2; ++c) {
        if (RS == 8) {
            u32x4 v;
            v.x = (unsigned)ktv[c][0] | ((unsigned)ktv[c][1] << 16); v.y = (unsigned)ktv[c][2] | ((unsigned)ktv[c][3] << 16);
            v.z = (unsigned)ktv[c][RS > 4 ? 4 : 0] | ((unsigned)ktv[c][RS > 4 ? 5 : 0] << 16); v.w = (unsigned)ktv[c][RS > 4 ? 6 : 0] | ((unsigned)ktv[c][RS > 4 ? 7 : 0] << 16);
            *(u32x4*)&Kt[(c0 + c) * 72 + l0] = v;
        } else {
            u32x2 v;
            v.x = (unsigned)ktv[c][0] | ((unsigned)ktv[c][1] << 16); v.y = (unsigned)ktv[c][2] | ((unsigned)ktv[c][3] << 16);
            *(u32x2*)&Kt[(c0 + c) * 72 + l0] = v;
        }
    }
    {
        const int vp = t & 63, vq = t >> 6;
        unsigned vr[8];
#pragma unroll
        for (int i = 0; i < 8; ++i) vr[i] = raw.v[i];
        u32x4 lo, hi;
        lo.x = (vr[0] & 0xffffu) | (vr[1] << 16); lo.y = (vr[2] & 0xffffu) | (vr[3] << 16); lo.z = (vr[4] & 0xffffu) | (vr[5] << 16); lo.w = (vr[6] & 0xffffu) | (vr[7] << 16);
        hi.x = (vr[0] >> 16) | (vr[1] & 0xffff0000u); hi.y = (vr[2] >> 16) | (vr[3] & 0xffff0000u); hi.z = (vr[4] >> 16) | (vr[5] & 0xffff0000u); hi.w = (vr[6] >> 16) | (vr[7] & 0xffff0000u);
        *(u32x4*)&Vt[(2 * vp) * 72 + vq * 8] = lo;
        *(u32x4*)&Vt[(2 * vp + 1) * 72 + vq * 8] = hi;
    }
    if (has_next) rec_load_raw<DK, GLA, DIR, PASS3>(p, P, next_row0, h, raw);
    lds_sync();
}

DEVINL bf16x8 ldfrag(const bf16_t* base, int ld, int fr, int fq, int k0) { return *(const bf16x8*)(base + fr * ld + k0 + fq * 8); }

template <int DK, bool GLA, int DIR>
DEVINL void rec_load_a2(const Params& p, int h, float (&a2c)[2][16], float (&abv)[2]) {
#pragma unroll
    for (int c = 0; c < 2; ++c) { abv[c] = 0.f;
#pragma unroll
        for (int r = 0; r < 16; ++r) a2c[c][r] = 0.f; }
    if (GLA) {
        const int c0 = (tid_opaque() % (DK / 2)) * 2;
#pragma unroll
        for (int c = 0; c < 2; ++c) {
#pragma unroll
            for (int r = 0; r < 16; ++r) a2c[c][r] = p.gla_a2[(DIR * 16 + r) * 256 + h * 64 + c0 + c];
            abv[c] = p.gla_ab[DIR * 256 + h * 64 + c0 + c];
        }
    }
}

template <int DK, bool GLA, int DIR>
DEVINL void rec_pass1_unit(const Params& p, char* smem, const bf16_t* P, int b, int h, int cg, float* slots, float* decs) {
    using L = RecL<DK>; using G = RecGeo<DK, GLA>;
    constexpr int KT = G::KT;
    bf16_t* Kt = (bf16_t*)(smem + L::oKt); bf16_t* Vt = (bf16_t*)(smem + L::oVt); float* emid = (float*)(smem + L::oEmid);
    const int t = tid_opaque(), w = t >> 6, lane = t & 63, fr = lane & 15, fq = lane >> 4;
    float a2c[2][16], abv[2];
    rec_load_a2<DK, GLA, DIR>(p, h, a2c, abv);
    constexpr int VT = 4, KW = KT / 4;
    const int vh = w >> 2, kq = w & 3;
    f32x4 accS[VT][KW];
#pragma unroll
    for (int vt = 0; vt < VT; ++vt)
#pragma unroll
        for (int kw = 0; kw < KW; ++kw) accS[vt][kw] = (f32x4){0.f, 0.f, 0.f, 0.f};
    float bsum[2] = {0.f, 0.f};
    const int nch = (cg == 0) ? 4 : G::GC;
    auto chunk_row0 = [&](int ci) { const int pc = (cg == 0) ? (DIR == 0 ? ci : 3 - ci) : (DIR == 0 ? (4 + (cg - 1) * G::GC + ci) : (67 - (cg - 1) * G::GC - ci)); return b * RPB + pc * 64; };
    RawRegs raw;
    rec_load_raw<DK, GLA, DIR, false>(p, P, chunk_row0(0), h, raw);
    for (int ci = 0; ci < nch; ++ci) {
        const bool has_next = ci + 1 < nch;
        rec_prep<DK, GLA, DIR, false>(p, smem, P, raw, has_next, has_next ? chunk_row0(ci + 1) : 0, h, a2c, abv, bsum);
        bf16x8 av[VT][2];
#pragma unroll
        for (int vt = 0; vt < VT; ++vt)
#pragma unroll
            for (int ks = 0; ks < 2; ++ks) av[vt][ks] = ldfrag(Vt + ((vh * VT + vt) * 16) * 72, 72, fr, fq, ks * 32);
#pragma unroll
        for (int kw = 0; kw < KW; ++kw) {
            const int kt = kq * KW + kw;
            const f32x4 e4 = *(const f32x4*)&emid[kt * 16 + fq * 4];
            bf16x8 ak[2];
#pragma unroll
            for (int ks = 0; ks < 2; ++ks) ak[ks] = ldfrag(Kt + (kt * 16) * 72, 72, fr, fq, ks * 32);
#pragma unroll
            for (int vt = 0; vt < VT; ++vt) {
                f32x4 c = accS[vt][kw] * e4;
#pragma unroll
                for (int ks = 0; ks < 2; ++ks) c = __builtin_amdgcn_mfma_f32_16x16x32_bf16(ak[ks], av[vt][ks], c, 0, 0, 0);
                accS[vt][kw] = c;
            }
        }
        lds_sync();
    }
    const size_t chain = ((size_t)(b * G::H + h) * 2 + DIR);
    bf16_t* sl = (bf16_t*)slots + (chain * G::NS + cg) * (size_t)(128 * DK);
#pragma unroll
    for (int vt = 0; vt < VT; ++vt)
#pragma unroll
        for (int kw = 0; kw < KW; ++kw) *(u32x2*)&sl[((vh * VT + vt) * 16 + fr) * DK + (kq * KW + kw) * 16 + fq * 4] = pk4(accS[vt][kw]);
    if (t < DK / 2) { decs[(chain * G::NS + cg) * DK + 2 * t] = bsum[0]; decs[(chain * G::NS + cg) * DK + 2 * t + 1] = bsum[1]; }
}

template <int DK, bool GLA, int DIR>
DEVINL void rec_pass3_chunk(const Params& p, char* smem, const bf16_t* P, bf16_t* CAT, int row0, int h, f32x4 (&accS)[4][DK / 64], const float* gnorm) {
    using L = RecL<DK>; using C = RecCols<GLA>;
    constexpr int KT = DK / 16, QS = L::QS, KS = DK / 32;
    bf16_t* Qs = (bf16_t*)(smem + L::oQs); bf16_t* Ks = (bf16_t*)(smem + L::oKs); bf16_t* Kt = (bf16_t*)(smem + L::oKt); bf16_t* Vt = (bf16_t*)(smem + L::oVt);
    bf16_t* At = (bf16_t*)(smem + L::oAt); bf16_t* St = (bf16_t*)(smem + L::oSt);
    float* emid = (float*)(smem + L::oEmid); float* eend = (float*)(smem + L::oEend); float* red = (float*)(smem + L::oRed);
    const int t = tid_opaque(), w = t >> 6, lane = t & 63, fr = lane & 15, fq = lane >> 4;
    u32x2 obv[4], gbv[4];
    const int lh = w & 1, vq = w >> 1;
    if (DIR == 0) {
#pragma unroll
        for (int li = 0; li < 2; ++li) {
            const size_t prow = (size_t)(row0 + (lh * 2 + li) * 16 + fr);
            const bf16_t* cp0 = CAT + prow * 1024 + h * 128 + vq * 32 + fq * 4;
            const bf16_t* gp0 = P + prow * C::LDP + C::GOFF + h * 128 + vq * 32 + fq * 4;
#pragma unroll
            for (int vi = 0; vi < 2; ++vi) { obv[li * 2 + vi] = *(const u32x2*)(cp0 + vi * 16); gbv[li * 2 + vi] = *(const u32x2*)(gp0 + vi * 16); }
        }
    }
    constexpr int KW = KT / 4;
    const int vh = w >> 2, kq = w & 3;
#pragma unroll
    for (int kw = 0; kw < KW; ++kw) {
        const int kt = kq * KW + kw;
        const f32x4 e4 = *(const f32x4*)&emid[kt * 16 + fq * 4];
#pragma unroll
        for (int vt = 0; vt < 4; ++vt) {
            accS[vt][kw] = accS[vt][kw] * e4;
            *(u32x2*)&St[((vh * 4 + vt) * 16 + fr) * QS + kt * 16 + fq * 4] = pk4(accS[vt][kw]);
        }
    }
    {
        const int lt = w >> 1, st0 = (w & 1) * 2;
        bf16x8 aq[KS];
#pragma unroll
        for (int ks = 0; ks < KS; ++ks) aq[ks] = ldfrag(Qs + (lt * 16) * QS, QS, fr, fq, ks * 32);
#pragma unroll
        for (int s2 = 0; s2 < 2; ++s2) {
            const int st = st0 + s2;
            f32x4 c = (f32x4){0.f, 0.f, 0.f, 0.f};
#pragma unroll
            for (int ks = 0; ks < KS; ++ks) c = __builtin_amdgcn_mfma_f32_16x16x32_bf16(ldfrag(Ks + (st * 16) * QS, QS, fr, fq, ks * 32), aq[ks], c, 0, 0, 0);
            const int l = lt * 16 + fr;
#pragma unroll
            for (int j = 0; j < 4; ++j) { const int sidx = st * 16 + fq * 4 + j; const bool keep = (DIR == 0) ? (sidx <= l) : (sidx >= l); c[j] = keep ? c[j] : 0.f; }
            *(u32x2*)&At[l * 72 + st * 16 + fq * 4] = pk4(c);
        }
    }
    lds_sync();
    f32x4 o[4];
    {
        bf16x8 aa[2][2], aq[2][KS];
#pragma unroll
        for (int li = 0; li < 2; ++li) {
#pragma unroll
            for (int ks = 0; ks < 2; ++ks) aa[li][ks] = ldfrag(At + ((lh * 2 + li) * 16) * 72, 72, fr, fq, ks * 32);
#pragma unroll
            for (int ks = 0; ks < KS; ++ks) aq[li][ks] = ldfrag(Qs + ((lh * 2 + li) * 16) * QS, QS, fr, fq, ks * 32);
        }
#pragma unroll
        for (int vi = 0; vi < 2; ++vi) {
            const int vt = vq * 2 + vi;
            bf16x8 bv[2], bs[KS];
#pragma unroll
            for (int ks = 0; ks < 2; ++ks) bv[ks] = ldfrag(Vt + (vt * 16) * 72, 72, fr, fq, ks * 32);
#pragma unroll
            for (int ks = 0; ks < KS; ++ks) bs[ks] = ldfrag(St + (vt * 16) * QS, QS, fr, fq, ks * 32);
#pragma unroll
            for (int li = 0; li < 2; ++li) {
                f32x4 c = (f32x4){0.f, 0.f, 0.f, 0.f};
#pragma unroll
                for (int ks = 0; ks < 2; ++ks) c = __builtin_amdgcn_mfma_f32_16x16x32_bf16(bv[ks], aa[li][ks], c, 0, 0, 0);
#pragma unroll
                for (int ks = 0; ks < KS; ++ks) c = __builtin_amdgcn_mfma_f32_16x16x32_bf16(bs[ks], aq[li][ks], c, 0, 0, 0);
                o[li * 2 + vi] = c;
            }
        }
    }
    {
        bf16x8 av[4][2];
#pragma unroll
        for (int vt = 0; vt < 4; ++vt)
#pragma unroll
            for (int ks = 0; ks < 2; ++ks) av[vt][ks] = ldfrag(Vt + ((vh * 4 + vt) * 16) * 72, 72, fr, fq, ks * 32);
#pragma unroll
        for (int kw = 0; kw < KW; ++kw) {
            bf16x8 ak[2];
#pragma unroll
            for (int ks = 0; ks < 2; ++ks) ak[ks] = ldfrag(Kt + ((kq * KW + kw) * 16) * 72, 72, fr, fq, ks * 32);
#pragma unroll
            for (int vt = 0; vt < 4; ++vt) {
                f32x4 c = accS[vt][kw];
#pragma unroll
                for (int ks = 0; ks < 2; ++ks) c = __builtin_amdgcn_mfma_f32_16x16x32_bf16(ak[ks], av[vt][ks], c, 0, 0, 0);
                accS[vt][kw] = c;
            }
        }
    }
    if (DIR == 1) {
#pragma unroll
        for (int li = 0; li < 2; ++li) {
            bf16_t* cp = CAT + (size_t)(row0 + (lh * 2 + li) * 16 + fr) * 1024 + h * 128 + vq * 32 + fq * 4;
#pragma unroll
            for (int vi = 0; vi < 2; ++vi) *(u32x2*)(cp + vi * 16) = pk4(o[li * 2 + vi]);
        }
    } else {
#pragma unroll
        for (int li = 0; li < 2; ++li) {
            float ss = 0.f;
#pragma unroll
            for (int vi = 0; vi < 2; ++vi) {
                const int n = li * 2 + vi;
                const u32x2 ob = obv[n];
                o[n][0] += bf2f((bf16_t)(ob.x & 0xffff)); o[n][1] += bf2f((bf16_t)(ob.x >> 16));
                o[n][2] += bf2f((bf16_t)(ob.y & 0xffff)); o[n][3] += bf2f((bf16_t)(ob.y >> 16));
                ss += o[n][0] * o[n][0] + o[n][1] * o[n][1] + o[n][2] * o[n][2] + o[n][3] * o[n][3];
            }
            ss += __shfl_xor(ss, 16);
            ss += __shfl_xor(ss, 32);
            if (fq == 0) red[((lh * 2 + li) * 16 + fr) * 4 + vq] = ss;
        }
        lds_sync();
#pragma unroll
        for (int li = 0; li < 2; ++li) {
            const int l = (lh * 2 + li) * 16 + fr;
            const f32x4 t4 = *(const f32x4*)&red[l * 4];
            const float rstd = rsqrtf((t4[0] + t4[1] + t4[2] + t4[3]) * (1.0f / 128.0f) + EPS);
            bf16_t* cp = CAT + (size_t)(row0 + l) * 1024 + h * 128 + vq * 32 + fq * 4;
#pragma unroll
            for (int vi = 0; vi < 2; ++vi) {
                const int n = li * 2 + vi;
                const u32x2 gb = gbv[n];
                const f32x4 gn = *(const f32x4*)(gnorm + vq * 32 + vi * 16 + fq * 4);
                f32x4 gv;
                gv[0] = bf2f((bf16_t)(gb.x & 0xffff)); gv[1] = bf2f((bf16_t)(gb.x >> 16)); gv[2] = bf2f((bf16_t)(gb.y & 0xffff)); gv[3] = bf2f((bf16_t)(gb.y >> 16));
                f32x4 r4;
#pragma unroll
                for (int j = 0; j < 4; ++j) { const float g = GLA ? siluf_(gv[j]) : gv[j]; r4[j] = o[n][j] * rstd * gn[j] * g; }
                *(u32x2*)(cp + vi * 16) = pk4(r4);
            }
        }
    }
    if (DIR == 1) lds_sync();
}

template <int DK, bool GLA, int DIR, int PRB = 0>
DEVINL void rec_pass3_sweep(const Params& p, char* smem, const bf16_t* P, bf16_t* CAT, int b, int h, int c_lo, int nch, int slot, const float* slots, const float* gnorm) {
    using G = RecGeo<DK, GLA>;
    constexpr int KT = G::KT;
    const int t = tid_opaque(), w = t >> 6, lane = t & 63, fr = lane & 15, fq = lane >> 4;
    float a2c[2][16], abv[2];
    rec_load_a2<DK, GLA, DIR>(p, h, a2c, abv);
    constexpr int KW = KT / 4;
    const int vh = w >> 2, kq = w & 3;
    f32x4 accS[4][KW];
    if (slot >= 0) {
        const size_t chain = ((size_t)(b * G::H + h) * 2 + DIR);
        const bf16_t* sl = (const bf16_t*)slots + (chain * G::NS + slot) * (size_t)(128 * DK);
#pragma unroll
        for (int vt = 0; vt < 4; ++vt)
#pragma unroll
            for (int kw = 0; kw < KW; ++kw) {
                const u32x2 sv = *(const u32x2*)&sl[((vh * 4 + vt) * 16 + fr) * DK + (kq * KW + kw) * 16 + fq * 4];
                accS[vt][kw][0] = bf2f((bf16_t)(sv.x & 0xffffu)); accS[vt][kw][1] = bf2f((bf16_t)(sv.x >> 16));
                accS[vt][kw][2] = bf2f((bf16_t)(sv.y & 0xffffu)); accS[vt][kw][3] = bf2f((bf16_t)(sv.y >> 16));
            }
    } else {
#pragma unroll
        for (int vt = 0; vt < 4; ++vt)
#pragma unroll
            for (int kw = 0; kw < KW; ++kw) accS[vt][kw] = (f32x4){0.f, 0.f, 0.f, 0.f};
    }
    float bsum[2] = {1.f, 1.f};
    float* gn_lds = (float*)(smem + RecL<DK>::oRed + 64 * 4 * 4);
    if (DIR == 0) { if (t < 128) gn_lds[t] = gnorm[t]; }
    auto chunk_row0 = [&](int ci) { const int pc = (DIR == 0) ? (c_lo + ci) : (c_lo + nch - 1 - ci); return b * RPB + pc * 64; };
    RawRegs raw;
    rec_load_raw<DK, GLA, DIR, true>(p, P, chunk_row0(0), h, raw);
    for (int ci = 0; ci < nch; ++ci) {
        const bool has_next = ci + 1 < nch;
        if (PRB != 2 || ci == 0) rec_prep<DK, GLA, DIR, true>(p, smem, P, raw, has_next, has_next ? chunk_row0(ci + 1) : 0, h, a2c, abv, bsum);
        if (PRB != 1) rec_pass3_chunk<DK, GLA, DIR>(p, smem, P, CAT, chunk_row0(ci), h, accS, gn_lds);
    }
}

template <int DK, bool GLA, int PRB = 0>
DEVINL void rec_pass3_unit(const Params& p, char* smem, const bf16_t* P, bf16_t* CAT, int b, int h, int gi, const float* slots, const float* gnorm) {
    using G = RecGeo<DK, GLA>;
    int c_lo, nch, slot_f, slot_b;
    if (GLA) {
        if (gi == 0) { c_lo = 0; nch = 4; slot_f = -1; slot_b = -1; }
        else { const int pg = gi - 1; c_lo = 4 + pg * G::GC; nch = G::GC; slot_f = pg; slot_b = G::NS - 1 - pg; }
    } else { const int pg = gi; c_lo = 4 + pg * G::GC; nch = G::GC; slot_f = pg; slot_b = G::NS - 1 - pg; }
    rec_pass3_sweep<DK, GLA, 1, PRB>(p, smem, P, CAT, b, h, c_lo, nch, slot_b, slots, gnorm);
    asm volatile("s_waitcnt vmcnt(0)" ::: "memory");
    rec_pass3_sweep<DK, GLA, 0, PRB>(p, smem, P, CAT, b, h, c_lo, nch, slot_f, slots, gnorm);
}

template <int DK, bool GLA>
DEVINL void rec_scan(float* slots, const float* decs, int bid, int nb) {
    using G = RecGeo<DK, GLA>;
    constexpr int NCHAIN = NBATCH * G::H * 2, PER = 128 * DK / 4;
    const int total = NCHAIN * PER;
    for (int i = bid * NTHR + tid_opaque(); i < total; i += nb * NTHR) {
        const int chain = i / PER, e = i - chain * PER;
        const int k4 = (e * 4) % DK;
        f32x4 run = (f32x4){0.f, 0.f, 0.f, 0.f};
#pragma unroll 1
        for (int s0 = 0; s0 < G::NS; s0 += 8) {
            f32x4 d4[8]; u32x2 a[8];
            bf16_t* sb = (bf16_t*)slots;
#pragma unroll
            for (int j = 0; j < 8; ++j) {
                d4[j] = *(const f32x4*)&decs[((size_t)chain * G::NS + s0 + j) * DK + k4];
                a[j] = *(const u32x2*)(sb + ((size_t)chain * G::NS + s0 + j) * (size_t)(128 * DK) + (size_t)e * 4);
            }
#pragma unroll
            for (int j = 0; j < 8; ++j) {
                const float av[4] = {bf2f((bf16_t)(a[j].x & 0xffffu)), bf2f((bf16_t)(a[j].x >> 16)), bf2f((bf16_t)(a[j].y & 0xffffu)), bf2f((bf16_t)(a[j].y >> 16))};
#pragma unroll
                for (int q = 0; q < 4; ++q) run[q] = __expf(d4[j][q]) * run[q] + av[q];
                *(u32x2*)(sb + ((size_t)chain * G::NS + s0 + j) * (size_t)(128 * DK) + (size_t)e * 4) = pk4(run);
            }
        }
    }
}

DEVINL size_t s5_idx(int b, int di, int pc, int g, int pp) { return ((((size_t)(b * 2 + di) * NCH + pc) * 32 + g) * 64 + pp) * 2; }

constexpr int S5_BU_LD = 20;
constexpr int S5_WAVE_LDS = 128 * S5_BU_LD * 4 + 16 * 136 * 2;
static_assert(8 * S5_WAVE_LDS <= LDS_BYTES, "s5 lds");

DEVINL void s5_load_afr(const Params& p, int row0, int g, int fr, int fq, bf16x8 (&afr)[4]) {
    const bf16x8 z = (bf16x8){0, 0, 0, 0, 0, 0, 0, 0};
#pragma unroll
    for (int sb = 0; sb < 4; ++sb) afr[sb] = (fq < 2) ? *(const bf16x8*)(p.P + (size_t)(row0 + sb * 16 + fr) * 2048 + 1536 + g * 16 + fq * 8) : z;
}
DEVINL void s5_load_bfr(const Params& p, int di, int g, int fr, int fq, bf16x8 (&bfr)[8]) {
    const bf16x8 z = (bf16x8){0, 0, 0, 0, 0, 0, 0, 0};
#pragma unroll
    for (int nt = 0; nt < 8; ++nt) bfr[nt] = (fq < 2) ? *(const bf16x8*)(p.bbm + ((size_t)((di * 32 + g) * 128 + nt * 16 + fr)) * 16 + fq * 8) : z;
}
DEVINL void s5_bu_subblock(float* BuT, const bf16x8& a, const bf16x8 (&bfr)[8], int fr, int fq) {
#pragma unroll
    for (int nt = 0; nt < 8; ++nt) {
        f32x4 c = (f32x4){0.f, 0.f, 0.f, 0.f};
        c = __builtin_amdgcn_mfma_f32_16x16x32_bf16(a, bfr[nt], c, 0, 0, 0);
        *(f32x4*)&BuT[(nt * 16 + fr) * S5_BU_LD + fq * 4] = c;
    }
}
template <int DIR, bool XS>
DEVINL void s5_scan16(const float* BuT, bf16_t* Xs, int lane, float are, float aim, float& xr, float& xi) {
    f32x4 br[4], bi[4];
#pragma unroll
    for (int q = 0; q < 4; ++q) { br[q] = *(const f32x4*)&BuT[lane * S5_BU_LD + q * 4]; bi[q] = *(const f32x4*)&BuT[(64 + lane) * S5_BU_LD + q * 4]; }
#pragma unroll
    for (int tt = 0; tt < 16; ++tt) {
        const int tl = DIR ? (15 - tt) : tt;
        const float nr = are * xr - aim * xi + br[tl >> 2][tl & 3], ni = are * xi + aim * xr + bi[tl >> 2][tl & 3];
        xr = nr; xi = ni;
        if (XS) *(unsigned*)&Xs[tl * 136 + 2 * lane] = cvt_pk_bf16(xr, xi);
    }
}
template <int DIR>
DEVINL void s5_pass1_task(const Params& p, float* BuT, int b, int pc, int g, const bf16x8 (&afr)[4], int lane, int fr, int fq) {
    bf16x8 bfr[8];
    s5_load_bfr(p, DIR, g, fr, fq, bfr);
    const float are = p.atab[((DIR * 32 + g) * 64 + lane) * 2], aim = p.atab[((DIR * 32 + g) * 64 + lane) * 2 + 1];
    float xr = 0.f, xi = 0.f;
#pragma unroll
    for (int sbi = 0; sbi < 4; ++sbi) {
        const int sb = DIR ? (3 - sbi) : sbi;
        s5_bu_subblock(BuT, afr[sb], bfr, fr, fq);
        asm volatile("s_waitcnt lgkmcnt(0)" ::: "memory");
        s5_scan16<DIR, false>(BuT, nullptr, lane, are, aim, xr, xi);
        asm volatile("s_waitcnt lgkmcnt(0)" ::: "memory");
    }
    float* o = p.s5xend + s5_idx(b, DIR, pc, g, lane);
    o[0] = xr; o[1] = xi;
}
DEVINL void s5_pass1_unit(const Params& p, char* smem, int b, int pc, int half) {
    const int t = tid_opaque(), w = t >> 6, lane = t & 63, fr = lane & 15, fq = lane >> 4;
    float* BuT = (float*)(smem + w * S5_WAVE_LDS);
    const int row0 = b * RPB + pc * 64;
#pragma unroll 1
    for (int q = 0; q < 2; ++q) {
        const int g = half * 16 + w * 2 + q;
        bf16x8 afr[4];
        s5_load_afr(p, row0, g, fr, fq, afr);
        s5_pass1_task<0>(p, BuT, b, pc, g, afr, lane, fr, fq);
        s5_pass1_task<1>(p, BuT, b, pc, g, afr, lane, fr, fq);
    }
}
constexpr int S5M_LD = 1032;
constexpr int S5M_PARTS = 4, S5M_TILES = NBATCH * NCH / 16, S5M_TPI = 3;
static_assert(NBATCH * NCH % 16 == 0 && S5M_TPI * 16 * S5M_LD * 2 <= LDS_BYTES - 64, "s5 mm");
DEVINL void s5_pass1_mm(const Params& p, char* smem, int dg, int part) {
    const int t = tid_opaque(), w = sgpr(t >> 6), lane = t & 63, fr = lane & 15, fq = lane >> 4;
    bf16_t* Us = (bf16_t*)smem;
    const int g = dg & 31, di = dg >> 5;
    bf16x8 mf[32];
    {
        const bf16_t* mt = p.s5m + ((size_t)(dg * 8 + w) * 32) * 512 + lane * 8;
#pragma unroll
        for (int ks = 0; ks < 32; ++ks) mf[ks] = *(const bf16x8*)(mt + ks * 512);
    }
    const int j_lo = (S5M_TILES * part) / S5M_PARTS, j_hi = (S5M_TILES * (part + 1)) / S5M_PARTS;
    const int lc = t >> 5, le = t & 31;
    u32x4 ur[S5M_TPI][4];
    auto gload = [&](int j, u32x4 (&u4)[4]) {
        const int cidx = j * 16 + lc; const int b = cidx / NCH, pc = cidx - b * NCH;
        const bf16_t* src = p.P + (size_t)(b * RPB + pc * 64) * 2048 + 1536 + g * 16;
#pragma unroll
        for (int i = 0; i < 4; ++i) { const int e = le + 32 * i; u4[i] = *(const u32x4*)(src + (size_t)(e >> 1) * 2048 + (e & 1) * 8); }
    };
#pragma unroll
    for (int tb = 0; tb < S5M_TPI; ++tb) if (j_lo + tb < j_hi) gload(j_lo + tb, ur[tb]);
    for (int j = j_lo; j < j_hi; j += S5M_TPI) {
#pragma unroll
        for (int tb = 0; tb < S5M_TPI; ++tb) {
            if (j + tb < j_hi) {
#pragma unroll
                for (int i = 0; i < 4; ++i) { const int e = le + 32 * i; *(u32x4*)&Us[(tb * 16 + lc) * S5M_LD + (e >> 1) * 16 + (e & 1) * 8] = ur[tb][i]; }
            }
        }
        lds_sync();
#pragma unroll
        for (int tb = 0; tb < S5M_TPI; ++tb) if (j + S5M_TPI + tb < j_hi) gload(j + S5M_TPI + tb, ur[tb]);
#pragma unroll
        for (int tb = 0; tb < S5M_TPI; ++tb) {
            if (j + tb < j_hi) {
                f32x4 acc[4];
#pragma unroll
                for (int q = 0; q < 4; ++q) acc[q] = (f32x4){0.f, 0.f, 0.f, 0.f};
#pragma unroll
                for (int ks = 0; ks < 32; ++ks) {
                    const bf16x8 ub = *(const bf16x8*)&Us[(tb * 16 + fr) * S5M_LD + ks * 32 + fq * 8];
                    acc[ks & 3] = __builtin_amdgcn_mfma_f32_16x16x32_bf16(mf[ks], ub, acc[ks & 3], 0, 0, 0);
                }
                const f32x4 r4 = (acc[0] + acc[1]) + (acc[2] + acc[3]);
                const int cidx = (j + tb) * 16 + fr; const int b = cidx / NCH, pc = cidx - b * NCH;
                *(f32x4*)(p.s5xend + s5_idx(b, di, pc, g, 0) + w * 16 + fq * 4) = r4;
            }
        }
        lds_sync();
    }
}
DEVINL void s5_scan(const Params& p, int bid, int nb) {
    for (int i = bid * NTHR + tid_opaque(); i < NBATCH * 2 * 32 * 64; i += nb * NTHR) {
        const int pp = i & 63, g = (i >> 6) & 31, di = (i >> 11) & 1, b = i >> 12;
        const float ar = p.a64tab[((di * 32 + g) * 64 + pp) * 2], ai = p.a64tab[((di * 32 + g) * 64 + pp) * 2 + 1];
        float cr = 0.f, ci = 0.f;
#pragma unroll 1
        for (int c0 = 0; c0 < NCH; c0 += 17) {
            float er[17], ei[17];
#pragma unroll
            for (int j = 0; j < 17; ++j) {
                const int ch = c0 + j, pc = di ? (ch < 4 ? 3 - ch : 71 - ch) : ch;
                const size_t ix = s5_idx(b, di, pc, g, 0);
                er[j] = p.s5xend[ix + pp]; ei[j] = p.s5xend[ix + 64 + pp];
            }
#pragma unroll
            for (int j = 0; j < 17; ++j) {
                const int ch = c0 + j, pc = di ? (ch < 4 ? 3 - ch : 71 - ch) : ch;
                const size_t ix = s5_idx(b, di, pc, g, pp);
                p.s5carry[ix] = cr; p.s5carry[ix + 1] = ci;
                const float nr = ar * cr - ai * ci + er[j], ni = ar * ci + ai * cr + ei[j];
                cr = nr; ci = ni;
            }
        }
    }
}
template <int DIR>
DEVINL void s5_pass3_task(const Params& p, float* BuT, bf16_t* Xs, int b, int pc, int g, const bf16x8 (&afr)[4], f32x4 (&acc)[4], int lane, int fr, int fq) {
    bf16x8 bfr[8];
    s5_load_bfr(p, DIR, g, fr, fq, bfr);
    bf16x8 cb[4];
#pragma unroll
    for (int ks = 0; ks < 4; ++ks) cb[ks] = *(const bf16x8*)(p.cmt + ((size_t)(g * 16 + fr)) * 256 + DIR * 128 + ks * 32 + fq * 8);
    const float are = p.atab[((DIR * 32 + g) * 64 + lane) * 2], aim = p.atab[((DIR * 32 + g) * 64 + lane) * 2 + 1];
    const size_t cix = s5_idx(b, DIR, pc, g, lane);
    float xr = p.s5carry[cix], xi = p.s5carry[cix + 1];
#pragma unroll
    for (int sbi = 0; sbi < 4; ++sbi) {
        const int sb = DIR ? (3 - sbi) : sbi;
        s5_bu_subblock(BuT, afr[sb], bfr, fr, fq);
        asm volatile("s_waitcnt lgkmcnt(0)" ::: "memory");
        s5_scan16<DIR, true>(BuT, Xs, lane, are, aim, xr, xi);
        asm volatile("s_waitcnt lgkmcnt(0)" ::: "memory");
        f32x4 c = acc[sb];
#pragma unroll
        for (int ks = 0; ks < 4; ++ks) {
            const bf16x8 a = *(const bf16x8*)(Xs + fr * 136 + ks * 32 + fq * 8);
            c = __builtin_amdgcn_mfma_f32_16x16x32_bf16(cb[ks], a, c, 0, 0, 0);
        }
        acc[sb] = c;
        asm volatile("s_waitcnt lgkmcnt(0)" ::: "memory");
    }
}
DEVINL void s5_pass3_unit(const Params& p, char* smem, int b, int pc, int half) {
    const int t = tid_opaque(), w = t >> 6, lane = t & 63, fr = lane & 15, fq = lane >> 4;
    float* BuT = (float*)(smem + w * S5_WAVE_LDS);
    bf16_t* Xs = (bf16_t*)(smem + w * S5_WAVE_LDS + 128 * S5_BU_LD * 4);
    const int row0 = b * RPB + pc * 64;
    const int g0 = half * 16 + w * 2;
    bf16x8 afrA[4], afrB[4]; u32x2 ubA[4], ubB[4]; f32x4 d4A, d4B;
    auto load_group = [&](int g, bf16x8 (&afr)[4], u32x2 (&ub)[4], f32x4& d4) {
        s5_load_afr(p, row0, g, fr, fq, afr);
#pragma unroll
        for (int sb = 0; sb < 4; ++sb) ub[sb] = *(const u32x2*)(p.P + (size_t)(row0 + sb * 16 + fr) * 2048 + 1536 + g * 16 + fq * 4);
        d4 = *(const f32x4*)(p.s5_d + g * 16 + fq * 4);
    };
    auto run_group = [&](int g, const bf16x8 (&afr)[4], const u32x2 (&ubv)[4], const f32x4& d4) {
        f32x4 acc[4];
#pragma unroll
        for (int sb = 0; sb < 4; ++sb) acc[sb] = (f32x4){0.f, 0.f, 0.f, 0.f};
        s5_pass3_task<1>(p, BuT, Xs, b, pc, g, afr, acc, lane, fr, fq);
        s5_pass3_task<0>(p, BuT, Xs, b, pc, g, afr, acc, lane, fr, fq);
#pragma unroll
        for (int sb = 0; sb < 4; ++sb) {
            const int tok = sb * 16 + fr;
            const u32x2 ub = ubv[sb];
            f32x4 uv; uv[0] = bf2f((bf16_t)(ub.x & 0xffff)); uv[1] = bf2f((bf16_t)(ub.x >> 16)); uv[2] = bf2f((bf16_t)(ub.y & 0xffff)); uv[3] = bf2f((bf16_t)(ub.y >> 16));
            f32x4 r4;
#pragma unroll
            for (int j = 0; j < 4; ++j) r4[j] = gelu_tanh(acc[sb][j] + d4[j] * uv[j]);
            *(u32x2*)(p.s5a + (size_t)(row0 + tok) * 512 + g * 16 + fq * 4) = pk4(r4);
        }
    };
    load_group(g0, afrA, ubA, d4A);
    load_group(g0 + 1, afrB, ubB, d4B);
    run_group(g0, afrA, ubA, d4A);
    run_group(g0 + 1, afrB, ubB, d4B);
}

struct UnitQueue {
    int* counter; int* slot; int total, shard, k, pend, per;
    static constexpr int NSH = 32;
    DEVINL void init(int* heads, int q, char* smem, int total_, int bid, int nb) {
        shard = sgpr(bid) & (NSH - 1); counter = heads + (q * NSH + shard) * 16; slot = (int*)(smem + LDS_BYTES - 64); total = total_;
        per = (sgpr(nb) - 1 - shard) / NSH + 1;
        k = sgpr(bid) >> 5; pend = 0;
        if (tid_opaque() == 0) pend = atomicAdd(counter, 1) + per;
    }
    DEVINL int unit() const { return shard + NSH * k; }
    DEVINL bool valid() const { return unit() < total; }
    DEVINL void advance() {
        if (tid_opaque() == 0) { *slot = pend; pend = atomicAdd(counter, 1) + per; }
        lds_sync();
        k = sgpr(*slot);
        lds_sync();
    }
};

DEVINL void phase_prologue(const Params& p, char* smem, int bid, int nb) {
    UnitQueue Q; Q.init(p.qheads, 0, smem, T0_END, bid, nb);
    for (; Q.valid(); Q.advance()) { const int u = Q.unit(); prologue_task(p, smem, (u < NT_S5) ? (T0_S5 + u) : (u - NT_S5)); }
}

template <int LAYER>
DEVINL void phase_rec1(const Params& p, char* smem, int bid, int nb) {
    if (LAYER == 0) {
        constexpr int NG = 8 * 4 * 2 * 16;
        constexpr int NS5 = 64 * S5M_PARTS;
        UnitQueue Q; Q.init(p.qheads, 1, smem, NG + NS5, bid, nb);
        for (; Q.valid(); Q.advance()) {
            const int u = Q.unit();
            if (u >= NS5) {
                const int v = u - NS5;
                const int cg = v & 15, dir = (v >> 4) & 1, h = (v >> 5) & 3, b = v >> 7;
                if (dir == 0) rec_pass1_unit<64, true, 0>(p, smem, p.P, b, h, cg, p.gslots, p.gdecs);
                else rec_pass1_unit<64, true, 1>(p, smem, p.P, b, h, cg, p.gslots, p.gdecs);
            } else s5_pass1_mm(p, smem, u >> 2, u & 3);
        }
    } else {
        constexpr int NG = 8 * 8 * 2 * 8;
        for (int u = bid; u < NG; u += nb) {
            const int cg = u & 7, dir = (u >> 3) & 1, h = (u >> 4) & 7, b = u >> 7;
            if (dir == 0) rec_pass1_unit<128, false, 0>(p, smem, p.P, b, h, cg, p.hslots, p.hdecs);
            else rec_pass1_unit<128, false, 1>(p, smem, p.P, b, h, cg, p.hslots, p.hdecs);
        }
    }
}
template <int LAYER>
DEVINL void phase_scan(const Params& p, char* smem, int bid, int nb) {
    if (LAYER == 0) { rec_scan<64, true>(p.gslots, p.gdecs, bid, nb); s5_scan(p, bid, nb); }
    else rec_scan<128, false>(p.hslots, p.hdecs, bid, nb);
}
template <int LAYER>
DEVINL void phase_rec3(const Params& p, char* smem, int bid, int nb) {
    if (LAYER == 0) {
        constexpr int NG = 8 * 4 * 17;
        constexpr int NS5 = NBATCH * NCH * 2;
        UnitQueue Q; Q.init(p.qheads, 2, smem, NG + NS5, bid, nb);
        for (; Q.valid(); Q.advance()) {
            const int u = Q.unit();
            if (u < NG) { const int gi = u % 17, h = (u / 17) & 3, b = u / 68; rec_pass3_unit<64, true>(p, smem, p.P, p.H, b, h, gi, p.gslots, p.gla_norm); }
            else { const int v = u - NG; s5_pass3_unit(p, smem, (v >> 1) / NCH, (v >> 1) % NCH, v & 1); }
        }
    } else {
        constexpr int NG = 8 * 8 * 8;
        for (int u = bid; u < NG; u += nb) { const int gi = u & 7, h = (u >> 3) & 7, b = u >> 6; rec_pass3_unit<128, false>(p, smem, p.P, p.H, b, h, gi, p.hslots, p.hg_norm); }
    }
}

DEVINL void phase_final(const Params& p, int bid, int nb) {
    const int t = tid_opaque(), w = sgpr(t >> 6), lane = t & 63;
    constexpr int NQ = NLAT / 16;
    const int per = (NQ + nb - 1) / nb;
    const int q_lo = bid * per;
    const int q_hi = (q_lo + per < NQ) ? (q_lo + per) : NQ;
    const int ng = q_hi - q_lo - w;
    const int nrows = sgpr((ng > 0) ? (((ng + 7) >> 3) * 16) : 0);
    if (nrows > 0) {
        auto lat_at = [&](int n) { return sgpr((q_lo + w + ((n >> 4) << 3)) * 16 + (n & 15)); };
        auto uni_of = [&](int i) { return (i >> 12) * RPB + CTXL + (i & 4095); };
        f32x4 gn[4], gu[4], gy[4];
#pragma unroll
        for (int i = 0; i < 4; ++i) gn[i] = *(const f32x4*)(p.final_norm + lane * 4 + i * 256);
        int b_cur = -1;
        u32x2 xA[4], uA[4], yA[4], xB[4], uB[4], yB[4];
        auto issue = [&](int i, int slot, u32x2 (&xv)[4], u32x2 (&uv)[4], u32x2 (&yv)[4]) {
            const int r = uni_of(i);
#pragma unroll
            for (int q = 0; q < 4; ++q) {
                xv[q] = *(const u32x2*)(p.xb + (size_t)i * D + lane * 4 + q * 256);
                uv[q] = *(const u32x2*)(p.y2 + (size_t)slot * D + lane * 4 + q * 256);
                yv[q] = *(const u32x2*)(p.Y + (size_t)r * D + lane * 4 + q * 256);
            }
        };
        int slot_n = p.sor[uni_of(lat_at(0))];
        issue(lat_at(0), sgpr(slot_n), xA, uA, yA);
        slot_n = (nrows > 1) ? p.sor[uni_of(lat_at(1))] : 0;
        for (int n = 0; n < nrows; ++n) {
            const int i = lat_at(n);
            int slot_nn = 0;
            if (n + 2 < nrows) slot_nn = p.sor[uni_of(lat_at(n + 2))];
            if (n + 1 < nrows) issue(lat_at(n + 1), sgpr(slot_n), xB, uB, yB);
            const int b = i >> 12;
            if (b != b_cur) {
                b_cur = b;
                const float* gatev = p.mod + ((size_t)(9 + b)) * 6144 + 5120;
                const float* gyv = p.mod + ((size_t)(9 + b)) * 6144 + 2048;
#pragma unroll
                for (int q = 0; q < 4; ++q) { gu[q] = *(const f32x4*)(gatev + lane * 4 + q * 256); gy[q] = *(const f32x4*)(gyv + lane * 4 + q * 256); }
            }
            f32x4 v[4];
            float ss = 0.f;
#pragma unroll
            for (int q = 0; q < 4; ++q) {
                const u32x2 u = uA[q], y = yA[q], xv = xA[q];
                v[q][0] = bf2f((bf16_t)(xv.x & 0xffffu)) + gu[q][0] * bf2f((bf16_t)(u.x & 0xffffu)) + gy[q][0] * bf2f((bf16_t)(y.x & 0xffffu));
                v[q][1] = bf2f((bf16_t)(xv.x >> 16)) + gu[q][1] * bf2f((bf16_t)(u.x >> 16)) + gy[q][1] * bf2f((bf16_t)(y.x >> 16));
                v[q][2] = bf2f((bf16_t)(xv.y & 0xffffu)) + gu[q][2] * bf2f((bf16_t)(u.y & 0xffffu)) + gy[q][2] * bf2f((bf16_t)(y.y & 0xffffu));
                v[q][3] = bf2f((bf16_t)(xv.y >> 16)) + gu[q][3] * bf2f((bf16_t)(u.y >> 16)) + gy[q][3] * bf2f((bf16_t)(y.y >> 16));
                ss += v[q][0] * v[q][0] + v[q][1] * v[q][1] + v[q][2] * v[q][2] + v[q][3] * v[q][3];
            }
#pragma unroll
            for (int o = 32; o >= 1; o >>= 1) ss += __shfl_xor(ss, o);
            const float rstd = rsqrtf(ss * (1.0f / 1024.0f) + EPS);
            float* res = p.out + (size_t)i * D;
#pragma unroll
            for (int q = 0; q < 4; ++q) *(f32x4*)(res + lane * 4 + q * 256) = v[q] * rstd * gn[q];
#pragma unroll
            for (int q = 0; q < 4; ++q) { xA[q] = xB[q]; uA[q] = uB[q]; yA[q] = yB[q]; }
            slot_n = slot_nn;
        }
    }
}

constexpr int NPHASE = 23;
constexpr int MEGA_LDS = LDS_BYTES + 16 + 1024;
static_assert(sizeof(Params) <= 1024 && sizeof(Params) % 8 == 0, "params block");
template <int PH>
DEVINL void run_phase(const Params& p, char* smem, int bid, int nb) {
    if (PH == 0) phase_prologue(p, smem, bid, nb);
    if (PH == 1) phase_pre<0>(p, smem, bid, nb);
    if (PH == 2) phase_gemm<0>(p, smem, bid, nb);
    if (PH == 3) phase_rec1<0>(p, smem, bid, nb);
    if (PH == 4) phase_scan<0>(p, smem, bid, nb);
    if (PH == 5) phase_rec3<0>(p, smem, bid, nb);
    if (PH == 6) phase_gemm<1>(p, smem, bid, nb);
    if (PH == 7) phase_gemm<2>(p, smem, bid, nb);
    if (PH == 8) phase_pre<1>(p, smem, bid, nb);
    if (PH == 9) phase_list<0>(p, smem, bid, nb);
    if (PH == 10) phase_moe<0, 1>(p, smem, bid, nb);
    if (PH == 11) phase_moe<0, 2>(p, smem, bid, nb);
    if (PH == 12) phase_pre<2>(p, smem, bid, nb);
    if (PH == 13) phase_gemm<3>(p, smem, bid, nb);
    if (PH == 14) phase_rec1<1>(p, smem, bid, nb);
    if (PH == 15) phase_scan<1>(p, smem, bid, nb);
    if (PH == 16) phase_rec3<1>(p, smem, bid, nb);
    if (PH == 17) phase_gemm<4>(p, smem, bid, nb);
    if (PH == 18) phase_pre<3>(p, smem, bid, nb);
    if (PH == 19) phase_list<1>(p, smem, bid, nb);
    if (PH == 20) phase_moe<1, 1>(p, smem, bid, nb);
    if (PH == 21) phase_moe<1, 2>(p, smem, bid, nb);
    if (PH == 22) phase_final(p, bid, nb);
}

extern __shared__ __attribute__((aligned(16))) char dyn_smem[];

#if ONE_LAUNCH
template <int PH> struct PhaseSeq {
    static DEVINL void run(const Params& p, char* smem, const XcdBarrier& bar) {
        PhaseSeq<PH - 1>::run(p, smem, bar);
        xcd_barrier(bar);
        run_phase<PH>(p, smem, (int)blockIdx.x, (int)gridDim.x);
#ifdef DUP_MASK
        if ((DUP_MASK >> PH) & 1) { xcd_barrier(bar); run_phase<PH>(p, smem, (int)blockIdx.x, (int)gridDim.x); }
#endif
    }
};
template <> struct PhaseSeq<0> {
    static DEVINL void run(const Params& p, char* smem, const XcdBarrier& bar) {
        run_phase<0>(p, smem, (int)blockIdx.x, (int)gridDim.x);
#ifdef DUP_MASK
        if (DUP_MASK & 1) { xcd_barrier(bar); run_phase<0>(p, smem, (int)blockIdx.x, (int)gridDim.x); }
#endif
    }
};
__global__ void __launch_bounds__(NTHR, 2) mega_kernel(Params p) {
    volatile LAS unsigned* st = (volatile LAS unsigned*)(dyn_smem + LDS_BYTES);
    if (threadIdx.x == 0) { st[0] = 0u; st[1] = 0u; st[2] = 0u; st[3] = 0u; }
    __syncthreads();
    XcdBarrier bar = xcd_barrier_post(p.bar, st);
#ifdef PROBE_ID
    {
        const int bid = (int)blockIdx.x, nb = (int)gridDim.x;
        if (PROBE_ID == 1) for (int v = bid; v < NBATCH * NCH * 2; v += nb) s5_pass1_unit(p, dyn_smem, (v >> 1) / NCH, (v >> 1) % NCH, v & 1);
        if (PROBE_ID == 2) for (int u = bid; u < 1024; u += nb) { const int cg = u & 15, dir = (u >> 4) & 1, h = (u >> 5) & 3, b = u >> 7;
            if (dir == 0) rec_pass1_unit<64, true, 0>(p, dyn_smem, p.P, b, h, cg, p.gslots, p.gdecs); else rec_pass1_unit<64, true, 1>(p, dyn_smem, p.P, b, h, cg, p.gslots, p.gdecs); }
        if (PROBE_ID == 3) for (int v = bid; v < NBATCH * NCH * 2; v += nb) s5_pass3_unit(p, dyn_smem, (v >> 1) / NCH, (v >> 1) % NCH, v & 1);
        if (PROBE_ID == 4) for (int u = bid; u < 8 * 4 * 17; u += nb) { const int gi = u % 17, h = (u / 17) & 3, b = u / 68; rec_pass3_unit<64, true>(p, dyn_smem, p.P, p.H, b, h, gi, p.gslots, p.gla_norm); }
        if (PROBE_ID == 6) for (int u = bid; u < 512; u += nb) { const int gi = u & 7, h = (u >> 3) & 7, b = u >> 6; rec_pass3_unit<128, false, RECPROBE>(p, dyn_smem, p.P, p.H, b, h, gi, p.hslots, p.hg_norm); }
        if (PROBE_ID == 5) for (int u = bid; u < 1024 + NBATCH * NCH * 2; u += nb) {
            if (u < 1024) { const int cg = u & 15, dir = (u >> 4) & 1, h = (u >> 5) & 3, b = u >> 7;
                if (dir == 0) rec_pass1_unit<64, true, 0>(p, dyn_smem, p.P, b, h, cg, p.gslots, p.gdecs); else rec_pass1_unit<64, true, 1>(p, dyn_smem, p.P, b, h, cg, p.gslots, p.gdecs); }
            else { const int v = u - 1024; s5_pass1_unit(p, dyn_smem, (v >> 1) / NCH, (v >> 1) % NCH, v & 1); } }
        xcd_barrier(bar);
    }
#endif
#ifdef PREFIX_K
    PhaseSeq<PREFIX_K>::run(p, dyn_smem, bar);
    xcd_barrier(bar);
    if (blockIdx.x == 0) { if (threadIdx.x < 256) p.cnt[threadIdx.x] = 0; for (int i = threadIdx.x; i < 3 * 32 * 16; i += NTHR) p.qheads[i] = 0; }
    xcd_barrier(bar);
#endif
    PhaseSeq<NPHASE - 1>::run(p, dyn_smem, bar);
}
#else
template <int PH>
__global__ void __launch_bounds__(NTHR, 2) phase_kernel(Params p) {
    run_phase<PH>(p, dyn_smem, (int)blockIdx.x, (int)gridDim.x);
}
template <int PH> struct Launcher {
    static void go(const Params& p, int grid, hipStream_t s) {
        Launcher<PH - 1>::go(p, grid, s);
        static bool attr = false;
        if (!attr) { hipFuncSetAttribute((const void*)phase_kernel<PH>, hipFuncAttributeMaxDynamicSharedMemorySize, LDS_BYTES + 16); attr = true; }
        phase_kernel<PH><<<grid, NTHR, LDS_BYTES + 16, s>>>(p);
    }
};
template <> struct Launcher<-1> { static void go(const Params&, int, hipStream_t) {} };
#endif

static size_t align_up(size_t v, size_t a) { return (v + a - 1) / a * a; }

extern "C" void kernel_launch(void* const* d_in, const int* in_sizes, int n_in, void* d_out, int out_size, void* d_ws, size_t ws_size, hipStream_t stream) {
    (void)in_sizes; (void)n_in; (void)out_size;
    Params p;
    memset(&p, 0, sizeof(p));
    const float* const* in = (const float* const*)d_in;
    p.x = in[0]; p.c = in[1]; p.ctx = in[2]; p.c_ctx = in[3]; p.ada_w = in[4]; p.ada_b = in[5]; p.norm_mix = in[6]; p.norm_ffn = in[7];
    p.ab_w_in = in[8]; p.ab_w_out = in[9]; p.gla_a2 = in[10]; p.gla_ab = in[11]; p.gla_norm = in[12];
    p.s5_lam_re = in[13]; p.s5_lam_im = in[14]; p.s5_log_dt = in[15]; p.s5_b_re = in[16]; p.s5_b_im = in[17]; p.s5_c_re = in[18]; p.s5_c_im = in[19];
    p.s5_d = in[20]; p.glu_w = in[21]; p.glu_b = in[22]; p.hg_w_in = in[23]; p.hg_w_out = in[24]; p.hg_lb = in[25]; p.hg_norm = in[26];
    p.router_w = in[27]; p.router_bias = in[28]; p.moe_wg = in[29]; p.moe_wu = in[30]; p.moe_wd = in[31]; p.final_norm = in[32];
    p.out = (float*)d_out;

    char* ws = (char*)d_ws;
    size_t o = 0;
    auto take = [&](size_t bytes) { char* r = ws + o; o = align_up(o + bytes, 256); return r; };
    p.bar = (unsigned*)take(XCD_BAR_WORDS * 4);
    p.cnt = (int*)take(256 * 4);
    p.qheads = (int*)take(3 * 32 * 16 * 4);
    p.mod = (float*)take((size_t)2 * 9 * 6144 * 4);
    p.pos = (float*)take(64 * 512 * 4);
    p.lb = (float*)take(1024 * 4);
    p.atab = (float*)take(2 * 32 * 64 * 2 * 4);
    p.a64tab = (float*)take(2 * 32 * 64 * 2 * 4);
    p.cmt = (bf16_t*)take((size_t)32 * 16 * 256 * 2);
    p.bbm = (bf16_t*)take((size_t)2 * 32 * 128 * 16 * 2);
    p.wrt = (bf16_t*)take((size_t)2 * 2 * 32 * 1024 * 2);
    p.RT = (float4*)take((size_t)R * 16);
    p.list = (int*)take((size_t)ACT_ROWS * 4);
    p.wl = (float*)take((size_t)ACT_ROWS * 4);
    p.wh = (float*)take((size_t)ACT_ROWS * 4);
    p.cx = (float*)take((size_t)NBATCH * CTXL * D * 4);
    p.sor = (int*)take((size_t)R * 4);
    p.blkcnt = (int*)take((size_t)2 * 256 * 48 * 4);
    p.wt_in0 = (bf16_t*)take((size_t)2048 * 1024 * 2);
    p.wt_out0 = (bf16_t*)take((size_t)1024 * 1024 * 2);
    p.glu_t = (bf16_t*)take((size_t)512 * 512 * 2);
    p.wt_in1 = (bf16_t*)take((size_t)5120 * 1024 * 2);
    p.wt_out1 = (bf16_t*)take((size_t)1024 * 1024 * 2);
    p.H = (bf16_t*)take((size_t)R * 1024 * 2);
    p.xb = (bf16_t*)take((size_t)NLAT * 1024 * 2);
    const size_t big = o;
    p.P = (bf16_t*)(ws + big);
    size_t o0 = big + (size_t)R * 2048 * 2;
    auto take0 = [&](size_t bytes) { char* r = ws + o0; o0 = align_up(o0 + bytes, 256); return r; };
    p.gslots = (float*)take0((size_t)64 * 16 * 128 * 64 * 4);
    p.gdecs = (float*)take0((size_t)64 * 16 * 64 * 4);
    p.s5xend = (float*)take0((size_t)NBATCH * 2 * NCH * 32 * 64 * 2 * 4);
    p.s5carry = (float*)take0((size_t)NBATCH * 2 * NCH * 32 * 64 * 2 * 4);
    p.s5m = (bf16_t*)take0((size_t)64 * 128 * 1024 * 2);
    p.s5a = (bf16_t*)take0((size_t)R * 512 * 2);
    p.AF = (float*)take0((size_t)R * 32 * 4);
    p.wgu_t = (bf16_t*)take0((size_t)32 * 512 * 1024 * 2);
    p.wd_t = (bf16_t*)take0((size_t)32 * 1024 * 256 * 2);
    p.hs = (bf16_t*)(ws + big);
    p.Y = (bf16_t*)(ws + big);
    p.y2 = (bf16_t*)(ws + big + (size_t)R * 1024 * 2);
    p.act = (bf16_t*)(ws + big + (size_t)R * 1024 * 2 + (size_t)ACT_ROWS * 1024 * 2);
    if (big + (size_t)R * 1024 * 2 + (size_t)ACT_ROWS * 1024 * 2 + (size_t)ACT_ROWS * 512 * 2 > (size_t)((char*)p.wgu_t - ws)) fprintf(stderr, "moe overlay overlaps live buffers\n");
    size_t o1 = big + (size_t)R * 5120 * 2;
    auto take1 = [&](size_t bytes) { char* r = ws + o1; o1 = align_up(o1 + bytes, 256); return r; };
    p.hslots = (float*)d_out;
    p.hdecs = (float*)((char*)d_out + (size_t)128 * 8 * 128 * 128 * 4);
    const size_t need = o0 > o1 ? o0 : o1;
    if (need > ws_size) fprintf(stderr, "workspace too small: need %zu have %zu\n", need, ws_size);

    static int grid = 0;
    if (!grid) {
        int dev = 0, cus = 0;
        if (hipGetDevice(&dev) != hipSuccess || hipDeviceGetAttribute(&cus, hipDeviceAttributeMultiprocessorCount, dev) != hipSuccess || cus <= 0) cus = 256;
        grid = cus > 256 ? 256 : (cus & ~7);
    }
#if ONE_LAUNCH
    static bool attr = false;
    if (!attr) { hipFuncSetAttribute((const void*)mega_kernel, hipFuncAttributeMaxDynamicSharedMemorySize, MEGA_LDS); attr = true; }
    hipMemsetAsync(p.bar, 0, XCD_BAR_WORDS * 4 + 256 * 4 + 3 * 32 * 16 * 4, stream);
    mega_kernel<<<grid, NTHR, MEGA_LDS, stream>>>(p);
#else
    Launcher<NPHASE - 1>::go(p, grid, stream);
#endif
}
```
